# Optimizing an MI355X kernel written in HIP

```python
import math
import jax
import jax.numpy as jnp
from jax import lax
import numpy as np

D_MODEL = 2048
BATCH = 1
SEQ = 16384
DEPTH = 2

GRID_W = 64
CTX_LEN = 256

S5_WIDTH = 1024
S5_GROUP = 16
S5_GROUPS = S5_WIDTH // S5_GROUP
S5_STATE = 64

SSD_WIDTH = 2048
SSD_HEAD_DIM = 64
SSD_HEADS = SSD_WIDTH // SSD_HEAD_DIM
SSD_GROUPS = 4
SSD_STATE = 128
SSD_CONV = 3
SSD_CHUNK = 128
SSD_CONV_CH = SSD_WIDTH + 2 * SSD_GROUPS * SSD_STATE

D_FF = 5632
FFN_CONV = 3

COL_XBC = S5_WIDTH
COL_DT = COL_XBC + SSD_CONV_CH
COL_Z = COL_DT + 2 * SSD_HEADS
COL_GATES = COL_Z + SSD_WIDTH
PROJ_COLS = COL_GATES + 2 * D_MODEL

DEEPNORM_ALPHA = (2 * DEPTH) ** 0.25
DEEPNORM_BETA = (8 * DEPTH) ** -0.25
LN_EPS = 1e-5
RMS_EPS = 1e-5
F32 = jnp.float32

kernel_name = 'hybrid_s5_ssd_convffn_diffusion_block'


def layer_norm(x, g, b):
    xf = x.astype(F32)
    mu = jnp.mean(xf, axis=-1, keepdims=True)
    var = jnp.mean(jnp.square(xf - mu), axis=-1, keepdims=True)
    return ((xf - mu) * lax.rsqrt(var + LN_EPS) * g.astype(F32) + b.astype(F32)).astype(x.dtype)


def modulate(h, shift, scale):
    return h * (1.0 + scale) + shift


def adaln(cvec, w, b):
    return jax.nn.silu(cvec) @ w + b


def _ident(a):
    return a


def _rev(a):
    return jnp.flip(a, axis=1)


def dwconv_seq(x, w, b):
    k, ch = w.shape
    y = lax.conv_general_dilated(x, w[:, None, :], window_strides=(1,), padding=[(k // 2, k // 2)],
                                 dimension_numbers=('NWC', 'WIO', 'NWC'), feature_group_count=ch)
    return y + b


def dwconv_grid(x, w, b):
    bsz, n, ch = x.shape
    rows = n // GRID_W
    k = w.shape[0]
    img = x.reshape(bsz, rows, GRID_W, ch)
    y = lax.conv_general_dilated(img, w[:, :, None, :], window_strides=(1, 1),
                                 padding=[(k // 2, k // 2), (k // 2, k // 2)],
                                 dimension_numbers=('NHWC', 'HWIO', 'NHWC'), feature_group_count=ch)
    return (y + b).reshape(bsz, n, ch)


def s5_discretise(lam_re, lam_im, log_step, b_re, b_im):
    lam_re = jnp.minimum(lam_re.astype(F32), -1e-4)
    lam_im = lam_im.astype(F32)
    step = jnp.exp(log_step.astype(F32))[:, None]
    mag = jnp.exp(lam_re * step)
    ab_re = mag * jnp.cos(lam_im * step)
    ab_im = mag * jnp.sin(lam_im * step)
    den = jnp.square(lam_re) + jnp.square(lam_im)
    q_re = ((ab_re - 1.0) * lam_re + ab_im * lam_im) / den
    q_im = (ab_im * lam_re - (ab_re - 1.0) * lam_im) / den
    b_re = b_re.astype(F32)
    b_im = b_im.astype(F32)
    bb_re = q_re[..., None] * b_re - q_im[..., None] * b_im
    bb_im = q_re[..., None] * b_im + q_im[..., None] * b_re
    return ab_re, ab_im, bb_re, bb_im


def _complex_affine_combine(e1, e2):
    a1r, a1i, b1r, b1i = e1
    a2r, a2i, b2r, b2i = e2
    return (a2r * a1r - a2i * a1i,
            a2r * a1i + a2i * a1r,
            a2r * b1r - a2i * b1i + b2r,
            a2r * b1i + a2i * b1r + b2i)


def s5_states(u, disc, s0=None):
    ab_re, ab_im, bb_re, bb_im = disc
    bu_re = jnp.einsum('blgj,gpj->blgp', u, bb_re)
    bu_im = jnp.einsum('blgj,gpj->blgp', u, bb_im)
    if s0 is not None:
        s0_re, s0_im = s0
        bu_re = bu_re.at[:, 0].add(ab_re * s0_re - ab_im * s0_im)
        bu_im = bu_im.at[:, 0].add(ab_re * s0_im + ab_im * s0_re)
    a_re = jnp.broadcast_to(ab_re, bu_re.shape)
    a_im = jnp.broadcast_to(ab_im, bu_im.shape)
    _, _, s_re, s_im = lax.associative_scan(_complex_affine_combine, (a_re, a_im, bu_re, bu_im), axis=1)
    return s_re, s_im


def s5_readout(s_re, s_im, c_re, c_im):
    return jnp.einsum('blgp,gjp->blgj', s_re, c_re.astype(F32)) - jnp.einsum('blgp,gjp->blgj', s_im, c_im.astype(F32))


def s5_glu(y, u, d, w_glu):
    bsz, n = y.shape[:2]
    y = (y + u * d.astype(F32).reshape(S5_GROUPS, S5_GROUP)).reshape(bsz, n, S5_WIDTH)
    a = jax.nn.gelu(y) @ w_glu
    return a[..., :S5_WIDTH] * jax.nn.sigmoid(a[..., S5_WIDTH:])


def s5_branch(u_lat, u_ctx, lam_re, lam_im, log_step, b_re, b_im, c_re, c_im, d, w_glu, ctx_out):
    bsz = u_lat.shape[0]
    ul = u_lat.astype(F32).reshape(bsz, u_lat.shape[1], S5_GROUPS, S5_GROUP)
    uc = u_ctx.astype(F32).reshape(bsz, u_ctx.shape[1], S5_GROUPS, S5_GROUP)
    ys_l, ys_c = [], []
    for k, order in ((0, _ident), (1, _rev)):
        disc = s5_discretise(lam_re[k], lam_im[k], log_step[k], b_re, b_im)
        sc_re, sc_im = s5_states(order(uc), disc)
        sl_re, sl_im = s5_states(order(ul), disc, (sc_re[:, -1], sc_im[:, -1]))
        ys_l.append(order(s5_readout(sl_re, sl_im, c_re[k], c_im[k])))
        if ctx_out:
            ys_c.append(order(s5_readout(sc_re, sc_im, c_re[k], c_im[k])))
    y_lat = s5_glu(ys_l[0] + ys_l[1], ul, d, w_glu).astype(u_lat.dtype)
    y_ctx = s5_glu(ys_c[0] + ys_c[1], uc, d, w_glu).astype(u_ctx.dtype) if ctx_out else None
    return y_lat, y_ctx


def segsum_exp(cum):
    t = cum.shape[-1]
    mask = jnp.tril(jnp.ones((t, t), dtype=bool))
    diff = cum[..., :, None] - cum[..., None, :]
    return jnp.where(mask, jnp.exp(jnp.where(mask, diff, 0.0)), 0.0)


def ssd_chunked(xh, dt, a, bm, cm, s0):
    bsz, n, _, hp = xh.shape
    grp, ns = bm.shape[2], bm.shape[3]
    rep = SSD_HEADS // grp
    nc = n // SSD_CHUNK
    xc = (xh * dt[..., None]).reshape(bsz, nc, SSD_CHUNK, grp, rep, hp)
    la = jnp.moveaxis((dt * a).reshape(bsz, nc, SSD_CHUNK, grp, rep), 2, -1)
    cum = jnp.cumsum(la, axis=-1)
    bc = bm.reshape(bsz, nc, SSD_CHUNK, grp, ns)
    cc = cm.reshape(bsz, nc, SSD_CHUNK, grp, ns)
    cb = jnp.einsum('bclgn,bcsgn->bcgls', cc, bc)
    scores = cb[:, :, :, None] * segsum_exp(cum)
    y = jnp.einsum('bcgrls,bcsgrp->bclgrp', scores, xc)
    decay_to_end = jnp.exp(cum[..., -1:] - cum)
    states = jnp.einsum('bclgn,bcgrl,bclgrp->bcgrpn', bc, decay_to_end, xc)
    states = jnp.concatenate([s0[:, None], states], axis=1)
    chunk_cum = jnp.cumsum(jnp.pad(cum[..., -1], ((0, 0), (1, 0), (0, 0), (0, 0))), axis=1)
    decay_chunk = segsum_exp(jnp.moveaxis(chunk_cum, 1, -1))
    states_in = jnp.einsum('bgrzc,bcgrpn->bzgrpn', decay_chunk[..., :-1, :], states)
    y = y + jnp.einsum('bclgn,bcgrpn,bcgrl->bclgrp', cc, states_in, jnp.exp(cum))
    return y.reshape(bsz, n, SSD_HEADS, hp)


def ssd_final_state(xh, dt, a, bm):
    bsz, n, _, hp = xh.shape
    grp = bm.shape[2]
    rep = SSD_HEADS // grp
    cum = jnp.cumsum(dt * a, axis=1)
    decay = jnp.exp(cum[:, -1:] - cum).reshape(bsz, n, grp, rep)
    xd = (xh * dt[..., None]).reshape(bsz, n, grp, rep, hp)
    return jnp.einsum('blgn,blgr,blgrp->bgrpn', bm, decay, xd)


def ssd_prepare(xbc, dtr, conv_w, conv_b, dt_bias):
    xbc = jax.nn.silu(dwconv_seq(xbc, conv_w, conv_b)).astype(F32)
    bsz, n, _ = xbc.shape
    gn = SSD_GROUPS * SSD_STATE
    xh = xbc[..., :SSD_WIDTH].reshape(bsz, n, SSD_HEADS, SSD_HEAD_DIM)
    bm = xbc[..., SSD_WIDTH:SSD_WIDTH + gn].reshape(bsz, n, SSD_GROUPS, SSD_STATE)
    cm = xbc[..., SSD_WIDTH + gn:].reshape(bsz, n, SSD_GROUPS, SSD_STATE)
    dt = jax.nn.softplus(dtr.astype(F32).reshape(bsz, n, 2, SSD_HEADS) + dt_bias.astype(F32))
    return xh, bm, cm, dt


def ssd_output(y, xh, z, d, norm_w):
    y = (y + xh * d.astype(F32)[:, None]).reshape(z.shape)
    h = y * jax.nn.silu(z.astype(F32))
    hg = h.reshape(h.shape[0], h.shape[1], SSD_GROUPS, SSD_WIDTH // SSD_GROUPS)
    hg = hg * lax.rsqrt(jnp.mean(jnp.square(hg), axis=-1, keepdims=True) + RMS_EPS)
    return (hg.reshape(h.shape) * norm_w.astype(F32)).astype(z.dtype)


def ssd_branch(xbc_l, dtr_l, z_l, xbc_c, dtr_c, z_c, conv_w, conv_b, dt_bias, a_log, d, norm_w):
    a = -jnp.exp(a_log.astype(F32))
    xl, bl, cl, dtl = ssd_prepare(xbc_l, dtr_l, conv_w, conv_b, dt_bias)
    xc, bc, cc, dtc = ssd_prepare(xbc_c, dtr_c, conv_w, conv_b, dt_bias)
    ys_l, ys_c = [], []
    for k, order in ((0, _ident), (1, _rev)):
        s_ctx = ssd_final_state(order(xc), order(dtc[:, :, k]), a[k], order(bc))
        ys_l.append(order(ssd_chunked(order(xl), order(dtl[:, :, k]), a[k], order(bl), order(cl), s_ctx)))
        if z_c is not None:
            ys_c.append(order(ssd_chunked(order(xc), order(dtc[:, :, k]), a[k], order(bc), order(cc),
                                          jnp.zeros_like(s_ctx))))
    y_lat = ssd_output(ys_l[0] + ys_l[1], xl, z_l, d, norm_w)
    y_ctx = ssd_output(ys_c[0] + ys_c[1], xc, z_c, d, norm_w) if z_c is not None else None
    return y_lat, y_ctx


def merge_branches(y_s5, y_ssd, gates, w_s5p, w_ssdp, w_out):
    g = jax.nn.sigmoid(gates.astype(F32)).astype(gates.dtype)
    merged = g[..., :D_MODEL] * (y_s5 @ w_s5p) + g[..., D_MODEL:] * (y_ssd @ w_ssdp)
    return merged @ w_out


def conv_ffn(h, w_up, conv_w, conv_b, w_down, grid):
    up = h @ w_up
    gate, val = up[..., :D_FF], up[..., D_FF:]
    gate = dwconv_grid(gate, conv_w, conv_b) if grid else dwconv_seq(gate, conv_w[FFN_CONV // 2], conv_b)
    return (jax.nn.silu(gate) * val) @ w_down


def setup_inputs(seed: int = 0) -> dict:
    key = jax.random.key(seed)
    kit = iter(jax.random.split(key, 48))

    def normal(shape, scale):
        return scale * jax.random.normal(next(kit), shape, F32)

    L = DEPTH
    x = normal((BATCH, SEQ, D_MODEL), 1.0)
    c = normal((BATCH, D_MODEL), 1.0)
    ctx = normal((BATCH, CTX_LEN, D_MODEL), 1.0)
    c_ctx = normal((D_MODEL,), 1.0)
    w_ada = normal((L, D_MODEL, 6 * D_MODEL), 0.5 * D_MODEL ** -0.5)
    b_ada = normal((L, 6 * D_MODEL), 0.01)
    w_in = normal((L, D_MODEL, PROJ_COLS), D_MODEL ** -0.5)
    n_idx = jnp.arange(S5_STATE, dtype=F32)
    s5_lam_re = -0.5 + normal((L, 2, S5_GROUPS, S5_STATE), 0.01)
    s5_lam_im = jnp.pi * n_idx + normal((L, 2, S5_GROUPS, S5_STATE), 0.01)
    s5_log_step = jax.random.uniform(next(kit), (L, 2, S5_GROUPS), F32, math.log(1e-3), math.log(1e-1))
    s5_b_re = normal((L, S5_GROUPS, S5_STATE, S5_GROUP), (2 * S5_GROUP) ** -0.5)
    s5_b_im = normal((L, S5_GROUPS, S5_STATE, S5_GROUP), (2 * S5_GROUP) ** -0.5)
    s5_c_re = normal((L, 2, S5_GROUPS, S5_GROUP, S5_STATE), 0.5)
    s5_c_im = normal((L, 2, S5_GROUPS, S5_GROUP, S5_STATE), 0.5)
    s5_d = normal((L, S5_WIDTH), 1.0)
    s5_w_glu = normal((L, S5_WIDTH, 2 * S5_WIDTH), S5_WIDTH ** -0.5)
    s5_w_proj = normal((L, S5_WIDTH, D_MODEL), DEEPNORM_BETA * S5_WIDTH ** -0.5)
    ssd_conv_w = normal((L, SSD_CONV, SSD_CONV_CH), SSD_CONV ** -0.5)
    ssd_conv_b = normal((L, SSD_CONV_CH), 0.01)
    dt0 = jnp.exp(jax.random.uniform(next(kit), (L, 2, SSD_HEADS), F32, math.log(1e-3), math.log(1e-1)))
    ssd_dt_bias = dt0 + jnp.log(-jnp.expm1(-dt0))
    ssd_a_log = jnp.log(jax.random.uniform(next(kit), (L, 2, SSD_HEADS), F32, 1.0, 16.0))
    ssd_d = 1.0 + normal((L, SSD_HEADS), 0.1)
    ssd_norm_w = 1.0 + normal((L, SSD_WIDTH), 0.01)
    ssd_w_proj = normal((L, SSD_WIDTH, D_MODEL), DEEPNORM_BETA * SSD_WIDTH ** -0.5)
    w_out = normal((L, D_MODEL, D_MODEL), DEEPNORM_BETA * D_MODEL ** -0.5)
    ln1_g = 1.0 + normal((L, D_MODEL), 0.01)
    ln1_b = normal((L, D_MODEL), 0.01)
    w_up = normal((L, D_MODEL, 2 * D_FF), D_MODEL ** -0.5)
    ffn_conv_w = normal((L, FFN_CONV, FFN_CONV, D_FF), 1.0 / FFN_CONV)
    ffn_conv_b = normal((L, D_FF), 0.01)
    w_down = normal((L, D_FF, D_MODEL), DEEPNORM_BETA * D_FF ** -0.5)
    ln2_g = 1.0 + normal((L, D_MODEL), 0.01)
    ln2_b = normal((L, D_MODEL), 0.01)
    return {'x': x, 'c': c, 'ctx': ctx, 'c_ctx': c_ctx, 'w_ada': w_ada, 'b_ada': b_ada, 'w_in': w_in,
            's5_lam_re': s5_lam_re, 's5_lam_im': s5_lam_im, 's5_log_step': s5_log_step,
            's5_b_re': s5_b_re, 's5_b_im': s5_b_im, 's5_c_re': s5_c_re, 's5_c_im': s5_c_im,
            's5_d': s5_d, 's5_w_glu': s5_w_glu, 's5_w_proj': s5_w_proj,
            'ssd_conv_w': ssd_conv_w, 'ssd_conv_b': ssd_conv_b, 'ssd_dt_bias': ssd_dt_bias,
            'ssd_a_log': ssd_a_log, 'ssd_d': ssd_d, 'ssd_norm_w': ssd_norm_w, 'ssd_w_proj': ssd_w_proj,
            'w_out': w_out, 'ln1_g': ln1_g, 'ln1_b': ln1_b, 'w_up': w_up, 'ffn_conv_w': ffn_conv_w,
            'ffn_conv_b': ffn_conv_b, 'w_down': w_down, 'ln2_g': ln2_g, 'ln2_b': ln2_b}


def reference(x, c, ctx, c_ctx, w_ada, b_ada, w_in, s5_lam_re, s5_lam_im, s5_log_step, s5_b_re, s5_b_im,
              s5_c_re, s5_c_im, s5_d, s5_w_glu, s5_w_proj, ssd_conv_w, ssd_conv_b, ssd_dt_bias, ssd_a_log,
              ssd_d, ssd_norm_w, ssd_w_proj, w_out, ln1_g, ln1_b, w_up, ffn_conv_w, ffn_conv_b, w_down,
              ln2_g, ln2_b):
    h_lat, h_ctx = x, ctx
    for i in range(DEPTH):
        last = i == DEPTH - 1
        n_mod_ctx = (2 if last else 6) * D_MODEL
        m_lat = adaln(c, w_ada[i], b_ada[i])[:, None, :]
        sh1, sc1, g1, sh2, sc2, g2 = jnp.split(m_lat, 6, axis=-1)
        m_ctx = adaln(c_ctx, w_ada[i][:, :n_mod_ctx], b_ada[i][:n_mod_ctx])

        p_lat = modulate(h_lat, sh1, sc1) @ w_in[i]
        w_in_ctx = w_in[i][:, :COL_Z] if last else w_in[i]
        p_ctx = modulate(h_ctx, m_ctx[:D_MODEL], m_ctx[D_MODEL:2 * D_MODEL]) @ w_in_ctx
        y5_l, y5_c = s5_branch(p_lat[..., :S5_WIDTH], p_ctx[..., :S5_WIDTH], s5_lam_re[i], s5_lam_im[i],
                               s5_log_step[i], s5_b_re[i], s5_b_im[i], s5_c_re[i], s5_c_im[i], s5_d[i],
                               s5_w_glu[i], not last)
        z_ctx = None if last else p_ctx[..., COL_Z:COL_GATES]
        yd_l, yd_c = ssd_branch(p_lat[..., COL_XBC:COL_DT], p_lat[..., COL_DT:COL_Z], p_lat[..., COL_Z:COL_GATES],
                                p_ctx[..., COL_XBC:COL_DT], p_ctx[..., COL_DT:COL_Z], z_ctx,
                                ssd_conv_w[i], ssd_conv_b[i], ssd_dt_bias[i], ssd_a_log[i], ssd_d[i],
                                ssd_norm_w[i])
        out_l = merge_branches(y5_l, yd_l, p_lat[..., COL_GATES:], s5_w_proj[i], ssd_w_proj[i], w_out[i])
        h_lat = layer_norm(DEEPNORM_ALPHA * h_lat + g1 * out_l, ln1_g[i], ln1_b[i])

        f_l = conv_ffn(modulate(h_lat, sh2, sc2), w_up[i], ffn_conv_w[i], ffn_conv_b[i], w_down[i], True)
        h_lat = layer_norm(DEEPNORM_ALPHA * h_lat + g2 * f_l, ln2_g[i], ln2_b[i])

        if not last:
            c_g1, c_sh2, c_sc2, c_g2 = (m_ctx[2 * D_MODEL:3 * D_MODEL], m_ctx[3 * D_MODEL:4 * D_MODEL],
                                        m_ctx[4 * D_MODEL:5 * D_MODEL], m_ctx[5 * D_MODEL:])
            out_c = merge_branches(y5_c, yd_c, p_ctx[..., COL_GATES:], s5_w_proj[i], ssd_w_proj[i], w_out[i])
            h_ctx = layer_norm(DEEPNORM_ALPHA * h_ctx + c_g1 * out_c, ln1_g[i], ln1_b[i])
            f_c = conv_ffn(modulate(h_ctx, c_sh2, c_sc2), w_up[i], ffn_conv_w[i], ffn_conv_b[i], w_down[i], False)
            h_ctx = layer_norm(DEEPNORM_ALPHA * h_ctx + c_g2 * f_c, ln2_g[i], ln2_b[i])
    return h_lat
```

```cpp
#include <hip/hip_runtime.h>
#include <hip/hip_cooperative_groups.h>
#include <cstdio>
namespace cg = cooperative_groups;
#define MK_N_LAUNCH_MODE 0
namespace pg8 {
#define PG8_LAS __attribute__((address_space(3)))
typedef unsigned short bf16_t;
typedef short bf16x8 __attribute__((ext_vector_type(8)));
typedef float f32x4 __attribute__((ext_vector_type(4)));
typedef unsigned u32x4 __attribute__((ext_vector_type(4)));
constexpr int BM = 256, BK = 64, HALF = 128, HTB = HALF * BK * 2  , STAGE_BYTES = 8 * HTB, NXCD = 8, WGM = 8;

__host__ __device__ __forceinline__ int lds_byte(int r, int c) { const int st = (r >> 4) * 2 + (c >> 5), rr = r & 15, cc = c & 31, ob = rr * 64 + cc * 2; return st * 1024 + (ob ^ (((ob >> 9) & 1) << 5)); }
__host__ __device__ __forceinline__ void stage_rc(int b, int& R, int& C) { const int st = b / 1024, sb = b % 1024, swz = sb ^ (((sb >> 9) & 1) << 5); R = (st >> 1) * 16 + swz / 64; C = (st & 1) * 32 + (swz % 64) / 2; }
__host__ __device__ __forceinline__ int perm32(int rho) { const int n = rho >> 4, i = rho & 15; return 8 * (i >> 2) + 4 * n + (i & 3); }

__device__ __forceinline__ int pg8_tid() { int t = threadIdx.x; asm volatile("" : "+v"(t)); return t; }
struct Unit { int pm, pn; };
struct Gemm { const bf16_t* A; const bf16_t* Bt; int M, N, K; };

struct StaticOrder {
    int nM, nN, nwg, G, c;
    __host__ __device__ void init(int M, int N, int G_, int c_) { nM = M / BM; nN = N / BM; nwg = nM * nN; G = G_; c = c_; }
    __host__ __device__ bool next(int i, Unit& u) const {
        const long L = (long)i * G + c; if (L >= nwg) return false;
        int wgid = (int)L; { const int q = nwg / NXCD, r = nwg % NXCD, xcd = wgid % NXCD, off = wgid / NXCD; wgid = (xcd < r ? xcd * (q + 1) : r * (q + 1) + (xcd - r) * q) + off; }
        const int nig = WGM * nN, gid = wgid / nig, fm = gid * WGM, gsz = (nM - fm) < WGM ? (nM - fm) : WGM;
        u.pm = fm + ((wgid % nig) % gsz); u.pn = (wgid % nig) / gsz; return true;
    }
    __device__ __forceinline__ void a_ready(const Unit&) const {}
    __device__ __forceinline__ void done(const Unit&) const {}
};
__device__ __forceinline__ unsigned cvt_pk_bf16(float lo, float hi) { unsigned r; asm volatile("v_cvt_pk_bf16_f32 %0, %1, %2" : "=v"(r) : "v"(lo), "v"(hi)); return r; }
__device__ __forceinline__ void mfma_settle(const float __attribute__((ext_vector_type(4)))& a) { asm volatile("s_nop 15\n\ts_nop 7" :: "v"(a)); }
typedef float f32x2 __attribute__((ext_vector_type(2)));
template <class Epi, class Sched, bool STAMP = false>
__device__ __forceinline__ void gemm_phase(PG8_LAS unsigned char* lds, const Gemm g, const Sched& S, const Epi& E, unsigned long long* stamps) {
    const int tid = pg8_tid(), wid = __builtin_amdgcn_readfirstlane(tid >> 6), lane = tid & 63, wr = wid >> 2, wc = wid & 3, fr = lane & 15, fq = lane >> 4;
    const int K = g.K, nt = K / BK;
    int ts_lo = 0, ts_hi = 0, nts = 0; const unsigned long long rt_entry = STAMP ? (unsigned long long)wall_clock64() : 0ull;
#define PG8_STAMP() do { if (STAMP && wid == 0 && nts < 64) { const unsigned long long _c = (unsigned long long)clock64(); \
        ts_lo = (lane == nts) ? (int)(unsigned)_c : ts_lo; ts_hi = (lane == nts) ? (int)(unsigned)(_c >> 32) : ts_hi; ++nts; } } while (0)
    PG8_STAMP();
    unsigned voffA[2], voffB[2];
#pragma unroll
    for (int i = 0; i < 2; ++i) { int R, C; stage_rc(tid * 16 + i * 8192, R, C); const int Rb = Epi::PERM ? ((R & ~31) + perm32(R & 31)) : R;
        voffA[i] = (unsigned)(R * K + C) * 2u; voffB[i] = (unsigned)(Rb * K + C) * 2u; }
    const size_t kstep = (size_t)(BK * 2);
    const size_t hstep = (size_t)HALF * K * 2;
    const size_t tstep = 2 * hstep;
    const unsigned ldsw = (unsigned)wid * 1024u;
    const int aoff = lds_byte(wr * 64 + fr, fq * 8), boff = lds_byte(wc * 32 + fr, fq * 8);
#define PG8_SA(b, h) (((b) * 2 + (h)) * HTB)
#define PG8_SB(b, h) ((4 + (b) * 2 + (h)) * HTB)
#define PG8_STAGE(bufoff, gbase, voff) do { _Pragma("unroll") for (int _i = 0; _i < 2; ++_i) \
        __builtin_amdgcn_global_load_lds((const unsigned*)((const char*)(gbase) + (voff)[_i]), (PG8_LAS unsigned*)(lds + (bufoff) + ldsw + _i * 8192), 16, 0, 0); } while (0)
#define PG8_LDA(dst, b, h) do { _Pragma("unroll") for (int m = 0; m < 4; ++m) _Pragma("unroll") for (int k = 0; k < 2; ++k) dst[m][k] = *(const PG8_LAS bf16x8*)(lds + PG8_SA(b, h) + aoff + m * 2048 + k * 1024); } while (0)
#define PG8_LDB(dst, b, h) do { _Pragma("unroll") for (int n = 0; n < 2; ++n) _Pragma("unroll") for (int k = 0; k < 2; ++k) dst[n][k] = *(const PG8_LAS bf16x8*)(lds + PG8_SB(b, h) + boff + n * 2048 + k * 1024); } while (0)
#define PG8_MMA(ai, bj, At, Bt) do { __builtin_amdgcn_s_setprio(1); _Pragma("unroll") for (int m = 0; m < 4; ++m) _Pragma("unroll") for (int n = 0; n < 2; ++n) _Pragma("unroll") for (int k = 0; k < 2; ++k) \
        acc[ai][bj][m][n] = __builtin_amdgcn_mfma_f32_16x16x32_bf16(Bt[n][k], At[m][k], acc[ai][bj][m][n], 0, 0, 0); __builtin_amdgcn_s_setprio(0); } while (0)
#define PG8_WAIT_V(n) asm volatile("s_waitcnt vmcnt(" #n ")" ::: "memory")
#define PG8_WAIT_L(n) asm volatile("s_waitcnt lgkmcnt(" #n ")" ::: "memory")
#define PG8_BAR __builtin_amdgcn_s_barrier()
#define PG8_SCHED __builtin_amdgcn_sched_barrier(0)
    Unit cur, nxt; int ui = 0;
    if (!S.next(0, cur)) return;
    f32x4 acc[2][2][4][2];
#pragma unroll
    for (int a = 0; a < 2; ++a)
#pragma unroll
        for (int b = 0; b < 2; ++b)
#pragma unroll
            for (int m = 0; m < 4; ++m)
#pragma unroll
                for (int n = 0; n < 2; ++n) acc[a][b][m][n] = (f32x4){0.f, 0.f, 0.f, 0.f};
    bf16x8 At[4][2], B0[2][2], B1[2][2];
    const char* cA = (const char*)g.A + (size_t)cur.pm * tstep; const char* cB = (const char*)g.Bt + (size_t)cur.pn * tstep;
    S.a_ready(cur);
    PG8_STAGE(PG8_SB(0, 0), cB, voffB); PG8_STAGE(PG8_SA(0, 0), cA, voffA); PG8_STAGE(PG8_SB(0, 1), cB + hstep, voffB); PG8_STAGE(PG8_SA(0, 1), cA + hstep, voffA);
    if (wr == 1) PG8_BAR;
    PG8_WAIT_V(4); PG8_BAR;
    PG8_STAGE(PG8_SB(1, 0), cB + kstep, voffB); PG8_STAGE(PG8_SA(1, 0), cA + kstep, voffA); PG8_STAGE(PG8_SB(1, 1), cB + hstep + kstep, voffB);
    PG8_WAIT_V(6); PG8_BAR;
    PG8_STAMP();
    for (;;) {
        const bool has_next = S.next(ui + 1, nxt);
        const char* nA = has_next ? (const char*)g.A + (size_t)nxt.pm * tstep : cA; const char* nB = has_next ? (const char*)g.Bt + (size_t)nxt.pn * tstep : cB;
        for (int t = 0; t < nt; t += 2) {
            const bool last = (t == nt - 2);
            const char* a1 = cA + (size_t)(t + 1) * kstep;
            const char* a2 = last ? nA : cA + (size_t)(t + 2) * kstep; const char* b2 = last ? nB : cB + (size_t)(t + 2) * kstep;
            const char* a3 = a2 + kstep; const char* b3 = b2 + kstep;
            if (last && has_next) S.a_ready(nxt);
            PG8_LDB(B0, 0, 0); PG8_SCHED; PG8_LDA(At, 0, 0); PG8_STAGE(PG8_SA(1, 1), a1 + hstep, voffA);
            PG8_WAIT_L(8); PG8_BAR; PG8_WAIT_L(0); PG8_MMA(0, 0, At, B0); PG8_BAR; PG8_SCHED;
            PG8_LDB(B1, 0, 1); PG8_STAGE(PG8_SB(0, 0), b2, voffB);
            PG8_BAR; PG8_WAIT_L(0); PG8_MMA(0, 1, At, B1); PG8_BAR;
            PG8_LDA(At, 0, 1); PG8_STAGE(PG8_SA(0, 0), a2, voffA);
            PG8_BAR; PG8_WAIT_L(0); PG8_MMA(1, 0, At, B0); PG8_BAR; PG8_SCHED;
            PG8_STAGE(PG8_SB(0, 1), b2 + hstep, voffB);
            PG8_WAIT_V(6); PG8_BAR; PG8_MMA(1, 1, At, B1); PG8_BAR;
            PG8_LDB(B0, 1, 0); PG8_SCHED; PG8_LDA(At, 1, 0); PG8_STAGE(PG8_SA(0, 1), a2 + hstep, voffA);
            PG8_WAIT_L(8); PG8_BAR; PG8_WAIT_L(0); PG8_MMA(0, 0, At, B0); PG8_BAR; PG8_SCHED;
            PG8_LDB(B1, 1, 1); PG8_STAGE(PG8_SB(1, 0), b3, voffB);
            PG8_BAR; PG8_WAIT_L(0); PG8_MMA(0, 1, At, B1); PG8_BAR;
            PG8_LDA(At, 1, 1); PG8_STAGE(PG8_SA(1, 0), a3, voffA);
            PG8_BAR; PG8_WAIT_L(0); PG8_MMA(1, 0, At, B0); PG8_BAR; PG8_SCHED;
            PG8_STAGE(PG8_SB(1, 1), b3 + hstep, voffB);
            PG8_WAIT_V(6); PG8_BAR; PG8_MMA(1, 1, At, B1); PG8_BAR;
        }
        PG8_STAMP();
        if constexpr (!Epi::AFTER_DRAIN) { E(acc, cur, wr, wc, fr, fq); S.done(cur); }
        PG8_STAMP();
        if (!has_next) break;
#pragma unroll
        for (int a = 0; a < 2; ++a)
#pragma unroll
            for (int b = 0; b < 2; ++b)
#pragma unroll
                for (int m = 0; m < 4; ++m)
#pragma unroll
                    for (int n = 0; n < 2; ++n) acc[a][b][m][n] = (f32x4){0.f, 0.f, 0.f, 0.f};
        cur = nxt; cA = nA; cB = nB; ++ui;
    }
    PG8_WAIT_V(0);
    if (wr == 0) PG8_BAR;
    PG8_BAR;
    if constexpr (Epi::AFTER_DRAIN) { E.fused(acc, cur, wr, wc, fr, fq, lds, wid, lane); S.done(cur); }
    PG8_STAMP();
    if (STAMP && wid == 0) { stamps[lane] = lane < nts ? (((unsigned long long)(unsigned)ts_hi << 32) | (unsigned)ts_lo) : 0ull;
        if (lane == 62) stamps[62] = rt_entry; if (lane == 63) stamps[63] = (unsigned long long)wall_clock64(); }
#undef PG8_STAMP
#undef PG8_SA
#undef PG8_SB
#undef PG8_STAGE
#undef PG8_LDA
#undef PG8_LDB
#undef PG8_MMA
#undef PG8_WAIT_V
#undef PG8_WAIT_L
#undef PG8_BAR
#undef PG8_SCHED
}
}

namespace mk {
using pg8::bf16_t; using pg8::bf16x8; using pg8::f32x4; using pg8::u32x4; using pg8::Unit; using pg8::cvt_pk_bf16; using pg8::mfma_settle;
typedef unsigned u32x2 __attribute__((ext_vector_type(2)));
constexpr int D = 2048, TL = 16384, TC = 256, MT = TL + TC, NCH = MT / 128;
constexpr int NPROJ = 10496, DFF = 5632;
constexpr size_t MiB = 1u << 20;
constexpr size_t WS_MVEC = 0, WS_CHD = 256 * 1024, WS_S5LOC = 1 * MiB, WS_WA = 10 * MiB, WS_WB = 75 * MiB, WS_HCTX = 141 * MiB, WS_XM = 143 * MiB, WS_SST = 208 * MiB, WS_BIG = 338 * MiB, WS_END = 766 * MiB;
constexpr size_t B_U5 = 0, B_XBC = B_U5 + (size_t)MT * 1024 * 2, B_Z = B_XBC + (size_t)MT * 3072 * 2, B_GATE = B_Z + (size_t)MT * 2048 * 2, B_DT = B_GATE + (size_t)MT * 4096 * 2,
                 B_Y5 = 330 * MiB, B_YD = B_Y5 + (size_t)MT * 1024 * 2;
static_assert(B_DT + (size_t)MT * 64 * 4 <= B_Y5 && B_YD + (size_t)MT * 2048 * 2 <= 428 * MiB, "big map");
constexpr size_t B_G = 0, B_V = (size_t)MT * DFF * 2;
constexpr size_t WA_IN = 0, WA_GLU = 41 * MiB, WA_S5P = 45 * MiB, WA_SSDP = 49 * MiB, WA_WOUT = 57 * MiB, WB_UP = 0, WB_DOWN = 44 * MiB;
constexpr int LDS_BYTES = 163840;
constexpr float ALPHA = 1.41421356237f, LN_EPS = 1e-5f, RMS_EPS = 1e-5f;

struct Args { const float* in[33]; float* out; unsigned char* ws; int ph_lo, ph_hi; };

__device__ __forceinline__ float bf2f(unsigned b) { return __uint_as_float(b << 16); }
__device__ __forceinline__ float bflo(unsigned w) { return __uint_as_float(w << 16); }
__device__ __forceinline__ float bfhi(unsigned w) { return __uint_as_float(w & 0xffff0000u); }
__device__ __forceinline__ float sigm(float x) { return 1.f / (1.f + __expf(-x)); }
__device__ __forceinline__ float silu_(float x) { return x / (1.f + __expf(-x)); }
__device__ __forceinline__ float gelu_tanh(float x) { const float u = 0.7978845608028654f * (x + 0.044715f * x * x * x); const float th = 1.f - 2.f / (__expf(2.f * u) + 1.f); return 0.5f * x * (1.f + th); }
__device__ __forceinline__ bf16x8 mkfrag(unsigned a, unsigned b, unsigned c, unsigned d) { u32x4 v; v.x = a; v.y = b; v.z = c; v.w = d; return __builtin_bit_cast(bf16x8, v); }
__device__ __forceinline__ float* hrow(const Args& a, int row) { return row < TL ? a.out + (size_t)row * D : (float*)(a.ws + WS_HCTX) + (size_t)(row - TL) * D; }
__device__ __forceinline__ const float* mvec(const Args& a, int layer, int isctx) { return (const float*)(a.ws + WS_MVEC) + (size_t)(layer * 2 + isctx) * 12288; }

struct EpiInProj {
    static constexpr bool PERM = true, AFTER_DRAIN = false;
    unsigned char* big; const float* dt_bias;
    __device__ __forceinline__ void operator()(const f32x4 (&acc)[2][2][4][2], const Unit& u, int wr, int wc, int fr, int fq) const {
        mfma_settle(acc[1][1][3][1]); mfma_settle(acc[1][1][3][0]);
        const int row0 = u.pm * 256 + wr * 64 + fr, ct = u.pn * 256;
        if (ct >= 10240) {
            if (wc < 2) { const int cc = wc * 32 + 8 * fq; float* DT = (float*)(big + B_DT);
                const f32x4 b0 = *(const f32x4*)(dt_bias + cc), b1 = *(const f32x4*)(dt_bias + cc + 4);
#pragma unroll
                for (int ai = 0; ai < 2; ++ai)
#pragma unroll
                    for (int m = 0; m < 4; ++m) { float* rp = DT + (size_t)(row0 + ai * 128 + m * 16) * 64 + cc; f32x4 v0 = acc[ai][0][m][0] + b0, v1 = acc[ai][0][m][1] + b1;
#pragma unroll
                        for (int j = 0; j < 4; ++j) { v0[j] = v0[j] > 20.f ? v0[j] : log1pf(expf(v0[j])); v1[j] = v1[j] > 20.f ? v1[j] : log1pf(expf(v1[j])); }
                        *(f32x4*)rp = v0; *(f32x4*)(rp + 4) = v1; } }
            return;
        }
        bf16_t* base; int ld, c0; bool sg = false;
        if (ct < 1024) { base = (bf16_t*)(big + B_U5); ld = 1024; c0 = ct; }
        else if (ct < 4096) { base = (bf16_t*)(big + B_XBC); ld = 3072; c0 = ct - 1024; }
        else if (ct < 6144) { base = (bf16_t*)(big + B_Z); ld = 2048; c0 = ct - 4096; }
        else { base = (bf16_t*)(big + B_GATE); ld = 4096; c0 = ct - 6144; sg = true; }
        const int col0 = c0 + wc * 32 + 8 * fq;
#pragma unroll
        for (int ai = 0; ai < 2; ++ai)
#pragma unroll
            for (int m = 0; m < 4; ++m) { bf16_t* rowp = base + (size_t)(row0 + ai * 128 + m * 16) * ld + col0;
#pragma unroll
                for (int bj = 0; bj < 2; ++bj) { f32x4 v0 = acc[ai][bj][m][0], v1 = acc[ai][bj][m][1];
                    if (sg) {
#pragma unroll
                        for (int j = 0; j < 4; ++j) { v0[j] = sigm(v0[j]); v1[j] = sigm(v1[j]); } }
                    u32x4 w; w.x = cvt_pk_bf16(v0[0], v0[1]); w.y = cvt_pk_bf16(v0[2], v0[3]); w.z = cvt_pk_bf16(v1[0], v1[1]); w.w = cvt_pk_bf16(v1[2], v1[3]);
                    *(u32x4*)(rowp + bj * 128) = w; } }
    }
};
struct EpiGlu {
    static constexpr bool PERM = true, AFTER_DRAIN = false;
    bf16_t* O;
    __device__ __forceinline__ void operator()(const f32x4 (&acc)[2][2][4][2], const Unit& u, int wr, int wc, int fr, int fq) const {
        mfma_settle(acc[1][1][3][1]); mfma_settle(acc[1][1][3][0]);
        const int row0 = u.pm * 256 + wr * 64 + fr, col0 = u.pn * 128 + wc * 32 + 8 * fq;
#pragma unroll
        for (int ai = 0; ai < 2; ++ai)
#pragma unroll
            for (int m = 0; m < 4; ++m) { f32x4 v0 = acc[ai][0][m][0], v1 = acc[ai][0][m][1]; const f32x4 g0 = acc[ai][1][m][0], g1 = acc[ai][1][m][1];
#pragma unroll
                for (int j = 0; j < 4; ++j) { v0[j] *= sigm(g0[j]); v1[j] *= sigm(g1[j]); }
                u32x4 w; w.x = cvt_pk_bf16(v0[0], v0[1]); w.y = cvt_pk_bf16(v0[2], v0[3]); w.z = cvt_pk_bf16(v1[0], v1[1]); w.w = cvt_pk_bf16(v1[2], v1[3]);
                *(u32x4*)(O + (size_t)(row0 + ai * 128 + m * 16) * 1024 + col0) = w; }
    }
};
template <int SECOND, int GSEL = SECOND> struct EpiMerge {
    static constexpr bool PERM = true, AFTER_DRAIN = false;
    bf16_t* MG; const bf16_t* GATE;
    __device__ __forceinline__ void operator()(const f32x4 (&acc)[2][2][4][2], const Unit& u, int wr, int wc, int fr, int fq) const {
        mfma_settle(acc[1][1][3][1]); mfma_settle(acc[1][1][3][0]);
        const int row0 = u.pm * 256 + wr * 64 + fr, col0 = u.pn * 256 + wc * 32 + 8 * fq;
#pragma unroll
        for (int ai = 0; ai < 2; ++ai)
#pragma unroll
            for (int m = 0; m < 4; ++m) { const size_t r = (size_t)(row0 + ai * 128 + m * 16);
#pragma unroll
                for (int bj = 0; bj < 2; ++bj) { const int c = col0 + bj * 128; const u32x4 g = *(const u32x4*)(GATE + r * 4096 + (GSEL ? 2048 : 0) + c);
                    f32x4 v0 = acc[ai][bj][m][0], v1 = acc[ai][bj][m][1];
                    v0[0] *= bflo(g.x); v0[1] *= bfhi(g.x); v0[2] *= bflo(g.y); v0[3] *= bfhi(g.y); v1[0] *= bflo(g.z); v1[1] *= bfhi(g.z); v1[2] *= bflo(g.w); v1[3] *= bfhi(g.w);
                    if (SECOND) { const u32x4 o = *(const u32x4*)(MG + r * 2048 + c);
                        v0[0] += bflo(o.x); v0[1] += bfhi(o.x); v0[2] += bflo(o.y); v0[3] += bfhi(o.y); v1[0] += bflo(o.z); v1[1] += bfhi(o.z); v1[2] += bflo(o.w); v1[3] += bfhi(o.w); }
                    u32x4 w; w.x = cvt_pk_bf16(v0[0], v0[1]); w.y = cvt_pk_bf16(v0[2], v0[3]); w.z = cvt_pk_bf16(v1[0], v1[1]); w.w = cvt_pk_bf16(v1[2], v1[3]);
                    *(u32x4*)(MG + r * 2048 + c) = w; } }
    }
};
struct EpiResid {
    static constexpr bool PERM = false, AFTER_DRAIN = false;
    float* out; float* hctx; const float* glat; const float* gctx;
    __device__ __forceinline__ void operator()(const f32x4 (&acc)[2][2][4][2], const Unit& u, int wr, int wc, int fr, int fq) const {
        mfma_settle(acc[1][1][3][1]); mfma_settle(acc[1][1][3][0]);
        const bool isctx = u.pm >= 64; const float* g = isctx ? gctx : glat;
        float* hb = isctx ? hctx + (size_t)(wr * 64 + fr) * D : out + (size_t)(u.pm * 256 + wr * 64 + fr) * D;
        const int col0 = u.pn * 256 + wc * 32 + 4 * fq;
        f32x4 gv[2][2];
#pragma unroll
        for (int bj = 0; bj < 2; ++bj)
#pragma unroll
            for (int n = 0; n < 2; ++n) gv[bj][n] = *(const f32x4*)(g + col0 + bj * 128 + n * 16);
#pragma unroll
        for (int ai = 0; ai < 2; ++ai)
#pragma unroll
            for (int m = 0; m < 4; ++m) { float* rowp = hb + (size_t)(ai * 128 + m * 16) * D + col0;
#pragma unroll
                for (int bj = 0; bj < 2; ++bj)
#pragma unroll
                    for (int n = 0; n < 2; ++n) { float* p = rowp + bj * 128 + n * 16; const f32x4 h = *(const f32x4*)p; *(f32x4*)p = h * ALPHA + gv[bj][n] * acc[ai][bj][m][n]; } }
    }
};
struct EpiUp {
    static constexpr bool PERM = true, AFTER_DRAIN = false;
    bf16_t* G; bf16_t* V;
    __device__ __forceinline__ void operator()(const f32x4 (&acc)[2][2][4][2], const Unit& u, int wr, int wc, int fr, int fq) const {
        mfma_settle(acc[1][1][3][1]); mfma_settle(acc[1][1][3][0]);
        const int row0 = u.pm * 256 + wr * 64 + fr; int ct = u.pn * 256; bf16_t* base = G; if (ct >= DFF) { base = V; ct -= DFF; }
        const int col0 = ct + wc * 32 + 8 * fq;
#pragma unroll
        for (int ai = 0; ai < 2; ++ai)
#pragma unroll
            for (int m = 0; m < 4; ++m) { bf16_t* rowp = base + (size_t)(row0 + ai * 128 + m * 16) * DFF + col0;
#pragma unroll
                for (int bj = 0; bj < 2; ++bj) { const f32x4 v0 = acc[ai][bj][m][0], v1 = acc[ai][bj][m][1];
                    u32x4 w; w.x = cvt_pk_bf16(v0[0], v0[1]); w.y = cvt_pk_bf16(v0[2], v0[3]); w.z = cvt_pk_bf16(v1[0], v1[1]); w.w = cvt_pk_bf16(v1[2], v1[3]);
                    *(u32x4*)(rowp + bj * 128) = w; } }
    }
};

__device__ __forceinline__ void xpose_item(const float* W, int K, int N, bf16_t* WT, int d0, int s0, int k0, float* scr, int lane) {
#pragma unroll 8
    for (int i = 0; i < 32; ++i) { const int kk = 2 * i + (lane >> 5); scr[kk * 33 + (lane & 31)] = s0 >= 0 ? W[(size_t)(k0 + kk) * N + s0 + (lane & 31)] : 0.f; }
    asm volatile("s_waitcnt lgkmcnt(0)" ::: "memory");
    const int c = lane & 7;
#pragma unroll
    for (int j = 0; j < 4; ++j) { const int n = (lane >> 3) + 8 * j; const float* s = scr + (8 * c) * 33 + n;
        u32x4 o; o.x = cvt_pk_bf16(s[0 * 33], s[1 * 33]); o.y = cvt_pk_bf16(s[2 * 33], s[3 * 33]); o.z = cvt_pk_bf16(s[4 * 33], s[5 * 33]); o.w = cvt_pk_bf16(s[6 * 33], s[7 * 33]);
        *(u32x4*)(WT + (size_t)(d0 + n) * K + k0 + 8 * c) = o; }
    asm volatile("s_waitcnt lgkmcnt(0)" ::: "memory");
}
__device__ __forceinline__ void xpose_region(const Args& a, int layer, int region, float* scr, int gw, int NGW, int lane) {
    if (region == 0) {
        const float* w_in = a.in[6] + (size_t)layer * 2048 * 10304; const float* w_glu = a.in[15] + (size_t)layer * 1024 * 2048; const float* w_s5p = a.in[16] + (size_t)layer * 1024 * 2048;
        const float* w_ssdp = a.in[23] + (size_t)layer * 2048 * 2048; const float* w_out = a.in[24] + (size_t)layer * 2048 * 2048;
        bf16_t* WA = (bf16_t*)(a.ws + WS_WA);
        constexpr int I_IN = 32 * 328, I_GLU = 16 * 64, I_S5P = 16 * 64, I_SSDP = 32 * 64, I_WOUT = 32 * 64, NI = I_IN + I_GLU + I_S5P + I_SSDP + I_WOUT;
        for (int it = gw; it < NI; it += NGW) { int r = it;
            if (r < I_IN) { const int kb = r / 328, d0 = (r % 328) * 32; int s0; if (d0 < 4096) s0 = d0; else if (d0 < 10240) s0 = d0 + 64; else if (d0 < 10304) s0 = d0 - 10240 + 4096; else s0 = -1;
                xpose_item(w_in, 2048, 10304, WA + WA_IN / 2, d0, s0, kb * 64, scr, lane); continue; } r -= I_IN;
            if (r < I_GLU) { const int kb = r / 64, d0 = (r % 64) * 32, t = d0 >> 8, j = d0 & 255; const int s0 = j < 128 ? t * 128 + j : 1024 + t * 128 + (j - 128);
                xpose_item(w_glu, 1024, 2048, WA + WA_GLU / 2, d0, s0, kb * 64, scr, lane); continue; } r -= I_GLU;
            if (r < I_S5P) { const int kb = r / 64, d0 = (r % 64) * 32; xpose_item(w_s5p, 1024, 2048, WA + WA_S5P / 2, d0, d0, kb * 64, scr, lane); continue; } r -= I_S5P;
            if (r < I_SSDP) { const int kb = r / 64, d0 = (r % 64) * 32; xpose_item(w_ssdp, 2048, 2048, WA + WA_SSDP / 2, d0, d0, kb * 64, scr, lane); continue; } r -= I_SSDP;
            { const int kb = r / 64, d0 = (r % 64) * 32; xpose_item(w_out, 2048, 2048, WA + WA_WOUT / 2, d0, d0, kb * 64, scr, lane); }
        }
    } else {
        const float* w_up = a.in[27] + (size_t)layer * 2048 * 11264; const float* w_down = a.in[30] + (size_t)layer * 5632 * 2048;
        bf16_t* WB = (bf16_t*)(a.ws + WS_WB);
        constexpr int I_UP = 32 * 352, I_DOWN = 88 * 64, NI = I_UP + I_DOWN;
        for (int it = gw; it < NI; it += NGW) { int r = it;
            if (r < I_UP) { const int kb = r / 352, d0 = (r % 352) * 32; xpose_item(w_up, 2048, 11264, WB + WB_UP / 2, d0, d0, kb * 64, scr, lane); continue; } r -= I_UP;
            { const int kb = r / 64, d0 = (r % 64) * 32; xpose_item(w_down, 5632, 2048, WB + WB_DOWN / 2, d0, d0, kb * 64, scr, lane); }
        }
    }
}

__device__ __forceinline__ void adaln_phase(const Args& a, float* lds, int tid) {
    float* sc = lds; float* scx = lds + 2048; float* red = lds + 4096;
    for (int i = tid; i < 2048; i += 512) { sc[i] = silu_(a.in[1][i]); scx[i] = silu_(a.in[3][i]); }
    __syncthreads();
    for (int unit = blockIdx.x; unit < 256; unit += gridDim.x) {
        const int layer = unit >> 7, col0 = (unit & 127) * 96;
        const float* W = a.in[4] + (size_t)layer * 2048 * 12288 + col0;
        if (tid < 504) { const int cq = tid % 24, ks = tid / 24; f32x4 al = {0.f, 0.f, 0.f, 0.f}, ac = {0.f, 0.f, 0.f, 0.f};
            for (int k = ks; k < 2048; k += 21) { const f32x4 w = *(const f32x4*)(W + (size_t)k * 12288 + cq * 4); al += w * sc[k]; ac += w * scx[k]; }
            *(f32x4*)(red + (ks * 2 + 0) * 96 + cq * 4) = al; *(f32x4*)(red + (ks * 2 + 1) * 96 + cq * 4) = ac; }
        __syncthreads();
        if (tid < 192) { const int v = tid / 96, c = tid % 96; float s = 0.f; for (int ks = 0; ks < 21; ++ks) s += red[(ks * 2 + v) * 96 + c];
            ((float*)(a.ws + WS_MVEC))[(size_t)(layer * 2 + v) * 12288 + col0 + c] = s + a.in[5][(size_t)layer * 12288 + col0 + c]; }
        __syncthreads();
    }
}

__device__ __forceinline__ float wave_sum(float v) {
#pragma unroll
    for (int o = 1; o < 64; o <<= 1) v += __shfl_xor(v, o);
    return v;
}
template <int MODE> __device__ __forceinline__ void row_phase(const Args& a, int nrows, const float* lng, const float* lnb, int mod_layer, int mod_off, int gw, int NGW, int lane) {
    bf16_t* XM = (bf16_t*)(a.ws + WS_XM);
    for (int row = gw; row < nrows; row += NGW) {
        const int isctx = row >= TL; float* h = hrow(a, row);
        const float* src = MODE == 0 ? (isctx ? a.in[2] + (size_t)(row - TL) * D : a.in[0] + (size_t)row * D) : h;
        f32x4 v[8];
#pragma unroll
        for (int j = 0; j < 8; ++j) v[j] = *(const f32x4*)(src + 4 * lane + 256 * j);
        if (MODE == 1) {
            float s = 0.f;
#pragma unroll
            for (int j = 0; j < 8; ++j) s += (v[j][0] + v[j][1]) + (v[j][2] + v[j][3]);
            const float mean = wave_sum(s) * (1.f / D); float q = 0.f;
#pragma unroll
            for (int j = 0; j < 8; ++j) { v[j] = v[j] - mean; q += (v[j][0] * v[j][0] + v[j][1] * v[j][1]) + (v[j][2] * v[j][2] + v[j][3] * v[j][3]); }
            const float rstd = 1.f / sqrtf(wave_sum(q) * (1.f / D) + LN_EPS);
#pragma unroll
            for (int j = 0; j < 8; ++j) { const f32x4 g = *(const f32x4*)(lng + 4 * lane + 256 * j), b = *(const f32x4*)(lnb + 4 * lane + 256 * j); v[j] = v[j] * rstd * g + b; }
        }
#ifdef MK_SANITIZE
#pragma unroll
        for (int j = 0; j < 8; ++j)
#pragma unroll
            for (int e = 0; e < 4; ++e) if (!(fabsf(v[j][e]) < 1e30f)) v[j][e] = 0.f;
#endif
#pragma unroll
        for (int j = 0; j < 8; ++j) *(f32x4*)(h + 4 * lane + 256 * j) = v[j];
        if (mod_layer >= 0) { const float* m = mvec(a, mod_layer, isctx) + mod_off;
#pragma unroll
            for (int j = 0; j < 8; ++j) { const f32x4 sh = *(const f32x4*)(m + 4 * lane + 256 * j), scl = *(const f32x4*)(m + D + 4 * lane + 256 * j); const f32x4 o = v[j] * (scl + 1.f) + sh;
                u32x2 w; w.x = cvt_pk_bf16(o[0], o[1]); w.y = cvt_pk_bf16(o[2], o[3]); *(u32x2*)(XM + (size_t)row * D + 4 * lane + 256 * j) = w; } }
    }
}

__device__ __forceinline__ void ffnconv_phase(const Args& a, int layer, bool with_ctx, int tid) {
    const bf16_t* G = (const bf16_t*)(a.ws + WS_BIG + B_G); bf16_t* V = (bf16_t*)(a.ws + WS_BIG + B_V);
    const float* cw = a.in[28] + (size_t)layer * 9 * DFF; const float* cb = a.in[29] + (size_t)layer * DFF;
    const int nunits = (with_ctx ? 260 : 256) * 11; const int oc = tid & 63, xs = tid >> 6;
    for (int unit = blockIdx.x; unit < nunits; unit += gridDim.x) {
        const int seg = unit / 11, ob = unit % 11, ch0 = ob * 512 + oc * 8; const bool cs = seg >= 256; const int t0 = seg * 64;
        float w[9][8], bias[8];
#pragma unroll
        for (int k = 0; k < 9; ++k) { const f32x4 w0 = *(const f32x4*)(cw + (size_t)k * DFF + ch0), w1 = *(const f32x4*)(cw + (size_t)k * DFF + ch0 + 4);
            w[k][0] = w0[0]; w[k][1] = w0[1]; w[k][2] = w0[2]; w[k][3] = w0[3]; w[k][4] = w1[0]; w[k][5] = w1[1]; w[k][6] = w1[2]; w[k][7] = w1[3]; }
        { const f32x4 b0 = *(const f32x4*)(cb + ch0), b1 = *(const f32x4*)(cb + ch0 + 4); bias[0] = b0[0]; bias[1] = b0[1]; bias[2] = b0[2]; bias[3] = b0[3]; bias[4] = b1[0]; bias[5] = b1[1]; bias[6] = b1[2]; bias[7] = b1[3]; }
#pragma unroll 1
        for (int xi = 0; xi < 8; ++xi) { const int x = xs * 8 + xi, t = t0 + x; float acc[8];
#pragma unroll
            for (int k = 0; k < 8; ++k) acc[k] = bias[k];
#pragma unroll
            for (int dy = -1; dy <= 1; ++dy) { bool rok = cs ? (dy == 0) : ((dy < 0 ? seg > 0 : true) && (dy > 0 ? seg < 255 : true));
#pragma unroll
                for (int dx = -1; dx <= 1; ++dx) { const bool ok = rok && (cs ? (t + dx >= TL && t + dx < MT) : (x + dx >= 0 && x + dx < 64));
                    if (ok) { const u32x4 g = *(const u32x4*)(G + (size_t)(t + dy * 64 + dx) * DFF + ch0); const int k = (dy + 1) * 3 + dx + 1;
                        acc[0] += w[k][0] * bflo(g.x); acc[1] += w[k][1] * bfhi(g.x); acc[2] += w[k][2] * bflo(g.y); acc[3] += w[k][3] * bfhi(g.y);
                        acc[4] += w[k][4] * bflo(g.z); acc[5] += w[k][5] * bfhi(g.z); acc[6] += w[k][6] * bflo(g.w); acc[7] += w[k][7] * bfhi(g.w); } } }
            bf16_t* vp = V + (size_t)t * DFF + ch0; const u32x4 vv = *(const u32x4*)vp;
            u32x4 o; o.x = cvt_pk_bf16(silu_(acc[0]) * bflo(vv.x), silu_(acc[1]) * bfhi(vv.x)); o.y = cvt_pk_bf16(silu_(acc[2]) * bflo(vv.y), silu_(acc[3]) * bfhi(vv.y));
            o.z = cvt_pk_bf16(silu_(acc[4]) * bflo(vv.z), silu_(acc[5]) * bfhi(vv.z)); o.w = cvt_pk_bf16(silu_(acc[6]) * bflo(vv.w), silu_(acc[7]) * bfhi(vv.w));
            *(u32x4*)vp = o; }
    }
}

__device__ __forceinline__ int s5_chunk_at(int dir, int q) { return dir ? 129 - q : (q + 128) % 130; }
__device__ __forceinline__ int s5_pos_of(int dir, int c) { return dir ? 129 - c : (c + 2) % 130; }
template <int PASS> __device__ __forceinline__ void s5_phase(const Args& a, int layer, unsigned char* lds, int tid) {
    float* uL = (float*)lds;
    float* YL = (float*)(lds + 32768);
    bf16_t* ST = (bf16_t*)(lds + 65536);
    const bf16_t* U5 = (const bf16_t*)(a.ws + WS_BIG + B_U5); bf16_t* Y5 = (bf16_t*)(a.ws + WS_BIG + B_Y5);
    float2* S5LOC = (float2*)(a.ws + WS_S5LOC);
    const int lane = tid & 63, w = tid >> 6, gl = tid >> 7, dir = (tid >> 6) & 1, p = tid & 63, fr = lane & 15, fq = lane >> 4;
    int cur_gq = -1; float ab_re = 0.f, ab_im = 0.f, a128r = 0.f, a128i = 0.f; float bbr[16], bbi[16]; bf16x8 cm[4];
    for (int unit = blockIdx.x; unit < 16 * NCH; unit += gridDim.x) {
        const int gq = unit / NCH, c = unit % NCH, g = gq * 4 + gl, row0 = c * 128;
        if (gq != cur_gq) { cur_gq = gq;
            const size_t pi = ((size_t)(layer * 2 + dir) * 64 + g) * 64 + p;
            const float lre = fminf(a.in[7][pi], -1e-4f), lim = a.in[8][pi], step = expf(a.in[9][(size_t)(layer * 2 + dir) * 64 + g]);
            const float mag = expf(lre * step); float sn, cs; sincosf(lim * step, &sn, &cs); ab_re = mag * cs; ab_im = mag * sn;
            const float den = lre * lre + lim * lim, q_re = ((ab_re - 1.f) * lre + ab_im * lim) / den, q_im = (ab_im * lre - (ab_re - 1.f) * lim) / den;
            const float* br = a.in[10] + (((size_t)layer * 64 + g) * 64 + p) * 16; const float* bi = a.in[11] + (((size_t)layer * 64 + g) * 64 + p) * 16;
#pragma unroll
            for (int j = 0; j < 16; ++j) { const float r = br[j], i = bi[j]; bbr[j] = q_re * r - q_im * i; bbi[j] = q_re * i + q_im * r; }
            a128r = ab_re; a128i = ab_im;
#pragma unroll
            for (int k = 0; k < 7; ++k) { const float r = a128r * a128r - a128i * a128i, i = 2.f * a128r * a128i; a128r = r; a128i = i; }
            if (PASS == 1) {
                const float* cre = a.in[12] + (((size_t)(layer * 2 + dir) * 64 + g) * 16 + fr) * 64; const float* cim = a.in[13] + (((size_t)(layer * 2 + dir) * 64 + g) * 16 + fr) * 64;
#pragma unroll
                for (int ks = 0; ks < 4; ++ks) { const float* s = (ks < 2 ? cre : cim) + (ks & 1) * 32 + fq * 8; const float sg = ks < 2 ? 1.f : -1.f;
                    const f32x4 v0 = *(const f32x4*)s, v1 = *(const f32x4*)(s + 4);
                    cm[ks] = mkfrag(cvt_pk_bf16(sg * v0[0], sg * v0[1]), cvt_pk_bf16(sg * v0[2], sg * v0[3]), cvt_pk_bf16(sg * v1[0], sg * v1[1]), cvt_pk_bf16(sg * v1[2], sg * v1[3])); }
            }
        }
        __syncthreads();
        { const int t = tid >> 2, q = tid & 3; const bf16_t* s = U5 + (size_t)(row0 + t) * 1024 + gq * 64 + q * 16; const u32x4 v0 = *(const u32x4*)s, v1 = *(const u32x4*)(s + 8);
            float* d = uL + t * 64 + q * 16;
            *(f32x4*)d = (f32x4){bflo(v0.x), bfhi(v0.x), bflo(v0.y), bfhi(v0.y)}; *(f32x4*)(d + 4) = (f32x4){bflo(v0.z), bfhi(v0.z), bflo(v0.w), bfhi(v0.w)};
            *(f32x4*)(d + 8) = (f32x4){bflo(v1.x), bfhi(v1.x), bflo(v1.y), bfhi(v1.y)}; *(f32x4*)(d + 12) = (f32x4){bflo(v1.z), bfhi(v1.z), bflo(v1.w), bfhi(v1.w)};
            if (PASS == 1) { float* y = YL + q * 2048 + t * 16;
#pragma unroll
                for (int j = 0; j < 4; ++j) *(f32x4*)(y + 4 * j) = (f32x4){0.f, 0.f, 0.f, 0.f}; } }
        float sr = 0.f, si = 0.f;
        if (PASS == 1) {
            const int pos = s5_pos_of(dir, c);
            for (int q = 0; q < pos; ++q) { const float2 l = S5LOC[((size_t)(dir * NCH + s5_chunk_at(dir, q)) * 64 + g) * 64 + p];
                const float nr = a128r * sr - a128i * si + l.x, ni = a128r * si + a128i * sr + l.y; sr = nr; si = ni; }
        }
        __syncthreads();
#pragma unroll 1
        for (int stp = 0; stp < 4; ++stp) {
#pragma unroll 4
            for (int ii = 0; ii < 32; ++ii) { const int i = stp * 32 + ii, t = dir ? 127 - i : i; const float* ut = uL + t * 64 + gl * 16;
                const f32x4 u0 = *(const f32x4*)ut, u1 = *(const f32x4*)(ut + 4), u2 = *(const f32x4*)(ut + 8), u3 = *(const f32x4*)(ut + 12);
                float br_ = 0.f, bi_ = 0.f;
#pragma unroll
                for (int j = 0; j < 4; ++j) { br_ += bbr[j] * u0[j] + bbr[4 + j] * u1[j] + bbr[8 + j] * u2[j] + bbr[12 + j] * u3[j]; bi_ += bbi[j] * u0[j] + bbi[4 + j] * u1[j] + bbi[8 + j] * u2[j] + bbi[12 + j] * u3[j]; }
                const float nr = ab_re * sr - ab_im * si + br_, ni = ab_re * si + ab_im * sr + bi_; sr = nr; si = ni;
                if (PASS == 1) { bf16_t* st = ST + ((size_t)(dir * 4 + gl) * 32 + (t & 31)) * 136; st[p] = (bf16_t)(cvt_pk_bf16(sr, 0.f) & 0xffffu); st[64 + p] = (bf16_t)(cvt_pk_bf16(si, 0.f) & 0xffffu); }
            }
            if (PASS == 1) {
                asm volatile("s_waitcnt lgkmcnt(0)" ::: "memory");
                const int tb = (dir ? 3 - stp : stp) * 32;
#pragma unroll
                for (int rt = 0; rt < 2; ++rt) { f32x4 acc = {0.f, 0.f, 0.f, 0.f};
#pragma unroll
                    for (int ks = 0; ks < 4; ++ks) { const bf16x8 af = *(const bf16x8*)(ST + ((size_t)(dir * 4 + gl) * 32 + rt * 16 + fr) * 136 + ks * 32 + fq * 8); acc = __builtin_amdgcn_mfma_f32_16x16x32_bf16(af, cm[ks], acc, 0, 0, 0); }
#pragma unroll
                    for (int jj = 0; jj < 4; ++jj) YL[gl * 2048 + (tb + rt * 16 + fq * 4 + jj) * 16 + fr] += acc[jj]; }
                __syncthreads();
            }
        }
        if (PASS == 0) { S5LOC[((size_t)(dir * NCH + c) * 64 + g) * 64 + p] = make_float2(sr, si); }
        else { const int t = tid >> 2, q = tid & 3; const float* y = YL + q * 2048 + t * 16; const float* u = uL + t * 64 + q * 16; const float* dd = a.in[14] + (size_t)layer * 1024 + gq * 64 + q * 16;
            unsigned o[8];
#pragma unroll
            for (int j = 0; j < 8; ++j) { const float y0 = y[2 * j] + u[2 * j] * dd[2 * j], y1 = y[2 * j + 1] + u[2 * j + 1] * dd[2 * j + 1]; o[j] = cvt_pk_bf16(gelu_tanh(y0), gelu_tanh(y1)); }
            bf16_t* dst = Y5 + (size_t)(row0 + t) * 1024 + gq * 64 + q * 16; u32x4 o0, o1; o0.x = o[0]; o0.y = o[1]; o0.z = o[2]; o0.w = o[3]; o1.x = o[4]; o1.y = o[5]; o1.z = o[6]; o1.w = o[7];
            *(u32x4*)dst = o0; *(u32x4*)(dst + 8) = o1; }
    }
    __syncthreads();
}

__device__ __forceinline__ int ssd_chunk_at(int dir, int q) { return s5_chunk_at(dir, q); }
__device__ __forceinline__ void conv8(const bf16_t* XBC, int rowbase, int l0, int ch, bool lo_ok, bool hi_ok, float w0, float w1, float w2, float b, float (&out)[8]) {
    float r[10];
#pragma unroll
    for (int i = 0; i < 10; ++i) { const int l = l0 - 1 + i; const bool ok = (l >= 0 || lo_ok) && (l < 128 || hi_ok); r[i] = ok ? bf2f((unsigned)XBC[(size_t)(rowbase + l) * 3072 + ch]) : 0.f; }
#pragma unroll
    for (int j = 0; j < 8; ++j) out[j] = silu_(w0 * r[j] + w1 * r[j + 1] + w2 * r[j + 2] + b);
}
__device__ __forceinline__ void stage_conv_tile(const bf16_t* XBC, const float* cw, const float* cb, int rowbase, int chbase, bool lo_ok, bool hi_ok, bf16_t* dst, int tid) {
    const int oc = tid & 15, ch = chbase + oc * 8; float w[3][8], b[8];
#pragma unroll
    for (int k = 0; k < 3; ++k) { const f32x4 a0 = *(const f32x4*)(cw + (size_t)k * 3072 + ch), a1 = *(const f32x4*)(cw + (size_t)k * 3072 + ch + 4);
        w[k][0] = a0[0]; w[k][1] = a0[1]; w[k][2] = a0[2]; w[k][3] = a0[3]; w[k][4] = a1[0]; w[k][5] = a1[1]; w[k][6] = a1[2]; w[k][7] = a1[3]; }
    { const f32x4 a0 = *(const f32x4*)(cb + ch), a1 = *(const f32x4*)(cb + ch + 4); b[0] = a0[0]; b[1] = a0[1]; b[2] = a0[2]; b[3] = a0[3]; b[4] = a1[0]; b[5] = a1[1]; b[6] = a1[2]; b[7] = a1[3]; }
#pragma unroll
    for (int i = 0; i < 4; ++i) { const int row = (tid >> 4) + i * 32; float acc[8];
#pragma unroll
        for (int k = 0; k < 8; ++k) acc[k] = b[k];
#pragma unroll
        for (int d = 0; d < 3; ++d) { const int l = row + d - 1; const bool ok = (l >= 0 || lo_ok) && (l < 128 || hi_ok);
            if (ok) { const u32x4 g = *(const u32x4*)(XBC + (size_t)(rowbase + l) * 3072 + ch);
                acc[0] += w[d][0] * bflo(g.x); acc[1] += w[d][1] * bfhi(g.x); acc[2] += w[d][2] * bflo(g.y); acc[3] += w[d][3] * bfhi(g.y);
                acc[4] += w[d][4] * bflo(g.z); acc[5] += w[d][5] * bfhi(g.z); acc[6] += w[d][6] * bflo(g.w); acc[7] += w[d][7] * bfhi(g.w); } }
        u32x4 o; o.x = cvt_pk_bf16(silu_(acc[0]), silu_(acc[1])); o.y = cvt_pk_bf16(silu_(acc[2]), silu_(acc[3])); o.z = cvt_pk_bf16(silu_(acc[4]), silu_(acc[5])); o.w = cvt_pk_bf16(silu_(acc[6]), silu_(acc[7]));
        *(u32x4*)(dst + row * 136 + oc * 8) = o; }
}
constexpr int SL_CS = 0, SL_CB = 34816, SL_CUM = 69632, SL_DT = 77824, SL_PART = 86016, SL_BS = 94208, SL_XF = 94208;
template <int AUX> __device__ __forceinline__ void ssd_cum(const Args& a, int layer, int c, int h, int w, int lane, unsigned char* lds) {
    const float* DT = (const float*)(a.ws + WS_BIG + B_DT); float* cumL = (float*)(lds + SL_CUM); float* dtL = (float*)(lds + SL_DT); float* CHD = (float*)(a.ws + WS_CHD);
#pragma unroll
    for (int dir = 0; dir < 2; ++dir) {
        const float ah = -expf(a.in[20][(size_t)(layer * 2 + dir) * 32 + h]);
        const float d0 = DT[(size_t)(c * 128 + 2 * lane) * 64 + dir * 32 + h], d1 = DT[(size_t)(c * 128 + 2 * lane + 1) * 64 + dir * 32 + h];
        const float l0 = d0 * ah, l1 = d1 * ah, s = l0 + l1; float incl = s;
#pragma unroll
        for (int o = 1; o < 64; o <<= 1) { const float t = __shfl_up(incl, o); if (lane >= o) incl += t; }
        const float excl = incl - s, tot = __shfl(incl, 63);
        float c0, c1;
        if (dir == 0) { c0 = excl + l0; c1 = incl; } else { c0 = tot - excl; c1 = tot - (excl + l0); }
        float* cu = cumL + (dir * 8 + w) * 128 + 2 * lane; cu[0] = c0; cu[1] = c1;
        float* dd = dtL + (dir * 8 + w) * 128 + 2 * lane;
        if (AUX == 0) { dd[0] = d0; dd[1] = d1; } else { dd[0] = d0 * __expf(tot - c0); dd[1] = d1 * __expf(tot - c1); if (lane == 0) CHD[(size_t)(dir * NCH + c) * 32 + h] = tot; }
    }
}
__device__ __forceinline__ void ssd_a_phase(const Args& a, int layer, unsigned char* lds, int tid) {
    const bf16_t* XBC = (const bf16_t*)(a.ws + WS_BIG + B_XBC); bf16_t* SST = (bf16_t*)(a.ws + WS_SST);
    const float* cw = a.in[17] + (size_t)layer * 3 * 3072; const float* cb = a.in[18] + (size_t)layer * 3072;
    bf16_t* Bs = (bf16_t*)(lds + SL_BS); const float* wL = (const float*)(lds + SL_DT);
    const int lane = tid & 63, w = tid >> 6, fr = lane & 15, fq = lane >> 4;
    for (int unit = blockIdx.x; unit < NCH * 4; unit += gridDim.x) {
        const int c = unit >> 2, g = unit & 3, rowbase = c * 128, h = g * 8 + w; const bool lo_ok = !(c == 0 || c == 128), hi_ok = !(c == 127 || c == 129);
        __syncthreads();
        stage_conv_tile(XBC, cw, cb, rowbase, 2048 + g * 128, lo_ok, hi_ok, Bs, tid);
        ssd_cum<1>(a, layer, c, h, w, lane, lds);
        __syncthreads();
#pragma unroll 1
        for (int dir = 0; dir < 2; ++dir) {
            bf16_t* sb = SST + (((size_t)(dir * NCH + c) * 32 + h) * 64) * 128;
#pragma unroll 1
            for (int pt = 0; pt < 4; ++pt) {
                const int ch = h * 64 + pt * 16 + fr; const float w0 = cw[ch], w1 = cw[3072 + ch], w2 = cw[6144 + ch], bb = cb[ch];
                f32x4 acc[8];
#pragma unroll
                for (int nt = 0; nt < 8; ++nt) acc[nt] = (f32x4){0.f, 0.f, 0.f, 0.f};
#pragma unroll 1
                for (int ks = 0; ks < 4; ++ks) {
                    const float* wp = wL + (dir * 8 + w) * 128 + ks * 32 + fq * 8; const f32x4 wl0 = *(const f32x4*)wp, wl1 = *(const f32x4*)(wp + 4);
                    float x[8]; conv8(XBC, rowbase, ks * 32 + fq * 8, ch, lo_ok, hi_ok, w0, w1, w2, bb, x);
                    const bf16x8 yf = mkfrag(cvt_pk_bf16(x[0] * wl0[0], x[1] * wl0[1]), cvt_pk_bf16(x[2] * wl0[2], x[3] * wl0[3]), cvt_pk_bf16(x[4] * wl1[0], x[5] * wl1[1]), cvt_pk_bf16(x[6] * wl1[2], x[7] * wl1[3]));
#pragma unroll
                    for (int nt = 0; nt < 8; ++nt) { const bf16_t* bp = Bs + (ks * 32 + fq * 8) * 136 + nt * 16 + fr;
                        const bf16x8 xf = mkfrag((unsigned)bp[0] | ((unsigned)bp[136] << 16), (unsigned)bp[2 * 136] | ((unsigned)bp[3 * 136] << 16), (unsigned)bp[4 * 136] | ((unsigned)bp[5 * 136] << 16), (unsigned)bp[6 * 136] | ((unsigned)bp[7 * 136] << 16));
                        acc[nt] = __builtin_amdgcn_mfma_f32_16x16x32_bf16(xf, yf, acc[nt], 0, 0, 0); }
                }
                mfma_settle(acc[7]); mfma_settle(acc[6]);
#pragma unroll
                for (int nt = 0; nt < 8; ++nt) { u32x2 o; o.x = cvt_pk_bf16(acc[nt][0], acc[nt][1]); o.y = cvt_pk_bf16(acc[nt][2], acc[nt][3]);
                    *(u32x2*)(sb + (size_t)(pt * 16 + fr) * 128 + nt * 16 + fq * 4) = o; }
            }
        }
    }
    __syncthreads();
}
__device__ __forceinline__ void ssd_b_phase(const Args& a, int tid) {
    bf16_t* SST = (bf16_t*)(a.ws + WS_SST); const float* CHD = (const float*)(a.ws + WS_CHD);
    for (int idx = blockIdx.x * 512 + tid; idx < 64 * 2048; idx += gridDim.x * 512) {
        const int e4 = idx & 2047, hd = idx >> 11, dir = hd >> 5, h = hd & 31; float s0 = 0.f, s1 = 0.f, s2 = 0.f, s3 = 0.f;
#pragma unroll 1
        for (int b = 0; b < 13; ++b) { u32x2 loc[10]; float dc[10];
#pragma unroll
            for (int i = 0; i < 10; ++i) { const int cq = ssd_chunk_at(dir, b * 10 + i); loc[i] = *(const u32x2*)(SST + ((size_t)(dir * NCH + cq) * 32 + h) * 8192 + e4 * 4); dc[i] = CHD[(size_t)(dir * NCH + cq) * 32 + h]; }
#pragma unroll
            for (int i = 0; i < 10; ++i) { const int cq = ssd_chunk_at(dir, b * 10 + i); u32x2 o; o.x = cvt_pk_bf16(s0, s1); o.y = cvt_pk_bf16(s2, s3);
                *(u32x2*)(SST + ((size_t)(dir * NCH + cq) * 32 + h) * 8192 + e4 * 4) = o; const float e = __expf(dc[i]);
                s0 = e * s0 + bflo(loc[i].x); s1 = e * s1 + bfhi(loc[i].x); s2 = e * s2 + bflo(loc[i].y); s3 = e * s3 + bfhi(loc[i].y); }
        }
    }
}
__device__ __forceinline__ void ssd_c_phase(const Args& a, int layer, unsigned char* lds, int tid) {
    const bf16_t* XBC = (const bf16_t*)(a.ws + WS_BIG + B_XBC); const bf16_t* SST = (const bf16_t*)(a.ws + WS_SST); const bf16_t* Z = (const bf16_t*)(a.ws + WS_BIG + B_Z); bf16_t* YD = (bf16_t*)(a.ws + WS_BIG + B_YD);
    const float* cw = a.in[17] + (size_t)layer * 3 * 3072; const float* cb = a.in[18] + (size_t)layer * 3072; const float* normw = a.in[22] + (size_t)layer * 2048;
    bf16_t* Cs = (bf16_t*)(lds + SL_CS); bf16_t* Bs = (bf16_t*)(lds + SL_BS); bf16_t* CBs = (bf16_t*)(lds + SL_CB); const float* cumL = (const float*)(lds + SL_CUM); const float* dtL = (const float*)(lds + SL_DT); float* part = (float*)(lds + SL_PART);
    const int lane = tid & 63, w = tid >> 6, fr = lane & 15, fq = lane >> 4;
    for (int unit = blockIdx.x; unit < NCH * 4; unit += gridDim.x) {
        const int c = unit >> 2, g = unit & 3, rowbase = c * 128, h = g * 8 + w; const bool lo_ok = !(c == 0 || c == 128), hi_ok = !(c == 127 || c == 129);
        const float Dh = a.in[21][(size_t)layer * 32 + h];
        __syncthreads();
        stage_conv_tile(XBC, cw, cb, rowbase, 2560 + g * 128, lo_ok, hi_ok, Cs, tid);
        stage_conv_tile(XBC, cw, cb, rowbase, 2048 + g * 128, lo_ok, hi_ok, Bs, tid);
        ssd_cum<0>(a, layer, c, h, w, lane, lds);
        __syncthreads();
#pragma unroll 1
        for (int st = 0; st < 8; ++st) { f32x4 acc = {0.f, 0.f, 0.f, 0.f};
#pragma unroll
            for (int ks = 0; ks < 4; ++ks) { const bf16x8 xf = *(const bf16x8*)(Bs + (st * 16 + fr) * 136 + ks * 32 + fq * 8), yf = *(const bf16x8*)(Cs + (w * 16 + fr) * 136 + ks * 32 + fq * 8);
                acc = __builtin_amdgcn_mfma_f32_16x16x32_bf16(xf, yf, acc, 0, 0, 0); }
            mfma_settle(acc);
            u32x2 o; o.x = cvt_pk_bf16(acc[0], acc[1]); o.y = cvt_pk_bf16(acc[2], acc[3]); *(u32x2*)(CBs + (w * 16 + fr) * 136 + st * 16 + fq * 4) = o; }
        __syncthreads();
#pragma unroll 1
        for (int hp = 0; hp < 2; ++hp) {
        bf16_t* XFw = (bf16_t*)(lds + SL_XF) + (size_t)w * 4096;
#pragma unroll 1
        for (int f = 0; f < 8; ++f) { const int p2 = f & 1, ks = f >> 1; const int ch = h * 64 + (hp * 2 + p2) * 16 + fr; const float w0 = cw[ch], w1 = cw[3072 + ch], w2 = cw[6144 + ch], bb = cb[ch];
            float x[8]; conv8(XBC, rowbase, ks * 32 + fq * 8, ch, lo_ok, hi_ok, w0, w1, w2, bb, x);
            *(bf16x8*)(XFw + (f * 64 + lane) * 8) = mkfrag(cvt_pk_bf16(x[0], x[1]), cvt_pk_bf16(x[2], x[3]), cvt_pk_bf16(x[4], x[5]), cvt_pk_bf16(x[6], x[7])); }
        asm volatile("s_waitcnt lgkmcnt(0)" ::: "memory");
#pragma unroll 1
        for (int lt = 0; lt < 8; ++lt) {
            const int l = lt * 16 + fr; f32x4 acc[2];
#pragma unroll
            for (int p2 = 0; p2 < 2; ++p2) acc[p2] = (f32x4){0.f, 0.f, 0.f, 0.f};
#pragma unroll
            for (int dir = 0; dir < 2; ++dir) {
                f32x4 tmp[2];
#pragma unroll
                for (int p2 = 0; p2 < 2; ++p2) tmp[p2] = (f32x4){0.f, 0.f, 0.f, 0.f};
                const bf16_t* sb = SST + (((size_t)(dir * NCH + c) * 32 + h) * 64) * 128;
#pragma unroll
                for (int ks = 0; ks < 4; ++ks) { const bf16x8 yf = *(const bf16x8*)(Cs + l * 136 + ks * 32 + fq * 8);
#pragma unroll
                    for (int p2 = 0; p2 < 2; ++p2) { const bf16x8 sf = *(const bf16x8*)(sb + (size_t)((hp * 2 + p2) * 16 + fr) * 128 + ks * 32 + fq * 8); tmp[p2] = __builtin_amdgcn_mfma_f32_16x16x32_bf16(sf, yf, tmp[p2], 0, 0, 0); } }
                __builtin_amdgcn_sched_barrier(0);
                const float cl = cumL[(dir * 8 + w) * 128 + l], el = __expf(cl);
#pragma unroll
                for (int p2 = 0; p2 < 2; ++p2) acc[p2] += tmp[p2] * el;
#pragma unroll
                for (int ks = 0; ks < 4; ++ks) { const int s0 = ks * 32;
                    const bool skip = dir == 0 ? (s0 > lt * 16 + 15) : (s0 + 31 < lt * 16);
                    if (!skip) { const u32x4 cbv = *(const u32x4*)(CBs + l * 136 + s0 + fq * 8);
                        const float* cp = cumL + (dir * 8 + w) * 128 + s0 + fq * 8; const float* dp = dtL + (dir * 8 + w) * 128 + s0 + fq * 8;
                        const f32x4 c0 = *(const f32x4*)cp, c1 = *(const f32x4*)(cp + 4), d0 = *(const f32x4*)dp, d1 = *(const f32x4*)(dp + 4);
                        float cbf[8] = {bflo(cbv.x), bfhi(cbv.x), bflo(cbv.y), bfhi(cbv.y), bflo(cbv.z), bfhi(cbv.z), bflo(cbv.w), bfhi(cbv.w)}; float v[8];
#pragma unroll
                        for (int j = 0; j < 8; ++j) { const int s = s0 + fq * 8 + j; const float cs = j < 4 ? c0[j & 3] : c1[j & 3], ds = j < 4 ? d0[j & 3] : d1[j & 3];
                            const bool valid = dir == 0 ? (s <= l) : (s >= l); float t = valid ? cbf[j] * __expf(fminf(cl - cs, 0.f)) * ds : 0.f; if (dir == 0 && s == l) t += Dh; v[j] = t; }
                        const bf16x8 yf = mkfrag(cvt_pk_bf16(v[0], v[1]), cvt_pk_bf16(v[2], v[3]), cvt_pk_bf16(v[4], v[5]), cvt_pk_bf16(v[6], v[7]));
#pragma unroll
                        for (int p2 = 0; p2 < 2; ++p2) acc[p2] = __builtin_amdgcn_mfma_f32_16x16x32_bf16(*(const bf16x8*)(XFw + ((ks * 2 + p2) * 64 + lane) * 8), yf, acc[p2], 0, 0, 0); }
                    __builtin_amdgcn_sched_barrier(0); }
            }
            const size_t row = (size_t)(rowbase + l); float ss = 0.f;
#pragma unroll
            for (int p2 = 0; p2 < 2; ++p2) { const int ch = h * 64 + (hp * 2 + p2) * 16 + fq * 4; const u32x2 zz = *(const u32x2*)(Z + row * 2048 + ch);
                const float h0 = acc[p2][0] * silu_(bflo(zz.x)), h1 = acc[p2][1] * silu_(bfhi(zz.x)), h2 = acc[p2][2] * silu_(bflo(zz.y)), h3 = acc[p2][3] * silu_(bfhi(zz.y));
                ss += (h0 * h0 + h1 * h1) + (h2 * h2 + h3 * h3); u32x2 o; o.x = cvt_pk_bf16(h0, h1); o.y = cvt_pk_bf16(h2, h3); *(u32x2*)(YD + row * 2048 + ch) = o; }
            ss += __shfl_xor(ss, 16); ss += __shfl_xor(ss, 32);
            if (fq == 0) part[(hp * 8 + w) * 128 + l] = ss;
        }
        }
        __syncthreads();
#pragma unroll 1
        for (int lt = 0; lt < 8; ++lt) { const int l = lt * 16 + fr; float tot = 0.f;
#pragma unroll
            for (int ww = 0; ww < 16; ++ww) tot += part[ww * 128 + l];
            const float r = 1.f / sqrtf(tot * (1.f / 512.f) + RMS_EPS); const size_t row = (size_t)(rowbase + l);
#pragma unroll
            for (int pt = 0; pt < 4; ++pt) { const int ch = h * 64 + pt * 16 + fq * 4; bf16_t* yp = YD + row * 2048 + ch; const u32x2 hv = *(const u32x2*)yp; const f32x4 nw = *(const f32x4*)(normw + ch);
                u32x2 o; o.x = cvt_pk_bf16(bflo(hv.x) * r * nw[0], bfhi(hv.x) * r * nw[1]); o.y = cvt_pk_bf16(bflo(hv.y) * r * nw[2], bfhi(hv.y) * r * nw[3]); *(u32x2*)yp = o; } }
    }
    __syncthreads();
}

constexpr int NPHASE = 2 + 11 * 2;
__global__ void __launch_bounds__(512, 2) fwd_megakernel(Args a) {
    extern __shared__ __attribute__((aligned(16))) unsigned char lds[];
    PG8_LAS unsigned char* lds3 = (PG8_LAS unsigned char*)lds;
    unsigned char* big = a.ws + WS_BIG;
    for (int ph = a.ph_lo; ph < a.ph_hi; ++ph) {
        const int tid = pg8::pg8_tid(), lane = tid & 63, wave = tid >> 6, gw = blockIdx.x * 8 + wave, NGW = gridDim.x * 8;
        if (ph == 0) {
            adaln_phase(a, (float*)lds, tid);
            float* scr = (float*)lds + wave * (64 * 33);
            xpose_region(a, 0, 0, scr, gw, NGW, lane); xpose_region(a, 0, 1, scr, gw, NGW, lane);
        } else if (ph == 1) {
            row_phase<0>(a, MT, nullptr, nullptr, 0, 0, gw, NGW, lane);
        } else {
            const int layer = (ph - 2) / 11, k = (ph - 2) % 11; const bool last = layer == 1; const int Mrows = last ? TL : MT;
            const bf16_t* WA = (const bf16_t*)(a.ws + WS_WA); const bf16_t* WB = (const bf16_t*)(a.ws + WS_WB);
#ifdef MK_SKIP_MASK
            if ((MK_SKIP_MASK >> k) & 1) { if (ph + 1 < a.ph_hi) cg::this_grid().sync(); continue; }
#endif
            if (k == 0) {
                pg8::Gemm g{(const bf16_t*)(a.ws + WS_XM), WA + WA_IN / 2, MT, NPROJ, D}; pg8::StaticOrder S; S.init(MT, NPROJ, gridDim.x, blockIdx.x);
                EpiInProj E{big, a.in[19] + (size_t)layer * 64}; pg8::gemm_phase<EpiInProj, pg8::StaticOrder>(lds3, g, S, E, nullptr);
            } else if (k == 1) {
#if !defined(MK_NO_SSD) && !defined(MK_NO_SSDA)
                ssd_a_phase(a, layer, lds, tid);
#endif
#ifndef MK_NO_S5
                s5_phase<0>(a, layer, lds, tid);
#endif
            } else if (k == 2) {
#if !defined(MK_NO_SSD) && !defined(MK_NO_SSDB)
                ssd_b_phase(a, tid);
#endif
#ifndef MK_NO_S5
                s5_phase<1>(a, layer, lds, tid);
#endif
            } else if (k == 3) {
#ifndef MK_NO_SSD
                ssd_c_phase(a, layer, lds, tid);
#endif
#ifndef MK_NO_S5
                pg8::Gemm g{(const bf16_t*)(big + B_Y5), WA + WA_GLU / 2, Mrows, 2048, 1024}; pg8::StaticOrder S; S.init(Mrows, 2048, gridDim.x, blockIdx.x);
                EpiGlu E{(bf16_t*)(big + B_U5)}; pg8::gemm_phase<EpiGlu, pg8::StaticOrder>(lds3, g, S, E, nullptr);
#endif
            } else if (k == 4) {
#ifndef MK_NO_S5
                { pg8::Gemm g{(const bf16_t*)(big + B_U5), WA + WA_S5P / 2, Mrows, 2048, 1024}; pg8::StaticOrder S; S.init(Mrows, 2048, gridDim.x, blockIdx.x);
                  EpiMerge<0> E{(bf16_t*)(big + B_XBC), (const bf16_t*)(big + B_GATE)}; pg8::gemm_phase<EpiMerge<0>, pg8::StaticOrder>(lds3, g, S, E, nullptr); }
                __syncthreads();
#endif
#ifndef MK_NO_SSD
#ifdef MK_NO_S5
                { pg8::Gemm g{(const bf16_t*)(big + B_YD), WA + WA_SSDP / 2, Mrows, 2048, 2048}; pg8::StaticOrder S; S.init(Mrows, 2048, gridDim.x, blockIdx.x);
                  EpiMerge<0, 1> E{(bf16_t*)(big + B_XBC), (const bf16_t*)(big + B_GATE)}; pg8::gemm_phase<EpiMerge<0, 1>, pg8::StaticOrder>(lds3, g, S, E, nullptr); }
#else
                { pg8::Gemm g{(const bf16_t*)(big + B_YD), WA + WA_SSDP / 2, Mrows, 2048, 2048}; pg8::StaticOrder S; S.init(Mrows, 2048, gridDim.x, blockIdx.x);
                  EpiMerge<1> E{(bf16_t*)(big + B_XBC), (const bf16_t*)(big + B_GATE)}; pg8::gemm_phase<EpiMerge<1>, pg8::StaticOrder>(lds3, g, S, E, nullptr); }
#endif
#endif
            } else if (k == 5) {
                pg8::Gemm g{(const bf16_t*)(big + B_XBC), WA + WA_WOUT / 2, Mrows, 2048, 2048}; pg8::StaticOrder S; S.init(Mrows, 2048, gridDim.x, blockIdx.x);
                EpiResid E{a.out, (float*)(a.ws + WS_HCTX), mvec(a, layer, 0) + 2 * D, mvec(a, layer, 1) + 2 * D}; pg8::gemm_phase<EpiResid, pg8::StaticOrder>(lds3, g, S, E, nullptr);
            } else if (k == 6) {
                row_phase<1>(a, Mrows, a.in[25] + (size_t)layer * D, a.in[26] + (size_t)layer * D, layer, 3 * D, gw, NGW, lane);
                if (!last) { __syncthreads(); xpose_region(a, layer + 1, 0, (float*)lds + wave * (64 * 33), gw, NGW, lane); }
            } else if (k == 7) {
                pg8::Gemm g{(const bf16_t*)(a.ws + WS_XM), WB + WB_UP / 2, Mrows, 2 * DFF, D}; pg8::StaticOrder S; S.init(Mrows, 2 * DFF, gridDim.x, blockIdx.x);
                EpiUp E{(bf16_t*)(big + B_G), (bf16_t*)(big + B_V)}; pg8::gemm_phase<EpiUp, pg8::StaticOrder>(lds3, g, S, E, nullptr);
            } else if (k == 8) {
                ffnconv_phase(a, layer, !last, tid);
            } else if (k == 9) {
                pg8::Gemm g{(const bf16_t*)(big + B_V), WB + WB_DOWN / 2, Mrows, D, DFF}; pg8::StaticOrder S; S.init(Mrows, D, gridDim.x, blockIdx.x);
                EpiResid E{a.out, (float*)(a.ws + WS_HCTX), mvec(a, layer, 0) + 5 * D, mvec(a, layer, 1) + 5 * D}; pg8::gemm_phase<EpiResid, pg8::StaticOrder>(lds3, g, S, E, nullptr);
            } else {
                row_phase<1>(a, Mrows, a.in[31] + (size_t)layer * D, a.in[32] + (size_t)layer * D, last ? -1 : layer + 1, 0, gw, NGW, lane);
                if (!last) { __syncthreads(); xpose_region(a, layer + 1, 1, (float*)lds + wave * (64 * 33), gw, NGW, lane); }
            }
        }
        if (ph + 1 < a.ph_hi) cg::this_grid().sync();
    }
}
}

#ifndef MK_N_LAUNCH_MODE
#define MK_N_LAUNCH_MODE 0
#endif
extern "C" void kernel_launch(void* const* d_in, const int* in_sizes, int n_in, void* d_out, int out_size, void* d_ws, size_t ws_size, hipStream_t stream) {
    static int grid = 0;
    if (grid == 0) {
        if (n_in != 33 || ws_size < mk::WS_END) { fprintf(stderr, "kernel_launch: need 33 inputs and %zu bytes of workspace (got %d, %zu)\n", (size_t)mk::WS_END, n_in, ws_size); grid = -1; return; }
        int dev = 0, cus = 0, per_cu = 0;
        (void)hipGetDevice(&dev); (void)hipDeviceGetAttribute(&cus, hipDeviceAttributeMultiprocessorCount, dev);
        if (hipFuncSetAttribute((const void*)mk::fwd_megakernel, hipFuncAttributeMaxDynamicSharedMemorySize, mk::LDS_BYTES) != hipSuccess) { fprintf(stderr, "kernel_launch: hipFuncSetAttribute failed\n"); grid = -1; return; }
        if (hipOccupancyMaxActiveBlocksPerMultiprocessor(&per_cu, (const void*)mk::fwd_megakernel, 512, mk::LDS_BYTES) != hipSuccess || per_cu < 1) { fprintf(stderr, "kernel_launch: occupancy query says %d\n", per_cu); per_cu = 1; }
        (void)hipGetLastError();
        grid = cus * per_cu; if (grid > 256) grid = 256;
    }
    if (grid < 0) return;
    mk::Args a{};
    for (int i = 0; i < 33; ++i) a.in[i] = (const float*)d_in[i];
    a.out = (float*)d_out; a.ws = (unsigned char*)d_ws;
#if MK_N_LAUNCH_MODE == 1
    for (int ph = 0; ph < mk::NPHASE; ++ph) { a.ph_lo = ph; a.ph_hi = ph + 1; hipLaunchKernelGGL(mk::fwd_megakernel, dim3(grid), dim3(512), mk::LDS_BYTES, stream, a); }
#else
    a.ph_lo = 0; a.ph_hi = mk::NPHASE;
    void* args[] = {&a};
    hipError_t e = hipLaunchCooperativeKernel((const void*)mk::fwd_megakernel, dim3(grid), dim3(512), args, mk::LDS_BYTES, stream);
    if (e != hipSuccess) fprintf(stderr, "cooperative launch failed: %s (grid %d)\n", hipGetErrorString(e), grid);
#endif
}
```

```cpp
#include <hip/hip_runtime.h>
#include <hip/hip_cooperative_groups.h>
#include <cstdio>
namespace cg = cooperative_groups;
#define MK_N_LAUNCH_MODE 0
namespace pg8 {
#define PG8_LAS __attribute__((address_space(3)))
typedef unsigned short bf16_t;
typedef short bf16x8 __attribute__((ext_vector_type(8)));
typedef float f32x4 __attribute__((ext_vector_type(4)));
typedef unsigned u32x4 __attribute__((ext_vector_type(4)));
constexpr int BM = 256, BK = 64, HALF = 128, HTB = HALF * BK * 2  , STAGE_BYTES = 8 * HTB, NXCD = 8, WGM = 8;

__host__ __device__ __forceinline__ int lds_byte(int r, int c) { const int st = (r >> 4) * 2 + (c >> 5), rr = r & 15, cc = c & 31, ob = rr * 64 + cc * 2; return st * 1024 + (ob ^ (((ob >> 9) & 1) << 5)); }
__host__ __device__ __forceinline__ void stage_rc(int b, int& R, int& C) { const int st = b / 1024, sb = b % 1024, swz = sb ^ (((sb >> 9) & 1) << 5); R = (st >> 1) * 16 + swz / 64; C = (st & 1) * 32 + (swz % 64) / 2; }
__host__ __device__ __forceinline__ int perm32(int rho) { const int n = rho >> 4, i = rho & 15; return 8 * (i >> 2) + 4 * n + (i & 3); }

__device__ __forceinline__ int pg8_tid() { int t = threadIdx.x; asm volatile("" : "+v"(t)); return t; }
struct Unit { int pm, pn; };
struct Gemm { const bf16_t* A; const bf16_t* Bt; int M, N, K; };

struct StaticOrder {
    int nM, nN, nwg, G, c;
    __host__ __device__ void init(int M, int N, int G_, int c_) { nM = M / BM; nN = N / BM; nwg = nM * nN; G = G_; c = c_; }
    __host__ __device__ bool next(int i, Unit& u) const {
        const long L = (long)i * G + c; if (L >= nwg) return false;
        int wgid = (int)L; { const int q = nwg / NXCD, r = nwg % NXCD, xcd = wgid % NXCD, off = wgid / NXCD; wgid = (xcd < r ? xcd * (q + 1) : r * (q + 1) + (xcd - r) * q) + off; }
        const int nig = WGM * nN, gid = wgid / nig, fm = gid * WGM, gsz = (nM - fm) < WGM ? (nM - fm) : WGM;
        u.pm = fm + ((wgid % nig) % gsz); u.pn = (wgid % nig) / gsz; return true;
    }
    __device__ __forceinline__ void a_ready(const Unit&) const {}
    __device__ __forceinline__ void done(const Unit&) const {}
};
__device__ __forceinline__ unsigned cvt_pk_bf16(float lo, float hi) { unsigned r; asm volatile("v_cvt_pk_bf16_f32 %0, %1, %2" : "=v"(r) : "v"(lo), "v"(hi)); return r; }
__device__ __forceinline__ void mfma_settle(const float __attribute__((ext_vector_type(4)))& a) { asm volatile("s_nop 15\n\ts_nop 7" :: "v"(a)); }
typedef float f32x2 __attribute__((ext_vector_type(2)));
template <class Epi, class Sched, bool STAMP = false>
__device__ __forceinline__ void gemm_phase(PG8_LAS unsigned char* lds, const Gemm g, const Sched& S, const Epi& E, unsigned long long* stamps) {
    const int tid = pg8_tid(), wid = __builtin_amdgcn_readfirstlane(tid >> 6), lane = tid & 63, wr = wid >> 2, wc = wid & 3, fr = lane & 15, fq = lane >> 4;
    const int K = g.K, nt = K / BK;
    int ts_lo = 0, ts_hi = 0, nts = 0; const unsigned long long rt_entry = STAMP ? (unsigned long long)wall_clock64() : 0ull;
#define PG8_STAMP() do { if (STAMP && wid == 0 && nts < 64) { const unsigned long long _c = (unsigned long long)clock64(); \
        ts_lo = (lane == nts) ? (int)(unsigned)_c : ts_lo; ts_hi = (lane == nts) ? (int)(unsigned)(_c >> 32) : ts_hi; ++nts; } } while (0)
    PG8_STAMP();
    unsigned voffA[2], voffB[2];
#pragma unroll
    for (int i = 0; i < 2; ++i) { int R, C; stage_rc(tid * 16 + i * 8192, R, C); const int Rb = Epi::PERM ? ((R & ~31) + perm32(R & 31)) : R;
        voffA[i] = (unsigned)(R * K + C) * 2u; voffB[i] = (unsigned)(Rb * K + C) * 2u; }
    const size_t kstep = (size_t)(BK * 2);
    const size_t hstep = (size_t)HALF * K * 2;
    const size_t tstep = 2 * hstep;
    const unsigned ldsw = (unsigned)wid * 1024u;
    const int aoff = lds_byte(wr * 64 + fr, fq * 8), boff = lds_byte(wc * 32 + fr, fq * 8);
#define PG8_SA(b, h) (((b) * 2 + (h)) * HTB)
#define PG8_SB(b, h) ((4 + (b) * 2 + (h)) * HTB)
#define PG8_STAGE(bufoff, gbase, voff) do { _Pragma("unroll") for (int _i = 0; _i < 2; ++_i) \
        __builtin_amdgcn_global_load_lds((const unsigned*)((const char*)(gbase) + (voff)[_i]), (PG8_LAS unsigned*)(lds + (bufoff) + ldsw + _i * 8192), 16, 0, 0); } while (0)
#define PG8_LDA(dst, b, h) do { _Pragma("unroll") for (int m = 0; m < 4; ++m) _Pragma("unroll") for (int k = 0; k < 2; ++k) dst[m][k] = *(const PG8_LAS bf16x8*)(lds + PG8_SA(b, h) + aoff + m * 2048 + k * 1024); } while (0)
#define PG8_LDB(dst, b, h) do { _Pragma("unroll") for (int n = 0; n < 2; ++n) _Pragma("unroll") for (int k = 0; k < 2; ++k) dst[n][k] = *(const PG8_LAS bf16x8*)(lds + PG8_SB(b, h) + boff + n * 2048 + k * 1024); } while (0)
#define PG8_MMA(ai, bj, At, Bt) do { __builtin_amdgcn_s_setprio(1); _Pragma("unroll") for (int m = 0; m < 4; ++m) _Pragma("unroll") for (int n = 0; n < 2; ++n) _Pragma("unroll") for (int k = 0; k < 2; ++k) \
        acc[ai][bj][m][n] = __builtin_amdgcn_mfma_f32_16x16x32_bf16(Bt[n][k], At[m][k], acc[ai][bj][m][n], 0, 0, 0); __builtin_amdgcn_s_setprio(0); } while (0)
#define PG8_WAIT_V(n) asm volatile("s_waitcnt vmcnt(" #n ")" ::: "memory")
#define PG8_WAIT_L(n) asm volatile("s_waitcnt lgkmcnt(" #n ")" ::: "memory")
#define PG8_BAR __builtin_amdgcn_s_barrier()
#define PG8_SCHED __builtin_amdgcn_sched_barrier(0)
    Unit cur, nxt; int ui = 0;
    if (!S.next(0, cur)) return;
    f32x4 acc[2][2][4][2];
#pragma unroll
    for (int a = 0; a < 2; ++a)
#pragma unroll
        for (int b = 0; b < 2; ++b)
#pragma unroll
            for (int m = 0; m < 4; ++m)
#pragma unroll
                for (int n = 0; n < 2; ++n) acc[a][b][m][n] = (f32x4){0.f, 0.f, 0.f, 0.f};
    bf16x8 At[4][2], B0[2][2], B1[2][2];
    const char* cA = (const char*)g.A + (size_t)cur.pm * tstep; const char* cB = (const char*)g.Bt + (size_t)cur.pn * tstep;
    S.a_ready(cur);
    PG8_STAGE(PG8_SB(0, 0), cB, voffB); PG8_STAGE(PG8_SA(0, 0), cA, voffA); PG8_STAGE(PG8_SB(0, 1), cB + hstep, voffB); PG8_STAGE(PG8_SA(0, 1), cA + hstep, voffA);
    if (wr == 1) PG8_BAR;
    PG8_WAIT_V(4); PG8_BAR;
    PG8_STAGE(PG8_SB(1, 0), cB + kstep, voffB); PG8_STAGE(PG8_SA(1, 0), cA + kstep, voffA); PG8_STAGE(PG8_SB(1, 1), cB + hstep + kstep, voffB);
    PG8_WAIT_V(6); PG8_BAR;
    PG8_STAMP();
    for (;;) {
        const bool has_next = S.next(ui + 1, nxt);
        const char* nA = has_next ? (const char*)g.A + (size_t)nxt.pm * tstep : cA; const char* nB = has_next ? (const char*)g.Bt + (size_t)nxt.pn * tstep : cB;
        for (int t = 0; t < nt; t += 2) {
            const bool last = (t == nt - 2);
            const char* a1 = cA + (size_t)(t + 1) * kstep;
            const char* a2 = last ? nA : cA + (size_t)(t + 2) * kstep; const char* b2 = last ? nB : cB + (size_t)(t + 2) * kstep;
            const char* a3 = a2 + kstep; const char* b3 = b2 + kstep;
            if (last && has_next) S.a_ready(nxt);
            PG8_LDB(B0, 0, 0); PG8_SCHED; PG8_LDA(At, 0, 0); PG8_STAGE(PG8_SA(1, 1), a1 + hstep, voffA);
            PG8_WAIT_L(8); PG8_BAR; PG8_WAIT_L(0); PG8_MMA(0, 0, At, B0); PG8_BAR; PG8_SCHED;
            PG8_LDB(B1, 0, 1); PG8_STAGE(PG8_SB(0, 0), b2, voffB);
            PG8_BAR; PG8_WAIT_L(0); PG8_MMA(0, 1, At, B1); PG8_BAR;
            PG8_LDA(At, 0, 1); PG8_STAGE(PG8_SA(0, 0), a2, voffA);
            PG8_BAR; PG8_WAIT_L(0); PG8_MMA(1, 0, At, B0); PG8_BAR; PG8_SCHED;
            PG8_STAGE(PG8_SB(0, 1), b2 + hstep, voffB);
            PG8_WAIT_V(6); PG8_BAR; PG8_MMA(1, 1, At, B1); PG8_BAR;
            PG8_LDB(B0, 1, 0); PG8_SCHED; PG8_LDA(At, 1, 0); PG8_STAGE(PG8_SA(0, 1), a2 + hstep, voffA);
            PG8_WAIT_L(8); PG8_BAR; PG8_WAIT_L(0); PG8_MMA(0, 0, At, B0); PG8_BAR; PG8_SCHED;
            PG8_LDB(B1, 1, 1); PG8_STAGE(PG8_SB(1, 0), b3, voffB);
            PG8_BAR; PG8_WAIT_L(0); PG8_MMA(0, 1, At, B1); PG8_BAR;
            PG8_LDA(At, 1, 1); PG8_STAGE(PG8_SA(1, 0), a3, voffA);
            PG8_BAR; PG8_WAIT_L(0); PG8_MMA(1, 0, At, B0); PG8_BAR; PG8_SCHED;
            PG8_STAGE(PG8_SB(1, 1), b3 + hstep, voffB);
            PG8_WAIT_V(6); PG8_BAR; PG8_MMA(1, 1, At, B1); PG8_BAR;
        }
        PG8_STAMP();
        if constexpr (!Epi::AFTER_DRAIN) { E(acc, cur, wr, wc, fr, fq); S.done(cur); }
        PG8_STAMP();
        if (!has_next) break;
#pragma unroll
        for (int a = 0; a < 2; ++a)
#pragma unroll
            for (int b = 0; b < 2; ++b)
#pragma unroll
                for (int m = 0; m < 4; ++m)
#pragma unroll
                    for (int n = 0; n < 2; ++n) acc[a][b][m][n] = (f32x4){0.f, 0.f, 0.f, 0.f};
        cur = nxt; cA = nA; cB = nB; ++ui;
    }
    PG8_WAIT_V(0);
    if (wr == 0) PG8_BAR;
    PG8_BAR;
    if constexpr (Epi::AFTER_DRAIN) { E.fused(acc, cur, wr, wc, fr, fq, lds, wid, lane); S.done(cur); }
    PG8_STAMP();
    if (STAMP && wid == 0) { stamps[lane] = lane < nts ? (((unsigned long long)(unsigned)ts_hi << 32) | (unsigned)ts_lo) : 0ull;
        if (lane == 62) stamps[62] = rt_entry; if (lane == 63) stamps[63] = (unsigned long long)wall_clock64(); }
#undef PG8_STAMP
#undef PG8_SA
#undef PG8_SB
#undef PG8_STAGE
#undef PG8_LDA
#undef PG8_LDB
#undef PG8_MMA
#undef PG8_WAIT_V
#undef PG8_WAIT_L
#undef PG8_BAR
#undef PG8_SCHED
}
}

namespace mk {
using pg8::bf16_t; using pg8::bf16x8; using pg8::f32x4; using pg8::u32x4; using pg8::Unit; using pg8::cvt_pk_bf16; using pg8::mfma_settle;
typedef unsigned u32x2 __attribute__((ext_vector_type(2)));
typedef float f32x2 __attribute__((ext_vector_type(2)));
constexpr int D = 2048, TL = 16384, TC = 256, MT = TL + TC, NCH = MT / 128;
constexpr int NPROJ = 10496, DFF = 5632;
constexpr size_t MiB = 1u << 20;
constexpr size_t WS_MVEC = 0, WS_CHD = 256 * 1024, WS_S5LOC = 1 * MiB, WS_WA = 10 * MiB, WS_WB = 75 * MiB, WS_HCTX = 141 * MiB, WS_XM = 143 * MiB, WS_SST = 208 * MiB, WS_BIG = 338 * MiB, WS_END = 766 * MiB;
constexpr size_t B_U5 = 0, B_XBC = B_U5 + (size_t)MT * 1024 * 2, B_Z = B_XBC + (size_t)MT * 3072 * 2, B_GATE = B_Z + (size_t)MT * 2048 * 2, B_DT = B_GATE + (size_t)MT * 4096 * 2,
                 B_Y5 = 330 * MiB, B_YD = B_Y5 + (size_t)MT * 1024 * 2;
static_assert(B_DT + (size_t)MT * 64 * 4 <= B_Y5 && B_YD + (size_t)MT * 2048 * 2 <= 428 * MiB, "big map");
constexpr size_t B_G = 0, B_V = (size_t)MT * DFF * 2;
constexpr size_t WA_IN = 0, WA_GLU = 41 * MiB, WA_S5P = 45 * MiB, WA_SSDP = 49 * MiB, WA_WOUT = 57 * MiB, WB_UP = 0, WB_DOWN = 44 * MiB;
constexpr int LDS_BYTES = 163840;
constexpr float ALPHA = 1.41421356237f, LN_EPS = 1e-5f, RMS_EPS = 1e-5f;

struct Args { const float* in[33]; float* out; unsigned char* ws; int ph_lo, ph_hi; };

__device__ __forceinline__ float bf2f(unsigned b) { return __uint_as_float(b << 16); }
__device__ __forceinline__ float bflo(unsigned w) { return __uint_as_float(w << 16); }
__device__ __forceinline__ float bfhi(unsigned w) { return __uint_as_float(w & 0xffff0000u); }
__device__ __forceinline__ float sigm(float x) { return 1.f / (1.f + __expf(-x)); }
__device__ __forceinline__ float silu_(float x) { return x / (1.f + __expf(-x)); }
__device__ __forceinline__ float gelu_tanh(float x) { const float u = 0.7978845608028654f * (x + 0.044715f * x * x * x); const float th = 1.f - 2.f / (__expf(2.f * u) + 1.f); return 0.5f * x * (1.f + th); }
__device__ __forceinline__ bf16x8 mkfrag(unsigned a, unsigned b, unsigned c, unsigned d) { u32x4 v; v.x = a; v.y = b; v.z = c; v.w = d; return __builtin_bit_cast(bf16x8, v); }
__device__ __forceinline__ float* hrow(const Args& a, int row) { return row < TL ? a.out + (size_t)row * D : (float*)(a.ws + WS_HCTX) + (size_t)(row - TL) * D; }
__device__ __forceinline__ const float* mvec(const Args& a, int layer, int isctx) { return (const float*)(a.ws + WS_MVEC) + (size_t)(layer * 2 + isctx) * 12288; }

struct EpiInProj {
    static constexpr bool PERM = true, AFTER_DRAIN = false;
    unsigned char* big; const float* dt_bias;
    __device__ __forceinline__ void operator()(const f32x4 (&acc)[2][2][4][2], const Unit& u, int wr, int wc, int fr, int fq) const {
        mfma_settle(acc[1][1][3][1]); mfma_settle(acc[1][1][3][0]);
        const int row0 = u.pm * 256 + wr * 64 + fr, ct = u.pn * 256;
        if (ct >= 10240) {
            if (wc < 2) { const int cc = wc * 32 + 8 * fq; float* DT = (float*)(big + B_DT);
                const f32x4 b0 = *(const f32x4*)(dt_bias + cc), b1 = *(const f32x4*)(dt_bias + cc + 4);
#pragma unroll
                for (int ai = 0; ai < 2; ++ai)
#pragma unroll
                    for (int m = 0; m < 4; ++m) { float* rp = DT + (size_t)(row0 + ai * 128 + m * 16) * 64 + cc; f32x4 v0 = acc[ai][0][m][0] + b0, v1 = acc[ai][0][m][1] + b1;
#pragma unroll
                        for (int j = 0; j < 4; ++j) { v0[j] = v0[j] > 20.f ? v0[j] : log1pf(expf(v0[j])); v1[j] = v1[j] > 20.f ? v1[j] : log1pf(expf(v1[j])); }
                        *(f32x4*)rp = v0; *(f32x4*)(rp + 4) = v1; } }
            return;
        }
        bf16_t* base; int ld, c0; bool sg = false;
        if (ct < 1024) { base = (bf16_t*)(big + B_U5); ld = 1024; c0 = ct; }
        else if (ct < 4096) { base = (bf16_t*)(big + B_XBC); ld = 3072; c0 = ct - 1024; }
        else if (ct < 6144) { base = (bf16_t*)(big + B_Z); ld = 2048; c0 = ct - 4096; }
        else { base = (bf16_t*)(big + B_GATE); ld = 4096; c0 = ct - 6144; sg = true; }
        const int col0 = c0 + wc * 32 + 8 * fq;
#pragma unroll
        for (int ai = 0; ai < 2; ++ai)
#pragma unroll
            for (int m = 0; m < 4; ++m) { bf16_t* rowp = base + (size_t)(row0 + ai * 128 + m * 16) * ld + col0;
#pragma unroll
                for (int bj = 0; bj < 2; ++bj) { f32x4 v0 = acc[ai][bj][m][0], v1 = acc[ai][bj][m][1];
                    if (sg) {
#pragma unroll
                        for (int j = 0; j < 4; ++j) { v0[j] = sigm(v0[j]); v1[j] = sigm(v1[j]); } }
                    u32x4 w; w.x = cvt_pk_bf16(v0[0], v0[1]); w.y = cvt_pk_bf16(v0[2], v0[3]); w.z = cvt_pk_bf16(v1[0], v1[1]); w.w = cvt_pk_bf16(v1[2], v1[3]);
                    *(u32x4*)(rowp + bj * 128) = w; } }
    }
};
struct EpiGlu {
    static constexpr bool PERM = true, AFTER_DRAIN = false;
    bf16_t* O;
    __device__ __forceinline__ void operator()(const f32x4 (&acc)[2][2][4][2], const Unit& u, int wr, int wc, int fr, int fq) const {
        mfma_settle(acc[1][1][3][1]); mfma_settle(acc[1][1][3][0]);
        const int row0 = u.pm * 256 + wr * 64 + fr, col0 = u.pn * 128 + wc * 32 + 8 * fq;
#pragma unroll
        for (int ai = 0; ai < 2; ++ai)
#pragma unroll
            for (int m = 0; m < 4; ++m) { f32x4 v0 = acc[ai][0][m][0], v1 = acc[ai][0][m][1]; const f32x4 g0 = acc[ai][1][m][0], g1 = acc[ai][1][m][1];
#pragma unroll
                for (int j = 0; j < 4; ++j) { v0[j] *= sigm(g0[j]); v1[j] *= sigm(g1[j]); }
                u32x4 w; w.x = cvt_pk_bf16(v0[0], v0[1]); w.y = cvt_pk_bf16(v0[2], v0[3]); w.z = cvt_pk_bf16(v1[0], v1[1]); w.w = cvt_pk_bf16(v1[2], v1[3]);
                *(u32x4*)(O + (size_t)(row0 + ai * 128 + m * 16) * 1024 + col0) = w; }
    }
};
template <int SECOND, int GSEL = SECOND> struct EpiMerge {
    static constexpr bool PERM = true, AFTER_DRAIN = false;
    bf16_t* MG; const bf16_t* GATE;
    __device__ __forceinline__ void operator()(const f32x4 (&acc)[2][2][4][2], const Unit& u, int wr, int wc, int fr, int fq) const {
        mfma_settle(acc[1][1][3][1]); mfma_settle(acc[1][1][3][0]);
        const int row0 = u.pm * 256 + wr * 64 + fr, col0 = u.pn * 256 + wc * 32 + 8 * fq;
#pragma unroll
        for (int ai = 0; ai < 2; ++ai)
#pragma unroll
            for (int m = 0; m < 4; ++m) { const size_t r = (size_t)(row0 + ai * 128 + m * 16);
#pragma unroll
                for (int bj = 0; bj < 2; ++bj) { const int c = col0 + bj * 128; const u32x4 g = *(const u32x4*)(GATE + r * 4096 + (GSEL ? 2048 : 0) + c);
                    f32x4 v0 = acc[ai][bj][m][0], v1 = acc[ai][bj][m][1];
                    v0[0] *= bflo(g.x); v0[1] *= bfhi(g.x); v0[2] *= bflo(g.y); v0[3] *= bfhi(g.y); v1[0] *= bflo(g.z); v1[1] *= bfhi(g.z); v1[2] *= bflo(g.w); v1[3] *= bfhi(g.w);
                    if (SECOND) { const u32x4 o = *(const u32x4*)(MG + r * 2048 + c);
                        v0[0] += bflo(o.x); v0[1] += bfhi(o.x); v0[2] += bflo(o.y); v0[3] += bfhi(o.y); v1[0] += bflo(o.z); v1[1] += bfhi(o.z); v1[2] += bflo(o.w); v1[3] += bfhi(o.w); }
                    u32x4 w; w.x = cvt_pk_bf16(v0[0], v0[1]); w.y = cvt_pk_bf16(v0[2], v0[3]); w.z = cvt_pk_bf16(v1[0], v1[1]); w.w = cvt_pk_bf16(v1[2], v1[3]);
                    *(u32x4*)(MG + r * 2048 + c) = w; } }
    }
};
struct EpiResid {
    static constexpr bool PERM = false, AFTER_DRAIN = false;
    float* out; float* hctx; const float* glat; const float* gctx;
    __device__ __forceinline__ void operator()(const f32x4 (&acc)[2][2][4][2], const Unit& u, int wr, int wc, int fr, int fq) const {
        mfma_settle(acc[1][1][3][1]); mfma_settle(acc[1][1][3][0]);
        const bool isctx = u.pm >= 64; const float* g = isctx ? gctx : glat;
        float* hb = isctx ? hctx + (size_t)(wr * 64 + fr) * D : out + (size_t)(u.pm * 256 + wr * 64 + fr) * D;
        const int col0 = u.pn * 256 + wc * 32 + 4 * fq;
        f32x4 gv[2][2];
#pragma unroll
        for (int bj = 0; bj < 2; ++bj)
#pragma unroll
            for (int n = 0; n < 2; ++n) gv[bj][n] = *(const f32x4*)(g + col0 + bj * 128 + n * 16);
#pragma unroll
        for (int ai = 0; ai < 2; ++ai)
#pragma unroll
            for (int m = 0; m < 4; ++m) { float* rowp = hb + (size_t)(ai * 128 + m * 16) * D + col0;
#pragma unroll
                for (int bj = 0; bj < 2; ++bj)
#pragma unroll
                    for (int n = 0; n < 2; ++n) { float* p = rowp + bj * 128 + n * 16; const f32x4 h = *(const f32x4*)p; *(f32x4*)p = h * ALPHA + gv[bj][n] * acc[ai][bj][m][n]; } }
    }
};
struct EpiUp {
    static constexpr bool PERM = true, AFTER_DRAIN = false;
    bf16_t* G; bf16_t* V;
    __device__ __forceinline__ void operator()(const f32x4 (&acc)[2][2][4][2], const Unit& u, int wr, int wc, int fr, int fq) const {
        mfma_settle(acc[1][1][3][1]); mfma_settle(acc[1][1][3][0]);
        const int row0 = u.pm * 256 + wr * 64 + fr; int ct = u.pn * 256; bf16_t* base = G; if (ct >= DFF) { base = V; ct -= DFF; }
        const int col0 = ct + wc * 32 + 8 * fq;
#pragma unroll
        for (int ai = 0; ai < 2; ++ai)
#pragma unroll
            for (int m = 0; m < 4; ++m) { bf16_t* rowp = base + (size_t)(row0 + ai * 128 + m * 16) * DFF + col0;
#pragma unroll
                for (int bj = 0; bj < 2; ++bj) { const f32x4 v0 = acc[ai][bj][m][0], v1 = acc[ai][bj][m][1];
                    u32x4 w; w.x = cvt_pk_bf16(v0[0], v0[1]); w.y = cvt_pk_bf16(v0[2], v0[3]); w.z = cvt_pk_bf16(v1[0], v1[1]); w.w = cvt_pk_bf16(v1[2], v1[3]);
                    *(u32x4*)(rowp + bj * 128) = w; } }
    }
};

__device__ __forceinline__ void xpose_item(const float* W, int K, int N, bf16_t* WT, int d0, int s0, int k0, float* scr, int lane) {
#pragma unroll
    for (int i = 0; i < 32; ++i) { const int kk = 2 * i + (lane >> 5); scr[kk * 33 + (lane & 31)] = s0 >= 0 ? W[(size_t)(k0 + kk) * N + s0 + (lane & 31)] : 0.f; }
    asm volatile("s_waitcnt lgkmcnt(0)" ::: "memory");
    const int c = lane & 7;
#pragma unroll
    for (int j = 0; j < 4; ++j) { const int n = (lane >> 3) + 8 * j; const float* s = scr + (8 * c) * 33 + n;
        u32x4 o; o.x = cvt_pk_bf16(s[0 * 33], s[1 * 33]); o.y = cvt_pk_bf16(s[2 * 33], s[3 * 33]); o.z = cvt_pk_bf16(s[4 * 33], s[5 * 33]); o.w = cvt_pk_bf16(s[6 * 33], s[7 * 33]);
        *(u32x4*)(WT + (size_t)(d0 + n) * K + k0 + 8 * c) = o; }
    asm volatile("s_waitcnt lgkmcnt(0)" ::: "memory");
}
__device__ __forceinline__ void xpose_region(const Args& a, int layer, int region, float* scr, int gw, int NGW, int lane) {
    if (region == 0) {
        const float* w_in = a.in[6] + (size_t)layer * 2048 * 10304; const float* w_glu = a.in[15] + (size_t)layer * 1024 * 2048; const float* w_s5p = a.in[16] + (size_t)layer * 1024 * 2048;
        const float* w_ssdp = a.in[23] + (size_t)layer * 2048 * 2048; const float* w_out = a.in[24] + (size_t)layer * 2048 * 2048;
        bf16_t* WA = (bf16_t*)(a.ws + WS_WA);
        constexpr int I_IN = 32 * 328, I_GLU = 16 * 64, I_S5P = 16 * 64, I_SSDP = 32 * 64, I_WOUT = 32 * 64, NI = I_IN + I_GLU + I_S5P + I_SSDP + I_WOUT;
        for (int it = gw; it < NI; it += NGW) { int r = it;
            if (r < I_IN) { const int kb = r / 328, d0 = (r % 328) * 32; int s0; if (d0 < 4096) s0 = d0; else if (d0 < 10240) s0 = d0 + 64; else if (d0 < 10304) s0 = d0 - 10240 + 4096; else s0 = -1;
                xpose_item(w_in, 2048, 10304, WA + WA_IN / 2, d0, s0, kb * 64, scr, lane); continue; } r -= I_IN;
            if (r < I_GLU) { const int kb = r / 64, d0 = (r % 64) * 32, t = d0 >> 8, j = d0 & 255; const int s0 = j < 128 ? t * 128 + j : 1024 + t * 128 + (j - 128);
                xpose_item(w_glu, 1024, 2048, WA + WA_GLU / 2, d0, s0, kb * 64, scr, lane); continue; } r -= I_GLU;
            if (r < I_S5P) { const int kb = r / 64, d0 = (r % 64) * 32; xpose_item(w_s5p, 1024, 2048, WA + WA_S5P / 2, d0, d0, kb * 64, scr, lane); continue; } r -= I_S5P;
            if (r < I_SSDP) { const int kb = r / 64, d0 = (r % 64) * 32; xpose_item(w_ssdp, 2048, 2048, WA + WA_SSDP / 2, d0, d0, kb * 64, scr, lane); continue; } r -= I_SSDP;
            { const int kb = r / 64, d0 = (r % 64) * 32; xpose_item(w_out, 2048, 2048, WA + WA_WOUT / 2, d0, d0, kb * 64, scr, lane); }
        }
    } else {
        const float* w_up = a.in[27] + (size_t)layer * 2048 * 11264; const float* w_down = a.in[30] + (size_t)layer * 5632 * 2048;
        bf16_t* WB = (bf16_t*)(a.ws + WS_WB);
        constexpr int I_UP = 32 * 352, I_DOWN = 88 * 64, NI = I_UP + I_DOWN;
        for (int it = gw; it < NI; it += NGW) { int r = it;
            if (r < I_UP) { const int kb = r / 352, d0 = (r % 352) * 32; xpose_item(w_up, 2048, 11264, WB + WB_UP / 2, d0, d0, kb * 64, scr, lane); continue; } r -= I_UP;
            { const int kb = r / 64, d0 = (r % 64) * 32; xpose_item(w_down, 5632, 2048, WB + WB_DOWN / 2, d0, d0, kb * 64, scr, lane); }
        }
    }
}

__device__ __forceinline__ void adaln_phase(const Args& a, float* lds, int tid) {
    float* sc = lds; float* scx = lds + 2048; float* red = lds + 4096;
    for (int i = tid; i < 2048; i += 512) { sc[i] = silu_(a.in[1][i]); scx[i] = silu_(a.in[3][i]); }
    __syncthreads();
    for (int unit = blockIdx.x; unit < 256; unit += gridDim.x) {
        const int layer = unit >> 7, col0 = (unit & 127) * 96;
        const float* W = a.in[4] + (size_t)layer * 2048 * 12288 + col0;
        if (tid < 504) { const int cq = tid % 24, ks = tid / 24; f32x4 al = {0.f, 0.f, 0.f, 0.f}, ac = {0.f, 0.f, 0.f, 0.f};
#pragma unroll 7
            for (int k = ks; k < 2048; k += 21) { const f32x4 w = *(const f32x4*)(W + (size_t)k * 12288 + cq * 4); al += w * sc[k]; ac += w * scx[k]; }
            *(f32x4*)(red + (ks * 2 + 0) * 96 + cq * 4) = al; *(f32x4*)(red + (ks * 2 + 1) * 96 + cq * 4) = ac; }
        __syncthreads();
        if (tid < 192) { const int v = tid / 96, c = tid % 96; float s = 0.f; for (int ks = 0; ks < 21; ++ks) s += red[(ks * 2 + v) * 96 + c];
            ((float*)(a.ws + WS_MVEC))[(size_t)(layer * 2 + v) * 12288 + col0 + c] = s + a.in[5][(size_t)layer * 12288 + col0 + c]; }
        __syncthreads();
    }
}

__device__ __forceinline__ float wave_sum(float v) {
#pragma unroll
    for (int o = 1; o < 64; o <<= 1) v += __shfl_xor(v, o);
    return v;
}
template <int MODE> __device__ __forceinline__ void row_phase(const Args& a, int nrows, const float* lng, const float* lnb, int mod_layer, int mod_off, int gw, int NGW, int lane) {
    bf16_t* XM = (bf16_t*)(a.ws + WS_XM);
    for (int row = gw; row < nrows; row += NGW) {
        const int isctx = row >= TL; float* h = hrow(a, row);
        const float* src = MODE == 0 ? (isctx ? a.in[2] + (size_t)(row - TL) * D : a.in[0] + (size_t)row * D) : h;
        f32x4 v[8];
#pragma unroll
        for (int j = 0; j < 8; ++j) v[j] = *(const f32x4*)(src + 4 * lane + 256 * j);
        if (MODE == 1) {
            float s = 0.f;
#pragma unroll
            for (int j = 0; j < 8; ++j) s += (v[j][0] + v[j][1]) + (v[j][2] + v[j][3]);
            const float mean = wave_sum(s) * (1.f / D); float q = 0.f;
#pragma unroll
            for (int j = 0; j < 8; ++j) { v[j] = v[j] - mean; q += (v[j][0] * v[j][0] + v[j][1] * v[j][1]) + (v[j][2] * v[j][2] + v[j][3] * v[j][3]); }
            const float rstd = 1.f / sqrtf(wave_sum(q) * (1.f / D) + LN_EPS);
#pragma unroll
            for (int j = 0; j < 8; ++j) { const f32x4 g = *(const f32x4*)(lng + 4 * lane + 256 * j), b = *(const f32x4*)(lnb + 4 * lane + 256 * j); v[j] = v[j] * rstd * g + b; }
        }
#ifdef MK_SANITIZE
#pragma unroll
        for (int j = 0; j < 8; ++j)
#pragma unroll
            for (int e = 0; e < 4; ++e) if (!(fabsf(v[j][e]) < 1e30f)) v[j][e] = 0.f;
#endif
#pragma unroll
        for (int j = 0; j < 8; ++j) *(f32x4*)(h + 4 * lane + 256 * j) = v[j];
        if (mod_layer >= 0) { const float* m = mvec(a, mod_layer, isctx) + mod_off;
#pragma unroll
            for (int j = 0; j < 8; ++j) { const f32x4 sh = *(const f32x4*)(m + 4 * lane + 256 * j), scl = *(const f32x4*)(m + D + 4 * lane + 256 * j); const f32x4 o = v[j] * (scl + 1.f) + sh;
                u32x2 w; w.x = cvt_pk_bf16(o[0], o[1]); w.y = cvt_pk_bf16(o[2], o[3]); *(u32x2*)(XM + (size_t)row * D + 4 * lane + 256 * j) = w; } }
    }
}

__device__ __forceinline__ void ffnconv_phase(const Args& a, int layer, bool with_ctx, int tid) {
    const bf16_t* G = (const bf16_t*)(a.ws + WS_BIG + B_G); bf16_t* V = (bf16_t*)(a.ws + WS_BIG + B_V);
    const float* cw = a.in[28] + (size_t)layer * 9 * DFF; const float* cb = a.in[29] + (size_t)layer * DFF;
    const int nunits = (with_ctx ? 260 : 256) * 11; const int oc = tid & 63, xs = tid >> 6;
    for (int unit = blockIdx.x; unit < nunits; unit += gridDim.x) {
        const int seg = unit / 11, ob = unit % 11, ch0 = ob * 512 + oc * 8; const bool cs = seg >= 256; const int t0 = seg * 64;
        float w[9][8], bias[8];
#pragma unroll
        for (int k = 0; k < 9; ++k) { const f32x4 w0 = *(const f32x4*)(cw + (size_t)k * DFF + ch0), w1 = *(const f32x4*)(cw + (size_t)k * DFF + ch0 + 4);
            w[k][0] = w0[0]; w[k][1] = w0[1]; w[k][2] = w0[2]; w[k][3] = w0[3]; w[k][4] = w1[0]; w[k][5] = w1[1]; w[k][6] = w1[2]; w[k][7] = w1[3]; }
        { const f32x4 b0 = *(const f32x4*)(cb + ch0), b1 = *(const f32x4*)(cb + ch0 + 4); bias[0] = b0[0]; bias[1] = b0[1]; bias[2] = b0[2]; bias[3] = b0[3]; bias[4] = b1[0]; bias[5] = b1[1]; bias[6] = b1[2]; bias[7] = b1[3]; }
#pragma unroll 2
        for (int xi = 0; xi < 8; ++xi) { const int x = xs * 8 + xi, t = t0 + x; float acc[8];
#pragma unroll
            for (int k = 0; k < 8; ++k) acc[k] = bias[k];
#pragma unroll
            for (int dy = -1; dy <= 1; ++dy) { bool rok = cs ? (dy == 0) : ((dy < 0 ? seg > 0 : true) && (dy > 0 ? seg < 255 : true));
#pragma unroll
                for (int dx = -1; dx <= 1; ++dx) { const bool ok = rok && (cs ? (t + dx >= TL && t + dx < MT) : (x + dx >= 0 && x + dx < 64));
                    if (ok) { const u32x4 g = *(const u32x4*)(G + (size_t)(t + dy * 64 + dx) * DFF + ch0); const int k = (dy + 1) * 3 + dx + 1;
                        acc[0] += w[k][0] * bflo(g.x); acc[1] += w[k][1] * bfhi(g.x); acc[2] += w[k][2] * bflo(g.y); acc[3] += w[k][3] * bfhi(g.y);
                        acc[4] += w[k][4] * bflo(g.z); acc[5] += w[k][5] * bfhi(g.z); acc[6] += w[k][6] * bflo(g.w); acc[7] += w[k][7] * bfhi(g.w); } } }
            bf16_t* vp = V + (size_t)t * DFF + ch0; const u32x4 vv = *(const u32x4*)vp;
            u32x4 o; o.x = cvt_pk_bf16(silu_(acc[0]) * bflo(vv.x), silu_(acc[1]) * bfhi(vv.x)); o.y = cvt_pk_bf16(silu_(acc[2]) * bflo(vv.y), silu_(acc[3]) * bfhi(vv.y));
            o.z = cvt_pk_bf16(silu_(acc[4]) * bflo(vv.z), silu_(acc[5]) * bfhi(vv.z)); o.w = cvt_pk_bf16(silu_(acc[6]) * bflo(vv.w), silu_(acc[7]) * bfhi(vv.w));
            *(u32x4*)vp = o; }
    }
}

__device__ __forceinline__ int s5_chunk_at(int dir, int q) { return dir ? 129 - q : (q + 128) % 130; }
__device__ __forceinline__ int s5_pos_of(int dir, int c) { return dir ? 129 - c : (c + 2) % 130; }
template <int PASS> __device__ __forceinline__ void s5_phase(const Args& a, int layer, unsigned char* lds, int tid, int nchunks) {
    float* uL = (float*)lds;
    float* YL = (float*)(lds + 32768);
    bf16_t* ST = (bf16_t*)(lds + 65536);
    const bf16_t* U5 = (const bf16_t*)(a.ws + WS_BIG + B_U5); bf16_t* Y5 = (bf16_t*)(a.ws + WS_BIG + B_Y5);
    float2* S5LOC = (float2*)(a.ws + WS_S5LOC);
    const int lane = tid & 63, w = tid >> 6, gl = tid >> 7, dir = (tid >> 6) & 1, p = tid & 63, fr = lane & 15, fq = lane >> 4;
    int cur_gq = -1; float ab_re = 0.f, ab_im = 0.f, a128r = 0.f, a128i = 0.f; float bbr[16], bbi[16]; bf16x8 cm[4];
    for (int unit = blockIdx.x; unit < 16 * nchunks; unit += gridDim.x) {
        const int gq = unit / nchunks, c = unit % nchunks, g = gq * 4 + gl, row0 = c * 128;
        if (gq != cur_gq) { cur_gq = gq;
            const size_t pi = ((size_t)(layer * 2 + dir) * 64 + g) * 64 + p;
            const float lre = fminf(a.in[7][pi], -1e-4f), lim = a.in[8][pi], step = expf(a.in[9][(size_t)(layer * 2 + dir) * 64 + g]);
            const float mag = expf(lre * step); float sn, cs; sincosf(lim * step, &sn, &cs); ab_re = mag * cs; ab_im = mag * sn;
            const float den = lre * lre + lim * lim, q_re = ((ab_re - 1.f) * lre + ab_im * lim) / den, q_im = (ab_im * lre - (ab_re - 1.f) * lim) / den;
            const float* br = a.in[10] + (((size_t)layer * 64 + g) * 64 + p) * 16; const float* bi = a.in[11] + (((size_t)layer * 64 + g) * 64 + p) * 16;
#pragma unroll
            for (int j = 0; j < 16; ++j) { const float r = br[j], i = bi[j]; bbr[j] = q_re * r - q_im * i; bbi[j] = q_re * i + q_im * r; }
            a128r = ab_re; a128i = ab_im;
#pragma unroll
            for (int k = 0; k < 7; ++k) { const float r = a128r * a128r - a128i * a128i, i = 2.f * a128r * a128i; a128r = r; a128i = i; }
            if (PASS == 1) {
                const float* cre = a.in[12] + (((size_t)(layer * 2 + dir) * 64 + g) * 16 + fr) * 64; const float* cim = a.in[13] + (((size_t)(layer * 2 + dir) * 64 + g) * 16 + fr) * 64;
#pragma unroll
                for (int ks = 0; ks < 4; ++ks) { const float* s = (ks < 2 ? cre : cim) + (ks & 1) * 32 + fq * 8; const float sg = ks < 2 ? 1.f : -1.f;
                    const f32x4 v0 = *(const f32x4*)s, v1 = *(const f32x4*)(s + 4);
                    cm[ks] = mkfrag(cvt_pk_bf16(sg * v0[0], sg * v0[1]), cvt_pk_bf16(sg * v0[2], sg * v0[3]), cvt_pk_bf16(sg * v1[0], sg * v1[1]), cvt_pk_bf16(sg * v1[2], sg * v1[3])); }
            }
        }
        __syncthreads();
        { const int t = tid >> 2, q = tid & 3; const bf16_t* s = U5 + (size_t)(row0 + t) * 1024 + gq * 64 + q * 16; const u32x4 v0 = *(const u32x4*)s, v1 = *(const u32x4*)(s + 8);
            float* d = uL + t * 64 + q * 16;
            *(f32x4*)d = (f32x4){bflo(v0.x), bfhi(v0.x), bflo(v0.y), bfhi(v0.y)}; *(f32x4*)(d + 4) = (f32x4){bflo(v0.z), bfhi(v0.z), bflo(v0.w), bfhi(v0.w)};
            *(f32x4*)(d + 8) = (f32x4){bflo(v1.x), bfhi(v1.x), bflo(v1.y), bfhi(v1.y)}; *(f32x4*)(d + 12) = (f32x4){bflo(v1.z), bfhi(v1.z), bflo(v1.w), bfhi(v1.w)};
            if (PASS == 1) { float* y = YL + q * 2048 + t * 16;
#pragma unroll
                for (int j = 0; j < 4; ++j) *(f32x4*)(y + 4 * j) = (f32x4){0.f, 0.f, 0.f, 0.f}; } }
        float sr = 0.f, si = 0.f;
        if (PASS == 1) {
            const int pos = s5_pos_of(dir, c);
#pragma unroll 1
            for (int q0 = 0; q0 < pos; q0 += 13) { float2 l[13];
#pragma unroll
                for (int i = 0; i < 13; ++i) { const int q = q0 + i < pos ? q0 + i : pos - 1; l[i] = S5LOC[((size_t)(dir * NCH + s5_chunk_at(dir, q)) * 64 + g) * 64 + p]; }
#pragma unroll
                for (int i = 0; i < 13; ++i) if (q0 + i < pos) { const float nr = a128r * sr - a128i * si + l[i].x, ni = a128r * si + a128i * sr + l[i].y; sr = nr; si = ni; } }
        }
        __syncthreads();
#pragma unroll 1
        for (int stp = 0; stp < 4; ++stp) {
#pragma unroll 4
            for (int ii = 0; ii < 32; ++ii) { const int i = stp * 32 + ii, t = dir ? 127 - i : i; const float* ut = uL + t * 64 + gl * 16;
                const f32x4 u0 = *(const f32x4*)ut, u1 = *(const f32x4*)(ut + 4), u2 = *(const f32x4*)(ut + 8), u3 = *(const f32x4*)(ut + 12);
                f32x2 b0 = {0.f, 0.f}, b1 = {0.f, 0.f};
#pragma unroll
                for (int j = 0; j < 4; ++j) { b0 = __builtin_elementwise_fma((f32x2){bbr[j], bbi[j]}, (f32x2){u0[j], u0[j]}, b0); b1 = __builtin_elementwise_fma((f32x2){bbr[4 + j], bbi[4 + j]}, (f32x2){u1[j], u1[j]}, b1);
                    b0 = __builtin_elementwise_fma((f32x2){bbr[8 + j], bbi[8 + j]}, (f32x2){u2[j], u2[j]}, b0); b1 = __builtin_elementwise_fma((f32x2){bbr[12 + j], bbi[12 + j]}, (f32x2){u3[j], u3[j]}, b1); }
                f32x2 ns = b0 + b1; ns = __builtin_elementwise_fma((f32x2){ab_re, ab_re}, (f32x2){sr, si}, ns); ns = __builtin_elementwise_fma((f32x2){-ab_im, ab_im}, (f32x2){si, sr}, ns); sr = ns[0]; si = ns[1];
                if (PASS == 1) { bf16_t* st = ST + ((size_t)(dir * 4 + gl) * 32 + (t & 31)) * 136; st[p] = (bf16_t)(cvt_pk_bf16(sr, 0.f) & 0xffffu); st[64 + p] = (bf16_t)(cvt_pk_bf16(si, 0.f) & 0xffffu); }
            }
            if (PASS == 1) {
                asm volatile("s_waitcnt lgkmcnt(0)" ::: "memory");
                const int tb = (dir ? 3 - stp : stp) * 32;
#pragma unroll
                for (int rt = 0; rt < 2; ++rt) { f32x4 acc = {0.f, 0.f, 0.f, 0.f};
#pragma unroll
                    for (int ks = 0; ks < 4; ++ks) { const bf16x8 af = *(const bf16x8*)(ST + ((size_t)(dir * 4 + gl) * 32 + rt * 16 + fr) * 136 + ks * 32 + fq * 8); acc = __builtin_amdgcn_mfma_f32_16x16x32_bf16(af, cm[ks], acc, 0, 0, 0); }
#pragma unroll
                    for (int jj = 0; jj < 4; ++jj) YL[gl * 2048 + (tb + rt * 16 + fq * 4 + jj) * 16 + fr] += acc[jj]; }
                __syncthreads();
            }
        }
        if (PASS == 0) { S5LOC[((size_t)(dir * NCH + c) * 64 + g) * 64 + p] = make_float2(sr, si); }
        else { const int t = tid >> 2, q = tid & 3; const float* y = YL + q * 2048 + t * 16; const float* u = uL + t * 64 + q * 16; const float* dd = a.in[14] + (size_t)layer * 1024 + gq * 64 + q * 16;
            unsigned o[8];
#pragma unroll
            for (int j = 0; j < 8; ++j) { const float y0 = y[2 * j] + u[2 * j] * dd[2 * j], y1 = y[2 * j + 1] + u[2 * j + 1] * dd[2 * j + 1]; o[j] = cvt_pk_bf16(gelu_tanh(y0), gelu_tanh(y1)); }
            bf16_t* dst = Y5 + (size_t)(row0 + t) * 1024 + gq * 64 + q * 16; u32x4 o0, o1; o0.x = o[0]; o0.y = o[1]; o0.z = o[2]; o0.w = o[3]; o1.x = o[4]; o1.y = o[5]; o1.z = o[6]; o1.w = o[7];
            *(u32x4*)dst = o0; *(u32x4*)(dst + 8) = o1; }
    }
    __syncthreads();
}

__device__ __forceinline__ int ssd_chunk_at(int dir, int q) { return s5_chunk_at(dir, q); }
__device__ __forceinline__ void conv8(const bf16_t* XBC, int rowbase, int l0, int ch, bool lo_ok, bool hi_ok, float w0, float w1, float w2, float b, float (&out)[8]) {
    float r[10];
#pragma unroll
    for (int i = 0; i < 10; ++i) { const int l = l0 - 1 + i; const bool ok = (l >= 0 || lo_ok) && (l < 128 || hi_ok); r[i] = ok ? bf2f((unsigned)XBC[(size_t)(rowbase + l) * 3072 + ch]) : 0.f; }
#pragma unroll
    for (int j = 0; j < 8; ++j) out[j] = silu_(w0 * r[j] + w1 * r[j + 1] + w2 * r[j + 2] + b);
}
__device__ __forceinline__ void stage_conv_tile(const bf16_t* XBC, const float* cw, const float* cb, int rowbase, int chbase, bool lo_ok, bool hi_ok, bf16_t* dst, int tid) {
    const int oc = tid & 15, ch = chbase + oc * 8; float w[3][8], b[8];
#pragma unroll
    for (int k = 0; k < 3; ++k) { const f32x4 a0 = *(const f32x4*)(cw + (size_t)k * 3072 + ch), a1 = *(const f32x4*)(cw + (size_t)k * 3072 + ch + 4);
        w[k][0] = a0[0]; w[k][1] = a0[1]; w[k][2] = a0[2]; w[k][3] = a0[3]; w[k][4] = a1[0]; w[k][5] = a1[1]; w[k][6] = a1[2]; w[k][7] = a1[3]; }
    { const f32x4 a0 = *(const f32x4*)(cb + ch), a1 = *(const f32x4*)(cb + ch + 4); b[0] = a0[0]; b[1] = a0[1]; b[2] = a0[2]; b[3] = a0[3]; b[4] = a1[0]; b[5] = a1[1]; b[6] = a1[2]; b[7] = a1[3]; }
#pragma unroll
    for (int i = 0; i < 4; ++i) { const int row = (tid >> 4) + i * 32; float acc[8];
#pragma unroll
        for (int k = 0; k < 8; ++k) acc[k] = b[k];
#pragma unroll
        for (int d = 0; d < 3; ++d) { const int l = row + d - 1; const bool ok = (l >= 0 || lo_ok) && (l < 128 || hi_ok);
            if (ok) { const u32x4 g = *(const u32x4*)(XBC + (size_t)(rowbase + l) * 3072 + ch);
                acc[0] += w[d][0] * bflo(g.x); acc[1] += w[d][1] * bfhi(g.x); acc[2] += w[d][2] * bflo(g.y); acc[3] += w[d][3] * bfhi(g.y);
                acc[4] += w[d][4] * bflo(g.z); acc[5] += w[d][5] * bfhi(g.z); acc[6] += w[d][6] * bflo(g.w); acc[7] += w[d][7] * bfhi(g.w); } }
        u32x4 o; o.x = cvt_pk_bf16(silu_(acc[0]), silu_(acc[1])); o.y = cvt_pk_bf16(silu_(acc[2]), silu_(acc[3])); o.z = cvt_pk_bf16(silu_(acc[4]), silu_(acc[5])); o.w = cvt_pk_bf16(silu_(acc[6]), silu_(acc[7]));
        *(u32x4*)(dst + row * 136 + oc * 8) = o; }
}
constexpr int SL_CS = 0, SL_CB = 34816, SL_CUM = 69632, SL_DT = 77824, SL_PART = 86016, SL_BS = 94208, SL_XF = 94208;
template <int AUX> __device__ __forceinline__ void ssd_cum(const Args& a, int layer, int c, int h, int w, int lane, unsigned char* lds) {
    const float* DT = (const float*)(a.ws + WS_BIG + B_DT); float* cumL = (float*)(lds + SL_CUM); float* dtL = (float*)(lds + SL_DT); float* CHD = (float*)(a.ws + WS_CHD);
#pragma unroll
    for (int dir = 0; dir < 2; ++dir) {
        const float ah = -expf(a.in[20][(size_t)(layer * 2 + dir) * 32 + h]);
        const float d0 = DT[(size_t)(c * 128 + 2 * lane) * 64 + dir * 32 + h], d1 = DT[(size_t)(c * 128 + 2 * lane + 1) * 64 + dir * 32 + h];
        const float l0 = d0 * ah, l1 = d1 * ah, s = l0 + l1; float incl = s;
#pragma unroll
        for (int o = 1; o < 64; o <<= 1) { const float t = __shfl_up(incl, o); if (lane >= o) incl += t; }
        const float excl = incl - s, tot = __shfl(incl, 63);
        float c0, c1;
        if (dir == 0) { c0 = excl + l0; c1 = incl; } else { c0 = tot - excl; c1 = tot - (excl + l0); }
        float* cu = cumL + (dir * 8 + w) * 128 + 2 * lane; cu[0] = c0; cu[1] = c1;
        float* dd = dtL + (dir * 8 + w) * 128 + 2 * lane;
        if (AUX == 0) { dd[0] = d0; dd[1] = d1; } else { dd[0] = d0 * __expf(tot - c0); dd[1] = d1 * __expf(tot - c1); if (lane == 0) CHD[(size_t)(dir * NCH + c) * 32 + h] = tot; }
    }
}
__device__ __forceinline__ void ssd_a_phase(const Args& a, int layer, unsigned char* lds, int tid) {
    const bf16_t* XBC = (const bf16_t*)(a.ws + WS_BIG + B_XBC); bf16_t* SST = (bf16_t*)(a.ws + WS_SST);
    const float* cw = a.in[17] + (size_t)layer * 3 * 3072; const float* cb = a.in[18] + (size_t)layer * 3072;
    bf16_t* Bs = (bf16_t*)(lds + SL_BS); const float* wL = (const float*)(lds + SL_DT);
    const int lane = tid & 63, w = tid >> 6, fr = lane & 15, fq = lane >> 4;
    for (int unit = blockIdx.x; unit < NCH * 4; unit += gridDim.x) {
        const int c = unit >> 2, g = unit & 3, rowbase = c * 128, h = g * 8 + w; const bool lo_ok = !(c == 0 || c == 128), hi_ok = !(c == 127 || c == 129);
        __syncthreads();
        stage_conv_tile(XBC, cw, cb, rowbase, 2048 + g * 128, lo_ok, hi_ok, Bs, tid);
        ssd_cum<1>(a, layer, c, h, w, lane, lds);
        __syncthreads();
#pragma unroll 1
        for (int dir = 0; dir < 2; ++dir) {
            bf16_t* sb = SST + (((size_t)(dir * NCH + c) * 32 + h) * 64) * 128;
#pragma unroll 1
            for (int pt = 0; pt < 4; ++pt) {
                const int ch = h * 64 + pt * 16 + fr; const float w0 = cw[ch], w1 = cw[3072 + ch], w2 = cw[6144 + ch], bb = cb[ch];
                f32x4 acc[8];
#pragma unroll
                for (int nt = 0; nt < 8; ++nt) acc[nt] = (f32x4){0.f, 0.f, 0.f, 0.f};
#pragma unroll 2
                for (int ks = 0; ks < 4; ++ks) {
                    const float* wp = wL + (dir * 8 + w) * 128 + ks * 32 + fq * 8; const f32x4 wl0 = *(const f32x4*)wp, wl1 = *(const f32x4*)(wp + 4);
                    float x[8]; conv8(XBC, rowbase, ks * 32 + fq * 8, ch, lo_ok, hi_ok, w0, w1, w2, bb, x);
                    const bf16x8 yf = mkfrag(cvt_pk_bf16(x[0] * wl0[0], x[1] * wl0[1]), cvt_pk_bf16(x[2] * wl0[2], x[3] * wl0[3]), cvt_pk_bf16(x[4] * wl1[0], x[5] * wl1[1]), cvt_pk_bf16(x[6] * wl1[2], x[7] * wl1[3]));
#pragma unroll
                    for (int nt = 0; nt < 8; ++nt) { const bf16_t* bp = Bs + (ks * 32 + fq * 8) * 136 + nt * 16 + fr;
                        const bf16x8 xf = mkfrag((unsigned)bp[0] | ((unsigned)bp[136] << 16), (unsigned)bp[2 * 136] | ((unsigned)bp[3 * 136] << 16), (unsigned)bp[4 * 136] | ((unsigned)bp[5 * 136] << 16), (unsigned)bp[6 * 136] | ((unsigned)bp[7 * 136] << 16));
                        acc[nt] = __builtin_amdgcn_mfma_f32_16x16x32_bf16(xf, yf, acc[nt], 0, 0, 0); }
                }
                mfma_settle(acc[7]); mfma_settle(acc[6]);
#pragma unroll
                for (int nt = 0; nt < 8; ++nt) { u32x2 o; o.x = cvt_pk_bf16(acc[nt][0], acc[nt][1]); o.y = cvt_pk_bf16(acc[nt][2], acc[nt][3]);
                    *(u32x2*)(sb + (size_t)(pt * 16 + fr) * 128 + nt * 16 + fq * 4) = o; }
            }
        }
    }
    __syncthreads();
}
__device__ __forceinline__ void ssd_b_phase(const Args& a, int tid) {
    bf16_t* SST = (bf16_t*)(a.ws + WS_SST); const float* CHD = (const float*)(a.ws + WS_CHD);
    for (int idx = blockIdx.x * 512 + tid; idx < 64 * 2048; idx += gridDim.x * 512) {
        const int e4 = idx & 2047, hd = idx >> 11, dir = hd >> 5, h = hd & 31; float s0 = 0.f, s1 = 0.f, s2 = 0.f, s3 = 0.f;
#pragma unroll 1
        for (int b = 0; b < 13; ++b) { u32x2 loc[10]; float dc[10];
#pragma unroll
            for (int i = 0; i < 10; ++i) { const int cq = ssd_chunk_at(dir, b * 10 + i); loc[i] = *(const u32x2*)(SST + ((size_t)(dir * NCH + cq) * 32 + h) * 8192 + e4 * 4); dc[i] = CHD[(size_t)(dir * NCH + cq) * 32 + h]; }
#pragma unroll
            for (int i = 0; i < 10; ++i) { const int cq = ssd_chunk_at(dir, b * 10 + i); u32x2 o; o.x = cvt_pk_bf16(s0, s1); o.y = cvt_pk_bf16(s2, s3);
                *(u32x2*)(SST + ((size_t)(dir * NCH + cq) * 32 + h) * 8192 + e4 * 4) = o; const float e = __expf(dc[i]);
                s0 = e * s0 + bflo(loc[i].x); s1 = e * s1 + bfhi(loc[i].x); s2 = e * s2 + bflo(loc[i].y); s3 = e * s3 + bfhi(loc[i].y); }
        }
    }
}
__device__ __forceinline__ void ssd_c_phase(const Args& a, int layer, unsigned char* lds, int tid, int nchunks) {
    const bf16_t* XBC = (const bf16_t*)(a.ws + WS_BIG + B_XBC); const bf16_t* SST = (const bf16_t*)(a.ws + WS_SST); const bf16_t* Z = (const bf16_t*)(a.ws + WS_BIG + B_Z); bf16_t* YD = (bf16_t*)(a.ws + WS_BIG + B_YD);
    const float* cw = a.in[17] + (size_t)layer * 3 * 3072; const float* cb = a.in[18] + (size_t)layer * 3072; const float* normw = a.in[22] + (size_t)layer * 2048;
    bf16_t* Cs = (bf16_t*)(lds + SL_CS); bf16_t* Bs = (bf16_t*)(lds + SL_BS); bf16_t* CBs = (bf16_t*)(lds + SL_CB); const float* cumL = (const float*)(lds + SL_CUM); const float* dtL = (const float*)(lds + SL_DT); float* part = (float*)(lds + SL_PART);
    const int lane = tid & 63, w = tid >> 6, fr = lane & 15, fq = lane >> 4;
    for (int unit = blockIdx.x; unit < nchunks * 4; unit += gridDim.x) {
        const int c = unit >> 2, g = unit & 3, rowbase = c * 128, h = g * 8 + w; const bool lo_ok = !(c == 0 || c == 128), hi_ok = !(c == 127 || c == 129);
        const float Dh = a.in[21][(size_t)layer * 32 + h];
        __syncthreads();
        stage_conv_tile(XBC, cw, cb, rowbase, 2560 + g * 128, lo_ok, hi_ok, Cs, tid);
        stage_conv_tile(XBC, cw, cb, rowbase, 2048 + g * 128, lo_ok, hi_ok, Bs, tid);
        ssd_cum<0>(a, layer, c, h, w, lane, lds);
        __syncthreads();
#pragma unroll 1
        for (int st = 0; st < 8; ++st) { f32x4 acc = {0.f, 0.f, 0.f, 0.f};
#pragma unroll
            for (int ks = 0; ks < 4; ++ks) { const bf16x8 xf = *(const bf16x8*)(Bs + (st * 16 + fr) * 136 + ks * 32 + fq * 8), yf = *(const bf16x8*)(Cs + (w * 16 + fr) * 136 + ks * 32 + fq * 8);
                acc = __builtin_amdgcn_mfma_f32_16x16x32_bf16(xf, yf, acc, 0, 0, 0); }
            mfma_settle(acc);
            u32x2 o; o.x = cvt_pk_bf16(acc[0], acc[1]); o.y = cvt_pk_bf16(acc[2], acc[3]); *(u32x2*)(CBs + (w * 16 + fr) * 136 + st * 16 + fq * 4) = o; }
        __syncthreads();
#pragma unroll 1
        for (int hp = 0; hp < 2; ++hp) {
        bf16_t* XFw = (bf16_t*)(lds + SL_XF) + (size_t)w * 4096;
#pragma unroll 1
        for (int f = 0; f < 8; ++f) { const int p2 = f & 1, ks = f >> 1; const int ch = h * 64 + (hp * 2 + p2) * 16 + fr; const float w0 = cw[ch], w1 = cw[3072 + ch], w2 = cw[6144 + ch], bb = cb[ch];
            float x[8]; conv8(XBC, rowbase, ks * 32 + fq * 8, ch, lo_ok, hi_ok, w0, w1, w2, bb, x);
            *(bf16x8*)(XFw + (f * 64 + lane) * 8) = mkfrag(cvt_pk_bf16(x[0], x[1]), cvt_pk_bf16(x[2], x[3]), cvt_pk_bf16(x[4], x[5]), cvt_pk_bf16(x[6], x[7])); }
        asm volatile("s_waitcnt lgkmcnt(0)" ::: "memory");
#pragma unroll 1
        for (int lt = 0; lt < 8; ++lt) {
            const int l = lt * 16 + fr; f32x4 acc[2];
#pragma unroll
            for (int p2 = 0; p2 < 2; ++p2) acc[p2] = (f32x4){0.f, 0.f, 0.f, 0.f};
#pragma unroll
            for (int dir = 0; dir < 2; ++dir) {
                f32x4 tmp[2];
#pragma unroll
                for (int p2 = 0; p2 < 2; ++p2) tmp[p2] = (f32x4){0.f, 0.f, 0.f, 0.f};
                const bf16_t* sb = SST + (((size_t)(dir * NCH + c) * 32 + h) * 64) * 128;
#pragma unroll
                for (int ks = 0; ks < 4; ++ks) { const bf16x8 yf = *(const bf16x8*)(Cs + l * 136 + ks * 32 + fq * 8);
#pragma unroll
                    for (int p2 = 0; p2 < 2; ++p2) { const bf16x8 sf = *(const bf16x8*)(sb + (size_t)((hp * 2 + p2) * 16 + fr) * 128 + ks * 32 + fq * 8); tmp[p2] = __builtin_amdgcn_mfma_f32_16x16x32_bf16(sf, yf, tmp[p2], 0, 0, 0); } }
                __builtin_amdgcn_sched_barrier(0);
                const float cl = cumL[(dir * 8 + w) * 128 + l], el = __expf(cl);
#pragma unroll
                for (int p2 = 0; p2 < 2; ++p2) acc[p2] += tmp[p2] * el;
#pragma unroll
                for (int ks = 0; ks < 4; ++ks) { const int s0 = ks * 32;
                    const bool skip = dir == 0 ? (s0 > lt * 16 + 15) : (s0 + 31 < lt * 16);
                    if (!skip) { const u32x4 cbv = *(const u32x4*)(CBs + l * 136 + s0 + fq * 8);
                        const float* cp = cumL + (dir * 8 + w) * 128 + s0 + fq * 8; const float* dp = dtL + (dir * 8 + w) * 128 + s0 + fq * 8;
                        const f32x4 c0 = *(const f32x4*)cp, c1 = *(const f32x4*)(cp + 4), d0 = *(const f32x4*)dp, d1 = *(const f32x4*)(dp + 4);
                        float cbf[8] = {bflo(cbv.x), bfhi(cbv.x), bflo(cbv.y), bfhi(cbv.y), bflo(cbv.z), bfhi(cbv.z), bflo(cbv.w), bfhi(cbv.w)}; float v[8];
#pragma unroll
                        for (int j = 0; j < 8; ++j) { const int s = s0 + fq * 8 + j; const float cs = j < 4 ? c0[j & 3] : c1[j & 3], ds = j < 4 ? d0[j & 3] : d1[j & 3];
                            const bool valid = dir == 0 ? (s <= l) : (s >= l); float t = valid ? cbf[j] * __expf(fminf(cl - cs, 0.f)) * ds : 0.f; if (dir == 0 && s == l) t += Dh; v[j] = t; }
                        const bf16x8 yf = mkfrag(cvt_pk_bf16(v[0], v[1]), cvt_pk_bf16(v[2], v[3]), cvt_pk_bf16(v[4], v[5]), cvt_pk_bf16(v[6], v[7]));
#pragma unroll
                        for (int p2 = 0; p2 < 2; ++p2) acc[p2] = __builtin_amdgcn_mfma_f32_16x16x32_bf16(*(const bf16x8*)(XFw + ((ks * 2 + p2) * 64 + lane) * 8), yf, acc[p2], 0, 0, 0); }
                    __builtin_amdgcn_sched_barrier(0); }
            }
            const size_t row = (size_t)(rowbase + l); float ss = 0.f;
#pragma unroll
            for (int p2 = 0; p2 < 2; ++p2) { const int ch = h * 64 + (hp * 2 + p2) * 16 + fq * 4; const u32x2 zz = *(const u32x2*)(Z + row * 2048 + ch);
                const float h0 = acc[p2][0] * silu_(bflo(zz.x)), h1 = acc[p2][1] * silu_(bfhi(zz.x)), h2 = acc[p2][2] * silu_(bflo(zz.y)), h3 = acc[p2][3] * silu_(bfhi(zz.y));
                ss += (h0 * h0 + h1 * h1) + (h2 * h2 + h3 * h3); u32x2 o; o.x = cvt_pk_bf16(h0, h1); o.y = cvt_pk_bf16(h2, h3); *(u32x2*)(YD + row * 2048 + ch) = o; }
            ss += __shfl_xor(ss, 16); ss += __shfl_xor(ss, 32);
            if (fq == 0) part[(hp * 8 + w) * 128 + l] = ss;
        }
        }
        __syncthreads();
#pragma unroll 1
        for (int lt = 0; lt < 8; ++lt) { const int l = lt * 16 + fr; float tot = 0.f;
#pragma unroll
            for (int ww = 0; ww < 16; ++ww) tot += part[ww * 128 + l];
            const float r = 1.f / sqrtf(tot * (1.f / 512.f) + RMS_EPS); const size_t row = (size_t)(rowbase + l);
#pragma unroll
            for (int pt = 0; pt < 4; ++pt) { const int ch = h * 64 + pt * 16 + fq * 4; bf16_t* yp = YD + row * 2048 + ch; const u32x2 hv = *(const u32x2*)yp; const f32x4 nw = *(const f32x4*)(normw + ch);
                u32x2 o; o.x = cvt_pk_bf16(bflo(hv.x) * r * nw[0], bfhi(hv.x) * r * nw[1]); o.y = cvt_pk_bf16(bflo(hv.y) * r * nw[2], bfhi(hv.y) * r * nw[3]); *(u32x2*)yp = o; } }
    }
    __syncthreads();
}

#ifndef MK_REP_S5
#define MK_REP_S5 1
#endif
#ifndef MK_REP_SSD
#define MK_REP_SSD 1
#endif
constexpr int NPHASE = 2 + 11 * 2;
__global__ void __launch_bounds__(512, 2) fwd_megakernel(Args a) {
    extern __shared__ __attribute__((aligned(16))) unsigned char lds[];
    PG8_LAS unsigned char* lds3 = (PG8_LAS unsigned char*)lds;
    unsigned char* big = a.ws + WS_BIG;
    for (int ph = a.ph_lo; ph < a.ph_hi; ++ph) {
        const int tid = pg8::pg8_tid(), lane = tid & 63, wave = tid >> 6, gw = blockIdx.x * 8 + wave, NGW = gridDim.x * 8;
        if (ph == 0) {
            adaln_phase(a, (float*)lds, tid);
            float* scr = (float*)lds + wave * (64 * 33);
            xpose_region(a, 0, 0, scr, gw, NGW, lane); xpose_region(a, 0, 1, scr, gw, NGW, lane);
        } else if (ph == 1) {
            row_phase<0>(a, MT, nullptr, nullptr, 0, 0, gw, NGW, lane);
        } else {
            const int layer = (ph - 2) / 11, k = (ph - 2) % 11; const bool last = layer == 1; const int Mrows = last ? TL : MT;
            const bf16_t* WA = (const bf16_t*)(a.ws + WS_WA); const bf16_t* WB = (const bf16_t*)(a.ws + WS_WB);
#ifdef MK_SKIP_MASK
            if ((MK_SKIP_MASK >> k) & 1) { if (ph + 1 < a.ph_hi) cg::this_grid().sync(); continue; }
#endif
            if (k == 0) {
                pg8::Gemm g{(const bf16_t*)(a.ws + WS_XM), WA + WA_IN / 2, MT, NPROJ, D}; pg8::StaticOrder S; S.init(MT, NPROJ, gridDim.x, blockIdx.x);
                EpiInProj E{big, a.in[19] + (size_t)layer * 64}; pg8::gemm_phase<EpiInProj, pg8::StaticOrder>(lds3, g, S, E, nullptr);
            } else if (k == 1) {
                for (int rep = 0; rep < MK_REP_SSD; ++rep) ssd_a_phase(a, layer, lds, tid);
                for (int rep = 0; rep < MK_REP_S5; ++rep) s5_phase<0>(a, layer, lds, tid, NCH);
            } else if (k == 2) {
#if !defined(MK_NO_SSD) && !defined(MK_NO_SSDB)
                ssd_b_phase(a, tid);
#endif
                for (int rep = 0; rep < MK_REP_S5; ++rep) s5_phase<1>(a, layer, lds, tid, last ? 128 : NCH);
            } else if (k == 3) {
                for (int rep = 0; rep < MK_REP_SSD; ++rep) ssd_c_phase(a, layer, lds, tid, last ? 128 : NCH);
#ifndef MK_NO_S5
                pg8::Gemm g{(const bf16_t*)(big + B_Y5), WA + WA_GLU / 2, Mrows, 2048, 1024}; pg8::StaticOrder S; S.init(Mrows, 2048, gridDim.x, blockIdx.x);
                EpiGlu E{(bf16_t*)(big + B_U5)}; pg8::gemm_phase<EpiGlu, pg8::StaticOrder>(lds3, g, S, E, nullptr);
#endif
            } else if (k == 4) {
#ifndef MK_NO_S5
                { pg8::Gemm g{(const bf16_t*)(big + B_U5), WA + WA_S5P / 2, Mrows, 2048, 1024}; pg8::StaticOrder S; S.init(Mrows, 2048, gridDim.x, blockIdx.x);
                  EpiMerge<0> E{(bf16_t*)(big + B_XBC), (const bf16_t*)(big + B_GATE)}; pg8::gemm_phase<EpiMerge<0>, pg8::StaticOrder>(lds3, g, S, E, nullptr); }
                __syncthreads();
#endif
#ifndef MK_NO_SSD
#ifdef MK_NO_S5
                { pg8::Gemm g{(const bf16_t*)(big + B_YD), WA + WA_SSDP / 2, Mrows, 2048, 2048}; pg8::StaticOrder S; S.init(Mrows, 2048, gridDim.x, blockIdx.x);
                  EpiMerge<0, 1> E{(bf16_t*)(big + B_XBC), (const bf16_t*)(big + B_GATE)}; pg8::gemm_phase<EpiMerge<0, 1>, pg8::StaticOrder>(lds3, g, S, E, nullptr); }
#else
                { pg8::Gemm g{(const bf16_t*)(big + B_YD), WA + WA_SSDP / 2, Mrows, 2048, 2048}; pg8::StaticOrder S; S.init(Mrows, 2048, gridDim.x, blockIdx.x);
                  EpiMerge<1> E{(bf16_t*)(big + B_XBC), (const bf16_t*)(big + B_GATE)}; pg8::gemm_phase<EpiMerge<1>, pg8::StaticOrder>(lds3, g, S, E, nullptr); }
#endif
#endif
            } else if (k == 5) {
                pg8::Gemm g{(const bf16_t*)(big + B_XBC), WA + WA_WOUT / 2, Mrows, 2048, 2048}; pg8::StaticOrder S; S.init(Mrows, 2048, gridDim.x, blockIdx.x);
                EpiResid E{a.out, (float*)(a.ws + WS_HCTX), mvec(a, layer, 0) + 2 * D, mvec(a, layer, 1) + 2 * D}; pg8::gemm_phase<EpiResid, pg8::StaticOrder>(lds3, g, S, E, nullptr);
            } else if (k == 6) {
                row_phase<1>(a, Mrows, a.in[25] + (size_t)layer * D, a.in[26] + (size_t)layer * D, layer, 3 * D, gw, NGW, lane);
                if (!last) { __syncthreads(); xpose_region(a, layer + 1, 0, (float*)lds + wave * (64 * 33), gw, NGW, lane); }
            } else if (k == 7) {
                pg8::Gemm g{(const bf16_t*)(a.ws + WS_XM), WB + WB_UP / 2, Mrows, 2 * DFF, D}; pg8::StaticOrder S; S.init(Mrows, 2 * DFF, gridDim.x, blockIdx.x);
                EpiUp E{(bf16_t*)(big + B_G), (bf16_t*)(big + B_V)}; pg8::gemm_phase<EpiUp, pg8::StaticOrder>(lds3, g, S, E, nullptr);
            } else if (k == 8) {
                ffnconv_phase(a, layer, !last, tid);
            } else if (k == 9) {
                pg8::Gemm g{(const bf16_t*)(big + B_V), WB + WB_DOWN / 2, Mrows, D, DFF}; pg8::StaticOrder S; S.init(Mrows, D, gridDim.x, blockIdx.x);
                EpiResid E{a.out, (float*)(a.ws + WS_HCTX), mvec(a, layer, 0) + 5 * D, mvec(a, layer, 1) + 5 * D}; pg8::gemm_phase<EpiResid, pg8::StaticOrder>(lds3, g, S, E, nullptr);
            } else {
                row_phase<1>(a, Mrows, a.in[31] + (size_t)layer * D, a.in[32] + (size_t)layer * D, last ? -1 : layer + 1, 0, gw, NGW, lane);
                if (!last) { __syncthreads(); xpose_region(a, layer + 1, 1, (float*)lds + wave * (64 * 33), gw, NGW, lane); }
            }
        }
        if (ph + 1 < a.ph_hi) cg::this_grid().sync();
    }
}
}

#ifndef MK_N_LAUNCH_MODE
#define MK_N_LAUNCH_MODE 0
#endif
extern "C" void kernel_launch(void* const* d_in, const int* in_sizes, int n_in, void* d_out, int out_size, void* d_ws, size_t ws_size, hipStream_t stream) {
    static int grid = 0;
    if (grid == 0) {
        if (n_in != 33 || ws_size < mk::WS_END) { fprintf(stderr, "kernel_launch: need 33 inputs and %zu bytes of workspace (got %d, %zu)\n", (size_t)mk::WS_END, n_in, ws_size); grid = -1; return; }
        int dev = 0, cus = 0, per_cu = 0;
        (void)hipGetDevice(&dev); (void)hipDeviceGetAttribute(&cus, hipDeviceAttributeMultiprocessorCount, dev);
        if (hipFuncSetAttribute((const void*)mk::fwd_megakernel, hipFuncAttributeMaxDynamicSharedMemorySize, mk::LDS_BYTES) != hipSuccess) { fprintf(stderr, "kernel_launch: hipFuncSetAttribute failed\n"); grid = -1; return; }
        if (hipOccupancyMaxActiveBlocksPerMultiprocessor(&per_cu, (const void*)mk::fwd_megakernel, 512, mk::LDS_BYTES) != hipSuccess || per_cu < 1) { fprintf(stderr, "kernel_launch: occupancy query says %d\n", per_cu); per_cu = 1; }
        (void)hipGetLastError();
        grid = cus * per_cu; if (grid > 256) grid = 256;
    }
    if (grid < 0) return;
    mk::Args a{};
    for (int i = 0; i < 33; ++i) a.in[i] = (const float*)d_in[i];
    a.out = (float*)d_out; a.ws = (unsigned char*)d_ws;
#if MK_N_LAUNCH_MODE == 1
    for (int ph = 0; ph < mk::NPHASE; ++ph) { a.ph_lo = ph; a.ph_hi = ph + 1; hipLaunchKernelGGL(mk::fwd_megakernel, dim3(grid), dim3(512), mk::LDS_BYTES, stream, a); }
#else
    a.ph_lo = 0; a.ph_hi = mk::NPHASE;
    void* args[] = {&a};
    hipError_t e = hipLaunchCooperativeKernel((const void*)mk::fwd_megakernel, dim3(grid), dim3(512), args, mk::LDS_BYTES, stream);
    if (e != hipSuccess) fprintf(stderr, "cooperative launch failed: %s (grid %d)\n", hipGetErrorString(e), grid);
#endif
}
```

```cpp
#include <hip/hip_runtime.h>
#include <hip/hip_cooperative_groups.h>
#include <cstdio>
namespace cg = cooperative_groups;
#define MK_N_LAUNCH_MODE 0
namespace pg8 {
#define PG8_LAS __attribute__((address_space(3)))
typedef unsigned short bf16_t;
typedef short bf16x8 __attribute__((ext_vector_type(8)));
typedef float f32x4 __attribute__((ext_vector_type(4)));
typedef unsigned u32x4 __attribute__((ext_vector_type(4)));
constexpr int BM = 256, BK = 64, HALF = 128, HTB = HALF * BK * 2  , STAGE_BYTES = 8 * HTB, NXCD = 8, WGM = 8;

__host__ __device__ __forceinline__ int lds_byte(int r, int c) { const int st = (r >> 4) * 2 + (c >> 5), rr = r & 15, cc = c & 31, ob = rr * 64 + cc * 2; return st * 1024 + (ob ^ (((ob >> 9) & 1) << 5)); }
__host__ __device__ __forceinline__ void stage_rc(int b, int& R, int& C) { const int st = b / 1024, sb = b % 1024, swz = sb ^ (((sb >> 9) & 1) << 5); R = (st >> 1) * 16 + swz / 64; C = (st & 1) * 32 + (swz % 64) / 2; }
__host__ __device__ __forceinline__ int perm32(int rho) { const int n = rho >> 4, i = rho & 15; return 8 * (i >> 2) + 4 * n + (i & 3); }

__device__ __forceinline__ int pg8_tid() { int t = threadIdx.x; asm volatile("" : "+v"(t)); return t; }
struct Unit { int pm, pn; };
struct Gemm { const bf16_t* A; const bf16_t* Bt; int M, N, K; };

struct StaticOrder {
    int nM, nN, nwg, G, c;
    __host__ __device__ void init(int M, int N, int G_, int c_) { nM = M / BM; nN = N / BM; nwg = nM * nN; G = G_; c = c_; }
    __host__ __device__ bool next(int i, Unit& u) const {
        const long L = (long)i * G + c; if (L >= nwg) return false;
        int wgid = (int)L; { const int q = nwg / NXCD, r = nwg % NXCD, xcd = wgid % NXCD, off = wgid / NXCD; wgid = (xcd < r ? xcd * (q + 1) : r * (q + 1) + (xcd - r) * q) + off; }
        const int nig = WGM * nN, gid = wgid / nig, fm = gid * WGM, gsz = (nM - fm) < WGM ? (nM - fm) : WGM;
        u.pm = fm + ((wgid % nig) % gsz); u.pn = (wgid % nig) / gsz; return true;
    }
    __device__ __forceinline__ void a_ready(const Unit&) const {}
    __device__ __forceinline__ void done(const Unit&) const {}
};
__device__ __forceinline__ unsigned cvt_pk_bf16(float lo, float hi) { unsigned r; asm volatile("v_cvt_pk_bf16_f32 %0, %1, %2" : "=v"(r) : "v"(lo), "v"(hi)); return r; }
__device__ __forceinline__ void mfma_settle(const float __attribute__((ext_vector_type(4)))& a) { asm volatile("s_nop 15\n\ts_nop 7" :: "v"(a)); }
typedef float f32x2 __attribute__((ext_vector_type(2)));
template <class Epi, class Sched, bool STAMP = false>
__device__ __forceinline__ void gemm_phase(PG8_LAS unsigned char* lds, const Gemm g, const Sched& S, const Epi& E, unsigned long long* stamps) {
    const int tid = pg8_tid(), wid = __builtin_amdgcn_readfirstlane(tid >> 6), lane = tid & 63, wr = wid >> 2, wc = wid & 3, fr = lane & 15, fq = lane >> 4;
    const int K = g.K, nt = K / BK;
    int ts_lo = 0, ts_hi = 0, nts = 0; const unsigned long long rt_entry = STAMP ? (unsigned long long)wall_clock64() : 0ull;
#define PG8_STAMP() do { if (STAMP && wid == 0 && nts < 64) { const unsigned long long _c = (unsigned long long)clock64(); \
        ts_lo = (lane == nts) ? (int)(unsigned)_c : ts_lo; ts_hi = (lane == nts) ? (int)(unsigned)(_c >> 32) : ts_hi; ++nts; } } while (0)
    PG8_STAMP();
    unsigned voffA[2], voffB[2];
#pragma unroll
    for (int i = 0; i < 2; ++i) { int R, C; stage_rc(tid * 16 + i * 8192, R, C); const int Rb = Epi::PERM ? ((R & ~31) + perm32(R & 31)) : R;
        voffA[i] = (unsigned)(R * K + C) * 2u; voffB[i] = (unsigned)(Rb * K + C) * 2u; }
    const size_t kstep = (size_t)(BK * 2);
    const size_t hstep = (size_t)HALF * K * 2;
    const size_t tstep = 2 * hstep;
    const unsigned ldsw = (unsigned)wid * 1024u;
    const int aoff = lds_byte(wr * 64 + fr, fq * 8), boff = lds_byte(wc * 32 + fr, fq * 8);
#define PG8_SA(b, h) (((b) * 2 + (h)) * HTB)
#define PG8_SB(b, h) ((4 + (b) * 2 + (h)) * HTB)
#define PG8_STAGE(bufoff, gbase, voff) do { _Pragma("unroll") for (int _i = 0; _i < 2; ++_i) \
        __builtin_amdgcn_global_load_lds((const unsigned*)((const char*)(gbase) + (voff)[_i]), (PG8_LAS unsigned*)(lds + (bufoff) + ldsw + _i * 8192), 16, 0, 0); } while (0)
#define PG8_LDA(dst, b, h) do { _Pragma("unroll") for (int m = 0; m < 4; ++m) _Pragma("unroll") for (int k = 0; k < 2; ++k) dst[m][k] = *(const PG8_LAS bf16x8*)(lds + PG8_SA(b, h) + aoff + m * 2048 + k * 1024); } while (0)
#define PG8_LDB(dst, b, h) do { _Pragma("unroll") for (int n = 0; n < 2; ++n) _Pragma("unroll") for (int k = 0; k < 2; ++k) dst[n][k] = *(const PG8_LAS bf16x8*)(lds + PG8_SB(b, h) + boff + n * 2048 + k * 1024); } while (0)
#define PG8_MMA(ai, bj, At, Bt) do { __builtin_amdgcn_s_setprio(1); _Pragma("unroll") for (int m = 0; m < 4; ++m) _Pragma("unroll") for (int n = 0; n < 2; ++n) _Pragma("unroll") for (int k = 0; k < 2; ++k) \
        acc[ai][bj][m][n] = __builtin_amdgcn_mfma_f32_16x16x32_bf16(Bt[n][k], At[m][k], acc[ai][bj][m][n], 0, 0, 0); __builtin_amdgcn_s_setprio(0); } while (0)
#define PG8_WAIT_V(n) asm volatile("s_waitcnt vmcnt(" #n ")" ::: "memory")
#define PG8_WAIT_L(n) asm volatile("s_waitcnt lgkmcnt(" #n ")" ::: "memory")
#define PG8_BAR __builtin_amdgcn_s_barrier()
#define PG8_SCHED __builtin_amdgcn_sched_barrier(0)
    Unit cur, nxt; int ui = 0;
    if (!S.next(0, cur)) return;
    f32x4 acc[2][2][4][2];
#pragma unroll
    for (int a = 0; a < 2; ++a)
#pragma unroll
        for (int b = 0; b < 2; ++b)
#pragma unroll
            for (int m = 0; m < 4; ++m)
#pragma unroll
                for (int n = 0; n < 2; ++n) acc[a][b][m][n] = (f32x4){0.f, 0.f, 0.f, 0.f};
    bf16x8 At[4][2], B0[2][2], B1[2][2];
    const char* cA = (const char*)g.A + (size_t)cur.pm * tstep; const char* cB = (const char*)g.Bt + (size_t)cur.pn * tstep;
    S.a_ready(cur);
    PG8_STAGE(PG8_SB(0, 0), cB, voffB); PG8_STAGE(PG8_SA(0, 0), cA, voffA); PG8_STAGE(PG8_SB(0, 1), cB + hstep, voffB); PG8_STAGE(PG8_SA(0, 1), cA + hstep, voffA);
    if (wr == 1) PG8_BAR;
    PG8_WAIT_V(4); PG8_BAR;
    PG8_STAGE(PG8_SB(1, 0), cB + kstep, voffB); PG8_STAGE(PG8_SA(1, 0), cA + kstep, voffA); PG8_STAGE(PG8_SB(1, 1), cB + hstep + kstep, voffB);
    PG8_WAIT_V(6); PG8_BAR;
    PG8_STAMP();
    for (;;) {
        const bool has_next = S.next(ui + 1, nxt);
        const char* nA = has_next ? (const char*)g.A + (size_t)nxt.pm * tstep : cA; const char* nB = has_next ? (const char*)g.Bt + (size_t)nxt.pn * tstep : cB;
        for (int t = 0; t < nt; t += 2) {
            const bool last = (t == nt - 2);
            const char* a1 = cA + (size_t)(t + 1) * kstep;
            const char* a2 = last ? nA : cA + (size_t)(t + 2) * kstep; const char* b2 = last ? nB : cB + (size_t)(t + 2) * kstep;
            const char* a3 = a2 + kstep; const char* b3 = b2 + kstep;
            if (last && has_next) S.a_ready(nxt);
            PG8_LDB(B0, 0, 0); PG8_SCHED; PG8_LDA(At, 0, 0); PG8_STAGE(PG8_SA(1, 1), a1 + hstep, voffA);
            PG8_WAIT_L(8); PG8_BAR; PG8_WAIT_L(0); PG8_MMA(0, 0, At, B0); PG8_BAR; PG8_SCHED;
            PG8_LDB(B1, 0, 1); PG8_STAGE(PG8_SB(0, 0), b2, voffB);
            PG8_BAR; PG8_WAIT_L(0); PG8_MMA(0, 1, At, B1); PG8_BAR;
            PG8_LDA(At, 0, 1); PG8_STAGE(PG8_SA(0, 0), a2, voffA);
            PG8_BAR; PG8_WAIT_L(0); PG8_MMA(1, 0, At, B0); PG8_BAR; PG8_SCHED;
            PG8_STAGE(PG8_SB(0, 1), b2 + hstep, voffB);
            PG8_WAIT_V(6); PG8_BAR; PG8_MMA(1, 1, At, B1); PG8_BAR;
            PG8_LDB(B0, 1, 0); PG8_SCHED; PG8_LDA(At, 1, 0); PG8_STAGE(PG8_SA(0, 1), a2 + hstep, voffA);
            PG8_WAIT_L(8); PG8_BAR; PG8_WAIT_L(0); PG8_MMA(0, 0, At, B0); PG8_BAR; PG8_SCHED;
            PG8_LDB(B1, 1, 1); PG8_STAGE(PG8_SB(1, 0), b3, voffB);
            PG8_BAR; PG8_WAIT_L(0); PG8_MMA(0, 1, At, B1); PG8_BAR;
            PG8_LDA(At, 1, 1); PG8_STAGE(PG8_SA(1, 0), a3, voffA);
            PG8_BAR; PG8_WAIT_L(0); PG8_MMA(1, 0, At, B0); PG8_BAR; PG8_SCHED;
            PG8_STAGE(PG8_SB(1, 1), b3 + hstep, voffB);
            PG8_WAIT_V(6); PG8_BAR; PG8_MMA(1, 1, At, B1); PG8_BAR;
        }
        PG8_STAMP();
        if constexpr (!Epi::AFTER_DRAIN) { E(acc, cur, wr, wc, fr, fq); S.done(cur); }
        PG8_STAMP();
        if (!has_next) break;
#pragma unroll
        for (int a = 0; a < 2; ++a)
#pragma unroll
            for (int b = 0; b < 2; ++b)
#pragma unroll
                for (int m = 0; m < 4; ++m)
#pragma unroll
                    for (int n = 0; n < 2; ++n) acc[a][b][m][n] = (f32x4){0.f, 0.f, 0.f, 0.f};
        cur = nxt; cA = nA; cB = nB; ++ui;
    }
    PG8_WAIT_V(0);
    if (wr == 0) PG8_BAR;
    PG8_BAR;
    if constexpr (Epi::AFTER_DRAIN) { E.fused(acc, cur, wr, wc, fr, fq, lds, wid, lane); S.done(cur); }
    PG8_STAMP();
    if (STAMP && wid == 0) { stamps[lane] = lane < nts ? (((unsigned long long)(unsigned)ts_hi << 32) | (unsigned)ts_lo) : 0ull;
        if (lane == 62) stamps[62] = rt_entry; if (lane == 63) stamps[63] = (unsigned long long)wall_clock64(); }
#undef PG8_STAMP
#undef PG8_SA
#undef PG8_SB
#undef PG8_STAGE
#undef PG8_LDA
#undef PG8_LDB
#undef PG8_MMA
#undef PG8_WAIT_V
#undef PG8_WAIT_L
#undef PG8_BAR
#undef PG8_SCHED
}
}

namespace mk {
using pg8::bf16_t; using pg8::bf16x8; using pg8::f32x4; using pg8::u32x4; using pg8::Unit; using pg8::cvt_pk_bf16; using pg8::mfma_settle;
typedef unsigned u32x2 __attribute__((ext_vector_type(2)));
typedef float f32x2 __attribute__((ext_vector_type(2)));
constexpr int D = 2048, TL = 16384, TC = 256, MT = TL + TC, NCH = MT / 128;
constexpr int NPROJ = 10496, DFF = 5632;
constexpr size_t MiB = 1u << 20;
constexpr size_t WS_MVEC = 0, WS_CHD = 256 * 1024, WS_S5LOC = 1 * MiB, WS_WA = 10 * MiB, WS_WB = 75 * MiB, WS_HCTX = 141 * MiB, WS_XM = 143 * MiB, WS_SST = 208 * MiB, WS_BIG = 338 * MiB, WS_END = 766 * MiB;
constexpr size_t B_U5 = 0, B_XBC = B_U5 + (size_t)MT * 1024 * 2, B_Z = B_XBC + (size_t)MT * 3072 * 2, B_GATE = B_Z + (size_t)MT * 2048 * 2, B_DT = B_GATE + (size_t)MT * 4096 * 2,
                 B_Y5 = 330 * MiB, B_YD = B_Y5 + (size_t)MT * 1024 * 2;
static_assert(B_DT + (size_t)MT * 64 * 4 <= B_Y5 && B_YD + (size_t)MT * 2048 * 2 <= 428 * MiB, "big map");
constexpr size_t B_G = 0, B_V = (size_t)MT * DFF * 2;
constexpr size_t WA_IN = 0, WA_GLU = 41 * MiB, WA_S5P = 45 * MiB, WA_SSDP = 49 * MiB, WA_WOUT = 57 * MiB, WB_UP = 0, WB_DOWN = 44 * MiB;
constexpr int LDS_BYTES = 163840;
constexpr float ALPHA = 1.41421356237f, LN_EPS = 1e-5f, RMS_EPS = 1e-5f;

struct Args { const float* in[33]; float* out; unsigned char* ws; int ph_lo, ph_hi; };

__device__ __forceinline__ float bf2f(unsigned b) { return __uint_as_float(b << 16); }
__device__ __forceinline__ float bflo(unsigned w) { return __uint_as_float(w << 16); }
__device__ __forceinline__ float bfhi(unsigned w) { return __uint_as_float(w & 0xffff0000u); }
__device__ __forceinline__ float sigm(float x) { return 1.f / (1.f + __expf(-x)); }
__device__ __forceinline__ float silu_(float x) { return x / (1.f + __expf(-x)); }
__device__ __forceinline__ float gelu_tanh(float x) { const float u = 0.7978845608028654f * (x + 0.044715f * x * x * x); const float th = 1.f - 2.f / (__expf(2.f * u) + 1.f); return 0.5f * x * (1.f + th); }
__device__ __forceinline__ bf16x8 mkfrag(unsigned a, unsigned b, unsigned c, unsigned d) { u32x4 v; v.x = a; v.y = b; v.z = c; v.w = d; return __builtin_bit_cast(bf16x8, v); }
__device__ __forceinline__ float* hrow(const Args& a, int row) { return row < TL ? a.out + (size_t)row * D : (float*)(a.ws + WS_HCTX) + (size_t)(row - TL) * D; }
__device__ __forceinline__ const float* mvec(const Args& a, int layer, int isctx) { return (const float*)(a.ws + WS_MVEC) + (size_t)(layer * 2 + isctx) * 12288; }

struct EpiInProj {
    static constexpr bool PERM = true, AFTER_DRAIN = false;
    unsigned char* big; const float* dt_bias;
    __device__ __forceinline__ void operator()(const f32x4 (&acc)[2][2][4][2], const Unit& u, int wr, int wc, int fr, int fq) const {
        mfma_settle(acc[1][1][3][1]); mfma_settle(acc[1][1][3][0]);
        const int row0 = u.pm * 256 + wr * 64 + fr, ct = u.pn * 256;
        if (ct >= 10240) {
            if (wc < 2) { const int cc = wc * 32 + 8 * fq; float* DT = (float*)(big + B_DT);
                const f32x4 b0 = *(const f32x4*)(dt_bias + cc), b1 = *(const f32x4*)(dt_bias + cc + 4);
#pragma unroll
                for (int ai = 0; ai < 2; ++ai)
#pragma unroll
                    for (int m = 0; m < 4; ++m) { float* rp = DT + (size_t)(row0 + ai * 128 + m * 16) * 64 + cc; f32x4 v0 = acc[ai][0][m][0] + b0, v1 = acc[ai][0][m][1] + b1;
#pragma unroll
                        for (int j = 0; j < 4; ++j) { v0[j] = v0[j] > 20.f ? v0[j] : log1pf(expf(v0[j])); v1[j] = v1[j] > 20.f ? v1[j] : log1pf(expf(v1[j])); }
                        *(f32x4*)rp = v0; *(f32x4*)(rp + 4) = v1; } }
            return;
        }
        bf16_t* base; int ld, c0; bool sg = false;
        if (ct < 1024) { base = (bf16_t*)(big + B_U5); ld = 1024; c0 = ct; }
        else if (ct < 4096) { base = (bf16_t*)(big + B_XBC); ld = 3072; c0 = ct - 1024; }
        else if (ct < 6144) { base = (bf16_t*)(big + B_Z); ld = 2048; c0 = ct - 4096; }
        else { base = (bf16_t*)(big + B_GATE); ld = 4096; c0 = ct - 6144; sg = true; }
        const int col0 = c0 + wc * 32 + 8 * fq;
#pragma unroll
        for (int ai = 0; ai < 2; ++ai)
#pragma unroll
            for (int m = 0; m < 4; ++m) { bf16_t* rowp = base + (size_t)(row0 + ai * 128 + m * 16) * ld + col0;
#pragma unroll
                for (int bj = 0; bj < 2; ++bj) { f32x4 v0 = acc[ai][bj][m][0], v1 = acc[ai][bj][m][1];
                    if (sg) {
#pragma unroll
                        for (int j = 0; j < 4; ++j) { v0[j] = sigm(v0[j]); v1[j] = sigm(v1[j]); } }
                    u32x4 w; w.x = cvt_pk_bf16(v0[0], v0[1]); w.y = cvt_pk_bf16(v0[2], v0[3]); w.z = cvt_pk_bf16(v1[0], v1[1]); w.w = cvt_pk_bf16(v1[2], v1[3]);
                    *(u32x4*)(rowp + bj * 128) = w; } }
    }
};
struct EpiGlu {
    static constexpr bool PERM = true, AFTER_DRAIN = false;
    bf16_t* O;
    __device__ __forceinline__ void operator()(const f32x4 (&acc)[2][2][4][2], const Unit& u, int wr, int wc, int fr, int fq) const {
        mfma_settle(acc[1][1][3][1]); mfma_settle(acc[1][1][3][0]);
        const int row0 = u.pm * 256 + wr * 64 + fr, col0 = u.pn * 128 + wc * 32 + 8 * fq;
#pragma unroll
        for (int ai = 0; ai < 2; ++ai)
#pragma unroll
            for (int m = 0; m < 4; ++m) { f32x4 v0 = acc[ai][0][m][0], v1 = acc[ai][0][m][1]; const f32x4 g0 = acc[ai][1][m][0], g1 = acc[ai][1][m][1];
#pragma unroll
                for (int j = 0; j < 4; ++j) { v0[j] *= sigm(g0[j]); v1[j] *= sigm(g1[j]); }
                u32x4 w; w.x = cvt_pk_bf16(v0[0], v0[1]); w.y = cvt_pk_bf16(v0[2], v0[3]); w.z = cvt_pk_bf16(v1[0], v1[1]); w.w = cvt_pk_bf16(v1[2], v1[3]);
                *(u32x4*)(O + (size_t)(row0 + ai * 128 + m * 16) * 1024 + col0) = w; }
    }
};
template <int SECOND, int GSEL = SECOND> struct EpiMerge {
    static constexpr bool PERM = true, AFTER_DRAIN = false;
    bf16_t* MG; const bf16_t* GATE;
    __device__ __forceinline__ void operator()(const f32x4 (&acc)[2][2][4][2], const Unit& u, int wr, int wc, int fr, int fq) const {
        mfma_settle(acc[1][1][3][1]); mfma_settle(acc[1][1][3][0]);
        const int row0 = u.pm * 256 + wr * 64 + fr, col0 = u.pn * 256 + wc * 32 + 8 * fq;
#pragma unroll
        for (int ai = 0; ai < 2; ++ai)
#pragma unroll
            for (int m = 0; m < 4; ++m) { const size_t r = (size_t)(row0 + ai * 128 + m * 16);
#pragma unroll
                for (int bj = 0; bj < 2; ++bj) { const int c = col0 + bj * 128; const u32x4 g = *(const u32x4*)(GATE + r * 4096 + (GSEL ? 2048 : 0) + c);
                    f32x4 v0 = acc[ai][bj][m][0], v1 = acc[ai][bj][m][1];
                    v0[0] *= bflo(g.x); v0[1] *= bfhi(g.x); v0[2] *= bflo(g.y); v0[3] *= bfhi(g.y); v1[0] *= bflo(g.z); v1[1] *= bfhi(g.z); v1[2] *= bflo(g.w); v1[3] *= bfhi(g.w);
                    if (SECOND) { const u32x4 o = *(const u32x4*)(MG + r * 2048 + c);
                        v0[0] += bflo(o.x); v0[1] += bfhi(o.x); v0[2] += bflo(o.y); v0[3] += bfhi(o.y); v1[0] += bflo(o.z); v1[1] += bfhi(o.z); v1[2] += bflo(o.w); v1[3] += bfhi(o.w); }
                    u32x4 w; w.x = cvt_pk_bf16(v0[0], v0[1]); w.y = cvt_pk_bf16(v0[2], v0[3]); w.z = cvt_pk_bf16(v1[0], v1[1]); w.w = cvt_pk_bf16(v1[2], v1[3]);
                    *(u32x4*)(MG + r * 2048 + c) = w; } }
    }
};
struct EpiResid {
    static constexpr bool PERM = false, AFTER_DRAIN = false;
    float* out; float* hctx; const float* glat; const float* gctx;
    __device__ __forceinline__ void operator()(const f32x4 (&acc)[2][2][4][2], const Unit& u, int wr, int wc, int fr, int fq) const {
        mfma_settle(acc[1][1][3][1]); mfma_settle(acc[1][1][3][0]);
        const bool isctx = u.pm >= 64; const float* g = isctx ? gctx : glat;
        float* hb = isctx ? hctx + (size_t)(wr * 64 + fr) * D : out + (size_t)(u.pm * 256 + wr * 64 + fr) * D;
        const int col0 = u.pn * 256 + wc * 32 + 4 * fq;
        f32x4 gv[2][2];
#pragma unroll
        for (int bj = 0; bj < 2; ++bj)
#pragma unroll
            for (int n = 0; n < 2; ++n) gv[bj][n] = *(const f32x4*)(g + col0 + bj * 128 + n * 16);
#pragma unroll
        for (int ai = 0; ai < 2; ++ai)
#pragma unroll
            for (int m = 0; m < 4; ++m) { float* rowp = hb + (size_t)(ai * 128 + m * 16) * D + col0;
#pragma unroll
                for (int bj = 0; bj < 2; ++bj)
#pragma unroll
                    for (int n = 0; n < 2; ++n) { float* p = rowp + bj * 128 + n * 16; const f32x4 h = *(const f32x4*)p; *(f32x4*)p = h * ALPHA + gv[bj][n] * acc[ai][bj][m][n]; } }
    }
};
struct EpiUp {
    static constexpr bool PERM = true, AFTER_DRAIN = false;
    bf16_t* G; bf16_t* V;
    __device__ __forceinline__ void operator()(const f32x4 (&acc)[2][2][4][2], const Unit& u, int wr, int wc, int fr, int fq) const {
        mfma_settle(acc[1][1][3][1]); mfma_settle(acc[1][1][3][0]);
        const int row0 = u.pm * 256 + wr * 64 + fr; int ct = u.pn * 256; bf16_t* base = G; if (ct >= DFF) { base = V; ct -= DFF; }
        const int col0 = ct + wc * 32 + 8 * fq;
#pragma unroll
        for (int ai = 0; ai < 2; ++ai)
#pragma unroll
            for (int m = 0; m < 4; ++m) { bf16_t* rowp = base + (size_t)(row0 + ai * 128 + m * 16) * DFF + col0;
#pragma unroll
                for (int bj = 0; bj < 2; ++bj) { const f32x4 v0 = acc[ai][bj][m][0], v1 = acc[ai][bj][m][1];
                    u32x4 w; w.x = cvt_pk_bf16(v0[0], v0[1]); w.y = cvt_pk_bf16(v0[2], v0[3]); w.z = cvt_pk_bf16(v1[0], v1[1]); w.w = cvt_pk_bf16(v1[2], v1[3]);
                    *(u32x4*)(rowp + bj * 128) = w; } }
    }
};

__device__ __forceinline__ void xpose_item(const float* W, int K, int N, bf16_t* WT, int d0, int s0, int k0, float* scr, int lane) {
#pragma unroll
    for (int i = 0; i < 32; ++i) { const int kk = 2 * i + (lane >> 5); scr[kk * 33 + (lane & 31)] = s0 >= 0 ? W[(size_t)(k0 + kk) * N + s0 + (lane & 31)] : 0.f; }
    asm volatile("s_waitcnt lgkmcnt(0)" ::: "memory");
    const int c = lane & 7;
#pragma unroll
    for (int j = 0; j < 4; ++j) { const int n = (lane >> 3) + 8 * j; const float* s = scr + (8 * c) * 33 + n;
        u32x4 o; o.x = cvt_pk_bf16(s[0 * 33], s[1 * 33]); o.y = cvt_pk_bf16(s[2 * 33], s[3 * 33]); o.z = cvt_pk_bf16(s[4 * 33], s[5 * 33]); o.w = cvt_pk_bf16(s[6 * 33], s[7 * 33]);
        *(u32x4*)(WT + (size_t)(d0 + n) * K + k0 + 8 * c) = o; }
    asm volatile("s_waitcnt lgkmcnt(0)" ::: "memory");
}
__device__ __forceinline__ void xpose_region(const Args& a, int layer, int region, float* scr, int gw, int NGW, int lane) {
    if (region == 0) {
        const float* w_in = a.in[6] + (size_t)layer * 2048 * 10304; const float* w_glu = a.in[15] + (size_t)layer * 1024 * 2048; const float* w_s5p = a.in[16] + (size_t)layer * 1024 * 2048;
        const float* w_ssdp = a.in[23] + (size_t)layer * 2048 * 2048; const float* w_out = a.in[24] + (size_t)layer * 2048 * 2048;
        bf16_t* WA = (bf16_t*)(a.ws + WS_WA);
        constexpr int I_IN = 32 * 328, I_GLU = 16 * 64, I_S5P = 16 * 64, I_SSDP = 32 * 64, I_WOUT = 32 * 64, NI = I_IN + I_GLU + I_S5P + I_SSDP + I_WOUT;
        for (int it = gw; it < NI; it += NGW) { int r = it;
            if (r < I_IN) { const int kb = r / 328, d0 = (r % 328) * 32; int s0; if (d0 < 4096) s0 = d0; else if (d0 < 10240) s0 = d0 + 64; else if (d0 < 10304) s0 = d0 - 10240 + 4096; else s0 = -1;
                xpose_item(w_in, 2048, 10304, WA + WA_IN / 2, d0, s0, kb * 64, scr, lane); continue; } r -= I_IN;
            if (r < I_GLU) { const int kb = r / 64, d0 = (r % 64) * 32, t = d0 >> 8, j = d0 & 255; const int s0 = j < 128 ? t * 128 + j : 1024 + t * 128 + (j - 128);
                xpose_item(w_glu, 1024, 2048, WA + WA_GLU / 2, d0, s0, kb * 64, scr, lane); continue; } r -= I_GLU;
            if (r < I_S5P) { const int kb = r / 64, d0 = (r % 64) * 32; xpose_item(w_s5p, 1024, 2048, WA + WA_S5P / 2, d0, d0, kb * 64, scr, lane); continue; } r -= I_S5P;
            if (r < I_SSDP) { const int kb = r / 64, d0 = (r % 64) * 32; xpose_item(w_ssdp, 2048, 2048, WA + WA_SSDP / 2, d0, d0, kb * 64, scr, lane); continue; } r -= I_SSDP;
            { const int kb = r / 64, d0 = (r % 64) * 32; xpose_item(w_out, 2048, 2048, WA + WA_WOUT / 2, d0, d0, kb * 64, scr, lane); }
        }
    } else {
        const float* w_up = a.in[27] + (size_t)layer * 2048 * 11264; const float* w_down = a.in[30] + (size_t)layer * 5632 * 2048;
        bf16_t* WB = (bf16_t*)(a.ws + WS_WB);
        constexpr int I_UP = 32 * 352, I_DOWN = 88 * 64, NI = I_UP + I_DOWN;
        for (int it = gw; it < NI; it += NGW) { int r = it;
            if (r < I_UP) { const int kb = r / 352, d0 = (r % 352) * 32; xpose_item(w_up, 2048, 11264, WB + WB_UP / 2, d0, d0, kb * 64, scr, lane); continue; } r -= I_UP;
            { const int kb = r / 64, d0 = (r % 64) * 32; xpose_item(w_down, 5632, 2048, WB + WB_DOWN / 2, d0, d0, kb * 64, scr, lane); }
        }
    }
}

__device__ __forceinline__ void adaln_phase(const Args& a, float* lds, int tid) {
    float* sc = lds; float* scx = lds + 2048; float* red = lds + 4096;
    for (int i = tid; i < 2048; i += 512) { sc[i] = silu_(a.in[1][i]); scx[i] = silu_(a.in[3][i]); }
    __syncthreads();
    for (int unit = blockIdx.x; unit < 256; unit += gridDim.x) {
        const int layer = unit >> 7, col0 = (unit & 127) * 96;
        const float* W = a.in[4] + (size_t)layer * 2048 * 12288 + col0;
        if (tid < 504) { const int cq = tid % 24, ks = tid / 24; f32x4 al = {0.f, 0.f, 0.f, 0.f}, ac = {0.f, 0.f, 0.f, 0.f};
#pragma unroll 7
            for (int k = ks; k < 2048; k += 21) { const f32x4 w = *(const f32x4*)(W + (size_t)k * 12288 + cq * 4); al += w * sc[k]; ac += w * scx[k]; }
            *(f32x4*)(red + (ks * 2 + 0) * 96 + cq * 4) = al; *(f32x4*)(red + (ks * 2 + 1) * 96 + cq * 4) = ac; }
        __syncthreads();
        if (tid < 192) { const int v = tid / 96, c = tid % 96; float s = 0.f; for (int ks = 0; ks < 21; ++ks) s += red[(ks * 2 + v) * 96 + c];
            ((float*)(a.ws + WS_MVEC))[(size_t)(layer * 2 + v) * 12288 + col0 + c] = s + a.in[5][(size_t)layer * 12288 + col0 + c]; }
        __syncthreads();
    }
}

__device__ __forceinline__ float wave_sum(float v) {
#pragma unroll
    for (int o = 1; o < 64; o <<= 1) v += __shfl_xor(v, o);
    return v;
}
template <int MODE> __device__ __forceinline__ void row_phase(const Args& a, int nrows, const float* lng, const float* lnb, int mod_layer, int mod_off, int gw, int NGW, int lane) {
    bf16_t* XM = (bf16_t*)(a.ws + WS_XM);
    for (int row = gw; row < nrows; row += NGW) {
        const int isctx = row >= TL; float* h = hrow(a, row);
        const float* src = MODE == 0 ? (isctx ? a.in[2] + (size_t)(row - TL) * D : a.in[0] + (size_t)row * D) : h;
        f32x4 v[8];
#pragma unroll
        for (int j = 0; j < 8; ++j) v[j] = *(const f32x4*)(src + 4 * lane + 256 * j);
        if (MODE == 1) {
            float s = 0.f;
#pragma unroll
            for (int j = 0; j < 8; ++j) s += (v[j][0] + v[j][1]) + (v[j][2] + v[j][3]);
            const float mean = wave_sum(s) * (1.f / D); float q = 0.f;
#pragma unroll
            for (int j = 0; j < 8; ++j) { v[j] = v[j] - mean; q += (v[j][0] * v[j][0] + v[j][1] * v[j][1]) + (v[j][2] * v[j][2] + v[j][3] * v[j][3]); }
            const float rstd = 1.f / sqrtf(wave_sum(q) * (1.f / D) + LN_EPS);
#pragma unroll
            for (int j = 0; j < 8; ++j) { const f32x4 g = *(const f32x4*)(lng + 4 * lane + 256 * j), b = *(const f32x4*)(lnb + 4 * lane + 256 * j); v[j] = v[j] * rstd * g + b; }
        }
#ifdef MK_SANITIZE
#pragma unroll
        for (int j = 0; j < 8; ++j)
#pragma unroll
            for (int e = 0; e < 4; ++e) if (!(fabsf(v[j][e]) < 1e30f)) v[j][e] = 0.f;
#endif
#pragma unroll
        for (int j = 0; j < 8; ++j) *(f32x4*)(h + 4 * lane + 256 * j) = v[j];
        if (mod_layer >= 0) { const float* m = mvec(a, mod_layer, isctx) + mod_off;
#pragma unroll
            for (int j = 0; j < 8; ++j) { const f32x4 sh = *(const f32x4*)(m + 4 * lane + 256 * j), scl = *(const f32x4*)(m + D + 4 * lane + 256 * j); const f32x4 o = v[j] * (scl + 1.f) + sh;
                u32x2 w; w.x = cvt_pk_bf16(o[0], o[1]); w.y = cvt_pk_bf16(o[2], o[3]); *(u32x2*)(XM + (size_t)row * D + 4 * lane + 256 * j) = w; } }
    }
}

__device__ __forceinline__ void ffnconv_phase(const Args& a, int layer, bool with_ctx, int tid) {
    const bf16_t* G = (const bf16_t*)(a.ws + WS_BIG + B_G); bf16_t* V = (bf16_t*)(a.ws + WS_BIG + B_V);
    const float* cw = a.in[28] + (size_t)layer * 9 * DFF; const float* cb = a.in[29] + (size_t)layer * DFF;
    const int nunits = (with_ctx ? 260 : 256) * 11; const int oc = tid & 63, xs = tid >> 6;
    for (int unit = blockIdx.x; unit < nunits; unit += gridDim.x) {
        const int seg = unit / 11, ob = unit % 11, ch0 = ob * 512 + oc * 8; const bool cs = seg >= 256; const int t0 = seg * 64;
        float w[9][8], bias[8];
#pragma unroll
        for (int k = 0; k < 9; ++k) { const f32x4 w0 = *(const f32x4*)(cw + (size_t)k * DFF + ch0), w1 = *(const f32x4*)(cw + (size_t)k * DFF + ch0 + 4);
            w[k][0] = w0[0]; w[k][1] = w0[1]; w[k][2] = w0[2]; w[k][3] = w0[3]; w[k][4] = w1[0]; w[k][5] = w1[1]; w[k][6] = w1[2]; w[k][7] = w1[3]; }
        { const f32x4 b0 = *(const f32x4*)(cb + ch0), b1 = *(const f32x4*)(cb + ch0 + 4); bias[0] = b0[0]; bias[1] = b0[1]; bias[2] = b0[2]; bias[3] = b0[3]; bias[4] = b1[0]; bias[5] = b1[1]; bias[6] = b1[2]; bias[7] = b1[3]; }
#pragma unroll 2
        for (int xi = 0; xi < 8; ++xi) { const int x = xs * 8 + xi, t = t0 + x; float acc[8];
#pragma unroll
            for (int k = 0; k < 8; ++k) acc[k] = bias[k];
#pragma unroll
            for (int dy = -1; dy <= 1; ++dy) { bool rok = cs ? (dy == 0) : ((dy < 0 ? seg > 0 : true) && (dy > 0 ? seg < 255 : true));
#pragma unroll
                for (int dx = -1; dx <= 1; ++dx) { const bool ok = rok && (cs ? (t + dx >= TL && t + dx < MT) : (x + dx >= 0 && x + dx < 64));
                    if (ok) { const u32x4 g = *(const u32x4*)(G + (size_t)(t + dy * 64 + dx) * DFF + ch0); const int k = (dy + 1) * 3 + dx + 1;
                        acc[0] += w[k][0] * bflo(g.x); acc[1] += w[k][1] * bfhi(g.x); acc[2] += w[k][2] * bflo(g.y); acc[3] += w[k][3] * bfhi(g.y);
                        acc[4] += w[k][4] * bflo(g.z); acc[5] += w[k][5] * bfhi(g.z); acc[6] += w[k][6] * bflo(g.w); acc[7] += w[k][7] * bfhi(g.w); } } }
            bf16_t* vp = V + (size_t)t * DFF + ch0; const u32x4 vv = *(const u32x4*)vp;
            u32x4 o; o.x = cvt_pk_bf16(silu_(acc[0]) * bflo(vv.x), silu_(acc[1]) * bfhi(vv.x)); o.y = cvt_pk_bf16(silu_(acc[2]) * bflo(vv.y), silu_(acc[3]) * bfhi(vv.y));
            o.z = cvt_pk_bf16(silu_(acc[4]) * bflo(vv.z), silu_(acc[5]) * bfhi(vv.z)); o.w = cvt_pk_bf16(silu_(acc[6]) * bflo(vv.w), silu_(acc[7]) * bfhi(vv.w));
            *(u32x4*)vp = o; }
    }
}

__device__ __forceinline__ int s5_chunk_at(int dir, int q) { return dir ? 129 - q : (q + 128) % 130; }
__device__ __forceinline__ int s5_pos_of(int dir, int c) { return dir ? 129 - c : (c + 2) % 130; }
template <int PASS> __device__ __forceinline__ void s5_phase(const Args& a, int layer, unsigned char* lds, int tid, int nchunks) {
    float* uL = (float*)lds;
    float* YL = (float*)(lds + 32768);
    bf16_t* ST = (bf16_t*)(lds + 65536);
    const bf16_t* U5 = (const bf16_t*)(a.ws + WS_BIG + B_U5); bf16_t* Y5 = (bf16_t*)(a.ws + WS_BIG + B_Y5);
    float2* S5LOC = (float2*)(a.ws + WS_S5LOC);
    const int lane = tid & 63, w = tid >> 6, gl = tid >> 7, dir = (tid >> 6) & 1, p = tid & 63, fr = lane & 15, fq = lane >> 4;
    int cur_gq = -1; float ab_re = 0.f, ab_im = 0.f, a128r = 0.f, a128i = 0.f; float bbr[16], bbi[16]; bf16x8 cm[4];
    for (int unit = blockIdx.x; unit < 16 * nchunks; unit += gridDim.x) {
        const int gq = unit / nchunks, c = unit % nchunks, g = gq * 4 + gl, row0 = c * 128;
        if (gq != cur_gq) { cur_gq = gq;
            const size_t pi = ((size_t)(layer * 2 + dir) * 64 + g) * 64 + p;
            const float lre = fminf(a.in[7][pi], -1e-4f), lim = a.in[8][pi], step = expf(a.in[9][(size_t)(layer * 2 + dir) * 64 + g]);
            const float mag = expf(lre * step); float sn, cs; sincosf(lim * step, &sn, &cs); ab_re = mag * cs; ab_im = mag * sn;
            const float den = lre * lre + lim * lim, q_re = ((ab_re - 1.f) * lre + ab_im * lim) / den, q_im = (ab_im * lre - (ab_re - 1.f) * lim) / den;
            const float* br = a.in[10] + (((size_t)layer * 64 + g) * 64 + p) * 16; const float* bi = a.in[11] + (((size_t)layer * 64 + g) * 64 + p) * 16;
#pragma unroll
            for (int j = 0; j < 16; ++j) { const float r = br[j], i = bi[j]; bbr[j] = q_re * r - q_im * i; bbi[j] = q_re * i + q_im * r; }
            a128r = ab_re; a128i = ab_im;
#pragma unroll
            for (int k = 0; k < 7; ++k) { const float r = a128r * a128r - a128i * a128i, i = 2.f * a128r * a128i; a128r = r; a128i = i; }
            if (PASS == 1) {
                const float* cre = a.in[12] + (((size_t)(layer * 2 + dir) * 64 + g) * 16 + fr) * 64; const float* cim = a.in[13] + (((size_t)(layer * 2 + dir) * 64 + g) * 16 + fr) * 64;
#pragma unroll
                for (int ks = 0; ks < 4; ++ks) { const float* s = (ks < 2 ? cre : cim) + (ks & 1) * 32 + fq * 8; const float sg = ks < 2 ? 1.f : -1.f;
                    const f32x4 v0 = *(const f32x4*)s, v1 = *(const f32x4*)(s + 4);
                    cm[ks] = mkfrag(cvt_pk_bf16(sg * v0[0], sg * v0[1]), cvt_pk_bf16(sg * v0[2], sg * v0[3]), cvt_pk_bf16(sg * v1[0], sg * v1[1]), cvt_pk_bf16(sg * v1[2], sg * v1[3])); }
            }
        }
        __syncthreads();
        { const int t = tid >> 2, q = tid & 3; const bf16_t* s = U5 + (size_t)(row0 + t) * 1024 + gq * 64 + q * 16; const u32x4 v0 = *(const u32x4*)s, v1 = *(const u32x4*)(s + 8);
            float* d = uL + t * 64 + q * 16;
            *(f32x4*)d = (f32x4){bflo(v0.x), bfhi(v0.x), bflo(v0.y), bfhi(v0.y)}; *(f32x4*)(d + 4) = (f32x4){bflo(v0.z), bfhi(v0.z), bflo(v0.w), bfhi(v0.w)};
            *(f32x4*)(d + 8) = (f32x4){bflo(v1.x), bfhi(v1.x), bflo(v1.y), bfhi(v1.y)}; *(f32x4*)(d + 12) = (f32x4){bflo(v1.z), bfhi(v1.z), bflo(v1.w), bfhi(v1.w)};
            if (PASS == 1) { float* y = YL + q * 2048 + t * 16;
#pragma unroll
                for (int j = 0; j < 4; ++j) *(f32x4*)(y + 4 * j) = (f32x4){0.f, 0.f, 0.f, 0.f}; } }
        float sr = 0.f, si = 0.f;
        if (PASS == 1) {
            const int pos = s5_pos_of(dir, c);
#pragma unroll 1
            for (int q0 = 0; q0 < pos; q0 += 13) { float2 l[13];
#pragma unroll
                for (int i = 0; i < 13; ++i) { const int q = q0 + i < pos ? q0 + i : pos - 1; l[i] = S5LOC[((size_t)(dir * NCH + s5_chunk_at(dir, q)) * 64 + g) * 64 + p]; }
#pragma unroll
                for (int i = 0; i < 13; ++i) if (q0 + i < pos) { const float nr = a128r * sr - a128i * si + l[i].x, ni = a128r * si + a128i * sr + l[i].y; sr = nr; si = ni; } }
        }
        __syncthreads();
#pragma unroll 1
        for (int stp = 0; stp < 4; ++stp) {
#pragma unroll 4
            for (int ii = 0; ii < 32; ++ii) { const int i = stp * 32 + ii, t = dir ? 127 - i : i; const float* ut = uL + t * 64 + gl * 16;
                const f32x4 u0 = *(const f32x4*)ut, u1 = *(const f32x4*)(ut + 4), u2 = *(const f32x4*)(ut + 8), u3 = *(const f32x4*)(ut + 12);
                f32x2 b0 = {0.f, 0.f}, b1 = {0.f, 0.f};
#pragma unroll
                for (int j = 0; j < 4; ++j) { b0 = __builtin_elementwise_fma((f32x2){bbr[j], bbi[j]}, (f32x2){u0[j], u0[j]}, b0); b1 = __builtin_elementwise_fma((f32x2){bbr[4 + j], bbi[4 + j]}, (f32x2){u1[j], u1[j]}, b1);
                    b0 = __builtin_elementwise_fma((f32x2){bbr[8 + j], bbi[8 + j]}, (f32x2){u2[j], u2[j]}, b0); b1 = __builtin_elementwise_fma((f32x2){bbr[12 + j], bbi[12 + j]}, (f32x2){u3[j], u3[j]}, b1); }
                f32x2 ns = b0 + b1; ns = __builtin_elementwise_fma((f32x2){ab_re, ab_re}, (f32x2){sr, si}, ns); ns = __builtin_elementwise_fma((f32x2){-ab_im, ab_im}, (f32x2){si, sr}, ns); sr = ns[0]; si = ns[1];
                if (PASS == 1) { bf16_t* st = ST + ((size_t)(dir * 4 + gl) * 32 + (t & 31)) * 136; st[p] = (bf16_t)(cvt_pk_bf16(sr, 0.f) & 0xffffu); st[64 + p] = (bf16_t)(cvt_pk_bf16(si, 0.f) & 0xffffu); }
            }
            if (PASS == 1) {
                asm volatile("s_waitcnt lgkmcnt(0)" ::: "memory");
                const int tb = (dir ? 3 - stp : stp) * 32;
#pragma unroll
                for (int rt = 0; rt < 2; ++rt) { f32x4 acc = {0.f, 0.f, 0.f, 0.f};
#pragma unroll
                    for (int ks = 0; ks < 4; ++ks) { const bf16x8 af = *(const bf16x8*)(ST + ((size_t)(dir * 4 + gl) * 32 + rt * 16 + fr) * 136 + ks * 32 + fq * 8); acc = __builtin_amdgcn_mfma_f32_16x16x32_bf16(af, cm[ks], acc, 0, 0, 0); }
#pragma unroll
                    for (int jj = 0; jj < 4; ++jj) YL[gl * 2048 + (tb + rt * 16 + fq * 4 + jj) * 16 + fr] += acc[jj]; }
                __syncthreads();
            }
        }
        if (PASS == 0) { S5LOC[((size_t)(dir * NCH + c) * 64 + g) * 64 + p] = make_float2(sr, si); }
        else { const int t = tid >> 2, q = tid & 3; const float* y = YL + q * 2048 + t * 16; const float* u = uL + t * 64 + q * 16; const float* dd = a.in[14] + (size_t)layer * 1024 + gq * 64 + q * 16;
            unsigned o[8];
#pragma unroll
            for (int j = 0; j < 8; ++j) { const float y0 = y[2 * j] + u[2 * j] * dd[2 * j], y1 = y[2 * j + 1] + u[2 * j + 1] * dd[2 * j + 1]; o[j] = cvt_pk_bf16(gelu_tanh(y0), gelu_tanh(y1)); }
            bf16_t* dst = Y5 + (size_t)(row0 + t) * 1024 + gq * 64 + q * 16; u32x4 o0, o1; o0.x = o[0]; o0.y = o[1]; o0.z = o[2]; o0.w = o[3]; o1.x = o[4]; o1.y = o[5]; o1.z = o[6]; o1.w = o[7];
            *(u32x4*)dst = o0; *(u32x4*)(dst + 8) = o1; }
    }
    __syncthreads();
}

__device__ __forceinline__ int ssd_chunk_at(int dir, int q) { return s5_chunk_at(dir, q); }
__device__ __forceinline__ void conv8(const bf16_t* XBC, int rowbase, int l0, int ch, bool lo_ok, bool hi_ok, float w0, float w1, float w2, float b, float (&out)[8]) {
    float r[10];
#pragma unroll
    for (int i = 0; i < 10; ++i) { const int l = l0 - 1 + i; const bool ok = (l >= 0 || lo_ok) && (l < 128 || hi_ok); r[i] = ok ? bf2f((unsigned)XBC[(size_t)(rowbase + l) * 3072 + ch]) : 0.f; }
#pragma unroll
    for (int j = 0; j < 8; ++j) out[j] = silu_(w0 * r[j] + w1 * r[j + 1] + w2 * r[j + 2] + b);
}
__device__ __forceinline__ void stage_conv_tile(const bf16_t* XBC, const float* cw, const float* cb, int rowbase, int chbase, bool lo_ok, bool hi_ok, bf16_t* dst, int tid) {
    const int oc = tid & 15, ch = chbase + oc * 8; float w[3][8], b[8];
#pragma unroll
    for (int k = 0; k < 3; ++k) { const f32x4 a0 = *(const f32x4*)(cw + (size_t)k * 3072 + ch), a1 = *(const f32x4*)(cw + (size_t)k * 3072 + ch + 4);
        w[k][0] = a0[0]; w[k][1] = a0[1]; w[k][2] = a0[2]; w[k][3] = a0[3]; w[k][4] = a1[0]; w[k][5] = a1[1]; w[k][6] = a1[2]; w[k][7] = a1[3]; }
    { const f32x4 a0 = *(const f32x4*)(cb + ch), a1 = *(const f32x4*)(cb + ch + 4); b[0] = a0[0]; b[1] = a0[1]; b[2] = a0[2]; b[3] = a0[3]; b[4] = a1[0]; b[5] = a1[1]; b[6] = a1[2]; b[7] = a1[3]; }
#pragma unroll
    for (int i = 0; i < 4; ++i) { const int row = (tid >> 4) + i * 32; float acc[8];
#pragma unroll
        for (int k = 0; k < 8; ++k) acc[k] = b[k];
#pragma unroll
        for (int d = 0; d < 3; ++d) { const int l = row + d - 1; const bool ok = (l >= 0 || lo_ok) && (l < 128 || hi_ok);
            if (ok) { const u32x4 g = *(const u32x4*)(XBC + (size_t)(rowbase + l) * 3072 + ch);
                acc[0] += w[d][0] * bflo(g.x); acc[1] += w[d][1] * bfhi(g.x); acc[2] += w[d][2] * bflo(g.y); acc[3] += w[d][3] * bfhi(g.y);
                acc[4] += w[d][4] * bflo(g.z); acc[5] += w[d][5] * bfhi(g.z); acc[6] += w[d][6] * bflo(g.w); acc[7] += w[d][7] * bfhi(g.w); } }
        u32x4 o; o.x = cvt_pk_bf16(silu_(acc[0]), silu_(acc[1])); o.y = cvt_pk_bf16(silu_(acc[2]), silu_(acc[3])); o.z = cvt_pk_bf16(silu_(acc[4]), silu_(acc[5])); o.w = cvt_pk_bf16(silu_(acc[6]), silu_(acc[7]));
        *(u32x4*)(dst + row * 136 + oc * 8) = o; }
}
constexpr int SL_CS = 0, SL_CB = 34816, SL_CUM = 69632, SL_DT = 77824, SL_PART = 86016, SL_BS = 94208, SL_XF = 94208;
template <int AUX> __device__ __forceinline__ void ssd_cum(const Args& a, int layer, int c, int h, int w, int lane, unsigned char* lds) {
    const float* DT = (const float*)(a.ws + WS_BIG + B_DT); float* cumL = (float*)(lds + SL_CUM); float* dtL = (float*)(lds + SL_DT); float* CHD = (float*)(a.ws + WS_CHD);
#pragma unroll
    for (int dir = 0; dir < 2; ++dir) {
        const float ah = -expf(a.in[20][(size_t)(layer * 2 + dir) * 32 + h]);
        const float d0 = DT[(size_t)(c * 128 + 2 * lane) * 64 + dir * 32 + h], d1 = DT[(size_t)(c * 128 + 2 * lane + 1) * 64 + dir * 32 + h];
        const float l0 = d0 * ah, l1 = d1 * ah, s = l0 + l1; float incl = s;
#pragma unroll
        for (int o = 1; o < 64; o <<= 1) { const float t = __shfl_up(incl, o); if (lane >= o) incl += t; }
        const float excl = incl - s, tot = __shfl(incl, 63);
        float c0, c1;
        if (dir == 0) { c0 = excl + l0; c1 = incl; } else { c0 = tot - excl; c1 = tot - (excl + l0); }
        float* cu = cumL + (dir * 8 + w) * 128 + 2 * lane; cu[0] = c0; cu[1] = c1;
        float* dd = dtL + (dir * 8 + w) * 128 + 2 * lane;
        if (AUX == 0) { dd[0] = d0; dd[1] = d1; } else { dd[0] = d0 * __expf(tot - c0); dd[1] = d1 * __expf(tot - c1); if (lane == 0) CHD[(size_t)(dir * NCH + c) * 32 + h] = tot; }
    }
}
__device__ __forceinline__ void ssd_a_phase(const Args& a, int layer, unsigned char* lds, int tid) {
    const bf16_t* XBC = (const bf16_t*)(a.ws + WS_BIG + B_XBC); bf16_t* SST = (bf16_t*)(a.ws + WS_SST);
    const float* cw = a.in[17] + (size_t)layer * 3 * 3072; const float* cb = a.in[18] + (size_t)layer * 3072;
    bf16_t* Bs = (bf16_t*)(lds + SL_BS); const float* wL = (const float*)(lds + SL_DT);
    const int lane = tid & 63, w = tid >> 6, fr = lane & 15, fq = lane >> 4;
    for (int unit = blockIdx.x; unit < NCH * 4; unit += gridDim.x) {
        const int c = unit >> 2, g = unit & 3, rowbase = c * 128, h = g * 8 + w; const bool lo_ok = !(c == 0 || c == 128), hi_ok = !(c == 127 || c == 129);
        __syncthreads();
        stage_conv_tile(XBC, cw, cb, rowbase, 2048 + g * 128, lo_ok, hi_ok, Bs, tid);
        ssd_cum<1>(a, layer, c, h, w, lane, lds);
        __syncthreads();
#pragma unroll 1
        for (int dir = 0; dir < 2; ++dir) {
            bf16_t* sb = SST + (((size_t)(dir * NCH + c) * 32 + h) * 64) * 128;
#pragma unroll 1
            for (int pt = 0; pt < 4; ++pt) {
                const int ch = h * 64 + pt * 16 + fr; const float w0 = cw[ch], w1 = cw[3072 + ch], w2 = cw[6144 + ch], bb = cb[ch];
                f32x4 acc[8];
#pragma unroll
                for (int nt = 0; nt < 8; ++nt) acc[nt] = (f32x4){0.f, 0.f, 0.f, 0.f};
#pragma unroll 2
                for (int ks = 0; ks < 4; ++ks) {
                    const float* wp = wL + (dir * 8 + w) * 128 + ks * 32 + fq * 8; const f32x4 wl0 = *(const f32x4*)wp, wl1 = *(const f32x4*)(wp + 4);
                    float x[8]; conv8(XBC, rowbase, ks * 32 + fq * 8, ch, lo_ok, hi_ok, w0, w1, w2, bb, x);
                    const bf16x8 yf = mkfrag(cvt_pk_bf16(x[0] * wl0[0], x[1] * wl0[1]), cvt_pk_bf16(x[2] * wl0[2], x[3] * wl0[3]), cvt_pk_bf16(x[4] * wl1[0], x[5] * wl1[1]), cvt_pk_bf16(x[6] * wl1[2], x[7] * wl1[3]));
#pragma unroll
                    for (int nt = 0; nt < 8; ++nt) { const bf16_t* bp = Bs + (ks * 32 + fq * 8) * 136 + nt * 16 + fr;
                        const bf16x8 xf = mkfrag((unsigned)bp[0] | ((unsigned)bp[136] << 16), (unsigned)bp[2 * 136] | ((unsigned)bp[3 * 136] << 16), (unsigned)bp[4 * 136] | ((unsigned)bp[5 * 136] << 16), (unsigned)bp[6 * 136] | ((unsigned)bp[7 * 136] << 16));
                        acc[nt] = __builtin_amdgcn_mfma_f32_16x16x32_bf16(xf, yf, acc[nt], 0, 0, 0); }
                }
                mfma_settle(acc[7]); mfma_settle(acc[6]);
#pragma unroll
                for (int nt = 0; nt < 8; ++nt) { u32x2 o; o.x = cvt_pk_bf16(acc[nt][0], acc[nt][1]); o.y = cvt_pk_bf16(acc[nt][2], acc[nt][3]);
                    *(u32x2*)(sb + (size_t)(pt * 16 + fr) * 128 + nt * 16 + fq * 4) = o; }
            }
        }
    }
    __syncthreads();
}
__device__ __forceinline__ void ssd_b_phase(const Args& a, int tid) {
    bf16_t* SST = (bf16_t*)(a.ws + WS_SST); const float* CHD = (const float*)(a.ws + WS_CHD);
    for (int idx = blockIdx.x * 512 + tid; idx < 64 * 2048; idx += gridDim.x * 512) {
        const int e4 = idx & 2047, hd = idx >> 11, dir = hd >> 5, h = hd & 31; float s0 = 0.f, s1 = 0.f, s2 = 0.f, s3 = 0.f;
#pragma unroll 1
        for (int b = 0; b < 13; ++b) { u32x2 loc[10]; float dc[10];
#pragma unroll
            for (int i = 0; i < 10; ++i) { const int cq = ssd_chunk_at(dir, b * 10 + i); loc[i] = *(const u32x2*)(SST + ((size_t)(dir * NCH + cq) * 32 + h) * 8192 + e4 * 4); dc[i] = CHD[(size_t)(dir * NCH + cq) * 32 + h]; }
#pragma unroll
            for (int i = 0; i < 10; ++i) { const int cq = ssd_chunk_at(dir, b * 10 + i); u32x2 o; o.x = cvt_pk_bf16(s0, s1); o.y = cvt_pk_bf16(s2, s3);
                *(u32x2*)(SST + ((size_t)(dir * NCH + cq) * 32 + h) * 8192 + e4 * 4) = o; const float e = __expf(dc[i]);
                s0 = e * s0 + bflo(loc[i].x); s1 = e * s1 + bfhi(loc[i].x); s2 = e * s2 + bflo(loc[i].y); s3 = e * s3 + bfhi(loc[i].y); }
        }
    }
}
__device__ __forceinline__ void ssd_c_phase(const Args& a, int layer, unsigned char* lds, int tid, int nchunks) {
    const bf16_t* XBC = (const bf16_t*)(a.ws + WS_BIG + B_XBC); const bf16_t* SST = (const bf16_t*)(a.ws + WS_SST); const bf16_t* Z = (const bf16_t*)(a.ws + WS_BIG + B_Z); bf16_t* YD = (bf16_t*)(a.ws + WS_BIG + B_YD);
    const float* cw = a.in[17] + (size_t)layer * 3 * 3072; const float* cb = a.in[18] + (size_t)layer * 3072; const float* normw = a.in[22] + (size_t)layer * 2048;
    bf16_t* Cs = (bf16_t*)(lds + SL_CS); bf16_t* Bs = (bf16_t*)(lds + SL_BS); bf16_t* CBs = (bf16_t*)(lds + SL_CB); const float* cumL = (const float*)(lds + SL_CUM); const float* dtL = (const float*)(lds + SL_DT); float* part = (float*)(lds + SL_PART);
    const int lane = tid & 63, w = tid >> 6, fr = lane & 15, fq = lane >> 4;
    for (int unit = blockIdx.x; unit < nchunks * 4; unit += gridDim.x) {
        const int c = unit >> 2, g = unit & 3, rowbase = c * 128, h = g * 8 + w; const bool lo_ok = !(c == 0 || c == 128), hi_ok = !(c == 127 || c == 129);
        const float Dh = a.in[21][(size_t)layer * 32 + h];
        __syncthreads();
        stage_conv_tile(XBC, cw, cb, rowbase, 2560 + g * 128, lo_ok, hi_ok, Cs, tid);
        stage_conv_tile(XBC, cw, cb, rowbase, 2048 + g * 128, lo_ok, hi_ok, Bs, tid);
        ssd_cum<0>(a, layer, c, h, w, lane, lds);
        __syncthreads();
#pragma unroll 1
        for (int st = 0; st < 8; ++st) { f32x4 acc = {0.f, 0.f, 0.f, 0.f};
#pragma unroll
            for (int ks = 0; ks < 4; ++ks) { const bf16x8 xf = *(const bf16x8*)(Bs + (st * 16 + fr) * 136 + ks * 32 + fq * 8), yf = *(const bf16x8*)(Cs + (w * 16 + fr) * 136 + ks * 32 + fq * 8);
                acc = __builtin_amdgcn_mfma_f32_16x16x32_bf16(xf, yf, acc, 0, 0, 0); }
            mfma_settle(acc);
            u32x2 o; o.x = cvt_pk_bf16(acc[0], acc[1]); o.y = cvt_pk_bf16(acc[2], acc[3]); *(u32x2*)(CBs + (w * 16 + fr) * 136 + st * 16 + fq * 4) = o; }
        __syncthreads();
#pragma unroll 1
        for (int hp = 0; hp < 2; ++hp) {
        bf16_t* XFw = (bf16_t*)(lds + SL_XF) + (size_t)w * 4096;
#pragma unroll 2
        for (int f = 0; f < 8; ++f) { const int p2 = f & 1, ks = f >> 1; const int ch = h * 64 + (hp * 2 + p2) * 16 + fr; const float w0 = cw[ch], w1 = cw[3072 + ch], w2 = cw[6144 + ch], bb = cb[ch];
            float x[8]; conv8(XBC, rowbase, ks * 32 + fq * 8, ch, lo_ok, hi_ok, w0, w1, w2, bb, x);
            *(bf16x8*)(XFw + (f * 64 + lane) * 8) = mkfrag(cvt_pk_bf16(x[0], x[1]), cvt_pk_bf16(x[2], x[3]), cvt_pk_bf16(x[4], x[5]), cvt_pk_bf16(x[6], x[7])); }
        asm volatile("s_waitcnt lgkmcnt(0)" ::: "memory");
#pragma unroll 1
        for (int lt = 0; lt < 8; ++lt) {
            const int l = lt * 16 + fr; f32x4 acc[2];
#pragma unroll
            for (int p2 = 0; p2 < 2; ++p2) acc[p2] = (f32x4){0.f, 0.f, 0.f, 0.f};
#pragma unroll
            for (int dir = 0; dir < 2; ++dir) {
                f32x4 tmp[2];
#pragma unroll
                for (int p2 = 0; p2 < 2; ++p2) tmp[p2] = (f32x4){0.f, 0.f, 0.f, 0.f};
                const bf16_t* sb = SST + (((size_t)(dir * NCH + c) * 32 + h) * 64) * 128;
#pragma unroll
                for (int ks = 0; ks < 4; ++ks) { const bf16x8 yf = *(const bf16x8*)(Cs + l * 136 + ks * 32 + fq * 8);
#pragma unroll
                    for (int p2 = 0; p2 < 2; ++p2) { const bf16x8 sf = *(const bf16x8*)(sb + (size_t)((hp * 2 + p2) * 16 + fr) * 128 + ks * 32 + fq * 8); tmp[p2] = __builtin_amdgcn_mfma_f32_16x16x32_bf16(sf, yf, tmp[p2], 0, 0, 0); } }
                const float cl = cumL[(dir * 8 + w) * 128 + l], el = __expf(cl);
#pragma unroll
                for (int p2 = 0; p2 < 2; ++p2) acc[p2] += tmp[p2] * el;
#pragma unroll
                for (int ks = 0; ks < 4; ++ks) { const int s0 = ks * 32;
                    const bool skip = dir == 0 ? (s0 > lt * 16 + 15) : (s0 + 31 < lt * 16);
                    if (!skip) { const u32x4 cbv = *(const u32x4*)(CBs + l * 136 + s0 + fq * 8);
                        const float* cp = cumL + (dir * 8 + w) * 128 + s0 + fq * 8; const float* dp = dtL + (dir * 8 + w) * 128 + s0 + fq * 8;
                        const f32x4 c0 = *(const f32x4*)cp, c1 = *(const f32x4*)(cp + 4), d0 = *(const f32x4*)dp, d1 = *(const f32x4*)(dp + 4);
                        float cbf[8] = {bflo(cbv.x), bfhi(cbv.x), bflo(cbv.y), bfhi(cbv.y), bflo(cbv.z), bfhi(cbv.z), bflo(cbv.w), bfhi(cbv.w)}; float v[8];
#pragma unroll
                        for (int j = 0; j < 8; ++j) { const int s = s0 + fq * 8 + j; const float cs = j < 4 ? c0[j & 3] : c1[j & 3], ds = j < 4 ? d0[j & 3] : d1[j & 3];
                            const bool valid = dir == 0 ? (s <= l) : (s >= l); float t = valid ? cbf[j] * __expf(fminf(cl - cs, 0.f)) * ds : 0.f; if (dir == 0 && s == l) t += Dh; v[j] = t; }
                        const bf16x8 yf = mkfrag(cvt_pk_bf16(v[0], v[1]), cvt_pk_bf16(v[2], v[3]), cvt_pk_bf16(v[4], v[5]), cvt_pk_bf16(v[6], v[7]));
#pragma unroll
                        for (int p2 = 0; p2 < 2; ++p2) acc[p2] = __builtin_amdgcn_mfma_f32_16x16x32_bf16(*(const bf16x8*)(XFw + ((ks * 2 + p2) * 64 + lane) * 8), yf, acc[p2], 0, 0, 0); }
                    }
            }
            const size_t row = (size_t)(rowbase + l); float ss = 0.f;
#pragma unroll
            for (int p2 = 0; p2 < 2; ++p2) { const int ch = h * 64 + (hp * 2 + p2) * 16 + fq * 4; const u32x2 zz = *(const u32x2*)(Z + row * 2048 + ch);
                const float h0 = acc[p2][0] * silu_(bflo(zz.x)), h1 = acc[p2][1] * silu_(bfhi(zz.x)), h2 = acc[p2][2] * silu_(bflo(zz.y)), h3 = acc[p2][3] * silu_(bfhi(zz.y));
                ss += (h0 * h0 + h1 * h1) + (h2 * h2 + h3 * h3); u32x2 o; o.x = cvt_pk_bf16(h0, h1); o.y = cvt_pk_bf16(h2, h3); *(u32x2*)(YD + row * 2048 + ch) = o; }
            ss += __shfl_xor(ss, 16); ss += __shfl_xor(ss, 32);
            if (fq == 0) part[(hp * 8 + w) * 128 + l] = ss;
        }
        }
        __syncthreads();
#pragma unroll 1
        for (int lt = 0; lt < 8; ++lt) { const int l = lt * 16 + fr; float tot = 0.f;
#pragma unroll
            for (int ww = 0; ww < 16; ++ww) tot += part[ww * 128 + l];
            const float r = 1.f / sqrtf(tot * (1.f / 512.f) + RMS_EPS); const size_t row = (size_t)(rowbase + l);
#pragma unroll
            for (int pt = 0; pt < 4; ++pt) { const int ch = h * 64 + pt * 16 + fq * 4; bf16_t* yp = YD + row * 2048 + ch; const u32x2 hv = *(const u32x2*)yp; const f32x4 nw = *(const f32x4*)(normw + ch);
                u32x2 o; o.x = cvt_pk_bf16(bflo(hv.x) * r * nw[0], bfhi(hv.x) * r * nw[1]); o.y = cvt_pk_bf16(bflo(hv.y) * r * nw[2], bfhi(hv.y) * r * nw[3]); *(u32x2*)yp = o; } }
    }
    __syncthreads();
}

#ifndef MK_REP_S5
#define MK_REP_S5 1
#endif
#ifndef MK_REP_SSD
#define MK_REP_SSD 1
#endif
constexpr int NPHASE = 2 + 11 * 2;
__global__ void __launch_bounds__(512, 2) fwd_megakernel(Args a) {
    extern __shared__ __attribute__((aligned(16))) unsigned char lds[];
    PG8_LAS unsigned char* lds3 = (PG8_LAS unsigned char*)lds;
    unsigned char* big = a.ws + WS_BIG;
    for (int ph = a.ph_lo; ph < a.ph_hi; ++ph) {
        const int tid = pg8::pg8_tid(), lane = tid & 63, wave = tid >> 6, gw = blockIdx.x * 8 + wave, NGW = gridDim.x * 8;
        if (ph == 0) {
            adaln_phase(a, (float*)lds, tid);
            float* scr = (float*)lds + wave * (64 * 33);
            xpose_region(a, 0, 0, scr, gw, NGW, lane); xpose_region(a, 0, 1, scr, gw, NGW, lane);
        } else if (ph == 1) {
            row_phase<0>(a, MT, nullptr, nullptr, 0, 0, gw, NGW, lane);
        } else {
            const int layer = (ph - 2) / 11, k = (ph - 2) % 11; const bool last = layer == 1; const int Mrows = last ? TL : MT;
            const bf16_t* WA = (const bf16_t*)(a.ws + WS_WA); const bf16_t* WB = (const bf16_t*)(a.ws + WS_WB);
#ifdef MK_SKIP_MASK
            if ((MK_SKIP_MASK >> k) & 1) { if (ph + 1 < a.ph_hi) cg::this_grid().sync(); continue; }
#endif
            if (k == 0) {
                pg8::Gemm g{(const bf16_t*)(a.ws + WS_XM), WA + WA_IN / 2, MT, NPROJ, D}; pg8::StaticOrder S; S.init(MT, NPROJ, gridDim.x, blockIdx.x);
                EpiInProj E{big, a.in[19] + (size_t)layer * 64}; pg8::gemm_phase<EpiInProj, pg8::StaticOrder>(lds3, g, S, E, nullptr);
            } else if (k == 1) {
                for (int rep = 0; rep < MK_REP_SSD; ++rep) ssd_a_phase(a, layer, lds, tid);
                for (int rep = 0; rep < MK_REP_S5; ++rep) s5_phase<0>(a, layer, lds, tid, NCH);
            } else if (k == 2) {
#if !defined(MK_NO_SSD) && !defined(MK_NO_SSDB)
                ssd_b_phase(a, tid);
#endif
                for (int rep = 0; rep < MK_REP_S5; ++rep) s5_phase<1>(a, layer, lds, tid, last ? 128 : NCH);
            } else if (k == 3) {
                for (int rep = 0; rep < MK_REP_SSD; ++rep) ssd_c_phase(a, layer, lds, tid, last ? 128 : NCH);
#ifndef MK_NO_S5
                pg8::Gemm g{(const bf16_t*)(big + B_Y5), WA + WA_GLU / 2, Mrows, 2048, 1024}; pg8::StaticOrder S; S.init(Mrows, 2048, gridDim.x, blockIdx.x);
                EpiGlu E{(bf16_t*)(big + B_U5)}; pg8::gemm_phase<EpiGlu, pg8::StaticOrder>(lds3, g, S, E, nullptr);
#endif
            } else if (k == 4) {
#ifndef MK_NO_S5
                { pg8::Gemm g{(const bf16_t*)(big + B_U5), WA + WA_S5P / 2, Mrows, 2048, 1024}; pg8::StaticOrder S; S.init(Mrows, 2048, gridDim.x, blockIdx.x);
                  EpiMerge<0> E{(bf16_t*)(big + B_XBC), (const bf16_t*)(big + B_GATE)}; pg8::gemm_phase<EpiMerge<0>, pg8::StaticOrder>(lds3, g, S, E, nullptr); }
                __syncthreads();
#endif
#ifndef MK_NO_SSD
#ifdef MK_NO_S5
                { pg8::Gemm g{(const bf16_t*)(big + B_YD), WA + WA_SSDP / 2, Mrows, 2048, 2048}; pg8::StaticOrder S; S.init(Mrows, 2048, gridDim.x, blockIdx.x);
                  EpiMerge<0, 1> E{(bf16_t*)(big + B_XBC), (const bf16_t*)(big + B_GATE)}; pg8::gemm_phase<EpiMerge<0, 1>, pg8::StaticOrder>(lds3, g, S, E, nullptr); }
#else
                { pg8::Gemm g{(const bf16_t*)(big + B_YD), WA + WA_SSDP / 2, Mrows, 2048, 2048}; pg8::StaticOrder S; S.init(Mrows, 2048, gridDim.x, blockIdx.x);
                  EpiMerge<1> E{(bf16_t*)(big + B_XBC), (const bf16_t*)(big + B_GATE)}; pg8::gemm_phase<EpiMerge<1>, pg8::StaticOrder>(lds3, g, S, E, nullptr); }
#endif
#endif
            } else if (k == 5) {
                pg8::Gemm g{(const bf16_t*)(big + B_XBC), WA + WA_WOUT / 2, Mrows, 2048, 2048}; pg8::StaticOrder S; S.init(Mrows, 2048, gridDim.x, blockIdx.x);
                EpiResid E{a.out, (float*)(a.ws + WS_HCTX), mvec(a, layer, 0) + 2 * D, mvec(a, layer, 1) + 2 * D}; pg8::gemm_phase<EpiResid, pg8::StaticOrder>(lds3, g, S, E, nullptr);
            } else if (k == 6) {
                row_phase<1>(a, Mrows, a.in[25] + (size_t)layer * D, a.in[26] + (size_t)layer * D, layer, 3 * D, gw, NGW, lane);
                if (!last) { __syncthreads(); xpose_region(a, layer + 1, 0, (float*)lds + wave * (64 * 33), gw, NGW, lane); }
            } else if (k == 7) {
                pg8::Gemm g{(const bf16_t*)(a.ws + WS_XM), WB + WB_UP / 2, Mrows, 2 * DFF, D}; pg8::StaticOrder S; S.init(Mrows, 2 * DFF, gridDim.x, blockIdx.x);
                EpiUp E{(bf16_t*)(big + B_G), (bf16_t*)(big + B_V)}; pg8::gemm_phase<EpiUp, pg8::StaticOrder>(lds3, g, S, E, nullptr);
            } else if (k == 8) {
                ffnconv_phase(a, layer, !last, tid);
            } else if (k == 9) {
                pg8::Gemm g{(const bf16_t*)(big + B_V), WB + WB_DOWN / 2, Mrows, D, DFF}; pg8::StaticOrder S; S.init(Mrows, D, gridDim.x, blockIdx.x);
                EpiResid E{a.out, (float*)(a.ws + WS_HCTX), mvec(a, layer, 0) + 5 * D, mvec(a, layer, 1) + 5 * D}; pg8::gemm_phase<EpiResid, pg8::StaticOrder>(lds3, g, S, E, nullptr);
            } else {
                row_phase<1>(a, Mrows, a.in[31] + (size_t)layer * D, a.in[32] + (size_t)layer * D, last ? -1 : layer + 1, 0, gw, NGW, lane);
                if (!last) { __syncthreads(); xpose_region(a, layer + 1, 1, (float*)lds + wave * (64 * 33), gw, NGW, lane); }
            }
        }
        if (ph + 1 < a.ph_hi) cg::this_grid().sync();
    }
}
}

#ifndef MK_N_LAUNCH_MODE
#define MK_N_LAUNCH_MODE 0
#endif
extern "C" void kernel_launch(void* const* d_in, const int* in_sizes, int n_in, void* d_out, int out_size, void* d_ws, size_t ws_size, hipStream_t stream) {
    static int grid = 0;
    if (grid == 0) {
        if (n_in != 33 || ws_size < mk::WS_END) { fprintf(stderr, "kernel_launch: need 33 inputs and %zu bytes of workspace (got %d, %zu)\n", (size_t)mk::WS_END, n_in, ws_size); grid = -1; return; }
        int dev = 0, cus = 0, per_cu = 0;
        (void)hipGetDevice(&dev); (void)hipDeviceGetAttribute(&cus, hipDeviceAttributeMultiprocessorCount, dev);
        if (hipFuncSetAttribute((const void*)mk::fwd_megakernel, hipFuncAttributeMaxDynamicSharedMemorySize, mk::LDS_BYTES) != hipSuccess) { fprintf(stderr, "kernel_launch: hipFuncSetAttribute failed\n"); grid = -1; return; }
        if (hipOccupancyMaxActiveBlocksPerMultiprocessor(&per_cu, (const void*)mk::fwd_megakernel, 512, mk::LDS_BYTES) != hipSuccess || per_cu < 1) { fprintf(stderr, "kernel_launch: occupancy query says %d\n", per_cu); per_cu = 1; }
        (void)hipGetLastError();
        grid = cus * per_cu; if (grid > 256) grid = 256;
    }
    if (grid < 0) return;
    mk::Args a{};
    for (int i = 0; i < 33; ++i) a.in[i] = (const float*)d_in[i];
    a.out = (float*)d_out; a.ws = (unsigned char*)d_ws;
#if MK_N_LAUNCH_MODE == 1
    for (int ph = 0; ph < mk::NPHASE; ++ph) { a.ph_lo = ph; a.ph_hi = ph + 1; hipLaunchKernelGGL(mk::fwd_megakernel, dim3(grid), dim3(512), mk::LDS_BYTES, stream, a); }
#else
    a.ph_lo = 0; a.ph_hi = mk::NPHASE;
    void* args[] = {&a};
    hipError_t e = hipLaunchCooperativeKernel((const void*)mk::fwd_megakernel, dim3(grid), dim3(512), args, mk::LDS_BYTES, stream);
    if (e != hipSuccess) fprintf(stderr, "cooperative launch failed: %s (grid %d)\n", hipGetErrorString(e), grid);
#endif
}
```

```cpp
#include <hip/hip_runtime.h>
#include <hip/hip_cooperative_groups.h>
#include <cstdio>
namespace cg = cooperative_groups;
#define MK_N_LAUNCH_MODE 0
namespace pg8 {
#define PG8_LAS __attribute__((address_space(3)))
typedef unsigned short bf16_t;
typedef short bf16x8 __attribute__((ext_vector_type(8)));
typedef float f32x4 __attribute__((ext_vector_type(4)));
typedef unsigned u32x4 __attribute__((ext_vector_type(4)));
constexpr int BM = 256, BK = 64, HALF = 128, HTB = HALF * BK * 2  , STAGE_BYTES = 8 * HTB, NXCD = 8, WGM = 8;

__host__ __device__ __forceinline__ int lds_byte(int r, int c) { const int st = (r >> 4) * 2 + (c >> 5), rr = r & 15, cc = c & 31, ob = rr * 64 + cc * 2; return st * 1024 + (ob ^ (((ob >> 9) & 1) << 5)); }
__host__ __device__ __forceinline__ void stage_rc(int b, int& R, int& C) { const int st = b / 1024, sb = b % 1024, swz = sb ^ (((sb >> 9) & 1) << 5); R = (st >> 1) * 16 + swz / 64; C = (st & 1) * 32 + (swz % 64) / 2; }
__host__ __device__ __forceinline__ int perm32(int rho) { const int n = rho >> 4, i = rho & 15; return 8 * (i >> 2) + 4 * n + (i & 3); }

__device__ __forceinline__ int pg8_tid() { int t = threadIdx.x; asm volatile("" : "+v"(t)); return t; }
struct Unit { int pm, pn; };
struct Gemm { const bf16_t* A; const bf16_t* Bt; int M, N, K; };

struct StaticOrder {
    int nM, nN, nwg, G, c;
    __host__ __device__ void init(int M, int N, int G_, int c_) { nM = M / BM; nN = N / BM; nwg = nM * nN; G = G_; c = c_; }
    __host__ __device__ bool next(int i, Unit& u) const {
        const long L = (long)i * G + c; if (L >= nwg) return false;
        int wgid = (int)L; { const int q = nwg / NXCD, r = nwg % NXCD, xcd = wgid % NXCD, off = wgid / NXCD; wgid = (xcd < r ? xcd * (q + 1) : r * (q + 1) + (xcd - r) * q) + off; }
        const int nig = WGM * nN, gid = wgid / nig, fm = gid * WGM, gsz = (nM - fm) < WGM ? (nM - fm) : WGM;
        u.pm = fm + ((wgid % nig) % gsz); u.pn = (wgid % nig) / gsz; return true;
    }
    __device__ __forceinline__ void a_ready(const Unit&) const {}
    __device__ __forceinline__ void done(const Unit&) const {}
};
__device__ __forceinline__ unsigned cvt_pk_bf16(float lo, float hi) { unsigned r; asm volatile("v_cvt_pk_bf16_f32 %0, %1, %2" : "=v"(r) : "v"(lo), "v"(hi)); return r; }
__device__ __forceinline__ void mfma_settle(const float __attribute__((ext_vector_type(4)))& a) { asm volatile("s_nop 15\n\ts_nop 7" :: "v"(a)); }
typedef float f32x2 __attribute__((ext_vector_type(2)));
template <class Epi, class Sched, bool STAMP = false>
__device__ __forceinline__ void gemm_phase(PG8_LAS unsigned char* lds, const Gemm g, const Sched& S, const Epi& E, unsigned long long* stamps) {
    const int tid = pg8_tid(), wid = __builtin_amdgcn_readfirstlane(tid >> 6), lane = tid & 63, wr = wid >> 2, wc = wid & 3, fr = lane & 15, fq = lane >> 4;
    const int K = g.K, nt = K / BK;
    int ts_lo = 0, ts_hi = 0, nts = 0; const unsigned long long rt_entry = STAMP ? (unsigned long long)wall_clock64() : 0ull;
#define PG8_STAMP() do { if (STAMP && wid == 0 && nts < 64) { const unsigned long long _c = (unsigned long long)clock64(); \
        ts_lo = (lane == nts) ? (int)(unsigned)_c : ts_lo; ts_hi = (lane == nts) ? (int)(unsigned)(_c >> 32) : ts_hi; ++nts; } } while (0)
    PG8_STAMP();
    unsigned voffA[2], voffB[2];
#pragma unroll
    for (int i = 0; i < 2; ++i) { int R, C; stage_rc(tid * 16 + i * 8192, R, C); const int Rb = Epi::PERM ? ((R & ~31) + perm32(R & 31)) : R;
        voffA[i] = (unsigned)(R * K + C) * 2u; voffB[i] = (unsigned)(Rb * K + C) * 2u; }
    const size_t kstep = (size_t)(BK * 2);
    const size_t hstep = (size_t)HALF * K * 2;
    const size_t tstep = 2 * hstep;
    const unsigned ldsw = (unsigned)wid * 1024u;
    const int aoff = lds_byte(wr * 64 + fr, fq * 8), boff = lds_byte(wc * 32 + fr, fq * 8);
#define PG8_SA(b, h) (((b) * 2 + (h)) * HTB)
#define PG8_SB(b, h) ((4 + (b) * 2 + (h)) * HTB)
#define PG8_STAGE(bufoff, gbase, voff) do { _Pragma("unroll") for (int _i = 0; _i < 2; ++_i) \
        __builtin_amdgcn_global_load_lds((const unsigned*)((const char*)(gbase) + (voff)[_i]), (PG8_LAS unsigned*)(lds + (bufoff) + ldsw + _i * 8192), 16, 0, 0); } while (0)
#define PG8_LDA(dst, b, h) do { _Pragma("unroll") for (int m = 0; m < 4; ++m) _Pragma("unroll") for (int k = 0; k < 2; ++k) dst[m][k] = *(const PG8_LAS bf16x8*)(lds + PG8_SA(b, h) + aoff + m * 2048 + k * 1024); } while (0)
#define PG8_LDB(dst, b, h) do { _Pragma("unroll") for (int n = 0; n < 2; ++n) _Pragma("unroll") for (int k = 0; k < 2; ++k) dst[n][k] = *(const PG8_LAS bf16x8*)(lds + PG8_SB(b, h) + boff + n * 2048 + k * 1024); } while (0)
#define PG8_MMA(ai, bj, At, Bt) do { __builtin_amdgcn_s_setprio(1); _Pragma("unroll") for (int m = 0; m < 4; ++m) _Pragma("unroll") for (int n = 0; n < 2; ++n) _Pragma("unroll") for (int k = 0; k < 2; ++k) \
        acc[ai][bj][m][n] = __builtin_amdgcn_mfma_f32_16x16x32_bf16(Bt[n][k], At[m][k], acc[ai][bj][m][n], 0, 0, 0); __builtin_amdgcn_s_setprio(0); } while (0)
#define PG8_WAIT_V(n) asm volatile("s_waitcnt vmcnt(" #n ")" ::: "memory")
#define PG8_WAIT_L(n) asm volatile("s_waitcnt lgkmcnt(" #n ")" ::: "memory")
#define PG8_BAR __builtin_amdgcn_s_barrier()
#define PG8_SCHED __builtin_amdgcn_sched_barrier(0)
    Unit cur, nxt; int ui = 0;
    if (!S.next(0, cur)) return;
    f32x4 acc[2][2][4][2];
#pragma unroll
    for (int a = 0; a < 2; ++a)
#pragma unroll
        for (int b = 0; b < 2; ++b)
#pragma unroll
            for (int m = 0; m < 4; ++m)
#pragma unroll
                for (int n = 0; n < 2; ++n) acc[a][b][m][n] = (f32x4){0.f, 0.f, 0.f, 0.f};
    bf16x8 At[4][2], B0[2][2], B1[2][2];
    const char* cA = (const char*)g.A + (size_t)cur.pm * tstep; const char* cB = (const char*)g.Bt + (size_t)cur.pn * tstep;
    S.a_ready(cur);
    PG8_STAGE(PG8_SB(0, 0), cB, voffB); PG8_STAGE(PG8_SA(0, 0), cA, voffA); PG8_STAGE(PG8_SB(0, 1), cB + hstep, voffB); PG8_STAGE(PG8_SA(0, 1), cA + hstep, voffA);
    if (wr == 1) PG8_BAR;
    PG8_WAIT_V(4); PG8_BAR;
    PG8_STAGE(PG8_SB(1, 0), cB + kstep, voffB); PG8_STAGE(PG8_SA(1, 0), cA + kstep, voffA); PG8_STAGE(PG8_SB(1, 1), cB + hstep + kstep, voffB);
    PG8_WAIT_V(6); PG8_BAR;
    PG8_STAMP();
    for (;;) {
        const bool has_next = S.next(ui + 1, nxt);
        const char* nA = has_next ? (const char*)g.A + (size_t)nxt.pm * tstep : cA; const char* nB = has_next ? (const char*)g.Bt + (size_t)nxt.pn * tstep : cB;
        for (int t = 0; t < nt; t += 2) {
            const bool last = (t == nt - 2);
            const char* a1 = cA + (size_t)(t + 1) * kstep;
            const char* a2 = last ? nA : cA + (size_t)(t + 2) * kstep; const char* b2 = last ? nB : cB + (size_t)(t + 2) * kstep;
            const char* a3 = a2 + kstep; const char* b3 = b2 + kstep;
            if (last && has_next) S.a_ready(nxt);
            PG8_LDB(B0, 0, 0); PG8_SCHED; PG8_LDA(At, 0, 0); PG8_STAGE(PG8_SA(1, 1), a1 + hstep, voffA);
            PG8_WAIT_L(8); PG8_BAR; PG8_WAIT_L(0); PG8_MMA(0, 0, At, B0); PG8_BAR; PG8_SCHED;
            PG8_LDB(B1, 0, 1); PG8_STAGE(PG8_SB(0, 0), b2, voffB);
            PG8_BAR; PG8_WAIT_L(0); PG8_MMA(0, 1, At, B1); PG8_BAR;
            PG8_LDA(At, 0, 1); PG8_STAGE(PG8_SA(0, 0), a2, voffA);
            PG8_BAR; PG8_WAIT_L(0); PG8_MMA(1, 0, At, B0); PG8_BAR; PG8_SCHED;
            PG8_STAGE(PG8_SB(0, 1), b2 + hstep, voffB);
            PG8_WAIT_V(6); PG8_BAR; PG8_MMA(1, 1, At, B1); PG8_BAR;
            PG8_LDB(B0, 1, 0); PG8_SCHED; PG8_LDA(At, 1, 0); PG8_STAGE(PG8_SA(0, 1), a2 + hstep, voffA);
            PG8_WAIT_L(8); PG8_BAR; PG8_WAIT_L(0); PG8_MMA(0, 0, At, B0); PG8_BAR; PG8_SCHED;
            PG8_LDB(B1, 1, 1); PG8_STAGE(PG8_SB(1, 0), b3, voffB);
            PG8_BAR; PG8_WAIT_L(0); PG8_MMA(0, 1, At, B1); PG8_BAR;
            PG8_LDA(At, 1, 1); PG8_STAGE(PG8_SA(1, 0), a3, voffA);
            PG8_BAR; PG8_WAIT_L(0); PG8_MMA(1, 0, At, B0); PG8_BAR; PG8_SCHED;
            PG8_STAGE(PG8_SB(1, 1), b3 + hstep, voffB);
            PG8_WAIT_V(6); PG8_BAR; PG8_MMA(1, 1, At, B1); PG8_BAR;
        }
        PG8_STAMP();
        if constexpr (!Epi::AFTER_DRAIN) { E(acc, cur, wr, wc, fr, fq); S.done(cur); }
        PG8_STAMP();
        if (!has_next) break;
#pragma unroll
        for (int a = 0; a < 2; ++a)
#pragma unroll
            for (int b = 0; b < 2; ++b)
#pragma unroll
                for (int m = 0; m < 4; ++m)
#pragma unroll
                    for (int n = 0; n < 2; ++n) acc[a][b][m][n] = (f32x4){0.f, 0.f, 0.f, 0.f};
        cur = nxt; cA = nA; cB = nB; ++ui;
    }
    PG8_WAIT_V(0);
    if (wr == 0) PG8_BAR;
    PG8_BAR;
    if constexpr (Epi::AFTER_DRAIN) { E.fused(acc, cur, wr, wc, fr, fq, lds, wid, lane); S.done(cur); }
    PG8_STAMP();
    if (STAMP && wid == 0) { stamps[lane] = lane < nts ? (((unsigned long long)(unsigned)ts_hi << 32) | (unsigned)ts_lo) : 0ull;
        if (lane == 62) stamps[62] = rt_entry; if (lane == 63) stamps[63] = (unsigned long long)wall_clock64(); }
#undef PG8_STAMP
#undef PG8_SA
#undef PG8_SB
#undef PG8_STAGE
#undef PG8_LDA
#undef PG8_LDB
#undef PG8_MMA
#undef PG8_WAIT_V
#undef PG8_WAIT_L
#undef PG8_BAR
#undef PG8_SCHED
}
}

namespace mk {
using pg8::bf16_t; using pg8::bf16x8; using pg8::f32x4; using pg8::u32x4; using pg8::Unit; using pg8::cvt_pk_bf16; using pg8::mfma_settle;
typedef unsigned u32x2 __attribute__((ext_vector_type(2)));
typedef float f32x2 __attribute__((ext_vector_type(2)));
constexpr int D = 2048, TL = 16384, TC = 256, MT = TL + TC, NCH = MT / 128;
constexpr int NPROJ = 10496, DFF = 5632;
constexpr size_t MiB = 1u << 20;
constexpr size_t WS_MVEC = 0, WS_CHD = 256 * 1024, WS_BAR = 512 * 1024, WS_S5LOC = 1 * MiB, WS_WA = 10 * MiB, WS_WB = 75 * MiB, WS_HCTX = 141 * MiB, WS_XM = 143 * MiB, WS_SST = 208 * MiB, WS_BIG = 338 * MiB, WS_END = 766 * MiB;
constexpr size_t B_U5 = 0, B_XBC = B_U5 + (size_t)MT * 1024 * 2, B_Z = B_XBC + (size_t)MT * 3072 * 2, B_GATE = B_Z + (size_t)MT * 2048 * 2, B_DT = B_GATE + (size_t)MT * 4096 * 2,
                 B_Y5 = 330 * MiB, B_YD = B_Y5 + (size_t)MT * 1024 * 2;
static_assert(B_DT + (size_t)MT * 64 * 4 <= B_Y5 && B_YD + (size_t)MT * 2048 * 2 <= 428 * MiB, "big map");
constexpr size_t B_G = 0, B_V = (size_t)MT * DFF * 2;
constexpr size_t WA_IN = 0, WA_GLU = 41 * MiB, WA_S5P = 45 * MiB, WA_SSDP = 49 * MiB, WA_WOUT = 57 * MiB, WB_UP = 0, WB_DOWN = 44 * MiB;
constexpr int LDS_BYTES = 163840;
constexpr float ALPHA = 1.41421356237f, LN_EPS = 1e-5f, RMS_EPS = 1e-5f;

struct Args { const float* in[33]; float* out; unsigned char* ws; int ph_lo, ph_hi; };

__device__ __forceinline__ float bf2f(unsigned b) { return __uint_as_float(b << 16); }
__device__ __forceinline__ float bflo(unsigned w) { return __uint_as_float(w << 16); }
__device__ __forceinline__ float bfhi(unsigned w) { return __uint_as_float(w & 0xffff0000u); }
__device__ __forceinline__ float sigm(float x) { return 1.f / (1.f + __expf(-x)); }
__device__ __forceinline__ float silu_(float x) { return x / (1.f + __expf(-x)); }
__device__ __forceinline__ float gelu_tanh(float x) { const float u = 0.7978845608028654f * (x + 0.044715f * x * x * x); const float th = 1.f - 2.f / (__expf(2.f * u) + 1.f); return 0.5f * x * (1.f + th); }
__device__ __forceinline__ bf16x8 mkfrag(unsigned a, unsigned b, unsigned c, unsigned d) { u32x4 v; v.x = a; v.y = b; v.z = c; v.w = d; return __builtin_bit_cast(bf16x8, v); }
__device__ __forceinline__ float* hrow(const Args& a, int row) { return row < TL ? a.out + (size_t)row * D : (float*)(a.ws + WS_HCTX) + (size_t)(row - TL) * D; }
__device__ __forceinline__ const float* mvec(const Args& a, int layer, int isctx) { return (const float*)(a.ws + WS_MVEC) + (size_t)(layer * 2 + isctx) * 12288; }

struct EpiInProj {
    static constexpr bool PERM = true, AFTER_DRAIN = false;
    unsigned char* big; const float* dt_bias;
    __device__ __forceinline__ void operator()(const f32x4 (&acc)[2][2][4][2], const Unit& u, int wr, int wc, int fr, int fq) const {
        mfma_settle(acc[1][1][3][1]); mfma_settle(acc[1][1][3][0]);
        const int row0 = u.pm * 256 + wr * 64 + fr, ct = u.pn * 256;
        if (ct >= 10240) {
            if (wc < 2) { const int cc = wc * 32 + 8 * fq; float* DT = (float*)(big + B_DT);
                const f32x4 b0 = *(const f32x4*)(dt_bias + cc), b1 = *(const f32x4*)(dt_bias + cc + 4);
#pragma unroll
                for (int ai = 0; ai < 2; ++ai)
#pragma unroll
                    for (int m = 0; m < 4; ++m) { float* rp = DT + (size_t)(row0 + ai * 128 + m * 16) * 64 + cc; f32x4 v0 = acc[ai][0][m][0] + b0, v1 = acc[ai][0][m][1] + b1;
#pragma unroll
                        for (int j = 0; j < 4; ++j) { v0[j] = v0[j] > 20.f ? v0[j] : log1pf(expf(v0[j])); v1[j] = v1[j] > 20.f ? v1[j] : log1pf(expf(v1[j])); }
                        *(f32x4*)rp = v0; *(f32x4*)(rp + 4) = v1; } }
            return;
        }
        bf16_t* base; int ld, c0; bool sg = false;
        if (ct < 1024) { base = (bf16_t*)(big + B_U5); ld = 1024; c0 = ct; }
        else if (ct < 4096) { base = (bf16_t*)(big + B_XBC); ld = 3072; c0 = ct - 1024; }
        else if (ct < 6144) { base = (bf16_t*)(big + B_Z); ld = 2048; c0 = ct - 4096; }
        else { base = (bf16_t*)(big + B_GATE); ld = 4096; c0 = ct - 6144; sg = true; }
        const int col0 = c0 + wc * 32 + 8 * fq;
#pragma unroll
        for (int ai = 0; ai < 2; ++ai)
#pragma unroll
            for (int m = 0; m < 4; ++m) { bf16_t* rowp = base + (size_t)(row0 + ai * 128 + m * 16) * ld + col0;
#pragma unroll
                for (int bj = 0; bj < 2; ++bj) { f32x4 v0 = acc[ai][bj][m][0], v1 = acc[ai][bj][m][1];
                    if (sg) {
#pragma unroll
                        for (int j = 0; j < 4; ++j) { v0[j] = sigm(v0[j]); v1[j] = sigm(v1[j]); } }
                    u32x4 w; w.x = cvt_pk_bf16(v0[0], v0[1]); w.y = cvt_pk_bf16(v0[2], v0[3]); w.z = cvt_pk_bf16(v1[0], v1[1]); w.w = cvt_pk_bf16(v1[2], v1[3]);
                    *(u32x4*)(rowp + bj * 128) = w; } }
    }
};
struct EpiGlu {
    static constexpr bool PERM = true, AFTER_DRAIN = false;
    bf16_t* O;
    __device__ __forceinline__ void operator()(const f32x4 (&acc)[2][2][4][2], const Unit& u, int wr, int wc, int fr, int fq) const {
        mfma_settle(acc[1][1][3][1]); mfma_settle(acc[1][1][3][0]);
        const int row0 = u.pm * 256 + wr * 64 + fr, col0 = u.pn * 128 + wc * 32 + 8 * fq;
#pragma unroll
        for (int ai = 0; ai < 2; ++ai)
#pragma unroll
            for (int m = 0; m < 4; ++m) { f32x4 v0 = acc[ai][0][m][0], v1 = acc[ai][0][m][1]; const f32x4 g0 = acc[ai][1][m][0], g1 = acc[ai][1][m][1];
#pragma unroll
                for (int j = 0; j < 4; ++j) { v0[j] *= sigm(g0[j]); v1[j] *= sigm(g1[j]); }
                u32x4 w; w.x = cvt_pk_bf16(v0[0], v0[1]); w.y = cvt_pk_bf16(v0[2], v0[3]); w.z = cvt_pk_bf16(v1[0], v1[1]); w.w = cvt_pk_bf16(v1[2], v1[3]);
                *(u32x4*)(O + (size_t)(row0 + ai * 128 + m * 16) * 1024 + col0) = w; }
    }
};
template <int SECOND, int GSEL = SECOND> struct EpiMerge {
    static constexpr bool PERM = true, AFTER_DRAIN = false;
    bf16_t* MG; const bf16_t* GATE;
    __device__ __forceinline__ void operator()(const f32x4 (&acc)[2][2][4][2], const Unit& u, int wr, int wc, int fr, int fq) const {
        mfma_settle(acc[1][1][3][1]); mfma_settle(acc[1][1][3][0]);
        const int row0 = u.pm * 256 + wr * 64 + fr, col0 = u.pn * 256 + wc * 32 + 8 * fq;
#pragma unroll
        for (int ai = 0; ai < 2; ++ai)
#pragma unroll
            for (int m = 0; m < 4; ++m) { const size_t r = (size_t)(row0 + ai * 128 + m * 16);
#pragma unroll
                for (int bj = 0; bj < 2; ++bj) { const int c = col0 + bj * 128; const u32x4 g = *(const u32x4*)(GATE + r * 4096 + (GSEL ? 2048 : 0) + c);
                    f32x4 v0 = acc[ai][bj][m][0], v1 = acc[ai][bj][m][1];
                    v0[0] *= bflo(g.x); v0[1] *= bfhi(g.x); v0[2] *= bflo(g.y); v0[3] *= bfhi(g.y); v1[0] *= bflo(g.z); v1[1] *= bfhi(g.z); v1[2] *= bflo(g.w); v1[3] *= bfhi(g.w);
                    if (SECOND) { const u32x4 o = *(const u32x4*)(MG + r * 2048 + c);
                        v0[0] += bflo(o.x); v0[1] += bfhi(o.x); v0[2] += bflo(o.y); v0[3] += bfhi(o.y); v1[0] += bflo(o.z); v1[1] += bfhi(o.z); v1[2] += bflo(o.w); v1[3] += bfhi(o.w); }
                    u32x4 w; w.x = cvt_pk_bf16(v0[0], v0[1]); w.y = cvt_pk_bf16(v0[2], v0[3]); w.z = cvt_pk_bf16(v1[0], v1[1]); w.w = cvt_pk_bf16(v1[2], v1[3]);
                    *(u32x4*)(MG + r * 2048 + c) = w; } }
    }
};
struct EpiResid {
    static constexpr bool PERM = false, AFTER_DRAIN = false;
    float* out; float* hctx; const float* glat; const float* gctx;
    __device__ __forceinline__ void operator()(const f32x4 (&acc)[2][2][4][2], const Unit& u, int wr, int wc, int fr, int fq) const {
        mfma_settle(acc[1][1][3][1]); mfma_settle(acc[1][1][3][0]);
        const bool isctx = u.pm >= 64; const float* g = isctx ? gctx : glat;
        float* hb = isctx ? hctx + (size_t)(wr * 64 + fr) * D : out + (size_t)(u.pm * 256 + wr * 64 + fr) * D;
        const int col0 = u.pn * 256 + wc * 32 + 4 * fq;
        f32x4 gv[2][2];
#pragma unroll
        for (int bj = 0; bj < 2; ++bj)
#pragma unroll
            for (int n = 0; n < 2; ++n) gv[bj][n] = *(const f32x4*)(g + col0 + bj * 128 + n * 16);
#pragma unroll
        for (int ai = 0; ai < 2; ++ai)
#pragma unroll
            for (int m = 0; m < 4; ++m) { float* rowp = hb + (size_t)(ai * 128 + m * 16) * D + col0;
#pragma unroll
                for (int bj = 0; bj < 2; ++bj)
#pragma unroll
                    for (int n = 0; n < 2; ++n) { float* p = rowp + bj * 128 + n * 16; const f32x4 h = *(const f32x4*)p; *(f32x4*)p = h * ALPHA + gv[bj][n] * acc[ai][bj][m][n]; } }
    }
};
struct EpiUp {
    static constexpr bool PERM = true, AFTER_DRAIN = false;
    bf16_t* G; bf16_t* V;
    __device__ __forceinline__ void operator()(const f32x4 (&acc)[2][2][4][2], const Unit& u, int wr, int wc, int fr, int fq) const {
        mfma_settle(acc[1][1][3][1]); mfma_settle(acc[1][1][3][0]);
        const int row0 = u.pm * 256 + wr * 64 + fr; int ct = u.pn * 256; bf16_t* base = G; if (ct >= DFF) { base = V; ct -= DFF; }
        const int col0 = ct + wc * 32 + 8 * fq;
#pragma unroll
        for (int ai = 0; ai < 2; ++ai)
#pragma unroll
            for (int m = 0; m < 4; ++m) { bf16_t* rowp = base + (size_t)(row0 + ai * 128 + m * 16) * DFF + col0;
#pragma unroll
                for (int bj = 0; bj < 2; ++bj) { const f32x4 v0 = acc[ai][bj][m][0], v1 = acc[ai][bj][m][1];
                    u32x4 w; w.x = cvt_pk_bf16(v0[0], v0[1]); w.y = cvt_pk_bf16(v0[2], v0[3]); w.z = cvt_pk_bf16(v1[0], v1[1]); w.w = cvt_pk_bf16(v1[2], v1[3]);
                    *(u32x4*)(rowp + bj * 128) = w; } }
    }
};

__device__ __forceinline__ void xpose_item(const float* W, int K, int N, bf16_t* WT, int d0, int s0, int k0, float* scr, int lane) {
#pragma unroll
    for (int i = 0; i < 32; ++i) { const int kk = 2 * i + (lane >> 5); scr[kk * 33 + (lane & 31)] = s0 >= 0 ? W[(size_t)(k0 + kk) * N + s0 + (lane & 31)] : 0.f; }
    asm volatile("s_waitcnt lgkmcnt(0)" ::: "memory");
    const int c = lane & 7;
#pragma unroll
    for (int j = 0; j < 4; ++j) { const int n = (lane >> 3) + 8 * j; const float* s = scr + (8 * c) * 33 + n;
        u32x4 o; o.x = cvt_pk_bf16(s[0 * 33], s[1 * 33]); o.y = cvt_pk_bf16(s[2 * 33], s[3 * 33]); o.z = cvt_pk_bf16(s[4 * 33], s[5 * 33]); o.w = cvt_pk_bf16(s[6 * 33], s[7 * 33]);
        *(u32x4*)(WT + (size_t)(d0 + n) * K + k0 + 8 * c) = o; }
    asm volatile("s_waitcnt lgkmcnt(0)" ::: "memory");
}
__device__ __forceinline__ void xpose_region(const Args& a, int layer, int region, float* scr, int gw, int NGW, int lane) {
    if (region == 0) {
        const float* w_in = a.in[6] + (size_t)layer * 2048 * 10304; const float* w_glu = a.in[15] + (size_t)layer * 1024 * 2048; const float* w_s5p = a.in[16] + (size_t)layer * 1024 * 2048;
        const float* w_ssdp = a.in[23] + (size_t)layer * 2048 * 2048; const float* w_out = a.in[24] + (size_t)layer * 2048 * 2048;
        bf16_t* WA = (bf16_t*)(a.ws + WS_WA);
        constexpr int I_IN = 32 * 328, I_GLU = 16 * 64, I_S5P = 16 * 64, I_SSDP = 32 * 64, I_WOUT = 32 * 64, NI = I_IN + I_GLU + I_S5P + I_SSDP + I_WOUT;
        for (int it = gw; it < NI; it += NGW) { int r = it;
            if (r < I_IN) { const int kb = r / 328, d0 = (r % 328) * 32; int s0; if (d0 < 4096) s0 = d0; else if (d0 < 10240) s0 = d0 + 64; else if (d0 < 10304) s0 = d0 - 10240 + 4096; else s0 = -1;
                xpose_item(w_in, 2048, 10304, WA + WA_IN / 2, d0, s0, kb * 64, scr, lane); continue; } r -= I_IN;
            if (r < I_GLU) { const int kb = r / 64, d0 = (r % 64) * 32, t = d0 >> 8, j = d0 & 255; const int s0 = j < 128 ? t * 128 + j : 1024 + t * 128 + (j - 128);
                xpose_item(w_glu, 1024, 2048, WA + WA_GLU / 2, d0, s0, kb * 64, scr, lane); continue; } r -= I_GLU;
            if (r < I_S5P) { const int kb = r / 64, d0 = (r % 64) * 32; xpose_item(w_s5p, 1024, 2048, WA + WA_S5P / 2, d0, d0, kb * 64, scr, lane); continue; } r -= I_S5P;
            if (r < I_SSDP) { const int kb = r / 64, d0 = (r % 64) * 32; xpose_item(w_ssdp, 2048, 2048, WA + WA_SSDP / 2, d0, d0, kb * 64, scr, lane); continue; } r -= I_SSDP;
            { const int kb = r / 64, d0 = (r % 64) * 32; xpose_item(w_out, 2048, 2048, WA + WA_WOUT / 2, d0, d0, kb * 64, scr, lane); }
        }
    } else {
        const float* w_up = a.in[27] + (size_t)layer * 2048 * 11264; const float* w_down = a.in[30] + (size_t)layer * 5632 * 2048;
        bf16_t* WB = (bf16_t*)(a.ws + WS_WB);
        constexpr int I_UP = 32 * 352, I_DOWN = 88 * 64, NI = I_UP + I_DOWN;
        for (int it = gw; it < NI; it += NGW) { int r = it;
            if (r < I_UP) { const int kb = r / 352, d0 = (r % 352) * 32; xpose_item(w_up, 2048, 11264, WB + WB_UP / 2, d0, d0, kb * 64, scr, lane); continue; } r -= I_UP;
            { const int kb = r / 64, d0 = (r % 64) * 32; xpose_item(w_down, 5632, 2048, WB + WB_DOWN / 2, d0, d0, kb * 64, scr, lane); }
        }
    }
}

__device__ __forceinline__ void adaln_phase(const Args& a, float* lds, int tid) {
    float* sc = lds; float* scx = lds + 2048; float* red = lds + 4096;
    for (int i = tid; i < 2048; i += 512) { sc[i] = silu_(a.in[1][i]); scx[i] = silu_(a.in[3][i]); }
    __syncthreads();
    for (int unit = blockIdx.x; unit < 256; unit += gridDim.x) {
        const int layer = unit >> 7, col0 = (unit & 127) * 96;
        const float* W = a.in[4] + (size_t)layer * 2048 * 12288 + col0;
        if (tid < 504) { const int cq = tid % 24, ks = tid / 24; f32x4 al = {0.f, 0.f, 0.f, 0.f}, ac = {0.f, 0.f, 0.f, 0.f};
#pragma unroll 7
            for (int k = ks; k < 2048; k += 21) { const f32x4 w = *(const f32x4*)(W + (size_t)k * 12288 + cq * 4); al += w * sc[k]; ac += w * scx[k]; }
            *(f32x4*)(red + (ks * 2 + 0) * 96 + cq * 4) = al; *(f32x4*)(red + (ks * 2 + 1) * 96 + cq * 4) = ac; }
        __syncthreads();
        if (tid < 192) { const int v = tid / 96, c = tid % 96; float s = 0.f; for (int ks = 0; ks < 21; ++ks) s += red[(ks * 2 + v) * 96 + c];
            ((float*)(a.ws + WS_MVEC))[(size_t)(layer * 2 + v) * 12288 + col0 + c] = s + a.in[5][(size_t)layer * 12288 + col0 + c]; }
        __syncthreads();
    }
}

__device__ __forceinline__ float wave_sum(float v) {
#pragma unroll
    for (int o = 1; o < 64; o <<= 1) v += __shfl_xor(v, o);
    return v;
}
template <int MODE> __device__ __forceinline__ void row_phase(const Args& a, int nrows, const float* lng, const float* lnb, int mod_layer, int mod_off, int gw, int NGW, int lane) {
    bf16_t* XM = (bf16_t*)(a.ws + WS_XM);
    for (int row = gw; row < nrows; row += NGW) {
        const int isctx = row >= TL; float* h = hrow(a, row);
        const float* src = MODE == 0 ? (isctx ? a.in[2] + (size_t)(row - TL) * D : a.in[0] + (size_t)row * D) : h;
        f32x4 v[8];
#pragma unroll
        for (int j = 0; j < 8; ++j) v[j] = *(const f32x4*)(src + 4 * lane + 256 * j);
        if (MODE == 1) {
            float s = 0.f;
#pragma unroll
            for (int j = 0; j < 8; ++j) s += (v[j][0] + v[j][1]) + (v[j][2] + v[j][3]);
            const float mean = wave_sum(s) * (1.f / D); float q = 0.f;
#pragma unroll
            for (int j = 0; j < 8; ++j) { v[j] = v[j] - mean; q += (v[j][0] * v[j][0] + v[j][1] * v[j][1]) + (v[j][2] * v[j][2] + v[j][3] * v[j][3]); }
            const float rstd = 1.f / sqrtf(wave_sum(q) * (1.f / D) + LN_EPS);
#pragma unroll
            for (int j = 0; j < 8; ++j) { const f32x4 g = *(const f32x4*)(lng + 4 * lane + 256 * j), b = *(const f32x4*)(lnb + 4 * lane + 256 * j); v[j] = v[j] * rstd * g + b; }
        }
#ifdef MK_SANITIZE
#pragma unroll
        for (int j = 0; j < 8; ++j)
#pragma unroll
            for (int e = 0; e < 4; ++e) if (!(fabsf(v[j][e]) < 1e30f)) v[j][e] = 0.f;
#endif
#pragma unroll
        for (int j = 0; j < 8; ++j) *(f32x4*)(h + 4 * lane + 256 * j) = v[j];
        if (mod_layer >= 0) { const float* m = mvec(a, mod_layer, isctx) + mod_off;
#pragma unroll
            for (int j = 0; j < 8; ++j) { const f32x4 sh = *(const f32x4*)(m + 4 * lane + 256 * j), scl = *(const f32x4*)(m + D + 4 * lane + 256 * j); const f32x4 o = v[j] * (scl + 1.f) + sh;
                u32x2 w; w.x = cvt_pk_bf16(o[0], o[1]); w.y = cvt_pk_bf16(o[2], o[3]); *(u32x2*)(XM + (size_t)row * D + 4 * lane + 256 * j) = w; } }
    }
}

__device__ __forceinline__ void ffnconv_phase(const Args& a, int layer, bool with_ctx, int tid) {
    const bf16_t* G = (const bf16_t*)(a.ws + WS_BIG + B_G); bf16_t* V = (bf16_t*)(a.ws + WS_BIG + B_V);
    const float* cw = a.in[28] + (size_t)layer * 9 * DFF; const float* cb = a.in[29] + (size_t)layer * DFF;
    const int nunits = (with_ctx ? 260 : 256) * 11; const int oc = tid & 63, xs = tid >> 6;
    for (int unit = blockIdx.x; unit < nunits; unit += gridDim.x) {
        const int seg = unit / 11, ob = unit % 11, ch0 = ob * 512 + oc * 8; const bool cs = seg >= 256; const int t0 = seg * 64;
        float w[9][8], bias[8];
#pragma unroll
        for (int k = 0; k < 9; ++k) { const f32x4 w0 = *(const f32x4*)(cw + (size_t)k * DFF + ch0), w1 = *(const f32x4*)(cw + (size_t)k * DFF + ch0 + 4);
            w[k][0] = w0[0]; w[k][1] = w0[1]; w[k][2] = w0[2]; w[k][3] = w0[3]; w[k][4] = w1[0]; w[k][5] = w1[1]; w[k][6] = w1[2]; w[k][7] = w1[3]; }
        { const f32x4 b0 = *(const f32x4*)(cb + ch0), b1 = *(const f32x4*)(cb + ch0 + 4); bias[0] = b0[0]; bias[1] = b0[1]; bias[2] = b0[2]; bias[3] = b0[3]; bias[4] = b1[0]; bias[5] = b1[1]; bias[6] = b1[2]; bias[7] = b1[3]; }
#pragma unroll 4
        for (int xi = 0; xi < 8; ++xi) { const int x = xs * 8 + xi, t = t0 + x; float acc[8];
#pragma unroll
            for (int k = 0; k < 8; ++k) acc[k] = bias[k];
#pragma unroll
            for (int dy = -1; dy <= 1; ++dy) { bool rok = cs ? (dy == 0) : ((dy < 0 ? seg > 0 : true) && (dy > 0 ? seg < 255 : true));
#pragma unroll
                for (int dx = -1; dx <= 1; ++dx) { const bool ok = rok && (cs ? (t + dx >= TL && t + dx < MT) : (x + dx >= 0 && x + dx < 64));
                    if (ok) { const u32x4 g = *(const u32x4*)(G + (size_t)(t + dy * 64 + dx) * DFF + ch0); const int k = (dy + 1) * 3 + dx + 1;
                        acc[0] += w[k][0] * bflo(g.x); acc[1] += w[k][1] * bfhi(g.x); acc[2] += w[k][2] * bflo(g.y); acc[3] += w[k][3] * bfhi(g.y);
                        acc[4] += w[k][4] * bflo(g.z); acc[5] += w[k][5] * bfhi(g.z); acc[6] += w[k][6] * bflo(g.w); acc[7] += w[k][7] * bfhi(g.w); } } }
            bf16_t* vp = V + (size_t)t * DFF + ch0; const u32x4 vv = *(const u32x4*)vp;
            u32x4 o; o.x = cvt_pk_bf16(silu_(acc[0]) * bflo(vv.x), silu_(acc[1]) * bfhi(vv.x)); o.y = cvt_pk_bf16(silu_(acc[2]) * bflo(vv.y), silu_(acc[3]) * bfhi(vv.y));
            o.z = cvt_pk_bf16(silu_(acc[4]) * bflo(vv.z), silu_(acc[5]) * bfhi(vv.z)); o.w = cvt_pk_bf16(silu_(acc[6]) * bflo(vv.w), silu_(acc[7]) * bfhi(vv.w));
            *(u32x4*)vp = o; }
    }
}

__device__ __forceinline__ int s5_chunk_at(int dir, int q) { return dir ? 129 - q : (q + 128) % 130; }
__device__ __forceinline__ int s5_pos_of(int dir, int c) { return dir ? 129 - c : (c + 2) % 130; }
template <int PASS> __device__ __forceinline__ void s5_phase(const Args& a, int layer, unsigned char* lds, int tid, int nchunks) {
    float* uL = (float*)lds;
    float* YL = (float*)(lds + 32768);
    bf16_t* ST = (bf16_t*)(lds + 65536);
    const bf16_t* U5 = (const bf16_t*)(a.ws + WS_BIG + B_U5); bf16_t* Y5 = (bf16_t*)(a.ws + WS_BIG + B_Y5);
    float2* S5LOC = (float2*)(a.ws + WS_S5LOC);
    const int lane = tid & 63, w = tid >> 6, gl = tid >> 7, dir = (tid >> 6) & 1, p = tid & 63, fr = lane & 15, fq = lane >> 4;
    int cur_gq = -1; float ab_re = 0.f, ab_im = 0.f, a128r = 0.f, a128i = 0.f; float bbr[16], bbi[16]; bf16x8 cm[4];
    for (int unit = blockIdx.x; unit < 16 * nchunks; unit += gridDim.x) {
        const int gq = unit / nchunks, c = unit % nchunks, g = gq * 4 + gl, row0 = c * 128;
        if (gq != cur_gq) { cur_gq = gq;
            const size_t pi = ((size_t)(layer * 2 + dir) * 64 + g) * 64 + p;
            const float lre = fminf(a.in[7][pi], -1e-4f), lim = a.in[8][pi], step = expf(a.in[9][(size_t)(layer * 2 + dir) * 64 + g]);
            const float mag = expf(lre * step); float sn, cs; sincosf(lim * step, &sn, &cs); ab_re = mag * cs; ab_im = mag * sn;
            const float den = lre * lre + lim * lim, q_re = ((ab_re - 1.f) * lre + ab_im * lim) / den, q_im = (ab_im * lre - (ab_re - 1.f) * lim) / den;
            const float* br = a.in[10] + (((size_t)layer * 64 + g) * 64 + p) * 16; const float* bi = a.in[11] + (((size_t)layer * 64 + g) * 64 + p) * 16;
#pragma unroll
            for (int j = 0; j < 16; ++j) { const float r = br[j], i = bi[j]; bbr[j] = q_re * r - q_im * i; bbi[j] = q_re * i + q_im * r; }
            a128r = ab_re; a128i = ab_im;
#pragma unroll
            for (int k = 0; k < 7; ++k) { const float r = a128r * a128r - a128i * a128i, i = 2.f * a128r * a128i; a128r = r; a128i = i; }
            if (PASS == 1) {
                const float* cre = a.in[12] + (((size_t)(layer * 2 + dir) * 64 + g) * 16 + fr) * 64; const float* cim = a.in[13] + (((size_t)(layer * 2 + dir) * 64 + g) * 16 + fr) * 64;
#pragma unroll
                for (int ks = 0; ks < 4; ++ks) { const float* s = (ks < 2 ? cre : cim) + (ks & 1) * 32 + fq * 8; const float sg = ks < 2 ? 1.f : -1.f;
                    const f32x4 v0 = *(const f32x4*)s, v1 = *(const f32x4*)(s + 4);
                    cm[ks] = mkfrag(cvt_pk_bf16(sg * v0[0], sg * v0[1]), cvt_pk_bf16(sg * v0[2], sg * v0[3]), cvt_pk_bf16(sg * v1[0], sg * v1[1]), cvt_pk_bf16(sg * v1[2], sg * v1[3])); }
            }
        }
        __syncthreads();
        { const int t = tid >> 2, q = tid & 3; const bf16_t* s = U5 + (size_t)(row0 + t) * 1024 + gq * 64 + q * 16; const u32x4 v0 = *(const u32x4*)s, v1 = *(const u32x4*)(s + 8);
            float* d = uL + t * 64 + q * 16;
            *(f32x4*)d = (f32x4){bflo(v0.x), bfhi(v0.x), bflo(v0.y), bfhi(v0.y)}; *(f32x4*)(d + 4) = (f32x4){bflo(v0.z), bfhi(v0.z), bflo(v0.w), bfhi(v0.w)};
            *(f32x4*)(d + 8) = (f32x4){bflo(v1.x), bfhi(v1.x), bflo(v1.y), bfhi(v1.y)}; *(f32x4*)(d + 12) = (f32x4){bflo(v1.z), bfhi(v1.z), bflo(v1.w), bfhi(v1.w)};
            if (PASS == 1) { float* y = YL + q * 2048 + t * 16;
#pragma unroll
                for (int j = 0; j < 4; ++j) *(f32x4*)(y + 4 * j) = (f32x4){0.f, 0.f, 0.f, 0.f}; } }
        float sr = 0.f, si = 0.f;
        if (PASS == 1) {
            const int pos = s5_pos_of(dir, c);
#pragma unroll 1
            for (int q0 = 0; q0 < pos; q0 += 13) { float2 l[13];
#pragma unroll
                for (int i = 0; i < 13; ++i) { const int q = q0 + i < pos ? q0 + i : pos - 1; l[i] = S5LOC[((size_t)(dir * NCH + s5_chunk_at(dir, q)) * 64 + g) * 64 + p]; }
#pragma unroll
                for (int i = 0; i < 13; ++i) if (q0 + i < pos) { const float nr = a128r * sr - a128i * si + l[i].x, ni = a128r * si + a128i * sr + l[i].y; sr = nr; si = ni; } }
        }
        __syncthreads();
#pragma unroll 1
        for (int stp = 0; stp < 4; ++stp) {
#pragma unroll 8
            for (int ii = 0; ii < 32; ++ii) { const int i = stp * 32 + ii, t = dir ? 127 - i : i; const float* ut = uL + t * 64 + gl * 16;
                const f32x4 u0 = *(const f32x4*)ut, u1 = *(const f32x4*)(ut + 4), u2 = *(const f32x4*)(ut + 8), u3 = *(const f32x4*)(ut + 12);
                f32x2 b0 = {0.f, 0.f}, b1 = {0.f, 0.f};
#pragma unroll
                for (int j = 0; j < 4; ++j) { b0 = __builtin_elementwise_fma((f32x2){bbr[j], bbi[j]}, (f32x2){u0[j], u0[j]}, b0); b1 = __builtin_elementwise_fma((f32x2){bbr[4 + j], bbi[4 + j]}, (f32x2){u1[j], u1[j]}, b1);
                    b0 = __builtin_elementwise_fma((f32x2){bbr[8 + j], bbi[8 + j]}, (f32x2){u2[j], u2[j]}, b0); b1 = __builtin_elementwise_fma((f32x2){bbr[12 + j], bbi[12 + j]}, (f32x2){u3[j], u3[j]}, b1); }
                f32x2 ns = b0 + b1; ns = __builtin_elementwise_fma((f32x2){ab_re, ab_re}, (f32x2){sr, si}, ns); ns = __builtin_elementwise_fma((f32x2){-ab_im, ab_im}, (f32x2){si, sr}, ns); sr = ns[0]; si = ns[1];
                if (PASS == 1) { bf16_t* st = ST + ((size_t)(dir * 4 + gl) * 32 + (t & 31)) * 136; st[p] = (bf16_t)(cvt_pk_bf16(sr, 0.f) & 0xffffu); st[64 + p] = (bf16_t)(cvt_pk_bf16(si, 0.f) & 0xffffu); }
            }
            if (PASS == 1) {
                asm volatile("s_waitcnt lgkmcnt(0)" ::: "memory");
                const int tb = (dir ? 3 - stp : stp) * 32;
#pragma unroll
                for (int rt = 0; rt < 2; ++rt) { f32x4 acc = {0.f, 0.f, 0.f, 0.f};
#pragma unroll
                    for (int ks = 0; ks < 4; ++ks) { const bf16x8 af = *(const bf16x8*)(ST + ((size_t)(dir * 4 + gl) * 32 + rt * 16 + fr) * 136 + ks * 32 + fq * 8); acc = __builtin_amdgcn_mfma_f32_16x16x32_bf16(af, cm[ks], acc, 0, 0, 0); }
#pragma unroll
                    for (int jj = 0; jj < 4; ++jj) YL[gl * 2048 + (tb + rt * 16 + fq * 4 + jj) * 16 + fr] += acc[jj]; }
                __syncthreads();
            }
        }
        if (PASS == 0) { S5LOC[((size_t)(dir * NCH + c) * 64 + g) * 64 + p] = make_float2(sr, si); }
        else { const int t = tid >> 2, q = tid & 3; const float* y = YL + q * 2048 + t * 16; const float* u = uL + t * 64 + q * 16; const float* dd = a.in[14] + (size_t)layer * 1024 + gq * 64 + q * 16;
            unsigned o[8];
#pragma unroll
            for (int j = 0; j < 8; ++j) { const float y0 = y[2 * j] + u[2 * j] * dd[2 * j], y1 = y[2 * j + 1] + u[2 * j + 1] * dd[2 * j + 1]; o[j] = cvt_pk_bf16(gelu_tanh(y0), gelu_tanh(y1)); }
            bf16_t* dst = Y5 + (size_t)(row0 + t) * 1024 + gq * 64 + q * 16; u32x4 o0, o1; o0.x = o[0]; o0.y = o[1]; o0.z = o[2]; o0.w = o[3]; o1.x = o[4]; o1.y = o[5]; o1.z = o[6]; o1.w = o[7];
            *(u32x4*)dst = o0; *(u32x4*)(dst + 8) = o1; }
    }
    __syncthreads();
}

__device__ __forceinline__ int ssd_chunk_at(int dir, int q) { return s5_chunk_at(dir, q); }
__device__ __forceinline__ void conv8(const bf16_t* XBC, int rowbase, int l0, int ch, bool lo_ok, bool hi_ok, float w0, float w1, float w2, float b, float (&out)[8]) {
    float r[10];
#pragma unroll
    for (int i = 0; i < 10; ++i) { const int l = l0 - 1 + i; const bool ok = (l >= 0 || lo_ok) && (l < 128 || hi_ok); r[i] = ok ? bf2f((unsigned)XBC[(size_t)(rowbase + l) * 3072 + ch]) : 0.f; }
#pragma unroll
    for (int j = 0; j < 8; ++j) out[j] = silu_(w0 * r[j] + w1 * r[j + 1] + w2 * r[j + 2] + b);
}
__device__ __forceinline__ void stage_conv_tile(const bf16_t* XBC, const float* cw, const float* cb, int rowbase, int chbase, bool lo_ok, bool hi_ok, bf16_t* dst, int tid) {
    const int oc = tid & 15, ch = chbase + oc * 8; float w[3][8], b[8];
#pragma unroll
    for (int k = 0; k < 3; ++k) { const f32x4 a0 = *(const f32x4*)(cw + (size_t)k * 3072 + ch), a1 = *(const f32x4*)(cw + (size_t)k * 3072 + ch + 4);
        w[k][0] = a0[0]; w[k][1] = a0[1]; w[k][2] = a0[2]; w[k][3] = a0[3]; w[k][4] = a1[0]; w[k][5] = a1[1]; w[k][6] = a1[2]; w[k][7] = a1[3]; }
    { const f32x4 a0 = *(const f32x4*)(cb + ch), a1 = *(const f32x4*)(cb + ch + 4); b[0] = a0[0]; b[1] = a0[1]; b[2] = a0[2]; b[3] = a0[3]; b[4] = a1[0]; b[5] = a1[1]; b[6] = a1[2]; b[7] = a1[3]; }
#pragma unroll
    for (int i = 0; i < 4; ++i) { const int row = (tid >> 4) + i * 32; float acc[8];
#pragma unroll
        for (int k = 0; k < 8; ++k) acc[k] = b[k];
#pragma unroll
        for (int d = 0; d < 3; ++d) { const int l = row + d - 1; const bool ok = (l >= 0 || lo_ok) && (l < 128 || hi_ok);
            if (ok) { const u32x4 g = *(const u32x4*)(XBC + (size_t)(rowbase + l) * 3072 + ch);
                acc[0] += w[d][0] * bflo(g.x); acc[1] += w[d][1] * bfhi(g.x); acc[2] += w[d][2] * bflo(g.y); acc[3] += w[d][3] * bfhi(g.y);
                acc[4] += w[d][4] * bflo(g.z); acc[5] += w[d][5] * bfhi(g.z); acc[6] += w[d][6] * bflo(g.w); acc[7] += w[d][7] * bfhi(g.w); } }
        u32x4 o; o.x = cvt_pk_bf16(silu_(acc[0]), silu_(acc[1])); o.y = cvt_pk_bf16(silu_(acc[2]), silu_(acc[3])); o.z = cvt_pk_bf16(silu_(acc[4]), silu_(acc[5])); o.w = cvt_pk_bf16(silu_(acc[6]), silu_(acc[7]));
        *(u32x4*)(dst + row * 136 + oc * 8) = o; }
}
constexpr int SL_CS = 0, SL_CB = 34816, SL_CUM = 69632, SL_DT = 77824, SL_PART = 86016, SL_BS = 94208, SL_XF = 94208;
template <int AUX> __device__ __forceinline__ void ssd_cum(const Args& a, int layer, int c, int h, int w, int lane, unsigned char* lds) {
    const float* DT = (const float*)(a.ws + WS_BIG + B_DT); float* cumL = (float*)(lds + SL_CUM); float* dtL = (float*)(lds + SL_DT); float* CHD = (float*)(a.ws + WS_CHD);
#pragma unroll
    for (int dir = 0; dir < 2; ++dir) {
        const float ah = -expf(a.in[20][(size_t)(layer * 2 + dir) * 32 + h]);
        const float d0 = DT[(size_t)(c * 128 + 2 * lane) * 64 + dir * 32 + h], d1 = DT[(size_t)(c * 128 + 2 * lane + 1) * 64 + dir * 32 + h];
        const float l0 = d0 * ah, l1 = d1 * ah, s = l0 + l1; float incl = s;
#pragma unroll
        for (int o = 1; o < 64; o <<= 1) { const float t = __shfl_up(incl, o); if (lane >= o) incl += t; }
        const float excl = incl - s, tot = __shfl(incl, 63);
        float c0, c1;
        if (dir == 0) { c0 = excl + l0; c1 = incl; } else { c0 = tot - excl; c1 = tot - (excl + l0); }
        float* cu = cumL + (dir * 8 + w) * 128 + 2 * lane; cu[0] = c0; cu[1] = c1;
        float* dd = dtL + (dir * 8 + w) * 128 + 2 * lane;
        if (AUX == 0) { dd[0] = d0; dd[1] = d1; } else { dd[0] = d0 * __expf(tot - c0); dd[1] = d1 * __expf(tot - c1); if (lane == 0) CHD[(size_t)(dir * NCH + c) * 32 + h] = tot; }
    }
}
__device__ __forceinline__ void ssd_a_phase(const Args& a, int layer, unsigned char* lds, int tid) {
    const bf16_t* XBC = (const bf16_t*)(a.ws + WS_BIG + B_XBC); bf16_t* SST = (bf16_t*)(a.ws + WS_SST);
    const float* cw = a.in[17] + (size_t)layer * 3 * 3072; const float* cb = a.in[18] + (size_t)layer * 3072;
    bf16_t* Bs = (bf16_t*)(lds + SL_BS); const float* wL = (const float*)(lds + SL_DT);
    const int lane = tid & 63, w = tid >> 6, fr = lane & 15, fq = lane >> 4;
    for (int unit = blockIdx.x; unit < NCH * 4; unit += gridDim.x) {
        const int c = unit >> 2, g = unit & 3, rowbase = c * 128, h = g * 8 + w; const bool lo_ok = !(c == 0 || c == 128), hi_ok = !(c == 127 || c == 129);
        __syncthreads();
        stage_conv_tile(XBC, cw, cb, rowbase, 2048 + g * 128, lo_ok, hi_ok, Bs, tid);
        ssd_cum<1>(a, layer, c, h, w, lane, lds);
        __syncthreads();
#pragma unroll 1
        for (int dir = 0; dir < 2; ++dir) {
            bf16_t* sb = SST + (((size_t)(dir * NCH + c) * 32 + h) * 64) * 128;
#pragma unroll 1
            for (int pt = 0; pt < 4; ++pt) {
                const int ch = h * 64 + pt * 16 + fr; const float w0 = cw[ch], w1 = cw[3072 + ch], w2 = cw[6144 + ch], bb = cb[ch];
                f32x4 acc[8];
#pragma unroll
                for (int nt = 0; nt < 8; ++nt) acc[nt] = (f32x4){0.f, 0.f, 0.f, 0.f};
#pragma unroll 2
                for (int ks = 0; ks < 4; ++ks) {
                    const float* wp = wL + (dir * 8 + w) * 128 + ks * 32 + fq * 8; const f32x4 wl0 = *(const f32x4*)wp, wl1 = *(const f32x4*)(wp + 4);
                    float x[8]; conv8(XBC, rowbase, ks * 32 + fq * 8, ch, lo_ok, hi_ok, w0, w1, w2, bb, x);
                    const bf16x8 yf = mkfrag(cvt_pk_bf16(x[0] * wl0[0], x[1] * wl0[1]), cvt_pk_bf16(x[2] * wl0[2], x[3] * wl0[3]), cvt_pk_bf16(x[4] * wl1[0], x[5] * wl1[1]), cvt_pk_bf16(x[6] * wl1[2], x[7] * wl1[3]));
#pragma unroll
                    for (int nt = 0; nt < 8; ++nt) { const bf16_t* bp = Bs + (ks * 32 + fq * 8) * 136 + nt * 16 + fr;
                        const bf16x8 xf = mkfrag((unsigned)bp[0] | ((unsigned)bp[136] << 16), (unsigned)bp[2 * 136] | ((unsigned)bp[3 * 136] << 16), (unsigned)bp[4 * 136] | ((unsigned)bp[5 * 136] << 16), (unsigned)bp[6 * 136] | ((unsigned)bp[7 * 136] << 16));
                        acc[nt] = __builtin_amdgcn_mfma_f32_16x16x32_bf16(xf, yf, acc[nt], 0, 0, 0); }
                }
                mfma_settle(acc[7]); mfma_settle(acc[6]);
#pragma unroll
                for (int nt = 0; nt < 8; ++nt) { u32x2 o; o.x = cvt_pk_bf16(acc[nt][0], acc[nt][1]); o.y = cvt_pk_bf16(acc[nt][2], acc[nt][3]);
                    *(u32x2*)(sb + (size_t)(pt * 16 + fr) * 128 + nt * 16 + fq * 4) = o; }
            }
        }
    }
    __syncthreads();
}
__device__ __forceinline__ void ssd_b_phase(const Args& a, int tid) {
    bf16_t* SST = (bf16_t*)(a.ws + WS_SST); const float* CHD = (const float*)(a.ws + WS_CHD);
    for (int idx = blockIdx.x * 512 + tid; idx < 64 * 2048; idx += gridDim.x * 512) {
        const int e4 = idx & 2047, hd = idx >> 11, dir = hd >> 5, h = hd & 31; float s0 = 0.f, s1 = 0.f, s2 = 0.f, s3 = 0.f;
#pragma unroll 1
        for (int b = 0; b < 13; ++b) { u32x2 loc[10]; float dc[10];
#pragma unroll
            for (int i = 0; i < 10; ++i) { const int cq = ssd_chunk_at(dir, b * 10 + i); loc[i] = *(const u32x2*)(SST + ((size_t)(dir * NCH + cq) * 32 + h) * 8192 + e4 * 4); dc[i] = CHD[(size_t)(dir * NCH + cq) * 32 + h]; }
#pragma unroll
            for (int i = 0; i < 10; ++i) { const int cq = ssd_chunk_at(dir, b * 10 + i); u32x2 o; o.x = cvt_pk_bf16(s0, s1); o.y = cvt_pk_bf16(s2, s3);
                *(u32x2*)(SST + ((size_t)(dir * NCH + cq) * 32 + h) * 8192 + e4 * 4) = o; const float e = __expf(dc[i]);
                s0 = e * s0 + bflo(loc[i].x); s1 = e * s1 + bfhi(loc[i].x); s2 = e * s2 + bflo(loc[i].y); s3 = e * s3 + bfhi(loc[i].y); }
        }
    }
}
__device__ __forceinline__ void ssd_c_phase(const Args& a, int layer, unsigned char* lds, int tid, int nchunks) {
    const bf16_t* XBC = (const bf16_t*)(a.ws + WS_BIG + B_XBC); const bf16_t* SST = (const bf16_t*)(a.ws + WS_SST); const bf16_t* Z = (const bf16_t*)(a.ws + WS_BIG + B_Z); bf16_t* YD = (bf16_t*)(a.ws + WS_BIG + B_YD);
    const float* cw = a.in[17] + (size_t)layer * 3 * 3072; const float* cb = a.in[18] + (size_t)layer * 3072; const float* normw = a.in[22] + (size_t)layer * 2048;
    bf16_t* Cs = (bf16_t*)(lds + SL_CS); bf16_t* Bs = (bf16_t*)(lds + SL_BS); bf16_t* CBs = (bf16_t*)(lds + SL_CB); const float* cumL = (const float*)(lds + SL_CUM); const float* dtL = (const float*)(lds + SL_DT); float* part = (float*)(lds + SL_PART);
    const int lane = tid & 63, w = tid >> 6, fr = lane & 15, fq = lane >> 4;
    for (int unit = blockIdx.x; unit < nchunks * 4; unit += gridDim.x) {
        const int c = unit >> 2, g = unit & 3, rowbase = c * 128, h = g * 8 + w; const bool lo_ok = !(c == 0 || c == 128), hi_ok = !(c == 127 || c == 129);
        const float Dh = a.in[21][(size_t)layer * 32 + h];
        __syncthreads();
        stage_conv_tile(XBC, cw, cb, rowbase, 2560 + g * 128, lo_ok, hi_ok, Cs, tid);
        stage_conv_tile(XBC, cw, cb, rowbase, 2048 + g * 128, lo_ok, hi_ok, Bs, tid);
        ssd_cum<0>(a, layer, c, h, w, lane, lds);
        __syncthreads();
#pragma unroll 1
        for (int st = 0; st < 8; ++st) { f32x4 acc = {0.f, 0.f, 0.f, 0.f};
#pragma unroll
            for (int ks = 0; ks < 4; ++ks) { const bf16x8 xf = *(const bf16x8*)(Bs + (st * 16 + fr) * 136 + ks * 32 + fq * 8), yf = *(const bf16x8*)(Cs + (w * 16 + fr) * 136 + ks * 32 + fq * 8);
                acc = __builtin_amdgcn_mfma_f32_16x16x32_bf16(xf, yf, acc, 0, 0, 0); }
            mfma_settle(acc);
            u32x2 o; o.x = cvt_pk_bf16(acc[0], acc[1]); o.y = cvt_pk_bf16(acc[2], acc[3]); *(u32x2*)(CBs + (w * 16 + fr) * 136 + st * 16 + fq * 4) = o; }
        __syncthreads();
#pragma unroll 1
        for (int hp = 0; hp < 2; ++hp) {
        bf16_t* XFw = (bf16_t*)(lds + SL_XF) + (size_t)w * 4096;
#pragma unroll 2
        for (int f = 0; f < 8; ++f) { const int p2 = f & 1, ks = f >> 1; const int ch = h * 64 + (hp * 2 + p2) * 16 + fr; const float w0 = cw[ch], w1 = cw[3072 + ch], w2 = cw[6144 + ch], bb = cb[ch];
            float x[8]; conv8(XBC, rowbase, ks * 32 + fq * 8, ch, lo_ok, hi_ok, w0, w1, w2, bb, x);
            *(bf16x8*)(XFw + (f * 64 + lane) * 8) = mkfrag(cvt_pk_bf16(x[0], x[1]), cvt_pk_bf16(x[2], x[3]), cvt_pk_bf16(x[4], x[5]), cvt_pk_bf16(x[6], x[7])); }
        asm volatile("s_waitcnt lgkmcnt(0)" ::: "memory");
#pragma unroll 1
        for (int lt = 0; lt < 8; ++lt) {
            const int l = lt * 16 + fr; f32x4 acc[2];
#pragma unroll
            for (int p2 = 0; p2 < 2; ++p2) acc[p2] = (f32x4){0.f, 0.f, 0.f, 0.f};
#pragma unroll
            for (int dir = 0; dir < 2; ++dir) {
                f32x4 tmp[2];
#pragma unroll
                for (int p2 = 0; p2 < 2; ++p2) tmp[p2] = (f32x4){0.f, 0.f, 0.f, 0.f};
                const bf16_t* sb = SST + (((size_t)(dir * NCH + c) * 32 + h) * 64) * 128;
#pragma unroll
                for (int ks = 0; ks < 4; ++ks) { const bf16x8 yf = *(const bf16x8*)(Cs + l * 136 + ks * 32 + fq * 8);
#pragma unroll
                    for (int p2 = 0; p2 < 2; ++p2) { const bf16x8 sf = *(const bf16x8*)(sb + (size_t)((hp * 2 + p2) * 16 + fr) * 128 + ks * 32 + fq * 8); tmp[p2] = __builtin_amdgcn_mfma_f32_16x16x32_bf16(sf, yf, tmp[p2], 0, 0, 0); } }
                const float cl = cumL[(dir * 8 + w) * 128 + l], el = __expf(cl);
#pragma unroll
                for (int p2 = 0; p2 < 2; ++p2) acc[p2] += tmp[p2] * el;
#pragma unroll
                for (int ks = 0; ks < 4; ++ks) { const int s0 = ks * 32;
                    const bool skip = dir == 0 ? (s0 > lt * 16 + 15) : (s0 + 31 < lt * 16);
                    if (!skip) { const u32x4 cbv = *(const u32x4*)(CBs + l * 136 + s0 + fq * 8);
                        const float* cp = cumL + (dir * 8 + w) * 128 + s0 + fq * 8; const float* dp = dtL + (dir * 8 + w) * 128 + s0 + fq * 8;
                        const f32x4 c0 = *(const f32x4*)cp, c1 = *(const f32x4*)(cp + 4), d0 = *(const f32x4*)dp, d1 = *(const f32x4*)(dp + 4);
                        float cbf[8] = {bflo(cbv.x), bfhi(cbv.x), bflo(cbv.y), bfhi(cbv.y), bflo(cbv.z), bfhi(cbv.z), bflo(cbv.w), bfhi(cbv.w)}; float v[8];
#pragma unroll
                        for (int j = 0; j < 8; ++j) { const int s = s0 + fq * 8 + j; const float cs = j < 4 ? c0[j & 3] : c1[j & 3], ds = j < 4 ? d0[j & 3] : d1[j & 3];
                            const bool valid = dir == 0 ? (s <= l) : (s >= l); float t = valid ? cbf[j] * __expf(fminf(cl - cs, 0.f)) * ds : 0.f; if (dir == 0 && s == l) t += Dh; v[j] = t; }
                        const bf16x8 yf = mkfrag(cvt_pk_bf16(v[0], v[1]), cvt_pk_bf16(v[2], v[3]), cvt_pk_bf16(v[4], v[5]), cvt_pk_bf16(v[6], v[7]));
#pragma unroll
                        for (int p2 = 0; p2 < 2; ++p2) acc[p2] = __builtin_amdgcn_mfma_f32_16x16x32_bf16(*(const bf16x8*)(XFw + ((ks * 2 + p2) * 64 + lane) * 8), yf, acc[p2], 0, 0, 0); }
                    }
            }
            const size_t row = (size_t)(rowbase + l); float ss = 0.f;
#pragma unroll
            for (int p2 = 0; p2 < 2; ++p2) { const int ch = h * 64 + (hp * 2 + p2) * 16 + fq * 4; const u32x2 zz = *(const u32x2*)(Z + row * 2048 + ch);
                const float h0 = acc[p2][0] * silu_(bflo(zz.x)), h1 = acc[p2][1] * silu_(bfhi(zz.x)), h2 = acc[p2][2] * silu_(bflo(zz.y)), h3 = acc[p2][3] * silu_(bfhi(zz.y));
                ss += (h0 * h0 + h1 * h1) + (h2 * h2 + h3 * h3); u32x2 o; o.x = cvt_pk_bf16(h0, h1); o.y = cvt_pk_bf16(h2, h3); *(u32x2*)(YD + row * 2048 + ch) = o; }
            ss += __shfl_xor(ss, 16); ss += __shfl_xor(ss, 32);
            if (fq == 0) part[(hp * 8 + w) * 128 + l] = ss;
        }
        }
        __syncthreads();
#pragma unroll 1
        for (int lt = 0; lt < 8; ++lt) { const int l = lt * 16 + fr; float tot = 0.f;
#pragma unroll
            for (int ww = 0; ww < 16; ++ww) tot += part[ww * 128 + l];
            const float r = 1.f / sqrtf(tot * (1.f / 512.f) + RMS_EPS); const size_t row = (size_t)(rowbase + l);
#pragma unroll
            for (int pt = 0; pt < 4; ++pt) { const int ch = h * 64 + pt * 16 + fq * 4; bf16_t* yp = YD + row * 2048 + ch; const u32x2 hv = *(const u32x2*)yp; const f32x4 nw = *(const f32x4*)(normw + ch);
                u32x2 o; o.x = cvt_pk_bf16(bflo(hv.x) * r * nw[0], bfhi(hv.x) * r * nw[1]); o.y = cvt_pk_bf16(bflo(hv.y) * r * nw[2], bfhi(hv.y) * r * nw[3]); *(u32x2*)yp = o; } }
    }
    __syncthreads();
}

#define LAS __attribute__((address_space(3)))
#define XB_TMO      128
#define XB_XCNT(j)  (256  + 64 * (j))
#define XB_XSUB(j)  (1280 + 64 * (j))
#define XB_XGEN(j)  (2304 + 64 * (j))
#define XB_TOP      3328
#define XB_TOPGEN   3392
#define XCD_BAR_WORDS 3456
#define XB_SPIN_CAP (1u << 18)

__device__ __forceinline__ unsigned xb_ld(unsigned* p)              { return __hip_atomic_load(p, __ATOMIC_RELAXED, __HIP_MEMORY_SCOPE_AGENT); }
__device__ __forceinline__ unsigned xb_add(unsigned* p, unsigned v) { return __hip_atomic_fetch_add(p, v, __ATOMIC_RELAXED, __HIP_MEMORY_SCOPE_AGENT); }
__device__ __forceinline__ unsigned xb_xcc_id() { return (unsigned)__builtin_amdgcn_s_getreg((3 << 11) | 20) & 0xFu; }
#define XB_SPIN(cond, bar) do { unsigned _sp = 0; while (cond) { __builtin_amdgcn_s_sleep(1); \
    if ((++_sp & 255u) == 0u) { if (xb_ld(&(bar)[XB_TMO])) break; if (_sp > XB_SPIN_CAP) { atomicAdd(&(bar)[XB_TMO], 1u); break; } } } } while (0)

struct XcdBarrier {
    unsigned* bar; unsigned x;
    volatile LAS unsigned* st;
};

__device__ __forceinline__ XcdBarrier xcd_barrier_post(unsigned* bar, volatile LAS unsigned* st) {
    XcdBarrier b; b.bar = bar; b.x = xb_xcc_id(); b.st = st;
    if (threadIdx.x == 0) (void)xb_add(&bar[XB_XCNT(b.x)], 1u);
    return b;
}
__device__ __forceinline__ void xcd_barrier_complete(unsigned* bar, unsigned x, unsigned& nloc, unsigned& nx) {
    const unsigned G = gridDim.x * gridDim.y * gridDim.z;
    unsigned sum, cnt, mine, sp = 0u;
    for (;;) {
        sum = 0u; cnt = 0u; mine = 0u;
#pragma unroll
        for (unsigned j = 0; j < 16; ++j) { const unsigned c = xb_ld(&bar[XB_XCNT(j)]); sum += c; cnt += (c > 0u) ? 1u : 0u; mine = (j == x) ? c : mine; }
        if (sum == G) break;
        __builtin_amdgcn_s_sleep(1);
        if ((++sp & 255u) == 0u) { if (xb_ld(&bar[XB_TMO])) break; if (sp > XB_SPIN_CAP) { atomicAdd(&bar[XB_TMO], 1u); break; } }
    }
    nloc = mine > 0u ? mine : 1u; nx = cnt > 0u ? cnt : 1u;
}

__device__ __forceinline__ void xcd_barrier(const XcdBarrier& b) {
    asm volatile("s_waitcnt vmcnt(0)" ::: "memory");
    __syncthreads();
    if (threadIdx.x == 0) {
        unsigned* bar = b.bar;
        __builtin_amdgcn_s_waitcnt(0);
        unsigned nloc = b.st[0], nx = b.st[1];
        if (nloc == 0u) { xcd_barrier_complete(bar, b.x, nloc, nx); b.st[0] = nloc; b.st[1] = nx; }
        const unsigned old = xb_add(&bar[XB_XSUB(b.x)], 1u);
        const unsigned gen = old / nloc;
        if (old + 1u == (gen + 1u) * nloc) {
            __builtin_amdgcn_fence(__ATOMIC_RELEASE, "agent");
            asm volatile("s_waitcnt vmcnt(0)" ::: "memory");
            const unsigned og = xb_add(&bar[XB_TOP], 1u);
            const unsigned tg = og / nx;
            if (og + 1u == (tg + 1u) * nx) xb_add(&bar[XB_TOPGEN], 1u);
            else XB_SPIN(xb_ld(&bar[XB_TOPGEN]) == tg, bar);
            __builtin_amdgcn_fence(__ATOMIC_ACQUIRE, "agent");
            xb_add(&bar[XB_XGEN(b.x)], 1u);
            asm volatile("s_waitcnt vmcnt(0)" ::: "memory");
        } else {
            XB_SPIN(xb_ld(&bar[XB_XGEN(b.x)]) == gen, bar);
            __builtin_amdgcn_fence(__ATOMIC_ACQUIRE, "agent");
            asm volatile("s_waitcnt vmcnt(0)" ::: "memory");
        }
    }
    __syncthreads();
}

#ifndef MK_REP_S5
#define MK_REP_S5 1
#endif
#ifndef MK_REP_SSD
#define MK_REP_SSD 1
#endif
#ifndef MK_REP_SYNC
#define MK_REP_SYNC 1
#endif
#ifndef MK_CG_SYNC_ALL
#define MK_CG_SYNC_ALL 0
#endif
#ifndef MK_REP_PRO
#define MK_REP_PRO 1
#endif
#ifndef MK_REP_GEMM
#define MK_REP_GEMM 1
#endif
constexpr int NPHASE = 2 + 11 * 2;
__global__ void __launch_bounds__(512, 2) fwd_megakernel(Args a) {
    extern __shared__ __attribute__((aligned(16))) unsigned char lds[];
    PG8_LAS unsigned char* lds3 = (PG8_LAS unsigned char*)lds;
    unsigned char* big = a.ws + WS_BIG;
    volatile LAS unsigned* bst = (volatile LAS unsigned*)(lds3 + (LDS_BYTES - 16));
    if (threadIdx.x < 4) bst[threadIdx.x] = 0u;
    __syncthreads();
    XcdBarrier xbar; xbar.bar = (unsigned*)(a.ws + WS_BAR); xbar.x = 0; xbar.st = bst;
    if (a.ph_hi - a.ph_lo > 1) xbar = xcd_barrier_post((unsigned*)(a.ws + WS_BAR), bst);
    for (int ph = a.ph_lo; ph < a.ph_hi; ++ph) {
        const int tid = pg8::pg8_tid(), lane = tid & 63, wave = tid >> 6, gw = blockIdx.x * 8 + wave, NGW = gridDim.x * 8;
        if (ph == 0) {
            for (int rep = 0; rep < MK_REP_PRO; ++rep) {
            adaln_phase(a, (float*)lds, tid);
            float* scr = (float*)lds + wave * (64 * 33);
            xpose_region(a, 0, 0, scr, gw, NGW, lane); xpose_region(a, 0, 1, scr, gw, NGW, lane); __syncthreads(); }
        } else if (ph == 1) {
            row_phase<0>(a, MT, nullptr, nullptr, 0, 0, gw, NGW, lane);
        } else {
            const int layer = (ph - 2) / 11, k = (ph - 2) % 11; const bool last = layer == 1; const int Mrows = last ? TL : MT;
            const bf16_t* WA = (const bf16_t*)(a.ws + WS_WA); const bf16_t* WB = (const bf16_t*)(a.ws + WS_WB);
#ifdef MK_SKIP_MASK
            if ((MK_SKIP_MASK >> k) & 1) { if (ph + 1 < a.ph_hi) xcd_barrier(xbar); continue; }
#endif
            if (k == 0) {
                pg8::Gemm g{(const bf16_t*)(a.ws + WS_XM), WA + WA_IN / 2, MT, NPROJ, D}; pg8::StaticOrder S; S.init(MT, NPROJ, gridDim.x, blockIdx.x);
                EpiInProj E{big, a.in[19] + (size_t)layer * 64}; for (int rep = 0; rep < MK_REP_GEMM; ++rep) { pg8::gemm_phase<EpiInProj, pg8::StaticOrder>(lds3, g, S, E, nullptr); __syncthreads(); }
            } else if (k == 1) {
                for (int rep = 0; rep < MK_REP_SSD; ++rep) ssd_a_phase(a, layer, lds, tid);
                for (int rep = 0; rep < MK_REP_S5; ++rep) s5_phase<0>(a, layer, lds, tid, NCH);
            } else if (k == 2) {
#if !defined(MK_NO_SSD) && !defined(MK_NO_SSDB)
                ssd_b_phase(a, tid);
#endif
                for (int rep = 0; rep < MK_REP_S5; ++rep) s5_phase<1>(a, layer, lds, tid, last ? 128 : NCH);
            } else if (k == 3) {
                for (int rep = 0; rep < MK_REP_SSD; ++rep) ssd_c_phase(a, layer, lds, tid, last ? 128 : NCH);
#ifndef MK_NO_S5
                pg8::Gemm g{(const bf16_t*)(big + B_Y5), WA + WA_GLU / 2, Mrows, 2048, 1024}; pg8::StaticOrder S; S.init(Mrows, 2048, gridDim.x, blockIdx.x);
                EpiGlu E{(bf16_t*)(big + B_U5)}; pg8::gemm_phase<EpiGlu, pg8::StaticOrder>(lds3, g, S, E, nullptr);
#endif
            } else if (k == 4) {
#ifndef MK_NO_S5
                { pg8::Gemm g{(const bf16_t*)(big + B_U5), WA + WA_S5P / 2, Mrows, 2048, 1024}; pg8::StaticOrder S; S.init(Mrows, 2048, gridDim.x, blockIdx.x);
                  EpiMerge<0> E{(bf16_t*)(big + B_XBC), (const bf16_t*)(big + B_GATE)}; pg8::gemm_phase<EpiMerge<0>, pg8::StaticOrder>(lds3, g, S, E, nullptr); }
                __syncthreads();
#endif
#ifndef MK_NO_SSD
#ifdef MK_NO_S5
                { pg8::Gemm g{(const bf16_t*)(big + B_YD), WA + WA_SSDP / 2, Mrows, 2048, 2048}; pg8::StaticOrder S; S.init(Mrows, 2048, gridDim.x, blockIdx.x);
                  EpiMerge<0, 1> E{(bf16_t*)(big + B_XBC), (const bf16_t*)(big + B_GATE)}; pg8::gemm_phase<EpiMerge<0, 1>, pg8::StaticOrder>(lds3, g, S, E, nullptr); }
#else
                { pg8::Gemm g{(const bf16_t*)(big + B_YD), WA + WA_SSDP / 2, Mrows, 2048, 2048}; pg8::StaticOrder S; S.init(Mrows, 2048, gridDim.x, blockIdx.x);
                  EpiMerge<1> E{(bf16_t*)(big + B_XBC), (const bf16_t*)(big + B_GATE)}; pg8::gemm_phase<EpiMerge<1>, pg8::StaticOrder>(lds3, g, S, E, nullptr); }
#endif
#endif
            } else if (k == 5) {
                pg8::Gemm g{(const bf16_t*)(big + B_XBC), WA + WA_WOUT / 2, Mrows, 2048, 2048}; pg8::StaticOrder S; S.init(Mrows, 2048, gridDim.x, blockIdx.x);
                EpiResid E{a.out, (float*)(a.ws + WS_HCTX), mvec(a, layer, 0) + 2 * D, mvec(a, layer, 1) + 2 * D}; pg8::gemm_phase<EpiResid, pg8::StaticOrder>(lds3, g, S, E, nullptr);
            } else if (k == 6) {
                row_phase<1>(a, Mrows, a.in[25] + (size_t)layer * D, a.in[26] + (size_t)layer * D, layer, 3 * D, gw, NGW, lane);
                if (!last) for (int rep = 0; rep < MK_REP_PRO; ++rep) { __syncthreads(); xpose_region(a, layer + 1, 0, (float*)lds + wave * (64 * 33), gw, NGW, lane); }
            } else if (k == 7) {
                pg8::Gemm g{(const bf16_t*)(a.ws + WS_XM), WB + WB_UP / 2, Mrows, 2 * DFF, D}; pg8::StaticOrder S; S.init(Mrows, 2 * DFF, gridDim.x, blockIdx.x);
                EpiUp E{(bf16_t*)(big + B_G), (bf16_t*)(big + B_V)}; for (int rep = 0; rep < MK_REP_GEMM; ++rep) { pg8::gemm_phase<EpiUp, pg8::StaticOrder>(lds3, g, S, E, nullptr); __syncthreads(); }
            } else if (k == 8) {
                ffnconv_phase(a, layer, !last, tid);
            } else if (k == 9) {
                pg8::Gemm g{(const bf16_t*)(big + B_V), WB + WB_DOWN / 2, Mrows, D, DFF}; pg8::StaticOrder S; S.init(Mrows, D, gridDim.x, blockIdx.x);
                EpiResid E{a.out, (float*)(a.ws + WS_HCTX), mvec(a, layer, 0) + 5 * D, mvec(a, layer, 1) + 5 * D}; pg8::gemm_phase<EpiResid, pg8::StaticOrder>(lds3, g, S, E, nullptr);
            } else {
                row_phase<1>(a, Mrows, a.in[31] + (size_t)layer * D, a.in[32] + (size_t)layer * D, last ? -1 : layer + 1, 0, gw, NGW, lane);
                if (!last) for (int rep = 0; rep < MK_REP_PRO; ++rep) { __syncthreads(); xpose_region(a, layer + 1, 1, (float*)lds + wave * (64 * 33), gw, NGW, lane); }
            }
        }
        if (ph + 1 < a.ph_hi) { for (int rep = 0; rep < MK_REP_SYNC; ++rep) { if (MK_CG_SYNC_ALL || ph == a.ph_lo) cg::this_grid().sync(); else xcd_barrier(xbar); } }
    }
}
}

#ifndef MK_N_LAUNCH_MODE
#define MK_N_LAUNCH_MODE 0
#endif
extern "C" void kernel_launch(void* const* d_in, const int* in_sizes, int n_in, void* d_out, int out_size, void* d_ws, size_t ws_size, hipStream_t stream) {
    static int grid = 0;
    if (grid == 0) {
        if (n_in != 33 || ws_size < mk::WS_END) { fprintf(stderr, "kernel_launch: need 33 inputs and %zu bytes of workspace (got %d, %zu)\n", (size_t)mk::WS_END, n_in, ws_size); grid = -1; return; }
        int dev = 0, cus = 0, per_cu = 0;
        (void)hipGetDevice(&dev); (void)hipDeviceGetAttribute(&cus, hipDeviceAttributeMultiprocessorCount, dev);
        if (hipFuncSetAttribute((const void*)mk::fwd_megakernel, hipFuncAttributeMaxDynamicSharedMemorySize, mk::LDS_BYTES) != hipSuccess) { fprintf(stderr, "kernel_launch: hipFuncSetAttribute failed\n"); grid = -1; return; }
        if (hipOccupancyMaxActiveBlocksPerMultiprocessor(&per_cu, (const void*)mk::fwd_megakernel, 512, mk::LDS_BYTES) != hipSuccess || per_cu < 1) { fprintf(stderr, "kernel_launch: occupancy query says %d\n", per_cu); per_cu = 1; }
        (void)hipGetLastError();
        grid = cus * per_cu; if (grid > 256) grid = 256;
    }
    if (grid < 0) return;
    mk::Args a{};
    for (int i = 0; i < 33; ++i) a.in[i] = (const float*)d_in[i];
    a.out = (float*)d_out; a.ws = (unsigned char*)d_ws;
#if MK_N_LAUNCH_MODE == 1
    for (int ph = 0; ph < mk::NPHASE; ++ph) { a.ph_lo = ph; a.ph_hi = ph + 1; hipLaunchKernelGGL(mk::fwd_megakernel, dim3(grid), dim3(512), mk::LDS_BYTES, stream, a); }
#else
    a.ph_lo = 0; a.ph_hi = mk::NPHASE;
    (void)hipMemsetAsync((unsigned char*)d_ws + mk::WS_BAR, 0, XCD_BAR_WORDS * sizeof(unsigned), stream);
    void* args[] = {&a};
    hipError_t e = hipLaunchCooperativeKernel((const void*)mk::fwd_megakernel, dim3(grid), dim3(512), args, mk::LDS_BYTES, stream);
    if (e != hipSuccess) fprintf(stderr, "cooperative launch failed: %s (grid %d)\n", hipGetErrorString(e), grid);
#endif
}
```

```cpp
#include <hip/hip_runtime.h>
#include <hip/hip_cooperative_groups.h>
#include <cstdio>
namespace cg = cooperative_groups;
#define MK_N_LAUNCH_MODE 0
namespace pg8 {
#define PG8_LAS __attribute__((address_space(3)))
typedef unsigned short bf16_t;
typedef short bf16x8 __attribute__((ext_vector_type(8)));
typedef float f32x4 __attribute__((ext_vector_type(4)));
typedef unsigned u32x4 __attribute__((ext_vector_type(4)));
constexpr int BM = 256, BK = 64, HALF = 128, HTB = HALF * BK * 2  , STAGE_BYTES = 8 * HTB, NXCD = 8, WGM = 8;

__host__ __device__ __forceinline__ int lds_byte(int r, int c) { const int st = (r >> 4) * 2 + (c >> 5), rr = r & 15, cc = c & 31, ob = rr * 64 + cc * 2; return st * 1024 + (ob ^ (((ob >> 9) & 1) << 5)); }
__host__ __device__ __forceinline__ void stage_rc(int b, int& R, int& C) { const int st = b / 1024, sb = b % 1024, swz = sb ^ (((sb >> 9) & 1) << 5); R = (st >> 1) * 16 + swz / 64; C = (st & 1) * 32 + (swz % 64) / 2; }
__host__ __device__ __forceinline__ int perm32(int rho) { const int n = rho >> 4, i = rho & 15; return 8 * (i >> 2) + 4 * n + (i & 3); }

__device__ __forceinline__ int pg8_tid() { int t = threadIdx.x; asm volatile("" : "+v"(t)); return t; }
struct Unit { int pm, pn; };
struct Gemm { const bf16_t* A; const bf16_t* Bt; int M, N, K; };

struct StaticOrder {
    int nM, nN, nwg, G, c;
    __host__ __device__ void init(int M, int N, int G_, int c_) { nM = M / BM; nN = N / BM; nwg = nM * nN; G = G_; c = c_; }
    __host__ __device__ bool next(int i, Unit& u) const {
        const long L = (long)i * G + c; if (L >= nwg) return false;
        int wgid = (int)L; { const int q = nwg / NXCD, r = nwg % NXCD, xcd = wgid % NXCD, off = wgid / NXCD; wgid = (xcd < r ? xcd * (q + 1) : r * (q + 1) + (xcd - r) * q) + off; }
        const int nig = WGM * nN, gid = wgid / nig, fm = gid * WGM, gsz = (nM - fm) < WGM ? (nM - fm) : WGM;
        u.pm = fm + ((wgid % nig) % gsz); u.pn = (wgid % nig) / gsz; return true;
    }
    __device__ __forceinline__ void a_ready(const Unit&) const {}
    __device__ __forceinline__ void done(const Unit&) const {}
};
typedef float f32x2c __attribute__((ext_vector_type(2))); typedef __bf16 bf16x2c __attribute__((ext_vector_type(2)));
__device__ __forceinline__ unsigned cvt_pk_native(float lo, float hi) { const f32x2c v = {lo, hi}; const bf16x2c b = __builtin_convertvector(v, bf16x2c); return __builtin_bit_cast(unsigned, b); }
__device__ __forceinline__ unsigned cvt_pk_bf16(float lo, float hi) { unsigned r; asm volatile("v_cvt_pk_bf16_f32 %0, %1, %2" : "=v"(r) : "v"(lo), "v"(hi)); return r; }
__device__ __forceinline__ void mfma_settle(const float __attribute__((ext_vector_type(4)))& a) { asm volatile("s_nop 15\n\ts_nop 7" :: "v"(a)); }
typedef float f32x2 __attribute__((ext_vector_type(2)));
template <class Epi, class Sched, bool STAMP = false>
__device__ __forceinline__ void gemm_phase(PG8_LAS unsigned char* lds, const Gemm g, const Sched& S, const Epi& E, unsigned long long* stamps) {
    const int tid = pg8_tid(), wid = __builtin_amdgcn_readfirstlane(tid >> 6), lane = tid & 63, wr = wid >> 2, wc = wid & 3, fr = lane & 15, fq = lane >> 4;
    const int K = g.K, nt = K / BK;
    int ts_lo = 0, ts_hi = 0, nts = 0; const unsigned long long rt_entry = STAMP ? (unsigned long long)wall_clock64() : 0ull;
#define PG8_STAMP() do { if (STAMP && wid == 0 && nts < 64) { const unsigned long long _c = (unsigned long long)clock64(); \
        ts_lo = (lane == nts) ? (int)(unsigned)_c : ts_lo; ts_hi = (lane == nts) ? (int)(unsigned)(_c >> 32) : ts_hi; ++nts; } } while (0)
    PG8_STAMP();
    unsigned voffA[2], voffB[2];
#pragma unroll
    for (int i = 0; i < 2; ++i) { int R, C; stage_rc(tid * 16 + i * 8192, R, C); const int Rb = Epi::PERM ? ((R & ~31) + perm32(R & 31)) : R;
        voffA[i] = (unsigned)(R * K + C) * 2u; voffB[i] = (unsigned)(Rb * K + C) * 2u; }
    const size_t kstep = (size_t)(BK * 2);
    const size_t hstep = (size_t)HALF * K * 2;
    const size_t tstep = 2 * hstep;
    const unsigned ldsw = (unsigned)wid * 1024u;
    const int aoff = lds_byte(wr * 64 + fr, fq * 8), boff = lds_byte(wc * 32 + fr, fq * 8);
#define PG8_SA(b, h) (((b) * 2 + (h)) * HTB)
#define PG8_SB(b, h) ((4 + (b) * 2 + (h)) * HTB)
#define PG8_STAGE(bufoff, gbase, voff) do { _Pragma("unroll") for (int _i = 0; _i < 2; ++_i) \
        __builtin_amdgcn_global_load_lds((const unsigned*)((const char*)(gbase) + (voff)[_i]), (PG8_LAS unsigned*)(lds + (bufoff) + ldsw + _i * 8192), 16, 0, 0); } while (0)
#define PG8_LDA(dst, b, h) do { _Pragma("unroll") for (int m = 0; m < 4; ++m) _Pragma("unroll") for (int k = 0; k < 2; ++k) dst[m][k] = *(const PG8_LAS bf16x8*)(lds + PG8_SA(b, h) + aoff + m * 2048 + k * 1024); } while (0)
#define PG8_LDB(dst, b, h) do { _Pragma("unroll") for (int n = 0; n < 2; ++n) _Pragma("unroll") for (int k = 0; k < 2; ++k) dst[n][k] = *(const PG8_LAS bf16x8*)(lds + PG8_SB(b, h) + boff + n * 2048 + k * 1024); } while (0)
#define PG8_MMA(ai, bj, At, Bt) do { __builtin_amdgcn_s_setprio(1); _Pragma("unroll") for (int m = 0; m < 4; ++m) _Pragma("unroll") for (int n = 0; n < 2; ++n) _Pragma("unroll") for (int k = 0; k < 2; ++k) \
        acc[ai][bj][m][n] = __builtin_amdgcn_mfma_f32_16x16x32_bf16(Bt[n][k], At[m][k], acc[ai][bj][m][n], 0, 0, 0); __builtin_amdgcn_s_setprio(0); } while (0)
#define PG8_WAIT_V(n) asm volatile("s_waitcnt vmcnt(" #n ")" ::: "memory")
#define PG8_WAIT_L(n) asm volatile("s_waitcnt lgkmcnt(" #n ")" ::: "memory")
#define PG8_BAR __builtin_amdgcn_s_barrier()
#define PG8_SCHED __builtin_amdgcn_sched_barrier(0)
    Unit cur, nxt; int ui = 0;
    if (!S.next(0, cur)) return;
    f32x4 acc[2][2][4][2];
#pragma unroll
    for (int a = 0; a < 2; ++a)
#pragma unroll
        for (int b = 0; b < 2; ++b)
#pragma unroll
            for (int m = 0; m < 4; ++m)
#pragma unroll
                for (int n = 0; n < 2; ++n) acc[a][b][m][n] = (f32x4){0.f, 0.f, 0.f, 0.f};
    bf16x8 At[4][2], B0[2][2], B1[2][2];
    const char* cA = (const char*)g.A + (size_t)cur.pm * tstep; const char* cB = (const char*)g.Bt + (size_t)cur.pn * tstep;
    S.a_ready(cur);
    PG8_STAGE(PG8_SB(0, 0), cB, voffB); PG8_STAGE(PG8_SA(0, 0), cA, voffA); PG8_STAGE(PG8_SB(0, 1), cB + hstep, voffB); PG8_STAGE(PG8_SA(0, 1), cA + hstep, voffA);
    if (wr == 1) PG8_BAR;
    PG8_WAIT_V(4); PG8_BAR;
    PG8_STAGE(PG8_SB(1, 0), cB + kstep, voffB); PG8_STAGE(PG8_SA(1, 0), cA + kstep, voffA); PG8_STAGE(PG8_SB(1, 1), cB + hstep + kstep, voffB);
    PG8_WAIT_V(6); PG8_BAR;
    PG8_STAMP();
    for (;;) {
        const bool has_next = S.next(ui + 1, nxt);
        const char* nA = has_next ? (const char*)g.A + (size_t)nxt.pm * tstep : cA; const char* nB = has_next ? (const char*)g.Bt + (size_t)nxt.pn * tstep : cB;
        for (int t = 0; t < nt; t += 2) {
            const bool last = (t == nt - 2);
            const char* a1 = cA + (size_t)(t + 1) * kstep;
            const char* a2 = last ? nA : cA + (size_t)(t + 2) * kstep; const char* b2 = last ? nB : cB + (size_t)(t + 2) * kstep;
            const char* a3 = a2 + kstep; const char* b3 = b2 + kstep;
            if (last && has_next) S.a_ready(nxt);
            PG8_LDB(B0, 0, 0); PG8_SCHED; PG8_LDA(At, 0, 0); PG8_STAGE(PG8_SA(1, 1), a1 + hstep, voffA);
            PG8_WAIT_L(8); PG8_BAR; PG8_WAIT_L(0); PG8_MMA(0, 0, At, B0); PG8_BAR; PG8_SCHED;
            PG8_LDB(B1, 0, 1); PG8_STAGE(PG8_SB(0, 0), b2, voffB);
            PG8_BAR; PG8_WAIT_L(0); PG8_MMA(0, 1, At, B1); PG8_BAR;
            PG8_LDA(At, 0, 1); PG8_STAGE(PG8_SA(0, 0), a2, voffA);
            PG8_BAR; PG8_WAIT_L(0); PG8_MMA(1, 0, At, B0); PG8_BAR; PG8_SCHED;
            PG8_STAGE(PG8_SB(0, 1), b2 + hstep, voffB);
            PG8_WAIT_V(6); PG8_BAR; PG8_MMA(1, 1, At, B1); PG8_BAR;
            PG8_LDB(B0, 1, 0); PG8_SCHED; PG8_LDA(At, 1, 0); PG8_STAGE(PG8_SA(0, 1), a2 + hstep, voffA);
            PG8_WAIT_L(8); PG8_BAR; PG8_WAIT_L(0); PG8_MMA(0, 0, At, B0); PG8_BAR; PG8_SCHED;
            PG8_LDB(B1, 1, 1); PG8_STAGE(PG8_SB(1, 0), b3, voffB);
            PG8_BAR; PG8_WAIT_L(0); PG8_MMA(0, 1, At, B1); PG8_BAR;
            PG8_LDA(At, 1, 1); PG8_STAGE(PG8_SA(1, 0), a3, voffA);
            PG8_BAR; PG8_WAIT_L(0); PG8_MMA(1, 0, At, B0); PG8_BAR; PG8_SCHED;
            PG8_STAGE(PG8_SB(1, 1), b3 + hstep, voffB);
            PG8_WAIT_V(6); PG8_BAR; PG8_MMA(1, 1, At, B1); PG8_BAR;
        }
        PG8_STAMP();
        if constexpr (!Epi::AFTER_DRAIN) { E(acc, cur, wr, wc, fr, fq); S.done(cur); }
        PG8_STAMP();
        if (!has_next) break;
#pragma unroll
        for (int a = 0; a < 2; ++a)
#pragma unroll
            for (int b = 0; b < 2; ++b)
#pragma unroll
                for (int m = 0; m < 4; ++m)
#pragma unroll
                    for (int n = 0; n < 2; ++n) acc[a][b][m][n] = (f32x4){0.f, 0.f, 0.f, 0.f};
        cur = nxt; cA = nA; cB = nB; ++ui;
    }
    PG8_WAIT_V(0);
    if (wr == 0) PG8_BAR;
    PG8_BAR;
    if constexpr (Epi::AFTER_DRAIN) { E.fused(acc, cur, wr, wc, fr, fq, lds, wid, lane); S.done(cur); }
    PG8_STAMP();
    if (STAMP && wid == 0) { stamps[lane] = lane < nts ? (((unsigned long long)(unsigned)ts_hi << 32) | (unsigned)ts_lo) : 0ull;
        if (lane == 62) stamps[62] = rt_entry; if (lane == 63) stamps[63] = (unsigned long long)wall_clock64(); }
#undef PG8_STAMP
#undef PG8_SA
#undef PG8_SB
#undef PG8_STAGE
#undef PG8_LDA
#undef PG8_LDB
#undef PG8_MMA
#undef PG8_WAIT_V
#undef PG8_WAIT_L
#undef PG8_BAR
#undef PG8_SCHED
}
}

namespace mk {
using pg8::bf16_t; using pg8::bf16x8; using pg8::f32x4; using pg8::u32x4; using pg8::Unit; using pg8::cvt_pk_bf16; using pg8::cvt_pk_native; using pg8::mfma_settle;
typedef unsigned u32x2 __attribute__((ext_vector_type(2)));
typedef float f32x2 __attribute__((ext_vector_type(2)));
constexpr int D = 2048, TL = 16384, TC = 256, MT = TL + TC, NCH = MT / 128;
constexpr int NPROJ = 10496, DFF = 5632;
constexpr size_t MiB = 1u << 20;
constexpr size_t WS_MVEC = 0, WS_CHD = 256 * 1024, WS_BAR = 512 * 1024, WS_S5LOC = 1 * MiB, WS_WA = 10 * MiB, WS_WB = 75 * MiB, WS_HCTX = 141 * MiB, WS_XM = 143 * MiB, WS_SST = 208 * MiB, WS_BIG = 338 * MiB, WS_END = 766 * MiB;
constexpr size_t B_U5 = 0, B_XBC = B_U5 + (size_t)MT * 1024 * 2, B_Z = B_XBC + (size_t)MT * 3072 * 2, B_GATE = B_Z + (size_t)MT * 2048 * 2, B_DT = B_GATE + (size_t)MT * 4096 * 2,
                 B_Y5 = 330 * MiB, B_YD = B_Y5 + (size_t)MT * 1024 * 2;
static_assert(B_DT + (size_t)MT * 64 * 4 <= B_Y5 && B_YD + (size_t)MT * 2048 * 2 <= 428 * MiB, "big map");
constexpr size_t B_G = 0, B_V = (size_t)MT * DFF * 2;
constexpr size_t WA_IN = 0, WA_GLU = 41 * MiB, WA_S5P = 45 * MiB, WA_SSDP = 49 * MiB, WA_WOUT = 57 * MiB, WB_UP = 0, WB_DOWN = 44 * MiB;
constexpr int LDS_BYTES = 163840;
constexpr float ALPHA = 1.41421356237f, LN_EPS = 1e-5f, RMS_EPS = 1e-5f;

struct Args { const float* in[33]; float* out; unsigned char* ws; int ph_lo, ph_hi; };

__device__ __forceinline__ float bf2f(unsigned b) { return __uint_as_float(b << 16); }
__device__ __forceinline__ float bflo(unsigned w) { return __uint_as_float(w << 16); }
__device__ __forceinline__ float bfhi(unsigned w) { return __uint_as_float(w & 0xffff0000u); }
__device__ __forceinline__ float sigm(float x) { return 1.f / (1.f + __expf(-x)); }
__device__ __forceinline__ float silu_(float x) { return x / (1.f + __expf(-x)); }
__device__ __forceinline__ float gelu_tanh(float x) { const float u = 0.7978845608028654f * (x + 0.044715f * x * x * x); const float th = 1.f - 2.f / (__expf(2.f * u) + 1.f); return 0.5f * x * (1.f + th); }
__device__ __forceinline__ bf16x8 mkfrag(unsigned a, unsigned b, unsigned c, unsigned d) { u32x4 v; v.x = a; v.y = b; v.z = c; v.w = d; return __builtin_bit_cast(bf16x8, v); }
__device__ __forceinline__ float* hrow(const Args& a, int row) { return row < TL ? a.out + (size_t)row * D : (float*)(a.ws + WS_HCTX) + (size_t)(row - TL) * D; }
__device__ __forceinline__ const float* mvec(const Args& a, int layer, int isctx) { return (const float*)(a.ws + WS_MVEC) + (size_t)(layer * 2 + isctx) * 12288; }

struct EpiInProj {
    static constexpr bool PERM = true, AFTER_DRAIN = false;
    unsigned char* big; const float* dt_bias;
    __device__ __forceinline__ void operator()(const f32x4 (&acc)[2][2][4][2], const Unit& u, int wr, int wc, int fr, int fq) const {
        mfma_settle(acc[1][1][3][1]); mfma_settle(acc[1][1][3][0]);
        const int row0 = u.pm * 256 + wr * 64 + fr, ct = u.pn * 256;
        if (ct >= 10240) {
            if (wc < 2) { const int cc = wc * 32 + 8 * fq; float* DT = (float*)(big + B_DT);
                const f32x4 b0 = *(const f32x4*)(dt_bias + cc), b1 = *(const f32x4*)(dt_bias + cc + 4);
#pragma unroll
                for (int ai = 0; ai < 2; ++ai)
#pragma unroll
                    for (int m = 0; m < 4; ++m) { float* rp = DT + (size_t)(row0 + ai * 128 + m * 16) * 64 + cc; f32x4 v0 = acc[ai][0][m][0] + b0, v1 = acc[ai][0][m][1] + b1;
#pragma unroll
                        for (int j = 0; j < 4; ++j) { v0[j] = v0[j] > 20.f ? v0[j] : log1pf(expf(v0[j])); v1[j] = v1[j] > 20.f ? v1[j] : log1pf(expf(v1[j])); }
                        *(f32x4*)rp = v0; *(f32x4*)(rp + 4) = v1; } }
            return;
        }
        bf16_t* base; int ld, c0; bool sg = false;
        if (ct < 1024) { base = (bf16_t*)(big + B_U5); ld = 1024; c0 = ct; }
        else if (ct < 4096) { base = (bf16_t*)(big + B_XBC); ld = 3072; c0 = ct - 1024; }
        else if (ct < 6144) { base = (bf16_t*)(big + B_Z); ld = 2048; c0 = ct - 4096; }
        else { base = (bf16_t*)(big + B_GATE); ld = 4096; c0 = ct - 6144; sg = true; }
        const int col0 = c0 + wc * 32 + 8 * fq;
#pragma unroll
        for (int ai = 0; ai < 2; ++ai)
#pragma unroll
            for (int m = 0; m < 4; ++m) { bf16_t* rowp = base + (size_t)(row0 + ai * 128 + m * 16) * ld + col0;
#pragma unroll
                for (int bj = 0; bj < 2; ++bj) { f32x4 v0 = acc[ai][bj][m][0], v1 = acc[ai][bj][m][1];
                    if (sg) {
#pragma unroll
                        for (int j = 0; j < 4; ++j) { v0[j] = sigm(v0[j]); v1[j] = sigm(v1[j]); } }
                    u32x4 w; w.x = cvt_pk_bf16(v0[0], v0[1]); w.y = cvt_pk_bf16(v0[2], v0[3]); w.z = cvt_pk_bf16(v1[0], v1[1]); w.w = cvt_pk_bf16(v1[2], v1[3]);
                    *(u32x4*)(rowp + bj * 128) = w; } }
    }
};
struct EpiGlu {
    static constexpr bool PERM = true, AFTER_DRAIN = false;
    bf16_t* O;
    __device__ __forceinline__ void operator()(const f32x4 (&acc)[2][2][4][2], const Unit& u, int wr, int wc, int fr, int fq) const {
        mfma_settle(acc[1][1][3][1]); mfma_settle(acc[1][1][3][0]);
        const int row0 = u.pm * 256 + wr * 64 + fr, col0 = u.pn * 128 + wc * 32 + 8 * fq;
#pragma unroll
        for (int ai = 0; ai < 2; ++ai)
#pragma unroll
            for (int m = 0; m < 4; ++m) { f32x4 v0 = acc[ai][0][m][0], v1 = acc[ai][0][m][1]; const f32x4 g0 = acc[ai][1][m][0], g1 = acc[ai][1][m][1];
#pragma unroll
                for (int j = 0; j < 4; ++j) { v0[j] *= sigm(g0[j]); v1[j] *= sigm(g1[j]); }
                u32x4 w; w.x = cvt_pk_bf16(v0[0], v0[1]); w.y = cvt_pk_bf16(v0[2], v0[3]); w.z = cvt_pk_bf16(v1[0], v1[1]); w.w = cvt_pk_bf16(v1[2], v1[3]);
                *(u32x4*)(O + (size_t)(row0 + ai * 128 + m * 16) * 1024 + col0) = w; }
    }
};
template <int SECOND, int GSEL = SECOND> struct EpiMerge {
    static constexpr bool PERM = true, AFTER_DRAIN = false;
    bf16_t* MG; const bf16_t* GATE;
    __device__ __forceinline__ void operator()(const f32x4 (&acc)[2][2][4][2], const Unit& u, int wr, int wc, int fr, int fq) const {
        mfma_settle(acc[1][1][3][1]); mfma_settle(acc[1][1][3][0]);
        const int row0 = u.pm * 256 + wr * 64 + fr, col0 = u.pn * 256 + wc * 32 + 8 * fq;
#pragma unroll
        for (int ai = 0; ai < 2; ++ai)
#pragma unroll
            for (int m = 0; m < 4; ++m) { const size_t r = (size_t)(row0 + ai * 128 + m * 16);
#pragma unroll
                for (int bj = 0; bj < 2; ++bj) { const int c = col0 + bj * 128; const u32x4 g = *(const u32x4*)(GATE + r * 4096 + (GSEL ? 2048 : 0) + c);
                    f32x4 v0 = acc[ai][bj][m][0], v1 = acc[ai][bj][m][1];
                    v0[0] *= bflo(g.x); v0[1] *= bfhi(g.x); v0[2] *= bflo(g.y); v0[3] *= bfhi(g.y); v1[0] *= bflo(g.z); v1[1] *= bfhi(g.z); v1[2] *= bflo(g.w); v1[3] *= bfhi(g.w);
                    if (SECOND) { const u32x4 o = *(const u32x4*)(MG + r * 2048 + c);
                        v0[0] += bflo(o.x); v0[1] += bfhi(o.x); v0[2] += bflo(o.y); v0[3] += bfhi(o.y); v1[0] += bflo(o.z); v1[1] += bfhi(o.z); v1[2] += bflo(o.w); v1[3] += bfhi(o.w); }
                    u32x4 w; w.x = cvt_pk_bf16(v0[0], v0[1]); w.y = cvt_pk_bf16(v0[2], v0[3]); w.z = cvt_pk_bf16(v1[0], v1[1]); w.w = cvt_pk_bf16(v1[2], v1[3]);
                    *(u32x4*)(MG + r * 2048 + c) = w; } }
    }
};
struct EpiResid {
    static constexpr bool PERM = false, AFTER_DRAIN = false;
    float* out; float* hctx; const float* glat; const float* gctx;
    __device__ __forceinline__ void operator()(const f32x4 (&acc)[2][2][4][2], const Unit& u, int wr, int wc, int fr, int fq) const {
        mfma_settle(acc[1][1][3][1]); mfma_settle(acc[1][1][3][0]);
        const bool isctx = u.pm >= 64; const float* g = isctx ? gctx : glat;
        float* hb = isctx ? hctx + (size_t)(wr * 64 + fr) * D : out + (size_t)(u.pm * 256 + wr * 64 + fr) * D;
        const int col0 = u.pn * 256 + wc * 32 + 4 * fq;
        f32x4 gv[2][2];
#pragma unroll
        for (int bj = 0; bj < 2; ++bj)
#pragma unroll
            for (int n = 0; n < 2; ++n) gv[bj][n] = *(const f32x4*)(g + col0 + bj * 128 + n * 16);
#pragma unroll
        for (int ai = 0; ai < 2; ++ai)
#pragma unroll
            for (int m = 0; m < 4; ++m) { float* rowp = hb + (size_t)(ai * 128 + m * 16) * D + col0;
#pragma unroll
                for (int bj = 0; bj < 2; ++bj)
#pragma unroll
                    for (int n = 0; n < 2; ++n) { float* p = rowp + bj * 128 + n * 16; const f32x4 h = *(const f32x4*)p; *(f32x4*)p = h * ALPHA + gv[bj][n] * acc[ai][bj][m][n]; } }
    }
};
struct EpiUp {
    static constexpr bool PERM = true, AFTER_DRAIN = false;
    bf16_t* G; bf16_t* V;
    __device__ __forceinline__ void operator()(const f32x4 (&acc)[2][2][4][2], const Unit& u, int wr, int wc, int fr, int fq) const {
        mfma_settle(acc[1][1][3][1]); mfma_settle(acc[1][1][3][0]);
        const int row0 = u.pm * 256 + wr * 64 + fr; int ct = u.pn * 256; bf16_t* base = G; if (ct >= DFF) { base = V; ct -= DFF; }
        const int col0 = ct + wc * 32 + 8 * fq;
#pragma unroll
        for (int ai = 0; ai < 2; ++ai)
#pragma unroll
            for (int m = 0; m < 4; ++m) { bf16_t* rowp = base + (size_t)(row0 + ai * 128 + m * 16) * DFF + col0;
#pragma unroll
                for (int bj = 0; bj < 2; ++bj) { const f32x4 v0 = acc[ai][bj][m][0], v1 = acc[ai][bj][m][1];
                    u32x4 w; w.x = cvt_pk_bf16(v0[0], v0[1]); w.y = cvt_pk_bf16(v0[2], v0[3]); w.z = cvt_pk_bf16(v1[0], v1[1]); w.w = cvt_pk_bf16(v1[2], v1[3]);
                    *(u32x4*)(rowp + bj * 128) = w; } }
    }
};

__device__ __forceinline__ void xpose_item(const float* W, int K, int N, bf16_t* WT, int d0, int s0, int k0, float* scr, int lane) {
#pragma unroll
    for (int i = 0; i < 32; ++i) { const int kk = 2 * i + (lane >> 5); scr[kk * 33 + (lane & 31)] = s0 >= 0 ? W[(size_t)(k0 + kk) * N + s0 + (lane & 31)] : 0.f; }
    asm volatile("s_waitcnt lgkmcnt(0)" ::: "memory");
    const int c = lane & 7;
#pragma unroll
    for (int j = 0; j < 4; ++j) { const int n = (lane >> 3) + 8 * j; const float* s = scr + (8 * c) * 33 + n;
        u32x4 o; o.x = cvt_pk_bf16(s[0 * 33], s[1 * 33]); o.y = cvt_pk_bf16(s[2 * 33], s[3 * 33]); o.z = cvt_pk_bf16(s[4 * 33], s[5 * 33]); o.w = cvt_pk_bf16(s[6 * 33], s[7 * 33]);
        *(u32x4*)(WT + (size_t)(d0 + n) * K + k0 + 8 * c) = o; }
    asm volatile("s_waitcnt lgkmcnt(0)" ::: "memory");
}
__device__ __forceinline__ void xpose_region(const Args& a, int layer, int region, float* scr, int gw, int NGW, int lane) {
    if (region == 0) {
        const float* w_in = a.in[6] + (size_t)layer * 2048 * 10304; const float* w_glu = a.in[15] + (size_t)layer * 1024 * 2048; const float* w_s5p = a.in[16] + (size_t)layer * 1024 * 2048;
        const float* w_ssdp = a.in[23] + (size_t)layer * 2048 * 2048; const float* w_out = a.in[24] + (size_t)layer * 2048 * 2048;
        bf16_t* WA = (bf16_t*)(a.ws + WS_WA);
        constexpr int I_IN = 32 * 328, I_GLU = 16 * 64, I_S5P = 16 * 64, I_SSDP = 32 * 64, I_WOUT = 32 * 64, NI = I_IN + I_GLU + I_S5P + I_SSDP + I_WOUT;
        for (int it = gw; it < NI; it += NGW) { int r = it;
            if (r < I_IN) { const int kb = r / 328, d0 = (r % 328) * 32; int s0; if (d0 < 4096) s0 = d0; else if (d0 < 10240) s0 = d0 + 64; else if (d0 < 10304) s0 = d0 - 10240 + 4096; else s0 = -1;
                xpose_item(w_in, 2048, 10304, WA + WA_IN / 2, d0, s0, kb * 64, scr, lane); continue; } r -= I_IN;
            if (r < I_GLU) { const int kb = r / 64, d0 = (r % 64) * 32, t = d0 >> 8, j = d0 & 255; const int s0 = j < 128 ? t * 128 + j : 1024 + t * 128 + (j - 128);
                xpose_item(w_glu, 1024, 2048, WA + WA_GLU / 2, d0, s0, kb * 64, scr, lane); continue; } r -= I_GLU;
            if (r < I_S5P) { const int kb = r / 64, d0 = (r % 64) * 32; xpose_item(w_s5p, 1024, 2048, WA + WA_S5P / 2, d0, d0, kb * 64, scr, lane); continue; } r -= I_S5P;
            if (r < I_SSDP) { const int kb = r / 64, d0 = (r % 64) * 32; xpose_item(w_ssdp, 2048, 2048, WA + WA_SSDP / 2, d0, d0, kb * 64, scr, lane); continue; } r -= I_SSDP;
            { const int kb = r / 64, d0 = (r % 64) * 32; xpose_item(w_out, 2048, 2048, WA + WA_WOUT / 2, d0, d0, kb * 64, scr, lane); }
        }
    } else {
        const float* w_up = a.in[27] + (size_t)layer * 2048 * 11264; const float* w_down = a.in[30] + (size_t)layer * 5632 * 2048;
        bf16_t* WB = (bf16_t*)(a.ws + WS_WB);
        constexpr int I_UP = 32 * 352, I_DOWN = 88 * 64, NI = I_UP + I_DOWN;
        for (int it = gw; it < NI; it += NGW) { int r = it;
            if (r < I_UP) { const int kb = r / 352, d0 = (r % 352) * 32; xpose_item(w_up, 2048, 11264, WB + WB_UP / 2, d0, d0, kb * 64, scr, lane); continue; } r -= I_UP;
            { const int kb = r / 64, d0 = (r % 64) * 32; xpose_item(w_down, 5632, 2048, WB + WB_DOWN / 2, d0, d0, kb * 64, scr, lane); }
        }
    }
}

__device__ __forceinline__ void adaln_phase(const Args& a, float* lds, int tid) {
    float* sc = lds; float* scx = lds + 2048; float* red = lds + 4096;
    for (int i = tid; i < 2048; i += 512) { sc[i] = silu_(a.in[1][i]); scx[i] = silu_(a.in[3][i]); }
    __syncthreads();
    for (int unit = blockIdx.x; unit < 256; unit += gridDim.x) {
        const int layer = unit >> 7, col0 = (unit & 127) * 96;
        const float* W = a.in[4] + (size_t)layer * 2048 * 12288 + col0;
        if (tid < 504) { const int cq = tid % 24, ks = tid / 24; f32x4 al = {0.f, 0.f, 0.f, 0.f}, ac = {0.f, 0.f, 0.f, 0.f};
#pragma unroll 7
            for (int k = ks; k < 2048; k += 21) { const f32x4 w = *(const f32x4*)(W + (size_t)k * 12288 + cq * 4); al += w * sc[k]; ac += w * scx[k]; }
            *(f32x4*)(red + (ks * 2 + 0) * 96 + cq * 4) = al; *(f32x4*)(red + (ks * 2 + 1) * 96 + cq * 4) = ac; }
        __syncthreads();
        if (tid < 192) { const int v = tid / 96, c = tid % 96; float s = 0.f; for (int ks = 0; ks < 21; ++ks) s += red[(ks * 2 + v) * 96 + c];
            ((float*)(a.ws + WS_MVEC))[(size_t)(layer * 2 + v) * 12288 + col0 + c] = s + a.in[5][(size_t)layer * 12288 + col0 + c]; }
        __syncthreads();
    }
}

__device__ __forceinline__ float wave_sum(float v) {
#pragma unroll
    for (int o = 1; o < 64; o <<= 1) v += __shfl_xor(v, o);
    return v;
}
template <int MODE> __device__ __forceinline__ void row_phase(const Args& a, int nrows, const float* lng, const float* lnb, int mod_layer, int mod_off, int gw, int NGW, int lane) {
    bf16_t* XM = (bf16_t*)(a.ws + WS_XM);
    for (int row = gw; row < nrows; row += NGW) {
        const int isctx = row >= TL; float* h = hrow(a, row);
        const float* src = MODE == 0 ? (isctx ? a.in[2] + (size_t)(row - TL) * D : a.in[0] + (size_t)row * D) : h;
        f32x4 v[8];
#pragma unroll
        for (int j = 0; j < 8; ++j) v[j] = *(const f32x4*)(src + 4 * lane + 256 * j);
        if (MODE == 1) {
            float s = 0.f;
#pragma unroll
            for (int j = 0; j < 8; ++j) s += (v[j][0] + v[j][1]) + (v[j][2] + v[j][3]);
            const float mean = wave_sum(s) * (1.f / D); float q = 0.f;
#pragma unroll
            for (int j = 0; j < 8; ++j) { v[j] = v[j] - mean; q += (v[j][0] * v[j][0] + v[j][1] * v[j][1]) + (v[j][2] * v[j][2] + v[j][3] * v[j][3]); }
            const float rstd = 1.f / sqrtf(wave_sum(q) * (1.f / D) + LN_EPS);
#pragma unroll
            for (int j = 0; j < 8; ++j) { const f32x4 g = *(const f32x4*)(lng + 4 * lane + 256 * j), b = *(const f32x4*)(lnb + 4 * lane + 256 * j); v[j] = v[j] * rstd * g + b; }
        }
#ifdef MK_SANITIZE
#pragma unroll
        for (int j = 0; j < 8; ++j)
#pragma unroll
            for (int e = 0; e < 4; ++e) if (!(fabsf(v[j][e]) < 1e30f)) v[j][e] = 0.f;
#endif
#pragma unroll
        for (int j = 0; j < 8; ++j) *(f32x4*)(h + 4 * lane + 256 * j) = v[j];
        if (mod_layer >= 0) { const float* m = mvec(a, mod_layer, isctx) + mod_off;
#pragma unroll
            for (int j = 0; j < 8; ++j) { const f32x4 sh = *(const f32x4*)(m + 4 * lane + 256 * j), scl = *(const f32x4*)(m + D + 4 * lane + 256 * j); const f32x4 o = v[j] * (scl + 1.f) + sh;
                u32x2 w; w.x = cvt_pk_bf16(o[0], o[1]); w.y = cvt_pk_bf16(o[2], o[3]); *(u32x2*)(XM + (size_t)row * D + 4 * lane + 256 * j) = w; } }
    }
}

__device__ __forceinline__ void ffnconv_phase(const Args& a, int layer, bool with_ctx, int tid) {
    const bf16_t* G = (const bf16_t*)(a.ws + WS_BIG + B_G); bf16_t* V = (bf16_t*)(a.ws + WS_BIG + B_V);
    const float* cw = a.in[28] + (size_t)layer * 9 * DFF; const float* cb = a.in[29] + (size_t)layer * DFF;
    const int nunits = (with_ctx ? 260 : 256) * 11; const int oc = tid & 63, xs = tid >> 6;
    for (int unit = blockIdx.x; unit < nunits; unit += gridDim.x) {
        const int seg = unit / 11, ob = unit % 11, ch0 = ob * 512 + oc * 8; const bool cs = seg >= 256; const int t0 = seg * 64;
        float w[9][8], bias[8];
#pragma unroll
        for (int k = 0; k < 9; ++k) { const f32x4 w0 = *(const f32x4*)(cw + (size_t)k * DFF + ch0), w1 = *(const f32x4*)(cw + (size_t)k * DFF + ch0 + 4);
            w[k][0] = w0[0]; w[k][1] = w0[1]; w[k][2] = w0[2]; w[k][3] = w0[3]; w[k][4] = w1[0]; w[k][5] = w1[1]; w[k][6] = w1[2]; w[k][7] = w1[3]; }
        { const f32x4 b0 = *(const f32x4*)(cb + ch0), b1 = *(const f32x4*)(cb + ch0 + 4); bias[0] = b0[0]; bias[1] = b0[1]; bias[2] = b0[2]; bias[3] = b0[3]; bias[4] = b1[0]; bias[5] = b1[1]; bias[6] = b1[2]; bias[7] = b1[3]; }
#pragma unroll 4
        for (int xi = 0; xi < 8; ++xi) { const int x = xs * 8 + xi, t = t0 + x; float acc[8];
#pragma unroll
            for (int k = 0; k < 8; ++k) acc[k] = bias[k];
#pragma unroll
            for (int dy = -1; dy <= 1; ++dy) { bool rok = cs ? (dy == 0) : ((dy < 0 ? seg > 0 : true) && (dy > 0 ? seg < 255 : true));
#pragma unroll
                for (int dx = -1; dx <= 1; ++dx) { const bool ok = rok && (cs ? (t + dx >= TL && t + dx < MT) : (x + dx >= 0 && x + dx < 64));
                    if (ok) { const u32x4 g = *(const u32x4*)(G + (size_t)(t + dy * 64 + dx) * DFF + ch0); const int k = (dy + 1) * 3 + dx + 1;
                        acc[0] += w[k][0] * bflo(g.x); acc[1] += w[k][1] * bfhi(g.x); acc[2] += w[k][2] * bflo(g.y); acc[3] += w[k][3] * bfhi(g.y);
                        acc[4] += w[k][4] * bflo(g.z); acc[5] += w[k][5] * bfhi(g.z); acc[6] += w[k][6] * bflo(g.w); acc[7] += w[k][7] * bfhi(g.w); } } }
            bf16_t* vp = V + (size_t)t * DFF + ch0; const u32x4 vv = *(const u32x4*)vp;
            u32x4 o; o.x = cvt_pk_bf16(silu_(acc[0]) * bflo(vv.x), silu_(acc[1]) * bfhi(vv.x)); o.y = cvt_pk_bf16(silu_(acc[2]) * bflo(vv.y), silu_(acc[3]) * bfhi(vv.y));
            o.z = cvt_pk_bf16(silu_(acc[4]) * bflo(vv.z), silu_(acc[5]) * bfhi(vv.z)); o.w = cvt_pk_bf16(silu_(acc[6]) * bflo(vv.w), silu_(acc[7]) * bfhi(vv.w));
            *(u32x4*)vp = o; }
    }
}

__device__ __forceinline__ int s5_chunk_at(int dir, int q) { return dir ? 129 - q : (q + 128) % 130; }
__device__ __forceinline__ int s5_pos_of(int dir, int c) { return dir ? 129 - c : (c + 2) % 130; }
template <int PASS> __device__ __forceinline__ void s5_phase(const Args& a, int layer, unsigned char* lds, int tid, int nchunks) {
    float* uL = (float*)lds;
    float* YL = (float*)(lds + 32768);
    bf16_t* ST = (bf16_t*)(lds + 65536);
    const bf16_t* U5 = (const bf16_t*)(a.ws + WS_BIG + B_U5); bf16_t* Y5 = (bf16_t*)(a.ws + WS_BIG + B_Y5);
    float2* S5LOC = (float2*)(a.ws + WS_S5LOC);
    const int lane = tid & 63, w = tid >> 6, gl = tid >> 7, dir = (tid >> 6) & 1, p = tid & 63, fr = lane & 15, fq = lane >> 4;
    int cur_gq = -1; float ab_re = 0.f, ab_im = 0.f, a128r = 0.f, a128i = 0.f; float bbr[16], bbi[16]; bf16x8 cm[4];
    for (int unit = blockIdx.x; unit < 16 * nchunks; unit += gridDim.x) {
        const int gq = unit / nchunks, c = unit % nchunks, g = gq * 4 + gl, row0 = c * 128;
        if (gq != cur_gq) { cur_gq = gq;
            const size_t pi = ((size_t)(layer * 2 + dir) * 64 + g) * 64 + p;
            const float lre = fminf(a.in[7][pi], -1e-4f), lim = a.in[8][pi], step = expf(a.in[9][(size_t)(layer * 2 + dir) * 64 + g]);
            const float mag = expf(lre * step); float sn, cs; sincosf(lim * step, &sn, &cs); ab_re = mag * cs; ab_im = mag * sn;
            const float den = lre * lre + lim * lim, q_re = ((ab_re - 1.f) * lre + ab_im * lim) / den, q_im = (ab_im * lre - (ab_re - 1.f) * lim) / den;
            const float* br = a.in[10] + (((size_t)layer * 64 + g) * 64 + p) * 16; const float* bi = a.in[11] + (((size_t)layer * 64 + g) * 64 + p) * 16;
#pragma unroll
            for (int j = 0; j < 16; ++j) { const float r = br[j], i = bi[j]; bbr[j] = q_re * r - q_im * i; bbi[j] = q_re * i + q_im * r; }
            a128r = ab_re; a128i = ab_im;
#pragma unroll
            for (int k = 0; k < 7; ++k) { const float r = a128r * a128r - a128i * a128i, i = 2.f * a128r * a128i; a128r = r; a128i = i; }
            if (PASS == 1) {
                const float* cre = a.in[12] + (((size_t)(layer * 2 + dir) * 64 + g) * 16 + fr) * 64; const float* cim = a.in[13] + (((size_t)(layer * 2 + dir) * 64 + g) * 16 + fr) * 64;
#pragma unroll
                for (int ks = 0; ks < 4; ++ks) { const float* s = (ks < 2 ? cre : cim) + (ks & 1) * 32 + fq * 8; const float sg = ks < 2 ? 1.f : -1.f;
                    const f32x4 v0 = *(const f32x4*)s, v1 = *(const f32x4*)(s + 4);
                    cm[ks] = mkfrag(cvt_pk_bf16(sg * v0[0], sg * v0[1]), cvt_pk_bf16(sg * v0[2], sg * v0[3]), cvt_pk_bf16(sg * v1[0], sg * v1[1]), cvt_pk_bf16(sg * v1[2], sg * v1[3])); }
            }
        }
        __syncthreads();
        { const int t = tid >> 2, q = tid & 3; const bf16_t* s = U5 + (size_t)(row0 + t) * 1024 + gq * 64 + q * 16; const u32x4 v0 = *(const u32x4*)s, v1 = *(const u32x4*)(s + 8);
            float* d = uL + t * 64 + q * 16;
            *(f32x4*)d = (f32x4){bflo(v0.x), bfhi(v0.x), bflo(v0.y), bfhi(v0.y)}; *(f32x4*)(d + 4) = (f32x4){bflo(v0.z), bfhi(v0.z), bflo(v0.w), bfhi(v0.w)};
            *(f32x4*)(d + 8) = (f32x4){bflo(v1.x), bfhi(v1.x), bflo(v1.y), bfhi(v1.y)}; *(f32x4*)(d + 12) = (f32x4){bflo(v1.z), bfhi(v1.z), bflo(v1.w), bfhi(v1.w)};
            if (PASS == 1) { float* y = YL + q * 2048 + t * 16; float z0; asm volatile("v_mov_b32 %0, 0" : "=v"(z0)); const f32x4 zv = {z0, z0, z0, z0};
#pragma unroll
                for (int j = 0; j < 4; ++j) *(f32x4*)(y + 4 * j) = zv; } }
        float sr = 0.f, si = 0.f;
        if (PASS == 1) {
            const int pos = s5_pos_of(dir, c);
#pragma unroll 1
            for (int q0 = 0; q0 < pos; q0 += 13) { float2 l[13];
#pragma unroll
                for (int i = 0; i < 13; ++i) { const int q = q0 + i < pos ? q0 + i : pos - 1; l[i] = S5LOC[((size_t)(dir * NCH + s5_chunk_at(dir, q)) * 64 + g) * 64 + p]; }
#pragma unroll
                for (int i = 0; i < 13; ++i) if (q0 + i < pos) { const float nr = a128r * sr - a128i * si + l[i].x, ni = a128r * si + a128i * sr + l[i].y; sr = nr; si = ni; } }
        }
        __syncthreads();
#pragma unroll 1
        for (int stp = 0; stp < 4; ++stp) {
#pragma unroll 8
            for (int ii = 0; ii < 32; ++ii) { const int i = stp * 32 + ii, t = dir ? 127 - i : i; const float* ut = uL + t * 64 + gl * 16;
                const f32x4 u0 = *(const f32x4*)ut, u1 = *(const f32x4*)(ut + 4), u2 = *(const f32x4*)(ut + 8), u3 = *(const f32x4*)(ut + 12);
                f32x2 b0 = {0.f, 0.f}, b1 = {0.f, 0.f};
#pragma unroll
                for (int j = 0; j < 4; ++j) { b0 = __builtin_elementwise_fma((f32x2){bbr[j], bbi[j]}, (f32x2){u0[j], u0[j]}, b0); b1 = __builtin_elementwise_fma((f32x2){bbr[4 + j], bbi[4 + j]}, (f32x2){u1[j], u1[j]}, b1);
                    b0 = __builtin_elementwise_fma((f32x2){bbr[8 + j], bbi[8 + j]}, (f32x2){u2[j], u2[j]}, b0); b1 = __builtin_elementwise_fma((f32x2){bbr[12 + j], bbi[12 + j]}, (f32x2){u3[j], u3[j]}, b1); }
                f32x2 ns = b0 + b1; ns = __builtin_elementwise_fma((f32x2){ab_re, ab_re}, (f32x2){sr, si}, ns); ns = __builtin_elementwise_fma((f32x2){-ab_im, ab_im}, (f32x2){si, sr}, ns); sr = ns[0]; si = ns[1];
                if (PASS == 1) { bf16_t* st = ST + ((size_t)(dir * 4 + gl) * 32 + (t & 31)) * 136; st[p] = (bf16_t)(cvt_pk_bf16(sr, 0.f) & 0xffffu); st[64 + p] = (bf16_t)(cvt_pk_bf16(si, 0.f) & 0xffffu); }
            }
            if (PASS == 1) {
                asm volatile("s_waitcnt lgkmcnt(0)" ::: "memory");
                const int tb = (dir ? 3 - stp : stp) * 32;
#pragma unroll
                for (int rt = 0; rt < 2; ++rt) { f32x4 acc = {0.f, 0.f, 0.f, 0.f};
#pragma unroll
                    for (int ks = 0; ks < 4; ++ks) { const bf16x8 af = *(const bf16x8*)(ST + ((size_t)(dir * 4 + gl) * 32 + rt * 16 + fr) * 136 + ks * 32 + fq * 8); acc = __builtin_amdgcn_mfma_f32_16x16x32_bf16(af, cm[ks], acc, 0, 0, 0); }
#pragma unroll
                    for (int jj = 0; jj < 4; ++jj) YL[gl * 2048 + (tb + rt * 16 + fq * 4 + jj) * 16 + fr] += acc[jj]; }
                __syncthreads();
            }
        }
        if (PASS == 0) { S5LOC[((size_t)(dir * NCH + c) * 64 + g) * 64 + p] = make_float2(sr, si); }
        else { const int t = tid >> 2, q = tid & 3; const float* y = YL + q * 2048 + t * 16; const float* u = uL + t * 64 + q * 16; const float* dd = a.in[14] + (size_t)layer * 1024 + gq * 64 + q * 16;
            unsigned o[8];
#pragma unroll
            for (int j = 0; j < 8; ++j) { const float y0 = y[2 * j] + u[2 * j] * dd[2 * j], y1 = y[2 * j + 1] + u[2 * j + 1] * dd[2 * j + 1]; o[j] = cvt_pk_bf16(gelu_tanh(y0), gelu_tanh(y1)); }
            bf16_t* dst = Y5 + (size_t)(row0 + t) * 1024 + gq * 64 + q * 16; u32x4 o0, o1; o0.x = o[0]; o0.y = o[1]; o0.z = o[2]; o0.w = o[3]; o1.x = o[4]; o1.y = o[5]; o1.z = o[6]; o1.w = o[7];
            *(u32x4*)dst = o0; *(u32x4*)(dst + 8) = o1; }
    }
    __syncthreads();
}

__device__ __forceinline__ int ssd_chunk_at(int dir, int q) { return s5_chunk_at(dir, q); }
__device__ __forceinline__ void conv8(const bf16_t* XBC, int rowbase, int l0, int ch, bool lo_ok, bool hi_ok, float w0, float w1, float w2, float b, float (&out)[8]) {
    float r[10];
#pragma unroll
    for (int i = 0; i < 10; ++i) { const int l = l0 - 1 + i; const bool ok = (l >= 0 || lo_ok) && (l < 128 || hi_ok); r[i] = ok ? bf2f((unsigned)XBC[(size_t)(rowbase + l) * 3072 + ch]) : 0.f; }
#pragma unroll
    for (int j = 0; j < 8; ++j) out[j] = silu_(w0 * r[j] + w1 * r[j + 1] + w2 * r[j + 2] + b);
}
__device__ __forceinline__ void stage_conv_tile(const bf16_t* XBC, const float* cw, const float* cb, int rowbase, int chbase, bool lo_ok, bool hi_ok, bf16_t* dst, int tid) {
    const int oc = tid & 15, ch = chbase + oc * 8; float w[3][8], b[8];
#pragma unroll
    for (int k = 0; k < 3; ++k) { const f32x4 a0 = *(const f32x4*)(cw + (size_t)k * 3072 + ch), a1 = *(const f32x4*)(cw + (size_t)k * 3072 + ch + 4);
        w[k][0] = a0[0]; w[k][1] = a0[1]; w[k][2] = a0[2]; w[k][3] = a0[3]; w[k][4] = a1[0]; w[k][5] = a1[1]; w[k][6] = a1[2]; w[k][7] = a1[3]; }
    { const f32x4 a0 = *(const f32x4*)(cb + ch), a1 = *(const f32x4*)(cb + ch + 4); b[0] = a0[0]; b[1] = a0[1]; b[2] = a0[2]; b[3] = a0[3]; b[4] = a1[0]; b[5] = a1[1]; b[6] = a1[2]; b[7] = a1[3]; }
#pragma unroll
    for (int i = 0; i < 4; ++i) { const int row = (tid >> 4) + i * 32; float acc[8];
#pragma unroll
        for (int k = 0; k < 8; ++k) acc[k] = b[k];
#pragma unroll
        for (int d = 0; d < 3; ++d) { const bool ok = d == 1 ? true : (d == 0 ? (row > 0 || lo_ok) : (row < 127 || hi_ok)); const int l = ok ? row + d - 1 : row;
            { u32x4 g = *(const u32x4*)(XBC + (size_t)(rowbase + l) * 3072 + ch); if (!ok) g = (u32x4){0u, 0u, 0u, 0u};
                acc[0] += w[d][0] * bflo(g.x); acc[1] += w[d][1] * bfhi(g.x); acc[2] += w[d][2] * bflo(g.y); acc[3] += w[d][3] * bfhi(g.y);
                acc[4] += w[d][4] * bflo(g.z); acc[5] += w[d][5] * bfhi(g.z); acc[6] += w[d][6] * bflo(g.w); acc[7] += w[d][7] * bfhi(g.w); } }
        u32x4 o; o.x = cvt_pk_bf16(silu_(acc[0]), silu_(acc[1])); o.y = cvt_pk_bf16(silu_(acc[2]), silu_(acc[3])); o.z = cvt_pk_bf16(silu_(acc[4]), silu_(acc[5])); o.w = cvt_pk_bf16(silu_(acc[6]), silu_(acc[7]));
        *(u32x4*)(dst + row * 136 + oc * 8) = o; }
}
constexpr int SL_CS = 0, SL_CB = 34816, SL_CUM = 69632, SL_DT = 77824, SL_PART = 86016, SL_BS = 94208, SL_XT = 94208;
template <int AUX> __device__ __forceinline__ void ssd_cum(const Args& a, int layer, int c, int h, int w, int lane, unsigned char* lds) {
    const float* DT = (const float*)(a.ws + WS_BIG + B_DT); float* cumL = (float*)(lds + SL_CUM); float* dtL = (float*)(lds + SL_DT); float* CHD = (float*)(a.ws + WS_CHD);
#pragma unroll
    for (int dir = 0; dir < 2; ++dir) {
        const float ah = -expf(a.in[20][(size_t)(layer * 2 + dir) * 32 + h]);
        const float d0 = DT[(size_t)(c * 128 + 2 * lane) * 64 + dir * 32 + h], d1 = DT[(size_t)(c * 128 + 2 * lane + 1) * 64 + dir * 32 + h];
        const float l0 = d0 * ah, l1 = d1 * ah, s = l0 + l1; float incl = s;
#pragma unroll
        for (int o = 1; o < 64; o <<= 1) { const float t = __shfl_up(incl, o); if (lane >= o) incl += t; }
        const float excl = incl - s, tot = __shfl(incl, 63);
        float c0, c1;
        if (dir == 0) { c0 = excl + l0; c1 = incl; } else { c0 = tot - excl; c1 = tot - (excl + l0); }
        float* cu = cumL + (dir * 8 + w) * 128 + 2 * lane; cu[0] = c0; cu[1] = c1;
        float* dd = dtL + (dir * 8 + w) * 128 + 2 * lane;
        if (AUX == 0) { dd[0] = d0; dd[1] = d1; } else { dd[0] = d0 * __expf(tot - c0); dd[1] = d1 * __expf(tot - c1); if (lane == 0) CHD[(size_t)(dir * NCH + c) * 32 + h] = tot; }
    }
}
__device__ __forceinline__ void stage_T(const bf16_t* XBC, const float* cw, const float* cb, int rowbase, int ch, int r0, bool lo_ok, bool hi_ok, bf16_t* dstT) {
    float w[3][8], b[8];
#pragma unroll
    for (int k = 0; k < 3; ++k) { const f32x4 a0 = *(const f32x4*)(cw + (size_t)k * 3072 + ch), a1 = *(const f32x4*)(cw + (size_t)k * 3072 + ch + 4);
        w[k][0] = a0[0]; w[k][1] = a0[1]; w[k][2] = a0[2]; w[k][3] = a0[3]; w[k][4] = a1[0]; w[k][5] = a1[1]; w[k][6] = a1[2]; w[k][7] = a1[3]; }
    { const f32x4 a0 = *(const f32x4*)(cb + ch), a1 = *(const f32x4*)(cb + ch + 4); b[0] = a0[0]; b[1] = a0[1]; b[2] = a0[2]; b[3] = a0[3]; b[4] = a1[0]; b[5] = a1[1]; b[6] = a1[2]; b[7] = a1[3]; }
    u32x4 raw[10];
    const bf16_t* base = XBC + (size_t)(rowbase + r0) * 3072 + ch;
    const bool ok0 = r0 > 0 || lo_ok, ok9 = r0 < 120 || hi_ok;
#pragma unroll
    for (int i = 1; i < 9; ++i) raw[i] = *(const u32x4*)(base + (i - 1) * 3072);
    { const u32x4 v = *(const u32x4*)(base + (ok0 ? -3072 : 0)); raw[0] = ok0 ? v : (u32x4){0u, 0u, 0u, 0u}; }
    { const u32x4 v = *(const u32x4*)(base + (ok9 ? 8 * 3072 : 7 * 3072)); raw[9] = ok9 ? v : (u32x4){0u, 0u, 0u, 0u}; }
    float sp[8]; unsigned o[8][4];
#pragma unroll
    for (int r = 0; r < 8; ++r) { float sv[8];
#pragma unroll
        for (int k = 0; k < 8; ++k) { float acc = b[k];
#pragma unroll
            for (int d = 0; d < 3; ++d) { const unsigned wd = k < 2 ? raw[r + d].x : (k < 4 ? raw[r + d].y : (k < 6 ? raw[r + d].z : raw[r + d].w)); acc += w[d][k] * ((k & 1) ? bfhi(wd) : bflo(wd)); }
            sv[k] = silu_(acc); }
        if (r & 1) {
#pragma unroll
            for (int k = 0; k < 8; ++k) o[k][r >> 1] = cvt_pk_bf16(sp[k], sv[k]); }
        else {
#pragma unroll
            for (int k = 0; k < 8; ++k) sp[k] = sv[k]; } }
#pragma unroll
    for (int k = 0; k < 8; ++k) { u32x4 v; v.x = o[k][0]; v.y = o[k][1]; v.z = o[k][2]; v.w = o[k][3]; *(u32x4*)(dstT + k * 136 + r0) = v; }
}
__device__ __forceinline__ void ssd_a_phase(const Args& a, int layer, unsigned char* lds, int tid) {
    const bf16_t* XBC = (const bf16_t*)(a.ws + WS_BIG + B_XBC); bf16_t* SST = (bf16_t*)(a.ws + WS_SST);
    const float* cw = a.in[17] + (size_t)layer * 3 * 3072; const float* cb = a.in[18] + (size_t)layer * 3072;
    bf16_t* BT = (bf16_t*)(lds + SL_CS); bf16_t* xT = (bf16_t*)(lds + SL_XT); const float* wL = (const float*)(lds + SL_DT);
    for (int unit = blockIdx.x; unit < NCH * 4; unit += gridDim.x) {
        int tl = tid; asm volatile("" : "+v"(tl));
        const int lane = tl & 63, w = __builtin_amdgcn_readfirstlane(tl >> 6), fr = lane & 15, fq = lane >> 4, og = lane & 7, rr = lane >> 3;
        const int c = unit >> 2, g = unit & 3, rowbase = c * 128; const bool lo_ok = !(c == 0 || c == 128), hi_ok = !(c == 127 || c == 129);
        __syncthreads();
        if (w < 4) { const int oct = (w & 1) * 8 + og; stage_T(XBC, cw, cb, rowbase, 2048 + g * 128 + oct * 8, ((w >> 1) * 8 + rr) * 8, lo_ok, hi_ok, BT + (oct * 8) * 136); }
        ssd_cum<1>(a, layer, c, g * 8 + w, w, lane, lds);
#pragma unroll 1
        for (int pass = 0; pass < 2; ++pass) {
            if (pass) __syncthreads();
            { const int hs = w & 3; stage_T(XBC, cw, cb, rowbase, (g * 8 + pass * 4 + hs) * 64 + og * 8, ((w >> 2) * 8 + rr) * 8, lo_ok, hi_ok, xT + ((hs * 64 + og * 8) * 136)); }
            __syncthreads();
            const int hl = w >> 1, dir = w & 1, hh = pass * 4 + hl, h = g * 8 + hh;
            bf16_t* sb = SST + (((size_t)(dir * NCH + c) * 32 + h) * 64) * 128;
#pragma unroll 1
            for (int nh = 0; nh < 2; ++nh) {
                f32x4 acc[4][4];
#pragma unroll
                for (int pt = 0; pt < 4; ++pt)
#pragma unroll
                    for (int nt = 0; nt < 4; ++nt) acc[pt][nt] = (f32x4){0.f, 0.f, 0.f, 0.f};
#pragma unroll
                for (int ks = 0; ks < 4; ++ks) {
                    const float* wp = wL + (dir * 8 + hh) * 128 + ks * 32 + fq * 8; const f32x4 wl0 = *(const f32x4*)wp, wl1 = *(const f32x4*)(wp + 4);
                    bf16x8 yf[4];
#pragma unroll
                    for (int pt = 0; pt < 4; ++pt) { const u32x4 xr = *(const u32x4*)(xT + ((hl * 64 + pt * 16 + fr) * 136 + ks * 32 + fq * 8));
                        yf[pt] = mkfrag(cvt_pk_bf16(bflo(xr.x) * wl0[0], bfhi(xr.x) * wl0[1]), cvt_pk_bf16(bflo(xr.y) * wl0[2], bfhi(xr.y) * wl0[3]), cvt_pk_bf16(bflo(xr.z) * wl1[0], bfhi(xr.z) * wl1[1]), cvt_pk_bf16(bflo(xr.w) * wl1[2], bfhi(xr.w) * wl1[3])); }
#pragma unroll
                    for (int nt = 0; nt < 4; ++nt) { const bf16x8 xf = *(const bf16x8*)(BT + ((nh * 4 + nt) * 16 + fr) * 136 + ks * 32 + fq * 8);
#pragma unroll
                        for (int pt = 0; pt < 4; ++pt) acc[pt][nt] = __builtin_amdgcn_mfma_f32_16x16x32_bf16(xf, yf[pt], acc[pt][nt], 0, 0, 0); }
                }
#pragma unroll
                for (int pt = 0; pt < 4; ++pt) mfma_settle(acc[pt][3]);
#pragma unroll
                for (int pt = 0; pt < 4; ++pt)
#pragma unroll
                    for (int nt = 0; nt < 4; ++nt) { u32x2 o; o.x = cvt_pk_native(acc[pt][nt][0], acc[pt][nt][1]); o.y = cvt_pk_native(acc[pt][nt][2], acc[pt][nt][3]);
                        *(u32x2*)(sb + (size_t)(pt * 16 + fr) * 128 + (nh * 4 + nt) * 16 + fq * 4) = o; }
            }
        }
    }
    __syncthreads();
}
__device__ __forceinline__ void ssd_b_phase(const Args& a, int tid) {
    bf16_t* SST = (bf16_t*)(a.ws + WS_SST); const float* CHD = (const float*)(a.ws + WS_CHD);
    for (int idx = blockIdx.x * 512 + tid; idx < 64 * 2048; idx += gridDim.x * 512) {
        const int e4 = idx & 2047, hd = idx >> 11, dir = hd >> 5, h = hd & 31; float s0 = 0.f, s1 = 0.f, s2 = 0.f, s3 = 0.f;
#pragma unroll 1
        for (int b = 0; b < 13; ++b) { u32x2 loc[10]; float dc[10];
#pragma unroll
            for (int i = 0; i < 10; ++i) { const int cq = ssd_chunk_at(dir, b * 10 + i); loc[i] = *(const u32x2*)(SST + ((size_t)(dir * NCH + cq) * 32 + h) * 8192 + e4 * 4); dc[i] = CHD[(size_t)(dir * NCH + cq) * 32 + h]; }
#pragma unroll
            for (int i = 0; i < 10; ++i) { const int cq = ssd_chunk_at(dir, b * 10 + i); u32x2 o; o.x = cvt_pk_bf16(s0, s1); o.y = cvt_pk_bf16(s2, s3);
                *(u32x2*)(SST + ((size_t)(dir * NCH + cq) * 32 + h) * 8192 + e4 * 4) = o; const float e = __expf(dc[i]);
                s0 = e * s0 + bflo(loc[i].x); s1 = e * s1 + bfhi(loc[i].x); s2 = e * s2 + bflo(loc[i].y); s3 = e * s3 + bfhi(loc[i].y); }
        }
    }
}
__device__ __forceinline__ void ssd_c_phase(const Args& a, int layer, unsigned char* lds, int tid, int nchunks) {
    const bf16_t* XBC = (const bf16_t*)(a.ws + WS_BIG + B_XBC); const bf16_t* SST = (const bf16_t*)(a.ws + WS_SST); const bf16_t* Z = (const bf16_t*)(a.ws + WS_BIG + B_Z); bf16_t* YD = (bf16_t*)(a.ws + WS_BIG + B_YD);
    const float* cw = a.in[17] + (size_t)layer * 3 * 3072; const float* cb = a.in[18] + (size_t)layer * 3072; const float* normw = a.in[22] + (size_t)layer * 2048;
    bf16_t* Cs = (bf16_t*)(lds + SL_CS); bf16_t* Bs = (bf16_t*)(lds + SL_BS); bf16_t* CBs = (bf16_t*)(lds + SL_CB); bf16_t* xT = (bf16_t*)(lds + SL_XT);
    const float* cumL = (const float*)(lds + SL_CUM); const float* dtL = (const float*)(lds + SL_DT); float* part = (float*)(lds + SL_PART);
    for (int unit = blockIdx.x; unit < nchunks * 4; unit += gridDim.x) {
        int tl = tid; asm volatile("" : "+v"(tl));
        const int lane = tl & 63, w = __builtin_amdgcn_readfirstlane(tl >> 6), fr = lane & 15, fq = lane >> 4, og = lane & 7, rr = lane >> 3;
        const int hl = w & 3, lh = w >> 2;
        const int c = unit >> 2, g = unit & 3, rowbase = c * 128; const bool lo_ok = !(c == 0 || c == 128), hi_ok = !(c == 127 || c == 129);
        __syncthreads();
        stage_conv_tile(XBC, cw, cb, rowbase, 2560 + g * 128, lo_ok, hi_ok, Cs, tl);
        stage_conv_tile(XBC, cw, cb, rowbase, 2048 + g * 128, lo_ok, hi_ok, Bs, tl);
        ssd_cum<0>(a, layer, c, g * 8 + w, w, lane, lds);
        __syncthreads();
#pragma unroll 1
        for (int st = 0; st < 8; ++st) { f32x4 acc = {0.f, 0.f, 0.f, 0.f};
#pragma unroll
            for (int ks = 0; ks < 4; ++ks) { const bf16x8 xf = *(const bf16x8*)(Bs + (st * 16 + fr) * 136 + ks * 32 + fq * 8), yf = *(const bf16x8*)(Cs + (w * 16 + fr) * 136 + ks * 32 + fq * 8);
                acc = __builtin_amdgcn_mfma_f32_16x16x32_bf16(xf, yf, acc, 0, 0, 0); }
            mfma_settle(acc);
            u32x2 o; o.x = cvt_pk_native(acc[0], acc[1]); o.y = cvt_pk_native(acc[2], acc[3]); *(u32x2*)(CBs + (w * 16 + fr) * 136 + st * 16 + fq * 4) = o; }
#pragma unroll 1
        for (int pass = 0; pass < 2; ++pass) {
            __syncthreads();
            stage_T(XBC, cw, cb, rowbase, (g * 8 + pass * 4 + hl) * 64 + og * 8, (lh * 8 + rr) * 8, lo_ok, hi_ok, xT + ((hl * 64 + og * 8) * 136));
            __syncthreads();
            const int hh = pass * 4 + hl, h = g * 8 + hh; const float Dh = a.in[21][(size_t)layer * 32 + h];
#pragma unroll 1
            for (int ih = 0; ih < 2; ++ih) {
            f32x4 acc[2][4];
#pragma unroll
            for (int i = 0; i < 2; ++i)
#pragma unroll
                for (int pt = 0; pt < 4; ++pt) acc[i][pt] = (f32x4){0.f, 0.f, 0.f, 0.f};
#pragma unroll
            for (int dir = 0; dir < 2; ++dir) {
                const bf16_t* sb = SST + (((size_t)(dir * NCH + c) * 32 + h) * 64) * 128;
                f32x4 tmp[2][4];
#pragma unroll
                for (int i = 0; i < 2; ++i)
#pragma unroll
                    for (int pt = 0; pt < 4; ++pt) tmp[i][pt] = (f32x4){0.f, 0.f, 0.f, 0.f};
#pragma unroll
                for (int ks = 0; ks < 4; ++ks) { const int lb = (lh * 4 + ih * 2) * 16 + fr;
                    const bf16x8 yf0 = *(const bf16x8*)(Cs + lb * 136 + ks * 32 + fq * 8), yf1 = *(const bf16x8*)(Cs + (lb + 16) * 136 + ks * 32 + fq * 8);
#pragma unroll
                    for (int pt = 0; pt < 4; ++pt) { const bf16x8 sfr = *(const bf16x8*)(sb + (size_t)(pt * 16 + fr) * 128 + ks * 32 + fq * 8);
                        tmp[0][pt] = __builtin_amdgcn_mfma_f32_16x16x32_bf16(sfr, yf0, tmp[0][pt], 0, 0, 0); tmp[1][pt] = __builtin_amdgcn_mfma_f32_16x16x32_bf16(sfr, yf1, tmp[1][pt], 0, 0, 0); } }
#pragma unroll
                for (int i = 0; i < 2; ++i) { int frv = fr; asm volatile("" : "+v"(frv));
                    const int lt = lh * 4 + ih * 2 + i, l = lt * 16 + frv;
                    const float cl = cumL[(dir * 8 + hh) * 128 + l], el = __expf(cl);
#pragma unroll
                    for (int pt = 0; pt < 4; ++pt) acc[i][pt] += tmp[i][pt] * el;
#pragma unroll
                    for (int ks = 0; ks < 4; ++ks) { const int s0 = ks * 32;
                        const bool skip = dir == 0 ? (s0 > lt * 16 + 15) : (s0 + 31 < lt * 16);
                        if (!skip) { const u32x4 cbv = *(const u32x4*)(CBs + l * 136 + s0 + fq * 8);
                            const float* cp = cumL + (dir * 8 + hh) * 128 + s0 + fq * 8; const float* dp = dtL + (dir * 8 + hh) * 128 + s0 + fq * 8;
                            const f32x4 c0 = *(const f32x4*)cp, c1 = *(const f32x4*)(cp + 4), d0 = *(const f32x4*)dp, d1 = *(const f32x4*)(dp + 4);
                            float cbf[8] = {bflo(cbv.x), bfhi(cbv.x), bflo(cbv.y), bfhi(cbv.y), bflo(cbv.z), bfhi(cbv.z), bflo(cbv.w), bfhi(cbv.w)}; float v[8];
#pragma unroll
                            for (int j = 0; j < 8; ++j) { const int sx = s0 + fq * 8 + j; const float cs = j < 4 ? c0[j & 3] : c1[j & 3], ds = j < 4 ? d0[j & 3] : d1[j & 3];
                                const bool valid = dir == 0 ? (sx <= l) : (sx >= l); float t = valid ? cbf[j] * __expf(fminf(cl - cs, 0.f)) * ds : 0.f; if (dir == 0 && sx == l) t += Dh; v[j] = t; }
                            const bf16x8 yf = mkfrag(cvt_pk_bf16(v[0], v[1]), cvt_pk_bf16(v[2], v[3]), cvt_pk_bf16(v[4], v[5]), cvt_pk_bf16(v[6], v[7]));
#pragma unroll
                            for (int pt = 0; pt < 4; ++pt) acc[i][pt] = __builtin_amdgcn_mfma_f32_16x16x32_bf16(*(const bf16x8*)(xT + ((hl * 64 + pt * 16 + fr) * 136 + s0 + fq * 8)), yf, acc[i][pt], 0, 0, 0); } }
                }
            }
#pragma unroll
            for (int i = 0; i < 2; ++i) { const int l = (lh * 4 + ih * 2 + i) * 16 + fr; const size_t row = (size_t)(rowbase + l); float ss = 0.f;
#pragma unroll
                for (int pt = 0; pt < 4; ++pt) { const int ch = h * 64 + pt * 16 + fq * 4; const u32x2 zz = *(const u32x2*)(Z + row * 2048 + ch);
                    const float h0 = acc[i][pt][0] * silu_(bflo(zz.x)), h1 = acc[i][pt][1] * silu_(bfhi(zz.x)), h2 = acc[i][pt][2] * silu_(bflo(zz.y)), h3 = acc[i][pt][3] * silu_(bfhi(zz.y));
                    ss += (h0 * h0 + h1 * h1) + (h2 * h2 + h3 * h3); u32x2 o; o.x = cvt_pk_bf16(h0, h1); o.y = cvt_pk_bf16(h2, h3); *(u32x2*)(YD + row * 2048 + ch) = o; }
                ss += __shfl_xor(ss, 16); ss += __shfl_xor(ss, 32);
                if (fq == 0) part[hh * 128 + l] = ss; }
            }
        }
        __syncthreads();
#pragma unroll 1
        for (int it = 0; it < 8; ++it) { const int pass = it >> 2, i = it & 3, l = (lh * 4 + i) * 16 + fr, h = g * 8 + pass * 4 + hl; float tot = 0.f;
#pragma unroll
            for (int hd = 0; hd < 8; ++hd) tot += part[hd * 128 + l];
            const float r = 1.f / sqrtf(tot * (1.f / 512.f) + RMS_EPS); const size_t row = (size_t)(rowbase + l);
#pragma unroll
            for (int pt = 0; pt < 4; ++pt) { const int ch = h * 64 + pt * 16 + fq * 4; bf16_t* yp = YD + row * 2048 + ch; const u32x2 hv = *(const u32x2*)yp; const f32x4 nw = *(const f32x4*)(normw + ch);
                u32x2 o; o.x = cvt_pk_bf16(bflo(hv.x) * r * nw[0], bfhi(hv.x) * r * nw[1]); o.y = cvt_pk_bf16(bflo(hv.y) * r * nw[2], bfhi(hv.y) * r * nw[3]); *(u32x2*)yp = o; } }
    }
    __syncthreads();
}

#define LAS __attribute__((address_space(3)))
#define XB_TMO      128
#define XB_XCNT(j)  (256  + 64 * (j))
#define XB_XSUB(j)  (1280 + 64 * (j))
#define XB_XGEN(j)  (2304 + 64 * (j))
#define XB_TOP      3328
#define XB_TOPGEN   3392
#define XCD_BAR_WORDS 3456
#define XB_SPIN_CAP (1u << 18)

__device__ __forceinline__ unsigned xb_ld(unsigned* p)              { return __hip_atomic_load(p, __ATOMIC_RELAXED, __HIP_MEMORY_SCOPE_AGENT); }
__device__ __forceinline__ unsigned xb_add(unsigned* p, unsigned v) { return __hip_atomic_fetch_add(p, v, __ATOMIC_RELAXED, __HIP_MEMORY_SCOPE_AGENT); }
__device__ __forceinline__ unsigned xb_xcc_id() { return (unsigned)__builtin_amdgcn_s_getreg((3 << 11) | 20) & 0xFu; }
#define XB_SPIN(cond, bar) do { unsigned _sp = 0; while (cond) { __builtin_amdgcn_s_sleep(1); \
    if ((++_sp & 255u) == 0u) { if (xb_ld(&(bar)[XB_TMO])) break; if (_sp > XB_SPIN_CAP) { atomicAdd(&(bar)[XB_TMO], 1u); break; } } } } while (0)

struct XcdBarrier {
    unsigned* bar; unsigned x;
    volatile LAS unsigned* st;
};

__device__ __forceinline__ XcdBarrier xcd_barrier_post(unsigned* bar, volatile LAS unsigned* st) {
    XcdBarrier b; b.bar = bar; b.x = xb_xcc_id(); b.st = st;
    if (threadIdx.x == 0) (void)xb_add(&bar[XB_XCNT(b.x)], 1u);
    return b;
}
__device__ __forceinline__ void xcd_barrier_complete(unsigned* bar, unsigned x, unsigned& nloc, unsigned& nx) {
    const unsigned G = gridDim.x * gridDim.y * gridDim.z;
    unsigned sum, cnt, mine, sp = 0u;
    for (;;) {
        sum = 0u; cnt = 0u; mine = 0u;
#pragma unroll
        for (unsigned j = 0; j < 16; ++j) { const unsigned c = xb_ld(&bar[XB_XCNT(j)]); sum += c; cnt += (c > 0u) ? 1u : 0u; mine = (j == x) ? c : mine; }
        if (sum == G) break;
        __builtin_amdgcn_s_sleep(1);
        if ((++sp & 255u) == 0u) { if (xb_ld(&bar[XB_TMO])) break; if (sp > XB_SPIN_CAP) { atomicAdd(&bar[XB_TMO], 1u); break; } }
    }
    nloc = mine > 0u ? mine : 1u; nx = cnt > 0u ? cnt : 1u;
}

__device__ __forceinline__ void xcd_barrier(const XcdBarrier& b) {
    asm volatile("s_waitcnt vmcnt(0)" ::: "memory");
    __syncthreads();
    if (threadIdx.x == 0) {
        unsigned* bar = b.bar;
        __builtin_amdgcn_s_waitcnt(0);
        unsigned nloc = b.st[0], nx = b.st[1];
        if (nloc == 0u) { xcd_barrier_complete(bar, b.x, nloc, nx); b.st[0] = nloc; b.st[1] = nx; }
        const unsigned old = xb_add(&bar[XB_XSUB(b.x)], 1u);
        const unsigned gen = old / nloc;
        if (old + 1u == (gen + 1u) * nloc) {
            __builtin_amdgcn_fence(__ATOMIC_RELEASE, "agent");
            asm volatile("s_waitcnt vmcnt(0)" ::: "memory");
            const unsigned og = xb_add(&bar[XB_TOP], 1u);
            const unsigned tg = og / nx;
            if (og + 1u == (tg + 1u) * nx) xb_add(&bar[XB_TOPGEN], 1u);
            else XB_SPIN(xb_ld(&bar[XB_TOPGEN]) == tg, bar);
            __builtin_amdgcn_fence(__ATOMIC_ACQUIRE, "agent");
            xb_add(&bar[XB_XGEN(b.x)], 1u);
            asm volatile("s_waitcnt vmcnt(0)" ::: "memory");
        } else {
            XB_SPIN(xb_ld(&bar[XB_XGEN(b.x)]) == gen, bar);
            __builtin_amdgcn_fence(__ATOMIC_ACQUIRE, "agent");
            asm volatile("s_waitcnt vmcnt(0)" ::: "memory");
        }
    }
    __syncthreads();
}

#ifndef MK_REP_S5
#define MK_REP_S5 1
#endif
#ifndef MK_REP_SSD
#define MK_REP_SSD 1
#endif
#ifndef MK_REP_SYNC
#define MK_REP_SYNC 1
#endif
#ifndef MK_CG_SYNC_ALL
#define MK_CG_SYNC_ALL 0
#endif
#ifndef MK_REP_PRO
#define MK_REP_PRO 1
#endif
#ifndef MK_REP_GEMM
#define MK_REP_GEMM 1
#endif
constexpr int NPHASE = 2 + 11 * 2;
__global__ void __launch_bounds__(512, 2) fwd_megakernel(Args a) {
    extern __shared__ __attribute__((aligned(16))) unsigned char lds[];
    PG8_LAS unsigned char* lds3 = (PG8_LAS unsigned char*)lds;
    unsigned char* big = a.ws + WS_BIG;
    volatile LAS unsigned* bst = (volatile LAS unsigned*)(lds3 + (LDS_BYTES - 16));
    if (threadIdx.x < 4) bst[threadIdx.x] = 0u;
    __syncthreads();
    XcdBarrier xbar; xbar.bar = (unsigned*)(a.ws + WS_BAR); xbar.x = 0; xbar.st = bst;
    if (a.ph_hi - a.ph_lo > 1) xbar = xcd_barrier_post((unsigned*)(a.ws + WS_BAR), bst);
    for (int ph = a.ph_lo; ph < a.ph_hi; ++ph) {
        const int tid = pg8::pg8_tid(), lane = tid & 63, wave = tid >> 6, gw = blockIdx.x * 8 + wave, NGW = gridDim.x * 8;
        if (ph == 0) {
            for (int rep = 0; rep < MK_REP_PRO; ++rep) {
            adaln_phase(a, (float*)lds, tid);
            float* scr = (float*)lds + wave * (64 * 33);
            xpose_region(a, 0, 0, scr, gw, NGW, lane); xpose_region(a, 0, 1, scr, gw, NGW, lane); __syncthreads(); }
        } else if (ph == 1) {
            row_phase<0>(a, MT, nullptr, nullptr, 0, 0, gw, NGW, lane);
        } else {
            const int layer = (ph - 2) / 11, k = (ph - 2) % 11; const bool last = layer == 1; const int Mrows = last ? TL : MT;
            const bf16_t* WA = (const bf16_t*)(a.ws + WS_WA); const bf16_t* WB = (const bf16_t*)(a.ws + WS_WB);
#ifdef MK_SKIP_MASK
            if ((MK_SKIP_MASK >> k) & 1) { if (ph + 1 < a.ph_hi) xcd_barrier(xbar); continue; }
#endif
            if (k == 0) {
                pg8::Gemm g{(const bf16_t*)(a.ws + WS_XM), WA + WA_IN / 2, MT, NPROJ, D}; pg8::StaticOrder S; S.init(MT, NPROJ, gridDim.x, blockIdx.x);
                EpiInProj E{big, a.in[19] + (size_t)layer * 64}; for (int rep = 0; rep < MK_REP_GEMM; ++rep) { pg8::gemm_phase<EpiInProj, pg8::StaticOrder>(lds3, g, S, E, nullptr); __syncthreads(); }
            } else if (k == 1) {
                for (int rep = 0; rep < MK_REP_SSD; ++rep) ssd_a_phase(a, layer, lds, tid);
                for (int rep = 0; rep < MK_REP_S5; ++rep) s5_phase<0>(a, layer, lds, tid, NCH);
            } else if (k == 2) {
#if !defined(MK_NO_SSD) && !defined(MK_NO_SSDB)
                ssd_b_phase(a, tid);
#endif
                for (int rep = 0; rep < MK_REP_S5; ++rep) s5_phase<1>(a, layer, lds, tid, last ? 128 : NCH);
            } else if (k == 3) {
                for (int rep = 0; rep < MK_REP_SSD; ++rep) ssd_c_phase(a, layer, lds, tid, last ? 128 : NCH);
#ifndef MK_NO_S5
                pg8::Gemm g{(const bf16_t*)(big + B_Y5), WA + WA_GLU / 2, Mrows, 2048, 1024}; pg8::StaticOrder S; S.init(Mrows, 2048, gridDim.x, blockIdx.x);
                EpiGlu E{(bf16_t*)(big + B_U5)}; pg8::gemm_phase<EpiGlu, pg8::StaticOrder>(lds3, g, S, E, nullptr);
#endif
            } else if (k == 4) {
#ifndef MK_NO_S5
                { pg8::Gemm g{(const bf16_t*)(big + B_U5), WA + WA_S5P / 2, Mrows, 2048, 1024}; pg8::StaticOrder S; S.init(Mrows, 2048, gridDim.x, blockIdx.x);
                  EpiMerge<0> E{(bf16_t*)(big + B_XBC), (const bf16_t*)(big + B_GATE)}; pg8::gemm_phase<EpiMerge<0>, pg8::StaticOrder>(lds3, g, S, E, nullptr); }
                __syncthreads();
#endif
#ifndef MK_NO_SSD
#ifdef MK_NO_S5
                { pg8::Gemm g{(const bf16_t*)(big + B_YD), WA + WA_SSDP / 2, Mrows, 2048, 2048}; pg8::StaticOrder S; S.init(Mrows, 2048, gridDim.x, blockIdx.x);
                  EpiMerge<0, 1> E{(bf16_t*)(big + B_XBC), (const bf16_t*)(big + B_GATE)}; pg8::gemm_phase<EpiMerge<0, 1>, pg8::StaticOrder>(lds3, g, S, E, nullptr); }
#else
                { pg8::Gemm g{(const bf16_t*)(big + B_YD), WA + WA_SSDP / 2, Mrows, 2048, 2048}; pg8::StaticOrder S; S.init(Mrows, 2048, gridDim.x, blockIdx.x);
                  EpiMerge<1> E{(bf16_t*)(big + B_XBC), (const bf16_t*)(big + B_GATE)}; pg8::gemm_phase<EpiMerge<1>, pg8::StaticOrder>(lds3, g, S, E, nullptr); }
#endif
#endif
            } else if (k == 5) {
                pg8::Gemm g{(const bf16_t*)(big + B_XBC), WA + WA_WOUT / 2, Mrows, 2048, 2048}; pg8::StaticOrder S; S.init(Mrows, 2048, gridDim.x, blockIdx.x);
                EpiResid E{a.out, (float*)(a.ws + WS_HCTX), mvec(a, layer, 0) + 2 * D, mvec(a, layer, 1) + 2 * D}; pg8::gemm_phase<EpiResid, pg8::StaticOrder>(lds3, g, S, E, nullptr);
            } else if (k == 6) {
                row_phase<1>(a, Mrows, a.in[25] + (size_t)layer * D, a.in[26] + (size_t)layer * D, layer, 3 * D, gw, NGW, lane);
                if (!last) for (int rep = 0; rep < MK_REP_PRO; ++rep) { __syncthreads(); xpose_region(a, layer + 1, 0, (float*)lds + wave * (64 * 33), gw, NGW, lane); }
            } else if (k == 7) {
                pg8::Gemm g{(const bf16_t*)(a.ws + WS_XM), WB + WB_UP / 2, Mrows, 2 * DFF, D}; pg8::StaticOrder S; S.init(Mrows, 2 * DFF, gridDim.x, blockIdx.x);
                EpiUp E{(bf16_t*)(big + B_G), (bf16_t*)(big + B_V)}; for (int rep = 0; rep < MK_REP_GEMM; ++rep) { pg8::gemm_phase<EpiUp, pg8::StaticOrder>(lds3, g, S, E, nullptr); __syncthreads(); }
            } else if (k == 8) {
                ffnconv_phase(a, layer, !last, tid);
            } else if (k == 9) {
                pg8::Gemm g{(const bf16_t*)(big + B_V), WB + WB_DOWN / 2, Mrows, D, DFF}; pg8::StaticOrder S; S.init(Mrows, D, gridDim.x, blockIdx.x);
                EpiResid E{a.out, (float*)(a.ws + WS_HCTX), mvec(a, layer, 0) + 5 * D, mvec(a, layer, 1) + 5 * D}; pg8::gemm_phase<EpiResid, pg8::StaticOrder>(lds3, g, S, E, nullptr);
            } else {
                row_phase<1>(a, Mrows, a.in[31] + (size_t)layer * D, a.in[32] + (size_t)layer * D, last ? -1 : layer + 1, 0, gw, NGW, lane);
                if (!last) for (int rep = 0; rep < MK_REP_PRO; ++rep) { __syncthreads(); xpose_region(a, layer + 1, 1, (float*)lds + wave * (64 * 33), gw, NGW, lane); }
            }
        }
        if (ph + 1 < a.ph_hi) { for (int rep = 0; rep < MK_REP_SYNC; ++rep) { if (MK_CG_SYNC_ALL || ph == a.ph_lo) cg::this_grid().sync(); else xcd_barrier(xbar); } }
    }
}
}

#ifndef MK_N_LAUNCH_MODE
#define MK_N_LAUNCH_MODE 0
#endif
extern "C" void kernel_launch(void* const* d_in, const int* in_sizes, int n_in, void* d_out, int out_size, void* d_ws, size_t ws_size, hipStream_t stream) {
    static int grid = 0;
    if (grid == 0) {
        if (n_in != 33 || ws_size < mk::WS_END) { fprintf(stderr, "kernel_launch: need 33 inputs and %zu bytes of workspace (got %d, %zu)\n", (size_t)mk::WS_END, n_in, ws_size); grid = -1; return; }
        int dev = 0, cus = 0, per_cu = 0;
        (void)hipGetDevice(&dev); (void)hipDeviceGetAttribute(&cus, hipDeviceAttributeMultiprocessorCount, dev);
        if (hipFuncSetAttribute((const void*)mk::fwd_megakernel, hipFuncAttributeMaxDynamicSharedMemorySize, mk::LDS_BYTES) != hipSuccess) { fprintf(stderr, "kernel_launch: hipFuncSetAttribute failed\n"); grid = -1; return; }
        if (hipOccupancyMaxActiveBlocksPerMultiprocessor(&per_cu, (const void*)mk::fwd_megakernel, 512, mk::LDS_BYTES) != hipSuccess || per_cu < 1) { fprintf(stderr, "kernel_launch: occupancy query says %d\n", per_cu); per_cu = 1; }
        (void)hipGetLastError();
        grid = cus * per_cu; if (grid > 256) grid = 256;
    }
    if (grid < 0) return;
    mk::Args a{};
    for (int i = 0; i < 33; ++i) a.in[i] = (const float*)d_in[i];
    a.out = (float*)d_out; a.ws = (unsigned char*)d_ws;
#if MK_N_LAUNCH_MODE == 1
    for (int ph = 0; ph < mk::NPHASE; ++ph) { a.ph_lo = ph; a.ph_hi = ph + 1; hipLaunchKernelGGL(mk::fwd_megakernel, dim3(grid), dim3(512), mk::LDS_BYTES, stream, a); }
#else
    a.ph_lo = 0; a.ph_hi = mk::NPHASE;
    (void)hipMemsetAsync((unsigned char*)d_ws + mk::WS_BAR, 0, XCD_BAR_WORDS * sizeof(unsigned), stream);
    void* args[] = {&a};
    hipError_t e = hipLaunchCooperativeKernel((const void*)mk::fwd_megakernel, dim3(grid), dim3(512), args, mk::LDS_BYTES, stream);
    if (e != hipSuccess) fprintf(stderr, "cooperative launch failed: %s (grid %d)\n", hipGetErrorString(e), grid);
#endif
}
```

```cpp
#include <hip/hip_runtime.h>
#include <hip/hip_cooperative_groups.h>
#include <cstdio>
namespace cg = cooperative_groups;
#define MK_N_LAUNCH_MODE 0
namespace pg8 {
#define PG8_LAS __attribute__((address_space(3)))
typedef unsigned short bf16_t;
typedef short bf16x8 __attribute__((ext_vector_type(8)));
typedef float f32x4 __attribute__((ext_vector_type(4)));
typedef unsigned u32x4 __attribute__((ext_vector_type(4)));
constexpr int BM = 256, BK = 64, HALF = 128, HTB = HALF * BK * 2  , STAGE_BYTES = 8 * HTB, NXCD = 8, WGM = 8;

__host__ __device__ __forceinline__ int lds_byte(int r, int c) { const int st = (r >> 4) * 2 + (c >> 5), rr = r & 15, cc = c & 31, ob = rr * 64 + cc * 2; return st * 1024 + (ob ^ (((ob >> 9) & 1) << 5)); }
__host__ __device__ __forceinline__ void stage_rc(int b, int& R, int& C) { const int st = b / 1024, sb = b % 1024, swz = sb ^ (((sb >> 9) & 1) << 5); R = (st >> 1) * 16 + swz / 64; C = (st & 1) * 32 + (swz % 64) / 2; }
__host__ __device__ __forceinline__ int perm32(int rho) { const int n = rho >> 4, i = rho & 15; return 8 * (i >> 2) + 4 * n + (i & 3); }

__device__ __forceinline__ int pg8_tid() { int t = threadIdx.x; asm volatile("" : "+v"(t)); return t; }
struct Unit { int pm, pn; };
struct Gemm { const bf16_t* A; const bf16_t* Bt; int M, N, K; };

struct StaticOrder {
    int nM, nN, nwg, G, c;
    __host__ __device__ void init(int M, int N, int G_, int c_) { nM = M / BM; nN = N / BM; nwg = nM * nN; G = G_; c = c_; }
    __host__ __device__ bool next(int i, Unit& u) const {
        const long L = (long)i * G + c; if (L >= nwg) return false;
        int wgid = (int)L; { const int q = nwg / NXCD, r = nwg % NXCD, xcd = wgid % NXCD, off = wgid / NXCD; wgid = (xcd < r ? xcd * (q + 1) : r * (q + 1) + (xcd - r) * q) + off; }
        const int nig = WGM * nN, gid = wgid / nig, fm = gid * WGM, gsz = (nM - fm) < WGM ? (nM - fm) : WGM;
        u.pm = fm + ((wgid % nig) % gsz); u.pn = (wgid % nig) / gsz; return true;
    }
    __device__ __forceinline__ void a_ready(const Unit&) const {}
    __device__ __forceinline__ void done(const Unit&) const {}
};
typedef float f32x2c __attribute__((ext_vector_type(2))); typedef __bf16 bf16x2c __attribute__((ext_vector_type(2)));
__device__ __forceinline__ unsigned cvt_pk_native(float lo, float hi) { const f32x2c v = {lo, hi}; const bf16x2c b = __builtin_convertvector(v, bf16x2c); return __builtin_bit_cast(unsigned, b); }
__device__ __forceinline__ unsigned cvt_pk_bf16(float lo, float hi) { unsigned r; asm volatile("v_cvt_pk_bf16_f32 %0, %1, %2" : "=v"(r) : "v"(lo), "v"(hi)); return r; }
__device__ __forceinline__ void mfma_settle(const float __attribute__((ext_vector_type(4)))& a) { asm volatile("s_nop 15\n\ts_nop 7" :: "v"(a)); }
typedef float f32x2 __attribute__((ext_vector_type(2)));
template <class Epi, class Sched, bool STAMP = false>
__device__ __forceinline__ void gemm_phase(PG8_LAS unsigned char* lds, const Gemm g, const Sched& S, const Epi& E, unsigned long long* stamps) {
    const int tid = pg8_tid(), wid = __builtin_amdgcn_readfirstlane(tid >> 6), lane = tid & 63, wr = wid >> 2, wc = wid & 3, fr = lane & 15, fq = lane >> 4;
    const int K = g.K, nt = K / BK;
    int ts_lo = 0, ts_hi = 0, nts = 0; const unsigned long long rt_entry = STAMP ? (unsigned long long)wall_clock64() : 0ull;
#define PG8_STAMP() do { if (STAMP && wid == 0 && nts < 64) { const unsigned long long _c = (unsigned long long)clock64(); \
        ts_lo = (lane == nts) ? (int)(unsigned)_c : ts_lo; ts_hi = (lane == nts) ? (int)(unsigned)(_c >> 32) : ts_hi; ++nts; } } while (0)
    PG8_STAMP();
    unsigned voffA[2], voffB[2];
#pragma unroll
    for (int i = 0; i < 2; ++i) { int R, C; stage_rc(tid * 16 + i * 8192, R, C); const int Rb = Epi::PERM ? ((R & ~31) + perm32(R & 31)) : R;
        voffA[i] = (unsigned)(R * K + C) * 2u; voffB[i] = (unsigned)(Rb * K + C) * 2u; }
    const size_t kstep = (size_t)(BK * 2);
    const size_t hstep = (size_t)HALF * K * 2;
    const size_t tstep = 2 * hstep;
    const unsigned ldsw = (unsigned)wid * 1024u;
    const int aoff = lds_byte(wr * 64 + fr, fq * 8), boff = lds_byte(wc * 32 + fr, fq * 8);
#define PG8_SA(b, h) (((b) * 2 + (h)) * HTB)
#define PG8_SB(b, h) ((4 + (b) * 2 + (h)) * HTB)
#define PG8_STAGE(bufoff, gbase, voff) do { _Pragma("unroll") for (int _i = 0; _i < 2; ++_i) \
        __builtin_amdgcn_global_load_lds((const unsigned*)((const char*)(gbase) + (voff)[_i]), (PG8_LAS unsigned*)(lds + (bufoff) + ldsw + _i * 8192), 16, 0, 0); } while (0)
#define PG8_LDA(dst, b, h) do { _Pragma("unroll") for (int m = 0; m < 4; ++m) _Pragma("unroll") for (int k = 0; k < 2; ++k) dst[m][k] = *(const PG8_LAS bf16x8*)(lds + PG8_SA(b, h) + aoff + m * 2048 + k * 1024); } while (0)
#define PG8_LDB(dst, b, h) do { _Pragma("unroll") for (int n = 0; n < 2; ++n) _Pragma("unroll") for (int k = 0; k < 2; ++k) dst[n][k] = *(const PG8_LAS bf16x8*)(lds + PG8_SB(b, h) + boff + n * 2048 + k * 1024); } while (0)
#define PG8_MMA(ai, bj, At, Bt) do { __builtin_amdgcn_s_setprio(1); _Pragma("unroll") for (int m = 0; m < 4; ++m) _Pragma("unroll") for (int n = 0; n < 2; ++n) _Pragma("unroll") for (int k = 0; k < 2; ++k) \
        acc[ai][bj][m][n] = __builtin_amdgcn_mfma_f32_16x16x32_bf16(Bt[n][k], At[m][k], acc[ai][bj][m][n], 0, 0, 0); __builtin_amdgcn_s_setprio(0); } while (0)
#define PG8_WAIT_V(n) asm volatile("s_waitcnt vmcnt(" #n ")" ::: "memory")
#define PG8_WAIT_L(n) asm volatile("s_waitcnt lgkmcnt(" #n ")" ::: "memory")
#define PG8_BAR __builtin_amdgcn_s_barrier()
#define PG8_SCHED __builtin_amdgcn_sched_barrier(0)
    Unit cur, nxt; int ui = 0;
    if (!S.next(0, cur)) return;
    f32x4 acc[2][2][4][2];
#pragma unroll
    for (int a = 0; a < 2; ++a)
#pragma unroll
        for (int b = 0; b < 2; ++b)
#pragma unroll
            for (int m = 0; m < 4; ++m)
#pragma unroll
                for (int n = 0; n < 2; ++n) acc[a][b][m][n] = (f32x4){0.f, 0.f, 0.f, 0.f};
    bf16x8 At[4][2], B0[2][2], B1[2][2];
    const char* cA = (const char*)g.A + (size_t)cur.pm * tstep; const char* cB = (const char*)g.Bt + (size_t)cur.pn * tstep;
    S.a_ready(cur);
    PG8_STAGE(PG8_SB(0, 0), cB, voffB); PG8_STAGE(PG8_SA(0, 0), cA, voffA); PG8_STAGE(PG8_SB(0, 1), cB + hstep, voffB); PG8_STAGE(PG8_SA(0, 1), cA + hstep, voffA);
    if (wr == 1) PG8_BAR;
    PG8_WAIT_V(4); PG8_BAR;
    PG8_STAGE(PG8_SB(1, 0), cB + kstep, voffB); PG8_STAGE(PG8_SA(1, 0), cA + kstep, voffA); PG8_STAGE(PG8_SB(1, 1), cB + hstep + kstep, voffB);
    PG8_WAIT_V(6); PG8_BAR;
    PG8_STAMP();
    for (;;) {
        const bool has_next = S.next(ui + 1, nxt);
        const char* nA = has_next ? (const char*)g.A + (size_t)nxt.pm * tstep : cA; const char* nB = has_next ? (const char*)g.Bt + (size_t)nxt.pn * tstep : cB;
        for (int t = 0; t < nt; t += 2) {
            const bool last = (t == nt - 2);
            const char* a1 = cA + (size_t)(t + 1) * kstep;
            const char* a2 = last ? nA : cA + (size_t)(t + 2) * kstep; const char* b2 = last ? nB : cB + (size_t)(t + 2) * kstep;
            const char* a3 = a2 + kstep; const char* b3 = b2 + kstep;
            if (last && has_next) S.a_ready(nxt);
            PG8_LDB(B0, 0, 0); PG8_SCHED; PG8_LDA(At, 0, 0); PG8_STAGE(PG8_SA(1, 1), a1 + hstep, voffA);
            PG8_WAIT_L(8); PG8_BAR; PG8_WAIT_L(0); PG8_MMA(0, 0, At, B0); PG8_BAR; PG8_SCHED;
            PG8_LDB(B1, 0, 1); PG8_STAGE(PG8_SB(0, 0), b2, voffB);
            PG8_BAR; PG8_WAIT_L(0); PG8_MMA(0, 1, At, B1); PG8_BAR;
            PG8_LDA(At, 0, 1); PG8_STAGE(PG8_SA(0, 0), a2, voffA);
            PG8_BAR; PG8_WAIT_L(0); PG8_MMA(1, 0, At, B0); PG8_BAR; PG8_SCHED;
            PG8_STAGE(PG8_SB(0, 1), b2 + hstep, voffB);
            PG8_WAIT_V(6); PG8_BAR; PG8_MMA(1, 1, At, B1); PG8_BAR;
            PG8_LDB(B0, 1, 0); PG8_SCHED; PG8_LDA(At, 1, 0); PG8_STAGE(PG8_SA(0, 1), a2 + hstep, voffA);
            PG8_WAIT_L(8); PG8_BAR; PG8_WAIT_L(0); PG8_MMA(0, 0, At, B0); PG8_BAR; PG8_SCHED;
            PG8_LDB(B1, 1, 1); PG8_STAGE(PG8_SB(1, 0), b3, voffB);
            PG8_BAR; PG8_WAIT_L(0); PG8_MMA(0, 1, At, B1); PG8_BAR;
            PG8_LDA(At, 1, 1); PG8_STAGE(PG8_SA(1, 0), a3, voffA);
            PG8_BAR; PG8_WAIT_L(0); PG8_MMA(1, 0, At, B0); PG8_BAR; PG8_SCHED;
            PG8_STAGE(PG8_SB(1, 1), b3 + hstep, voffB);
            PG8_WAIT_V(6); PG8_BAR; PG8_MMA(1, 1, At, B1); PG8_BAR;
        }
        PG8_STAMP();
        if constexpr (!Epi::AFTER_DRAIN) { E(acc, cur, wr, wc, fr, fq); S.done(cur); }
        PG8_STAMP();
        if (!has_next) break;
#pragma unroll
        for (int a = 0; a < 2; ++a)
#pragma unroll
            for (int b = 0; b < 2; ++b)
#pragma unroll
                for (int m = 0; m < 4; ++m)
#pragma unroll
                    for (int n = 0; n < 2; ++n) acc[a][b][m][n] = (f32x4){0.f, 0.f, 0.f, 0.f};
        cur = nxt; cA = nA; cB = nB; ++ui;
    }
    PG8_WAIT_V(0);
    if (wr == 0) PG8_BAR;
    PG8_BAR;
    if constexpr (Epi::AFTER_DRAIN) { E.fused(acc, cur, wr, wc, fr, fq, lds, wid, lane); S.done(cur); }
    PG8_STAMP();
    if (STAMP && wid == 0) { stamps[lane] = lane < nts ? (((unsigned long long)(unsigned)ts_hi << 32) | (unsigned)ts_lo) : 0ull;
        if (lane == 62) stamps[62] = rt_entry; if (lane == 63) stamps[63] = (unsigned long long)wall_clock64(); }
#undef PG8_STAMP
#undef PG8_SA
#undef PG8_SB
#undef PG8_STAGE
#undef PG8_LDA
#undef PG8_LDB
#undef PG8_MMA
#undef PG8_WAIT_V
#undef PG8_WAIT_L
#undef PG8_BAR
#undef PG8_SCHED
}
}

namespace mk {
using pg8::bf16_t; using pg8::bf16x8; using pg8::f32x4; using pg8::u32x4; using pg8::Unit; using pg8::cvt_pk_bf16; using pg8::cvt_pk_native; using pg8::mfma_settle;
typedef unsigned u32x2 __attribute__((ext_vector_type(2)));
typedef float f32x2 __attribute__((ext_vector_type(2)));
constexpr int D = 2048, TL = 16384, TC = 256, MT = TL + TC, NCH = MT / 128;
constexpr int NPROJ = 10496, DFF = 5632;
constexpr size_t MiB = 1u << 20;
constexpr size_t WS_MVEC = 0, WS_CHD = 256 * 1024, WS_BAR = 512 * 1024, WS_S5LOC = 1 * MiB, WS_WA = 10 * MiB, WS_WB = 75 * MiB, WS_HCTX = 141 * MiB, WS_XM = 143 * MiB, WS_SST = 208 * MiB, WS_BIG = 338 * MiB, WS_END = 766 * MiB;
constexpr size_t B_U5 = 0, B_XBC = B_U5 + (size_t)MT * 1024 * 2, B_Z = B_XBC + (size_t)MT * 3072 * 2, B_GATE = B_Z + (size_t)MT * 2048 * 2, B_DT = B_GATE + (size_t)MT * 4096 * 2,
                 B_Y5 = 330 * MiB, B_YD = B_Y5 + (size_t)MT * 1024 * 2;
static_assert(B_DT + (size_t)MT * 64 * 4 <= B_Y5 && B_YD + (size_t)MT * 2048 * 2 <= 428 * MiB, "big map");
constexpr size_t B_G = 0, B_V = (size_t)MT * DFF * 2;
constexpr size_t WA_IN = 0, WA_GLU = 41 * MiB, WA_S5P = 45 * MiB, WA_SSDP = 49 * MiB, WA_WOUT = 57 * MiB, WB_UP = 0, WB_DOWN = 44 * MiB;
constexpr int LDS_BYTES = 163840;
constexpr float ALPHA = 1.41421356237f, LN_EPS = 1e-5f, RMS_EPS = 1e-5f;

struct Args { const float* in[33]; float* out; unsigned char* ws; int ph_lo, ph_hi; };

__device__ __forceinline__ float bf2f(unsigned b) { return __uint_as_float(b << 16); }
__device__ __forceinline__ float bflo(unsigned w) { return __uint_as_float(w << 16); }
__device__ __forceinline__ float bfhi(unsigned w) { return __uint_as_float(w & 0xffff0000u); }
__device__ __forceinline__ float sigm(float x) { return 1.f / (1.f + __expf(-x)); }
__device__ __forceinline__ float silu_(float x) { return x / (1.f + __expf(-x)); }
__device__ __forceinline__ float gelu_tanh(float x) { const float u = 0.7978845608028654f * (x + 0.044715f * x * x * x); const float th = 1.f - 2.f / (__expf(2.f * u) + 1.f); return 0.5f * x * (1.f + th); }
__device__ __forceinline__ bf16x8 mkfrag(unsigned a, unsigned b, unsigned c, unsigned d) { u32x4 v; v.x = a; v.y = b; v.z = c; v.w = d; return __builtin_bit_cast(bf16x8, v); }
__device__ __forceinline__ float* hrow(const Args& a, int row) { return row < TL ? a.out + (size_t)row * D : (float*)(a.ws + WS_HCTX) + (size_t)(row - TL) * D; }
__device__ __forceinline__ const float* mvec(const Args& a, int layer, int isctx) { return (const float*)(a.ws + WS_MVEC) + (size_t)(layer * 2 + isctx) * 12288; }

struct EpiInProj {
    static constexpr bool PERM = true, AFTER_DRAIN = false;
    unsigned char* big; const float* dt_bias;
    __device__ __forceinline__ void operator()(const f32x4 (&acc)[2][2][4][2], const Unit& u, int wr, int wc, int fr, int fq) const {
        mfma_settle(acc[1][1][3][1]); mfma_settle(acc[1][1][3][0]);
        const int row0 = u.pm * 256 + wr * 64 + fr, ct = u.pn * 256;
        if (ct >= 10240) {
            if (wc < 2) { const int cc = wc * 32 + 8 * fq; float* DT = (float*)(big + B_DT);
                const f32x4 b0 = *(const f32x4*)(dt_bias + cc), b1 = *(const f32x4*)(dt_bias + cc + 4);
#pragma unroll
                for (int ai = 0; ai < 2; ++ai)
#pragma unroll
                    for (int m = 0; m < 4; ++m) { float* rp = DT + (size_t)(row0 + ai * 128 + m * 16) * 64 + cc; f32x4 v0 = acc[ai][0][m][0] + b0, v1 = acc[ai][0][m][1] + b1;
#pragma unroll
                        for (int j = 0; j < 4; ++j) { v0[j] = v0[j] > 20.f ? v0[j] : log1pf(expf(v0[j])); v1[j] = v1[j] > 20.f ? v1[j] : log1pf(expf(v1[j])); }
                        *(f32x4*)rp = v0; *(f32x4*)(rp + 4) = v1; } }
            return;
        }
        bf16_t* base; int ld, c0; bool sg = false;
        if (ct < 1024) { base = (bf16_t*)(big + B_U5); ld = 1024; c0 = ct; }
        else if (ct < 4096) { base = (bf16_t*)(big + B_XBC); ld = 3072; c0 = ct - 1024; }
        else if (ct < 6144) { base = (bf16_t*)(big + B_Z); ld = 2048; c0 = ct - 4096; }
        else { base = (bf16_t*)(big + B_GATE); ld = 4096; c0 = ct - 6144; sg = true; }
        const int col0 = c0 + wc * 32 + 8 * fq;
#pragma unroll
        for (int ai = 0; ai < 2; ++ai)
#pragma unroll
            for (int m = 0; m < 4; ++m) { bf16_t* rowp = base + (size_t)(row0 + ai * 128 + m * 16) * ld + col0;
#pragma unroll
                for (int bj = 0; bj < 2; ++bj) { f32x4 v0 = acc[ai][bj][m][0], v1 = acc[ai][bj][m][1];
                    if (sg) {
#pragma unroll
                        for (int j = 0; j < 4; ++j) { v0[j] = sigm(v0[j]); v1[j] = sigm(v1[j]); } }
                    u32x4 w; w.x = cvt_pk_bf16(v0[0], v0[1]); w.y = cvt_pk_bf16(v0[2], v0[3]); w.z = cvt_pk_bf16(v1[0], v1[1]); w.w = cvt_pk_bf16(v1[2], v1[3]);
                    *(u32x4*)(rowp + bj * 128) = w; } }
    }
};
struct EpiGlu {
    static constexpr bool PERM = true, AFTER_DRAIN = false;
    bf16_t* O;
    __device__ __forceinline__ void operator()(const f32x4 (&acc)[2][2][4][2], const Unit& u, int wr, int wc, int fr, int fq) const {
        mfma_settle(acc[1][1][3][1]); mfma_settle(acc[1][1][3][0]);
        const int row0 = u.pm * 256 + wr * 64 + fr, col0 = u.pn * 128 + wc * 32 + 8 * fq;
#pragma unroll
        for (int ai = 0; ai < 2; ++ai)
#pragma unroll
            for (int m = 0; m < 4; ++m) { f32x4 v0 = acc[ai][0][m][0], v1 = acc[ai][0][m][1]; const f32x4 g0 = acc[ai][1][m][0], g1 = acc[ai][1][m][1];
#pragma unroll
                for (int j = 0; j < 4; ++j) { v0[j] *= sigm(g0[j]); v1[j] *= sigm(g1[j]); }
                u32x4 w; w.x = cvt_pk_bf16(v0[0], v0[1]); w.y = cvt_pk_bf16(v0[2], v0[3]); w.z = cvt_pk_bf16(v1[0], v1[1]); w.w = cvt_pk_bf16(v1[2], v1[3]);
                *(u32x4*)(O + (size_t)(row0 + ai * 128 + m * 16) * 1024 + col0) = w; }
    }
};
template <int SECOND, int GSEL = SECOND> struct EpiMerge {
    static constexpr bool PERM = true, AFTER_DRAIN = false;
    bf16_t* MG; const bf16_t* GATE;
    __device__ __forceinline__ void operator()(const f32x4 (&acc)[2][2][4][2], const Unit& u, int wr, int wc, int fr, int fq) const {
        mfma_settle(acc[1][1][3][1]); mfma_settle(acc[1][1][3][0]);
        const int row0 = u.pm * 256 + wr * 64 + fr, col0 = u.pn * 256 + wc * 32 + 8 * fq;
#pragma unroll
        for (int ai = 0; ai < 2; ++ai)
#pragma unroll
            for (int m = 0; m < 4; ++m) { const size_t r = (size_t)(row0 + ai * 128 + m * 16);
#pragma unroll
                for (int bj = 0; bj < 2; ++bj) { const int c = col0 + bj * 128; const u32x4 g = *(const u32x4*)(GATE + r * 4096 + (GSEL ? 2048 : 0) + c);
                    f32x4 v0 = acc[ai][bj][m][0], v1 = acc[ai][bj][m][1];
                    v0[0] *= bflo(g.x); v0[1] *= bfhi(g.x); v0[2] *= bflo(g.y); v0[3] *= bfhi(g.y); v1[0] *= bflo(g.z); v1[1] *= bfhi(g.z); v1[2] *= bflo(g.w); v1[3] *= bfhi(g.w);
                    if (SECOND) { const u32x4 o = *(const u32x4*)(MG + r * 2048 + c);
                        v0[0] += bflo(o.x); v0[1] += bfhi(o.x); v0[2] += bflo(o.y); v0[3] += bfhi(o.y); v1[0] += bflo(o.z); v1[1] += bfhi(o.z); v1[2] += bflo(o.w); v1[3] += bfhi(o.w); }
                    u32x4 w; w.x = cvt_pk_bf16(v0[0], v0[1]); w.y = cvt_pk_bf16(v0[2], v0[3]); w.z = cvt_pk_bf16(v1[0], v1[1]); w.w = cvt_pk_bf16(v1[2], v1[3]);
                    *(u32x4*)(MG + r * 2048 + c) = w; } }
    }
};
struct EpiResid {
    static constexpr bool PERM = false, AFTER_DRAIN = false;
    float* out; float* hctx; const float* glat; const float* gctx;
    __device__ __forceinline__ void operator()(const f32x4 (&acc)[2][2][4][2], const Unit& u, int wr, int wc, int fr, int fq) const {
        mfma_settle(acc[1][1][3][1]); mfma_settle(acc[1][1][3][0]);
        const bool isctx = u.pm >= 64; const float* g = isctx ? gctx : glat;
        float* hb = isctx ? hctx + (size_t)(wr * 64 + fr) * D : out + (size_t)(u.pm * 256 + wr * 64 + fr) * D;
        const int col0 = u.pn * 256 + wc * 32 + 4 * fq;
        f32x4 gv[2][2];
#pragma unroll
        for (int bj = 0; bj < 2; ++bj)
#pragma unroll
            for (int n = 0; n < 2; ++n) gv[bj][n] = *(const f32x4*)(g + col0 + bj * 128 + n * 16);
#pragma unroll
        for (int ai = 0; ai < 2; ++ai)
#pragma unroll
            for (int m = 0; m < 4; ++m) { float* rowp = hb + (size_t)(ai * 128 + m * 16) * D + col0;
#pragma unroll
                for (int bj = 0; bj < 2; ++bj)
#pragma unroll
                    for (int n = 0; n < 2; ++n) { float* p = rowp + bj * 128 + n * 16; const f32x4 h = *(const f32x4*)p; *(f32x4*)p = h * ALPHA + gv[bj][n] * acc[ai][bj][m][n]; } }
    }
};
struct EpiUp {
    static constexpr bool PERM = true, AFTER_DRAIN = false;
    bf16_t* G; bf16_t* V;
    __device__ __forceinline__ void operator()(const f32x4 (&acc)[2][2][4][2], const Unit& u, int wr, int wc, int fr, int fq) const {
        mfma_settle(acc[1][1][3][1]); mfma_settle(acc[1][1][3][0]);
        const int row0 = u.pm * 256 + wr * 64 + fr; int ct = u.pn * 256; bf16_t* base = G; if (ct >= DFF) { base = V; ct -= DFF; }
        const int col0 = ct + wc * 32 + 8 * fq;
#pragma unroll
        for (int ai = 0; ai < 2; ++ai)
#pragma unroll
            for (int m = 0; m < 4; ++m) { bf16_t* rowp = base + (size_t)(row0 + ai * 128 + m * 16) * DFF + col0;
#pragma unroll
                for (int bj = 0; bj < 2; ++bj) { const f32x4 v0 = acc[ai][bj][m][0], v1 = acc[ai][bj][m][1];
                    u32x4 w; w.x = cvt_pk_bf16(v0[0], v0[1]); w.y = cvt_pk_bf16(v0[2], v0[3]); w.z = cvt_pk_bf16(v1[0], v1[1]); w.w = cvt_pk_bf16(v1[2], v1[3]);
                    *(u32x4*)(rowp + bj * 128) = w; } }
    }
};

__device__ __forceinline__ void xpose_item(const float* W, int K, int N, bf16_t* WT, int d0, int s0, int k0, float* scr, int lane) {
#pragma unroll
    for (int i = 0; i < 32; ++i) { const int kk = 2 * i + (lane >> 5); scr[kk * 33 + (lane & 31)] = s0 >= 0 ? W[(size_t)(k0 + kk) * N + s0 + (lane & 31)] : 0.f; }
    asm volatile("s_waitcnt lgkmcnt(0)" ::: "memory");
    const int c = lane & 7;
#pragma unroll
    for (int j = 0; j < 4; ++j) { const int n = (lane >> 3) + 8 * j; const float* s = scr + (8 * c) * 33 + n;
        u32x4 o; o.x = cvt_pk_bf16(s[0 * 33], s[1 * 33]); o.y = cvt_pk_bf16(s[2 * 33], s[3 * 33]); o.z = cvt_pk_bf16(s[4 * 33], s[5 * 33]); o.w = cvt_pk_bf16(s[6 * 33], s[7 * 33]);
        *(u32x4*)(WT + (size_t)(d0 + n) * K + k0 + 8 * c) = o; }
    asm volatile("s_waitcnt lgkmcnt(0)" ::: "memory");
}
__device__ __forceinline__ void xpose_region(const Args& a, int layer, int region, float* scr, int gw, int NGW, int lane) {
    if (region == 0) {
        const float* w_in = a.in[6] + (size_t)layer * 2048 * 10304; const float* w_glu = a.in[15] + (size_t)layer * 1024 * 2048; const float* w_s5p = a.in[16] + (size_t)layer * 1024 * 2048;
        const float* w_ssdp = a.in[23] + (size_t)layer * 2048 * 2048; const float* w_out = a.in[24] + (size_t)layer * 2048 * 2048;
        bf16_t* WA = (bf16_t*)(a.ws + WS_WA);
        constexpr int I_IN = 32 * 328, I_GLU = 16 * 64, I_S5P = 16 * 64, I_SSDP = 32 * 64, I_WOUT = 32 * 64, NI = I_IN + I_GLU + I_S5P + I_SSDP + I_WOUT;
        for (int it = gw; it < NI; it += NGW) { int r = it;
            if (r < I_IN) { const int kb = r / 328, d0 = (r % 328) * 32; int s0; if (d0 < 4096) s0 = d0; else if (d0 < 10240) s0 = d0 + 64; else if (d0 < 10304) s0 = d0 - 10240 + 4096; else s0 = -1;
                xpose_item(w_in, 2048, 10304, WA + WA_IN / 2, d0, s0, kb * 64, scr, lane); continue; } r -= I_IN;
            if (r < I_GLU) { const int kb = r / 64, d0 = (r % 64) * 32, t = d0 >> 8, j = d0 & 255; const int s0 = j < 128 ? t * 128 + j : 1024 + t * 128 + (j - 128);
                xpose_item(w_glu, 1024, 2048, WA + WA_GLU / 2, d0, s0, kb * 64, scr, lane); continue; } r -= I_GLU;
            if (r < I_S5P) { const int kb = r / 64, d0 = (r % 64) * 32; xpose_item(w_s5p, 1024, 2048, WA + WA_S5P / 2, d0, d0, kb * 64, scr, lane); continue; } r -= I_S5P;
            if (r < I_SSDP) { const int kb = r / 64, d0 = (r % 64) * 32; xpose_item(w_ssdp, 2048, 2048, WA + WA_SSDP / 2, d0, d0, kb * 64, scr, lane); continue; } r -= I_SSDP;
            { const int kb = r / 64, d0 = (r % 64) * 32; xpose_item(w_out, 2048, 2048, WA + WA_WOUT / 2, d0, d0, kb * 64, scr, lane); }
        }
    } else {
        const float* w_up = a.in[27] + (size_t)layer * 2048 * 11264; const float* w_down = a.in[30] + (size_t)layer * 5632 * 2048;
        bf16_t* WB = (bf16_t*)(a.ws + WS_WB);
        constexpr int I_UP = 32 * 352, I_DOWN = 88 * 64, NI = I_UP + I_DOWN;
        for (int it = gw; it < NI; it += NGW) { int r = it;
            if (r < I_UP) { const int kb = r / 352, d0 = (r % 352) * 32; xpose_item(w_up, 2048, 11264, WB + WB_UP / 2, d0, d0, kb * 64, scr, lane); continue; } r -= I_UP;
            { const int kb = r / 64, d0 = (r % 64) * 32; xpose_item(w_down, 5632, 2048, WB + WB_DOWN / 2, d0, d0, kb * 64, scr, lane); }
        }
    }
}

__device__ __forceinline__ void adaln_phase(const Args& a, float* lds, int tid) {
    float* sc = lds; float* scx = lds + 2048; float* red = lds + 4096;
    for (int i = tid; i < 2048; i += 512) { sc[i] = silu_(a.in[1][i]); scx[i] = silu_(a.in[3][i]); }
    __syncthreads();
    for (int unit = blockIdx.x; unit < 256; unit += gridDim.x) {
        const int layer = unit >> 7, col0 = (unit & 127) * 96;
        const float* W = a.in[4] + (size_t)layer * 2048 * 12288 + col0;
        if (tid < 504) { const int cq = tid % 24, ks = tid / 24; f32x4 al = {0.f, 0.f, 0.f, 0.f}, ac = {0.f, 0.f, 0.f, 0.f};
#pragma unroll 7
            for (int k = ks; k < 2048; k += 21) { const f32x4 w = *(const f32x4*)(W + (size_t)k * 12288 + cq * 4); al += w * sc[k]; ac += w * scx[k]; }
            *(f32x4*)(red + (ks * 2 + 0) * 96 + cq * 4) = al; *(f32x4*)(red + (ks * 2 + 1) * 96 + cq * 4) = ac; }
        __syncthreads();
        if (tid < 192) { const int v = tid / 96, c = tid % 96; float s = 0.f; for (int ks = 0; ks < 21; ++ks) s += red[(ks * 2 + v) * 96 + c];
            ((float*)(a.ws + WS_MVEC))[(size_t)(layer * 2 + v) * 12288 + col0 + c] = s + a.in[5][(size_t)layer * 12288 + col0 + c]; }
        __syncthreads();
    }
}

__device__ __forceinline__ float wave_sum(float v) {
#pragma unroll
    for (int o = 1; o < 64; o <<= 1) v += __shfl_xor(v, o);
    return v;
}
template <int MODE> __device__ __forceinline__ void row_phase(const Args& a, int nrows, const float* lng, const float* lnb, int mod_layer, int mod_off, int gw, int NGW, int lane) {
    bf16_t* XM = (bf16_t*)(a.ws + WS_XM);
    for (int row = gw; row < nrows; row += NGW) {
        const int isctx = row >= TL; float* h = hrow(a, row);
        const float* src = MODE == 0 ? (isctx ? a.in[2] + (size_t)(row - TL) * D : a.in[0] + (size_t)row * D) : h;
        f32x4 v[8];
#pragma unroll
        for (int j = 0; j < 8; ++j) v[j] = *(const f32x4*)(src + 4 * lane + 256 * j);
        if (MODE == 1) {
            float s = 0.f;
#pragma unroll
            for (int j = 0; j < 8; ++j) s += (v[j][0] + v[j][1]) + (v[j][2] + v[j][3]);
            const float mean = wave_sum(s) * (1.f / D); float q = 0.f;
#pragma unroll
            for (int j = 0; j < 8; ++j) { v[j] = v[j] - mean; q += (v[j][0] * v[j][0] + v[j][1] * v[j][1]) + (v[j][2] * v[j][2] + v[j][3] * v[j][3]); }
            const float rstd = 1.f / sqrtf(wave_sum(q) * (1.f / D) + LN_EPS);
#pragma unroll
            for (int j = 0; j < 8; ++j) { const f32x4 g = *(const f32x4*)(lng + 4 * lane + 256 * j), b = *(const f32x4*)(lnb + 4 * lane + 256 * j); v[j] = v[j] * rstd * g + b; }
        }
#ifdef MK_SANITIZE
#pragma unroll
        for (int j = 0; j < 8; ++j)
#pragma unroll
            for (int e = 0; e < 4; ++e) if (!(fabsf(v[j][e]) < 1e30f)) v[j][e] = 0.f;
#endif
#pragma unroll
        for (int j = 0; j < 8; ++j) *(f32x4*)(h + 4 * lane + 256 * j) = v[j];
        if (mod_layer >= 0) { const float* m = mvec(a, mod_layer, isctx) + mod_off;
#pragma unroll
            for (int j = 0; j < 8; ++j) { const f32x4 sh = *(const f32x4*)(m + 4 * lane + 256 * j), scl = *(const f32x4*)(m + D + 4 * lane + 256 * j); const f32x4 o = v[j] * (scl + 1.f) + sh;
                u32x2 w; w.x = cvt_pk_bf16(o[0], o[1]); w.y = cvt_pk_bf16(o[2], o[3]); *(u32x2*)(XM + (size_t)row * D + 4 * lane + 256 * j) = w; } }
    }
}

__device__ __forceinline__ void ffnconv_phase(const Args& a, int layer, bool with_ctx, int tid) {
    const bf16_t* G = (const bf16_t*)(a.ws + WS_BIG + B_G); bf16_t* V = (bf16_t*)(a.ws + WS_BIG + B_V);
    const float* cw = a.in[28] + (size_t)layer * 9 * DFF; const float* cb = a.in[29] + (size_t)layer * DFF;
    const int nunits = (with_ctx ? 260 : 256) * 11; const int oc = tid & 63, xs = tid >> 6;
    for (int unit = blockIdx.x; unit < nunits; unit += gridDim.x) {
        const int seg = unit / 11, ob = unit % 11, ch0 = ob * 512 + oc * 8; const bool cs = seg >= 256; const int t0 = seg * 64;
        float w[9][8], bias[8];
#pragma unroll
        for (int k = 0; k < 9; ++k) { const f32x4 w0 = *(const f32x4*)(cw + (size_t)k * DFF + ch0), w1 = *(const f32x4*)(cw + (size_t)k * DFF + ch0 + 4);
            w[k][0] = w0[0]; w[k][1] = w0[1]; w[k][2] = w0[2]; w[k][3] = w0[3]; w[k][4] = w1[0]; w[k][5] = w1[1]; w[k][6] = w1[2]; w[k][7] = w1[3]; }
        { const f32x4 b0 = *(const f32x4*)(cb + ch0), b1 = *(const f32x4*)(cb + ch0 + 4); bias[0] = b0[0]; bias[1] = b0[1]; bias[2] = b0[2]; bias[3] = b0[3]; bias[4] = b1[0]; bias[5] = b1[1]; bias[6] = b1[2]; bias[7] = b1[3]; }
#pragma unroll 4
        for (int xi = 0; xi < 8; ++xi) { const int x = xs * 8 + xi, t = t0 + x; float acc[8];
#pragma unroll
            for (int k = 0; k < 8; ++k) acc[k] = bias[k];
#pragma unroll
            for (int dy = -1; dy <= 1; ++dy) { bool rok = cs ? (dy == 0) : ((dy < 0 ? seg > 0 : true) && (dy > 0 ? seg < 255 : true));
#pragma unroll
                for (int dx = -1; dx <= 1; ++dx) { const bool ok = rok && (cs ? (t + dx >= TL && t + dx < MT) : (x + dx >= 0 && x + dx < 64));
                    if (ok) { const u32x4 g = *(const u32x4*)(G + (size_t)(t + dy * 64 + dx) * DFF + ch0); const int k = (dy + 1) * 3 + dx + 1;
                        acc[0] += w[k][0] * bflo(g.x); acc[1] += w[k][1] * bfhi(g.x); acc[2] += w[k][2] * bflo(g.y); acc[3] += w[k][3] * bfhi(g.y);
                        acc[4] += w[k][4] * bflo(g.z); acc[5] += w[k][5] * bfhi(g.z); acc[6] += w[k][6] * bflo(g.w); acc[7] += w[k][7] * bfhi(g.w); } } }
            bf16_t* vp = V + (size_t)t * DFF + ch0; const u32x4 vv = *(const u32x4*)vp;
            u32x4 o; o.x = cvt_pk_bf16(silu_(acc[0]) * bflo(vv.x), silu_(acc[1]) * bfhi(vv.x)); o.y = cvt_pk_bf16(silu_(acc[2]) * bflo(vv.y), silu_(acc[3]) * bfhi(vv.y));
            o.z = cvt_pk_bf16(silu_(acc[4]) * bflo(vv.z), silu_(acc[5]) * bfhi(vv.z)); o.w = cvt_pk_bf16(silu_(acc[6]) * bflo(vv.w), silu_(acc[7]) * bfhi(vv.w));
            *(u32x4*)vp = o; }
    }
}

__device__ __forceinline__ int s5_chunk_at(int dir, int q) { return dir ? 129 - q : (q + 128) % 130; }
__device__ __forceinline__ int s5_pos_of(int dir, int c) { return dir ? 129 - c : (c + 2) % 130; }
template <int PASS> __device__ __forceinline__ void s5_phase(const Args& a, int layer, unsigned char* lds, int tid, int nchunks) {
    constexpr int BUP = 132;
    const bf16_t* U5 = (const bf16_t*)(a.ws + WS_BIG + B_U5); bf16_t* Y5 = (bf16_t*)(a.ws + WS_BIG + B_Y5);
    float2* S5LOC = (float2*)(a.ws + WS_S5LOC);
    const int lane = tid & 63, w = tid >> 6, gl = w >> 1, dir = w & 1, p = lane, fr = lane & 15, fq = lane >> 4;
    float* BuW = (float*)lds + (size_t)w * (16 * BUP);
    bf16_t* STw = (bf16_t*)(lds + 67584) + (size_t)w * (16 * 136);
    float* YL = (float*)(lds + 102400);
    const int gq = blockIdx.x & 15, g = gq * 4 + gl;
    float ab_re, ab_im, a128r, a128i;
    const float step = expf(a.in[9][(size_t)(layer * 2 + dir) * 64 + g]);
    { const size_t pi = ((size_t)(layer * 2 + dir) * 64 + g) * 64 + p; const float lre = fminf(a.in[7][pi], -1e-4f), lim = a.in[8][pi];
      const float mag = expf(lre * step); float sn, cs; sincosf(lim * step, &sn, &cs); ab_re = mag * cs; ab_im = mag * sn; a128r = ab_re; a128i = ab_im;
#pragma unroll
      for (int k = 0; k < 7; ++k) { const float r = a128r * a128r - a128i * a128i, i = 2.f * a128r * a128i; a128r = r; a128i = i; } }
    bf16x8 bbf[8];
#pragma unroll
    for (int nt = 0; nt < 8; ++nt) { const int pp = nt * 8 + (fr >> 1), cc = fr & 1; const size_t pi = ((size_t)(layer * 2 + dir) * 64 + g) * 64 + pp;
        const float lre = fminf(a.in[7][pi], -1e-4f), lim = a.in[8][pi]; const float mag = expf(lre * step); float sn, cs; sincosf(lim * step, &sn, &cs);
        const float are = mag * cs, aim = mag * sn, den = lre * lre + lim * lim, q_re = ((are - 1.f) * lre + aim * lim) / den, q_im = (aim * lre - (are - 1.f) * lim) / den;
        const float* br = a.in[10] + (((size_t)layer * 64 + g) * 64 + pp) * 16 + (fq & 1) * 8; const float* bi = a.in[11] + (((size_t)layer * 64 + g) * 64 + pp) * 16 + (fq & 1) * 8;
        const f32x4 r0 = *(const f32x4*)br, r1 = *(const f32x4*)(br + 4), i0 = *(const f32x4*)bi, i1 = *(const f32x4*)(bi + 4); float v[8];
#pragma unroll
        for (int j = 0; j < 8; ++j) { const float r = j < 4 ? r0[j & 3] : r1[j & 3], i = j < 4 ? i0[j & 3] : i1[j & 3]; v[j] = fq < 2 ? (cc ? q_re * i + q_im * r : q_re * r - q_im * i) : 0.f; }
        bbf[nt] = mkfrag(cvt_pk_bf16(v[0], v[1]), cvt_pk_bf16(v[2], v[3]), cvt_pk_bf16(v[4], v[5]), cvt_pk_bf16(v[6], v[7])); }
    bf16x8 cm[4];
    if (PASS == 1) {
        const float* cre = a.in[12] + (((size_t)(layer * 2 + dir) * 64 + g) * 16 + fr) * 64; const float* cim = a.in[13] + (((size_t)(layer * 2 + dir) * 64 + g) * 16 + fr) * 64;
#pragma unroll
        for (int ks = 0; ks < 4; ++ks) { const f32x4 r = *(const f32x4*)(cre + ks * 16 + fq * 4), i = *(const f32x4*)(cim + ks * 16 + fq * 4);
            cm[ks] = mkfrag(cvt_pk_bf16(r[0], -i[0]), cvt_pk_bf16(r[1], -i[1]), cvt_pk_bf16(r[2], -i[2]), cvt_pk_bf16(r[3], -i[3])); }
    }
    const int cstep = gridDim.x >> 4;
    for (int c = blockIdx.x >> 4; c < nchunks; c += cstep) {
        const int row0 = c * 128;
        bf16x8 uf[8];
#pragma unroll
        for (int k = 0; k < 8; ++k) { const int sl = dir ? 7 - k : k; const u32x4 v = *(const u32x4*)(U5 + (size_t)(row0 + sl * 16 + fr) * 1024 + g * 16 + (fq & 1) * 8);
            uf[k] = fq < 2 ? __builtin_bit_cast(bf16x8, v) : mkfrag(0u, 0u, 0u, 0u); }
        float sr = 0.f, si = 0.f;
        if (PASS == 1) {
            const int pos = s5_pos_of(dir, c);
#pragma unroll 1
            for (int q0 = 0; q0 < pos; q0 += 13) { float2 l[13];
#pragma unroll
                for (int i = 0; i < 13; ++i) { const int q = q0 + i < pos ? q0 + i : pos - 1; l[i] = S5LOC[((size_t)(dir * NCH + s5_chunk_at(dir, q)) * 64 + g) * 64 + p]; }
#pragma unroll
                for (int i = 0; i < 13; ++i) if (q0 + i < pos) { const float nr = a128r * sr - a128i * si + l[i].x, ni = a128r * si + a128i * sr + l[i].y; sr = nr; si = ni; } }
        }
        f32x4 yacc[8];
#pragma unroll
        for (int k = 0; k < 8; ++k) {
#pragma unroll
            for (int nt = 0; nt < 8; ++nt) { f32x4 acc = {0.f, 0.f, 0.f, 0.f}; acc = __builtin_amdgcn_mfma_f32_16x16x32_bf16(uf[k], bbf[nt], acc, 0, 0, 0);
#pragma unroll
                for (int jj = 0; jj < 4; ++jj) BuW[(fq * 4 + jj) * BUP + nt * 16 + fr] = acc[jj]; }
            asm volatile("s_waitcnt lgkmcnt(0)" ::: "memory");
#pragma unroll
            for (int ii = 0; ii < 16; ++ii) { const int tl = dir ? 15 - ii : ii; const f32x2 b2 = *(const f32x2*)(BuW + tl * BUP + 2 * p);
                f32x2 ns = __builtin_elementwise_fma((f32x2){ab_re, ab_re}, (f32x2){sr, si}, b2); ns = __builtin_elementwise_fma((f32x2){-ab_im, ab_im}, (f32x2){si, sr}, ns); sr = ns[0]; si = ns[1];
                if (PASS == 1) *(unsigned*)(STw + tl * 136 + 2 * p) = cvt_pk_bf16(sr, si); }
            if (PASS == 1) {
                asm volatile("s_waitcnt lgkmcnt(0)" ::: "memory");
                f32x4 acc = {0.f, 0.f, 0.f, 0.f};
#pragma unroll
                for (int ks = 0; ks < 4; ++ks) acc = __builtin_amdgcn_mfma_f32_16x16x32_bf16(*(const bf16x8*)(STw + fr * 136 + ks * 32 + fq * 8), cm[ks], acc, 0, 0, 0);
                yacc[k] = acc;
            }
            asm volatile("s_waitcnt lgkmcnt(0)" ::: "memory");
        }
        if (PASS == 0) { S5LOC[((size_t)(dir * NCH + c) * 64 + g) * 64 + p] = make_float2(sr, si); }
        else {
            __syncthreads();
            if (dir == 0) {
#pragma unroll
                for (int k = 0; k < 8; ++k)
#pragma unroll
                    for (int jj = 0; jj < 4; ++jj) YL[gl * 2048 + (k * 16 + fq * 4 + jj) * 16 + fr] = yacc[k][jj]; }
            __syncthreads();
            if (dir == 1) {
#pragma unroll
                for (int k = 0; k < 8; ++k)
#pragma unroll
                    for (int jj = 0; jj < 4; ++jj) YL[gl * 2048 + ((7 - k) * 16 + fq * 4 + jj) * 16 + fr] += yacc[k][jj]; }
            __syncthreads();
            const int t = tid >> 2, q = tid & 3; const float* y = YL + q * 2048 + t * 16; const float* dd = a.in[14] + (size_t)layer * 1024 + gq * 64 + q * 16;
            const bf16_t* us = U5 + (size_t)(row0 + t) * 1024 + gq * 64 + q * 16; const u32x4 u0 = *(const u32x4*)us, u1 = *(const u32x4*)(us + 8);
            const float u[16] = {bflo(u0.x), bfhi(u0.x), bflo(u0.y), bfhi(u0.y), bflo(u0.z), bfhi(u0.z), bflo(u0.w), bfhi(u0.w), bflo(u1.x), bfhi(u1.x), bflo(u1.y), bfhi(u1.y), bflo(u1.z), bfhi(u1.z), bflo(u1.w), bfhi(u1.w)};
            unsigned o[8];
#pragma unroll
            for (int j = 0; j < 8; ++j) { const float y0 = y[2 * j] + u[2 * j] * dd[2 * j], y1 = y[2 * j + 1] + u[2 * j + 1] * dd[2 * j + 1]; o[j] = cvt_pk_bf16(gelu_tanh(y0), gelu_tanh(y1)); }
            bf16_t* dst = Y5 + (size_t)(row0 + t) * 1024 + gq * 64 + q * 16; u32x4 o0, o1; o0.x = o[0]; o0.y = o[1]; o0.z = o[2]; o0.w = o[3]; o1.x = o[4]; o1.y = o[5]; o1.z = o[6]; o1.w = o[7];
            *(u32x4*)dst = o0; *(u32x4*)(dst + 8) = o1;
        }
    }
    __syncthreads();
}

__device__ __forceinline__ int ssd_chunk_at(int dir, int q) { return s5_chunk_at(dir, q); }
__device__ __forceinline__ void conv8(const bf16_t* XBC, int rowbase, int l0, int ch, bool lo_ok, bool hi_ok, float w0, float w1, float w2, float b, float (&out)[8]) {
    float r[10];
#pragma unroll
    for (int i = 0; i < 10; ++i) { const int l = l0 - 1 + i; const bool ok = (l >= 0 || lo_ok) && (l < 128 || hi_ok); r[i] = ok ? bf2f((unsigned)XBC[(size_t)(rowbase + l) * 3072 + ch]) : 0.f; }
#pragma unroll
    for (int j = 0; j < 8; ++j) out[j] = silu_(w0 * r[j] + w1 * r[j + 1] + w2 * r[j + 2] + b);
}
__device__ __forceinline__ void stage_conv_tile(const bf16_t* XBC, const float* cw, const float* cb, int rowbase, int chbase, bool lo_ok, bool hi_ok, bf16_t* dst, int tid) {
    const int oc = tid & 15, ch = chbase + oc * 8; float w[3][8], b[8];
#pragma unroll
    for (int k = 0; k < 3; ++k) { const f32x4 a0 = *(const f32x4*)(cw + (size_t)k * 3072 + ch), a1 = *(const f32x4*)(cw + (size_t)k * 3072 + ch + 4);
        w[k][0] = a0[0]; w[k][1] = a0[1]; w[k][2] = a0[2]; w[k][3] = a0[3]; w[k][4] = a1[0]; w[k][5] = a1[1]; w[k][6] = a1[2]; w[k][7] = a1[3]; }
    { const f32x4 a0 = *(const f32x4*)(cb + ch), a1 = *(const f32x4*)(cb + ch + 4); b[0] = a0[0]; b[1] = a0[1]; b[2] = a0[2]; b[3] = a0[3]; b[4] = a1[0]; b[5] = a1[1]; b[6] = a1[2]; b[7] = a1[3]; }
#pragma unroll
    for (int i = 0; i < 4; ++i) { const int row = (tid >> 4) + i * 32; float acc[8];
#pragma unroll
        for (int k = 0; k < 8; ++k) acc[k] = b[k];
#pragma unroll
        for (int d = 0; d < 3; ++d) { const bool ok = d == 1 ? true : (d == 0 ? (row > 0 || lo_ok) : (row < 127 || hi_ok)); const int l = ok ? row + d - 1 : row;
            { u32x4 g = *(const u32x4*)(XBC + (size_t)(rowbase + l) * 3072 + ch); if (!ok) g = (u32x4){0u, 0u, 0u, 0u};
                acc[0] += w[d][0] * bflo(g.x); acc[1] += w[d][1] * bfhi(g.x); acc[2] += w[d][2] * bflo(g.y); acc[3] += w[d][3] * bfhi(g.y);
                acc[4] += w[d][4] * bflo(g.z); acc[5] += w[d][5] * bfhi(g.z); acc[6] += w[d][6] * bflo(g.w); acc[7] += w[d][7] * bfhi(g.w); } }
        u32x4 o; o.x = cvt_pk_bf16(silu_(acc[0]), silu_(acc[1])); o.y = cvt_pk_bf16(silu_(acc[2]), silu_(acc[3])); o.z = cvt_pk_bf16(silu_(acc[4]), silu_(acc[5])); o.w = cvt_pk_bf16(silu_(acc[6]), silu_(acc[7]));
        *(u32x4*)(dst + row * 136 + oc * 8) = o; }
}
constexpr int SL_CS = 0, SL_CB = 34816, SL_CUM = 69632, SL_DT = 77824, SL_PART = 86016, SL_BS = 94208, SL_XT = 94208;
template <int AUX> __device__ __forceinline__ void ssd_cum(const Args& a, int layer, int c, int h, int w, int lane, unsigned char* lds) {
    const float* DT = (const float*)(a.ws + WS_BIG + B_DT); float* cumL = (float*)(lds + SL_CUM); float* dtL = (float*)(lds + SL_DT); float* CHD = (float*)(a.ws + WS_CHD);
#pragma unroll
    for (int dir = 0; dir < 2; ++dir) {
        const float ah = -expf(a.in[20][(size_t)(layer * 2 + dir) * 32 + h]);
        const float d0 = DT[(size_t)(c * 128 + 2 * lane) * 64 + dir * 32 + h], d1 = DT[(size_t)(c * 128 + 2 * lane + 1) * 64 + dir * 32 + h];
        const float l0 = d0 * ah, l1 = d1 * ah, s = l0 + l1; float incl = s;
#pragma unroll
        for (int o = 1; o < 64; o <<= 1) { const float t = __shfl_up(incl, o); if (lane >= o) incl += t; }
        const float excl = incl - s, tot = __shfl(incl, 63);
        float c0, c1;
        if (dir == 0) { c0 = excl + l0; c1 = incl; } else { c0 = tot - excl; c1 = tot - (excl + l0); }
        float* cu = cumL + (dir * 8 + w) * 128 + 2 * lane; cu[0] = c0; cu[1] = c1;
        float* dd = dtL + (dir * 8 + w) * 128 + 2 * lane;
        if (AUX == 0) { dd[0] = d0; dd[1] = d1; } else { dd[0] = d0 * __expf(tot - c0); dd[1] = d1 * __expf(tot - c1); if (lane == 0) CHD[(size_t)(dir * NCH + c) * 32 + h] = tot; }
    }
}
__device__ __forceinline__ void stage_T(const bf16_t* XBC, const float* cw, const float* cb, int rowbase, int ch, int r0, bool lo_ok, bool hi_ok, bf16_t* dstT) {
    float w[3][8], b[8];
#pragma unroll
    for (int k = 0; k < 3; ++k) { const f32x4 a0 = *(const f32x4*)(cw + (size_t)k * 3072 + ch), a1 = *(const f32x4*)(cw + (size_t)k * 3072 + ch + 4);
        w[k][0] = a0[0]; w[k][1] = a0[1]; w[k][2] = a0[2]; w[k][3] = a0[3]; w[k][4] = a1[0]; w[k][5] = a1[1]; w[k][6] = a1[2]; w[k][7] = a1[3]; }
    { const f32x4 a0 = *(const f32x4*)(cb + ch), a1 = *(const f32x4*)(cb + ch + 4); b[0] = a0[0]; b[1] = a0[1]; b[2] = a0[2]; b[3] = a0[3]; b[4] = a1[0]; b[5] = a1[1]; b[6] = a1[2]; b[7] = a1[3]; }
    u32x4 raw[10];
    const bf16_t* base = XBC + (size_t)(rowbase + r0) * 3072 + ch;
    const bool ok0 = r0 > 0 || lo_ok, ok9 = r0 < 120 || hi_ok;
#pragma unroll
    for (int i = 1; i < 9; ++i) raw[i] = *(const u32x4*)(base + (i - 1) * 3072);
    { const u32x4 v = *(const u32x4*)(base + (ok0 ? -3072 : 0)); raw[0] = ok0 ? v : (u32x4){0u, 0u, 0u, 0u}; }
    { const u32x4 v = *(const u32x4*)(base + (ok9 ? 8 * 3072 : 7 * 3072)); raw[9] = ok9 ? v : (u32x4){0u, 0u, 0u, 0u}; }
    float sp[8]; unsigned o[8][4];
#pragma unroll
    for (int r = 0; r < 8; ++r) { float sv[8];
#pragma unroll
        for (int k = 0; k < 8; ++k) { float acc = b[k];
#pragma unroll
            for (int d = 0; d < 3; ++d) { const unsigned wd = k < 2 ? raw[r + d].x : (k < 4 ? raw[r + d].y : (k < 6 ? raw[r + d].z : raw[r + d].w)); acc += w[d][k] * ((k & 1) ? bfhi(wd) : bflo(wd)); }
            sv[k] = silu_(acc); }
        if (r & 1) {
#pragma unroll
            for (int k = 0; k < 8; ++k) o[k][r >> 1] = cvt_pk_bf16(sp[k], sv[k]); }
        else {
#pragma unroll
            for (int k = 0; k < 8; ++k) sp[k] = sv[k]; } }
#pragma unroll
    for (int k = 0; k < 8; ++k) { u32x4 v; v.x = o[k][0]; v.y = o[k][1]; v.z = o[k][2]; v.w = o[k][3]; *(u32x4*)(dstT + k * 136 + r0) = v; }
}
__device__ __forceinline__ void ssd_a_phase(const Args& a, int layer, unsigned char* lds, int tid) {
    const bf16_t* XBC = (const bf16_t*)(a.ws + WS_BIG + B_XBC); bf16_t* SST = (bf16_t*)(a.ws + WS_SST);
    const float* cw = a.in[17] + (size_t)layer * 3 * 3072; const float* cb = a.in[18] + (size_t)layer * 3072;
    bf16_t* BT = (bf16_t*)(lds + SL_CS); bf16_t* xT = (bf16_t*)(lds + SL_XT); const float* wL = (const float*)(lds + SL_DT);
    for (int unit = blockIdx.x; unit < NCH * 4; unit += gridDim.x) {
        int tl = tid; asm volatile("" : "+v"(tl));
        const int lane = tl & 63, w = __builtin_amdgcn_readfirstlane(tl >> 6), fr = lane & 15, fq = lane >> 4, og = lane & 7, rr = lane >> 3;
        const int c = unit >> 2, g = unit & 3, rowbase = c * 128; const bool lo_ok = !(c == 0 || c == 128), hi_ok = !(c == 127 || c == 129);
        __syncthreads();
        if (w < 4) { const int oct = (w & 1) * 8 + og; stage_T(XBC, cw, cb, rowbase, 2048 + g * 128 + oct * 8, ((w >> 1) * 8 + rr) * 8, lo_ok, hi_ok, BT + (oct * 8) * 136); }
        ssd_cum<1>(a, layer, c, g * 8 + w, w, lane, lds);
#pragma unroll 1
        for (int pass = 0; pass < 2; ++pass) {
            if (pass) __syncthreads();
            { const int hs = w & 3; stage_T(XBC, cw, cb, rowbase, (g * 8 + pass * 4 + hs) * 64 + og * 8, ((w >> 2) * 8 + rr) * 8, lo_ok, hi_ok, xT + ((hs * 64 + og * 8) * 136)); }
            __syncthreads();
            const int hl = w >> 1, dir = w & 1, hh = pass * 4 + hl, h = g * 8 + hh;
            bf16_t* sb = SST + (((size_t)(dir * NCH + c) * 32 + h) * 64) * 128;
#pragma unroll 1
            for (int nh = 0; nh < 2; ++nh) {
                f32x4 acc[4][4];
#pragma unroll
                for (int pt = 0; pt < 4; ++pt)
#pragma unroll
                    for (int nt = 0; nt < 4; ++nt) acc[pt][nt] = (f32x4){0.f, 0.f, 0.f, 0.f};
#pragma unroll
                for (int ks = 0; ks < 4; ++ks) {
                    const float* wp = wL + (dir * 8 + hh) * 128 + ks * 32 + fq * 8; const f32x4 wl0 = *(const f32x4*)wp, wl1 = *(const f32x4*)(wp + 4);
                    bf16x8 yf[4];
#pragma unroll
                    for (int pt = 0; pt < 4; ++pt) { const u32x4 xr = *(const u32x4*)(xT + ((hl * 64 + pt * 16 + fr) * 136 + ks * 32 + fq * 8));
                        yf[pt] = mkfrag(cvt_pk_bf16(bflo(xr.x) * wl0[0], bfhi(xr.x) * wl0[1]), cvt_pk_bf16(bflo(xr.y) * wl0[2], bfhi(xr.y) * wl0[3]), cvt_pk_bf16(bflo(xr.z) * wl1[0], bfhi(xr.z) * wl1[1]), cvt_pk_bf16(bflo(xr.w) * wl1[2], bfhi(xr.w) * wl1[3])); }
#pragma unroll
                    for (int nt = 0; nt < 4; ++nt) { const bf16x8 xf = *(const bf16x8*)(BT + ((nh * 4 + nt) * 16 + fr) * 136 + ks * 32 + fq * 8);
#pragma unroll
                        for (int pt = 0; pt < 4; ++pt) acc[pt][nt] = __builtin_amdgcn_mfma_f32_16x16x32_bf16(xf, yf[pt], acc[pt][nt], 0, 0, 0); }
                }
#pragma unroll
                for (int pt = 0; pt < 4; ++pt) mfma_settle(acc[pt][3]);
#pragma unroll
                for (int pt = 0; pt < 4; ++pt)
#pragma unroll
                    for (int nt = 0; nt < 4; ++nt) { u32x2 o; o.x = cvt_pk_native(acc[pt][nt][0], acc[pt][nt][1]); o.y = cvt_pk_native(acc[pt][nt][2], acc[pt][nt][3]);
                        *(u32x2*)(sb + (size_t)(pt * 16 + fr) * 128 + (nh * 4 + nt) * 16 + fq * 4) = o; }
            }
        }
    }
    __syncthreads();
}
__device__ __forceinline__ void ssd_b_phase(const Args& a, int tid) {
    bf16_t* SST = (bf16_t*)(a.ws + WS_SST); const float* CHD = (const float*)(a.ws + WS_CHD);
    for (int idx = blockIdx.x * 512 + tid; idx < 64 * 2048; idx += gridDim.x * 512) {
        const int e4 = idx & 2047, hd = idx >> 11, dir = hd >> 5, h = hd & 31; float s0 = 0.f, s1 = 0.f, s2 = 0.f, s3 = 0.f;
#pragma unroll 1
        for (int b = 0; b < 13; ++b) { u32x2 loc[10]; float dc[10];
#pragma unroll
            for (int i = 0; i < 10; ++i) { const int cq = ssd_chunk_at(dir, b * 10 + i); loc[i] = *(const u32x2*)(SST + ((size_t)(dir * NCH + cq) * 32 + h) * 8192 + e4 * 4); dc[i] = CHD[(size_t)(dir * NCH + cq) * 32 + h]; }
#pragma unroll
            for (int i = 0; i < 10; ++i) { const int cq = ssd_chunk_at(dir, b * 10 + i); u32x2 o; o.x = cvt_pk_bf16(s0, s1); o.y = cvt_pk_bf16(s2, s3);
                *(u32x2*)(SST + ((size_t)(dir * NCH + cq) * 32 + h) * 8192 + e4 * 4) = o; const float e = __expf(dc[i]);
                s0 = e * s0 + bflo(loc[i].x); s1 = e * s1 + bfhi(loc[i].x); s2 = e * s2 + bflo(loc[i].y); s3 = e * s3 + bfhi(loc[i].y); }
        }
    }
}
__device__ __forceinline__ void ssd_c_phase(const Args& a, int layer, unsigned char* lds, int tid, int nchunks) {
    const bf16_t* XBC = (const bf16_t*)(a.ws + WS_BIG + B_XBC); const bf16_t* SST = (const bf16_t*)(a.ws + WS_SST); const bf16_t* Z = (const bf16_t*)(a.ws + WS_BIG + B_Z); bf16_t* YD = (bf16_t*)(a.ws + WS_BIG + B_YD);
    const float* cw = a.in[17] + (size_t)layer * 3 * 3072; const float* cb = a.in[18] + (size_t)layer * 3072; const float* normw = a.in[22] + (size_t)layer * 2048;
    bf16_t* Cs = (bf16_t*)(lds + SL_CS); bf16_t* Bs = (bf16_t*)(lds + SL_BS); bf16_t* CBs = (bf16_t*)(lds + SL_CB); bf16_t* xT = (bf16_t*)(lds + SL_XT);
    const float* cumL = (const float*)(lds + SL_CUM); const float* dtL = (const float*)(lds + SL_DT); float* part = (float*)(lds + SL_PART);
    for (int unit = blockIdx.x; unit < nchunks * 4; unit += gridDim.x) {
        int tl = tid; asm volatile("" : "+v"(tl));
        const int lane = tl & 63, w = __builtin_amdgcn_readfirstlane(tl >> 6), fr = lane & 15, fq = lane >> 4, og = lane & 7, rr = lane >> 3;
        const int hl = w & 3, lh = w >> 2;
        const int c = unit >> 2, g = unit & 3, rowbase = c * 128; const bool lo_ok = !(c == 0 || c == 128), hi_ok = !(c == 127 || c == 129);
        __syncthreads();
        stage_conv_tile(XBC, cw, cb, rowbase, 2560 + g * 128, lo_ok, hi_ok, Cs, tl);
        stage_conv_tile(XBC, cw, cb, rowbase, 2048 + g * 128, lo_ok, hi_ok, Bs, tl);
        ssd_cum<0>(a, layer, c, g * 8 + w, w, lane, lds);
        __syncthreads();
#pragma unroll 1
        for (int st = 0; st < 8; ++st) { f32x4 acc = {0.f, 0.f, 0.f, 0.f};
#pragma unroll
            for (int ks = 0; ks < 4; ++ks) { const bf16x8 xf = *(const bf16x8*)(Bs + (st * 16 + fr) * 136 + ks * 32 + fq * 8), yf = *(const bf16x8*)(Cs + (w * 16 + fr) * 136 + ks * 32 + fq * 8);
                acc = __builtin_amdgcn_mfma_f32_16x16x32_bf16(xf, yf, acc, 0, 0, 0); }
            mfma_settle(acc);
            u32x2 o; o.x = cvt_pk_native(acc[0], acc[1]); o.y = cvt_pk_native(acc[2], acc[3]); *(u32x2*)(CBs + (w * 16 + fr) * 136 + st * 16 + fq * 4) = o; }
#pragma unroll 1
        for (int pass = 0; pass < 2; ++pass) {
            __syncthreads();
            stage_T(XBC, cw, cb, rowbase, (g * 8 + pass * 4 + hl) * 64 + og * 8, (lh * 8 + rr) * 8, lo_ok, hi_ok, xT + ((hl * 64 + og * 8) * 136));
            __syncthreads();
            const int hh = pass * 4 + hl, h = g * 8 + hh; const float Dh = a.in[21][(size_t)layer * 32 + h];
#pragma unroll 1
            for (int ih = 0; ih < 2; ++ih) {
            f32x4 acc[2][4];
#pragma unroll
            for (int i = 0; i < 2; ++i)
#pragma unroll
                for (int pt = 0; pt < 4; ++pt) acc[i][pt] = (f32x4){0.f, 0.f, 0.f, 0.f};
#pragma unroll
            for (int dir = 0; dir < 2; ++dir) {
                const bf16_t* sb = SST + (((size_t)(dir * NCH + c) * 32 + h) * 64) * 128;
                f32x4 tmp[2][4];
#pragma unroll
                for (int i = 0; i < 2; ++i)
#pragma unroll
                    for (int pt = 0; pt < 4; ++pt) tmp[i][pt] = (f32x4){0.f, 0.f, 0.f, 0.f};
#pragma unroll
                for (int ks = 0; ks < 4; ++ks) { const int lb = (lh * 4 + ih * 2) * 16 + fr;
                    const bf16x8 yf0 = *(const bf16x8*)(Cs + lb * 136 + ks * 32 + fq * 8), yf1 = *(const bf16x8*)(Cs + (lb + 16) * 136 + ks * 32 + fq * 8);
#pragma unroll
                    for (int pt = 0; pt < 4; ++pt) { const bf16x8 sfr = *(const bf16x8*)(sb + (size_t)(pt * 16 + fr) * 128 + ks * 32 + fq * 8);
                        tmp[0][pt] = __builtin_amdgcn_mfma_f32_16x16x32_bf16(sfr, yf0, tmp[0][pt], 0, 0, 0); tmp[1][pt] = __builtin_amdgcn_mfma_f32_16x16x32_bf16(sfr, yf1, tmp[1][pt], 0, 0, 0); } }
#pragma unroll
                for (int i = 0; i < 2; ++i) { int frv = fr; asm volatile("" : "+v"(frv));
                    const int lt = lh * 4 + ih * 2 + i, l = lt * 16 + frv;
                    const float cl = cumL[(dir * 8 + hh) * 128 + l], el = __expf(cl);
#pragma unroll
                    for (int pt = 0; pt < 4; ++pt) acc[i][pt] += tmp[i][pt] * el;
#pragma unroll
                    for (int ks = 0; ks < 4; ++ks) { const int s0 = ks * 32;
                        const bool skip = dir == 0 ? (s0 > lt * 16 + 15) : (s0 + 31 < lt * 16);
                        if (!skip) { const u32x4 cbv = *(const u32x4*)(CBs + l * 136 + s0 + fq * 8);
                            const float* cp = cumL + (dir * 8 + hh) * 128 + s0 + fq * 8; const float* dp = dtL + (dir * 8 + hh) * 128 + s0 + fq * 8;
                            const f32x4 c0 = *(const f32x4*)cp, c1 = *(const f32x4*)(cp + 4), d0 = *(const f32x4*)dp, d1 = *(const f32x4*)(dp + 4);
                            float cbf[8] = {bflo(cbv.x), bfhi(cbv.x), bflo(cbv.y), bfhi(cbv.y), bflo(cbv.z), bfhi(cbv.z), bflo(cbv.w), bfhi(cbv.w)}; float v[8];
#pragma unroll
                            for (int j = 0; j < 8; ++j) { const int sx = s0 + fq * 8 + j; const float cs = j < 4 ? c0[j & 3] : c1[j & 3], ds = j < 4 ? d0[j & 3] : d1[j & 3];
                                const bool valid = dir == 0 ? (sx <= l) : (sx >= l); float t = valid ? cbf[j] * __expf(fminf(cl - cs, 0.f)) * ds : 0.f; if (dir == 0 && sx == l) t += Dh; v[j] = t; }
                            const bf16x8 yf = mkfrag(cvt_pk_bf16(v[0], v[1]), cvt_pk_bf16(v[2], v[3]), cvt_pk_bf16(v[4], v[5]), cvt_pk_bf16(v[6], v[7]));
#pragma unroll
                            for (int pt = 0; pt < 4; ++pt) acc[i][pt] = __builtin_amdgcn_mfma_f32_16x16x32_bf16(*(const bf16x8*)(xT + ((hl * 64 + pt * 16 + fr) * 136 + s0 + fq * 8)), yf, acc[i][pt], 0, 0, 0); } }
                }
            }
#pragma unroll
            for (int i = 0; i < 2; ++i) { const int l = (lh * 4 + ih * 2 + i) * 16 + fr; const size_t row = (size_t)(rowbase + l); float ss = 0.f;
#pragma unroll
                for (int pt = 0; pt < 4; ++pt) { const int ch = h * 64 + pt * 16 + fq * 4; const u32x2 zz = *(const u32x2*)(Z + row * 2048 + ch);
                    const float h0 = acc[i][pt][0] * silu_(bflo(zz.x)), h1 = acc[i][pt][1] * silu_(bfhi(zz.x)), h2 = acc[i][pt][2] * silu_(bflo(zz.y)), h3 = acc[i][pt][3] * silu_(bfhi(zz.y));
                    ss += (h0 * h0 + h1 * h1) + (h2 * h2 + h3 * h3); u32x2 o; o.x = cvt_pk_bf16(h0, h1); o.y = cvt_pk_bf16(h2, h3); *(u32x2*)(YD + row * 2048 + ch) = o; }
                ss += __shfl_xor(ss, 16); ss += __shfl_xor(ss, 32);
                if (fq == 0) part[hh * 128 + l] = ss; }
            }
        }
        __syncthreads();
#pragma unroll 1
        for (int it = 0; it < 8; ++it) { const int pass = it >> 2, i = it & 3, l = (lh * 4 + i) * 16 + fr, h = g * 8 + pass * 4 + hl; float tot = 0.f;
#pragma unroll
            for (int hd = 0; hd < 8; ++hd) tot += part[hd * 128 + l];
            const float r = 1.f / sqrtf(tot * (1.f / 512.f) + RMS_EPS); const size_t row = (size_t)(rowbase + l);
#pragma unroll
            for (int pt = 0; pt < 4; ++pt) { const int ch = h * 64 + pt * 16 + fq * 4; bf16_t* yp = YD + row * 2048 + ch; const u32x2 hv = *(const u32x2*)yp; const f32x4 nw = *(const f32x4*)(normw + ch);
                u32x2 o; o.x = cvt_pk_bf16(bflo(hv.x) * r * nw[0], bfhi(hv.x) * r * nw[1]); o.y = cvt_pk_bf16(bflo(hv.y) * r * nw[2], bfhi(hv.y) * r * nw[3]); *(u32x2*)yp = o; } }
    }
    __syncthreads();
}

#define LAS __attribute__((address_space(3)))
#define XB_TMO      128
#define XB_XCNT(j)  (256  + 64 * (j))
#define XB_XSUB(j)  (1280 + 64 * (j))
#define XB_XGEN(j)  (2304 + 64 * (j))
#define XB_TOP      3328
#define XB_TOPGEN   3392
#define XCD_BAR_WORDS 3456
#define XB_SPIN_CAP (1u << 18)

__device__ __forceinline__ unsigned xb_ld(unsigned* p)              { return __hip_atomic_load(p, __ATOMIC_RELAXED, __HIP_MEMORY_SCOPE_AGENT); }
__device__ __forceinline__ unsigned xb_add(unsigned* p, unsigned v) { return __hip_atomic_fetch_add(p, v, __ATOMIC_RELAXED, __HIP_MEMORY_SCOPE_AGENT); }
__device__ __forceinline__ unsigned xb_xcc_id() { return (unsigned)__builtin_amdgcn_s_getreg((3 << 11) | 20) & 0xFu; }
#define XB_SPIN(cond, bar) do { unsigned _sp = 0; while (cond) { __builtin_amdgcn_s_sleep(1); \
    if ((++_sp & 255u) == 0u) { if (xb_ld(&(bar)[XB_TMO])) break; if (_sp > XB_SPIN_CAP) { atomicAdd(&(bar)[XB_TMO], 1u); break; } } } } while (0)

struct XcdBarrier {
    unsigned* bar; unsigned x;
    volatile LAS unsigned* st;
};

__device__ __forceinline__ XcdBarrier xcd_barrier_post(unsigned* bar, volatile LAS unsigned* st) {
    XcdBarrier b; b.bar = bar; b.x = xb_xcc_id(); b.st = st;
    if (threadIdx.x == 0) (void)xb_add(&bar[XB_XCNT(b.x)], 1u);
    return b;
}
__device__ __forceinline__ void xcd_barrier_complete(unsigned* bar, unsigned x, unsigned& nloc, unsigned& nx) {
    const unsigned G = gridDim.x * gridDim.y * gridDim.z;
    unsigned sum, cnt, mine, sp = 0u;
    for (;;) {
        sum = 0u; cnt = 0u; mine = 0u;
#pragma unroll
        for (unsigned j = 0; j < 16; ++j) { const unsigned c = xb_ld(&bar[XB_XCNT(j)]); sum += c; cnt += (c > 0u) ? 1u : 0u; mine = (j == x) ? c : mine; }
        if (sum == G) break;
        __builtin_amdgcn_s_sleep(1);
        if ((++sp & 255u) == 0u) { if (xb_ld(&bar[XB_TMO])) break; if (sp > XB_SPIN_CAP) { atomicAdd(&bar[XB_TMO], 1u); break; } }
    }
    nloc = mine > 0u ? mine : 1u; nx = cnt > 0u ? cnt : 1u;
}

__device__ __forceinline__ void xcd_barrier(const XcdBarrier& b) {
    asm volatile("s_waitcnt vmcnt(0)" ::: "memory");
    __syncthreads();
    if (threadIdx.x == 0) {
        unsigned* bar = b.bar;
        __builtin_amdgcn_s_waitcnt(0);
        unsigned nloc = b.st[0], nx = b.st[1];
        if (nloc == 0u) { xcd_barrier_complete(bar, b.x, nloc, nx); b.st[0] = nloc; b.st[1] = nx; }
        const unsigned old = xb_add(&bar[XB_XSUB(b.x)], 1u);
        const unsigned gen = old / nloc;
        if (old + 1u == (gen + 1u) * nloc) {
            __builtin_amdgcn_fence(__ATOMIC_RELEASE, "agent");
            asm volatile("s_waitcnt vmcnt(0)" ::: "memory");
            const unsigned og = xb_add(&bar[XB_TOP], 1u);
            const unsigned tg = og / nx;
            if (og + 1u == (tg + 1u) * nx) xb_add(&bar[XB_TOPGEN], 1u);
            else XB_SPIN(xb_ld(&bar[XB_TOPGEN]) == tg, bar);
            __builtin_amdgcn_fence(__ATOMIC_ACQUIRE, "agent");
            xb_add(&bar[XB_XGEN(b.x)], 1u);
            asm volatile("s_waitcnt vmcnt(0)" ::: "memory");
        } else {
            XB_SPIN(xb_ld(&bar[XB_XGEN(b.x)]) == gen, bar);
            __builtin_amdgcn_fence(__ATOMIC_ACQUIRE, "agent");
            asm volatile("s_waitcnt vmcnt(0)" ::: "memory");
        }
    }
    __syncthreads();
}

#ifndef MK_REP_S5
#define MK_REP_S5 1
#endif
#ifndef MK_REP_SSD
#define MK_REP_SSD 1
#endif
#ifndef MK_REP_SYNC
#define MK_REP_SYNC 1
#endif
#ifndef MK_CG_SYNC_ALL
#define MK_CG_SYNC_ALL 0
#endif
#ifndef MK_REP_PRO
#define MK_REP_PRO 1
#endif
#ifndef MK_REP_GEMM
#define MK_REP_GEMM 1
#endif
constexpr int NPHASE = 2 + 11 * 2;
__global__ void __launch_bounds__(512, 2) fwd_megakernel(Args a) {
    extern __shared__ __attribute__((aligned(16))) unsigned char lds[];
    PG8_LAS unsigned char* lds3 = (PG8_LAS unsigned char*)lds;
    unsigned char* big = a.ws + WS_BIG;
    volatile LAS unsigned* bst = (volatile LAS unsigned*)(lds3 + (LDS_BYTES - 16));
    if (threadIdx.x < 4) bst[threadIdx.x] = 0u;
    __syncthreads();
    XcdBarrier xbar; xbar.bar = (unsigned*)(a.ws + WS_BAR); xbar.x = 0; xbar.st = bst;
    if (a.ph_hi - a.ph_lo > 1) xbar = xcd_barrier_post((unsigned*)(a.ws + WS_BAR), bst);
    for (int ph = a.ph_lo; ph < a.ph_hi; ++ph) {
        const int tid = pg8::pg8_tid(), lane = tid & 63, wave = tid >> 6, gw = blockIdx.x * 8 + wave, NGW = gridDim.x * 8;
        if (ph == 0) {
            for (int rep = 0; rep < MK_REP_PRO; ++rep) {
            adaln_phase(a, (float*)lds, tid);
            float* scr = (float*)lds + wave * (64 * 33);
            xpose_region(a, 0, 0, scr, gw, NGW, lane); xpose_region(a, 0, 1, scr, gw, NGW, lane); __syncthreads(); }
        } else if (ph == 1) {
            row_phase<0>(a, MT, nullptr, nullptr, 0, 0, gw, NGW, lane);
        } else {
            const int layer = (ph - 2) / 11, k = (ph - 2) % 11; const bool last = layer == 1; const int Mrows = last ? TL : MT;
            const bf16_t* WA = (const bf16_t*)(a.ws + WS_WA); const bf16_t* WB = (const bf16_t*)(a.ws + WS_WB);
#ifdef MK_SKIP_MASK
            if ((MK_SKIP_MASK >> k) & 1) { if (ph + 1 < a.ph_hi) xcd_barrier(xbar); continue; }
#endif
            if (k == 0) {
                pg8::Gemm g{(const bf16_t*)(a.ws + WS_XM), WA + WA_IN / 2, MT, NPROJ, D}; pg8::StaticOrder S; S.init(MT, NPROJ, gridDim.x, blockIdx.x);
                EpiInProj E{big, a.in[19] + (size_t)layer * 64}; for (int rep = 0; rep < MK_REP_GEMM; ++rep) { pg8::gemm_phase<EpiInProj, pg8::StaticOrder>(lds3, g, S, E, nullptr); __syncthreads(); }
            } else if (k == 1) {
                for (int rep = 0; rep < MK_REP_SSD; ++rep) ssd_a_phase(a, layer, lds, tid);
                for (int rep = 0; rep < MK_REP_S5; ++rep) s5_phase<0>(a, layer, lds, tid, NCH);
            } else if (k == 2) {
#if !defined(MK_NO_SSD) && !defined(MK_NO_SSDB)
                ssd_b_phase(a, tid);
#endif
                for (int rep = 0; rep < MK_REP_S5; ++rep) s5_phase<1>(a, layer, lds, tid, last ? 128 : NCH);
            } else if (k == 3) {
                for (int rep = 0; rep < MK_REP_SSD; ++rep) ssd_c_phase(a, layer, lds, tid, last ? 128 : NCH);
#ifndef MK_NO_S5
                pg8::Gemm g{(const bf16_t*)(big + B_Y5), WA + WA_GLU / 2, Mrows, 2048, 1024}; pg8::StaticOrder S; S.init(Mrows, 2048, gridDim.x, blockIdx.x);
                EpiGlu E{(bf16_t*)(big + B_U5)}; pg8::gemm_phase<EpiGlu, pg8::StaticOrder>(lds3, g, S, E, nullptr);
#endif
            } else if (k == 4) {
#ifndef MK_NO_S5
                { pg8::Gemm g{(const bf16_t*)(big + B_U5), WA + WA_S5P / 2, Mrows, 2048, 1024}; pg8::StaticOrder S; S.init(Mrows, 2048, gridDim.x, blockIdx.x);
                  EpiMerge<0> E{(bf16_t*)(big + B_XBC), (const bf16_t*)(big + B_GATE)}; pg8::gemm_phase<EpiMerge<0>, pg8::StaticOrder>(lds3, g, S, E, nullptr); }
                __syncthreads();
#endif
#ifndef MK_NO_SSD
#ifdef MK_NO_S5
                { pg8::Gemm g{(const bf16_t*)(big + B_YD), WA + WA_SSDP / 2, Mrows, 2048, 2048}; pg8::StaticOrder S; S.init(Mrows, 2048, gridDim.x, blockIdx.x);
                  EpiMerge<0, 1> E{(bf16_t*)(big + B_XBC), (const bf16_t*)(big + B_GATE)}; pg8::gemm_phase<EpiMerge<0, 1>, pg8::StaticOrder>(lds3, g, S, E, nullptr); }
#else
                { pg8::Gemm g{(const bf16_t*)(big + B_YD), WA + WA_SSDP / 2, Mrows, 2048, 2048}; pg8::StaticOrder S; S.init(Mrows, 2048, gridDim.x, blockIdx.x);
                  EpiMerge<1> E{(bf16_t*)(big + B_XBC), (const bf16_t*)(big + B_GATE)}; pg8::gemm_phase<EpiMerge<1>, pg8::StaticOrder>(lds3, g, S, E, nullptr); }
#endif
#endif
            } else if (k == 5) {
                pg8::Gemm g{(const bf16_t*)(big + B_XBC), WA + WA_WOUT / 2, Mrows, 2048, 2048}; pg8::StaticOrder S; S.init(Mrows, 2048, gridDim.x, blockIdx.x);
                EpiResid E{a.out, (float*)(a.ws + WS_HCTX), mvec(a, layer, 0) + 2 * D, mvec(a, layer, 1) + 2 * D}; pg8::gemm_phase<EpiResid, pg8::StaticOrder>(lds3, g, S, E, nullptr);
            } else if (k == 6) {
                row_phase<1>(a, Mrows, a.in[25] + (size_t)layer * D, a.in[26] + (size_t)layer * D, layer, 3 * D, gw, NGW, lane);
                if (!last) for (int rep = 0; rep < MK_REP_PRO; ++rep) { __syncthreads(); xpose_region(a, layer + 1, 0, (float*)lds + wave * (64 * 33), gw, NGW, lane); }
            } else if (k == 7) {
                pg8::Gemm g{(const bf16_t*)(a.ws + WS_XM), WB + WB_UP / 2, Mrows, 2 * DFF, D}; pg8::StaticOrder S; S.init(Mrows, 2 * DFF, gridDim.x, blockIdx.x);
                EpiUp E{(bf16_t*)(big + B_G), (bf16_t*)(big + B_V)}; for (int rep = 0; rep < MK_REP_GEMM; ++rep) { pg8::gemm_phase<EpiUp, pg8::StaticOrder>(lds3, g, S, E, nullptr); __syncthreads(); }
            } else if (k == 8) {
                ffnconv_phase(a, layer, !last, tid);
            } else if (k == 9) {
                pg8::Gemm g{(const bf16_t*)(big + B_V), WB + WB_DOWN / 2, Mrows, D, DFF}; pg8::StaticOrder S; S.init(Mrows, D, gridDim.x, blockIdx.x);
                EpiResid E{a.out, (float*)(a.ws + WS_HCTX), mvec(a, layer, 0) + 5 * D, mvec(a, layer, 1) + 5 * D}; pg8::gemm_phase<EpiResid, pg8::StaticOrder>(lds3, g, S, E, nullptr);
            } else {
                row_phase<1>(a, Mrows, a.in[31] + (size_t)layer * D, a.in[32] + (size_t)layer * D, last ? -1 : layer + 1, 0, gw, NGW, lane);
                if (!last) for (int rep = 0; rep < MK_REP_PRO; ++rep) { __syncthreads(); xpose_region(a, layer + 1, 1, (float*)lds + wave * (64 * 33), gw, NGW, lane); }
            }
        }
        if (ph + 1 < a.ph_hi) { for (int rep = 0; rep < MK_REP_SYNC; ++rep) { if (MK_CG_SYNC_ALL || ph == a.ph_lo) cg::this_grid().sync(); else xcd_barrier(xbar); } }
    }
}
}

#ifndef MK_N_LAUNCH_MODE
#define MK_N_LAUNCH_MODE 0
#endif
extern "C" void kernel_launch(void* const* d_in, const int* in_sizes, int n_in, void* d_out, int out_size, void* d_ws, size_t ws_size, hipStream_t stream) {
    static int grid = 0;
    if (grid == 0) {
        if (n_in != 33 || ws_size < mk::WS_END) { fprintf(stderr, "kernel_launch: need 33 inputs and %zu bytes of workspace (got %d, %zu)\n", (size_t)mk::WS_END, n_in, ws_size); grid = -1; return; }
        int dev = 0, cus = 0, per_cu = 0;
        (void)hipGetDevice(&dev); (void)hipDeviceGetAttribute(&cus, hipDeviceAttributeMultiprocessorCount, dev);
        if (hipFuncSetAttribute((const void*)mk::fwd_megakernel, hipFuncAttributeMaxDynamicSharedMemorySize, mk::LDS_BYTES) != hipSuccess) { fprintf(stderr, "kernel_launch: hipFuncSetAttribute failed\n"); grid = -1; return; }
        if (hipOccupancyMaxActiveBlocksPerMultiprocessor(&per_cu, (const void*)mk::fwd_megakernel, 512, mk::LDS_BYTES) != hipSuccess || per_cu < 1) { fprintf(stderr, "kernel_launch: occupancy query says %d\n", per_cu); per_cu = 1; }
        (void)hipGetLastError();
        grid = cus * per_cu; if (grid > 256) grid = 256;
    }
    if (grid < 0) return;
    mk::Args a{};
    for (int i = 0; i < 33; ++i) a.in[i] = (const float*)d_in[i];
    a.out = (float*)d_out; a.ws = (unsigned char*)d_ws;
#if MK_N_LAUNCH_MODE == 1
    for (int ph = 0; ph < mk::NPHASE; ++ph) { a.ph_lo = ph; a.ph_hi = ph + 1; hipLaunchKernelGGL(mk::fwd_megakernel, dim3(grid), dim3(512), mk::LDS_BYTES, stream, a); }
#else
    a.ph_lo = 0; a.ph_hi = mk::NPHASE;
    (void)hipMemsetAsync((unsigned char*)d_ws + mk::WS_BAR, 0, XCD_BAR_WORDS * sizeof(unsigned), stream);
    void* args[] = {&a};
    hipError_t e = hipLaunchCooperativeKernel((const void*)mk::fwd_megakernel, dim3(grid), dim3(512), args, mk::LDS_BYTES, stream);
    if (e != hipSuccess) fprintf(stderr, "cooperative launch failed: %s (grid %d)\n", hipGetErrorString(e), grid);
#endif
}
```

```cpp
#include <hip/hip_runtime.h>
#include <hip/hip_cooperative_groups.h>
#include <cstdio>
namespace cg = cooperative_groups;
#define MK_N_LAUNCH_MODE 0
namespace pg8 {
#define PG8_LAS __attribute__((address_space(3)))
typedef unsigned short bf16_t;
typedef short bf16x8 __attribute__((ext_vector_type(8)));
typedef float f32x4 __attribute__((ext_vector_type(4)));
typedef unsigned u32x4 __attribute__((ext_vector_type(4)));
constexpr int BM = 256, BK = 64, HALF = 128, HTB = HALF * BK * 2  , STAGE_BYTES = 8 * HTB, NXCD = 8, WGM = 8;

__host__ __device__ __forceinline__ int lds_byte(int r, int c) { const int st = (r >> 4) * 2 + (c >> 5), rr = r & 15, cc = c & 31, ob = rr * 64 + cc * 2; return st * 1024 + (ob ^ (((ob >> 9) & 1) << 5)); }
__host__ __device__ __forceinline__ void stage_rc(int b, int& R, int& C) { const int st = b / 1024, sb = b % 1024, swz = sb ^ (((sb >> 9) & 1) << 5); R = (st >> 1) * 16 + swz / 64; C = (st & 1) * 32 + (swz % 64) / 2; }
__host__ __device__ __forceinline__ int perm32(int rho) { const int n = rho >> 4, i = rho & 15; return 8 * (i >> 2) + 4 * n + (i & 3); }

__device__ __forceinline__ int pg8_tid() { int t = threadIdx.x; asm volatile("" : "+v"(t)); return t; }
struct Unit { int pm, pn; };
struct Gemm { const bf16_t* A; const bf16_t* Bt; int M, N, K; };

struct StaticOrder {
    int nM, nN, nwg, G, c;
    __host__ __device__ void init(int M, int N, int G_, int c_) { nM = M / BM; nN = N / BM; nwg = nM * nN; G = G_; c = c_; }
    __host__ __device__ bool next(int i, Unit& u) const {
        const long L = (long)i * G + c; if (L >= nwg) return false;
        int wgid = (int)L; { const int q = nwg / NXCD, r = nwg % NXCD, xcd = wgid % NXCD, off = wgid / NXCD; wgid = (xcd < r ? xcd * (q + 1) : r * (q + 1) + (xcd - r) * q) + off; }
        const int nig = WGM * nN, gid = wgid / nig, fm = gid * WGM, gsz = (nM - fm) < WGM ? (nM - fm) : WGM;
        u.pm = fm + ((wgid % nig) % gsz); u.pn = (wgid % nig) / gsz; return true;
    }
    __device__ __forceinline__ void a_ready(const Unit&) const {}
    __device__ __forceinline__ void done(const Unit&) const {}
};
typedef float f32x2c __attribute__((ext_vector_type(2))); typedef __bf16 bf16x2c __attribute__((ext_vector_type(2)));
__device__ __forceinline__ unsigned cvt_pk_native(float lo, float hi) { const f32x2c v = {lo, hi}; const bf16x2c b = __builtin_convertvector(v, bf16x2c); return __builtin_bit_cast(unsigned, b); }
__device__ __forceinline__ unsigned cvt_pk_bf16(float lo, float hi) { unsigned r; asm volatile("v_cvt_pk_bf16_f32 %0, %1, %2" : "=v"(r) : "v"(lo), "v"(hi)); return r; }
__device__ __forceinline__ void mfma_settle(const float __attribute__((ext_vector_type(4)))& a) { asm volatile("s_nop 15\n\ts_nop 7" :: "v"(a)); }
typedef float f32x2 __attribute__((ext_vector_type(2)));
template <class Epi, class Sched, bool STAMP = false>
__device__ __forceinline__ void gemm_phase(PG8_LAS unsigned char* lds, const Gemm g, const Sched& S, const Epi& E, unsigned long long* stamps) {
    const int tid = pg8_tid(), wid = __builtin_amdgcn_readfirstlane(tid >> 6), lane = tid & 63, wr = wid >> 2, wc = wid & 3, fr = lane & 15, fq = lane >> 4;
    const int K = g.K, nt = K / BK;
    int ts_lo = 0, ts_hi = 0, nts = 0; const unsigned long long rt_entry = STAMP ? (unsigned long long)wall_clock64() : 0ull;
#define PG8_STAMP() do { if (STAMP && wid == 0 && nts < 64) { const unsigned long long _c = (unsigned long long)clock64(); \
        ts_lo = (lane == nts) ? (int)(unsigned)_c : ts_lo; ts_hi = (lane == nts) ? (int)(unsigned)(_c >> 32) : ts_hi; ++nts; } } while (0)
    PG8_STAMP();
    unsigned voffA[2], voffB[2];
#pragma unroll
    for (int i = 0; i < 2; ++i) { int R, C; stage_rc(tid * 16 + i * 8192, R, C); const int Rb = Epi::PERM ? ((R & ~31) + perm32(R & 31)) : R;
        voffA[i] = (unsigned)(R * K + C) * 2u; voffB[i] = (unsigned)(Rb * K + C) * 2u; }
    const size_t kstep = (size_t)(BK * 2);
    const size_t hstep = (size_t)HALF * K * 2;
    const size_t tstep = 2 * hstep;
    const unsigned ldsw = (unsigned)wid * 1024u;
    const int aoff = lds_byte(wr * 64 + fr, fq * 8), boff = lds_byte(wc * 32 + fr, fq * 8);
#define PG8_SA(b, h) (((b) * 2 + (h)) * HTB)
#define PG8_SB(b, h) ((4 + (b) * 2 + (h)) * HTB)
#define PG8_STAGE(bufoff, gbase, voff) do { _Pragma("unroll") for (int _i = 0; _i < 2; ++_i) \
        __builtin_amdgcn_global_load_lds((const unsigned*)((const char*)(gbase) + (voff)[_i]), (PG8_LAS unsigned*)(lds + (bufoff) + ldsw + _i * 8192), 16, 0, 0); } while (0)
#define PG8_LDA(dst, b, h) do { _Pragma("unroll") for (int m = 0; m < 4; ++m) _Pragma("unroll") for (int k = 0; k < 2; ++k) dst[m][k] = *(const PG8_LAS bf16x8*)(lds + PG8_SA(b, h) + aoff + m * 2048 + k * 1024); } while (0)
#define PG8_LDB(dst, b, h) do { _Pragma("unroll") for (int n = 0; n < 2; ++n) _Pragma("unroll") for (int k = 0; k < 2; ++k) dst[n][k] = *(const PG8_LAS bf16x8*)(lds + PG8_SB(b, h) + boff + n * 2048 + k * 1024); } while (0)
#define PG8_MMA(ai, bj, At, Bt) do { __builtin_amdgcn_s_setprio(1); _Pragma("unroll") for (int m = 0; m < 4; ++m) _Pragma("unroll") for (int n = 0; n < 2; ++n) _Pragma("unroll") for (int k = 0; k < 2; ++k) \
        acc[ai][bj][m][n] = __builtin_amdgcn_mfma_f32_16x16x32_bf16(Bt[n][k], At[m][k], acc[ai][bj][m][n], 0, 0, 0); __builtin_amdgcn_s_setprio(0); } while (0)
#define PG8_WAIT_V(n) asm volatile("s_waitcnt vmcnt(" #n ")" ::: "memory")
#define PG8_WAIT_L(n) asm volatile("s_waitcnt lgkmcnt(" #n ")" ::: "memory")
#define PG8_BAR __builtin_amdgcn_s_barrier()
#define PG8_SCHED __builtin_amdgcn_sched_barrier(0)
    Unit cur, nxt; int ui = 0;
    if (!S.next(0, cur)) return;
    f32x4 acc[2][2][4][2];
#pragma unroll
    for (int a = 0; a < 2; ++a)
#pragma unroll
        for (int b = 0; b < 2; ++b)
#pragma unroll
            for (int m = 0; m < 4; ++m)
#pragma unroll
                for (int n = 0; n < 2; ++n) acc[a][b][m][n] = (f32x4){0.f, 0.f, 0.f, 0.f};
    bf16x8 At[4][2], B0[2][2], B1[2][2];
    const char* cA = (const char*)g.A + (size_t)cur.pm * tstep; const char* cB = (const char*)g.Bt + (size_t)cur.pn * tstep;
    S.a_ready(cur);
    PG8_STAGE(PG8_SB(0, 0), cB, voffB); PG8_STAGE(PG8_SA(0, 0), cA, voffA); PG8_STAGE(PG8_SB(0, 1), cB + hstep, voffB); PG8_STAGE(PG8_SA(0, 1), cA + hstep, voffA);
    if (wr == 1) PG8_BAR;
    PG8_WAIT_V(4); PG8_BAR;
    PG8_STAGE(PG8_SB(1, 0), cB + kstep, voffB); PG8_STAGE(PG8_SA(1, 0), cA + kstep, voffA); PG8_STAGE(PG8_SB(1, 1), cB + hstep + kstep, voffB);
    PG8_WAIT_V(6); PG8_BAR;
    PG8_STAMP();
    for (;;) {
        const bool has_next = S.next(ui + 1, nxt);
        const char* nA = has_next ? (const char*)g.A + (size_t)nxt.pm * tstep : cA; const char* nB = has_next ? (const char*)g.Bt + (size_t)nxt.pn * tstep : cB;
        for (int t = 0; t < nt; t += 2) {
            const bool last = (t == nt - 2);
            const char* a1 = cA + (size_t)(t + 1) * kstep;
            const char* a2 = last ? nA : cA + (size_t)(t + 2) * kstep; const char* b2 = last ? nB : cB + (size_t)(t + 2) * kstep;
            const char* a3 = a2 + kstep; const char* b3 = b2 + kstep;
            if (last && has_next) S.a_ready(nxt);
            PG8_LDB(B0, 0, 0); PG8_SCHED; PG8_LDA(At, 0, 0); PG8_STAGE(PG8_SA(1, 1), a1 + hstep, voffA);
            PG8_WAIT_L(8); PG8_BAR; PG8_WAIT_L(0); PG8_MMA(0, 0, At, B0); PG8_BAR; PG8_SCHED;
            PG8_LDB(B1, 0, 1); PG8_STAGE(PG8_SB(0, 0), b2, voffB);
            PG8_BAR; PG8_WAIT_L(0); PG8_MMA(0, 1, At, B1); PG8_BAR;
            PG8_LDA(At, 0, 1); PG8_STAGE(PG8_SA(0, 0), a2, voffA);
            PG8_BAR; PG8_WAIT_L(0); PG8_MMA(1, 0, At, B0); PG8_BAR; PG8_SCHED;
            PG8_STAGE(PG8_SB(0, 1), b2 + hstep, voffB);
            PG8_WAIT_V(6); PG8_BAR; PG8_MMA(1, 1, At, B1); PG8_BAR;
            PG8_LDB(B0, 1, 0); PG8_SCHED; PG8_LDA(At, 1, 0); PG8_STAGE(PG8_SA(0, 1), a2 + hstep, voffA);
            PG8_WAIT_L(8); PG8_BAR; PG8_WAIT_L(0); PG8_MMA(0, 0, At, B0); PG8_BAR; PG8_SCHED;
            PG8_LDB(B1, 1, 1); PG8_STAGE(PG8_SB(1, 0), b3, voffB);
            PG8_BAR; PG8_WAIT_L(0); PG8_MMA(0, 1, At, B1); PG8_BAR;
            PG8_LDA(At, 1, 1); PG8_STAGE(PG8_SA(1, 0), a3, voffA);
            PG8_BAR; PG8_WAIT_L(0); PG8_MMA(1, 0, At, B0); PG8_BAR; PG8_SCHED;
            PG8_STAGE(PG8_SB(1, 1), b3 + hstep, voffB);
            PG8_WAIT_V(6); PG8_BAR; PG8_MMA(1, 1, At, B1); PG8_BAR;
        }
        PG8_STAMP();
        if constexpr (!Epi::AFTER_DRAIN) { E(acc, cur, wr, wc, fr, fq); S.done(cur); }
        PG8_STAMP();
        if (!has_next) break;
#pragma unroll
        for (int a = 0; a < 2; ++a)
#pragma unroll
            for (int b = 0; b < 2; ++b)
#pragma unroll
                for (int m = 0; m < 4; ++m)
#pragma unroll
                    for (int n = 0; n < 2; ++n) acc[a][b][m][n] = (f32x4){0.f, 0.f, 0.f, 0.f};
        cur = nxt; cA = nA; cB = nB; ++ui;
    }
    PG8_WAIT_V(0);
    if (wr == 0) PG8_BAR;
    PG8_BAR;
    if constexpr (Epi::AFTER_DRAIN) { E.fused(acc, cur, wr, wc, fr, fq, lds, wid, lane); S.done(cur); }
    PG8_STAMP();
    if (STAMP && wid == 0) { stamps[lane] = lane < nts ? (((unsigned long long)(unsigned)ts_hi << 32) | (unsigned)ts_lo) : 0ull;
        if (lane == 62) stamps[62] = rt_entry; if (lane == 63) stamps[63] = (unsigned long long)wall_clock64(); }
#undef PG8_STAMP
#undef PG8_SA
#undef PG8_SB
#undef PG8_STAGE
#undef PG8_LDA
#undef PG8_LDB
#undef PG8_MMA
#undef PG8_WAIT_V
#undef PG8_WAIT_L
#undef PG8_BAR
#undef PG8_SCHED
}
}

namespace mk {
using pg8::bf16_t; using pg8::bf16x8; using pg8::f32x4; using pg8::u32x4; using pg8::Unit; using pg8::cvt_pk_bf16; using pg8::cvt_pk_native; using pg8::mfma_settle;
typedef unsigned u32x2 __attribute__((ext_vector_type(2)));
typedef float f32x2 __attribute__((ext_vector_type(2)));
constexpr int D = 2048, TL = 16384, TC = 256, MT = TL + TC, NCH = MT / 128;
constexpr int NPROJ = 10496, DFF = 5632;
constexpr size_t MiB = 1u << 20;
constexpr size_t WS_MVEC = 0, WS_CHD = 256 * 1024, WS_BAR = 512 * 1024, WS_S5LOC = 1 * MiB, WS_WA = 10 * MiB, WS_WB = 75 * MiB, WS_HCTX = 141 * MiB, WS_XM = 143 * MiB, WS_SST = 208 * MiB, WS_BIG = 338 * MiB, WS_END = 766 * MiB;
constexpr size_t B_U5 = 0, B_XBC = B_U5 + (size_t)MT * 1024 * 2, B_Z = B_XBC + (size_t)MT * 3072 * 2, B_GATE = B_Z + (size_t)MT * 2048 * 2, B_DT = B_GATE + (size_t)MT * 4096 * 2,
                 B_Y5 = 330 * MiB, B_YD = B_Y5 + (size_t)MT * 1024 * 2;
static_assert(B_DT + (size_t)MT * 64 * 4 <= B_Y5 && B_YD + (size_t)MT * 2048 * 2 <= 428 * MiB, "big map");
constexpr size_t B_G = 0, B_V = (size_t)MT * DFF * 2;
constexpr size_t WA_IN = 0, WA_GLU = 41 * MiB, WA_S5P = 45 * MiB, WA_SSDP = 49 * MiB, WA_WOUT = 57 * MiB, WB_UP = 0, WB_DOWN = 44 * MiB;
constexpr int LDS_BYTES = 163840;
constexpr float ALPHA = 1.41421356237f, LN_EPS = 1e-5f, RMS_EPS = 1e-5f;

struct Args { const float* in[33]; float* out; unsigned char* ws; int ph_lo, ph_hi; };

__device__ __forceinline__ float bf2f(unsigned b) { return __uint_as_float(b << 16); }
__device__ __forceinline__ float bflo(unsigned w) { return __uint_as_float(w << 16); }
__device__ __forceinline__ float bfhi(unsigned w) { return __uint_as_float(w & 0xffff0000u); }
__device__ __forceinline__ float sigm(float x) { return 1.f / (1.f + __expf(-x)); }
__device__ __forceinline__ float silu_(float x) { return x / (1.f + __expf(-x)); }
__device__ __forceinline__ float gelu_tanh(float x) { const float u = 0.7978845608028654f * (x + 0.044715f * x * x * x); const float th = 1.f - 2.f / (__expf(2.f * u) + 1.f); return 0.5f * x * (1.f + th); }
__device__ __forceinline__ bf16x8 mkfrag(unsigned a, unsigned b, unsigned c, unsigned d) { u32x4 v; v.x = a; v.y = b; v.z = c; v.w = d; return __builtin_bit_cast(bf16x8, v); }
__device__ __forceinline__ float* hrow(const Args& a, int row) { return row < TL ? a.out + (size_t)row * D : (float*)(a.ws + WS_HCTX) + (size_t)(row - TL) * D; }
__device__ __forceinline__ const float* mvec(const Args& a, int layer, int isctx) { return (const float*)(a.ws + WS_MVEC) + (size_t)(layer * 2 + isctx) * 12288; }

struct EpiInProj {
    static constexpr bool PERM = true, AFTER_DRAIN = false;
    unsigned char* big; const float* dt_bias;
    __device__ __forceinline__ void operator()(const f32x4 (&acc)[2][2][4][2], const Unit& u, int wr, int wc, int fr, int fq) const {
        mfma_settle(acc[1][1][3][1]); mfma_settle(acc[1][1][3][0]);
        const int row0 = u.pm * 256 + wr * 64 + fr, ct = u.pn * 256;
        if (ct >= 10240) {
            if (wc < 2) { const int cc = wc * 32 + 8 * fq; float* DT = (float*)(big + B_DT);
                const f32x4 b0 = *(const f32x4*)(dt_bias + cc), b1 = *(const f32x4*)(dt_bias + cc + 4);
#pragma unroll
                for (int ai = 0; ai < 2; ++ai)
#pragma unroll
                    for (int m = 0; m < 4; ++m) { float* rp = DT + (size_t)(row0 + ai * 128 + m * 16) * 64 + cc; f32x4 v0 = acc[ai][0][m][0] + b0, v1 = acc[ai][0][m][1] + b1;
#pragma unroll
                        for (int j = 0; j < 4; ++j) { v0[j] = v0[j] > 20.f ? v0[j] : log1pf(expf(v0[j])); v1[j] = v1[j] > 20.f ? v1[j] : log1pf(expf(v1[j])); }
                        *(f32x4*)rp = v0; *(f32x4*)(rp + 4) = v1; } }
            return;
        }
        bf16_t* base; int ld, c0; bool sg = false;
        if (ct < 1024) { base = (bf16_t*)(big + B_U5); ld = 1024; c0 = ct; }
        else if (ct < 4096) { base = (bf16_t*)(big + B_XBC); ld = 3072; c0 = ct - 1024; }
        else if (ct < 6144) { base = (bf16_t*)(big + B_Z); ld = 2048; c0 = ct - 4096; }
        else { base = (bf16_t*)(big + B_GATE); ld = 4096; c0 = ct - 6144; sg = true; }
        const int col0 = c0 + wc * 32 + 8 * fq;
#pragma unroll
        for (int ai = 0; ai < 2; ++ai)
#pragma unroll
            for (int m = 0; m < 4; ++m) { bf16_t* rowp = base + (size_t)(row0 + ai * 128 + m * 16) * ld + col0;
#pragma unroll
                for (int bj = 0; bj < 2; ++bj) { f32x4 v0 = acc[ai][bj][m][0], v1 = acc[ai][bj][m][1];
                    if (sg) {
#pragma unroll
                        for (int j = 0; j < 4; ++j) { v0[j] = sigm(v0[j]); v1[j] = sigm(v1[j]); } }
                    u32x4 w; w.x = cvt_pk_bf16(v0[0], v0[1]); w.y = cvt_pk_bf16(v0[2], v0[3]); w.z = cvt_pk_bf16(v1[0], v1[1]); w.w = cvt_pk_bf16(v1[2], v1[3]);
                    *(u32x4*)(rowp + bj * 128) = w; } }
    }
};
struct EpiGlu {
    static constexpr bool PERM = true, AFTER_DRAIN = false;
    bf16_t* O;
    __device__ __forceinline__ void operator()(const f32x4 (&acc)[2][2][4][2], const Unit& u, int wr, int wc, int fr, int fq) const {
        mfma_settle(acc[1][1][3][1]); mfma_settle(acc[1][1][3][0]);
        const int row0 = u.pm * 256 + wr * 64 + fr, col0 = u.pn * 128 + wc * 32 + 8 * fq;
#pragma unroll
        for (int ai = 0; ai < 2; ++ai)
#pragma unroll
            for (int m = 0; m < 4; ++m) { f32x4 v0 = acc[ai][0][m][0], v1 = acc[ai][0][m][1]; const f32x4 g0 = acc[ai][1][m][0], g1 = acc[ai][1][m][1];
#pragma unroll
                for (int j = 0; j < 4; ++j) { v0[j] *= sigm(g0[j]); v1[j] *= sigm(g1[j]); }
                u32x4 w; w.x = cvt_pk_bf16(v0[0], v0[1]); w.y = cvt_pk_bf16(v0[2], v0[3]); w.z = cvt_pk_bf16(v1[0], v1[1]); w.w = cvt_pk_bf16(v1[2], v1[3]);
                *(u32x4*)(O + (size_t)(row0 + ai * 128 + m * 16) * 1024 + col0) = w; }
    }
};
template <int SECOND, int GSEL = SECOND> struct EpiMerge {
    static constexpr bool PERM = true, AFTER_DRAIN = false;
    bf16_t* MG; const bf16_t* GATE;
    __device__ __forceinline__ void operator()(const f32x4 (&acc)[2][2][4][2], const Unit& u, int wr, int wc, int fr, int fq) const {
        mfma_settle(acc[1][1][3][1]); mfma_settle(acc[1][1][3][0]);
        const int row0 = u.pm * 256 + wr * 64 + fr, col0 = u.pn * 256 + wc * 32 + 8 * fq;
#pragma unroll
        for (int ai = 0; ai < 2; ++ai)
#pragma unroll
            for (int m = 0; m < 4; ++m) { const size_t r = (size_t)(row0 + ai * 128 + m * 16);
#pragma unroll
                for (int bj = 0; bj < 2; ++bj) { const int c = col0 + bj * 128; const u32x4 g = *(const u32x4*)(GATE + r * 4096 + (GSEL ? 2048 : 0) + c);
                    f32x4 v0 = acc[ai][bj][m][0], v1 = acc[ai][bj][m][1];
                    v0[0] *= bflo(g.x); v0[1] *= bfhi(g.x); v0[2] *= bflo(g.y); v0[3] *= bfhi(g.y); v1[0] *= bflo(g.z); v1[1] *= bfhi(g.z); v1[2] *= bflo(g.w); v1[3] *= bfhi(g.w);
                    if (SECOND) { const u32x4 o = *(const u32x4*)(MG + r * 2048 + c);
                        v0[0] += bflo(o.x); v0[1] += bfhi(o.x); v0[2] += bflo(o.y); v0[3] += bfhi(o.y); v1[0] += bflo(o.z); v1[1] += bfhi(o.z); v1[2] += bflo(o.w); v1[3] += bfhi(o.w); }
                    u32x4 w; w.x = cvt_pk_bf16(v0[0], v0[1]); w.y = cvt_pk_bf16(v0[2], v0[3]); w.z = cvt_pk_bf16(v1[0], v1[1]); w.w = cvt_pk_bf16(v1[2], v1[3]);
                    *(u32x4*)(MG + r * 2048 + c) = w; } }
    }
};
struct EpiResid {
    static constexpr bool PERM = false, AFTER_DRAIN = false;
    float* out; float* hctx; const float* glat; const float* gctx;
    __device__ __forceinline__ void operator()(const f32x4 (&acc)[2][2][4][2], const Unit& u, int wr, int wc, int fr, int fq) const {
        mfma_settle(acc[1][1][3][1]); mfma_settle(acc[1][1][3][0]);
        const bool isctx = u.pm >= 64; const float* g = isctx ? gctx : glat;
        float* hb = isctx ? hctx + (size_t)(wr * 64 + fr) * D : out + (size_t)(u.pm * 256 + wr * 64 + fr) * D;
        const int col0 = u.pn * 256 + wc * 32 + 4 * fq;
        f32x4 gv[2][2];
#pragma unroll
        for (int bj = 0; bj < 2; ++bj)
#pragma unroll
            for (int n = 0; n < 2; ++n) gv[bj][n] = *(const f32x4*)(g + col0 + bj * 128 + n * 16);
#pragma unroll
        for (int ai = 0; ai < 2; ++ai)
#pragma unroll
            for (int m = 0; m < 4; ++m) { float* rowp = hb + (size_t)(ai * 128 + m * 16) * D + col0;
#pragma unroll
                for (int bj = 0; bj < 2; ++bj)
#pragma unroll
                    for (int n = 0; n < 2; ++n) { float* p = rowp + bj * 128 + n * 16; const f32x4 h = *(const f32x4*)p; *(f32x4*)p = h * ALPHA + gv[bj][n] * acc[ai][bj][m][n]; } }
    }
};
struct EpiUp {
    static constexpr bool PERM = true, AFTER_DRAIN = false;
    bf16_t* G; bf16_t* V;
    __device__ __forceinline__ void operator()(const f32x4 (&acc)[2][2][4][2], const Unit& u, int wr, int wc, int fr, int fq) const {
        mfma_settle(acc[1][1][3][1]); mfma_settle(acc[1][1][3][0]);
        const int row0 = u.pm * 256 + wr * 64 + fr; int ct = u.pn * 256; bf16_t* base = G; if (ct >= DFF) { base = V; ct -= DFF; }
        const int col0 = ct + wc * 32 + 8 * fq;
#pragma unroll
        for (int ai = 0; ai < 2; ++ai)
#pragma unroll
            for (int m = 0; m < 4; ++m) { bf16_t* rowp = base + (size_t)(row0 + ai * 128 + m * 16) * DFF + col0;
#pragma unroll
                for (int bj = 0; bj < 2; ++bj) { const f32x4 v0 = acc[ai][bj][m][0], v1 = acc[ai][bj][m][1];
                    u32x4 w; w.x = cvt_pk_bf16(v0[0], v0[1]); w.y = cvt_pk_bf16(v0[2], v0[3]); w.z = cvt_pk_bf16(v1[0], v1[1]); w.w = cvt_pk_bf16(v1[2], v1[3]);
                    *(u32x4*)(rowp + bj * 128) = w; } }
    }
};

__device__ __forceinline__ void xpose_item(const float* W, int K, int N, bf16_t* WT, int d0, int s0, int k0, float* scr, int lane) {
#pragma unroll
    for (int i = 0; i < 32; ++i) { const int kk = 2 * i + (lane >> 5); scr[kk * 33 + (lane & 31)] = s0 >= 0 ? W[(size_t)(k0 + kk) * N + s0 + (lane & 31)] : 0.f; }
    asm volatile("s_waitcnt lgkmcnt(0)" ::: "memory");
    const int c = lane & 7;
#pragma unroll
    for (int j = 0; j < 4; ++j) { const int n = (lane >> 3) + 8 * j; const float* s = scr + (8 * c) * 33 + n;
        u32x4 o; o.x = cvt_pk_bf16(s[0 * 33], s[1 * 33]); o.y = cvt_pk_bf16(s[2 * 33], s[3 * 33]); o.z = cvt_pk_bf16(s[4 * 33], s[5 * 33]); o.w = cvt_pk_bf16(s[6 * 33], s[7 * 33]);
        *(u32x4*)(WT + (size_t)(d0 + n) * K + k0 + 8 * c) = o; }
    asm volatile("s_waitcnt lgkmcnt(0)" ::: "memory");
}
__device__ __forceinline__ void xpose_region(const Args& a, int layer, int region, float* scr, int gw, int NGW, int lane) {
    if (region == 0) {
        const float* w_in = a.in[6] + (size_t)layer * 2048 * 10304; const float* w_glu = a.in[15] + (size_t)layer * 1024 * 2048; const float* w_s5p = a.in[16] + (size_t)layer * 1024 * 2048;
        const float* w_ssdp = a.in[23] + (size_t)layer * 2048 * 2048; const float* w_out = a.in[24] + (size_t)layer * 2048 * 2048;
        bf16_t* WA = (bf16_t*)(a.ws + WS_WA);
        constexpr int I_IN = 32 * 328, I_GLU = 16 * 64, I_S5P = 16 * 64, I_SSDP = 32 * 64, I_WOUT = 32 * 64, NI = I_IN + I_GLU + I_S5P + I_SSDP + I_WOUT;
        for (int it = gw; it < NI; it += NGW) { int r = it;
            if (r < I_IN) { const int kb = r / 328, d0 = (r % 328) * 32; int s0; if (d0 < 4096) s0 = d0; else if (d0 < 10240) s0 = d0 + 64; else if (d0 < 10304) s0 = d0 - 10240 + 4096; else s0 = -1;
                xpose_item(w_in, 2048, 10304, WA + WA_IN / 2, d0, s0, kb * 64, scr, lane); continue; } r -= I_IN;
            if (r < I_GLU) { const int kb = r / 64, d0 = (r % 64) * 32, t = d0 >> 8, j = d0 & 255; const int s0 = j < 128 ? t * 128 + j : 1024 + t * 128 + (j - 128);
                xpose_item(w_glu, 1024, 2048, WA + WA_GLU / 2, d0, s0, kb * 64, scr, lane); continue; } r -= I_GLU;
            if (r < I_S5P) { const int kb = r / 64, d0 = (r % 64) * 32; xpose_item(w_s5p, 1024, 2048, WA + WA_S5P / 2, d0, d0, kb * 64, scr, lane); continue; } r -= I_S5P;
            if (r < I_SSDP) { const int kb = r / 64, d0 = (r % 64) * 32; xpose_item(w_ssdp, 2048, 2048, WA + WA_SSDP / 2, d0, d0, kb * 64, scr, lane); continue; } r -= I_SSDP;
            { const int kb = r / 64, d0 = (r % 64) * 32; xpose_item(w_out, 2048, 2048, WA + WA_WOUT / 2, d0, d0, kb * 64, scr, lane); }
        }
    } else {
        const float* w_up = a.in[27] + (size_t)layer * 2048 * 11264; const float* w_down = a.in[30] + (size_t)layer * 5632 * 2048;
        bf16_t* WB = (bf16_t*)(a.ws + WS_WB);
        constexpr int I_UP = 32 * 352, I_DOWN = 88 * 64, NI = I_UP + I_DOWN;
        for (int it = gw; it < NI; it += NGW) { int r = it;
            if (r < I_UP) { const int kb = r / 352, d0 = (r % 352) * 32; xpose_item(w_up, 2048, 11264, WB + WB_UP / 2, d0, d0, kb * 64, scr, lane); continue; } r -= I_UP;
            { const int kb = r / 64, d0 = (r % 64) * 32; xpose_item(w_down, 5632, 2048, WB + WB_DOWN / 2, d0, d0, kb * 64, scr, lane); }
        }
    }
}

__device__ __forceinline__ void adaln_phase(const Args& a, float* lds, int tid) {
    float* sc = lds; float* scx = lds + 2048; float* red = lds + 4096;
    for (int i = tid; i < 2048; i += 512) { sc[i] = silu_(a.in[1][i]); scx[i] = silu_(a.in[3][i]); }
    __syncthreads();
    for (int unit = blockIdx.x; unit < 256; unit += gridDim.x) {
        const int layer = unit >> 7, col0 = (unit & 127) * 96;
        const float* W = a.in[4] + (size_t)layer * 2048 * 12288 + col0;
        if (tid < 504) { const int cq = tid % 24, ks = tid / 24; f32x4 al = {0.f, 0.f, 0.f, 0.f}, ac = {0.f, 0.f, 0.f, 0.f};
#pragma unroll 7
            for (int k = ks; k < 2048; k += 21) { const f32x4 w = *(const f32x4*)(W + (size_t)k * 12288 + cq * 4); al += w * sc[k]; ac += w * scx[k]; }
            *(f32x4*)(red + (ks * 2 + 0) * 96 + cq * 4) = al; *(f32x4*)(red + (ks * 2 + 1) * 96 + cq * 4) = ac; }
        __syncthreads();
        if (tid < 192) { const int v = tid / 96, c = tid % 96; float s = 0.f; for (int ks = 0; ks < 21; ++ks) s += red[(ks * 2 + v) * 96 + c];
            ((float*)(a.ws + WS_MVEC))[(size_t)(layer * 2 + v) * 12288 + col0 + c] = s + a.in[5][(size_t)layer * 12288 + col0 + c]; }
        __syncthreads();
    }
}

__device__ __forceinline__ float wave_sum(float v) {
#pragma unroll
    for (int o = 1; o < 64; o <<= 1) v += __shfl_xor(v, o);
    return v;
}
template <int MODE> __device__ __forceinline__ void row_phase(const Args& a, int nrows, const float* lng, const float* lnb, int mod_layer, int mod_off, int gw, int NGW, int lane) {
    bf16_t* XM = (bf16_t*)(a.ws + WS_XM);
    for (int row = gw; row < nrows; row += NGW) {
        const int isctx = row >= TL; float* h = hrow(a, row);
        const float* src = MODE == 0 ? (isctx ? a.in[2] + (size_t)(row - TL) * D : a.in[0] + (size_t)row * D) : h;
        f32x4 v[8];
#pragma unroll
        for (int j = 0; j < 8; ++j) v[j] = *(const f32x4*)(src + 4 * lane + 256 * j);
        if (MODE == 1) {
            float s = 0.f;
#pragma unroll
            for (int j = 0; j < 8; ++j) s += (v[j][0] + v[j][1]) + (v[j][2] + v[j][3]);
            const float mean = wave_sum(s) * (1.f / D); float q = 0.f;
#pragma unroll
            for (int j = 0; j < 8; ++j) { v[j] = v[j] - mean; q += (v[j][0] * v[j][0] + v[j][1] * v[j][1]) + (v[j][2] * v[j][2] + v[j][3] * v[j][3]); }
            const float rstd = 1.f / sqrtf(wave_sum(q) * (1.f / D) + LN_EPS);
#pragma unroll
            for (int j = 0; j < 8; ++j) { const f32x4 g = *(const f32x4*)(lng + 4 * lane + 256 * j), b = *(const f32x4*)(lnb + 4 * lane + 256 * j); v[j] = v[j] * rstd * g + b; }
        }
#ifdef MK_SANITIZE
#pragma unroll
        for (int j = 0; j < 8; ++j)
#pragma unroll
            for (int e = 0; e < 4; ++e) if (!(fabsf(v[j][e]) < 1e30f)) v[j][e] = 0.f;
#endif
#pragma unroll
        for (int j = 0; j < 8; ++j) *(f32x4*)(h + 4 * lane + 256 * j) = v[j];
        if (mod_layer >= 0) { const float* m = mvec(a, mod_layer, isctx) + mod_off;
#pragma unroll
            for (int j = 0; j < 8; ++j) { const f32x4 sh = *(const f32x4*)(m + 4 * lane + 256 * j), scl = *(const f32x4*)(m + D + 4 * lane + 256 * j); const f32x4 o = v[j] * (scl + 1.f) + sh;
                u32x2 w; w.x = cvt_pk_bf16(o[0], o[1]); w.y = cvt_pk_bf16(o[2], o[3]); *(u32x2*)(XM + (size_t)row * D + 4 * lane + 256 * j) = w; } }
    }
}

__device__ __forceinline__ void ffnconv_ctx(const Args& a, int layer, int tid) {
    const bf16_t* G = (const bf16_t*)(a.ws + WS_BIG + B_G); bf16_t* V = (bf16_t*)(a.ws + WS_BIG + B_V);
    const float* cw = a.in[28] + (size_t)layer * 9 * DFF; const float* cb = a.in[29] + (size_t)layer * DFF;
    const int nunits = 260 * 11; const int oc = tid & 63, xs = tid >> 6;
    for (int unit = 256 * 11 + blockIdx.x; unit < nunits; unit += gridDim.x) {
        const int seg = unit / 11, ob = unit % 11, ch0 = ob * 512 + oc * 8; const bool cs = seg >= 256; const int t0 = seg * 64;
        float w[9][8], bias[8];
#pragma unroll
        for (int k = 0; k < 9; ++k) { const f32x4 w0 = *(const f32x4*)(cw + (size_t)k * DFF + ch0), w1 = *(const f32x4*)(cw + (size_t)k * DFF + ch0 + 4);
            w[k][0] = w0[0]; w[k][1] = w0[1]; w[k][2] = w0[2]; w[k][3] = w0[3]; w[k][4] = w1[0]; w[k][5] = w1[1]; w[k][6] = w1[2]; w[k][7] = w1[3]; }
        { const f32x4 b0 = *(const f32x4*)(cb + ch0), b1 = *(const f32x4*)(cb + ch0 + 4); bias[0] = b0[0]; bias[1] = b0[1]; bias[2] = b0[2]; bias[3] = b0[3]; bias[4] = b1[0]; bias[5] = b1[1]; bias[6] = b1[2]; bias[7] = b1[3]; }
#pragma unroll 4
        for (int xi = 0; xi < 8; ++xi) { const int x = xs * 8 + xi, t = t0 + x; float acc[8];
#pragma unroll
            for (int k = 0; k < 8; ++k) acc[k] = bias[k];
#pragma unroll
            for (int dy = -1; dy <= 1; ++dy) { bool rok = cs ? (dy == 0) : ((dy < 0 ? seg > 0 : true) && (dy > 0 ? seg < 255 : true));
#pragma unroll
                for (int dx = -1; dx <= 1; ++dx) { const bool ok = rok && (cs ? (t + dx >= TL && t + dx < MT) : (x + dx >= 0 && x + dx < 64));
                    if (ok) { const u32x4 g = *(const u32x4*)(G + (size_t)(t + dy * 64 + dx) * DFF + ch0); const int k = (dy + 1) * 3 + dx + 1;
                        acc[0] += w[k][0] * bflo(g.x); acc[1] += w[k][1] * bfhi(g.x); acc[2] += w[k][2] * bflo(g.y); acc[3] += w[k][3] * bfhi(g.y);
                        acc[4] += w[k][4] * bflo(g.z); acc[5] += w[k][5] * bfhi(g.z); acc[6] += w[k][6] * bflo(g.w); acc[7] += w[k][7] * bfhi(g.w); } } }
            bf16_t* vp = V + (size_t)t * DFF + ch0; const u32x4 vv = *(const u32x4*)vp;
            u32x4 o; o.x = cvt_pk_bf16(silu_(acc[0]) * bflo(vv.x), silu_(acc[1]) * bfhi(vv.x)); o.y = cvt_pk_bf16(silu_(acc[2]) * bflo(vv.y), silu_(acc[3]) * bfhi(vv.y));
            o.z = cvt_pk_bf16(silu_(acc[4]) * bflo(vv.z), silu_(acc[5]) * bfhi(vv.z)); o.w = cvt_pk_bf16(silu_(acc[6]) * bflo(vv.w), silu_(acc[7]) * bfhi(vv.w));
            *(u32x4*)vp = o; }
    }
}

__device__ __forceinline__ void ffnconv_phase(const Args& a, int layer, bool with_ctx, unsigned char* lds, int tid) {
    const bf16_t* G = (const bf16_t*)(a.ws + WS_BIG + B_G); bf16_t* V = (bf16_t*)(a.ws + WS_BIG + B_V);
    const float* cw = a.in[28] + (size_t)layer * 9 * DFF; const float* cb = a.in[29] + (size_t)layer * DFF;
    bf16_t* T = (bf16_t*)lds;
    const int oc = tid & 15, ts = tid >> 4;
    for (int unit = blockIdx.x; unit < 64 * 44; unit += gridDim.x) {
        const int rg = unit / 44, ch0 = (unit % 44) * 128 + oc * 8, y0 = rg * 4;
        __syncthreads();
#pragma unroll
        for (int i = 0; i < 12; ++i) { const int idx = tid + i * 512, r = idx >> 10, x = (idx >> 4) & 63, y = y0 - 1 + r; const bool ok = y >= 0 && y < 256;
            u32x4 v = *(const u32x4*)(G + (size_t)((ok ? y : y0) * 64 + x) * DFF + ch0); if (!ok) v = (u32x4){0u, 0u, 0u, 0u};
            *(u32x4*)(T + ((r * 64 + x) * 128 + oc * 8)) = v; }
        u32x4 vv[8];
#pragma unroll
        for (int o = 0; o < 8; ++o) vv[o] = *(const u32x4*)(V + (size_t)((y0 + (o >> 1)) * 64 + ts * 2 + (o & 1)) * DFF + ch0);
        float w[9][8], bias[8];
#pragma unroll
        for (int k = 0; k < 9; ++k) { const f32x4 w0 = *(const f32x4*)(cw + (size_t)k * DFF + ch0), w1 = *(const f32x4*)(cw + (size_t)k * DFF + ch0 + 4);
            w[k][0] = w0[0]; w[k][1] = w0[1]; w[k][2] = w0[2]; w[k][3] = w0[3]; w[k][4] = w1[0]; w[k][5] = w1[1]; w[k][6] = w1[2]; w[k][7] = w1[3]; }
        { const f32x4 b0 = *(const f32x4*)(cb + ch0), b1 = *(const f32x4*)(cb + ch0 + 4); bias[0] = b0[0]; bias[1] = b0[1]; bias[2] = b0[2]; bias[3] = b0[3]; bias[4] = b1[0]; bias[5] = b1[1]; bias[6] = b1[2]; bias[7] = b1[3]; }
        __syncthreads();
#pragma unroll
        for (int o = 0; o < 8; ++o) { const int rr = o >> 1, x = ts * 2 + (o & 1); float acc[8];
#pragma unroll
            for (int k = 0; k < 8; ++k) acc[k] = bias[k];
#pragma unroll
            for (int dy = -1; dy <= 1; ++dy)
#pragma unroll
                for (int dx = -1; dx <= 1; ++dx) { const int xn = x + dx; const bool ok = xn >= 0 && xn < 64;
                    u32x4 g = *(const u32x4*)(T + (((rr + 1 + dy) * 64 + (ok ? xn : x)) * 128 + oc * 8)); if (!ok) g = (u32x4){0u, 0u, 0u, 0u}; const int k = (dy + 1) * 3 + dx + 1;
                    acc[0] += w[k][0] * bflo(g.x); acc[1] += w[k][1] * bfhi(g.x); acc[2] += w[k][2] * bflo(g.y); acc[3] += w[k][3] * bfhi(g.y);
                    acc[4] += w[k][4] * bflo(g.z); acc[5] += w[k][5] * bfhi(g.z); acc[6] += w[k][6] * bflo(g.w); acc[7] += w[k][7] * bfhi(g.w); }
            const u32x4 v = vv[o];
            u32x4 q; q.x = cvt_pk_bf16(silu_(acc[0]) * bflo(v.x), silu_(acc[1]) * bfhi(v.x)); q.y = cvt_pk_bf16(silu_(acc[2]) * bflo(v.y), silu_(acc[3]) * bfhi(v.y));
            q.z = cvt_pk_bf16(silu_(acc[4]) * bflo(v.z), silu_(acc[5]) * bfhi(v.z)); q.w = cvt_pk_bf16(silu_(acc[6]) * bflo(v.w), silu_(acc[7]) * bfhi(v.w));
            *(u32x4*)(V + (size_t)((y0 + rr) * 64 + x) * DFF + ch0) = q; }
    }
    __syncthreads();
    if (with_ctx) ffnconv_ctx(a, layer, tid);
}
__device__ __forceinline__ int s5_chunk_at(int dir, int q) { return dir ? 129 - q : (q + 128) % 130; }
__device__ __forceinline__ int s5_pos_of(int dir, int c) { return dir ? 129 - c : (c + 2) % 130; }
template <int PASS> __device__ __forceinline__ void s5_phase(const Args& a, int layer, unsigned char* lds, int tid, int nchunks) {
    constexpr int BUP = 132;
    const bf16_t* U5 = (const bf16_t*)(a.ws + WS_BIG + B_U5); bf16_t* Y5 = (bf16_t*)(a.ws + WS_BIG + B_Y5);
    float2* S5LOC = (float2*)(a.ws + WS_S5LOC);
    const int lane = tid & 63, w = tid >> 6, gl = w >> 1, dir = w & 1, p = lane, fr = lane & 15, fq = lane >> 4;
    float* BuW = (float*)lds + (size_t)w * (16 * BUP);
    bf16_t* STw = (bf16_t*)(lds + 67584) + (size_t)w * (16 * 136);
    float* YL = (float*)(lds + 102400);
    const int gq = blockIdx.x & 15, g = gq * 4 + gl;
    float ab_re, ab_im, a128r, a128i;
    const float step = expf(a.in[9][(size_t)(layer * 2 + dir) * 64 + g]);
    { const size_t pi = ((size_t)(layer * 2 + dir) * 64 + g) * 64 + p; const float lre = fminf(a.in[7][pi], -1e-4f), lim = a.in[8][pi];
      const float mag = expf(lre * step); float sn, cs; sincosf(lim * step, &sn, &cs); ab_re = mag * cs; ab_im = mag * sn; a128r = ab_re; a128i = ab_im;
#pragma unroll
      for (int k = 0; k < 7; ++k) { const float r = a128r * a128r - a128i * a128i, i = 2.f * a128r * a128i; a128r = r; a128i = i; } }
    bf16x8 bbf[8];
#pragma unroll
    for (int nt = 0; nt < 8; ++nt) { const int pp = nt * 8 + (fr >> 1), cc = fr & 1; const size_t pi = ((size_t)(layer * 2 + dir) * 64 + g) * 64 + pp;
        const float lre = fminf(a.in[7][pi], -1e-4f), lim = a.in[8][pi]; const float mag = expf(lre * step); float sn, cs; sincosf(lim * step, &sn, &cs);
        const float are = mag * cs, aim = mag * sn, den = lre * lre + lim * lim, q_re = ((are - 1.f) * lre + aim * lim) / den, q_im = (aim * lre - (are - 1.f) * lim) / den;
        const float* br = a.in[10] + (((size_t)layer * 64 + g) * 64 + pp) * 16 + (fq & 1) * 8; const float* bi = a.in[11] + (((size_t)layer * 64 + g) * 64 + pp) * 16 + (fq & 1) * 8;
        const f32x4 r0 = *(const f32x4*)br, r1 = *(const f32x4*)(br + 4), i0 = *(const f32x4*)bi, i1 = *(const f32x4*)(bi + 4); float v[8];
#pragma unroll
        for (int j = 0; j < 8; ++j) { const float r = j < 4 ? r0[j & 3] : r1[j & 3], i = j < 4 ? i0[j & 3] : i1[j & 3]; v[j] = fq < 2 ? (cc ? q_re * i + q_im * r : q_re * r - q_im * i) : 0.f; }
        bbf[nt] = mkfrag(cvt_pk_bf16(v[0], v[1]), cvt_pk_bf16(v[2], v[3]), cvt_pk_bf16(v[4], v[5]), cvt_pk_bf16(v[6], v[7])); }
    bf16x8 cm[4];
    if (PASS == 1) {
        const float* cre = a.in[12] + (((size_t)(layer * 2 + dir) * 64 + g) * 16 + fr) * 64; const float* cim = a.in[13] + (((size_t)(layer * 2 + dir) * 64 + g) * 16 + fr) * 64;
#pragma unroll
        for (int ks = 0; ks < 4; ++ks) { const f32x4 r = *(const f32x4*)(cre + ks * 16 + fq * 4), i = *(const f32x4*)(cim + ks * 16 + fq * 4);
            cm[ks] = mkfrag(cvt_pk_bf16(r[0], -i[0]), cvt_pk_bf16(r[1], -i[1]), cvt_pk_bf16(r[2], -i[2]), cvt_pk_bf16(r[3], -i[3])); }
    }
    const int cstep = gridDim.x >> 4;
    for (int c = blockIdx.x >> 4; c < nchunks; c += cstep) {
        const int row0 = c * 128;
        bf16x8 uf[8];
#pragma unroll
        for (int k = 0; k < 8; ++k) { const int sl = dir ? 7 - k : k; const u32x4 v = *(const u32x4*)(U5 + (size_t)(row0 + sl * 16 + fr) * 1024 + g * 16 + (fq & 1) * 8);
            uf[k] = fq < 2 ? __builtin_bit_cast(bf16x8, v) : mkfrag(0u, 0u, 0u, 0u); }
        float sr = 0.f, si = 0.f;
        if (PASS == 1) {
            const int pos = s5_pos_of(dir, c);
#pragma unroll 1
            for (int q0 = 0; q0 < pos; q0 += 13) { float2 l[13];
#pragma unroll
                for (int i = 0; i < 13; ++i) { const int q = q0 + i < pos ? q0 + i : pos - 1; l[i] = S5LOC[((size_t)(dir * NCH + s5_chunk_at(dir, q)) * 64 + g) * 64 + p]; }
#pragma unroll
                for (int i = 0; i < 13; ++i) if (q0 + i < pos) { const float nr = a128r * sr - a128i * si + l[i].x, ni = a128r * si + a128i * sr + l[i].y; sr = nr; si = ni; } }
        }
        f32x4 yacc[8];
#pragma unroll
        for (int k = 0; k < 8; ++k) {
#pragma unroll
            for (int nt = 0; nt < 8; ++nt) { f32x4 acc = {0.f, 0.f, 0.f, 0.f}; acc = __builtin_amdgcn_mfma_f32_16x16x32_bf16(uf[k], bbf[nt], acc, 0, 0, 0);
#pragma unroll
                for (int jj = 0; jj < 4; ++jj) BuW[(fq * 4 + jj) * BUP + nt * 16 + fr] = acc[jj]; }
            asm volatile("s_waitcnt lgkmcnt(0)" ::: "memory");
#pragma unroll
            for (int ii = 0; ii < 16; ++ii) { const int tl = dir ? 15 - ii : ii; const f32x2 b2 = *(const f32x2*)(BuW + tl * BUP + 2 * p);
                f32x2 ns = __builtin_elementwise_fma((f32x2){ab_re, ab_re}, (f32x2){sr, si}, b2); ns = __builtin_elementwise_fma((f32x2){-ab_im, ab_im}, (f32x2){si, sr}, ns); sr = ns[0]; si = ns[1];
                if (PASS == 1) *(unsigned*)(STw + tl * 136 + 2 * p) = cvt_pk_bf16(sr, si); }
            if (PASS == 1) {
                asm volatile("s_waitcnt lgkmcnt(0)" ::: "memory");
                f32x4 acc = {0.f, 0.f, 0.f, 0.f};
#pragma unroll
                for (int ks = 0; ks < 4; ++ks) acc = __builtin_amdgcn_mfma_f32_16x16x32_bf16(*(const bf16x8*)(STw + fr * 136 + ks * 32 + fq * 8), cm[ks], acc, 0, 0, 0);
                yacc[k] = acc;
            }
            asm volatile("s_waitcnt lgkmcnt(0)" ::: "memory");
        }
        if (PASS == 0) { S5LOC[((size_t)(dir * NCH + c) * 64 + g) * 64 + p] = make_float2(sr, si); }
        else {
            __syncthreads();
            if (dir == 0) {
#pragma unroll
                for (int k = 0; k < 8; ++k)
#pragma unroll
                    for (int jj = 0; jj < 4; ++jj) YL[gl * 2048 + (k * 16 + fq * 4 + jj) * 16 + fr] = yacc[k][jj]; }
            __syncthreads();
            if (dir == 1) {
#pragma unroll
                for (int k = 0; k < 8; ++k)
#pragma unroll
                    for (int jj = 0; jj < 4; ++jj) YL[gl * 2048 + ((7 - k) * 16 + fq * 4 + jj) * 16 + fr] += yacc[k][jj]; }
            __syncthreads();
            const int t = tid >> 2, q = tid & 3; const float* y = YL + q * 2048 + t * 16; const float* dd = a.in[14] + (size_t)layer * 1024 + gq * 64 + q * 16;
            const bf16_t* us = U5 + (size_t)(row0 + t) * 1024 + gq * 64 + q * 16; const u32x4 u0 = *(const u32x4*)us, u1 = *(const u32x4*)(us + 8);
            const float u[16] = {bflo(u0.x), bfhi(u0.x), bflo(u0.y), bfhi(u0.y), bflo(u0.z), bfhi(u0.z), bflo(u0.w), bfhi(u0.w), bflo(u1.x), bfhi(u1.x), bflo(u1.y), bfhi(u1.y), bflo(u1.z), bfhi(u1.z), bflo(u1.w), bfhi(u1.w)};
            unsigned o[8];
#pragma unroll
            for (int j = 0; j < 8; ++j) { const float y0 = y[2 * j] + u[2 * j] * dd[2 * j], y1 = y[2 * j + 1] + u[2 * j + 1] * dd[2 * j + 1]; o[j] = cvt_pk_bf16(gelu_tanh(y0), gelu_tanh(y1)); }
            bf16_t* dst = Y5 + (size_t)(row0 + t) * 1024 + gq * 64 + q * 16; u32x4 o0, o1; o0.x = o[0]; o0.y = o[1]; o0.z = o[2]; o0.w = o[3]; o1.x = o[4]; o1.y = o[5]; o1.z = o[6]; o1.w = o[7];
            *(u32x4*)dst = o0; *(u32x4*)(dst + 8) = o1;
        }
    }
    __syncthreads();
}

__device__ __forceinline__ int ssd_chunk_at(int dir, int q) { return s5_chunk_at(dir, q); }
__device__ __forceinline__ void conv8(const bf16_t* XBC, int rowbase, int l0, int ch, bool lo_ok, bool hi_ok, float w0, float w1, float w2, float b, float (&out)[8]) {
    float r[10];
#pragma unroll
    for (int i = 0; i < 10; ++i) { const int l = l0 - 1 + i; const bool ok = (l >= 0 || lo_ok) && (l < 128 || hi_ok); r[i] = ok ? bf2f((unsigned)XBC[(size_t)(rowbase + l) * 3072 + ch]) : 0.f; }
#pragma unroll
    for (int j = 0; j < 8; ++j) out[j] = silu_(w0 * r[j] + w1 * r[j + 1] + w2 * r[j + 2] + b);
}
__device__ __forceinline__ void stage_conv_tile(const bf16_t* XBC, const float* cw, const float* cb, int rowbase, int chbase, bool lo_ok, bool hi_ok, bf16_t* dst, int tid) {
    const int oc = tid & 15, ch = chbase + oc * 8; float w[3][8], b[8];
#pragma unroll
    for (int k = 0; k < 3; ++k) { const f32x4 a0 = *(const f32x4*)(cw + (size_t)k * 3072 + ch), a1 = *(const f32x4*)(cw + (size_t)k * 3072 + ch + 4);
        w[k][0] = a0[0]; w[k][1] = a0[1]; w[k][2] = a0[2]; w[k][3] = a0[3]; w[k][4] = a1[0]; w[k][5] = a1[1]; w[k][6] = a1[2]; w[k][7] = a1[3]; }
    { const f32x4 a0 = *(const f32x4*)(cb + ch), a1 = *(const f32x4*)(cb + ch + 4); b[0] = a0[0]; b[1] = a0[1]; b[2] = a0[2]; b[3] = a0[3]; b[4] = a1[0]; b[5] = a1[1]; b[6] = a1[2]; b[7] = a1[3]; }
#pragma unroll
    for (int i = 0; i < 4; ++i) { const int row = (tid >> 4) + i * 32; float acc[8];
#pragma unroll
        for (int k = 0; k < 8; ++k) acc[k] = b[k];
#pragma unroll
        for (int d = 0; d < 3; ++d) { const bool ok = d == 1 ? true : (d == 0 ? (row > 0 || lo_ok) : (row < 127 || hi_ok)); const int l = ok ? row + d - 1 : row;
            { u32x4 g = *(const u32x4*)(XBC + (size_t)(rowbase + l) * 3072 + ch); if (!ok) g = (u32x4){0u, 0u, 0u, 0u};
                acc[0] += w[d][0] * bflo(g.x); acc[1] += w[d][1] * bfhi(g.x); acc[2] += w[d][2] * bflo(g.y); acc[3] += w[d][3] * bfhi(g.y);
                acc[4] += w[d][4] * bflo(g.z); acc[5] += w[d][5] * bfhi(g.z); acc[6] += w[d][6] * bflo(g.w); acc[7] += w[d][7] * bfhi(g.w); } }
        u32x4 o; o.x = cvt_pk_bf16(silu_(acc[0]), silu_(acc[1])); o.y = cvt_pk_bf16(silu_(acc[2]), silu_(acc[3])); o.z = cvt_pk_bf16(silu_(acc[4]), silu_(acc[5])); o.w = cvt_pk_bf16(silu_(acc[6]), silu_(acc[7]));
        *(u32x4*)(dst + row * 136 + oc * 8) = o; }
}
constexpr int SL_CS = 0, SL_CB = 34816, SL_CUM = 69632, SL_DT = 77824, SL_PART = 86016, SL_BS = 94208, SL_XT = 94208;
template <int AUX> __device__ __forceinline__ void ssd_cum(const Args& a, int layer, int c, int h, int w, int lane, unsigned char* lds) {
    const float* DT = (const float*)(a.ws + WS_BIG + B_DT); float* cumL = (float*)(lds + SL_CUM); float* dtL = (float*)(lds + SL_DT); float* CHD = (float*)(a.ws + WS_CHD);
#pragma unroll
    for (int dir = 0; dir < 2; ++dir) {
        const float ah = -expf(a.in[20][(size_t)(layer * 2 + dir) * 32 + h]);
        const float d0 = DT[(size_t)(c * 128 + 2 * lane) * 64 + dir * 32 + h], d1 = DT[(size_t)(c * 128 + 2 * lane + 1) * 64 + dir * 32 + h];
        const float l0 = d0 * ah, l1 = d1 * ah, s = l0 + l1; float incl = s;
#pragma unroll
        for (int o = 1; o < 64; o <<= 1) { const float t = __shfl_up(incl, o); if (lane >= o) incl += t; }
        const float excl = incl - s, tot = __shfl(incl, 63);
        float c0, c1;
        if (dir == 0) { c0 = excl + l0; c1 = incl; } else { c0 = tot - excl; c1 = tot - (excl + l0); }
        float* cu = cumL + (dir * 8 + w) * 128 + 2 * lane; cu[0] = c0; cu[1] = c1;
        float* dd = dtL + (dir * 8 + w) * 128 + 2 * lane;
        if (AUX == 0) { dd[0] = d0; dd[1] = d1; } else { dd[0] = d0 * __expf(tot - c0); dd[1] = d1 * __expf(tot - c1); if (lane == 0) CHD[(size_t)(dir * NCH + c) * 32 + h] = tot; }
    }
}
__device__ __forceinline__ void stage_T(const bf16_t* XBC, const float* cw, const float* cb, int rowbase, int ch, int r0, bool lo_ok, bool hi_ok, bf16_t* dstT) {
    float w[3][8], b[8];
#pragma unroll
    for (int k = 0; k < 3; ++k) { const f32x4 a0 = *(const f32x4*)(cw + (size_t)k * 3072 + ch), a1 = *(const f32x4*)(cw + (size_t)k * 3072 + ch + 4);
        w[k][0] = a0[0]; w[k][1] = a0[1]; w[k][2] = a0[2]; w[k][3] = a0[3]; w[k][4] = a1[0]; w[k][5] = a1[1]; w[k][6] = a1[2]; w[k][7] = a1[3]; }
    { const f32x4 a0 = *(const f32x4*)(cb + ch), a1 = *(const f32x4*)(cb + ch + 4); b[0] = a0[0]; b[1] = a0[1]; b[2] = a0[2]; b[3] = a0[3]; b[4] = a1[0]; b[5] = a1[1]; b[6] = a1[2]; b[7] = a1[3]; }
    u32x4 raw[10];
    const bf16_t* base = XBC + (size_t)(rowbase + r0) * 3072 + ch;
    const bool ok0 = r0 > 0 || lo_ok, ok9 = r0 < 120 || hi_ok;
#pragma unroll
    for (int i = 1; i < 9; ++i) raw[i] = *(const u32x4*)(base + (i - 1) * 3072);
    { const u32x4 v = *(const u32x4*)(base + (ok0 ? -3072 : 0)); raw[0] = ok0 ? v : (u32x4){0u, 0u, 0u, 0u}; }
    { const u32x4 v = *(const u32x4*)(base + (ok9 ? 8 * 3072 : 7 * 3072)); raw[9] = ok9 ? v : (u32x4){0u, 0u, 0u, 0u}; }
    float sp[8]; unsigned o[8][4];
#pragma unroll
    for (int r = 0; r < 8; ++r) { float sv[8];
#pragma unroll
        for (int k = 0; k < 8; ++k) { float acc = b[k];
#pragma unroll
            for (int d = 0; d < 3; ++d) { const unsigned wd = k < 2 ? raw[r + d].x : (k < 4 ? raw[r + d].y : (k < 6 ? raw[r + d].z : raw[r + d].w)); acc += w[d][k] * ((k & 1) ? bfhi(wd) : bflo(wd)); }
            sv[k] = silu_(acc); }
        if (r & 1) {
#pragma unroll
            for (int k = 0; k < 8; ++k) o[k][r >> 1] = cvt_pk_bf16(sp[k], sv[k]); }
        else {
#pragma unroll
            for (int k = 0; k < 8; ++k) sp[k] = sv[k]; } }
#pragma unroll
    for (int k = 0; k < 8; ++k) { u32x4 v; v.x = o[k][0]; v.y = o[k][1]; v.z = o[k][2]; v.w = o[k][3]; *(u32x4*)(dstT + k * 136 + r0) = v; }
}
__device__ __forceinline__ void ssd_a_phase(const Args& a, int layer, unsigned char* lds, int tid) {
    const bf16_t* XBC = (const bf16_t*)(a.ws + WS_BIG + B_XBC); bf16_t* SST = (bf16_t*)(a.ws + WS_SST);
    const float* cw = a.in[17] + (size_t)layer * 3 * 3072; const float* cb = a.in[18] + (size_t)layer * 3072;
    bf16_t* BT = (bf16_t*)(lds + SL_CS); bf16_t* xT = (bf16_t*)(lds + SL_XT); const float* wL = (const float*)(lds + SL_DT);
    for (int unit = blockIdx.x; unit < NCH * 4; unit += gridDim.x) {
        int tl = tid; asm volatile("" : "+v"(tl));
        const int lane = tl & 63, w = __builtin_amdgcn_readfirstlane(tl >> 6), fr = lane & 15, fq = lane >> 4, og = lane & 7, rr = lane >> 3;
        const int c = unit >> 2, g = unit & 3, rowbase = c * 128; const bool lo_ok = !(c == 0 || c == 128), hi_ok = !(c == 127 || c == 129);
        __syncthreads();
        if (w < 4) { const int oct = (w & 1) * 8 + og; stage_T(XBC, cw, cb, rowbase, 2048 + g * 128 + oct * 8, ((w >> 1) * 8 + rr) * 8, lo_ok, hi_ok, BT + (oct * 8) * 136); }
        ssd_cum<1>(a, layer, c, g * 8 + w, w, lane, lds);
#pragma unroll 1
        for (int pass = 0; pass < 2; ++pass) {
            if (pass) __syncthreads();
            { const int hs = w & 3; stage_T(XBC, cw, cb, rowbase, (g * 8 + pass * 4 + hs) * 64 + og * 8, ((w >> 2) * 8 + rr) * 8, lo_ok, hi_ok, xT + ((hs * 64 + og * 8) * 136)); }
            __syncthreads();
            const int hl = w >> 1, dir = w & 1, hh = pass * 4 + hl, h = g * 8 + hh;
            bf16_t* sb = SST + (((size_t)(dir * NCH + c) * 32 + h) * 64) * 128;
#pragma unroll 1
            for (int nh = 0; nh < 2; ++nh) {
                f32x4 acc[4][4];
#pragma unroll
                for (int pt = 0; pt < 4; ++pt)
#pragma unroll
                    for (int nt = 0; nt < 4; ++nt) acc[pt][nt] = (f32x4){0.f, 0.f, 0.f, 0.f};
#pragma unroll
                for (int ks = 0; ks < 4; ++ks) {
                    const float* wp = wL + (dir * 8 + hh) * 128 + ks * 32 + fq * 8; const f32x4 wl0 = *(const f32x4*)wp, wl1 = *(const f32x4*)(wp + 4);
                    bf16x8 yf[4];
#pragma unroll
                    for (int pt = 0; pt < 4; ++pt) { const u32x4 xr = *(const u32x4*)(xT + ((hl * 64 + pt * 16 + fr) * 136 + ks * 32 + fq * 8));
                        yf[pt] = mkfrag(cvt_pk_bf16(bflo(xr.x) * wl0[0], bfhi(xr.x) * wl0[1]), cvt_pk_bf16(bflo(xr.y) * wl0[2], bfhi(xr.y) * wl0[3]), cvt_pk_bf16(bflo(xr.z) * wl1[0], bfhi(xr.z) * wl1[1]), cvt_pk_bf16(bflo(xr.w) * wl1[2], bfhi(xr.w) * wl1[3])); }
#pragma unroll
                    for (int nt = 0; nt < 4; ++nt) { const bf16x8 xf = *(const bf16x8*)(BT + ((nh * 4 + nt) * 16 + fr) * 136 + ks * 32 + fq * 8);
#pragma unroll
                        for (int pt = 0; pt < 4; ++pt) acc[pt][nt] = __builtin_amdgcn_mfma_f32_16x16x32_bf16(xf, yf[pt], acc[pt][nt], 0, 0, 0); }
                }
#pragma unroll
                for (int pt = 0; pt < 4; ++pt) mfma_settle(acc[pt][3]);
#pragma unroll
                for (int pt = 0; pt < 4; ++pt)
#pragma unroll
                    for (int nt = 0; nt < 4; ++nt) { u32x2 o; o.x = cvt_pk_native(acc[pt][nt][0], acc[pt][nt][1]); o.y = cvt_pk_native(acc[pt][nt][2], acc[pt][nt][3]);
                        *(u32x2*)(sb + (size_t)(pt * 16 + fr) * 128 + (nh * 4 + nt) * 16 + fq * 4) = o; }
            }
        }
    }
    __syncthreads();
}
__device__ __forceinline__ void ssd_b_phase(const Args& a, int tid) {
    bf16_t* SST = (bf16_t*)(a.ws + WS_SST); const float* CHD = (const float*)(a.ws + WS_CHD);
    for (int idx = blockIdx.x * 512 + tid; idx < 64 * 2048; idx += gridDim.x * 512) {
        const int e4 = idx & 2047, hd = idx >> 11, dir = hd >> 5, h = hd & 31; float s0 = 0.f, s1 = 0.f, s2 = 0.f, s3 = 0.f;
#pragma unroll 1
        for (int b = 0; b < 13; ++b) { u32x2 loc[10]; float dc[10];
#pragma unroll
            for (int i = 0; i < 10; ++i) { const int cq = ssd_chunk_at(dir, b * 10 + i); loc[i] = *(const u32x2*)(SST + ((size_t)(dir * NCH + cq) * 32 + h) * 8192 + e4 * 4); dc[i] = CHD[(size_t)(dir * NCH + cq) * 32 + h]; }
#pragma unroll
            for (int i = 0; i < 10; ++i) { const int cq = ssd_chunk_at(dir, b * 10 + i); u32x2 o; o.x = cvt_pk_bf16(s0, s1); o.y = cvt_pk_bf16(s2, s3);
                *(u32x2*)(SST + ((size_t)(dir * NCH + cq) * 32 + h) * 8192 + e4 * 4) = o; const float e = __expf(dc[i]);
                s0 = e * s0 + bflo(loc[i].x); s1 = e * s1 + bfhi(loc[i].x); s2 = e * s2 + bflo(loc[i].y); s3 = e * s3 + bfhi(loc[i].y); }
        }
    }
}
__device__ __forceinline__ void ssd_c_phase(const Args& a, int layer, unsigned char* lds, int tid, int nchunks) {
    const bf16_t* XBC = (const bf16_t*)(a.ws + WS_BIG + B_XBC); const bf16_t* SST = (const bf16_t*)(a.ws + WS_SST); const bf16_t* Z = (const bf16_t*)(a.ws + WS_BIG + B_Z); bf16_t* YD = (bf16_t*)(a.ws + WS_BIG + B_YD);
    const float* cw = a.in[17] + (size_t)layer * 3 * 3072; const float* cb = a.in[18] + (size_t)layer * 3072; const float* normw = a.in[22] + (size_t)layer * 2048;
    bf16_t* Cs = (bf16_t*)(lds + SL_CS); bf16_t* Bs = (bf16_t*)(lds + SL_BS); bf16_t* CBs = (bf16_t*)(lds + SL_CB); bf16_t* xT = (bf16_t*)(lds + SL_XT);
    const float* cumL = (const float*)(lds + SL_CUM); const float* dtL = (const float*)(lds + SL_DT); float* part = (float*)(lds + SL_PART);
    for (int unit = blockIdx.x; unit < nchunks * 4; unit += gridDim.x) {
        int tl = tid; asm volatile("" : "+v"(tl));
        const int lane = tl & 63, w = __builtin_amdgcn_readfirstlane(tl >> 6), fr = lane & 15, fq = lane >> 4, og = lane & 7, rr = lane >> 3;
        const int hl = w & 3, lh = w >> 2;
        const int c = unit >> 2, g = unit & 3, rowbase = c * 128; const bool lo_ok = !(c == 0 || c == 128), hi_ok = !(c == 127 || c == 129);
        __syncthreads();
        stage_conv_tile(XBC, cw, cb, rowbase, 2560 + g * 128, lo_ok, hi_ok, Cs, tl);
        stage_conv_tile(XBC, cw, cb, rowbase, 2048 + g * 128, lo_ok, hi_ok, Bs, tl);
        ssd_cum<0>(a, layer, c, g * 8 + w, w, lane, lds);
        __syncthreads();
#pragma unroll 1
        for (int st = 0; st < 8; ++st) { f32x4 acc = {0.f, 0.f, 0.f, 0.f};
#pragma unroll
            for (int ks = 0; ks < 4; ++ks) { const bf16x8 xf = *(const bf16x8*)(Bs + (st * 16 + fr) * 136 + ks * 32 + fq * 8), yf = *(const bf16x8*)(Cs + (w * 16 + fr) * 136 + ks * 32 + fq * 8);
                acc = __builtin_amdgcn_mfma_f32_16x16x32_bf16(xf, yf, acc, 0, 0, 0); }
            mfma_settle(acc);
            u32x2 o; o.x = cvt_pk_native(acc[0], acc[1]); o.y = cvt_pk_native(acc[2], acc[3]); *(u32x2*)(CBs + (w * 16 + fr) * 136 + st * 16 + fq * 4) = o; }
#pragma unroll 1
        for (int pass = 0; pass < 2; ++pass) {
            __syncthreads();
            stage_T(XBC, cw, cb, rowbase, (g * 8 + pass * 4 + hl) * 64 + og * 8, (lh * 8 + rr) * 8, lo_ok, hi_ok, xT + ((hl * 64 + og * 8) * 136));
            __syncthreads();
            const int hh = pass * 4 + hl, h = g * 8 + hh; const float Dh = a.in[21][(size_t)layer * 32 + h];
#pragma unroll 1
            for (int ih = 0; ih < 2; ++ih) {
            f32x4 acc[2][4];
#pragma unroll
            for (int i = 0; i < 2; ++i)
#pragma unroll
                for (int pt = 0; pt < 4; ++pt) acc[i][pt] = (f32x4){0.f, 0.f, 0.f, 0.f};
#pragma unroll
            for (int dir = 0; dir < 2; ++dir) {
                const bf16_t* sb = SST + (((size_t)(dir * NCH + c) * 32 + h) * 64) * 128;
                f32x4 tmp[2][4];
#pragma unroll
                for (int i = 0; i < 2; ++i)
#pragma unroll
                    for (int pt = 0; pt < 4; ++pt) tmp[i][pt] = (f32x4){0.f, 0.f, 0.f, 0.f};
#pragma unroll
                for (int ks = 0; ks < 4; ++ks) { const int lb = (lh * 4 + ih * 2) * 16 + fr;
                    const bf16x8 yf0 = *(const bf16x8*)(Cs + lb * 136 + ks * 32 + fq * 8), yf1 = *(const bf16x8*)(Cs + (lb + 16) * 136 + ks * 32 + fq * 8);
#pragma unroll
                    for (int pt = 0; pt < 4; ++pt) { const bf16x8 sfr = *(const bf16x8*)(sb + (size_t)(pt * 16 + fr) * 128 + ks * 32 + fq * 8);
                        tmp[0][pt] = __builtin_amdgcn_mfma_f32_16x16x32_bf16(sfr, yf0, tmp[0][pt], 0, 0, 0); tmp[1][pt] = __builtin_amdgcn_mfma_f32_16x16x32_bf16(sfr, yf1, tmp[1][pt], 0, 0, 0); } }
#pragma unroll
                for (int i = 0; i < 2; ++i) { int frv = fr; asm volatile("" : "+v"(frv));
                    const int lt = lh * 4 + ih * 2 + i, l = lt * 16 + frv;
                    const float cl = cumL[(dir * 8 + hh) * 128 + l], el = __expf(cl);
#pragma unroll
                    for (int pt = 0; pt < 4; ++pt) acc[i][pt] += tmp[i][pt] * el;
#pragma unroll
                    for (int ks = 0; ks < 4; ++ks) { const int s0 = ks * 32;
                        const bool skip = dir == 0 ? (s0 > lt * 16 + 15) : (s0 + 31 < lt * 16);
                        if (!skip) { const u32x4 cbv = *(const u32x4*)(CBs + l * 136 + s0 + fq * 8);
                            const float* cp = cumL + (dir * 8 + hh) * 128 + s0 + fq * 8; const float* dp = dtL + (dir * 8 + hh) * 128 + s0 + fq * 8;
                            const f32x4 c0 = *(const f32x4*)cp, c1 = *(const f32x4*)(cp + 4), d0 = *(const f32x4*)dp, d1 = *(const f32x4*)(dp + 4);
                            float cbf[8] = {bflo(cbv.x), bfhi(cbv.x), bflo(cbv.y), bfhi(cbv.y), bflo(cbv.z), bfhi(cbv.z), bflo(cbv.w), bfhi(cbv.w)}; float v[8];
#pragma unroll
                            for (int j = 0; j < 8; ++j) { const int sx = s0 + fq * 8 + j; const float cs = j < 4 ? c0[j & 3] : c1[j & 3], ds = j < 4 ? d0[j & 3] : d1[j & 3];
                                const bool valid = dir == 0 ? (sx <= l) : (sx >= l); float t = valid ? cbf[j] * __expf(fminf(cl - cs, 0.f)) * ds : 0.f; if (dir == 0 && sx == l) t += Dh; v[j] = t; }
                            const bf16x8 yf = mkfrag(cvt_pk_bf16(v[0], v[1]), cvt_pk_bf16(v[2], v[3]), cvt_pk_bf16(v[4], v[5]), cvt_pk_bf16(v[6], v[7]));
#pragma unroll
                            for (int pt = 0; pt < 4; ++pt) acc[i][pt] = __builtin_amdgcn_mfma_f32_16x16x32_bf16(*(const bf16x8*)(xT + ((hl * 64 + pt * 16 + fr) * 136 + s0 + fq * 8)), yf, acc[i][pt], 0, 0, 0); } }
                }
            }
#pragma unroll
            for (int i = 0; i < 2; ++i) { const int l = (lh * 4 + ih * 2 + i) * 16 + fr; const size_t row = (size_t)(rowbase + l); float ss = 0.f;
#pragma unroll
                for (int pt = 0; pt < 4; ++pt) { const int ch = h * 64 + pt * 16 + fq * 4; const u32x2 zz = *(const u32x2*)(Z + row * 2048 + ch);
                    const float h0 = acc[i][pt][0] * silu_(bflo(zz.x)), h1 = acc[i][pt][1] * silu_(bfhi(zz.x)), h2 = acc[i][pt][2] * silu_(bflo(zz.y)), h3 = acc[i][pt][3] * silu_(bfhi(zz.y));
                    ss += (h0 * h0 + h1 * h1) + (h2 * h2 + h3 * h3); u32x2 o; o.x = cvt_pk_bf16(h0, h1); o.y = cvt_pk_bf16(h2, h3); *(u32x2*)(YD + row * 2048 + ch) = o; }
                ss += __shfl_xor(ss, 16); ss += __shfl_xor(ss, 32);
                if (fq == 0) part[hh * 128 + l] = ss; }
            }
        }
        __syncthreads();
#pragma unroll 1
        for (int it = 0; it < 8; ++it) { const int pass = it >> 2, i = it & 3, l = (lh * 4 + i) * 16 + fr, h = g * 8 + pass * 4 + hl; float tot = 0.f;
#pragma unroll
            for (int hd = 0; hd < 8; ++hd) tot += part[hd * 128 + l];
            const float r = 1.f / sqrtf(tot * (1.f / 512.f) + RMS_EPS); const size_t row = (size_t)(rowbase + l);
#pragma unroll
            for (int pt = 0; pt < 4; ++pt) { const int ch = h * 64 + pt * 16 + fq * 4; bf16_t* yp = YD + row * 2048 + ch; const u32x2 hv = *(const u32x2*)yp; const f32x4 nw = *(const f32x4*)(normw + ch);
                u32x2 o; o.x = cvt_pk_bf16(bflo(hv.x) * r * nw[0], bfhi(hv.x) * r * nw[1]); o.y = cvt_pk_bf16(bflo(hv.y) * r * nw[2], bfhi(hv.y) * r * nw[3]); *(u32x2*)yp = o; } }
    }
    __syncthreads();
}

#define LAS __attribute__((address_space(3)))
#define XB_TMO      128
#define XB_XCNT(j)  (256  + 64 * (j))
#define XB_XSUB(j)  (1280 + 64 * (j))
#define XB_XGEN(j)  (2304 + 64 * (j))
#define XB_TOP      3328
#define XB_TOPGEN   3392
#define XCD_BAR_WORDS 3456
#define XB_SPIN_CAP (1u << 18)

__device__ __forceinline__ unsigned xb_ld(unsigned* p)              { return __hip_atomic_load(p, __ATOMIC_RELAXED, __HIP_MEMORY_SCOPE_AGENT); }
__device__ __forceinline__ unsigned xb_add(unsigned* p, unsigned v) { return __hip_atomic_fetch_add(p, v, __ATOMIC_RELAXED, __HIP_MEMORY_SCOPE_AGENT); }
__device__ __forceinline__ unsigned xb_xcc_id() { return (unsigned)__builtin_amdgcn_s_getreg((3 << 11) | 20) & 0xFu; }
#define XB_SPIN(cond, bar) do { unsigned _sp = 0; while (cond) { __builtin_amdgcn_s_sleep(1); \
    if ((++_sp & 255u) == 0u) { if (xb_ld(&(bar)[XB_TMO])) break; if (_sp > XB_SPIN_CAP) { atomicAdd(&(bar)[XB_TMO], 1u); break; } } } } while (0)

struct XcdBarrier {
    unsigned* bar; unsigned x;
    volatile LAS unsigned* st;
};

__device__ __forceinline__ XcdBarrier xcd_barrier_post(unsigned* bar, volatile LAS unsigned* st) {
    XcdBarrier b; b.bar = bar; b.x = xb_xcc_id(); b.st = st;
    if (threadIdx.x == 0) (void)xb_add(&bar[XB_XCNT(b.x)], 1u);
    return b;
}
__device__ __forceinline__ void xcd_barrier_complete(unsigned* bar, unsigned x, unsigned& nloc, unsigned& nx) {
    const unsigned G = gridDim.x * gridDim.y * gridDim.z;
    unsigned sum, cnt, mine, sp = 0u;
    for (;;) {
        sum = 0u; cnt = 0u; mine = 0u;
#pragma unroll
        for (unsigned j = 0; j < 16; ++j) { const unsigned c = xb_ld(&bar[XB_XCNT(j)]); sum += c; cnt += (c > 0u) ? 1u : 0u; mine = (j == x) ? c : mine; }
        if (sum == G) break;
        __builtin_amdgcn_s_sleep(1);
        if ((++sp & 255u) == 0u) { if (xb_ld(&bar[XB_TMO])) break; if (sp > XB_SPIN_CAP) { atomicAdd(&bar[XB_TMO], 1u); break; } }
    }
    nloc = mine > 0u ? mine : 1u; nx = cnt > 0u ? cnt : 1u;
}

__device__ __forceinline__ void xcd_barrier(const XcdBarrier& b) {
    asm volatile("s_waitcnt vmcnt(0)" ::: "memory");
    __syncthreads();
    if (threadIdx.x == 0) {
        unsigned* bar = b.bar;
        __builtin_amdgcn_s_waitcnt(0);
        unsigned nloc = b.st[0], nx = b.st[1];
        if (nloc == 0u) { xcd_barrier_complete(bar, b.x, nloc, nx); b.st[0] = nloc; b.st[1] = nx; }
        const unsigned old = xb_add(&bar[XB_XSUB(b.x)], 1u);
        const unsigned gen = old / nloc;
        if (old + 1u == (gen + 1u) * nloc) {
            __builtin_amdgcn_fence(__ATOMIC_RELEASE, "agent");
            asm volatile("s_waitcnt vmcnt(0)" ::: "memory");
            const unsigned og = xb_add(&bar[XB_TOP], 1u);
            const unsigned tg = og / nx;
            if (og + 1u == (tg + 1u) * nx) xb_add(&bar[XB_TOPGEN], 1u);
            else XB_SPIN(xb_ld(&bar[XB_TOPGEN]) == tg, bar);
            __builtin_amdgcn_fence(__ATOMIC_ACQUIRE, "agent");
            xb_add(&bar[XB_XGEN(b.x)], 1u);
            asm volatile("s_waitcnt vmcnt(0)" ::: "memory");
        } else {
            XB_SPIN(xb_ld(&bar[XB_XGEN(b.x)]) == gen, bar);
            __builtin_amdgcn_fence(__ATOMIC_ACQUIRE, "agent");
            asm volatile("s_waitcnt vmcnt(0)" ::: "memory");
        }
    }
    __syncthreads();
}

#ifndef MK_REP_S5
#define MK_REP_S5 1
#endif
#ifndef MK_REP_SSD
#define MK_REP_SSD 1
#endif
#ifndef MK_REP_SYNC
#define MK_REP_SYNC 1
#endif
#ifndef MK_CG_SYNC_ALL
#define MK_CG_SYNC_ALL 0
#endif
#ifndef MK_REP_PRO
#define MK_REP_PRO 1
#endif
#ifndef MK_REP_GEMM
#define MK_REP_GEMM 1
#endif
constexpr int NPHASE = 2 + 11 * 2;
__global__ void __launch_bounds__(512, 2) fwd_megakernel(Args a) {
    extern __shared__ __attribute__((aligned(16))) unsigned char lds[];
    PG8_LAS unsigned char* lds3 = (PG8_LAS unsigned char*)lds;
    unsigned char* big = a.ws + WS_BIG;
    volatile LAS unsigned* bst = (volatile LAS unsigned*)(lds3 + (LDS_BYTES - 16));
    if (threadIdx.x < 4) bst[threadIdx.x] = 0u;
    __syncthreads();
    XcdBarrier xbar; xbar.bar = (unsigned*)(a.ws + WS_BAR); xbar.x = 0; xbar.st = bst;
    if (a.ph_hi - a.ph_lo > 1) xbar = xcd_barrier_post((unsigned*)(a.ws + WS_BAR), bst);
    for (int ph = a.ph_lo; ph < a.ph_hi; ++ph) {
        const int tid = pg8::pg8_tid(), lane = tid & 63, wave = tid >> 6, gw = blockIdx.x * 8 + wave, NGW = gridDim.x * 8;
        if (ph == 0) {
            for (int rep = 0; rep < MK_REP_PRO; ++rep) {
            adaln_phase(a, (float*)lds, tid);
            float* scr = (float*)lds + wave * (64 * 33);
            xpose_region(a, 0, 0, scr, gw, NGW, lane); xpose_region(a, 0, 1, scr, gw, NGW, lane); __syncthreads(); }
        } else if (ph == 1) {
            row_phase<0>(a, MT, nullptr, nullptr, 0, 0, gw, NGW, lane);
        } else {
            const int layer = (ph - 2) / 11, k = (ph - 2) % 11; const bool last = layer == 1; const int Mrows = last ? TL : MT;
            const bf16_t* WA = (const bf16_t*)(a.ws + WS_WA); const bf16_t* WB = (const bf16_t*)(a.ws + WS_WB);
#ifdef MK_SKIP_MASK
            if ((MK_SKIP_MASK >> k) & 1) { if (ph + 1 < a.ph_hi) xcd_barrier(xbar); continue; }
#endif
            if (k == 0) {
                pg8::Gemm g{(const bf16_t*)(a.ws + WS_XM), WA + WA_IN / 2, MT, NPROJ, D}; pg8::StaticOrder S; S.init(MT, NPROJ, gridDim.x, blockIdx.x);
                EpiInProj E{big, a.in[19] + (size_t)layer * 64}; for (int rep = 0; rep < MK_REP_GEMM; ++rep) { pg8::gemm_phase<EpiInProj, pg8::StaticOrder>(lds3, g, S, E, nullptr); __syncthreads(); }
            } else if (k == 1) {
                for (int rep = 0; rep < MK_REP_SSD; ++rep) ssd_a_phase(a, layer, lds, tid);
                for (int rep = 0; rep < MK_REP_S5; ++rep) s5_phase<0>(a, layer, lds, tid, NCH);
            } else if (k == 2) {
#if !defined(MK_NO_SSD) && !defined(MK_NO_SSDB)
                ssd_b_phase(a, tid);
#endif
                for (int rep = 0; rep < MK_REP_S5; ++rep) s5_phase<1>(a, layer, lds, tid, last ? 128 : NCH);
            } else if (k == 3) {
                for (int rep = 0; rep < MK_REP_SSD; ++rep) ssd_c_phase(a, layer, lds, tid, last ? 128 : NCH);
#ifndef MK_NO_S5
                pg8::Gemm g{(const bf16_t*)(big + B_Y5), WA + WA_GLU / 2, Mrows, 2048, 1024}; pg8::StaticOrder S; S.init(Mrows, 2048, gridDim.x, blockIdx.x);
                EpiGlu E{(bf16_t*)(big + B_U5)}; pg8::gemm_phase<EpiGlu, pg8::StaticOrder>(lds3, g, S, E, nullptr);
#endif
            } else if (k == 4) {
#ifndef MK_NO_S5
                { pg8::Gemm g{(const bf16_t*)(big + B_U5), WA + WA_S5P / 2, Mrows, 2048, 1024}; pg8::StaticOrder S; S.init(Mrows, 2048, gridDim.x, blockIdx.x);
                  EpiMerge<0> E{(bf16_t*)(big + B_XBC), (const bf16_t*)(big + B_GATE)}; pg8::gemm_phase<EpiMerge<0>, pg8::StaticOrder>(lds3, g, S, E, nullptr); }
                __syncthreads();
#endif
#ifndef MK_NO_SSD
#ifdef MK_NO_S5
                { pg8::Gemm g{(const bf16_t*)(big + B_YD), WA + WA_SSDP / 2, Mrows, 2048, 2048}; pg8::StaticOrder S; S.init(Mrows, 2048, gridDim.x, blockIdx.x);
                  EpiMerge<0, 1> E{(bf16_t*)(big + B_XBC), (const bf16_t*)(big + B_GATE)}; pg8::gemm_phase<EpiMerge<0, 1>, pg8::StaticOrder>(lds3, g, S, E, nullptr); }
#else
                { pg8::Gemm g{(const bf16_t*)(big + B_YD), WA + WA_SSDP / 2, Mrows, 2048, 2048}; pg8::StaticOrder S; S.init(Mrows, 2048, gridDim.x, blockIdx.x);
                  EpiMerge<1> E{(bf16_t*)(big + B_XBC), (const bf16_t*)(big + B_GATE)}; pg8::gemm_phase<EpiMerge<1>, pg8::StaticOrder>(lds3, g, S, E, nullptr); }
#endif
#endif
            } else if (k == 5) {
                pg8::Gemm g{(const bf16_t*)(big + B_XBC), WA + WA_WOUT / 2, Mrows, 2048, 2048}; pg8::StaticOrder S; S.init(Mrows, 2048, gridDim.x, blockIdx.x);
                EpiResid E{a.out, (float*)(a.ws + WS_HCTX), mvec(a, layer, 0) + 2 * D, mvec(a, layer, 1) + 2 * D}; pg8::gemm_phase<EpiResid, pg8::StaticOrder>(lds3, g, S, E, nullptr);
            } else if (k == 6) {
                row_phase<1>(a, Mrows, a.in[25] + (size_t)layer * D, a.in[26] + (size_t)layer * D, layer, 3 * D, gw, NGW, lane);
                if (!last) for (int rep = 0; rep < MK_REP_PRO; ++rep) { __syncthreads(); xpose_region(a, layer + 1, 0, (float*)lds + wave * (64 * 33), gw, NGW, lane); }
            } else if (k == 7) {
                pg8::Gemm g{(const bf16_t*)(a.ws + WS_XM), WB + WB_UP / 2, Mrows, 2 * DFF, D}; pg8::StaticOrder S; S.init(Mrows, 2 * DFF, gridDim.x, blockIdx.x);
                EpiUp E{(bf16_t*)(big + B_G), (bf16_t*)(big + B_V)}; for (int rep = 0; rep < MK_REP_GEMM; ++rep) { pg8::gemm_phase<EpiUp, pg8::StaticOrder>(lds3, g, S, E, nullptr); __syncthreads(); }
            } else if (k == 8) {
                ffnconv_phase(a, layer, !last, lds, tid);
            } else if (k == 9) {
                pg8::Gemm g{(const bf16_t*)(big + B_V), WB + WB_DOWN / 2, Mrows, D, DFF}; pg8::StaticOrder S; S.init(Mrows, D, gridDim.x, blockIdx.x);
                EpiResid E{a.out, (float*)(a.ws + WS_HCTX), mvec(a, layer, 0) + 5 * D, mvec(a, layer, 1) + 5 * D}; pg8::gemm_phase<EpiResid, pg8::StaticOrder>(lds3, g, S, E, nullptr);
            } else {
                row_phase<1>(a, Mrows, a.in[31] + (size_t)layer * D, a.in[32] + (size_t)layer * D, last ? -1 : layer + 1, 0, gw, NGW, lane);
                if (!last) for (int rep = 0; rep < MK_REP_PRO; ++rep) { __syncthreads(); xpose_region(a, layer + 1, 1, (float*)lds + wave * (64 * 33), gw, NGW, lane); }
            }
        }
        if (ph + 1 < a.ph_hi) { for (int rep = 0; rep < MK_REP_SYNC; ++rep) { if (MK_CG_SYNC_ALL || ph == a.ph_lo) cg::this_grid().sync(); else xcd_barrier(xbar); } }
#ifdef MK_TS_MASK
        if (blockIdx.x == 0 && threadIdx.x == 0) ((unsigned long long*)(a.ws + WS_BAR + 65536))[ph + 1] = __builtin_amdgcn_s_memrealtime();
#endif
    }
#ifdef MK_TS_MASK
    if (blockIdx.x == 0 && threadIdx.x == 0) {
        const unsigned long long* ts = (const unsigned long long*)(a.ws + WS_BAR + 65536); unsigned long long sum = 0;
        for (int ph = 1; ph < a.ph_hi - 1; ++ph) if ((MK_TS_MASK >> ph) & 1ull) sum += ts[ph + 1] - ts[ph];
        const unsigned long long t0 = __builtin_amdgcn_s_memrealtime();
        while (__builtin_amdgcn_s_memrealtime() - t0 < sum * MK_TS_AMP) __builtin_amdgcn_s_sleep(8);
    }
#endif
}
}

#ifndef MK_N_LAUNCH_MODE
#define MK_N_LAUNCH_MODE 0
#endif
extern "C" void kernel_launch(void* const* d_in, const int* in_sizes, int n_in, void* d_out, int out_size, void* d_ws, size_t ws_size, hipStream_t stream) {
    static int grid = 0;
    if (grid == 0) {
        if (n_in != 33 || ws_size < mk::WS_END) { fprintf(stderr, "kernel_launch: need 33 inputs and %zu bytes of workspace (got %d, %zu)\n", (size_t)mk::WS_END, n_in, ws_size); grid = -1; return; }
        int dev = 0, cus = 0, per_cu = 0;
        (void)hipGetDevice(&dev); (void)hipDeviceGetAttribute(&cus, hipDeviceAttributeMultiprocessorCount, dev);
        if (hipFuncSetAttribute((const void*)mk::fwd_megakernel, hipFuncAttributeMaxDynamicSharedMemorySize, mk::LDS_BYTES) != hipSuccess) { fprintf(stderr, "kernel_launch: hipFuncSetAttribute failed\n"); grid = -1; return; }
        if (hipOccupancyMaxActiveBlocksPerMultiprocessor(&per_cu, (const void*)mk::fwd_megakernel, 512, mk::LDS_BYTES) != hipSuccess || per_cu < 1) { fprintf(stderr, "kernel_launch: occupancy query says %d\n", per_cu); per_cu = 1; }
        (void)hipGetLastError();
        grid = cus * per_cu; if (grid > 256) grid = 256;
    }
    if (grid < 0) return;
    mk::Args a{};
    for (int i = 0; i < 33; ++i) a.in[i] = (const float*)d_in[i];
    a.out = (float*)d_out; a.ws = (unsigned char*)d_ws;
#if MK_N_LAUNCH_MODE == 1
    for (int ph = 0; ph < mk::NPHASE; ++ph) { a.ph_lo = ph; a.ph_hi = ph + 1; hipLaunchKernelGGL(mk::fwd_megakernel, dim3(grid), dim3(512), mk::LDS_BYTES, stream, a); }
#else
    a.ph_lo = 0; a.ph_hi = mk::NPHASE;
    (void)hipMemsetAsync((unsigned char*)d_ws + mk::WS_BAR, 0, XCD_BAR_WORDS * sizeof(unsigned), stream);
    void* args[] = {&a};
    hipError_t e = hipLaunchCooperativeKernel((const void*)mk::fwd_megakernel, dim3(grid), dim3(512), args, mk::LDS_BYTES, stream);
    if (e != hipSuccess) fprintf(stderr, "cooperative launch failed: %s (grid %d)\n", hipGetErrorString(e), grid);
#endif
}
```

```cpp
#include <hip/hip_runtime.h>
#include <hip/hip_cooperative_groups.h>
#include <cstdio>
namespace cg = cooperative_groups;
#define MK_N_LAUNCH_MODE 0
namespace pg8 {
#define PG8_LAS __attribute__((address_space(3)))
typedef unsigned short bf16_t;
typedef short bf16x8 __attribute__((ext_vector_type(8)));
typedef float f32x4 __attribute__((ext_vector_type(4)));
typedef unsigned u32x4 __attribute__((ext_vector_type(4)));
constexpr int BM = 256, BK = 64, HALF = 128, HTB = HALF * BK * 2  , STAGE_BYTES = 8 * HTB, NXCD = 8, WGM = 8;

__host__ __device__ __forceinline__ int lds_byte(int r, int c) { const int st = (r >> 4) * 2 + (c >> 5), rr = r & 15, cc = c & 31, ob = rr * 64 + cc * 2; return st * 1024 + (ob ^ (((ob >> 9) & 1) << 5)); }
__host__ __device__ __forceinline__ void stage_rc(int b, int& R, int& C) { const int st = b / 1024, sb = b % 1024, swz = sb ^ (((sb >> 9) & 1) << 5); R = (st >> 1) * 16 + swz / 64; C = (st & 1) * 32 + (swz % 64) / 2; }
__host__ __device__ __forceinline__ int perm32(int rho) { const int n = rho >> 4, i = rho & 15; return 8 * (i >> 2) + 4 * n + (i & 3); }

__device__ __forceinline__ int pg8_tid() { int t = threadIdx.x; asm volatile("" : "+v"(t)); return t; }
struct Unit { int pm, pn; };
struct Gemm { const bf16_t* A; const bf16_t* Bt; int M, N, K; };

struct StaticOrder {
    int nM, nN, nwg, G, c;
    __host__ __device__ void init(int M, int N, int G_, int c_) { nM = M / BM; nN = N / BM; nwg = nM * nN; G = G_; c = c_; }
    __host__ __device__ bool next(int i, Unit& u) const {
        const long L = (long)i * G + c; if (L >= nwg) return false;
        int wgid = (int)L; { const int q = nwg / NXCD, r = nwg % NXCD, xcd = wgid % NXCD, off = wgid / NXCD; wgid = (xcd < r ? xcd * (q + 1) : r * (q + 1) + (xcd - r) * q) + off; }
        const int nig = WGM * nN, gid = wgid / nig, fm = gid * WGM, gsz = (nM - fm) < WGM ? (nM - fm) : WGM;
        u.pm = fm + ((wgid % nig) % gsz); u.pn = (wgid % nig) / gsz; return true;
    }
    __device__ __forceinline__ void a_ready(const Unit&) const {}
    __device__ __forceinline__ void done(const Unit&) const {}
};
typedef float f32x2c __attribute__((ext_vector_type(2))); typedef __bf16 bf16x2c __attribute__((ext_vector_type(2)));
__device__ __forceinline__ unsigned cvt_pk_native(float lo, float hi) { const f32x2c v = {lo, hi}; const bf16x2c b = __builtin_convertvector(v, bf16x2c); return __builtin_bit_cast(unsigned, b); }
__device__ __forceinline__ unsigned cvt_pk_bf16(float lo, float hi) { unsigned r; asm volatile("v_cvt_pk_bf16_f32 %0, %1, %2" : "=v"(r) : "v"(lo), "v"(hi)); return r; }
__device__ __forceinline__ void mfma_settle(const float __attribute__((ext_vector_type(4)))& a) { asm volatile("s_nop 15\n\ts_nop 7" :: "v"(a)); }
typedef float f32x2 __attribute__((ext_vector_type(2)));
template <class Epi, class Sched, bool STAMP = false>
__device__ __forceinline__ void gemm_phase(PG8_LAS unsigned char* lds, const Gemm g, const Sched& S, const Epi& E, unsigned long long* stamps) {
    const int tid = pg8_tid(), wid = __builtin_amdgcn_readfirstlane(tid >> 6), lane = tid & 63, wr = wid >> 2, wc = wid & 3, fr = lane & 15, fq = lane >> 4;
    const int K = g.K, nt = K / BK;
    int ts_lo = 0, ts_hi = 0, nts = 0; const unsigned long long rt_entry = STAMP ? (unsigned long long)wall_clock64() : 0ull;
#define PG8_STAMP() do { if (STAMP && wid == 0 && nts < 64) { const unsigned long long _c = (unsigned long long)clock64(); \
        ts_lo = (lane == nts) ? (int)(unsigned)_c : ts_lo; ts_hi = (lane == nts) ? (int)(unsigned)(_c >> 32) : ts_hi; ++nts; } } while (0)
    PG8_STAMP();
    unsigned voffA[2], voffB[2];
#pragma unroll
    for (int i = 0; i < 2; ++i) { int R, C; stage_rc(tid * 16 + i * 8192, R, C); const int Rb = Epi::PERM ? ((R & ~31) + perm32(R & 31)) : R;
        voffA[i] = (unsigned)(R * K + C) * 2u; voffB[i] = (unsigned)(Rb * K + C) * 2u; }
    const size_t kstep = (size_t)(BK * 2);
    const size_t hstep = (size_t)HALF * K * 2;
    const size_t tstep = 2 * hstep;
    const unsigned ldsw = (unsigned)wid * 1024u;
    const int aoff = lds_byte(wr * 64 + fr, fq * 8), boff = lds_byte(wc * 32 + fr, fq * 8);
#define PG8_SA(b, h) (((b) * 2 + (h)) * HTB)
#define PG8_SB(b, h) ((4 + (b) * 2 + (h)) * HTB)
#define PG8_STAGE(bufoff, gbase, voff) do { _Pragma("unroll") for (int _i = 0; _i < 2; ++_i) \
        __builtin_amdgcn_global_load_lds((const unsigned*)((const char*)(gbase) + (voff)[_i]), (PG8_LAS unsigned*)(lds + (bufoff) + ldsw + _i * 8192), 16, 0, 0); } while (0)
#define PG8_LDA(dst, b, h) do { _Pragma("unroll") for (int m = 0; m < 4; ++m) _Pragma("unroll") for (int k = 0; k < 2; ++k) dst[m][k] = *(const PG8_LAS bf16x8*)(lds + PG8_SA(b, h) + aoff + m * 2048 + k * 1024); } while (0)
#define PG8_LDB(dst, b, h) do { _Pragma("unroll") for (int n = 0; n < 2; ++n) _Pragma("unroll") for (int k = 0; k < 2; ++k) dst[n][k] = *(const PG8_LAS bf16x8*)(lds + PG8_SB(b, h) + boff + n * 2048 + k * 1024); } while (0)
#define PG8_MMA(ai, bj, At, Bt) do { __builtin_amdgcn_s_setprio(1); _Pragma("unroll") for (int m = 0; m < 4; ++m) _Pragma("unroll") for (int n = 0; n < 2; ++n) _Pragma("unroll") for (int k = 0; k < 2; ++k) \
        acc[ai][bj][m][n] = __builtin_amdgcn_mfma_f32_16x16x32_bf16(Bt[n][k], At[m][k], acc[ai][bj][m][n], 0, 0, 0); __builtin_amdgcn_s_setprio(0); } while (0)
#define PG8_WAIT_V(n) asm volatile("s_waitcnt vmcnt(" #n ")" ::: "memory")
#define PG8_WAIT_L(n) asm volatile("s_waitcnt lgkmcnt(" #n ")" ::: "memory")
#define PG8_BAR __builtin_amdgcn_s_barrier()
#define PG8_SCHED __builtin_amdgcn_sched_barrier(0)
    Unit cur, nxt; int ui = 0;
    if (!S.next(0, cur)) return;
    f32x4 acc[2][2][4][2];
#pragma unroll
    for (int a = 0; a < 2; ++a)
#pragma unroll
        for (int b = 0; b < 2; ++b)
#pragma unroll
            for (int m = 0; m < 4; ++m)
#pragma unroll
                for (int n = 0; n < 2; ++n) acc[a][b][m][n] = (f32x4){0.f, 0.f, 0.f, 0.f};
    bf16x8 At[4][2], B0[2][2], B1[2][2];
    const char* cA = (const char*)g.A + (size_t)cur.pm * tstep; const char* cB = (const char*)g.Bt + (size_t)cur.pn * tstep;
    S.a_ready(cur);
    PG8_STAGE(PG8_SB(0, 0), cB, voffB); PG8_STAGE(PG8_SA(0, 0), cA, voffA); PG8_STAGE(PG8_SB(0, 1), cB + hstep, voffB); PG8_STAGE(PG8_SA(0, 1), cA + hstep, voffA);
    if (wr == 1) PG8_BAR;
    PG8_WAIT_V(4); PG8_BAR;
    PG8_STAGE(PG8_SB(1, 0), cB + kstep, voffB); PG8_STAGE(PG8_SA(1, 0), cA + kstep, voffA); PG8_STAGE(PG8_SB(1, 1), cB + hstep + kstep, voffB);
    PG8_WAIT_V(6); PG8_BAR;
    PG8_STAMP();
    for (;;) {
        const bool has_next = S.next(ui + 1, nxt);
        const char* nA = has_next ? (const char*)g.A + (size_t)nxt.pm * tstep : cA; const char* nB = has_next ? (const char*)g.Bt + (size_t)nxt.pn * tstep : cB;
        for (int t = 0; t < nt; t += 2) {
            const bool last = (t == nt - 2);
            const char* a1 = cA + (size_t)(t + 1) * kstep;
            const char* a2 = last ? nA : cA + (size_t)(t + 2) * kstep; const char* b2 = last ? nB : cB + (size_t)(t + 2) * kstep;
            const char* a3 = a2 + kstep; const char* b3 = b2 + kstep;
            if (last && has_next) S.a_ready(nxt);
            PG8_LDB(B0, 0, 0); PG8_SCHED; PG8_LDA(At, 0, 0); PG8_STAGE(PG8_SA(1, 1), a1 + hstep, voffA);
            PG8_WAIT_L(8); PG8_BAR; PG8_WAIT_L(0); PG8_MMA(0, 0, At, B0); PG8_BAR; PG8_SCHED;
            PG8_LDB(B1, 0, 1); PG8_STAGE(PG8_SB(0, 0), b2, voffB);
            PG8_BAR; PG8_WAIT_L(0); PG8_MMA(0, 1, At, B1); PG8_BAR;
            PG8_LDA(At, 0, 1); PG8_STAGE(PG8_SA(0, 0), a2, voffA);
            PG8_BAR; PG8_WAIT_L(0); PG8_MMA(1, 0, At, B0); PG8_BAR; PG8_SCHED;
            PG8_STAGE(PG8_SB(0, 1), b2 + hstep, voffB);
            PG8_WAIT_V(6); PG8_BAR; PG8_MMA(1, 1, At, B1); PG8_BAR;
            PG8_LDB(B0, 1, 0); PG8_SCHED; PG8_LDA(At, 1, 0); PG8_STAGE(PG8_SA(0, 1), a2 + hstep, voffA);
            PG8_WAIT_L(8); PG8_BAR; PG8_WAIT_L(0); PG8_MMA(0, 0, At, B0); PG8_BAR; PG8_SCHED;
            PG8_LDB(B1, 1, 1); PG8_STAGE(PG8_SB(1, 0), b3, voffB);
            PG8_BAR; PG8_WAIT_L(0); PG8_MMA(0, 1, At, B1); PG8_BAR;
            PG8_LDA(At, 1, 1); PG8_STAGE(PG8_SA(1, 0), a3, voffA);
            PG8_BAR; PG8_WAIT_L(0); PG8_MMA(1, 0, At, B0); PG8_BAR; PG8_SCHED;
            PG8_STAGE(PG8_SB(1, 1), b3 + hstep, voffB);
            PG8_WAIT_V(6); PG8_BAR; PG8_MMA(1, 1, At, B1); PG8_BAR;
        }
        PG8_STAMP();
        if constexpr (!Epi::AFTER_DRAIN) { E(acc, cur, wr, wc, fr, fq); S.done(cur); }
        PG8_STAMP();
        if (!has_next) break;
#pragma unroll
        for (int a = 0; a < 2; ++a)
#pragma unroll
            for (int b = 0; b < 2; ++b)
#pragma unroll
                for (int m = 0; m < 4; ++m)
#pragma unroll
                    for (int n = 0; n < 2; ++n) acc[a][b][m][n] = (f32x4){0.f, 0.f, 0.f, 0.f};
        cur = nxt; cA = nA; cB = nB; ++ui;
    }
    PG8_WAIT_V(0);
    if (wr == 0) PG8_BAR;
    PG8_BAR;
    if constexpr (Epi::AFTER_DRAIN) { E.fused(acc, cur, wr, wc, fr, fq, lds, wid, lane); S.done(cur); }
    PG8_STAMP();
    if (STAMP && wid == 0) { stamps[lane] = lane < nts ? (((unsigned long long)(unsigned)ts_hi << 32) | (unsigned)ts_lo) : 0ull;
        if (lane == 62) stamps[62] = rt_entry; if (lane == 63) stamps[63] = (unsigned long long)wall_clock64(); }
#undef PG8_STAMP
#undef PG8_SA
#undef PG8_SB
#undef PG8_STAGE
#undef PG8_LDA
#undef PG8_LDB
#undef PG8_MMA
#undef PG8_WAIT_V
#undef PG8_WAIT_L
#undef PG8_BAR
#undef PG8_SCHED
}
}

namespace mk {
using pg8::bf16_t; using pg8::bf16x8; using pg8::f32x4; using pg8::u32x4; using pg8::Unit; using pg8::cvt_pk_bf16; using pg8::cvt_pk_native; using pg8::mfma_settle;
typedef unsigned u32x2 __attribute__((ext_vector_type(2)));
typedef float f32x2 __attribute__((ext_vector_type(2)));
constexpr int D = 2048, TL = 16384, TC = 256, MT = TL + TC, NCH = MT / 128;
constexpr int NPROJ = 10496, DFF = 5632;
constexpr size_t MiB = 1u << 20;
constexpr size_t WS_MVEC = 0, WS_CHD = 256 * 1024, WS_BAR = 512 * 1024, WS_S5LOC = 1 * MiB, WS_WA = 10 * MiB, WS_WB = 75 * MiB, WS_HCTX = 141 * MiB, WS_XM = 143 * MiB, WS_SST = 208 * MiB, WS_BIG = 338 * MiB, WS_END = 766 * MiB;
constexpr size_t B_U5 = 0, B_XBC = B_U5 + (size_t)MT * 1024 * 2, B_Z = B_XBC + (size_t)MT * 3072 * 2, B_GATE = B_Z + (size_t)MT * 2048 * 2, B_DT = B_GATE + (size_t)MT * 4096 * 2,
                 B_Y5 = 330 * MiB, B_YD = B_Y5 + (size_t)MT * 1024 * 2;
static_assert(B_DT + (size_t)MT * 64 * 4 <= B_Y5 && B_YD + (size_t)MT * 2048 * 2 <= 428 * MiB, "big map");
constexpr size_t B_G = 0, B_V = (size_t)MT * DFF * 2;
constexpr size_t WA_IN = 0, WA_GLU = 41 * MiB, WA_S5P = 45 * MiB, WA_SSDP = 49 * MiB, WA_WOUT = 57 * MiB, WB_UP = 0, WB_DOWN = 44 * MiB;
constexpr int LDS_BYTES = 163840;
constexpr float ALPHA = 1.41421356237f, LN_EPS = 1e-5f, RMS_EPS = 1e-5f;

struct Args { const float* in[33]; float* out; unsigned char* ws; int ph_lo, ph_hi; };

__device__ __forceinline__ float bf2f(unsigned b) { return __uint_as_float(b << 16); }
__device__ __forceinline__ float bflo(unsigned w) { return __uint_as_float(w << 16); }
__device__ __forceinline__ float bfhi(unsigned w) { return __uint_as_float(w & 0xffff0000u); }
__device__ __forceinline__ float sigm(float x) { return __builtin_amdgcn_rcpf(1.f + __expf(-x)); }
__device__ __forceinline__ float silu_(float x) { return x * __builtin_amdgcn_rcpf(1.f + __expf(-x)); }
__device__ __forceinline__ float gelu_tanh(float x) { const float u = 0.7978845608028654f * (x + 0.044715f * x * x * x); const float th = 1.f - 2.f * __builtin_amdgcn_rcpf(__expf(2.f * u) + 1.f); return 0.5f * x * (1.f + th); }
__device__ __forceinline__ bf16x8 mkfrag(unsigned a, unsigned b, unsigned c, unsigned d) { u32x4 v; v.x = a; v.y = b; v.z = c; v.w = d; return __builtin_bit_cast(bf16x8, v); }
__device__ __forceinline__ float* hrow(const Args& a, int row) { return row < TL ? a.out + (size_t)row * D : (float*)(a.ws + WS_HCTX) + (size_t)(row - TL) * D; }
__device__ __forceinline__ const float* mvec(const Args& a, int layer, int isctx) { return (const float*)(a.ws + WS_MVEC) + (size_t)(layer * 2 + isctx) * 12288; }

struct EpiInProj {
    static constexpr bool PERM = true, AFTER_DRAIN = false;
    unsigned char* big; const float* dt_bias;
    __device__ __forceinline__ void operator()(const f32x4 (&acc)[2][2][4][2], const Unit& u, int wr, int wc, int fr, int fq) const {
        mfma_settle(acc[1][1][3][1]); mfma_settle(acc[1][1][3][0]);
        const int row0 = u.pm * 256 + wr * 64 + fr, ct = u.pn * 256;
        if (ct >= 10240) {
            if (wc < 2) { const int cc = wc * 32 + 8 * fq; float* DT = (float*)(big + B_DT);
                const f32x4 b0 = *(const f32x4*)(dt_bias + cc), b1 = *(const f32x4*)(dt_bias + cc + 4);
#pragma unroll
                for (int ai = 0; ai < 2; ++ai)
#pragma unroll
                    for (int m = 0; m < 4; ++m) { float* rp = DT + (size_t)(row0 + ai * 128 + m * 16) * 64 + cc; f32x4 v0 = acc[ai][0][m][0] + b0, v1 = acc[ai][0][m][1] + b1;
#pragma unroll
                        for (int j = 0; j < 4; ++j) { v0[j] = v0[j] > 20.f ? v0[j] : log1pf(expf(v0[j])); v1[j] = v1[j] > 20.f ? v1[j] : log1pf(expf(v1[j])); }
                        *(f32x4*)rp = v0; *(f32x4*)(rp + 4) = v1; } }
            return;
        }
        bf16_t* base; int ld, c0; bool sg = false;
        if (ct < 1024) { base = (bf16_t*)(big + B_U5); ld = 1024; c0 = ct; }
        else if (ct < 4096) { base = (bf16_t*)(big + B_XBC); ld = 3072; c0 = ct - 1024; }
        else if (ct < 6144) { base = (bf16_t*)(big + B_Z); ld = 2048; c0 = ct - 4096; }
        else { base = (bf16_t*)(big + B_GATE); ld = 4096; c0 = ct - 6144; sg = true; }
        const int col0 = c0 + wc * 32 + 8 * fq;
#pragma unroll
        for (int ai = 0; ai < 2; ++ai)
#pragma unroll
            for (int m = 0; m < 4; ++m) { bf16_t* rowp = base + (size_t)(row0 + ai * 128 + m * 16) * ld + col0;
#pragma unroll
                for (int bj = 0; bj < 2; ++bj) { f32x4 v0 = acc[ai][bj][m][0], v1 = acc[ai][bj][m][1];
                    if (sg) {
#pragma unroll
                        for (int j = 0; j < 4; ++j) { v0[j] = sigm(v0[j]); v1[j] = sigm(v1[j]); } }
                    u32x4 w; w.x = cvt_pk_bf16(v0[0], v0[1]); w.y = cvt_pk_bf16(v0[2], v0[3]); w.z = cvt_pk_bf16(v1[0], v1[1]); w.w = cvt_pk_bf16(v1[2], v1[3]);
                    *(u32x4*)(rowp + bj * 128) = w; } }
    }
};
struct EpiGlu {
    static constexpr bool PERM = true, AFTER_DRAIN = false;
    bf16_t* O;
    __device__ __forceinline__ void operator()(const f32x4 (&acc)[2][2][4][2], const Unit& u, int wr, int wc, int fr, int fq) const {
        mfma_settle(acc[1][1][3][1]); mfma_settle(acc[1][1][3][0]);
        const int row0 = u.pm * 256 + wr * 64 + fr, col0 = u.pn * 128 + wc * 32 + 8 * fq;
#pragma unroll
        for (int ai = 0; ai < 2; ++ai)
#pragma unroll
            for (int m = 0; m < 4; ++m) { f32x4 v0 = acc[ai][0][m][0], v1 = acc[ai][0][m][1]; const f32x4 g0 = acc[ai][1][m][0], g1 = acc[ai][1][m][1];
#pragma unroll
                for (int j = 0; j < 4; ++j) { v0[j] *= sigm(g0[j]); v1[j] *= sigm(g1[j]); }
                u32x4 w; w.x = cvt_pk_bf16(v0[0], v0[1]); w.y = cvt_pk_bf16(v0[2], v0[3]); w.z = cvt_pk_bf16(v1[0], v1[1]); w.w = cvt_pk_bf16(v1[2], v1[3]);
                *(u32x4*)(O + (size_t)(row0 + ai * 128 + m * 16) * 1024 + col0) = w; }
    }
};
template <int SECOND, int GSEL = SECOND> struct EpiMerge {
    static constexpr bool PERM = true, AFTER_DRAIN = false;
    bf16_t* MG; const bf16_t* GATE;
    __device__ __forceinline__ void operator()(const f32x4 (&acc)[2][2][4][2], const Unit& u, int wr, int wc, int fr, int fq) const {
        mfma_settle(acc[1][1][3][1]); mfma_settle(acc[1][1][3][0]);
        const int row0 = u.pm * 256 + wr * 64 + fr, col0 = u.pn * 256 + wc * 32 + 8 * fq;
#pragma unroll
        for (int ai = 0; ai < 2; ++ai)
#pragma unroll
            for (int m = 0; m < 4; ++m) { const size_t r = (size_t)(row0 + ai * 128 + m * 16);
#pragma unroll
                for (int bj = 0; bj < 2; ++bj) { const int c = col0 + bj * 128; const u32x4 g = *(const u32x4*)(GATE + r * 4096 + (GSEL ? 2048 : 0) + c);
                    f32x4 v0 = acc[ai][bj][m][0], v1 = acc[ai][bj][m][1];
                    v0[0] *= bflo(g.x); v0[1] *= bfhi(g.x); v0[2] *= bflo(g.y); v0[3] *= bfhi(g.y); v1[0] *= bflo(g.z); v1[1] *= bfhi(g.z); v1[2] *= bflo(g.w); v1[3] *= bfhi(g.w);
                    if (SECOND) { const u32x4 o = *(const u32x4*)(MG + r * 2048 + c);
                        v0[0] += bflo(o.x); v0[1] += bfhi(o.x); v0[2] += bflo(o.y); v0[3] += bfhi(o.y); v1[0] += bflo(o.z); v1[1] += bfhi(o.z); v1[2] += bflo(o.w); v1[3] += bfhi(o.w); }
                    u32x4 w; w.x = cvt_pk_bf16(v0[0], v0[1]); w.y = cvt_pk_bf16(v0[2], v0[3]); w.z = cvt_pk_bf16(v1[0], v1[1]); w.w = cvt_pk_bf16(v1[2], v1[3]);
                    *(u32x4*)(MG + r * 2048 + c) = w; } }
    }
};
struct EpiResid {
    static constexpr bool PERM = false, AFTER_DRAIN = false;
    float* out; float* hctx; const float* glat; const float* gctx;
    __device__ __forceinline__ void operator()(const f32x4 (&acc)[2][2][4][2], const Unit& u, int wr, int wc, int fr, int fq) const {
        mfma_settle(acc[1][1][3][1]); mfma_settle(acc[1][1][3][0]);
        const bool isctx = u.pm >= 64; const float* g = isctx ? gctx : glat;
        float* hb = isctx ? hctx + (size_t)(wr * 64 + fr) * D : out + (size_t)(u.pm * 256 + wr * 64 + fr) * D;
        const int col0 = u.pn * 256 + wc * 32 + 4 * fq;
        f32x4 gv[2][2];
#pragma unroll
        for (int bj = 0; bj < 2; ++bj)
#pragma unroll
            for (int n = 0; n < 2; ++n) gv[bj][n] = *(const f32x4*)(g + col0 + bj * 128 + n * 16);
#pragma unroll
        for (int ai = 0; ai < 2; ++ai)
#pragma unroll
            for (int m = 0; m < 4; ++m) { float* rowp = hb + (size_t)(ai * 128 + m * 16) * D + col0;
#pragma unroll
                for (int bj = 0; bj < 2; ++bj)
#pragma unroll
                    for (int n = 0; n < 2; ++n) { float* p = rowp + bj * 128 + n * 16; const f32x4 h = *(const f32x4*)p; *(f32x4*)p = h * ALPHA + gv[bj][n] * acc[ai][bj][m][n]; } }
    }
};
struct EpiUp {
    static constexpr bool PERM = true, AFTER_DRAIN = false;
    bf16_t* G; bf16_t* V;
    __device__ __forceinline__ void operator()(const f32x4 (&acc)[2][2][4][2], const Unit& u, int wr, int wc, int fr, int fq) const {
        mfma_settle(acc[1][1][3][1]); mfma_settle(acc[1][1][3][0]);
        const int row0 = u.pm * 256 + wr * 64 + fr; int ct = u.pn * 256; bf16_t* base = G; if (ct >= DFF) { base = V; ct -= DFF; }
        const int col0 = ct + wc * 32 + 8 * fq;
#pragma unroll
        for (int ai = 0; ai < 2; ++ai)
#pragma unroll
            for (int m = 0; m < 4; ++m) { bf16_t* rowp = base + (size_t)(row0 + ai * 128 + m * 16) * DFF + col0;
#pragma unroll
                for (int bj = 0; bj < 2; ++bj) { const f32x4 v0 = acc[ai][bj][m][0], v1 = acc[ai][bj][m][1];
                    u32x4 w; w.x = cvt_pk_bf16(v0[0], v0[1]); w.y = cvt_pk_bf16(v0[2], v0[3]); w.z = cvt_pk_bf16(v1[0], v1[1]); w.w = cvt_pk_bf16(v1[2], v1[3]);
                    *(u32x4*)(rowp + bj * 128) = w; } }
    }
};

__device__ __forceinline__ void xpose_item(const float* W, int K, int N, bf16_t* WT, int d0, int s0, int k0, float* scr, int lane) {
#pragma unroll
    for (int i = 0; i < 32; ++i) { const int kk = 2 * i + (lane >> 5); scr[kk * 33 + (lane & 31)] = s0 >= 0 ? W[(size_t)(k0 + kk) * N + s0 + (lane & 31)] : 0.f; }
    asm volatile("s_waitcnt lgkmcnt(0)" ::: "memory");
    const int c = lane & 7;
#pragma unroll
    for (int j = 0; j < 4; ++j) { const int n = (lane >> 3) + 8 * j; const float* s = scr + (8 * c) * 33 + n;
        u32x4 o; o.x = cvt_pk_bf16(s[0 * 33], s[1 * 33]); o.y = cvt_pk_bf16(s[2 * 33], s[3 * 33]); o.z = cvt_pk_bf16(s[4 * 33], s[5 * 33]); o.w = cvt_pk_bf16(s[6 * 33], s[7 * 33]);
        *(u32x4*)(WT + (size_t)(d0 + n) * K + k0 + 8 * c) = o; }
    asm volatile("s_waitcnt lgkmcnt(0)" ::: "memory");
}
__device__ __forceinline__ void xpose_region(const Args& a, int layer, int region, float* scr, int gw, int NGW, int lane) {
    if (region == 0) {
        const float* w_in = a.in[6] + (size_t)layer * 2048 * 10304; const float* w_glu = a.in[15] + (size_t)layer * 1024 * 2048; const float* w_s5p = a.in[16] + (size_t)layer * 1024 * 2048;
        const float* w_ssdp = a.in[23] + (size_t)layer * 2048 * 2048; const float* w_out = a.in[24] + (size_t)layer * 2048 * 2048;
        bf16_t* WA = (bf16_t*)(a.ws + WS_WA);
        constexpr int I_IN = 32 * 328, I_GLU = 16 * 64, I_S5P = 16 * 64, I_SSDP = 32 * 64, I_WOUT = 32 * 64, NI = I_IN + I_GLU + I_S5P + I_SSDP + I_WOUT;
        for (int it = gw; it < NI; it += NGW) { int r = it;
            if (r < I_IN) { const int kb = r / 328, d0 = (r % 328) * 32; int s0; if (d0 < 4096) s0 = d0; else if (d0 < 10240) s0 = d0 + 64; else if (d0 < 10304) s0 = d0 - 10240 + 4096; else s0 = -1;
                xpose_item(w_in, 2048, 10304, WA + WA_IN / 2, d0, s0, kb * 64, scr, lane); continue; } r -= I_IN;
            if (r < I_GLU) { const int kb = r / 64, d0 = (r % 64) * 32, t = d0 >> 8, j = d0 & 255; const int s0 = j < 128 ? t * 128 + j : 1024 + t * 128 + (j - 128);
                xpose_item(w_glu, 1024, 2048, WA + WA_GLU / 2, d0, s0, kb * 64, scr, lane); continue; } r -= I_GLU;
            if (r < I_S5P) { const int kb = r / 64, d0 = (r % 64) * 32; xpose_item(w_s5p, 1024, 2048, WA + WA_S5P / 2, d0, d0, kb * 64, scr, lane); continue; } r -= I_S5P;
            if (r < I_SSDP) { const int kb = r / 64, d0 = (r % 64) * 32; xpose_item(w_ssdp, 2048, 2048, WA + WA_SSDP / 2, d0, d0, kb * 64, scr, lane); continue; } r -= I_SSDP;
            { const int kb = r / 64, d0 = (r % 64) * 32; xpose_item(w_out, 2048, 2048, WA + WA_WOUT / 2, d0, d0, kb * 64, scr, lane); }
        }
    } else {
        const float* w_up = a.in[27] + (size_t)layer * 2048 * 11264; const float* w_down = a.in[30] + (size_t)layer * 5632 * 2048;
        bf16_t* WB = (bf16_t*)(a.ws + WS_WB);
        constexpr int I_UP = 32 * 352, I_DOWN = 88 * 64, NI = I_UP + I_DOWN;
        for (int it = gw; it < NI; it += NGW) { int r = it;
            if (r < I_UP) { const int kb = r / 352, d0 = (r % 352) * 32; xpose_item(w_up, 2048, 11264, WB + WB_UP / 2, d0, d0, kb * 64, scr, lane); continue; } r -= I_UP;
            { const int kb = r / 64, d0 = (r % 64) * 32; xpose_item(w_down, 5632, 2048, WB + WB_DOWN / 2, d0, d0, kb * 64, scr, lane); }
        }
    }
}

__device__ __forceinline__ void adaln_phase(const Args& a, float* lds, int tid) {
    float* sc = lds; float* scx = lds + 2048; float* red = lds + 4096;
    for (int i = tid; i < 2048; i += 512) { sc[i] = silu_(a.in[1][i]); scx[i] = silu_(a.in[3][i]); }
    __syncthreads();
    for (int unit = blockIdx.x; unit < 256; unit += gridDim.x) {
        const int layer = unit >> 7, col0 = (unit & 127) * 96;
        const float* W = a.in[4] + (size_t)layer * 2048 * 12288 + col0;
        if (tid < 504) { const int cq = tid % 24, ks = tid / 24; f32x4 al = {0.f, 0.f, 0.f, 0.f}, ac = {0.f, 0.f, 0.f, 0.f};
#pragma unroll 7
            for (int k = ks; k < 2048; k += 21) { const f32x4 w = *(const f32x4*)(W + (size_t)k * 12288 + cq * 4); al += w * sc[k]; ac += w * scx[k]; }
            *(f32x4*)(red + (ks * 2 + 0) * 96 + cq * 4) = al; *(f32x4*)(red + (ks * 2 + 1) * 96 + cq * 4) = ac; }
        __syncthreads();
        if (tid < 192) { const int v = tid / 96, c = tid % 96; float s = 0.f; for (int ks = 0; ks < 21; ++ks) s += red[(ks * 2 + v) * 96 + c];
            ((float*)(a.ws + WS_MVEC))[(size_t)(layer * 2 + v) * 12288 + col0 + c] = s + a.in[5][(size_t)layer * 12288 + col0 + c]; }
        __syncthreads();
    }
}

__device__ __forceinline__ float wave_sum(float v) {
#pragma unroll
    for (int o = 1; o < 64; o <<= 1) v += __shfl_xor(v, o);
    return v;
}
template <int MODE> __device__ __forceinline__ void row_phase(const Args& a, int nrows, const float* lng, const float* lnb, int mod_layer, int mod_off, int gw, int NGW, int lane) {
    bf16_t* XM = (bf16_t*)(a.ws + WS_XM);
    for (int row = gw; row < nrows; row += NGW) {
        const int isctx = row >= TL; float* h = hrow(a, row);
        const float* src = MODE == 0 ? (isctx ? a.in[2] + (size_t)(row - TL) * D : a.in[0] + (size_t)row * D) : h;
        f32x4 v[8];
#pragma unroll
        for (int j = 0; j < 8; ++j) v[j] = *(const f32x4*)(src + 4 * lane + 256 * j);
        if (MODE == 1) {
            float s = 0.f;
#pragma unroll
            for (int j = 0; j < 8; ++j) s += (v[j][0] + v[j][1]) + (v[j][2] + v[j][3]);
            const float mean = wave_sum(s) * (1.f / D); float q = 0.f;
#pragma unroll
            for (int j = 0; j < 8; ++j) { v[j] = v[j] - mean; q += (v[j][0] * v[j][0] + v[j][1] * v[j][1]) + (v[j][2] * v[j][2] + v[j][3] * v[j][3]); }
            const float rstd = __builtin_amdgcn_rsqf(wave_sum(q) * (1.f / D) + LN_EPS);
#pragma unroll
            for (int j = 0; j < 8; ++j) { const f32x4 g = *(const f32x4*)(lng + 4 * lane + 256 * j), b = *(const f32x4*)(lnb + 4 * lane + 256 * j); v[j] = v[j] * rstd * g + b; }
        }
#ifdef MK_SANITIZE
#pragma unroll
        for (int j = 0; j < 8; ++j)
#pragma unroll
            for (int e = 0; e < 4; ++e) if (!(fabsf(v[j][e]) < 1e30f)) v[j][e] = 0.f;
#endif
#pragma unroll
        for (int j = 0; j < 8; ++j) *(f32x4*)(h + 4 * lane + 256 * j) = v[j];
        if (mod_layer >= 0) { const float* m = mvec(a, mod_layer, isctx) + mod_off;
#pragma unroll
            for (int j = 0; j < 8; ++j) { const f32x4 sh = *(const f32x4*)(m + 4 * lane + 256 * j), scl = *(const f32x4*)(m + D + 4 * lane + 256 * j); const f32x4 o = v[j] * (scl + 1.f) + sh;
                u32x2 w; w.x = cvt_pk_bf16(o[0], o[1]); w.y = cvt_pk_bf16(o[2], o[3]); *(u32x2*)(XM + (size_t)row * D + 4 * lane + 256 * j) = w; } }
    }
}

__device__ __forceinline__ void ffnconv_ctx(const Args& a, int layer, int tid) {
    const bf16_t* G = (const bf16_t*)(a.ws + WS_BIG + B_G); bf16_t* V = (bf16_t*)(a.ws + WS_BIG + B_V);
    const float* cw = a.in[28] + (size_t)layer * 9 * DFF; const float* cb = a.in[29] + (size_t)layer * DFF;
    const int nunits = 260 * 11; const int oc = tid & 63, xs = tid >> 6;
    for (int unit = 256 * 11 + blockIdx.x; unit < nunits; unit += gridDim.x) {
        const int seg = unit / 11, ob = unit % 11, ch0 = ob * 512 + oc * 8; const bool cs = seg >= 256; const int t0 = seg * 64;
        float w[9][8], bias[8];
#pragma unroll
        for (int k = 0; k < 9; ++k) { const f32x4 w0 = *(const f32x4*)(cw + (size_t)k * DFF + ch0), w1 = *(const f32x4*)(cw + (size_t)k * DFF + ch0 + 4);
            w[k][0] = w0[0]; w[k][1] = w0[1]; w[k][2] = w0[2]; w[k][3] = w0[3]; w[k][4] = w1[0]; w[k][5] = w1[1]; w[k][6] = w1[2]; w[k][7] = w1[3]; }
        { const f32x4 b0 = *(const f32x4*)(cb + ch0), b1 = *(const f32x4*)(cb + ch0 + 4); bias[0] = b0[0]; bias[1] = b0[1]; bias[2] = b0[2]; bias[3] = b0[3]; bias[4] = b1[0]; bias[5] = b1[1]; bias[6] = b1[2]; bias[7] = b1[3]; }
#pragma unroll 4
        for (int xi = 0; xi < 8; ++xi) { const int x = xs * 8 + xi, t = t0 + x; float acc[8];
#pragma unroll
            for (int k = 0; k < 8; ++k) acc[k] = bias[k];
#pragma unroll
            for (int dy = -1; dy <= 1; ++dy) { bool rok = cs ? (dy == 0) : ((dy < 0 ? seg > 0 : true) && (dy > 0 ? seg < 255 : true));
#pragma unroll
                for (int dx = -1; dx <= 1; ++dx) { const bool ok = rok && (cs ? (t + dx >= TL && t + dx < MT) : (x + dx >= 0 && x + dx < 64));
                    if (ok) { const u32x4 g = *(const u32x4*)(G + (size_t)(t + dy * 64 + dx) * DFF + ch0); const int k = (dy + 1) * 3 + dx + 1;
                        acc[0] += w[k][0] * bflo(g.x); acc[1] += w[k][1] * bfhi(g.x); acc[2] += w[k][2] * bflo(g.y); acc[3] += w[k][3] * bfhi(g.y);
                        acc[4] += w[k][4] * bflo(g.z); acc[5] += w[k][5] * bfhi(g.z); acc[6] += w[k][6] * bflo(g.w); acc[7] += w[k][7] * bfhi(g.w); } } }
            bf16_t* vp = V + (size_t)t * DFF + ch0; const u32x4 vv = *(const u32x4*)vp;
            u32x4 o; o.x = cvt_pk_bf16(silu_(acc[0]) * bflo(vv.x), silu_(acc[1]) * bfhi(vv.x)); o.y = cvt_pk_bf16(silu_(acc[2]) * bflo(vv.y), silu_(acc[3]) * bfhi(vv.y));
            o.z = cvt_pk_bf16(silu_(acc[4]) * bflo(vv.z), silu_(acc[5]) * bfhi(vv.z)); o.w = cvt_pk_bf16(silu_(acc[6]) * bflo(vv.w), silu_(acc[7]) * bfhi(vv.w));
            *(u32x4*)vp = o; }
    }
}

__device__ __forceinline__ void ffnconv_phase(const Args& a, int layer, bool with_ctx, unsigned char* lds, int tid) {
    const bf16_t* G = (const bf16_t*)(a.ws + WS_BIG + B_G); bf16_t* V = (bf16_t*)(a.ws + WS_BIG + B_V);
    const float* cw = a.in[28] + (size_t)layer * 9 * DFF; const float* cb = a.in[29] + (size_t)layer * DFF;
    bf16_t* T = (bf16_t*)lds;
    const int oc = tid & 15, ts = tid >> 4;
    for (int unit = blockIdx.x; unit < 64 * 44; unit += gridDim.x) {
        const int rg = unit / 44, ch0 = (unit % 44) * 128 + oc * 8, y0 = rg * 4;
        __syncthreads();
#pragma unroll
        for (int i = 0; i < 12; ++i) { const int idx = tid + i * 512, r = idx >> 10, x = (idx >> 4) & 63, y = y0 - 1 + r; const bool ok = y >= 0 && y < 256;
            u32x4 v = *(const u32x4*)(G + (size_t)((ok ? y : y0) * 64 + x) * DFF + ch0); if (!ok) v = (u32x4){0u, 0u, 0u, 0u};
            *(u32x4*)(T + ((r * 64 + x) * 128 + oc * 8)) = v; }
        u32x4 vv[8];
#pragma unroll
        for (int o = 0; o < 8; ++o) vv[o] = *(const u32x4*)(V + (size_t)((y0 + (o >> 1)) * 64 + ts * 2 + (o & 1)) * DFF + ch0);
        float w[9][8], bias[8];
#pragma unroll
        for (int k = 0; k < 9; ++k) { const f32x4 w0 = *(const f32x4*)(cw + (size_t)k * DFF + ch0), w1 = *(const f32x4*)(cw + (size_t)k * DFF + ch0 + 4);
            w[k][0] = w0[0]; w[k][1] = w0[1]; w[k][2] = w0[2]; w[k][3] = w0[3]; w[k][4] = w1[0]; w[k][5] = w1[1]; w[k][6] = w1[2]; w[k][7] = w1[3]; }
        { const f32x4 b0 = *(const f32x4*)(cb + ch0), b1 = *(const f32x4*)(cb + ch0 + 4); bias[0] = b0[0]; bias[1] = b0[1]; bias[2] = b0[2]; bias[3] = b0[3]; bias[4] = b1[0]; bias[5] = b1[1]; bias[6] = b1[2]; bias[7] = b1[3]; }
        __syncthreads();
#pragma unroll
        for (int o = 0; o < 8; ++o) { const int rr = o >> 1, x = ts * 2 + (o & 1); float acc[8];
#pragma unroll
            for (int k = 0; k < 8; ++k) acc[k] = bias[k];
#pragma unroll
            for (int dy = -1; dy <= 1; ++dy)
#pragma unroll
                for (int dx = -1; dx <= 1; ++dx) { const int xn = x + dx; const bool ok = xn >= 0 && xn < 64;
                    u32x4 g = *(const u32x4*)(T + (((rr + 1 + dy) * 64 + (ok ? xn : x)) * 128 + oc * 8)); if (!ok) g = (u32x4){0u, 0u, 0u, 0u}; const int k = (dy + 1) * 3 + dx + 1;
                    acc[0] += w[k][0] * bflo(g.x); acc[1] += w[k][1] * bfhi(g.x); acc[2] += w[k][2] * bflo(g.y); acc[3] += w[k][3] * bfhi(g.y);
                    acc[4] += w[k][4] * bflo(g.z); acc[5] += w[k][5] * bfhi(g.z); acc[6] += w[k][6] * bflo(g.w); acc[7] += w[k][7] * bfhi(g.w); }
            const u32x4 v = vv[o];
            u32x4 q; q.x = cvt_pk_bf16(silu_(acc[0]) * bflo(v.x), silu_(acc[1]) * bfhi(v.x)); q.y = cvt_pk_bf16(silu_(acc[2]) * bflo(v.y), silu_(acc[3]) * bfhi(v.y));
            q.z = cvt_pk_bf16(silu_(acc[4]) * bflo(v.z), silu_(acc[5]) * bfhi(v.z)); q.w = cvt_pk_bf16(silu_(acc[6]) * bflo(v.w), silu_(acc[7]) * bfhi(v.w));
            *(u32x4*)(V + (size_t)((y0 + rr) * 64 + x) * DFF + ch0) = q; }
    }
    __syncthreads();
    if (with_ctx) ffnconv_ctx(a, layer, tid);
}
__device__ __forceinline__ int s5_chunk_at(int dir, int q) { return dir ? 129 - q : (q + 128) % 130; }
__device__ __forceinline__ int s5_pos_of(int dir, int c) { return dir ? 129 - c : (c + 2) % 130; }
template <int PASS> __device__ __forceinline__ void s5_phase(const Args& a, int layer, unsigned char* lds, int tid, int nchunks) {
    constexpr int BUP = 132;
    const bf16_t* U5 = (const bf16_t*)(a.ws + WS_BIG + B_U5); bf16_t* Y5 = (bf16_t*)(a.ws + WS_BIG + B_Y5);
    float2* S5LOC = (float2*)(a.ws + WS_S5LOC);
    const int lane = tid & 63, w = tid >> 6, gl = w >> 1, dir = w & 1, p = lane, fr = lane & 15, fq = lane >> 4;
    float* BuW = (float*)lds + (size_t)w * (16 * BUP);
    bf16_t* STw = (bf16_t*)(lds + 67584) + (size_t)w * (16 * 136);
    float* YL = (float*)(lds + 102400);
    const int gq = blockIdx.x & 15, g = gq * 4 + gl;
    float ab_re, ab_im, a128r, a128i;
    const float step = expf(a.in[9][(size_t)(layer * 2 + dir) * 64 + g]);
    { const size_t pi = ((size_t)(layer * 2 + dir) * 64 + g) * 64 + p; const float lre = fminf(a.in[7][pi], -1e-4f), lim = a.in[8][pi];
      const float mag = expf(lre * step); float sn, cs; sincosf(lim * step, &sn, &cs); ab_re = mag * cs; ab_im = mag * sn; a128r = ab_re; a128i = ab_im;
#pragma unroll
      for (int k = 0; k < 7; ++k) { const float r = a128r * a128r - a128i * a128i, i = 2.f * a128r * a128i; a128r = r; a128i = i; } }
    bf16x8 bbf[8];
#pragma unroll
    for (int nt = 0; nt < 8; ++nt) { const int pp = nt * 8 + (fr >> 1), cc = fr & 1; const size_t pi = ((size_t)(layer * 2 + dir) * 64 + g) * 64 + pp;
        const float lre = fminf(a.in[7][pi], -1e-4f), lim = a.in[8][pi]; const float mag = expf(lre * step); float sn, cs; sincosf(lim * step, &sn, &cs);
        const float are = mag * cs, aim = mag * sn, den = lre * lre + lim * lim, q_re = ((are - 1.f) * lre + aim * lim) / den, q_im = (aim * lre - (are - 1.f) * lim) / den;
        const float* br = a.in[10] + (((size_t)layer * 64 + g) * 64 + pp) * 16 + (fq & 1) * 8; const float* bi = a.in[11] + (((size_t)layer * 64 + g) * 64 + pp) * 16 + (fq & 1) * 8;
        const f32x4 r0 = *(const f32x4*)br, r1 = *(const f32x4*)(br + 4), i0 = *(const f32x4*)bi, i1 = *(const f32x4*)(bi + 4); float v[8];
#pragma unroll
        for (int j = 0; j < 8; ++j) { const float r = j < 4 ? r0[j & 3] : r1[j & 3], i = j < 4 ? i0[j & 3] : i1[j & 3]; v[j] = fq < 2 ? (cc ? q_re * i + q_im * r : q_re * r - q_im * i) : 0.f; }
        bbf[nt] = mkfrag(cvt_pk_bf16(v[0], v[1]), cvt_pk_bf16(v[2], v[3]), cvt_pk_bf16(v[4], v[5]), cvt_pk_bf16(v[6], v[7])); }
    bf16x8 cm[4];
    if (PASS == 1) {
        const float* cre = a.in[12] + (((size_t)(layer * 2 + dir) * 64 + g) * 16 + fr) * 64; const float* cim = a.in[13] + (((size_t)(layer * 2 + dir) * 64 + g) * 16 + fr) * 64;
#pragma unroll
        for (int ks = 0; ks < 4; ++ks) { const f32x4 r = *(const f32x4*)(cre + ks * 16 + fq * 4), i = *(const f32x4*)(cim + ks * 16 + fq * 4);
            cm[ks] = mkfrag(cvt_pk_bf16(r[0], -i[0]), cvt_pk_bf16(r[1], -i[1]), cvt_pk_bf16(r[2], -i[2]), cvt_pk_bf16(r[3], -i[3])); }
    }
    const int cstep = gridDim.x >> 4;
    for (int c = blockIdx.x >> 4; c < nchunks; c += cstep) {
        const int row0 = c * 128;
        bf16x8 uf[8];
#pragma unroll
        for (int k = 0; k < 8; ++k) { const int sl = dir ? 7 - k : k; const u32x4 v = *(const u32x4*)(U5 + (size_t)(row0 + sl * 16 + fr) * 1024 + g * 16 + (fq & 1) * 8);
            uf[k] = fq < 2 ? __builtin_bit_cast(bf16x8, v) : mkfrag(0u, 0u, 0u, 0u); }
        float sr = 0.f, si = 0.f;
        if (PASS == 1) {
            const int pos = s5_pos_of(dir, c);
#pragma unroll 1
            for (int q0 = 0; q0 < pos; q0 += 13) { float2 l[13];
#pragma unroll
                for (int i = 0; i < 13; ++i) { const int q = q0 + i < pos ? q0 + i : pos - 1; l[i] = S5LOC[((size_t)(dir * NCH + s5_chunk_at(dir, q)) * 64 + g) * 64 + p]; }
#pragma unroll
                for (int i = 0; i < 13; ++i) if (q0 + i < pos) { const float nr = a128r * sr - a128i * si + l[i].x, ni = a128r * si + a128i * sr + l[i].y; sr = nr; si = ni; } }
        }
        f32x4 yacc[8];
#pragma unroll
        for (int k = 0; k < 8; ++k) {
#pragma unroll
            for (int nt = 0; nt < 8; ++nt) { f32x4 acc = {0.f, 0.f, 0.f, 0.f}; acc = __builtin_amdgcn_mfma_f32_16x16x32_bf16(uf[k], bbf[nt], acc, 0, 0, 0);
#pragma unroll
                for (int jj = 0; jj < 4; ++jj) BuW[(fq * 4 + jj) * BUP + nt * 16 + fr] = acc[jj]; }
            asm volatile("s_waitcnt lgkmcnt(0)" ::: "memory");
#pragma unroll
            for (int ii = 0; ii < 16; ++ii) { const int tl = dir ? 15 - ii : ii; const f32x2 b2 = *(const f32x2*)(BuW + tl * BUP + 2 * p);
                f32x2 ns = __builtin_elementwise_fma((f32x2){ab_re, ab_re}, (f32x2){sr, si}, b2); ns = __builtin_elementwise_fma((f32x2){-ab_im, ab_im}, (f32x2){si, sr}, ns); sr = ns[0]; si = ns[1];
                if (PASS == 1) *(unsigned*)(STw + tl * 136 + 2 * p) = cvt_pk_bf16(sr, si); }
            if (PASS == 1) {
                asm volatile("s_waitcnt lgkmcnt(0)" ::: "memory");
                f32x4 acc = {0.f, 0.f, 0.f, 0.f};
#pragma unroll
                for (int ks = 0; ks < 4; ++ks) acc = __builtin_amdgcn_mfma_f32_16x16x32_bf16(*(const bf16x8*)(STw + fr * 136 + ks * 32 + fq * 8), cm[ks], acc, 0, 0, 0);
                yacc[k] = acc;
            }
            asm volatile("s_waitcnt lgkmcnt(0)" ::: "memory");
        }
        if (PASS == 0) { S5LOC[((size_t)(dir * NCH + c) * 64 + g) * 64 + p] = make_float2(sr, si); }
        else {
            __syncthreads();
            if (dir == 0) {
#pragma unroll
                for (int k = 0; k < 8; ++k)
#pragma unroll
                    for (int jj = 0; jj < 4; ++jj) YL[gl * 2048 + (k * 16 + fq * 4 + jj) * 16 + fr] = yacc[k][jj]; }
            __syncthreads();
            if (dir == 1) {
#pragma unroll
                for (int k = 0; k < 8; ++k)
#pragma unroll
                    for (int jj = 0; jj < 4; ++jj) YL[gl * 2048 + ((7 - k) * 16 + fq * 4 + jj) * 16 + fr] += yacc[k][jj]; }
            __syncthreads();
            const int t = tid >> 2, q = tid & 3; const float* y = YL + q * 2048 + t * 16; const float* dd = a.in[14] + (size_t)layer * 1024 + gq * 64 + q * 16;
            const bf16_t* us = U5 + (size_t)(row0 + t) * 1024 + gq * 64 + q * 16; const u32x4 u0 = *(const u32x4*)us, u1 = *(const u32x4*)(us + 8);
            const float u[16] = {bflo(u0.x), bfhi(u0.x), bflo(u0.y), bfhi(u0.y), bflo(u0.z), bfhi(u0.z), bflo(u0.w), bfhi(u0.w), bflo(u1.x), bfhi(u1.x), bflo(u1.y), bfhi(u1.y), bflo(u1.z), bfhi(u1.z), bflo(u1.w), bfhi(u1.w)};
            unsigned o[8];
#pragma unroll
            for (int j = 0; j < 8; ++j) { const float y0 = y[2 * j] + u[2 * j] * dd[2 * j], y1 = y[2 * j + 1] + u[2 * j + 1] * dd[2 * j + 1]; o[j] = cvt_pk_bf16(gelu_tanh(y0), gelu_tanh(y1)); }
            bf16_t* dst = Y5 + (size_t)(row0 + t) * 1024 + gq * 64 + q * 16; u32x4 o0, o1; o0.x = o[0]; o0.y = o[1]; o0.z = o[2]; o0.w = o[3]; o1.x = o[4]; o1.y = o[5]; o1.z = o[6]; o1.w = o[7];
            *(u32x4*)dst = o0; *(u32x4*)(dst + 8) = o1;
        }
    }
    __syncthreads();
}

__device__ __forceinline__ int ssd_chunk_at(int dir, int q) { return s5_chunk_at(dir, q); }
__device__ __forceinline__ void conv8(const bf16_t* XBC, int rowbase, int l0, int ch, bool lo_ok, bool hi_ok, float w0, float w1, float w2, float b, float (&out)[8]) {
    float r[10];
#pragma unroll
    for (int i = 0; i < 10; ++i) { const int l = l0 - 1 + i; const bool ok = (l >= 0 || lo_ok) && (l < 128 || hi_ok); r[i] = ok ? bf2f((unsigned)XBC[(size_t)(rowbase + l) * 3072 + ch]) : 0.f; }
#pragma unroll
    for (int j = 0; j < 8; ++j) out[j] = silu_(w0 * r[j] + w1 * r[j + 1] + w2 * r[j + 2] + b);
}
__device__ __forceinline__ void stage_conv_tile(const bf16_t* XBC, const float* cw, const float* cb, int rowbase, int chbase, bool lo_ok, bool hi_ok, bf16_t* dst, int tid) {
    const int oc = tid & 15, ch = chbase + oc * 8; float w[3][8], b[8];
#pragma unroll
    for (int k = 0; k < 3; ++k) { const f32x4 a0 = *(const f32x4*)(cw + (size_t)k * 3072 + ch), a1 = *(const f32x4*)(cw + (size_t)k * 3072 + ch + 4);
        w[k][0] = a0[0]; w[k][1] = a0[1]; w[k][2] = a0[2]; w[k][3] = a0[3]; w[k][4] = a1[0]; w[k][5] = a1[1]; w[k][6] = a1[2]; w[k][7] = a1[3]; }
    { const f32x4 a0 = *(const f32x4*)(cb + ch), a1 = *(const f32x4*)(cb + ch + 4); b[0] = a0[0]; b[1] = a0[1]; b[2] = a0[2]; b[3] = a0[3]; b[4] = a1[0]; b[5] = a1[1]; b[6] = a1[2]; b[7] = a1[3]; }
#pragma unroll
    for (int i = 0; i < 4; ++i) { const int row = (tid >> 4) + i * 32; float acc[8];
#pragma unroll
        for (int k = 0; k < 8; ++k) acc[k] = b[k];
#pragma unroll
        for (int d = 0; d < 3; ++d) { const bool ok = d == 1 ? true : (d == 0 ? (row > 0 || lo_ok) : (row < 127 || hi_ok)); const int l = ok ? row + d - 1 : row;
            { u32x4 g = *(const u32x4*)(XBC + (size_t)(rowbase + l) * 3072 + ch); if (!ok) g = (u32x4){0u, 0u, 0u, 0u};
                acc[0] += w[d][0] * bflo(g.x); acc[1] += w[d][1] * bfhi(g.x); acc[2] += w[d][2] * bflo(g.y); acc[3] += w[d][3] * bfhi(g.y);
                acc[4] += w[d][4] * bflo(g.z); acc[5] += w[d][5] * bfhi(g.z); acc[6] += w[d][6] * bflo(g.w); acc[7] += w[d][7] * bfhi(g.w); } }
        u32x4 o; o.x = cvt_pk_bf16(silu_(acc[0]), silu_(acc[1])); o.y = cvt_pk_bf16(silu_(acc[2]), silu_(acc[3])); o.z = cvt_pk_bf16(silu_(acc[4]), silu_(acc[5])); o.w = cvt_pk_bf16(silu_(acc[6]), silu_(acc[7]));
        *(u32x4*)(dst + row * 136 + oc * 8) = o; }
}
constexpr int SL_CS = 0, SL_CB = 34816, SL_CUM = 69632, SL_DT = 77824, SL_PART = 86016, SL_BS = 94208, SL_XT = 94208;
template <int AUX> __device__ __forceinline__ void ssd_cum(const Args& a, int layer, int c, int h, int w, int lane, unsigned char* lds) {
    const float* DT = (const float*)(a.ws + WS_BIG + B_DT); float* cumL = (float*)(lds + SL_CUM); float* dtL = (float*)(lds + SL_DT); float* CHD = (float*)(a.ws + WS_CHD);
#pragma unroll
    for (int dir = 0; dir < 2; ++dir) {
        const float ah = -expf(a.in[20][(size_t)(layer * 2 + dir) * 32 + h]);
        const float d0 = DT[(size_t)(c * 128 + 2 * lane) * 64 + dir * 32 + h], d1 = DT[(size_t)(c * 128 + 2 * lane + 1) * 64 + dir * 32 + h];
        const float l0 = d0 * ah, l1 = d1 * ah, s = l0 + l1; float incl = s;
#pragma unroll
        for (int o = 1; o < 64; o <<= 1) { const float t = __shfl_up(incl, o); if (lane >= o) incl += t; }
        const float excl = incl - s, tot = __shfl(incl, 63);
        float c0, c1;
        if (dir == 0) { c0 = excl + l0; c1 = incl; } else { c0 = tot - excl; c1 = tot - (excl + l0); }
        float* cu = cumL + (dir * 8 + w) * 128 + 2 * lane; cu[0] = c0; cu[1] = c1;
        float* dd = dtL + (dir * 8 + w) * 128 + 2 * lane;
        if (AUX == 0) { dd[0] = d0; dd[1] = d1; } else { dd[0] = d0 * __expf(tot - c0); dd[1] = d1 * __expf(tot - c1); if (lane == 0) CHD[(size_t)(dir * NCH + c) * 32 + h] = tot; }
    }
}
__device__ __forceinline__ void stage_T(const bf16_t* XBC, const float* cw, const float* cb, int rowbase, int ch, int r0, bool lo_ok, bool hi_ok, bf16_t* dstT) {
    float w[3][8], b[8];
#pragma unroll
    for (int k = 0; k < 3; ++k) { const f32x4 a0 = *(const f32x4*)(cw + (size_t)k * 3072 + ch), a1 = *(const f32x4*)(cw + (size_t)k * 3072 + ch + 4);
        w[k][0] = a0[0]; w[k][1] = a0[1]; w[k][2] = a0[2]; w[k][3] = a0[3]; w[k][4] = a1[0]; w[k][5] = a1[1]; w[k][6] = a1[2]; w[k][7] = a1[3]; }
    { const f32x4 a0 = *(const f32x4*)(cb + ch), a1 = *(const f32x4*)(cb + ch + 4); b[0] = a0[0]; b[1] = a0[1]; b[2] = a0[2]; b[3] = a0[3]; b[4] = a1[0]; b[5] = a1[1]; b[6] = a1[2]; b[7] = a1[3]; }
    u32x4 raw[10];
    const bf16_t* base = XBC + (size_t)(rowbase + r0) * 3072 + ch;
    const bool ok0 = r0 > 0 || lo_ok, ok9 = r0 < 120 || hi_ok;
#pragma unroll
    for (int i = 1; i < 9; ++i) raw[i] = *(const u32x4*)(base + (i - 1) * 3072);
    { const u32x4 v = *(const u32x4*)(base + (ok0 ? -3072 : 0)); raw[0] = ok0 ? v : (u32x4){0u, 0u, 0u, 0u}; }
    { const u32x4 v = *(const u32x4*)(base + (ok9 ? 8 * 3072 : 7 * 3072)); raw[9] = ok9 ? v : (u32x4){0u, 0u, 0u, 0u}; }
    float sp[8]; unsigned o[8][4];
#pragma unroll
    for (int r = 0; r < 8; ++r) { float sv[8];
#pragma unroll
        for (int k = 0; k < 8; ++k) { float acc = b[k];
#pragma unroll
            for (int d = 0; d < 3; ++d) { const unsigned wd = k < 2 ? raw[r + d].x : (k < 4 ? raw[r + d].y : (k < 6 ? raw[r + d].z : raw[r + d].w)); acc += w[d][k] * ((k & 1) ? bfhi(wd) : bflo(wd)); }
            sv[k] = silu_(acc); }
        if (r & 1) {
#pragma unroll
            for (int k = 0; k < 8; ++k) o[k][r >> 1] = cvt_pk_bf16(sp[k], sv[k]); }
        else {
#pragma unroll
            for (int k = 0; k < 8; ++k) sp[k] = sv[k]; } }
#pragma unroll
    for (int k = 0; k < 8; ++k) { u32x4 v; v.x = o[k][0]; v.y = o[k][1]; v.z = o[k][2]; v.w = o[k][3]; *(u32x4*)(dstT + k * 136 + r0) = v; }
}
__device__ __forceinline__ void ssd_a_phase(const Args& a, int layer, unsigned char* lds, int tid) {
    const bf16_t* XBC = (const bf16_t*)(a.ws + WS_BIG + B_XBC); bf16_t* SST = (bf16_t*)(a.ws + WS_SST);
    const float* cw = a.in[17] + (size_t)layer * 3 * 3072; const float* cb = a.in[18] + (size_t)layer * 3072;
    bf16_t* BT = (bf16_t*)(lds + SL_CS); bf16_t* xT = (bf16_t*)(lds + SL_XT); const float* wL = (const float*)(lds + SL_DT);
    for (int unit = blockIdx.x; unit < NCH * 4; unit += gridDim.x) {
        int tl = tid; asm volatile("" : "+v"(tl));
        const int lane = tl & 63, w = __builtin_amdgcn_readfirstlane(tl >> 6), fr = lane & 15, fq = lane >> 4, og = lane & 7, rr = lane >> 3;
        const int c = unit >> 2, g = unit & 3, rowbase = c * 128; const bool lo_ok = !(c == 0 || c == 128), hi_ok = !(c == 127 || c == 129);
        __syncthreads();
        if (w < 4) { const int oct = (w & 1) * 8 + og; stage_T(XBC, cw, cb, rowbase, 2048 + g * 128 + oct * 8, ((w >> 1) * 8 + rr) * 8, lo_ok, hi_ok, BT + (oct * 8) * 136); }
        ssd_cum<1>(a, layer, c, g * 8 + w, w, lane, lds);
#pragma unroll 1
        for (int pass = 0; pass < 2; ++pass) {
            if (pass) __syncthreads();
            { const int hs = w & 3; stage_T(XBC, cw, cb, rowbase, (g * 8 + pass * 4 + hs) * 64 + og * 8, ((w >> 2) * 8 + rr) * 8, lo_ok, hi_ok, xT + ((hs * 64 + og * 8) * 136)); }
            __syncthreads();
            const int hl = w >> 1, dir = w & 1, hh = pass * 4 + hl, h = g * 8 + hh;
            bf16_t* sb = SST + (((size_t)(dir * NCH + c) * 32 + h) * 64) * 128;
#pragma unroll 1
            for (int nh = 0; nh < 2; ++nh) {
                f32x4 acc[4][4];
#pragma unroll
                for (int pt = 0; pt < 4; ++pt)
#pragma unroll
                    for (int nt = 0; nt < 4; ++nt) acc[pt][nt] = (f32x4){0.f, 0.f, 0.f, 0.f};
#pragma unroll
                for (int ks = 0; ks < 4; ++ks) {
                    const float* wp = wL + (dir * 8 + hh) * 128 + ks * 32 + fq * 8; const f32x4 wl0 = *(const f32x4*)wp, wl1 = *(const f32x4*)(wp + 4);
                    bf16x8 yf[4];
#pragma unroll
                    for (int pt = 0; pt < 4; ++pt) { const u32x4 xr = *(const u32x4*)(xT + ((hl * 64 + pt * 16 + fr) * 136 + ks * 32 + fq * 8));
                        yf[pt] = mkfrag(cvt_pk_bf16(bflo(xr.x) * wl0[0], bfhi(xr.x) * wl0[1]), cvt_pk_bf16(bflo(xr.y) * wl0[2], bfhi(xr.y) * wl0[3]), cvt_pk_bf16(bflo(xr.z) * wl1[0], bfhi(xr.z) * wl1[1]), cvt_pk_bf16(bflo(xr.w) * wl1[2], bfhi(xr.w) * wl1[3])); }
#pragma unroll
                    for (int nt = 0; nt < 4; ++nt) { const bf16x8 xf = *(const bf16x8*)(BT + ((nh * 4 + nt) * 16 + fr) * 136 + ks * 32 + fq * 8);
#pragma unroll
                        for (int pt = 0; pt < 4; ++pt) acc[pt][nt] = __builtin_amdgcn_mfma_f32_16x16x32_bf16(xf, yf[pt], acc[pt][nt], 0, 0, 0); }
                }
#pragma unroll
                for (int pt = 0; pt < 4; ++pt) mfma_settle(acc[pt][3]);
#pragma unroll
                for (int pt = 0; pt < 4; ++pt)
#pragma unroll
                    for (int nt = 0; nt < 4; ++nt) { u32x2 o; o.x = cvt_pk_native(acc[pt][nt][0], acc[pt][nt][1]); o.y = cvt_pk_native(acc[pt][nt][2], acc[pt][nt][3]);
                        *(u32x2*)(sb + (size_t)(pt * 16 + fr) * 128 + (nh * 4 + nt) * 16 + fq * 4) = o; }
            }
        }
    }
    __syncthreads();
}
__device__ __forceinline__ void ssd_b_phase(const Args& a, int tid) {
    bf16_t* SST = (bf16_t*)(a.ws + WS_SST); const float* CHD = (const float*)(a.ws + WS_CHD);
    for (int idx = blockIdx.x * 512 + tid; idx < 64 * 2048; idx += gridDim.x * 512) {
        const int e4 = idx & 2047, hd = idx >> 11, dir = hd >> 5, h = hd & 31; float s0 = 0.f, s1 = 0.f, s2 = 0.f, s3 = 0.f;
#pragma unroll 1
        for (int b = 0; b < 13; ++b) { u32x2 loc[10]; float dc[10];
#pragma unroll
            for (int i = 0; i < 10; ++i) { const int cq = ssd_chunk_at(dir, b * 10 + i); loc[i] = *(const u32x2*)(SST + ((size_t)(dir * NCH + cq) * 32 + h) * 8192 + e4 * 4); dc[i] = CHD[(size_t)(dir * NCH + cq) * 32 + h]; }
#pragma unroll
            for (int i = 0; i < 10; ++i) { const int cq = ssd_chunk_at(dir, b * 10 + i); u32x2 o; o.x = cvt_pk_bf16(s0, s1); o.y = cvt_pk_bf16(s2, s3);
                *(u32x2*)(SST + ((size_t)(dir * NCH + cq) * 32 + h) * 8192 + e4 * 4) = o; const float e = __expf(dc[i]);
                s0 = e * s0 + bflo(loc[i].x); s1 = e * s1 + bfhi(loc[i].x); s2 = e * s2 + bflo(loc[i].y); s3 = e * s3 + bfhi(loc[i].y); }
        }
    }
}
__device__ __forceinline__ void ssd_c_phase(const Args& a, int layer, unsigned char* lds, int tid, int nchunks) {
    const bf16_t* XBC = (const bf16_t*)(a.ws + WS_BIG + B_XBC); const bf16_t* SST = (const bf16_t*)(a.ws + WS_SST); const bf16_t* Z = (const bf16_t*)(a.ws + WS_BIG + B_Z); bf16_t* YD = (bf16_t*)(a.ws + WS_BIG + B_YD);
    const float* cw = a.in[17] + (size_t)layer * 3 * 3072; const float* cb = a.in[18] + (size_t)layer * 3072; const float* normw = a.in[22] + (size_t)layer * 2048;
    bf16_t* Cs = (bf16_t*)(lds + SL_CS); bf16_t* Bs = (bf16_t*)(lds + SL_BS); bf16_t* CBs = (bf16_t*)(lds + SL_CB); bf16_t* xT = (bf16_t*)(lds + SL_XT);
    const float* cumL = (const float*)(lds + SL_CUM); const float* dtL = (const float*)(lds + SL_DT); float* part = (float*)(lds + SL_PART);
    for (int unit = blockIdx.x; unit < nchunks * 4; unit += gridDim.x) {
        int tl = tid; asm volatile("" : "+v"(tl));
        const int lane = tl & 63, w = __builtin_amdgcn_readfirstlane(tl >> 6), fr = lane & 15, fq = lane >> 4, og = lane & 7, rr = lane >> 3;
        const int hl = w & 3, lh = w >> 2;
        const int c = unit >> 2, g = unit & 3, rowbase = c * 128; const bool lo_ok = !(c == 0 || c == 128), hi_ok = !(c == 127 || c == 129);
        __syncthreads();
        stage_conv_tile(XBC, cw, cb, rowbase, 2560 + g * 128, lo_ok, hi_ok, Cs, tl);
        stage_conv_tile(XBC, cw, cb, rowbase, 2048 + g * 128, lo_ok, hi_ok, Bs, tl);
        ssd_cum<0>(a, layer, c, g * 8 + w, w, lane, lds);
        __syncthreads();
#pragma unroll 1
        for (int st = 0; st < 8; ++st) { f32x4 acc = {0.f, 0.f, 0.f, 0.f};
#pragma unroll
            for (int ks = 0; ks < 4; ++ks) { const bf16x8 xf = *(const bf16x8*)(Bs + (st * 16 + fr) * 136 + ks * 32 + fq * 8), yf = *(const bf16x8*)(Cs + (w * 16 + fr) * 136 + ks * 32 + fq * 8);
                acc = __builtin_amdgcn_mfma_f32_16x16x32_bf16(xf, yf, acc, 0, 0, 0); }
            mfma_settle(acc);
            u32x2 o; o.x = cvt_pk_native(acc[0], acc[1]); o.y = cvt_pk_native(acc[2], acc[3]); *(u32x2*)(CBs + (w * 16 + fr) * 136 + st * 16 + fq * 4) = o; }
#pragma unroll 1
        for (int pass = 0; pass < 2; ++pass) {
            __syncthreads();
            stage_T(XBC, cw, cb, rowbase, (g * 8 + pass * 4 + hl) * 64 + og * 8, (lh * 8 + rr) * 8, lo_ok, hi_ok, xT + ((hl * 64 + og * 8) * 136));
            __syncthreads();
            const int hh = pass * 4 + hl, h = g * 8 + hh; const float Dh = a.in[21][(size_t)layer * 32 + h];
#pragma unroll 1
            for (int ih = 0; ih < 2; ++ih) {
            f32x4 acc[2][4];
#pragma unroll
            for (int i = 0; i < 2; ++i)
#pragma unroll
                for (int pt = 0; pt < 4; ++pt) acc[i][pt] = (f32x4){0.f, 0.f, 0.f, 0.f};
#pragma unroll
            for (int dir = 0; dir < 2; ++dir) {
                const bf16_t* sb = SST + (((size_t)(dir * NCH + c) * 32 + h) * 64) * 128;
                f32x4 tmp[2][4];
#pragma unroll
                for (int i = 0; i < 2; ++i)
#pragma unroll
                    for (int pt = 0; pt < 4; ++pt) tmp[i][pt] = (f32x4){0.f, 0.f, 0.f, 0.f};
#pragma unroll
                for (int ks = 0; ks < 4; ++ks) { const int lb = (lh * 4 + ih * 2) * 16 + fr;
                    const bf16x8 yf0 = *(const bf16x8*)(Cs + lb * 136 + ks * 32 + fq * 8), yf1 = *(const bf16x8*)(Cs + (lb + 16) * 136 + ks * 32 + fq * 8);
#pragma unroll
                    for (int pt = 0; pt < 4; ++pt) { const bf16x8 sfr = *(const bf16x8*)(sb + (size_t)(pt * 16 + fr) * 128 + ks * 32 + fq * 8);
                        tmp[0][pt] = __builtin_amdgcn_mfma_f32_16x16x32_bf16(sfr, yf0, tmp[0][pt], 0, 0, 0); tmp[1][pt] = __builtin_amdgcn_mfma_f32_16x16x32_bf16(sfr, yf1, tmp[1][pt], 0, 0, 0); } }
#pragma unroll
                for (int i = 0; i < 2; ++i) { int frv = fr; asm volatile("" : "+v"(frv));
                    const int lt = lh * 4 + ih * 2 + i, l = lt * 16 + frv;
                    const float cl = cumL[(dir * 8 + hh) * 128 + l], el = __expf(cl);
#pragma unroll
                    for (int pt = 0; pt < 4; ++pt) acc[i][pt] += tmp[i][pt] * el;
#pragma unroll
                    for (int ks = 0; ks < 4; ++ks) { const int s0 = ks * 32;
                        const bool skip = dir == 0 ? (s0 > lt * 16 + 15) : (s0 + 31 < lt * 16);
                        if (!skip) { const u32x4 cbv = *(const u32x4*)(CBs + l * 136 + s0 + fq * 8);
                            const float* cp = cumL + (dir * 8 + hh) * 128 + s0 + fq * 8; const float* dp = dtL + (dir * 8 + hh) * 128 + s0 + fq * 8;
                            const f32x4 c0 = *(const f32x4*)cp, c1 = *(const f32x4*)(cp + 4), d0 = *(const f32x4*)dp, d1 = *(const f32x4*)(dp + 4);
                            float cbf[8] = {bflo(cbv.x), bfhi(cbv.x), bflo(cbv.y), bfhi(cbv.y), bflo(cbv.z), bfhi(cbv.z), bflo(cbv.w), bfhi(cbv.w)}; float v[8];
#pragma unroll
                            for (int j = 0; j < 8; ++j) { const int sx = s0 + fq * 8 + j; const float cs = j < 4 ? c0[j & 3] : c1[j & 3], ds = j < 4 ? d0[j & 3] : d1[j & 3];
                                const bool valid = dir == 0 ? (sx <= l) : (sx >= l); float t = valid ? cbf[j] * __expf(fminf(cl - cs, 0.f)) * ds : 0.f; if (dir == 0 && sx == l) t += Dh; v[j] = t; }
                            const bf16x8 yf = mkfrag(cvt_pk_bf16(v[0], v[1]), cvt_pk_bf16(v[2], v[3]), cvt_pk_bf16(v[4], v[5]), cvt_pk_bf16(v[6], v[7]));
#pragma unroll
                            for (int pt = 0; pt < 4; ++pt) acc[i][pt] = __builtin_amdgcn_mfma_f32_16x16x32_bf16(*(const bf16x8*)(xT + ((hl * 64 + pt * 16 + fr) * 136 + s0 + fq * 8)), yf, acc[i][pt], 0, 0, 0); } }
                }
            }
#pragma unroll
            for (int i = 0; i < 2; ++i) { const int l = (lh * 4 + ih * 2 + i) * 16 + fr; const size_t row = (size_t)(rowbase + l); float ss = 0.f;
#pragma unroll
                for (int pt = 0; pt < 4; ++pt) { const int ch = h * 64 + pt * 16 + fq * 4; const u32x2 zz = *(const u32x2*)(Z + row * 2048 + ch);
                    const float h0 = acc[i][pt][0] * silu_(bflo(zz.x)), h1 = acc[i][pt][1] * silu_(bfhi(zz.x)), h2 = acc[i][pt][2] * silu_(bflo(zz.y)), h3 = acc[i][pt][3] * silu_(bfhi(zz.y));
                    ss += (h0 * h0 + h1 * h1) + (h2 * h2 + h3 * h3); u32x2 o; o.x = cvt_pk_bf16(h0, h1); o.y = cvt_pk_bf16(h2, h3); *(u32x2*)(YD + row * 2048 + ch) = o; }
                ss += __shfl_xor(ss, 16); ss += __shfl_xor(ss, 32);
                if (fq == 0) part[hh * 128 + l] = ss; }
            }
        }
        __syncthreads();
#pragma unroll 1
        for (int it = 0; it < 8; ++it) { const int pass = it >> 2, i = it & 3, l = (lh * 4 + i) * 16 + fr, h = g * 8 + pass * 4 + hl; float tot = 0.f;
#pragma unroll
            for (int hd = 0; hd < 8; ++hd) tot += part[hd * 128 + l];
            const float r = __builtin_amdgcn_rsqf(tot * (1.f / 512.f) + RMS_EPS); const size_t row = (size_t)(rowbase + l);
#pragma unroll
            for (int pt = 0; pt < 4; ++pt) { const int ch = h * 64 + pt * 16 + fq * 4; bf16_t* yp = YD + row * 2048 + ch; const u32x2 hv = *(const u32x2*)yp; const f32x4 nw = *(const f32x4*)(normw + ch);
                u32x2 o; o.x = cvt_pk_bf16(bflo(hv.x) * r * nw[0], bfhi(hv.x) * r * nw[1]); o.y = cvt_pk_bf16(bflo(hv.y) * r * nw[2], bfhi(hv.y) * r * nw[3]); *(u32x2*)yp = o; } }
    }
    __syncthreads();
}

#define LAS __attribute__((address_space(3)))
#define XB_TMO      128
#define XB_XCNT(j)  (256  + 64 * (j))
#define XB_XSUB(j)  (1280 + 64 * (j))
#define XB_XGEN(j)  (2304 + 64 * (j))
#define XB_TOP      3328
#define XB_TOPGEN   3392
#define XCD_BAR_WORDS 3456
#define XB_SPIN_CAP (1u << 18)

__device__ __forceinline__ unsigned xb_ld(unsigned* p)              { return __hip_atomic_load(p, __ATOMIC_RELAXED, __HIP_MEMORY_SCOPE_AGENT); }
__device__ __forceinline__ unsigned xb_add(unsigned* p, unsigned v) { return __hip_atomic_fetch_add(p, v, __ATOMIC_RELAXED, __HIP_MEMORY_SCOPE_AGENT); }
__device__ __forceinline__ unsigned xb_xcc_id() { return (unsigned)__builtin_amdgcn_s_getreg((3 << 11) | 20) & 0xFu; }
#define XB_SPIN(cond, bar) do { unsigned _sp = 0; while (cond) { __builtin_amdgcn_s_sleep(1); \
    if ((++_sp & 255u) == 0u) { if (xb_ld(&(bar)[XB_TMO])) break; if (_sp > XB_SPIN_CAP) { atomicAdd(&(bar)[XB_TMO], 1u); break; } } } } while (0)

struct XcdBarrier {
    unsigned* bar; unsigned x;
    volatile LAS unsigned* st;
};

__device__ __forceinline__ XcdBarrier xcd_barrier_post(unsigned* bar, volatile LAS unsigned* st) {
    XcdBarrier b; b.bar = bar; b.x = xb_xcc_id(); b.st = st;
    if (threadIdx.x == 0) (void)xb_add(&bar[XB_XCNT(b.x)], 1u);
    return b;
}
__device__ __forceinline__ void xcd_barrier_complete(unsigned* bar, unsigned x, unsigned& nloc, unsigned& nx) {
    const unsigned G = gridDim.x * gridDim.y * gridDim.z;
    unsigned sum, cnt, mine, sp = 0u;
    for (;;) {
        sum = 0u; cnt = 0u; mine = 0u;
#pragma unroll
        for (unsigned j = 0; j < 16; ++j) { const unsigned c = xb_ld(&bar[XB_XCNT(j)]); sum += c; cnt += (c > 0u) ? 1u : 0u; mine = (j == x) ? c : mine; }
        if (sum == G) break;
        __builtin_amdgcn_s_sleep(1);
        if ((++sp & 255u) == 0u) { if (xb_ld(&bar[XB_TMO])) break; if (sp > XB_SPIN_CAP) { atomicAdd(&bar[XB_TMO], 1u); break; } }
    }
    nloc = mine > 0u ? mine : 1u; nx = cnt > 0u ? cnt : 1u;
}

__device__ __forceinline__ void xcd_barrier(const XcdBarrier& b) {
    asm volatile("s_waitcnt vmcnt(0)" ::: "memory");
    __syncthreads();
    if (threadIdx.x == 0) {
        unsigned* bar = b.bar;
        __builtin_amdgcn_s_waitcnt(0);
        unsigned nloc = b.st[0], nx = b.st[1];
        if (nloc == 0u) { xcd_barrier_complete(bar, b.x, nloc, nx); b.st[0] = nloc; b.st[1] = nx; }
        const unsigned old = xb_add(&bar[XB_XSUB(b.x)], 1u);
        const unsigned gen = old / nloc;
        if (old + 1u == (gen + 1u) * nloc) {
            __builtin_amdgcn_fence(__ATOMIC_RELEASE, "agent");
            asm volatile("s_waitcnt vmcnt(0)" ::: "memory");
            const unsigned og = xb_add(&bar[XB_TOP], 1u);
            const unsigned tg = og / nx;
            if (og + 1u == (tg + 1u) * nx) xb_add(&bar[XB_TOPGEN], 1u);
            else XB_SPIN(xb_ld(&bar[XB_TOPGEN]) == tg, bar);
            __builtin_amdgcn_fence(__ATOMIC_ACQUIRE, "agent");
            xb_add(&bar[XB_XGEN(b.x)], 1u);
            asm volatile("s_waitcnt vmcnt(0)" ::: "memory");
        } else {
            XB_SPIN(xb_ld(&bar[XB_XGEN(b.x)]) == gen, bar);
            __builtin_amdgcn_fence(__ATOMIC_ACQUIRE, "agent");
            asm volatile("s_waitcnt vmcnt(0)" ::: "memory");
        }
    }
    __syncthreads();
}

#ifndef MK_REP_S5
#define MK_REP_S5 1
#endif
#ifndef MK_REP_SSD
#define MK_REP_SSD 1
#endif
#ifndef MK_REP_SYNC
#define MK_REP_SYNC 1
#endif
#ifndef MK_CG_SYNC_ALL
#define MK_CG_SYNC_ALL 0
#endif
#ifndef MK_REP_PRO
#define MK_REP_PRO 1
#endif
#ifndef MK_REP_GEMM
#define MK_REP_GEMM 1
#endif
constexpr int NPHASE = 2 + 11 * 2;
__global__ void __launch_bounds__(512, 2) fwd_megakernel(Args a) {
    extern __shared__ __attribute__((aligned(16))) unsigned char lds[];
    PG8_LAS unsigned char* lds3 = (PG8_LAS unsigned char*)lds;
    unsigned char* big = a.ws + WS_BIG;
    volatile LAS unsigned* bst = (volatile LAS unsigned*)(lds3 + (LDS_BYTES - 16));
    if (threadIdx.x < 4) bst[threadIdx.x] = 0u;
    __syncthreads();
    XcdBarrier xbar; xbar.bar = (unsigned*)(a.ws + WS_BAR); xbar.x = 0; xbar.st = bst;
    if (a.ph_hi - a.ph_lo > 1) xbar = xcd_barrier_post((unsigned*)(a.ws + WS_BAR), bst);
    for (int ph = a.ph_lo; ph < a.ph_hi; ++ph) {
        const int tid = pg8::pg8_tid(), lane = tid & 63, wave = tid >> 6, gw = blockIdx.x * 8 + wave, NGW = gridDim.x * 8;
        if (ph == 0) {
            for (int rep = 0; rep < MK_REP_PRO; ++rep) {
            adaln_phase(a, (float*)lds, tid);
            float* scr = (float*)lds + wave * (64 * 33);
            xpose_region(a, 0, 0, scr, gw, NGW, lane); xpose_region(a, 0, 1, scr, gw, NGW, lane); __syncthreads(); }
        } else if (ph == 1) {
            row_phase<0>(a, MT, nullptr, nullptr, 0, 0, gw, NGW, lane);
        } else {
            const int layer = (ph - 2) / 11, k = (ph - 2) % 11; const bool last = layer == 1; const int Mrows = last ? TL : MT;
            const bf16_t* WA = (const bf16_t*)(a.ws + WS_WA); const bf16_t* WB = (const bf16_t*)(a.ws + WS_WB);
#ifdef MK_SKIP_MASK
            if ((MK_SKIP_MASK >> k) & 1) { if (ph + 1 < a.ph_hi) xcd_barrier(xbar); continue; }
#endif
            if (k == 0) {
                pg8::Gemm g{(const bf16_t*)(a.ws + WS_XM), WA + WA_IN / 2, MT, NPROJ, D}; pg8::StaticOrder S; S.init(MT, NPROJ, gridDim.x, blockIdx.x);
                EpiInProj E{big, a.in[19] + (size_t)layer * 64}; for (int rep = 0; rep < MK_REP_GEMM; ++rep) { pg8::gemm_phase<EpiInProj, pg8::StaticOrder>(lds3, g, S, E, nullptr); __syncthreads(); }
            } else if (k == 1) {
                for (int rep = 0; rep < MK_REP_SSD; ++rep) ssd_a_phase(a, layer, lds, tid);
                for (int rep = 0; rep < MK_REP_S5; ++rep) s5_phase<0>(a, layer, lds, tid, NCH);
            } else if (k == 2) {
#if !defined(MK_NO_SSD) && !defined(MK_NO_SSDB)
                ssd_b_phase(a, tid);
#endif
                for (int rep = 0; rep < MK_REP_S5; ++rep) s5_phase<1>(a, layer, lds, tid, last ? 128 : NCH);
            } else if (k == 3) {
                for (int rep = 0; rep < MK_REP_SSD; ++rep) ssd_c_phase(a, layer, lds, tid, last ? 128 : NCH);
#ifndef MK_NO_S5
                pg8::Gemm g{(const bf16_t*)(big + B_Y5), WA + WA_GLU / 2, Mrows, 2048, 1024}; pg8::StaticOrder S; S.init(Mrows, 2048, gridDim.x, blockIdx.x);
                EpiGlu E{(bf16_t*)(big + B_U5)}; pg8::gemm_phase<EpiGlu, pg8::StaticOrder>(lds3, g, S, E, nullptr);
#endif
            } else if (k == 4) {
#ifndef MK_NO_S5
                { pg8::Gemm g{(const bf16_t*)(big + B_U5), WA + WA_S5P / 2, Mrows, 2048, 1024}; pg8::StaticOrder S; S.init(Mrows, 2048, gridDim.x, blockIdx.x);
                  EpiMerge<0> E{(bf16_t*)(big + B_XBC), (const bf16_t*)(big + B_GATE)}; pg8::gemm_phase<EpiMerge<0>, pg8::StaticOrder>(lds3, g, S, E, nullptr); }
                __syncthreads();
#endif
#ifndef MK_NO_SSD
#ifdef MK_NO_S5
                { pg8::Gemm g{(const bf16_t*)(big + B_YD), WA + WA_SSDP / 2, Mrows, 2048, 2048}; pg8::StaticOrder S; S.init(Mrows, 2048, gridDim.x, blockIdx.x);
                  EpiMerge<0, 1> E{(bf16_t*)(big + B_XBC), (const bf16_t*)(big + B_GATE)}; pg8::gemm_phase<EpiMerge<0, 1>, pg8::StaticOrder>(lds3, g, S, E, nullptr); }
#else
                { pg8::Gemm g{(const bf16_t*)(big + B_YD), WA + WA_SSDP / 2, Mrows, 2048, 2048}; pg8::StaticOrder S; S.init(Mrows, 2048, gridDim.x, blockIdx.x);
                  EpiMerge<1> E{(bf16_t*)(big + B_XBC), (const bf16_t*)(big + B_GATE)}; pg8::gemm_phase<EpiMerge<1>, pg8::StaticOrder>(lds3, g, S, E, nullptr); }
#endif
#endif
            } else if (k == 5) {
                pg8::Gemm g{(const bf16_t*)(big + B_XBC), WA + WA_WOUT / 2, Mrows, 2048, 2048}; pg8::StaticOrder S; S.init(Mrows, 2048, gridDim.x, blockIdx.x);
                EpiResid E{a.out, (float*)(a.ws + WS_HCTX), mvec(a, layer, 0) + 2 * D, mvec(a, layer, 1) + 2 * D}; pg8::gemm_phase<EpiResid, pg8::StaticOrder>(lds3, g, S, E, nullptr);
            } else if (k == 6) {
                row_phase<1>(a, Mrows, a.in[25] + (size_t)layer * D, a.in[26] + (size_t)layer * D, layer, 3 * D, gw, NGW, lane);
                if (!last) for (int rep = 0; rep < MK_REP_PRO; ++rep) { __syncthreads(); xpose_region(a, layer + 1, 0, (float*)lds + wave * (64 * 33), gw, NGW, lane); }
            } else if (k == 7) {
                pg8::Gemm g{(const bf16_t*)(a.ws + WS_XM), WB + WB_UP / 2, Mrows, 2 * DFF, D}; pg8::StaticOrder S; S.init(Mrows, 2 * DFF, gridDim.x, blockIdx.x);
                EpiUp E{(bf16_t*)(big + B_G), (bf16_t*)(big + B_V)}; for (int rep = 0; rep < MK_REP_GEMM; ++rep) { pg8::gemm_phase<EpiUp, pg8::StaticOrder>(lds3, g, S, E, nullptr); __syncthreads(); }
            } else if (k == 8) {
                ffnconv_phase(a, layer, !last, lds, tid);
            } else if (k == 9) {
                pg8::Gemm g{(const bf16_t*)(big + B_V), WB + WB_DOWN / 2, Mrows, D, DFF}; pg8::StaticOrder S; S.init(Mrows, D, gridDim.x, blockIdx.x);
                EpiResid E{a.out, (float*)(a.ws + WS_HCTX), mvec(a, layer, 0) + 5 * D, mvec(a, layer, 1) + 5 * D}; pg8::gemm_phase<EpiResid, pg8::StaticOrder>(lds3, g, S, E, nullptr);
            } else {
                row_phase<1>(a, Mrows, a.in[31] + (size_t)layer * D, a.in[32] + (size_t)layer * D, last ? -1 : layer + 1, 0, gw, NGW, lane);
                if (!last) for (int rep = 0; rep < MK_REP_PRO; ++rep) { __syncthreads(); xpose_region(a, layer + 1, 1, (float*)lds + wave * (64 * 33), gw, NGW, lane); }
            }
        }
        if (ph + 1 < a.ph_hi) { for (int rep = 0; rep < MK_REP_SYNC; ++rep) { if (MK_CG_SYNC_ALL || ph == a.ph_lo) cg::this_grid().sync(); else xcd_barrier(xbar); } }
#ifdef MK_TS_MASK
        if (blockIdx.x == 0 && threadIdx.x == 0) ((unsigned long long*)(a.ws + WS_BAR + 65536))[ph + 1] = __builtin_amdgcn_s_memrealtime();
#endif
    }
#ifdef MK_TS_MASK
    if (blockIdx.x == 0 && threadIdx.x == 0) {
        const unsigned long long* ts = (const unsigned long long*)(a.ws + WS_BAR + 65536); unsigned long long sum = 0;
        for (int ph = 1; ph < a.ph_hi - 1; ++ph) if ((MK_TS_MASK >> ph) & 1ull) sum += ts[ph + 1] - ts[ph];
        const unsigned long long t0 = __builtin_amdgcn_s_memrealtime();
        while (__builtin_amdgcn_s_memrealtime() - t0 < sum * MK_TS_AMP) __builtin_amdgcn_s_sleep(8);
    }
#endif
}
}

#ifndef MK_N_LAUNCH_MODE
#define MK_N_LAUNCH_MODE 0
#endif
extern "C" void kernel_launch(void* const* d_in, const int* in_sizes, int n_in, void* d_out, int out_size, void* d_ws, size_t ws_size, hipStream_t stream) {
    static int grid = 0;
    if (grid == 0) {
        if (n_in != 33 || ws_size < mk::WS_END) { fprintf(stderr, "kernel_launch: need 33 inputs and %zu bytes of workspace (got %d, %zu)\n", (size_t)mk::WS_END, n_in, ws_size); grid = -1; return; }
        int dev = 0, cus = 0, per_cu = 0;
        (void)hipGetDevice(&dev); (void)hipDeviceGetAttribute(&cus, hipDeviceAttributeMultiprocessorCount, dev);
        if (hipFuncSetAttribute((const void*)mk::fwd_megakernel, hipFuncAttributeMaxDynamicSharedMemorySize, mk::LDS_BYTES) != hipSuccess) { fprintf(stderr, "kernel_launch: hipFuncSetAttribute failed\n"); grid = -1; return; }
        if (hipOccupancyMaxActiveBlocksPerMultiprocessor(&per_cu, (const void*)mk::fwd_megakernel, 512, mk::LDS_BYTES) != hipSuccess || per_cu < 1) { fprintf(stderr, "kernel_launch: occupancy query says %d\n", per_cu); per_cu = 1; }
        (void)hipGetLastError();
        grid = cus * per_cu; if (grid > 256) grid = 256;
    }
    if (grid < 0) return;
    mk::Args a{};
    for (int i = 0; i < 33; ++i) a.in[i] = (const float*)d_in[i];
    a.out = (float*)d_out; a.ws = (unsigned char*)d_ws;
#if MK_N_LAUNCH_MODE == 1
    for (int ph = 0; ph < mk::NPHASE; ++ph) { a.ph_lo = ph; a.ph_hi = ph + 1; hipLaunchKernelGGL(mk::fwd_megakernel, dim3(grid), dim3(512), mk::LDS_BYTES, stream, a); }
#else
    a.ph_lo = 0; a.ph_hi = mk::NPHASE;
    (void)hipMemsetAsync((unsigned char*)d_ws + mk::WS_BAR, 0, XCD_BAR_WORDS * sizeof(unsigned), stream);
    void* args[] = {&a};
    hipError_t e = hipLaunchCooperativeKernel((const void*)mk::fwd_megakernel, dim3(grid), dim3(512), args, mk::LDS_BYTES, stream);
    if (e != hipSuccess) fprintf(stderr, "cooperative launch failed: %s (grid %d)\n", hipGetErrorString(e), grid);
#endif
}
```

```cpp
#include <hip/hip_runtime.h>
#include <hip/hip_cooperative_groups.h>
#include <cstdio>
namespace cg = cooperative_groups;
#define MK_N_LAUNCH_MODE 0
namespace pg8 {
#define PG8_LAS __attribute__((address_space(3)))
typedef unsigned short bf16_t;
typedef short bf16x8 __attribute__((ext_vector_type(8)));
typedef float f32x4 __attribute__((ext_vector_type(4)));
typedef unsigned u32x4 __attribute__((ext_vector_type(4)));
constexpr int BM = 256, BK = 64, HALF = 128, HTB = HALF * BK * 2  , STAGE_BYTES = 8 * HTB, NXCD = 8, WGM = 8;

__host__ __device__ __forceinline__ int lds_byte(int r, int c) { const int st = (r >> 4) * 2 + (c >> 5), rr = r & 15, cc = c & 31, ob = rr * 64 + cc * 2; return st * 1024 + (ob ^ (((ob >> 9) & 1) << 5)); }
__host__ __device__ __forceinline__ void stage_rc(int b, int& R, int& C) { const int st = b / 1024, sb = b % 1024, swz = sb ^ (((sb >> 9) & 1) << 5); R = (st >> 1) * 16 + swz / 64; C = (st & 1) * 32 + (swz % 64) / 2; }
__host__ __device__ __forceinline__ int perm32(int rho) { const int n = rho >> 4, i = rho & 15; return 8 * (i >> 2) + 4 * n + (i & 3); }

__device__ __forceinline__ int pg8_tid() { int t = threadIdx.x; asm volatile("" : "+v"(t)); return t; }
struct Unit { int pm, pn; };
struct Gemm { const bf16_t* A; const bf16_t* Bt; int M, N, K; };

struct StaticOrder {
    int nM, nN, nwg, G, c;
    __host__ __device__ void init(int M, int N, int G_, int c_) { nM = M / BM; nN = N / BM; nwg = nM * nN; G = G_; c = c_; }
    __host__ __device__ bool next(int i, Unit& u) const {
        const long L = (long)i * G + c; if (L >= nwg) return false;
        int wgid = (int)L; { const int q = nwg / NXCD, r = nwg % NXCD, xcd = wgid % NXCD, off = wgid / NXCD; wgid = (xcd < r ? xcd * (q + 1) : r * (q + 1) + (xcd - r) * q) + off; }
        const int nig = WGM * nN, gid = wgid / nig, fm = gid * WGM, gsz = (nM - fm) < WGM ? (nM - fm) : WGM;
        u.pm = fm + ((wgid % nig) % gsz); u.pn = (wgid % nig) / gsz; return true;
    }
    __device__ __forceinline__ void a_ready(const Unit&) const {}
    __device__ __forceinline__ void done(const Unit&) const {}
};
typedef float f32x2c __attribute__((ext_vector_type(2))); typedef __bf16 bf16x2c __attribute__((ext_vector_type(2)));
__device__ __forceinline__ unsigned cvt_pk_native(float lo, float hi) { const f32x2c v = {lo, hi}; const bf16x2c b = __builtin_convertvector(v, bf16x2c); return __builtin_bit_cast(unsigned, b); }
__device__ __forceinline__ unsigned cvt_pk_bf16(float lo, float hi) { unsigned r; asm volatile("v_cvt_pk_bf16_f32 %0, %1, %2" : "=v"(r) : "v"(lo), "v"(hi)); return r; }
__device__ __forceinline__ void mfma_settle(const float __attribute__((ext_vector_type(4)))& a) { asm volatile("s_nop 15\n\ts_nop 7" :: "v"(a)); }
typedef float f32x2 __attribute__((ext_vector_type(2)));
template <class Epi, class Sched, bool STAMP = false>
__device__ __forceinline__ void gemm_phase(PG8_LAS unsigned char* lds, const Gemm g, const Sched& S, const Epi& E, unsigned long long* stamps) {
    const int tid = pg8_tid(), wid = __builtin_amdgcn_readfirstlane(tid >> 6), lane = tid & 63, wr = wid >> 2, wc = wid & 3, fr = lane & 15, fq = lane >> 4;
    const int K = g.K, nt = K / BK;
    int ts_lo = 0, ts_hi = 0, nts = 0; const unsigned long long rt_entry = STAMP ? (unsigned long long)wall_clock64() : 0ull;
#define PG8_STAMP() do { if (STAMP && wid == 0 && nts < 64) { const unsigned long long _c = (unsigned long long)clock64(); \
        ts_lo = (lane == nts) ? (int)(unsigned)_c : ts_lo; ts_hi = (lane == nts) ? (int)(unsigned)(_c >> 32) : ts_hi; ++nts; } } while (0)
    PG8_STAMP();
    unsigned voffA[2], voffB[2];
#pragma unroll
    for (int i = 0; i < 2; ++i) { int R, C; stage_rc(tid * 16 + i * 8192, R, C); const int Rb = Epi::PERM ? ((R & ~31) + perm32(R & 31)) : R;
        voffA[i] = (unsigned)(R * K + C) * 2u; voffB[i] = (unsigned)(Rb * K + C) * 2u; }
    const size_t kstep = (size_t)(BK * 2);
    const size_t hstep = (size_t)HALF * K * 2;
    const size_t tstep = 2 * hstep;
    const unsigned ldsw = (unsigned)wid * 1024u;
    const int aoff = lds_byte(wr * 64 + fr, fq * 8), boff = lds_byte(wc * 32 + fr, fq * 8);
#define PG8_SA(b, h) (((b) * 2 + (h)) * HTB)
#define PG8_SB(b, h) ((4 + (b) * 2 + (h)) * HTB)
#define PG8_STAGE(bufoff, gbase, voff) do { _Pragma("unroll") for (int _i = 0; _i < 2; ++_i) \
        __builtin_amdgcn_global_load_lds((const unsigned*)((const char*)(gbase) + (voff)[_i]), (PG8_LAS unsigned*)(lds + (bufoff) + ldsw + _i * 8192), 16, 0, 0); } while (0)
#define PG8_LDA(dst, b, h) do { _Pragma("unroll") for (int m = 0; m < 4; ++m) _Pragma("unroll") for (int k = 0; k < 2; ++k) dst[m][k] = *(const PG8_LAS bf16x8*)(lds + PG8_SA(b, h) + aoff + m * 2048 + k * 1024); } while (0)
#define PG8_LDB(dst, b, h) do { _Pragma("unroll") for (int n = 0; n < 2; ++n) _Pragma("unroll") for (int k = 0; k < 2; ++k) dst[n][k] = *(const PG8_LAS bf16x8*)(lds + PG8_SB(b, h) + boff + n * 2048 + k * 1024); } while (0)
#define PG8_MMA(ai, bj, At, Bt) do { __builtin_amdgcn_s_setprio(1); _Pragma("unroll") for (int m = 0; m < 4; ++m) _Pragma("unroll") for (int n = 0; n < 2; ++n) _Pragma("unroll") for (int k = 0; k < 2; ++k) \
        acc[ai][bj][m][n] = __builtin_amdgcn_mfma_f32_16x16x32_bf16(Bt[n][k], At[m][k], acc[ai][bj][m][n], 0, 0, 0); __builtin_amdgcn_s_setprio(0); } while (0)
#define PG8_WAIT_V(n) asm volatile("s_waitcnt vmcnt(" #n ")" ::: "memory")
#define PG8_WAIT_L(n) asm volatile("s_waitcnt lgkmcnt(" #n ")" ::: "memory")
#define PG8_BAR __builtin_amdgcn_s_barrier()
#define PG8_SCHED __builtin_amdgcn_sched_barrier(0)
    Unit cur, nxt; int ui = 0;
    if (!S.next(0, cur)) return;
    f32x4 acc[2][2][4][2];
#pragma unroll
    for (int a = 0; a < 2; ++a)
#pragma unroll
        for (int b = 0; b < 2; ++b)
#pragma unroll
            for (int m = 0; m < 4; ++m)
#pragma unroll
                for (int n = 0; n < 2; ++n) acc[a][b][m][n] = (f32x4){0.f, 0.f, 0.f, 0.f};
    bf16x8 At[4][2], B0[2][2], B1[2][2];
    const char* cA = (const char*)g.A + (size_t)cur.pm * tstep; const char* cB = (const char*)g.Bt + (size_t)cur.pn * tstep;
    S.a_ready(cur);
    PG8_STAGE(PG8_SB(0, 0), cB, voffB); PG8_STAGE(PG8_SA(0, 0), cA, voffA); PG8_STAGE(PG8_SB(0, 1), cB + hstep, voffB); PG8_STAGE(PG8_SA(0, 1), cA + hstep, voffA);
    if (wr == 1) PG8_BAR;
    PG8_WAIT_V(4); PG8_BAR;
    PG8_STAGE(PG8_SB(1, 0), cB + kstep, voffB); PG8_STAGE(PG8_SA(1, 0), cA + kstep, voffA); PG8_STAGE(PG8_SB(1, 1), cB + hstep + kstep, voffB);
    PG8_WAIT_V(6); PG8_BAR;
    PG8_STAMP();
    for (;;) {
        const bool has_next = S.next(ui + 1, nxt);
        const char* nA = has_next ? (const char*)g.A + (size_t)nxt.pm * tstep : cA; const char* nB = has_next ? (const char*)g.Bt + (size_t)nxt.pn * tstep : cB;
        for (int t = 0; t < nt; t += 2) {
            const bool last = (t == nt - 2);
            const char* a1 = cA + (size_t)(t + 1) * kstep;
            const char* a2 = last ? nA : cA + (size_t)(t + 2) * kstep; const char* b2 = last ? nB : cB + (size_t)(t + 2) * kstep;
            const char* a3 = a2 + kstep; const char* b3 = b2 + kstep;
            if (last && has_next) S.a_ready(nxt);
            PG8_LDB(B0, 0, 0); PG8_SCHED; PG8_LDA(At, 0, 0); PG8_STAGE(PG8_SA(1, 1), a1 + hstep, voffA);
            PG8_WAIT_L(8); PG8_BAR; PG8_WAIT_L(0); PG8_MMA(0, 0, At, B0); PG8_BAR; PG8_SCHED;
            PG8_LDB(B1, 0, 1); PG8_STAGE(PG8_SB(0, 0), b2, voffB);
            PG8_BAR; PG8_WAIT_L(0); PG8_MMA(0, 1, At, B1); PG8_BAR;
            PG8_LDA(At, 0, 1); PG8_STAGE(PG8_SA(0, 0), a2, voffA);
            PG8_BAR; PG8_WAIT_L(0); PG8_MMA(1, 0, At, B0); PG8_BAR; PG8_SCHED;
            PG8_STAGE(PG8_SB(0, 1), b2 + hstep, voffB);
            PG8_WAIT_V(6); PG8_BAR; PG8_MMA(1, 1, At, B1); PG8_BAR;
            PG8_LDB(B0, 1, 0); PG8_SCHED; PG8_LDA(At, 1, 0); PG8_STAGE(PG8_SA(0, 1), a2 + hstep, voffA);
            PG8_WAIT_L(8); PG8_BAR; PG8_WAIT_L(0); PG8_MMA(0, 0, At, B0); PG8_BAR; PG8_SCHED;
            PG8_LDB(B1, 1, 1); PG8_STAGE(PG8_SB(1, 0), b3, voffB);
            PG8_BAR; PG8_WAIT_L(0); PG8_MMA(0, 1, At, B1); PG8_BAR;
            PG8_LDA(At, 1, 1); PG8_STAGE(PG8_SA(1, 0), a3, voffA);
            PG8_BAR; PG8_WAIT_L(0); PG8_MMA(1, 0, At, B0); PG8_BAR; PG8_SCHED;
            PG8_STAGE(PG8_SB(1, 1), b3 + hstep, voffB);
            PG8_WAIT_V(6); PG8_BAR; PG8_MMA(1, 1, At, B1); PG8_BAR;
        }
        PG8_STAMP();
        if constexpr (!Epi::AFTER_DRAIN) { E(acc, cur, wr, wc, fr, fq); S.done(cur); }
        PG8_STAMP();
        if (!has_next) break;
#pragma unroll
        for (int a = 0; a < 2; ++a)
#pragma unroll
            for (int b = 0; b < 2; ++b)
#pragma unroll
                for (int m = 0; m < 4; ++m)
#pragma unroll
                    for (int n = 0; n < 2; ++n) acc[a][b][m][n] = (f32x4){0.f, 0.f, 0.f, 0.f};
        cur = nxt; cA = nA; cB = nB; ++ui;
    }
    PG8_WAIT_V(0);
    if (wr == 0) PG8_BAR;
    PG8_BAR;
    if constexpr (Epi::AFTER_DRAIN) { E.fused(acc, cur, wr, wc, fr, fq, lds, wid, lane); S.done(cur); }
    PG8_STAMP();
    if (STAMP && wid == 0) { stamps[lane] = lane < nts ? (((unsigned long long)(unsigned)ts_hi << 32) | (unsigned)ts_lo) : 0ull;
        if (lane == 62) stamps[62] = rt_entry; if (lane == 63) stamps[63] = (unsigned long long)wall_clock64(); }
#undef PG8_STAMP
#undef PG8_SA
#undef PG8_SB
#undef PG8_STAGE
#undef PG8_LDA
#undef PG8_LDB
#undef PG8_MMA
#undef PG8_WAIT_V
#undef PG8_WAIT_L
#undef PG8_BAR
#undef PG8_SCHED
}
}

namespace mk {
using pg8::bf16_t; using pg8::bf16x8; using pg8::f32x4; using pg8::u32x4; using pg8::Unit; using pg8::cvt_pk_bf16; using pg8::cvt_pk_native; using pg8::mfma_settle;
typedef unsigned u32x2 __attribute__((ext_vector_type(2)));
typedef float f32x2 __attribute__((ext_vector_type(2)));
constexpr int D = 2048, TL = 16384, TC = 256, MT = TL + TC, NCH = MT / 128;
constexpr int NPROJ = 10496, DFF = 5632;
constexpr size_t MiB = 1u << 20;
constexpr size_t WS_MVEC = 0, WS_CHD = 256 * 1024, WS_BAR = 512 * 1024, WS_S5LOC = 1 * MiB, WS_WA = 10 * MiB, WS_WB = 75 * MiB, WS_HCTX = 141 * MiB, WS_XM = 143 * MiB, WS_SST = 208 * MiB, WS_BIG = 338 * MiB, WS_S5IN = 766 * MiB, WS_END = 775 * MiB;
constexpr size_t B_U5 = 0, B_XBC = B_U5 + (size_t)MT * 1024 * 2, B_Z = B_XBC + (size_t)MT * 3072 * 2, B_GATE = B_Z + (size_t)MT * 2048 * 2, B_DT = B_GATE + (size_t)MT * 4096 * 2,
                 B_Y5 = 330 * MiB, B_YD = B_Y5 + (size_t)MT * 1024 * 2;
static_assert(B_DT + (size_t)MT * 64 * 4 <= B_Y5 && B_YD + (size_t)MT * 2048 * 2 <= 428 * MiB, "big map");
constexpr size_t B_G = 0, B_V = (size_t)MT * DFF * 2;
constexpr size_t WA_IN = 0, WA_GLU = 41 * MiB, WA_S5P = 45 * MiB, WA_SSDP = 49 * MiB, WA_WOUT = 57 * MiB, WB_UP = 0, WB_DOWN = 44 * MiB;
constexpr int LDS_BYTES = 163840;
constexpr float ALPHA = 1.41421356237f, LN_EPS = 1e-5f, RMS_EPS = 1e-5f;

struct Args { const float* in[33]; float* out; unsigned char* ws; int ph_lo, ph_hi; };

__device__ __forceinline__ float bf2f(unsigned b) { return __uint_as_float(b << 16); }
__device__ __forceinline__ float bflo(unsigned w) { return __uint_as_float(w << 16); }
__device__ __forceinline__ float bfhi(unsigned w) { return __uint_as_float(w & 0xffff0000u); }
__device__ __forceinline__ float sigm(float x) { return __builtin_amdgcn_rcpf(1.f + __expf(-x)); }
__device__ __forceinline__ float silu_(float x) { return x * __builtin_amdgcn_rcpf(1.f + __expf(-x)); }
__device__ __forceinline__ float gelu_tanh(float x) { const float u = 0.7978845608028654f * (x + 0.044715f * x * x * x); const float th = 1.f - 2.f * __builtin_amdgcn_rcpf(__expf(2.f * u) + 1.f); return 0.5f * x * (1.f + th); }
__device__ __forceinline__ bf16x8 mkfrag(unsigned a, unsigned b, unsigned c, unsigned d) { u32x4 v; v.x = a; v.y = b; v.z = c; v.w = d; return __builtin_bit_cast(bf16x8, v); }
__device__ __forceinline__ float* hrow(const Args& a, int row) { return row < TL ? a.out + (size_t)row * D : (float*)(a.ws + WS_HCTX) + (size_t)(row - TL) * D; }
__device__ __forceinline__ const float* mvec(const Args& a, int layer, int isctx) { return (const float*)(a.ws + WS_MVEC) + (size_t)(layer * 2 + isctx) * 12288; }

struct EpiInProj {
    static constexpr bool PERM = true, AFTER_DRAIN = false;
    unsigned char* big; const float* dt_bias;
    __device__ __forceinline__ void operator()(const f32x4 (&acc)[2][2][4][2], const Unit& u, int wr, int wc, int fr, int fq) const {
        mfma_settle(acc[1][1][3][1]); mfma_settle(acc[1][1][3][0]);
        const int row0 = u.pm * 256 + wr * 64 + fr, ct = u.pn * 256;
        if (ct >= 10240) {
            if (wc < 2) { const int cc = wc * 32 + 8 * fq; float* DT = (float*)(big + B_DT);
                const f32x4 b0 = *(const f32x4*)(dt_bias + cc), b1 = *(const f32x4*)(dt_bias + cc + 4);
#pragma unroll
                for (int ai = 0; ai < 2; ++ai)
#pragma unroll
                    for (int m = 0; m < 4; ++m) { float* rp = DT + (size_t)(row0 + ai * 128 + m * 16) * 64 + cc; f32x4 v0 = acc[ai][0][m][0] + b0, v1 = acc[ai][0][m][1] + b1;
#pragma unroll
                        for (int j = 0; j < 4; ++j) { v0[j] = v0[j] > 20.f ? v0[j] : log1pf(expf(v0[j])); v1[j] = v1[j] > 20.f ? v1[j] : log1pf(expf(v1[j])); }
                        *(f32x4*)rp = v0; *(f32x4*)(rp + 4) = v1; } }
            return;
        }
        bf16_t* base; int ld, c0; bool sg = false;
        if (ct < 1024) { base = (bf16_t*)(big + B_U5); ld = 1024; c0 = ct; }
        else if (ct < 4096) { base = (bf16_t*)(big + B_XBC); ld = 3072; c0 = ct - 1024; }
        else if (ct < 6144) { base = (bf16_t*)(big + B_Z); ld = 2048; c0 = ct - 4096; }
        else { base = (bf16_t*)(big + B_GATE); ld = 4096; c0 = ct - 6144; sg = true; }
        const int col0 = c0 + wc * 32 + 8 * fq;
#pragma unroll
        for (int ai = 0; ai < 2; ++ai)
#pragma unroll
            for (int m = 0; m < 4; ++m) { bf16_t* rowp = base + (size_t)(row0 + ai * 128 + m * 16) * ld + col0;
#pragma unroll
                for (int bj = 0; bj < 2; ++bj) { f32x4 v0 = acc[ai][bj][m][0], v1 = acc[ai][bj][m][1];
                    if (sg) {
#pragma unroll
                        for (int j = 0; j < 4; ++j) { v0[j] = sigm(v0[j]); v1[j] = sigm(v1[j]); } }
                    u32x4 w; w.x = cvt_pk_native(v0[0], v0[1]); w.y = cvt_pk_native(v0[2], v0[3]); w.z = cvt_pk_native(v1[0], v1[1]); w.w = cvt_pk_native(v1[2], v1[3]);
                    *(u32x4*)(rowp + bj * 128) = w; } }
    }
};
struct EpiGlu {
    static constexpr bool PERM = true, AFTER_DRAIN = false;
    bf16_t* O;
    __device__ __forceinline__ void operator()(const f32x4 (&acc)[2][2][4][2], const Unit& u, int wr, int wc, int fr, int fq) const {
        mfma_settle(acc[1][1][3][1]); mfma_settle(acc[1][1][3][0]);
        const int row0 = u.pm * 256 + wr * 64 + fr, col0 = u.pn * 128 + wc * 32 + 8 * fq;
#pragma unroll
        for (int ai = 0; ai < 2; ++ai)
#pragma unroll
            for (int m = 0; m < 4; ++m) { f32x4 v0 = acc[ai][0][m][0], v1 = acc[ai][0][m][1]; const f32x4 g0 = acc[ai][1][m][0], g1 = acc[ai][1][m][1];
#pragma unroll
                for (int j = 0; j < 4; ++j) { v0[j] *= sigm(g0[j]); v1[j] *= sigm(g1[j]); }
                u32x4 w; w.x = cvt_pk_bf16(v0[0], v0[1]); w.y = cvt_pk_bf16(v0[2], v0[3]); w.z = cvt_pk_bf16(v1[0], v1[1]); w.w = cvt_pk_bf16(v1[2], v1[3]);
                *(u32x4*)(O + (size_t)(row0 + ai * 128 + m * 16) * 1024 + col0) = w; }
    }
};
template <int SECOND, int GSEL = SECOND> struct EpiMerge {
    static constexpr bool PERM = true, AFTER_DRAIN = false;
    bf16_t* MG; const bf16_t* GATE;
    __device__ __forceinline__ void operator()(const f32x4 (&acc)[2][2][4][2], const Unit& u, int wr, int wc, int fr, int fq) const {
        mfma_settle(acc[1][1][3][1]); mfma_settle(acc[1][1][3][0]);
        const int row0 = u.pm * 256 + wr * 64 + fr, col0 = u.pn * 256 + wc * 32 + 8 * fq;
#pragma unroll
        for (int ai = 0; ai < 2; ++ai)
#pragma unroll
            for (int m = 0; m < 4; ++m) { const size_t r = (size_t)(row0 + ai * 128 + m * 16);
#pragma unroll
                for (int bj = 0; bj < 2; ++bj) { const int c = col0 + bj * 128; const u32x4 g = *(const u32x4*)(GATE + r * 4096 + (GSEL ? 2048 : 0) + c);
                    f32x4 v0 = acc[ai][bj][m][0], v1 = acc[ai][bj][m][1];
                    v0[0] *= bflo(g.x); v0[1] *= bfhi(g.x); v0[2] *= bflo(g.y); v0[3] *= bfhi(g.y); v1[0] *= bflo(g.z); v1[1] *= bfhi(g.z); v1[2] *= bflo(g.w); v1[3] *= bfhi(g.w);
                    if (SECOND) { const u32x4 o = *(const u32x4*)(MG + r * 2048 + c);
                        v0[0] += bflo(o.x); v0[1] += bfhi(o.x); v0[2] += bflo(o.y); v0[3] += bfhi(o.y); v1[0] += bflo(o.z); v1[1] += bfhi(o.z); v1[2] += bflo(o.w); v1[3] += bfhi(o.w); }
                    u32x4 w; w.x = cvt_pk_bf16(v0[0], v0[1]); w.y = cvt_pk_bf16(v0[2], v0[3]); w.z = cvt_pk_bf16(v1[0], v1[1]); w.w = cvt_pk_bf16(v1[2], v1[3]);
                    *(u32x4*)(MG + r * 2048 + c) = w; } }
    }
};
struct EpiResid {
    static constexpr bool PERM = false, AFTER_DRAIN = false;
    float* out; float* hctx; const float* glat; const float* gctx;
    __device__ __forceinline__ void operator()(const f32x4 (&acc)[2][2][4][2], const Unit& u, int wr, int wc, int fr, int fq) const {
        mfma_settle(acc[1][1][3][1]); mfma_settle(acc[1][1][3][0]);
        const bool isctx = u.pm >= 64; const float* g = isctx ? gctx : glat;
        float* hb = isctx ? hctx + (size_t)(wr * 64 + fr) * D : out + (size_t)(u.pm * 256 + wr * 64 + fr) * D;
        const int col0 = u.pn * 256 + wc * 32 + 4 * fq;
        f32x4 gv[2][2];
#pragma unroll
        for (int bj = 0; bj < 2; ++bj)
#pragma unroll
            for (int n = 0; n < 2; ++n) gv[bj][n] = *(const f32x4*)(g + col0 + bj * 128 + n * 16);
#pragma unroll
        for (int ai = 0; ai < 2; ++ai)
#pragma unroll
            for (int m = 0; m < 4; ++m) { float* rowp = hb + (size_t)(ai * 128 + m * 16) * D + col0;
#pragma unroll
                for (int bj = 0; bj < 2; ++bj)
#pragma unroll
                    for (int n = 0; n < 2; ++n) { float* p = rowp + bj * 128 + n * 16; const f32x4 h = *(const f32x4*)p; *(f32x4*)p = h * ALPHA + gv[bj][n] * acc[ai][bj][m][n]; } }
    }
};
struct EpiUp {
    static constexpr bool PERM = true, AFTER_DRAIN = false;
    bf16_t* G; bf16_t* V;
    __device__ __forceinline__ void operator()(const f32x4 (&acc)[2][2][4][2], const Unit& u, int wr, int wc, int fr, int fq) const {
        mfma_settle(acc[1][1][3][1]); mfma_settle(acc[1][1][3][0]);
        const int row0 = u.pm * 256 + wr * 64 + fr; int ct = u.pn * 256; bf16_t* base = G; if (ct >= DFF) { base = V; ct -= DFF; }
        const int col0 = ct + wc * 32 + 8 * fq;
#pragma unroll
        for (int ai = 0; ai < 2; ++ai)
#pragma unroll
            for (int m = 0; m < 4; ++m) { bf16_t* rowp = base + (size_t)(row0 + ai * 128 + m * 16) * DFF + col0;
#pragma unroll
                for (int bj = 0; bj < 2; ++bj) { const f32x4 v0 = acc[ai][bj][m][0], v1 = acc[ai][bj][m][1];
                    u32x4 w; w.x = cvt_pk_native(v0[0], v0[1]); w.y = cvt_pk_native(v0[2], v0[3]); w.z = cvt_pk_native(v1[0], v1[1]); w.w = cvt_pk_native(v1[2], v1[3]);
                    *(u32x4*)(rowp + bj * 128) = w; } }
    }
};

__device__ __forceinline__ void xpose_item(const float* W, int K, int N, bf16_t* WT, int d0, int s0, int k0, float* scr, int lane) {
#pragma unroll
    for (int i = 0; i < 32; ++i) { const int kk = 2 * i + (lane >> 5); scr[kk * 33 + (lane & 31)] = s0 >= 0 ? W[(size_t)(k0 + kk) * N + s0 + (lane & 31)] : 0.f; }
    asm volatile("s_waitcnt lgkmcnt(0)" ::: "memory");
    const int c = lane & 7;
#pragma unroll
    for (int j = 0; j < 4; ++j) { const int n = (lane >> 3) + 8 * j; const float* s = scr + (8 * c) * 33 + n;
        u32x4 o; o.x = cvt_pk_bf16(s[0 * 33], s[1 * 33]); o.y = cvt_pk_bf16(s[2 * 33], s[3 * 33]); o.z = cvt_pk_bf16(s[4 * 33], s[5 * 33]); o.w = cvt_pk_bf16(s[6 * 33], s[7 * 33]);
        *(u32x4*)(WT + (size_t)(d0 + n) * K + k0 + 8 * c) = o; }
    asm volatile("s_waitcnt lgkmcnt(0)" ::: "memory");
}
__device__ __forceinline__ void xpose_region(const Args& a, int layer, int region, float* scr, int gw, int NGW, int lane) {
    if (region == 0) {
        const float* w_in = a.in[6] + (size_t)layer * 2048 * 10304; const float* w_glu = a.in[15] + (size_t)layer * 1024 * 2048; const float* w_s5p = a.in[16] + (size_t)layer * 1024 * 2048;
        const float* w_ssdp = a.in[23] + (size_t)layer * 2048 * 2048; const float* w_out = a.in[24] + (size_t)layer * 2048 * 2048;
        bf16_t* WA = (bf16_t*)(a.ws + WS_WA);
        constexpr int I_IN = 32 * 328, I_GLU = 16 * 64, I_S5P = 16 * 64, I_SSDP = 32 * 64, I_WOUT = 32 * 64, NI = I_IN + I_GLU + I_S5P + I_SSDP + I_WOUT;
        for (int it = gw; it < NI; it += NGW) { int r = it;
            if (r < I_IN) { const int kb = r / 328, d0 = (r % 328) * 32; int s0; if (d0 < 4096) s0 = d0; else if (d0 < 10240) s0 = d0 + 64; else if (d0 < 10304) s0 = d0 - 10240 + 4096; else s0 = -1;
                xpose_item(w_in, 2048, 10304, WA + WA_IN / 2, d0, s0, kb * 64, scr, lane); continue; } r -= I_IN;
            if (r < I_GLU) { const int kb = r / 64, d0 = (r % 64) * 32, t = d0 >> 8, j = d0 & 255; const int s0 = j < 128 ? t * 128 + j : 1024 + t * 128 + (j - 128);
                xpose_item(w_glu, 1024, 2048, WA + WA_GLU / 2, d0, s0, kb * 64, scr, lane); continue; } r -= I_GLU;
            if (r < I_S5P) { const int kb = r / 64, d0 = (r % 64) * 32; xpose_item(w_s5p, 1024, 2048, WA + WA_S5P / 2, d0, d0, kb * 64, scr, lane); continue; } r -= I_S5P;
            if (r < I_SSDP) { const int kb = r / 64, d0 = (r % 64) * 32; xpose_item(w_ssdp, 2048, 2048, WA + WA_SSDP / 2, d0, d0, kb * 64, scr, lane); continue; } r -= I_SSDP;
            { const int kb = r / 64, d0 = (r % 64) * 32; xpose_item(w_out, 2048, 2048, WA + WA_WOUT / 2, d0, d0, kb * 64, scr, lane); }
        }
    } else {
        const float* w_up = a.in[27] + (size_t)layer * 2048 * 11264; const float* w_down = a.in[30] + (size_t)layer * 5632 * 2048;
        bf16_t* WB = (bf16_t*)(a.ws + WS_WB);
        constexpr int I_UP = 32 * 352, I_DOWN = 88 * 64, NI = I_UP + I_DOWN;
        for (int it = gw; it < NI; it += NGW) { int r = it;
            if (r < I_UP) { const int kb = r / 352, d0 = (r % 352) * 32; xpose_item(w_up, 2048, 11264, WB + WB_UP / 2, d0, d0, kb * 64, scr, lane); continue; } r -= I_UP;
            { const int kb = r / 64, d0 = (r % 64) * 32; xpose_item(w_down, 5632, 2048, WB + WB_DOWN / 2, d0, d0, kb * 64, scr, lane); }
        }
    }
}

__device__ __forceinline__ void adaln_phase(const Args& a, float* lds, int tid) {
    float* sc = lds; float* scx = lds + 2048; float* red = lds + 4096;
    for (int i = tid; i < 2048; i += 512) { sc[i] = silu_(a.in[1][i]); scx[i] = silu_(a.in[3][i]); }
    __syncthreads();
    for (int unit = blockIdx.x; unit < 256; unit += gridDim.x) {
        const int layer = unit >> 7, col0 = (unit & 127) * 96;
        const float* W = a.in[4] + (size_t)layer * 2048 * 12288 + col0;
        if (tid < 504) { const int cq = tid % 24, ks = tid / 24; f32x4 al = {0.f, 0.f, 0.f, 0.f}, ac = {0.f, 0.f, 0.f, 0.f};
#pragma unroll 7
            for (int k = ks; k < 2048; k += 21) { const f32x4 w = *(const f32x4*)(W + (size_t)k * 12288 + cq * 4); al += w * sc[k]; ac += w * scx[k]; }
            *(f32x4*)(red + (ks * 2 + 0) * 96 + cq * 4) = al; *(f32x4*)(red + (ks * 2 + 1) * 96 + cq * 4) = ac; }
        __syncthreads();
        if (tid < 192) { const int v = tid / 96, c = tid % 96; float s = 0.f; for (int ks = 0; ks < 21; ++ks) s += red[(ks * 2 + v) * 96 + c];
            ((float*)(a.ws + WS_MVEC))[(size_t)(layer * 2 + v) * 12288 + col0 + c] = s + a.in[5][(size_t)layer * 12288 + col0 + c]; }
        __syncthreads();
    }
}

__device__ __forceinline__ float wave_sum(float v) {
#pragma unroll
    for (int o = 1; o < 64; o <<= 1) v += __shfl_xor(v, o);
    return v;
}
template <int MODE> __device__ __forceinline__ void row_phase(const Args& a, int nrows, const float* lng, const float* lnb, int mod_layer, int mod_off, int gw, int NGW, int lane) {
    bf16_t* XM = (bf16_t*)(a.ws + WS_XM);
    for (int row = gw; row < nrows; row += NGW) {
        const int isctx = row >= TL; float* h = hrow(a, row);
        const float* src = MODE == 0 ? (isctx ? a.in[2] + (size_t)(row - TL) * D : a.in[0] + (size_t)row * D) : h;
        f32x4 v[8];
#pragma unroll
        for (int j = 0; j < 8; ++j) v[j] = *(const f32x4*)(src + 4 * lane + 256 * j);
        if (MODE == 1) {
            float s = 0.f;
#pragma unroll
            for (int j = 0; j < 8; ++j) s += (v[j][0] + v[j][1]) + (v[j][2] + v[j][3]);
            const float mean = wave_sum(s) * (1.f / D); float q = 0.f;
#pragma unroll
            for (int j = 0; j < 8; ++j) { v[j] = v[j] - mean; q += (v[j][0] * v[j][0] + v[j][1] * v[j][1]) + (v[j][2] * v[j][2] + v[j][3] * v[j][3]); }
            const float rstd = __builtin_amdgcn_rsqf(wave_sum(q) * (1.f / D) + LN_EPS);
#pragma unroll
            for (int j = 0; j < 8; ++j) { const f32x4 g = *(const f32x4*)(lng + 4 * lane + 256 * j), b = *(const f32x4*)(lnb + 4 * lane + 256 * j); v[j] = v[j] * rstd * g + b; }
        }
#ifdef MK_SANITIZE
#pragma unroll
        for (int j = 0; j < 8; ++j)
#pragma unroll
            for (int e = 0; e < 4; ++e) if (!(fabsf(v[j][e]) < 1e30f)) v[j][e] = 0.f;
#endif
#pragma unroll
        for (int j = 0; j < 8; ++j) *(f32x4*)(h + 4 * lane + 256 * j) = v[j];
        if (mod_layer >= 0) { const float* m = mvec(a, mod_layer, isctx) + mod_off;
#pragma unroll
            for (int j = 0; j < 8; ++j) { const f32x4 sh = *(const f32x4*)(m + 4 * lane + 256 * j), scl = *(const f32x4*)(m + D + 4 * lane + 256 * j); const f32x4 o = v[j] * (scl + 1.f) + sh;
                u32x2 w; w.x = cvt_pk_bf16(o[0], o[1]); w.y = cvt_pk_bf16(o[2], o[3]); *(u32x2*)(XM + (size_t)row * D + 4 * lane + 256 * j) = w; } }
    }
}

__device__ __forceinline__ void ffnconv_ctx(const Args& a, int layer, int tid) {
    const bf16_t* G = (const bf16_t*)(a.ws + WS_BIG + B_G); bf16_t* V = (bf16_t*)(a.ws + WS_BIG + B_V);
    const float* cw = a.in[28] + (size_t)layer * 9 * DFF; const float* cb = a.in[29] + (size_t)layer * DFF;
    const int nunits = 260 * 11; const int oc = tid & 63, xs = tid >> 6;
    for (int unit = 256 * 11 + blockIdx.x; unit < nunits; unit += gridDim.x) {
        const int seg = unit / 11, ob = unit % 11, ch0 = ob * 512 + oc * 8; const bool cs = seg >= 256; const int t0 = seg * 64;
        float w[9][8], bias[8];
#pragma unroll
        for (int k = 0; k < 9; ++k) { const f32x4 w0 = *(const f32x4*)(cw + (size_t)k * DFF + ch0), w1 = *(const f32x4*)(cw + (size_t)k * DFF + ch0 + 4);
            w[k][0] = w0[0]; w[k][1] = w0[1]; w[k][2] = w0[2]; w[k][3] = w0[3]; w[k][4] = w1[0]; w[k][5] = w1[1]; w[k][6] = w1[2]; w[k][7] = w1[3]; }
        { const f32x4 b0 = *(const f32x4*)(cb + ch0), b1 = *(const f32x4*)(cb + ch0 + 4); bias[0] = b0[0]; bias[1] = b0[1]; bias[2] = b0[2]; bias[3] = b0[3]; bias[4] = b1[0]; bias[5] = b1[1]; bias[6] = b1[2]; bias[7] = b1[3]; }
#pragma unroll 4
        for (int xi = 0; xi < 8; ++xi) { const int x = xs * 8 + xi, t = t0 + x; float acc[8];
#pragma unroll
            for (int k = 0; k < 8; ++k) acc[k] = bias[k];
#pragma unroll
            for (int dy = -1; dy <= 1; ++dy) { bool rok = cs ? (dy == 0) : ((dy < 0 ? seg > 0 : true) && (dy > 0 ? seg < 255 : true));
#pragma unroll
                for (int dx = -1; dx <= 1; ++dx) { const bool ok = rok && (cs ? (t + dx >= TL && t + dx < MT) : (x + dx >= 0 && x + dx < 64));
                    if (ok) { const u32x4 g = *(const u32x4*)(G + (size_t)(t + dy * 64 + dx) * DFF + ch0); const int k = (dy + 1) * 3 + dx + 1;
                        acc[0] += w[k][0] * bflo(g.x); acc[1] += w[k][1] * bfhi(g.x); acc[2] += w[k][2] * bflo(g.y); acc[3] += w[k][3] * bfhi(g.y);
                        acc[4] += w[k][4] * bflo(g.z); acc[5] += w[k][5] * bfhi(g.z); acc[6] += w[k][6] * bflo(g.w); acc[7] += w[k][7] * bfhi(g.w); } } }
            bf16_t* vp = V + (size_t)t * DFF + ch0; const u32x4 vv = *(const u32x4*)vp;
            u32x4 o; o.x = cvt_pk_bf16(silu_(acc[0]) * bflo(vv.x), silu_(acc[1]) * bfhi(vv.x)); o.y = cvt_pk_bf16(silu_(acc[2]) * bflo(vv.y), silu_(acc[3]) * bfhi(vv.y));
            o.z = cvt_pk_bf16(silu_(acc[4]) * bflo(vv.z), silu_(acc[5]) * bfhi(vv.z)); o.w = cvt_pk_bf16(silu_(acc[6]) * bflo(vv.w), silu_(acc[7]) * bfhi(vv.w));
            *(u32x4*)vp = o; }
    }
}

__device__ __forceinline__ void ffnconv_phase(const Args& a, int layer, bool with_ctx, unsigned char* lds, int tid) {
    const bf16_t* G = (const bf16_t*)(a.ws + WS_BIG + B_G); bf16_t* V = (bf16_t*)(a.ws + WS_BIG + B_V);
    const float* cw = a.in[28] + (size_t)layer * 9 * DFF; const float* cb = a.in[29] + (size_t)layer * DFF;
    bf16_t* T = (bf16_t*)lds;
    const int oc = tid & 15, ts = tid >> 4;
    for (int unit = blockIdx.x; unit < 64 * 44; unit += gridDim.x) {
        const int rg = unit / 44, ch0 = (unit % 44) * 128 + oc * 8, y0 = rg * 4;
        __syncthreads();
#pragma unroll
        for (int i = 0; i < 12; ++i) { const int idx = tid + i * 512, r = idx >> 10, x = (idx >> 4) & 63, y = y0 - 1 + r; const bool ok = y >= 0 && y < 256;
            u32x4 v = *(const u32x4*)(G + (size_t)((ok ? y : y0) * 64 + x) * DFF + ch0); if (!ok) v = (u32x4){0u, 0u, 0u, 0u};
            *(u32x4*)(T + ((r * 64 + x) * 128 + oc * 8)) = v; }
        u32x4 vv[8];
#pragma unroll
        for (int o = 0; o < 8; ++o) vv[o] = *(const u32x4*)(V + (size_t)((y0 + (o >> 1)) * 64 + ts * 2 + (o & 1)) * DFF + ch0);
        float w[9][8], bias[8];
#pragma unroll
        for (int k = 0; k < 9; ++k) { const f32x4 w0 = *(const f32x4*)(cw + (size_t)k * DFF + ch0), w1 = *(const f32x4*)(cw + (size_t)k * DFF + ch0 + 4);
            w[k][0] = w0[0]; w[k][1] = w0[1]; w[k][2] = w0[2]; w[k][3] = w0[3]; w[k][4] = w1[0]; w[k][5] = w1[1]; w[k][6] = w1[2]; w[k][7] = w1[3]; }
        { const f32x4 b0 = *(const f32x4*)(cb + ch0), b1 = *(const f32x4*)(cb + ch0 + 4); bias[0] = b0[0]; bias[1] = b0[1]; bias[2] = b0[2]; bias[3] = b0[3]; bias[4] = b1[0]; bias[5] = b1[1]; bias[6] = b1[2]; bias[7] = b1[3]; }
        __syncthreads();
#pragma unroll
        for (int o = 0; o < 8; ++o) { const int rr = o >> 1, x = ts * 2 + (o & 1); float acc[8];
#pragma unroll
            for (int k = 0; k < 8; ++k) acc[k] = bias[k];
#pragma unroll
            for (int dy = -1; dy <= 1; ++dy)
#pragma unroll
                for (int dx = -1; dx <= 1; ++dx) { const int xn = x + dx; const bool ok = xn >= 0 && xn < 64;
                    u32x4 g = *(const u32x4*)(T + (((rr + 1 + dy) * 64 + (ok ? xn : x)) * 128 + oc * 8)); if (!ok) g = (u32x4){0u, 0u, 0u, 0u}; const int k = (dy + 1) * 3 + dx + 1;
                    acc[0] += w[k][0] * bflo(g.x); acc[1] += w[k][1] * bfhi(g.x); acc[2] += w[k][2] * bflo(g.y); acc[3] += w[k][3] * bfhi(g.y);
                    acc[4] += w[k][4] * bflo(g.z); acc[5] += w[k][5] * bfhi(g.z); acc[6] += w[k][6] * bflo(g.w); acc[7] += w[k][7] * bfhi(g.w); }
            const u32x4 v = vv[o];
            u32x4 q; q.x = cvt_pk_bf16(silu_(acc[0]) * bflo(v.x), silu_(acc[1]) * bfhi(v.x)); q.y = cvt_pk_bf16(silu_(acc[2]) * bflo(v.y), silu_(acc[3]) * bfhi(v.y));
            q.z = cvt_pk_bf16(silu_(acc[4]) * bflo(v.z), silu_(acc[5]) * bfhi(v.z)); q.w = cvt_pk_bf16(silu_(acc[6]) * bflo(v.w), silu_(acc[7]) * bfhi(v.w));
            *(u32x4*)(V + (size_t)((y0 + rr) * 64 + x) * DFF + ch0) = q; }
    }
    __syncthreads();
    if (with_ctx) ffnconv_ctx(a, layer, tid);
}
__device__ __forceinline__ int s5_chunk_at(int dir, int q) { return dir ? 129 - q : (q + 128) % 130; }
__device__ __forceinline__ int s5_pos_of(int dir, int c) { return dir ? 129 - c : (c + 2) % 130; }
template <int PASS> __device__ __forceinline__ void s5_phase(const Args& a, int layer, unsigned char* lds, int tid, int nchunks) {
    constexpr int BUP = 132;
    const bf16_t* U5 = (const bf16_t*)(a.ws + WS_BIG + B_U5); bf16_t* Y5 = (bf16_t*)(a.ws + WS_BIG + B_Y5);
    float2* S5LOC = (float2*)(a.ws + WS_S5LOC);
    const int lane = tid & 63, w = tid >> 6, gl = w >> 1, dir = w & 1, p = lane, fr = lane & 15, fq = lane >> 4;
    float* BuW = (float*)lds + (size_t)w * (16 * BUP);
    bf16_t* STw = (bf16_t*)(lds + 67584) + (size_t)w * (16 * 136);
    float* YL = (float*)(lds + 102400);
    const int gq = blockIdx.x & 15, g = gq * 4 + gl;
    float ab_re, ab_im, a128r, a128i;
    const float step = expf(a.in[9][(size_t)(layer * 2 + dir) * 64 + g]);
    { const size_t pi = ((size_t)(layer * 2 + dir) * 64 + g) * 64 + p; const float lre = fminf(a.in[7][pi], -1e-4f), lim = a.in[8][pi];
      const float mag = expf(lre * step); float sn, cs; sincosf(lim * step, &sn, &cs); ab_re = mag * cs; ab_im = mag * sn; a128r = ab_re; a128i = ab_im;
#pragma unroll
      for (int k = 0; k < 7; ++k) { const float r = a128r * a128r - a128i * a128i, i = 2.f * a128r * a128i; a128r = r; a128i = i; } }
    bf16x8 bbf[8];
#pragma unroll
    for (int nt = 0; nt < 8; ++nt) { const int pp = nt * 8 + (fr >> 1), cc = fr & 1; const size_t pi = ((size_t)(layer * 2 + dir) * 64 + g) * 64 + pp;
        const float lre = fminf(a.in[7][pi], -1e-4f), lim = a.in[8][pi]; const float mag = expf(lre * step); float sn, cs; sincosf(lim * step, &sn, &cs);
        const float are = mag * cs, aim = mag * sn, den = lre * lre + lim * lim, q_re = ((are - 1.f) * lre + aim * lim) / den, q_im = (aim * lre - (are - 1.f) * lim) / den;
        const float* br = a.in[10] + (((size_t)layer * 64 + g) * 64 + pp) * 16 + (fq & 1) * 8; const float* bi = a.in[11] + (((size_t)layer * 64 + g) * 64 + pp) * 16 + (fq & 1) * 8;
        const f32x4 r0 = *(const f32x4*)br, r1 = *(const f32x4*)(br + 4), i0 = *(const f32x4*)bi, i1 = *(const f32x4*)(bi + 4); float v[8];
#pragma unroll
        for (int j = 0; j < 8; ++j) { const float r = j < 4 ? r0[j & 3] : r1[j & 3], i = j < 4 ? i0[j & 3] : i1[j & 3]; v[j] = fq < 2 ? (cc ? q_re * i + q_im * r : q_re * r - q_im * i) : 0.f; }
        bbf[nt] = mkfrag(cvt_pk_bf16(v[0], v[1]), cvt_pk_bf16(v[2], v[3]), cvt_pk_bf16(v[4], v[5]), cvt_pk_bf16(v[6], v[7])); }
    bf16x8 cm[4];
    if (PASS == 1) {
        const float* cre = a.in[12] + (((size_t)(layer * 2 + dir) * 64 + g) * 16 + fr) * 64; const float* cim = a.in[13] + (((size_t)(layer * 2 + dir) * 64 + g) * 16 + fr) * 64;
#pragma unroll
        for (int ks = 0; ks < 4; ++ks) { const f32x4 r = *(const f32x4*)(cre + ks * 16 + fq * 4), i = *(const f32x4*)(cim + ks * 16 + fq * 4);
            cm[ks] = mkfrag(cvt_pk_bf16(r[0], -i[0]), cvt_pk_bf16(r[1], -i[1]), cvt_pk_bf16(r[2], -i[2]), cvt_pk_bf16(r[3], -i[3])); }
    }
    const int cstep = gridDim.x >> 4;
    float2* S5IN = (float2*)(a.ws + WS_S5IN);
    if (PASS == 1) {
        float sr = 0.f, si = 0.f;
#pragma unroll 1
        for (int q0 = 0; q0 < NCH; q0 += 13) { float2 l[13];
#pragma unroll
            for (int i = 0; i < 13; ++i) l[i] = S5LOC[((size_t)(dir * NCH + s5_chunk_at(dir, q0 + i)) * 64 + g) * 64 + p];
#pragma unroll
            for (int i = 0; i < 13; ++i) { const int cc = s5_chunk_at(dir, q0 + i);
                if (cc < nchunks && (cc % cstep) == (int)(blockIdx.x >> 4)) S5IN[((size_t)(dir * NCH + cc) * 64 + g) * 64 + p] = make_float2(sr, si);
                const float nr = a128r * sr - a128i * si + l[i].x, ni = a128r * si + a128i * sr + l[i].y; sr = nr; si = ni; } }
    }
    for (int c = blockIdx.x >> 4; c < nchunks; c += cstep) {
        const int row0 = c * 128;
        bf16x8 uf[8];
#pragma unroll
        for (int k = 0; k < 8; ++k) { const int sl = dir ? 7 - k : k; const u32x4 v = *(const u32x4*)(U5 + (size_t)(row0 + sl * 16 + fr) * 1024 + g * 16 + (fq & 1) * 8);
            uf[k] = fq < 2 ? __builtin_bit_cast(bf16x8, v) : mkfrag(0u, 0u, 0u, 0u); }
        float sr = 0.f, si = 0.f;
        if (PASS == 1) { const float2 s0 = S5IN[((size_t)(dir * NCH + c) * 64 + g) * 64 + p]; sr = s0.x; si = s0.y; }
        f32x4 yacc[8];
#pragma unroll
        for (int k = 0; k < 8; ++k) {
#pragma unroll
            for (int nt = 0; nt < 8; ++nt) { f32x4 acc = {0.f, 0.f, 0.f, 0.f}; acc = __builtin_amdgcn_mfma_f32_16x16x32_bf16(uf[k], bbf[nt], acc, 0, 0, 0);
#pragma unroll
                for (int jj = 0; jj < 4; ++jj) BuW[(fq * 4 + jj) * BUP + nt * 16 + fr] = acc[jj]; }
            asm volatile("s_waitcnt lgkmcnt(0)" ::: "memory");
#pragma unroll
            for (int ii = 0; ii < 16; ++ii) { const int tl = dir ? 15 - ii : ii; const f32x2 b2 = *(const f32x2*)(BuW + tl * BUP + 2 * p);
                f32x2 ns = __builtin_elementwise_fma((f32x2){ab_re, ab_re}, (f32x2){sr, si}, b2); ns = __builtin_elementwise_fma((f32x2){-ab_im, ab_im}, (f32x2){si, sr}, ns); sr = ns[0]; si = ns[1];
                if (PASS == 1) *(unsigned*)(STw + tl * 136 + 2 * p) = cvt_pk_bf16(sr, si); }
            if (PASS == 1) {
                asm volatile("s_waitcnt lgkmcnt(0)" ::: "memory");
                f32x4 acc = {0.f, 0.f, 0.f, 0.f};
#pragma unroll
                for (int ks = 0; ks < 4; ++ks) acc = __builtin_amdgcn_mfma_f32_16x16x32_bf16(*(const bf16x8*)(STw + fr * 136 + ks * 32 + fq * 8), cm[ks], acc, 0, 0, 0);
                yacc[k] = acc;
            }
            asm volatile("s_waitcnt lgkmcnt(0)" ::: "memory");
        }
        if (PASS == 0) { S5LOC[((size_t)(dir * NCH + c) * 64 + g) * 64 + p] = make_float2(sr, si); }
        else {
            __syncthreads();
            if (dir == 0) {
#pragma unroll
                for (int k = 0; k < 8; ++k)
#pragma unroll
                    for (int jj = 0; jj < 4; ++jj) YL[gl * 2048 + (k * 16 + fq * 4 + jj) * 16 + fr] = yacc[k][jj]; }
            __syncthreads();
            if (dir == 1) {
#pragma unroll
                for (int k = 0; k < 8; ++k)
#pragma unroll
                    for (int jj = 0; jj < 4; ++jj) YL[gl * 2048 + ((7 - k) * 16 + fq * 4 + jj) * 16 + fr] += yacc[k][jj]; }
            __syncthreads();
            const int t = tid >> 2, q = tid & 3; const float* y = YL + q * 2048 + t * 16; const float* dd = a.in[14] + (size_t)layer * 1024 + gq * 64 + q * 16;
            const bf16_t* us = U5 + (size_t)(row0 + t) * 1024 + gq * 64 + q * 16; const u32x4 u0 = *(const u32x4*)us, u1 = *(const u32x4*)(us + 8);
            const float u[16] = {bflo(u0.x), bfhi(u0.x), bflo(u0.y), bfhi(u0.y), bflo(u0.z), bfhi(u0.z), bflo(u0.w), bfhi(u0.w), bflo(u1.x), bfhi(u1.x), bflo(u1.y), bfhi(u1.y), bflo(u1.z), bfhi(u1.z), bflo(u1.w), bfhi(u1.w)};
            unsigned o[8];
#pragma unroll
            for (int j = 0; j < 8; ++j) { const float y0 = y[2 * j] + u[2 * j] * dd[2 * j], y1 = y[2 * j + 1] + u[2 * j + 1] * dd[2 * j + 1]; o[j] = cvt_pk_bf16(gelu_tanh(y0), gelu_tanh(y1)); }
            bf16_t* dst = Y5 + (size_t)(row0 + t) * 1024 + gq * 64 + q * 16; u32x4 o0, o1; o0.x = o[0]; o0.y = o[1]; o0.z = o[2]; o0.w = o[3]; o1.x = o[4]; o1.y = o[5]; o1.z = o[6]; o1.w = o[7];
            *(u32x4*)dst = o0; *(u32x4*)(dst + 8) = o1;
        }
    }
    __syncthreads();
}

__device__ __forceinline__ int ssd_chunk_at(int dir, int q) { return s5_chunk_at(dir, q); }
__device__ __forceinline__ void conv8(const bf16_t* XBC, int rowbase, int l0, int ch, bool lo_ok, bool hi_ok, float w0, float w1, float w2, float b, float (&out)[8]) {
    float r[10];
#pragma unroll
    for (int i = 0; i < 10; ++i) { const int l = l0 - 1 + i; const bool ok = (l >= 0 || lo_ok) && (l < 128 || hi_ok); r[i] = ok ? bf2f((unsigned)XBC[(size_t)(rowbase + l) * 3072 + ch]) : 0.f; }
#pragma unroll
    for (int j = 0; j < 8; ++j) out[j] = silu_(w0 * r[j] + w1 * r[j + 1] + w2 * r[j + 2] + b);
}
__device__ __forceinline__ void stage_conv_tile(const bf16_t* XBC, const float* cw, const float* cb, int rowbase, int chbase, bool lo_ok, bool hi_ok, bf16_t* dst, int tid) {
    const int oc = tid & 15, ch = chbase + oc * 8; float w[3][8], b[8];
#pragma unroll
    for (int k = 0; k < 3; ++k) { const f32x4 a0 = *(const f32x4*)(cw + (size_t)k * 3072 + ch), a1 = *(const f32x4*)(cw + (size_t)k * 3072 + ch + 4);
        w[k][0] = a0[0]; w[k][1] = a0[1]; w[k][2] = a0[2]; w[k][3] = a0[3]; w[k][4] = a1[0]; w[k][5] = a1[1]; w[k][6] = a1[2]; w[k][7] = a1[3]; }
    { const f32x4 a0 = *(const f32x4*)(cb + ch), a1 = *(const f32x4*)(cb + ch + 4); b[0] = a0[0]; b[1] = a0[1]; b[2] = a0[2]; b[3] = a0[3]; b[4] = a1[0]; b[5] = a1[1]; b[6] = a1[2]; b[7] = a1[3]; }
#pragma unroll
    for (int i = 0; i < 4; ++i) { const int row = (tid >> 4) + i * 32; float acc[8];
#pragma unroll
        for (int k = 0; k < 8; ++k) acc[k] = b[k];
#pragma unroll
        for (int d = 0; d < 3; ++d) { const bool ok = d == 1 ? true : (d == 0 ? (row > 0 || lo_ok) : (row < 127 || hi_ok)); const int l = ok ? row + d - 1 : row;
            { u32x4 g = *(const u32x4*)(XBC + (size_t)(rowbase + l) * 3072 + ch); if (!ok) g = (u32x4){0u, 0u, 0u, 0u};
                acc[0] += w[d][0] * bflo(g.x); acc[1] += w[d][1] * bfhi(g.x); acc[2] += w[d][2] * bflo(g.y); acc[3] += w[d][3] * bfhi(g.y);
                acc[4] += w[d][4] * bflo(g.z); acc[5] += w[d][5] * bfhi(g.z); acc[6] += w[d][6] * bflo(g.w); acc[7] += w[d][7] * bfhi(g.w); } }
        u32x4 o; o.x = cvt_pk_bf16(silu_(acc[0]), silu_(acc[1])); o.y = cvt_pk_bf16(silu_(acc[2]), silu_(acc[3])); o.z = cvt_pk_bf16(silu_(acc[4]), silu_(acc[5])); o.w = cvt_pk_bf16(silu_(acc[6]), silu_(acc[7]));
        *(u32x4*)(dst + row * 136 + oc * 8) = o; }
}
constexpr int SL_CS = 0, SL_CB = 34816, SL_CUM = 69632, SL_DT = 77824, SL_PART = 86016, SL_BS = 94208, SL_XT = 94208;
template <int AUX> __device__ __forceinline__ void ssd_cum(const Args& a, int layer, int c, int h, int w, int lane, unsigned char* lds) {
    const float* DT = (const float*)(a.ws + WS_BIG + B_DT); float* cumL = (float*)(lds + SL_CUM); float* dtL = (float*)(lds + SL_DT); float* CHD = (float*)(a.ws + WS_CHD);
#pragma unroll
    for (int dir = 0; dir < 2; ++dir) {
        const float ah = -expf(a.in[20][(size_t)(layer * 2 + dir) * 32 + h]);
        const float d0 = DT[(size_t)(c * 128 + 2 * lane) * 64 + dir * 32 + h], d1 = DT[(size_t)(c * 128 + 2 * lane + 1) * 64 + dir * 32 + h];
        const float l0 = d0 * ah, l1 = d1 * ah, s = l0 + l1; float incl = s;
#pragma unroll
        for (int o = 1; o < 64; o <<= 1) { const float t = __shfl_up(incl, o); if (lane >= o) incl += t; }
        const float excl = incl - s, tot = __shfl(incl, 63);
        float c0, c1;
        if (dir == 0) { c0 = excl + l0; c1 = incl; } else { c0 = tot - excl; c1 = tot - (excl + l0); }
        float* cu = cumL + (dir * 8 + w) * 128 + 2 * lane; cu[0] = c0; cu[1] = c1;
        float* dd = dtL + (dir * 8 + w) * 128 + 2 * lane;
        if (AUX == 0) { dd[0] = d0; dd[1] = d1; } else { dd[0] = d0 * __expf(tot - c0); dd[1] = d1 * __expf(tot - c1); if (lane == 0) CHD[(size_t)(dir * NCH + c) * 32 + h] = tot; }
    }
}
__device__ __forceinline__ void stage_T(const bf16_t* XBC, const float* cw, const float* cb, int rowbase, int ch, int r0, bool lo_ok, bool hi_ok, bf16_t* dstT) {
    float w[3][8], b[8];
#pragma unroll
    for (int k = 0; k < 3; ++k) { const f32x4 a0 = *(const f32x4*)(cw + (size_t)k * 3072 + ch), a1 = *(const f32x4*)(cw + (size_t)k * 3072 + ch + 4);
        w[k][0] = a0[0]; w[k][1] = a0[1]; w[k][2] = a0[2]; w[k][3] = a0[3]; w[k][4] = a1[0]; w[k][5] = a1[1]; w[k][6] = a1[2]; w[k][7] = a1[3]; }
    { const f32x4 a0 = *(const f32x4*)(cb + ch), a1 = *(const f32x4*)(cb + ch + 4); b[0] = a0[0]; b[1] = a0[1]; b[2] = a0[2]; b[3] = a0[3]; b[4] = a1[0]; b[5] = a1[1]; b[6] = a1[2]; b[7] = a1[3]; }
    u32x4 raw[10];
    const bf16_t* base = XBC + (size_t)(rowbase + r0) * 3072 + ch;
    const bool ok0 = r0 > 0 || lo_ok, ok9 = r0 < 120 || hi_ok;
#pragma unroll
    for (int i = 1; i < 9; ++i) raw[i] = *(const u32x4*)(base + (i - 1) * 3072);
    { const u32x4 v = *(const u32x4*)(base + (ok0 ? -3072 : 0)); raw[0] = ok0 ? v : (u32x4){0u, 0u, 0u, 0u}; }
    { const u32x4 v = *(const u32x4*)(base + (ok9 ? 8 * 3072 : 7 * 3072)); raw[9] = ok9 ? v : (u32x4){0u, 0u, 0u, 0u}; }
    float sp[8]; unsigned o[8][4];
#pragma unroll
    for (int r = 0; r < 8; ++r) { float sv[8];
#pragma unroll
        for (int k = 0; k < 8; ++k) { float acc = b[k];
#pragma unroll
            for (int d = 0; d < 3; ++d) { const unsigned wd = k < 2 ? raw[r + d].x : (k < 4 ? raw[r + d].y : (k < 6 ? raw[r + d].z : raw[r + d].w)); acc += w[d][k] * ((k & 1) ? bfhi(wd) : bflo(wd)); }
            sv[k] = silu_(acc); }
        if (r & 1) {
#pragma unroll
            for (int k = 0; k < 8; ++k) o[k][r >> 1] = cvt_pk_bf16(sp[k], sv[k]); }
        else {
#pragma unroll
            for (int k = 0; k < 8; ++k) sp[k] = sv[k]; } }
#pragma unroll
    for (int k = 0; k < 8; ++k) { u32x4 v; v.x = o[k][0]; v.y = o[k][1]; v.z = o[k][2]; v.w = o[k][3]; *(u32x4*)(dstT + k * 136 + r0) = v; }
}
__device__ __forceinline__ void ssd_a_phase(const Args& a, int layer, unsigned char* lds, int tid) {
    const bf16_t* XBC = (const bf16_t*)(a.ws + WS_BIG + B_XBC); bf16_t* SST = (bf16_t*)(a.ws + WS_SST);
    const float* cw = a.in[17] + (size_t)layer * 3 * 3072; const float* cb = a.in[18] + (size_t)layer * 3072;
    bf16_t* BT = (bf16_t*)(lds + SL_CS); bf16_t* xT = (bf16_t*)(lds + SL_XT); const float* wL = (const float*)(lds + SL_DT);
    for (int unit = blockIdx.x; unit < NCH * 4; unit += gridDim.x) {
        int tl = tid; asm volatile("" : "+v"(tl));
        const int lane = tl & 63, w = __builtin_amdgcn_readfirstlane(tl >> 6), fr = lane & 15, fq = lane >> 4, og = lane & 7, rr = lane >> 3;
        const int c = unit >> 2, g = unit & 3, rowbase = c * 128; const bool lo_ok = !(c == 0 || c == 128), hi_ok = !(c == 127 || c == 129);
        __syncthreads();
        if (w < 4) { const int oct = (w & 1) * 8 + og; stage_T(XBC, cw, cb, rowbase, 2048 + g * 128 + oct * 8, ((w >> 1) * 8 + rr) * 8, lo_ok, hi_ok, BT + (oct * 8) * 136); }
        ssd_cum<1>(a, layer, c, g * 8 + w, w, lane, lds);
#pragma unroll 1
        for (int pass = 0; pass < 2; ++pass) {
            if (pass) __syncthreads();
            { const int hs = w & 3; stage_T(XBC, cw, cb, rowbase, (g * 8 + pass * 4 + hs) * 64 + og * 8, ((w >> 2) * 8 + rr) * 8, lo_ok, hi_ok, xT + ((hs * 64 + og * 8) * 136)); }
            __syncthreads();
            const int hl = w >> 1, dir = w & 1, hh = pass * 4 + hl, h = g * 8 + hh;
            bf16_t* sb = SST + (((size_t)(dir * NCH + c) * 32 + h) * 64) * 128;
#pragma unroll 1
            for (int nh = 0; nh < 2; ++nh) {
                f32x4 acc[4][4];
#pragma unroll
                for (int pt = 0; pt < 4; ++pt)
#pragma unroll
                    for (int nt = 0; nt < 4; ++nt) acc[pt][nt] = (f32x4){0.f, 0.f, 0.f, 0.f};
#pragma unroll
                for (int ks = 0; ks < 4; ++ks) {
                    const float* wp = wL + (dir * 8 + hh) * 128 + ks * 32 + fq * 8; const f32x4 wl0 = *(const f32x4*)wp, wl1 = *(const f32x4*)(wp + 4);
                    bf16x8 yf[4];
#pragma unroll
                    for (int pt = 0; pt < 4; ++pt) { const u32x4 xr = *(const u32x4*)(xT + ((hl * 64 + pt * 16 + fr) * 136 + ks * 32 + fq * 8));
                        yf[pt] = mkfrag(cvt_pk_bf16(bflo(xr.x) * wl0[0], bfhi(xr.x) * wl0[1]), cvt_pk_bf16(bflo(xr.y) * wl0[2], bfhi(xr.y) * wl0[3]), cvt_pk_bf16(bflo(xr.z) * wl1[0], bfhi(xr.z) * wl1[1]), cvt_pk_bf16(bflo(xr.w) * wl1[2], bfhi(xr.w) * wl1[3])); }
#pragma unroll
                    for (int nt = 0; nt < 4; ++nt) { const bf16x8 xf = *(const bf16x8*)(BT + ((nh * 4 + nt) * 16 + fr) * 136 + ks * 32 + fq * 8);
#pragma unroll
                        for (int pt = 0; pt < 4; ++pt) acc[pt][nt] = __builtin_amdgcn_mfma_f32_16x16x32_bf16(xf, yf[pt], acc[pt][nt], 0, 0, 0); }
                }
#pragma unroll
                for (int pt = 0; pt < 4; ++pt) mfma_settle(acc[pt][3]);
#pragma unroll
                for (int pt = 0; pt < 4; ++pt)
#pragma unroll
                    for (int nt = 0; nt < 4; ++nt) { u32x2 o; o.x = cvt_pk_native(acc[pt][nt][0], acc[pt][nt][1]); o.y = cvt_pk_native(acc[pt][nt][2], acc[pt][nt][3]);
                        *(u32x2*)(sb + (size_t)(pt * 16 + fr) * 128 + (nh * 4 + nt) * 16 + fq * 4) = o; }
            }
        }
    }
    __syncthreads();
}
__device__ __forceinline__ void ssd_b_phase(const Args& a, int tid) {
    bf16_t* SST = (bf16_t*)(a.ws + WS_SST); const float* CHD = (const float*)(a.ws + WS_CHD);
    for (int idx = blockIdx.x * 512 + tid; idx < 64 * 2048; idx += gridDim.x * 512) {
        const int e4 = idx & 2047, hd = idx >> 11, dir = hd >> 5, h = hd & 31; float s0 = 0.f, s1 = 0.f, s2 = 0.f, s3 = 0.f;
#pragma unroll 1
        for (int b = 0; b < 13; ++b) { u32x2 loc[10]; float dc[10];
#pragma unroll
            for (int i = 0; i < 10; ++i) { const int cq = ssd_chunk_at(dir, b * 10 + i); loc[i] = *(const u32x2*)(SST + ((size_t)(dir * NCH + cq) * 32 + h) * 8192 + e4 * 4); dc[i] = CHD[(size_t)(dir * NCH + cq) * 32 + h]; }
#pragma unroll
            for (int i = 0; i < 10; ++i) { const int cq = ssd_chunk_at(dir, b * 10 + i); u32x2 o; o.x = cvt_pk_bf16(s0, s1); o.y = cvt_pk_bf16(s2, s3);
                *(u32x2*)(SST + ((size_t)(dir * NCH + cq) * 32 + h) * 8192 + e4 * 4) = o; const float e = __expf(dc[i]);
                s0 = e * s0 + bflo(loc[i].x); s1 = e * s1 + bfhi(loc[i].x); s2 = e * s2 + bflo(loc[i].y); s3 = e * s3 + bfhi(loc[i].y); }
        }
    }
}
__device__ __forceinline__ void ssd_c_phase(const Args& a, int layer, unsigned char* lds, int tid, int nchunks) {
    const bf16_t* XBC = (const bf16_t*)(a.ws + WS_BIG + B_XBC); const bf16_t* SST = (const bf16_t*)(a.ws + WS_SST); const bf16_t* Z = (const bf16_t*)(a.ws + WS_BIG + B_Z); bf16_t* YD = (bf16_t*)(a.ws + WS_BIG + B_YD);
    const float* cw = a.in[17] + (size_t)layer * 3 * 3072; const float* cb = a.in[18] + (size_t)layer * 3072; const float* normw = a.in[22] + (size_t)layer * 2048;
    bf16_t* Cs = (bf16_t*)(lds + SL_CS); bf16_t* Bs = (bf16_t*)(lds + SL_BS); bf16_t* CBs = (bf16_t*)(lds + SL_CB); bf16_t* xT = (bf16_t*)(lds + SL_XT);
    const float* cumL = (const float*)(lds + SL_CUM); const float* dtL = (const float*)(lds + SL_DT); float* part = (float*)(lds + SL_PART);
    for (int unit = blockIdx.x; unit < nchunks * 4; unit += gridDim.x) {
        int tl = tid; asm volatile("" : "+v"(tl));
        const int lane = tl & 63, w = __builtin_amdgcn_readfirstlane(tl >> 6), fr = lane & 15, fq = lane >> 4, og = lane & 7, rr = lane >> 3;
        const int hl = w & 3, lh = w >> 2;
        const int c = unit >> 2, g = unit & 3, rowbase = c * 128; const bool lo_ok = !(c == 0 || c == 128), hi_ok = !(c == 127 || c == 129);
        __syncthreads();
        stage_conv_tile(XBC, cw, cb, rowbase, 2560 + g * 128, lo_ok, hi_ok, Cs, tl);
        stage_conv_tile(XBC, cw, cb, rowbase, 2048 + g * 128, lo_ok, hi_ok, Bs, tl);
        ssd_cum<0>(a, layer, c, g * 8 + w, w, lane, lds);
        __syncthreads();
#pragma unroll 1
        for (int st = 0; st < 8; ++st) { f32x4 acc = {0.f, 0.f, 0.f, 0.f};
#pragma unroll
            for (int ks = 0; ks < 4; ++ks) { const bf16x8 xf = *(const bf16x8*)(Bs + (st * 16 + fr) * 136 + ks * 32 + fq * 8), yf = *(const bf16x8*)(Cs + (w * 16 + fr) * 136 + ks * 32 + fq * 8);
                acc = __builtin_amdgcn_mfma_f32_16x16x32_bf16(xf, yf, acc, 0, 0, 0); }
            mfma_settle(acc);
            u32x2 o; o.x = cvt_pk_native(acc[0], acc[1]); o.y = cvt_pk_native(acc[2], acc[3]); *(u32x2*)(CBs + (w * 16 + fr) * 136 + st * 16 + fq * 4) = o; }
#pragma unroll 1
        for (int pass = 0; pass < 2; ++pass) {
            __syncthreads();
            stage_T(XBC, cw, cb, rowbase, (g * 8 + pass * 4 + hl) * 64 + og * 8, (lh * 8 + rr) * 8, lo_ok, hi_ok, xT + ((hl * 64 + og * 8) * 136));
            __syncthreads();
            const int hh = pass * 4 + hl, h = g * 8 + hh; const float Dh = a.in[21][(size_t)layer * 32 + h];
#pragma unroll 1
            for (int ih = 0; ih < 2; ++ih) {
            f32x4 acc[2][4];
#pragma unroll
            for (int i = 0; i < 2; ++i)
#pragma unroll
                for (int pt = 0; pt < 4; ++pt) acc[i][pt] = (f32x4){0.f, 0.f, 0.f, 0.f};
#pragma unroll
            for (int dir = 0; dir < 2; ++dir) {
                const bf16_t* sb = SST + (((size_t)(dir * NCH + c) * 32 + h) * 64) * 128;
                f32x4 tmp[2][4];
#pragma unroll
                for (int i = 0; i < 2; ++i)
#pragma unroll
                    for (int pt = 0; pt < 4; ++pt) tmp[i][pt] = (f32x4){0.f, 0.f, 0.f, 0.f};
#pragma unroll
                for (int ks = 0; ks < 4; ++ks) { const int lb = (lh * 4 + ih * 2) * 16 + fr;
                    const bf16x8 yf0 = *(const bf16x8*)(Cs + lb * 136 + ks * 32 + fq * 8), yf1 = *(const bf16x8*)(Cs + (lb + 16) * 136 + ks * 32 + fq * 8);
#pragma unroll
                    for (int pt = 0; pt < 4; ++pt) { const bf16x8 sfr = *(const bf16x8*)(sb + (size_t)(pt * 16 + fr) * 128 + ks * 32 + fq * 8);
                        tmp[0][pt] = __builtin_amdgcn_mfma_f32_16x16x32_bf16(sfr, yf0, tmp[0][pt], 0, 0, 0); tmp[1][pt] = __builtin_amdgcn_mfma_f32_16x16x32_bf16(sfr, yf1, tmp[1][pt], 0, 0, 0); } }
#pragma unroll
                for (int i = 0; i < 2; ++i) { int frv = fr; asm volatile("" : "+v"(frv));
                    const int lt = lh * 4 + ih * 2 + i, l = lt * 16 + frv;
                    const float cl = cumL[(dir * 8 + hh) * 128 + l], el = __expf(cl);
#pragma unroll
                    for (int pt = 0; pt < 4; ++pt) acc[i][pt] += tmp[i][pt] * el;
#pragma unroll
                    for (int ks = 0; ks < 4; ++ks) { const int s0 = ks * 32;
                        const bool skip = dir == 0 ? (s0 > lt * 16 + 15) : (s0 + 31 < lt * 16);
                        if (!skip) { const u32x4 cbv = *(const u32x4*)(CBs + l * 136 + s0 + fq * 8);
                            const float* cp = cumL + (dir * 8 + hh) * 128 + s0 + fq * 8; const float* dp = dtL + (dir * 8 + hh) * 128 + s0 + fq * 8;
                            const f32x4 c0 = *(const f32x4*)cp, c1 = *(const f32x4*)(cp + 4), d0 = *(const f32x4*)dp, d1 = *(const f32x4*)(dp + 4);
                            float cbf[8] = {bflo(cbv.x), bfhi(cbv.x), bflo(cbv.y), bfhi(cbv.y), bflo(cbv.z), bfhi(cbv.z), bflo(cbv.w), bfhi(cbv.w)}; float v[8];
#pragma unroll
                            for (int j = 0; j < 8; ++j) { const int sx = s0 + fq * 8 + j; const float cs = j < 4 ? c0[j & 3] : c1[j & 3], ds = j < 4 ? d0[j & 3] : d1[j & 3];
                                const bool valid = dir == 0 ? (sx <= l) : (sx >= l); float t = valid ? cbf[j] * __expf(fminf(cl - cs, 0.f)) * ds : 0.f; if (dir == 0 && sx == l) t += Dh; v[j] = t; }
                            const bf16x8 yf = mkfrag(cvt_pk_bf16(v[0], v[1]), cvt_pk_bf16(v[2], v[3]), cvt_pk_bf16(v[4], v[5]), cvt_pk_bf16(v[6], v[7]));
#pragma unroll
                            for (int pt = 0; pt < 4; ++pt) acc[i][pt] = __builtin_amdgcn_mfma_f32_16x16x32_bf16(*(const bf16x8*)(xT + ((hl * 64 + pt * 16 + fr) * 136 + s0 + fq * 8)), yf, acc[i][pt], 0, 0, 0); } }
                }
            }
#pragma unroll
            for (int i = 0; i < 2; ++i) { const int l = (lh * 4 + ih * 2 + i) * 16 + fr; const size_t row = (size_t)(rowbase + l); float ss = 0.f;
#pragma unroll
                for (int pt = 0; pt < 4; ++pt) { const int ch = h * 64 + pt * 16 + fq * 4; const u32x2 zz = *(const u32x2*)(Z + row * 2048 + ch);
                    const float h0 = acc[i][pt][0] * silu_(bflo(zz.x)), h1 = acc[i][pt][1] * silu_(bfhi(zz.x)), h2 = acc[i][pt][2] * silu_(bflo(zz.y)), h3 = acc[i][pt][3] * silu_(bfhi(zz.y));
                    ss += (h0 * h0 + h1 * h1) + (h2 * h2 + h3 * h3); u32x2 o; o.x = cvt_pk_bf16(h0, h1); o.y = cvt_pk_bf16(h2, h3); *(u32x2*)(YD + row * 2048 + ch) = o; }
                ss += __shfl_xor(ss, 16); ss += __shfl_xor(ss, 32);
                if (fq == 0) part[hh * 128 + l] = ss; }
            }
        }
        __syncthreads();
#pragma unroll 1
        for (int it = 0; it < 8; ++it) { const int pass = it >> 2, i = it & 3, l = (lh * 4 + i) * 16 + fr, h = g * 8 + pass * 4 + hl; float tot = 0.f;
#pragma unroll
            for (int hd = 0; hd < 8; ++hd) tot += part[hd * 128 + l];
            const float r = __builtin_amdgcn_rsqf(tot * (1.f / 512.f) + RMS_EPS); const size_t row = (size_t)(rowbase + l);
#pragma unroll
            for (int pt = 0; pt < 4; ++pt) { const int ch = h * 64 + pt * 16 + fq * 4; bf16_t* yp = YD + row * 2048 + ch; const u32x2 hv = *(const u32x2*)yp; const f32x4 nw = *(const f32x4*)(normw + ch);
                u32x2 o; o.x = cvt_pk_bf16(bflo(hv.x) * r * nw[0], bfhi(hv.x) * r * nw[1]); o.y = cvt_pk_bf16(bflo(hv.y) * r * nw[2], bfhi(hv.y) * r * nw[3]); *(u32x2*)yp = o; } }
    }
    __syncthreads();
}

#define LAS __attribute__((address_space(3)))
#define XB_TMO      128
#define XB_XCNT(j)  (256  + 64 * (j))
#define XB_XSUB(j)  (1280 + 64 * (j))
#define XB_XGEN(j)  (2304 + 64 * (j))
#define XB_TOP      3328
#define XB_TOPGEN   3392
#define XCD_BAR_WORDS 3456
#define XB_SPIN_CAP (1u << 18)

__device__ __forceinline__ unsigned xb_ld(unsigned* p)              { return __hip_atomic_load(p, __ATOMIC_RELAXED, __HIP_MEMORY_SCOPE_AGENT); }
__device__ __forceinline__ unsigned xb_add(unsigned* p, unsigned v) { return __hip_atomic_fetch_add(p, v, __ATOMIC_RELAXED, __HIP_MEMORY_SCOPE_AGENT); }
__device__ __forceinline__ unsigned xb_xcc_id() { return (unsigned)__builtin_amdgcn_s_getreg((3 << 11) | 20) & 0xFu; }
#define XB_SPIN(cond, bar) do { unsigned _sp = 0; while (cond) { __builtin_amdgcn_s_sleep(1); \
    if ((++_sp & 255u) == 0u) { if (xb_ld(&(bar)[XB_TMO])) break; if (_sp > XB_SPIN_CAP) { atomicAdd(&(bar)[XB_TMO], 1u); break; } } } } while (0)

struct XcdBarrier {
    unsigned* bar; unsigned x;
    volatile LAS unsigned* st;
};

__device__ __forceinline__ XcdBarrier xcd_barrier_post(unsigned* bar, volatile LAS unsigned* st) {
    XcdBarrier b; b.bar = bar; b.x = xb_xcc_id(); b.st = st;
    if (threadIdx.x == 0) (void)xb_add(&bar[XB_XCNT(b.x)], 1u);
    return b;
}
__device__ __forceinline__ void xcd_barrier_complete(unsigned* bar, unsigned x, unsigned& nloc, unsigned& nx) {
    const unsigned G = gridDim.x * gridDim.y * gridDim.z;
    unsigned sum, cnt, mine, sp = 0u;
    for (;;) {
        sum = 0u; cnt = 0u; mine = 0u;
#pragma unroll
        for (unsigned j = 0; j < 16; ++j) { const unsigned c = xb_ld(&bar[XB_XCNT(j)]); sum += c; cnt += (c > 0u) ? 1u : 0u; mine = (j == x) ? c : mine; }
        if (sum == G) break;
        __builtin_amdgcn_s_sleep(1);
        if ((++sp & 255u) == 0u) { if (xb_ld(&bar[XB_TMO])) break; if (sp > XB_SPIN_CAP) { atomicAdd(&bar[XB_TMO], 1u); break; } }
    }
    nloc = mine > 0u ? mine : 1u; nx = cnt > 0u ? cnt : 1u;
}

__device__ __forceinline__ void xcd_barrier(const XcdBarrier& b) {
    asm volatile("s_waitcnt vmcnt(0)" ::: "memory");
    __syncthreads();
    if (threadIdx.x == 0) {
        unsigned* bar = b.bar;
        __builtin_amdgcn_s_waitcnt(0);
        unsigned nloc = b.st[0], nx = b.st[1];
        if (nloc == 0u) { xcd_barrier_complete(bar, b.x, nloc, nx); b.st[0] = nloc; b.st[1] = nx; }
        const unsigned old = xb_add(&bar[XB_XSUB(b.x)], 1u);
        const unsigned gen = old / nloc;
        if (old + 1u == (gen + 1u) * nloc) {
            __builtin_amdgcn_fence(__ATOMIC_RELEASE, "agent");
            asm volatile("s_waitcnt vmcnt(0)" ::: "memory");
            const unsigned og = xb_add(&bar[XB_TOP], 1u);
            const unsigned tg = og / nx;
            if (og + 1u == (tg + 1u) * nx) xb_add(&bar[XB_TOPGEN], 1u);
            else XB_SPIN(xb_ld(&bar[XB_TOPGEN]) == tg, bar);
            __builtin_amdgcn_fence(__ATOMIC_ACQUIRE, "agent");
            xb_add(&bar[XB_XGEN(b.x)], 1u);
            asm volatile("s_waitcnt vmcnt(0)" ::: "memory");
        } else {
            XB_SPIN(xb_ld(&bar[XB_XGEN(b.x)]) == gen, bar);
            __builtin_amdgcn_fence(__ATOMIC_ACQUIRE, "agent");
            asm volatile("s_waitcnt vmcnt(0)" ::: "memory");
        }
    }
    __syncthreads();
}

#ifndef MK_REP_S5
#define MK_REP_S5 1
#endif
#ifndef MK_REP_SSD
#define MK_REP_SSD 1
#endif
#ifndef MK_REP_SYNC
#define MK_REP_SYNC 1
#endif
#ifndef MK_CG_SYNC_ALL
#define MK_CG_SYNC_ALL 0
#endif
#ifndef MK_REP_PRO
#define MK_REP_PRO 1
#endif
#ifndef MK_REP_GEMM
#define MK_REP_GEMM 1
#endif
constexpr int NPHASE = 2 + 11 * 2;
__global__ void __launch_bounds__(512, 2) fwd_megakernel(Args a) {
    extern __shared__ __attribute__((aligned(16))) unsigned char lds[];
    PG8_LAS unsigned char* lds3 = (PG8_LAS unsigned char*)lds;
    unsigned char* big = a.ws + WS_BIG;
    volatile LAS unsigned* bst = (volatile LAS unsigned*)(lds3 + (LDS_BYTES - 16));
    if (threadIdx.x < 4) bst[threadIdx.x] = 0u;
    __syncthreads();
    XcdBarrier xbar; xbar.bar = (unsigned*)(a.ws + WS_BAR); xbar.x = 0; xbar.st = bst;
    if (a.ph_hi - a.ph_lo > 1) xbar = xcd_barrier_post((unsigned*)(a.ws + WS_BAR), bst);
    for (int ph = a.ph_lo; ph < a.ph_hi; ++ph) {
        const int tid = pg8::pg8_tid(), lane = tid & 63, wave = tid >> 6, gw = blockIdx.x * 8 + wave, NGW = gridDim.x * 8;
        if (ph == 0) {
            for (int rep = 0; rep < MK_REP_PRO; ++rep) {
            adaln_phase(a, (float*)lds, tid);
            float* scr = (float*)lds + wave * (64 * 33);
            xpose_region(a, 0, 0, scr, gw, NGW, lane); xpose_region(a, 0, 1, scr, gw, NGW, lane); __syncthreads(); }
        } else if (ph == 1) {
            row_phase<0>(a, MT, nullptr, nullptr, 0, 0, gw, NGW, lane);
        } else {
            const int layer = (ph - 2) / 11, k = (ph - 2) % 11; const bool last = layer == 1; const int Mrows = last ? TL : MT;
            const bf16_t* WA = (const bf16_t*)(a.ws + WS_WA); const bf16_t* WB = (const bf16_t*)(a.ws + WS_WB);
#ifdef MK_SKIP_MASK
            if ((MK_SKIP_MASK >> k) & 1) { if (ph + 1 < a.ph_hi) xcd_barrier(xbar); continue; }
#endif
            if (k == 0) {
                pg8::Gemm g{(const bf16_t*)(a.ws + WS_XM), WA + WA_IN / 2, MT, NPROJ, D}; pg8::StaticOrder S; S.init(MT, NPROJ, gridDim.x, blockIdx.x);
                EpiInProj E{big, a.in[19] + (size_t)layer * 64}; for (int rep = 0; rep < MK_REP_GEMM; ++rep) { pg8::gemm_phase<EpiInProj, pg8::StaticOrder>(lds3, g, S, E, nullptr); __syncthreads(); }
            } else if (k == 1) {
                for (int rep = 0; rep < MK_REP_SSD; ++rep) ssd_a_phase(a, layer, lds, tid);
                for (int rep = 0; rep < MK_REP_S5; ++rep) s5_phase<0>(a, layer, lds, tid, NCH);
            } else if (k == 2) {
#if !defined(MK_NO_SSD) && !defined(MK_NO_SSDB)
                ssd_b_phase(a, tid);
#endif
                for (int rep = 0; rep < MK_REP_S5; ++rep) s5_phase<1>(a, layer, lds, tid, last ? 128 : NCH);
            } else if (k == 3) {
                for (int rep = 0; rep < MK_REP_SSD; ++rep) ssd_c_phase(a, layer, lds, tid, last ? 128 : NCH);
#ifndef MK_NO_S5
                pg8::Gemm g{(const bf16_t*)(big + B_Y5), WA + WA_GLU / 2, Mrows, 2048, 1024}; pg8::StaticOrder S; S.init(Mrows, 2048, gridDim.x, blockIdx.x);
                EpiGlu E{(bf16_t*)(big + B_U5)}; pg8::gemm_phase<EpiGlu, pg8::StaticOrder>(lds3, g, S, E, nullptr);
#endif
            } else if (k == 4) {
#ifndef MK_NO_S5
                { pg8::Gemm g{(const bf16_t*)(big + B_U5), WA + WA_S5P / 2, Mrows, 2048, 1024}; pg8::StaticOrder S; S.init(Mrows, 2048, gridDim.x, blockIdx.x);
                  EpiMerge<0> E{(bf16_t*)(big + B_XBC), (const bf16_t*)(big + B_GATE)}; pg8::gemm_phase<EpiMerge<0>, pg8::StaticOrder>(lds3, g, S, E, nullptr); }
                __syncthreads();
#endif
#ifndef MK_NO_SSD
#ifdef MK_NO_S5
                { pg8::Gemm g{(const bf16_t*)(big + B_YD), WA + WA_SSDP / 2, Mrows, 2048, 2048}; pg8::StaticOrder S; S.init(Mrows, 2048, gridDim.x, blockIdx.x);
                  EpiMerge<0, 1> E{(bf16_t*)(big + B_XBC), (const bf16_t*)(big + B_GATE)}; pg8::gemm_phase<EpiMerge<0, 1>, pg8::StaticOrder>(lds3, g, S, E, nullptr); }
#else
                { pg8::Gemm g{(const bf16_t*)(big + B_YD), WA + WA_SSDP / 2, Mrows, 2048, 2048}; pg8::StaticOrder S; S.init(Mrows, 2048, gridDim.x, blockIdx.x);
                  EpiMerge<1> E{(bf16_t*)(big + B_XBC), (const bf16_t*)(big + B_GATE)}; pg8::gemm_phase<EpiMerge<1>, pg8::StaticOrder>(lds3, g, S, E, nullptr); }
#endif
#endif
            } else if (k == 5) {
                pg8::Gemm g{(const bf16_t*)(big + B_XBC), WA + WA_WOUT / 2, Mrows, 2048, 2048}; pg8::StaticOrder S; S.init(Mrows, 2048, gridDim.x, blockIdx.x);
                EpiResid E{a.out, (float*)(a.ws + WS_HCTX), mvec(a, layer, 0) + 2 * D, mvec(a, layer, 1) + 2 * D}; pg8::gemm_phase<EpiResid, pg8::StaticOrder>(lds3, g, S, E, nullptr);
            } else if (k == 6) {
                row_phase<1>(a, Mrows, a.in[25] + (size_t)layer * D, a.in[26] + (size_t)layer * D, layer, 3 * D, gw, NGW, lane);
                if (!last) for (int rep = 0; rep < MK_REP_PRO; ++rep) { __syncthreads(); xpose_region(a, layer + 1, 0, (float*)lds + wave * (64 * 33), gw, NGW, lane); }
            } else if (k == 7) {
                pg8::Gemm g{(const bf16_t*)(a.ws + WS_XM), WB + WB_UP / 2, Mrows, 2 * DFF, D}; pg8::StaticOrder S; S.init(Mrows, 2 * DFF, gridDim.x, blockIdx.x);
                EpiUp E{(bf16_t*)(big + B_G), (bf16_t*)(big + B_V)}; for (int rep = 0; rep < MK_REP_GEMM; ++rep) { pg8::gemm_phase<EpiUp, pg8::StaticOrder>(lds3, g, S, E, nullptr); __syncthreads(); }
            } else if (k == 8) {
                ffnconv_phase(a, layer, !last, lds, tid);
            } else if (k == 9) {
                pg8::Gemm g{(const bf16_t*)(big + B_V), WB + WB_DOWN / 2, Mrows, D, DFF}; pg8::StaticOrder S; S.init(Mrows, D, gridDim.x, blockIdx.x);
                EpiResid E{a.out, (float*)(a.ws + WS_HCTX), mvec(a, layer, 0) + 5 * D, mvec(a, layer, 1) + 5 * D}; pg8::gemm_phase<EpiResid, pg8::StaticOrder>(lds3, g, S, E, nullptr);
            } else {
                row_phase<1>(a, Mrows, a.in[31] + (size_t)layer * D, a.in[32] + (size_t)layer * D, last ? -1 : layer + 1, 0, gw, NGW, lane);
                if (!last) for (int rep = 0; rep < MK_REP_PRO; ++rep) { __syncthreads(); xpose_region(a, layer + 1, 1, (float*)lds + wave * (64 * 33), gw, NGW, lane); }
            }
        }
        if (ph + 1 < a.ph_hi) { for (int rep = 0; rep < MK_REP_SYNC; ++rep) { if (MK_CG_SYNC_ALL || ph == a.ph_lo) cg::this_grid().sync(); else xcd_barrier(xbar); } }
#ifdef MK_TS_MASK
        if (blockIdx.x == 0 && threadIdx.x == 0) ((unsigned long long*)(a.ws + WS_BAR + 65536))[ph + 1] = __builtin_amdgcn_s_memrealtime();
#endif
    }
#ifdef MK_TS_MASK
    if (blockIdx.x == 0 && threadIdx.x == 0) {
        const unsigned long long* ts = (const unsigned long long*)(a.ws + WS_BAR + 65536); unsigned long long sum = 0;
        for (int ph = 1; ph < a.ph_hi - 1; ++ph) if ((MK_TS_MASK >> ph) & 1ull) sum += ts[ph + 1] - ts[ph];
        const unsigned long long t0 = __builtin_amdgcn_s_memrealtime();
        while (__builtin_amdgcn_s_memrealtime() - t0 < sum * MK_TS_AMP) __builtin_amdgcn_s_sleep(8);
    }
#endif
}
}

#ifndef MK_N_LAUNCH_MODE
#define MK_N_LAUNCH_MODE 0
#endif
extern "C" void kernel_launch(void* const* d_in, const int* in_sizes, int n_in, void* d_out, int out_size, void* d_ws, size_t ws_size, hipStream_t stream) {
    static int grid = 0;
    if (grid == 0) {
        if (n_in != 33 || ws_size < mk::WS_END) { fprintf(stderr, "kernel_launch: need 33 inputs and %zu bytes of workspace (got %d, %zu)\n", (size_t)mk::WS_END, n_in, ws_size); grid = -1; return; }
        int dev = 0, cus = 0, per_cu = 0;
        (void)hipGetDevice(&dev); (void)hipDeviceGetAttribute(&cus, hipDeviceAttributeMultiprocessorCount, dev);
        if (hipFuncSetAttribute((const void*)mk::fwd_megakernel, hipFuncAttributeMaxDynamicSharedMemorySize, mk::LDS_BYTES) != hipSuccess) { fprintf(stderr, "kernel_launch: hipFuncSetAttribute failed\n"); grid = -1; return; }
        if (hipOccupancyMaxActiveBlocksPerMultiprocessor(&per_cu, (const void*)mk::fwd_megakernel, 512, mk::LDS_BYTES) != hipSuccess || per_cu < 1) { fprintf(stderr, "kernel_launch: occupancy query says %d\n", per_cu); per_cu = 1; }
        (void)hipGetLastError();
        grid = cus * per_cu; if (grid > 256) grid = 256;
    }
    if (grid < 0) return;
    mk::Args a{};
    for (int i = 0; i < 33; ++i) a.in[i] = (const float*)d_in[i];
    a.out = (float*)d_out; a.ws = (unsigned char*)d_ws;
#if MK_N_LAUNCH_MODE == 1
    for (int ph = 0; ph < mk::NPHASE; ++ph) { a.ph_lo = ph; a.ph_hi = ph + 1; hipLaunchKernelGGL(mk::fwd_megakernel, dim3(grid), dim3(512), mk::LDS_BYTES, stream, a); }
#else
    a.ph_lo = 0; a.ph_hi = mk::NPHASE;
    (void)hipMemsetAsync((unsigned char*)d_ws + mk::WS_BAR, 0, XCD_BAR_WORDS * sizeof(unsigned), stream);
    void* args[] = {&a};
    hipError_t e = hipLaunchCooperativeKernel((const void*)mk::fwd_megakernel, dim3(grid), dim3(512), args, mk::LDS_BYTES, stream);
    if (e != hipSuccess) fprintf(stderr, "cooperative launch failed: %s (grid %d)\n", hipGetErrorString(e), grid);
#endif
}
```

```cpp
#include <hip/hip_runtime.h>
#include <hip/hip_cooperative_groups.h>
#include <cstdio>
namespace cg = cooperative_groups;
#define MK_N_LAUNCH_MODE 0
namespace pg8 {
#define PG8_LAS __attribute__((address_space(3)))
typedef unsigned short bf16_t;
typedef short bf16x8 __attribute__((ext_vector_type(8)));
typedef float f32x4 __attribute__((ext_vector_type(4)));
typedef unsigned u32x4 __attribute__((ext_vector_type(4)));
constexpr int BM = 256, BK = 64, HALF = 128, HTB = HALF * BK * 2  , STAGE_BYTES = 8 * HTB, NXCD = 8, WGM = 8;

__host__ __device__ __forceinline__ int lds_byte(int r, int c) { const int st = (r >> 4) * 2 + (c >> 5), rr = r & 15, cc = c & 31, ob = rr * 64 + cc * 2; return st * 1024 + (ob ^ (((ob >> 9) & 1) << 5)); }
__host__ __device__ __forceinline__ void stage_rc(int b, int& R, int& C) { const int st = b / 1024, sb = b % 1024, swz = sb ^ (((sb >> 9) & 1) << 5); R = (st >> 1) * 16 + swz / 64; C = (st & 1) * 32 + (swz % 64) / 2; }
__host__ __device__ __forceinline__ int perm32(int rho) { const int n = rho >> 4, i = rho & 15; return 8 * (i >> 2) + 4 * n + (i & 3); }

__device__ __forceinline__ int pg8_tid() { int t = threadIdx.x; asm volatile("" : "+v"(t)); return t; }
struct Unit { int pm, pn; };
struct Gemm { const bf16_t* A; const bf16_t* Bt; int M, N, K; };

struct StaticOrder {
    int nM, nN, nwg, G, c;
    __host__ __device__ void init(int M, int N, int G_, int c_) { nM = M / BM; nN = N / BM; nwg = nM * nN; G = G_; c = c_; }
    __host__ __device__ bool next(int i, Unit& u) const {
        const long L = (long)i * G + c; if (L >= nwg) return false;
        int wgid = (int)L; { const int q = nwg / NXCD, r = nwg % NXCD, xcd = wgid % NXCD, off = wgid / NXCD; wgid = (xcd < r ? xcd * (q + 1) : r * (q + 1) + (xcd - r) * q) + off; }
        const int nig = WGM * nN, gid = wgid / nig, fm = gid * WGM, gsz = (nM - fm) < WGM ? (nM - fm) : WGM;
        u.pm = fm + ((wgid % nig) % gsz); u.pn = (wgid % nig) / gsz; return true;
    }
    __device__ __forceinline__ void a_ready(const Unit&) const {}
    __device__ __forceinline__ void done(const Unit&) const {}
};
typedef float f32x2c __attribute__((ext_vector_type(2))); typedef __bf16 bf16x2c __attribute__((ext_vector_type(2)));
__device__ __forceinline__ unsigned cvt_pk_native(float lo, float hi) { const f32x2c v = {lo, hi}; const bf16x2c b = __builtin_convertvector(v, bf16x2c); return __builtin_bit_cast(unsigned, b); }
__device__ __forceinline__ unsigned cvt_pk_bf16(float lo, float hi) { unsigned r; asm volatile("v_cvt_pk_bf16_f32 %0, %1, %2" : "=v"(r) : "v"(lo), "v"(hi)); return r; }
__device__ __forceinline__ void mfma_settle(const float __attribute__((ext_vector_type(4)))& a) { asm volatile("s_nop 15\n\ts_nop 7" :: "v"(a)); }
typedef float f32x2 __attribute__((ext_vector_type(2)));
template <class Epi, class Sched, bool STAMP = false>
__device__ __forceinline__ void gemm_phase(PG8_LAS unsigned char* lds, const Gemm g, const Sched& S, const Epi& E, unsigned long long* stamps) {
    const int tid = pg8_tid(), wid = __builtin_amdgcn_readfirstlane(tid >> 6), lane = tid & 63, wr = wid >> 2, wc = wid & 3, fr = lane & 15, fq = lane >> 4;
    const int K = g.K, nt = K / BK;
    int ts_lo = 0, ts_hi = 0, nts = 0; const unsigned long long rt_entry = STAMP ? (unsigned long long)wall_clock64() : 0ull;
#define PG8_STAMP() do { if (STAMP && wid == 0 && nts < 64) { const unsigned long long _c = (unsigned long long)clock64(); \
        ts_lo = (lane == nts) ? (int)(unsigned)_c : ts_lo; ts_hi = (lane == nts) ? (int)(unsigned)(_c >> 32) : ts_hi; ++nts; } } while (0)
    PG8_STAMP();
    unsigned voffA[2], voffB[2];
#pragma unroll
    for (int i = 0; i < 2; ++i) { int R, C; stage_rc(tid * 16 + i * 8192, R, C); const int Rb = Epi::PERM ? ((R & ~31) + perm32(R & 31)) : R;
        voffA[i] = (unsigned)(R * K + C) * 2u; voffB[i] = (unsigned)(Rb * K + C) * 2u; }
    const size_t kstep = (size_t)(BK * 2);
    const size_t hstep = (size_t)HALF * K * 2;
    const size_t tstep = 2 * hstep;
    const unsigned ldsw = (unsigned)wid * 1024u;
    const int aoff = lds_byte(wr * 64 + fr, fq * 8), boff = lds_byte(wc * 32 + fr, fq * 8);
#define PG8_SA(b, h) (((b) * 2 + (h)) * HTB)
#define PG8_SB(b, h) ((4 + (b) * 2 + (h)) * HTB)
#define PG8_STAGE(bufoff, gbase, voff) do { _Pragma("unroll") for (int _i = 0; _i < 2; ++_i) \
        __builtin_amdgcn_global_load_lds((const unsigned*)((const char*)(gbase) + (voff)[_i]), (PG8_LAS unsigned*)(lds + (bufoff) + ldsw + _i * 8192), 16, 0, 0); } while (0)
#define PG8_LDA(dst, b, h) do { _Pragma("unroll") for (int m = 0; m < 4; ++m) _Pragma("unroll") for (int k = 0; k < 2; ++k) dst[m][k] = *(const PG8_LAS bf16x8*)(lds + PG8_SA(b, h) + aoff + m * 2048 + k * 1024); } while (0)
#define PG8_LDB(dst, b, h) do { _Pragma("unroll") for (int n = 0; n < 2; ++n) _Pragma("unroll") for (int k = 0; k < 2; ++k) dst[n][k] = *(const PG8_LAS bf16x8*)(lds + PG8_SB(b, h) + boff + n * 2048 + k * 1024); } while (0)
#define PG8_MMA(ai, bj, At, Bt) do { __builtin_amdgcn_s_setprio(1); _Pragma("unroll") for (int m = 0; m < 4; ++m) _Pragma("unroll") for (int n = 0; n < 2; ++n) _Pragma("unroll") for (int k = 0; k < 2; ++k) \
        acc[ai][bj][m][n] = __builtin_amdgcn_mfma_f32_16x16x32_bf16(Bt[n][k], At[m][k], acc[ai][bj][m][n], 0, 0, 0); __builtin_amdgcn_s_setprio(0); } while (0)
#define PG8_WAIT_V(n) asm volatile("s_waitcnt vmcnt(" #n ")" ::: "memory")
#define PG8_WAIT_L(n) asm volatile("s_waitcnt lgkmcnt(" #n ")" ::: "memory")
#define PG8_BAR __builtin_amdgcn_s_barrier()
#define PG8_SCHED __builtin_amdgcn_sched_barrier(0)
    Unit cur, nxt; int ui = 0;
    if (!S.next(0, cur)) return;
    f32x4 acc[2][2][4][2];
#pragma unroll
    for (int a = 0; a < 2; ++a)
#pragma unroll
        for (int b = 0; b < 2; ++b)
#pragma unroll
            for (int m = 0; m < 4; ++m)
#pragma unroll
                for (int n = 0; n < 2; ++n) acc[a][b][m][n] = (f32x4){0.f, 0.f, 0.f, 0.f};
    bf16x8 At[4][2], B0[2][2], B1[2][2];
    const char* cA = (const char*)g.A + (size_t)cur.pm * tstep; const char* cB = (const char*)g.Bt + (size_t)cur.pn * tstep;
    S.a_ready(cur);
    PG8_STAGE(PG8_SB(0, 0), cB, voffB); PG8_STAGE(PG8_SA(0, 0), cA, voffA); PG8_STAGE(PG8_SB(0, 1), cB + hstep, voffB); PG8_STAGE(PG8_SA(0, 1), cA + hstep, voffA);
    if (wr == 1) PG8_BAR;
    PG8_WAIT_V(4); PG8_BAR;
    PG8_STAGE(PG8_SB(1, 0), cB + kstep, voffB); PG8_STAGE(PG8_SA(1, 0), cA + kstep, voffA); PG8_STAGE(PG8_SB(1, 1), cB + hstep + kstep, voffB);
    PG8_WAIT_V(6); PG8_BAR;
    PG8_STAMP();
    for (;;) {
        const bool has_next = S.next(ui + 1, nxt);
        const char* nA = has_next ? (const char*)g.A + (size_t)nxt.pm * tstep : cA; const char* nB = has_next ? (const char*)g.Bt + (size_t)nxt.pn * tstep : cB;
        for (int t = 0; t < nt; t += 2) {
            const bool last = (t == nt - 2);
            const char* a1 = cA + (size_t)(t + 1) * kstep;
            const char* a2 = last ? nA : cA + (size_t)(t + 2) * kstep; const char* b2 = last ? nB : cB + (size_t)(t + 2) * kstep;
            const char* a3 = a2 + kstep; const char* b3 = b2 + kstep;
            if (last && has_next) S.a_ready(nxt);
            PG8_LDB(B0, 0, 0); PG8_SCHED; PG8_LDA(At, 0, 0); PG8_STAGE(PG8_SA(1, 1), a1 + hstep, voffA);
            PG8_WAIT_L(8); PG8_BAR; PG8_WAIT_L(0); PG8_MMA(0, 0, At, B0); PG8_BAR; PG8_SCHED;
            PG8_LDB(B1, 0, 1); PG8_STAGE(PG8_SB(0, 0), b2, voffB);
            PG8_BAR; PG8_WAIT_L(0); PG8_MMA(0, 1, At, B1); PG8_BAR;
            PG8_LDA(At, 0, 1); PG8_STAGE(PG8_SA(0, 0), a2, voffA);
            PG8_BAR; PG8_WAIT_L(0); PG8_MMA(1, 0, At, B0); PG8_BAR; PG8_SCHED;
            PG8_STAGE(PG8_SB(0, 1), b2 + hstep, voffB);
            PG8_WAIT_V(6); PG8_BAR; PG8_MMA(1, 1, At, B1); PG8_BAR;
            PG8_LDB(B0, 1, 0); PG8_SCHED; PG8_LDA(At, 1, 0); PG8_STAGE(PG8_SA(0, 1), a2 + hstep, voffA);
            PG8_WAIT_L(8); PG8_BAR; PG8_WAIT_L(0); PG8_MMA(0, 0, At, B0); PG8_BAR; PG8_SCHED;
            PG8_LDB(B1, 1, 1); PG8_STAGE(PG8_SB(1, 0), b3, voffB);
            PG8_BAR; PG8_WAIT_L(0); PG8_MMA(0, 1, At, B1); PG8_BAR;
            PG8_LDA(At, 1, 1); PG8_STAGE(PG8_SA(1, 0), a3, voffA);
            PG8_BAR; PG8_WAIT_L(0); PG8_MMA(1, 0, At, B0); PG8_BAR; PG8_SCHED;
            PG8_STAGE(PG8_SB(1, 1), b3 + hstep, voffB);
            PG8_WAIT_V(6); PG8_BAR; PG8_MMA(1, 1, At, B1); PG8_BAR;
        }
        PG8_STAMP();
        if constexpr (!Epi::AFTER_DRAIN) { E(acc, cur, wr, wc, fr, fq); S.done(cur); }
        PG8_STAMP();
        if (!has_next) break;
#pragma unroll
        for (int a = 0; a < 2; ++a)
#pragma unroll
            for (int b = 0; b < 2; ++b)
#pragma unroll
                for (int m = 0; m < 4; ++m)
#pragma unroll
                    for (int n = 0; n < 2; ++n) acc[a][b][m][n] = (f32x4){0.f, 0.f, 0.f, 0.f};
        cur = nxt; cA = nA; cB = nB; ++ui;
    }
    PG8_WAIT_V(0);
    if (wr == 0) PG8_BAR;
    PG8_BAR;
    if constexpr (Epi::AFTER_DRAIN) { E.fused(acc, cur, wr, wc, fr, fq, lds, wid, lane); S.done(cur); }
    PG8_STAMP();
    if (STAMP && wid == 0) { stamps[lane] = lane < nts ? (((unsigned long long)(unsigned)ts_hi << 32) | (unsigned)ts_lo) : 0ull;
        if (lane == 62) stamps[62] = rt_entry; if (lane == 63) stamps[63] = (unsigned long long)wall_clock64(); }
#undef PG8_STAMP
#undef PG8_SA
#undef PG8_SB
#undef PG8_STAGE
#undef PG8_LDA
#undef PG8_LDB
#undef PG8_MMA
#undef PG8_WAIT_V
#undef PG8_WAIT_L
#undef PG8_BAR
#undef PG8_SCHED
}
}

namespace mk {
using pg8::bf16_t; using pg8::bf16x8; using pg8::f32x4; using pg8::u32x4; using pg8::Unit; using pg8::cvt_pk_bf16; using pg8::cvt_pk_native; using pg8::mfma_settle;
typedef unsigned u32x2 __attribute__((ext_vector_type(2)));
typedef float f32x2 __attribute__((ext_vector_type(2)));
constexpr int D = 2048, TL = 16384, TC = 256, MT = TL + TC, NCH = MT / 128;
constexpr int NPROJ = 10496, DFF = 5632;
constexpr size_t MiB = 1u << 20;
constexpr size_t WS_MVEC = 0, WS_CHD = 256 * 1024, WS_BAR = 512 * 1024, WS_S5LOC = 1 * MiB, WS_WA = 10 * MiB, WS_WB = 75 * MiB, WS_HCTX = 141 * MiB, WS_XM = 143 * MiB, WS_SST = 208 * MiB, WS_BIG = 338 * MiB, WS_S5IN = 766 * MiB, WS_END = 775 * MiB;
constexpr size_t B_U5 = 0, B_XBC = B_U5 + (size_t)MT * 1024 * 2, B_Z = B_XBC + (size_t)MT * 3072 * 2, B_GATE = B_Z + (size_t)MT * 2048 * 2, B_DT = B_GATE + (size_t)MT * 4096 * 2,
                 B_Y5 = 330 * MiB, B_YD = B_Y5 + (size_t)MT * 1024 * 2;
static_assert(B_DT + (size_t)MT * 64 * 4 <= B_Y5 && B_YD + (size_t)MT * 2048 * 2 <= 428 * MiB, "big map");
constexpr size_t B_G = 0, B_V = (size_t)MT * DFF * 2;
constexpr size_t WA_IN = 0, WA_GLU = 41 * MiB, WA_S5P = 45 * MiB, WA_SSDP = 49 * MiB, WA_WOUT = 57 * MiB, WB_UP = 0, WB_DOWN = 44 * MiB;
constexpr int LDS_BYTES = 163840;
constexpr float ALPHA = 1.41421356237f, LN_EPS = 1e-5f, RMS_EPS = 1e-5f;

struct Args { const float* in[33]; float* out; unsigned char* ws; int ph_lo, ph_hi; };

__device__ __forceinline__ float bf2f(unsigned b) { return __uint_as_float(b << 16); }
__device__ __forceinline__ float bflo(unsigned w) { return __uint_as_float(w << 16); }
__device__ __forceinline__ float bfhi(unsigned w) { return __uint_as_float(w & 0xffff0000u); }
__device__ __forceinline__ float sigm(float x) { return __builtin_amdgcn_rcpf(1.f + __expf(-x)); }
__device__ __forceinline__ float silu_(float x) { return x * __builtin_amdgcn_rcpf(1.f + __expf(-x)); }
__device__ __forceinline__ float gelu_tanh(float x) { const float u = 0.7978845608028654f * (x + 0.044715f * x * x * x); const float th = 1.f - 2.f * __builtin_amdgcn_rcpf(__expf(2.f * u) + 1.f); return 0.5f * x * (1.f + th); }
__device__ __forceinline__ bf16x8 mkfrag(unsigned a, unsigned b, unsigned c, unsigned d) { u32x4 v; v.x = a; v.y = b; v.z = c; v.w = d; return __builtin_bit_cast(bf16x8, v); }
__device__ __forceinline__ float* hrow(const Args& a, int row) { return row < TL ? a.out + (size_t)row * D : (float*)(a.ws + WS_HCTX) + (size_t)(row - TL) * D; }
__device__ __forceinline__ const float* mvec(const Args& a, int layer, int isctx) { return (const float*)(a.ws + WS_MVEC) + (size_t)(layer * 2 + isctx) * 12288; }

struct EpiInProj {
    static constexpr bool PERM = true, AFTER_DRAIN = false;
    unsigned char* big; const float* dt_bias;
    __device__ __forceinline__ void operator()(const f32x4 (&acc)[2][2][4][2], const Unit& u, int wr, int wc, int fr, int fq) const {
        mfma_settle(acc[1][1][3][1]); mfma_settle(acc[1][1][3][0]);
        const int row0 = u.pm * 256 + wr * 64 + fr, ct = u.pn * 256;
        if (ct >= 10240) {
            if (wc < 2) { const int cc = wc * 32 + 8 * fq; float* DT = (float*)(big + B_DT);
                const f32x4 b0 = *(const f32x4*)(dt_bias + cc), b1 = *(const f32x4*)(dt_bias + cc + 4);
#pragma unroll
                for (int ai = 0; ai < 2; ++ai)
#pragma unroll
                    for (int m = 0; m < 4; ++m) { float* rp = DT + (size_t)(row0 + ai * 128 + m * 16) * 64 + cc; f32x4 v0 = acc[ai][0][m][0] + b0, v1 = acc[ai][0][m][1] + b1;
#pragma unroll
                        for (int j = 0; j < 4; ++j) { v0[j] = v0[j] > 20.f ? v0[j] : log1pf(expf(v0[j])); v1[j] = v1[j] > 20.f ? v1[j] : log1pf(expf(v1[j])); }
                        *(f32x4*)rp = v0; *(f32x4*)(rp + 4) = v1; } }
            return;
        }
        bf16_t* base; int ld, c0; bool sg = false;
        if (ct < 1024) { base = (bf16_t*)(big + B_U5); ld = 1024; c0 = ct; }
        else if (ct < 4096) { base = (bf16_t*)(big + B_XBC); ld = 3072; c0 = ct - 1024; }
        else if (ct < 6144) { base = (bf16_t*)(big + B_Z); ld = 2048; c0 = ct - 4096; }
        else { base = (bf16_t*)(big + B_GATE); ld = 4096; c0 = ct - 6144; sg = true; }
        const int col0 = c0 + wc * 32 + 8 * fq;
#pragma unroll
        for (int ai = 0; ai < 2; ++ai)
#pragma unroll
            for (int m = 0; m < 4; ++m) { bf16_t* rowp = base + (size_t)(row0 + ai * 128 + m * 16) * ld + col0;
#pragma unroll
                for (int bj = 0; bj < 2; ++bj) { f32x4 v0 = acc[ai][bj][m][0], v1 = acc[ai][bj][m][1];
                    if (sg) {
#pragma unroll
                        for (int j = 0; j < 4; ++j) { v0[j] = sigm(v0[j]); v1[j] = sigm(v1[j]); } }
                    u32x4 w; w.x = cvt_pk_native(v0[0], v0[1]); w.y = cvt_pk_native(v0[2], v0[3]); w.z = cvt_pk_native(v1[0], v1[1]); w.w = cvt_pk_native(v1[2], v1[3]);
                    *(u32x4*)(rowp + bj * 128) = w; } }
    }
};
struct EpiGlu {
    static constexpr bool PERM = true, AFTER_DRAIN = false;
    bf16_t* O;
    __device__ __forceinline__ void operator()(const f32x4 (&acc)[2][2][4][2], const Unit& u, int wr, int wc, int fr, int fq) const {
        mfma_settle(acc[1][1][3][1]); mfma_settle(acc[1][1][3][0]);
        const int row0 = u.pm * 256 + wr * 64 + fr, col0 = u.pn * 128 + wc * 32 + 8 * fq;
#pragma unroll
        for (int ai = 0; ai < 2; ++ai)
#pragma unroll
            for (int m = 0; m < 4; ++m) { f32x4 v0 = acc[ai][0][m][0], v1 = acc[ai][0][m][1]; const f32x4 g0 = acc[ai][1][m][0], g1 = acc[ai][1][m][1];
#pragma unroll
                for (int j = 0; j < 4; ++j) { v0[j] *= sigm(g0[j]); v1[j] *= sigm(g1[j]); }
                u32x4 w; w.x = cvt_pk_bf16(v0[0], v0[1]); w.y = cvt_pk_bf16(v0[2], v0[3]); w.z = cvt_pk_bf16(v1[0], v1[1]); w.w = cvt_pk_bf16(v1[2], v1[3]);
                *(u32x4*)(O + (size_t)(row0 + ai * 128 + m * 16) * 1024 + col0) = w; }
    }
};
template <int SECOND, int GSEL = SECOND> struct EpiMerge {
    static constexpr bool PERM = true, AFTER_DRAIN = false;
    bf16_t* MG; const bf16_t* GATE;
    __device__ __forceinline__ void operator()(const f32x4 (&acc)[2][2][4][2], const Unit& u, int wr, int wc, int fr, int fq) const {
        mfma_settle(acc[1][1][3][1]); mfma_settle(acc[1][1][3][0]);
        const int row0 = u.pm * 256 + wr * 64 + fr, col0 = u.pn * 256 + wc * 32 + 8 * fq;
#pragma unroll
        for (int ai = 0; ai < 2; ++ai)
#pragma unroll
            for (int m = 0; m < 4; ++m) { const size_t r = (size_t)(row0 + ai * 128 + m * 16);
#pragma unroll
                for (int bj = 0; bj < 2; ++bj) { const int c = col0 + bj * 128; const u32x4 g = *(const u32x4*)(GATE + r * 4096 + (GSEL ? 2048 : 0) + c);
                    f32x4 v0 = acc[ai][bj][m][0], v1 = acc[ai][bj][m][1];
                    v0[0] *= bflo(g.x); v0[1] *= bfhi(g.x); v0[2] *= bflo(g.y); v0[3] *= bfhi(g.y); v1[0] *= bflo(g.z); v1[1] *= bfhi(g.z); v1[2] *= bflo(g.w); v1[3] *= bfhi(g.w);
                    if (SECOND) { const u32x4 o = *(const u32x4*)(MG + r * 2048 + c);
                        v0[0] += bflo(o.x); v0[1] += bfhi(o.x); v0[2] += bflo(o.y); v0[3] += bfhi(o.y); v1[0] += bflo(o.z); v1[1] += bfhi(o.z); v1[2] += bflo(o.w); v1[3] += bfhi(o.w); }
                    u32x4 w; w.x = cvt_pk_bf16(v0[0], v0[1]); w.y = cvt_pk_bf16(v0[2], v0[3]); w.z = cvt_pk_bf16(v1[0], v1[1]); w.w = cvt_pk_bf16(v1[2], v1[3]);
                    *(u32x4*)(MG + r * 2048 + c) = w; } }
    }
};
struct EpiResid {
    static constexpr bool PERM = false, AFTER_DRAIN = false;
    float* out; float* hctx; const float* glat; const float* gctx;
    __device__ __forceinline__ void operator()(const f32x4 (&acc)[2][2][4][2], const Unit& u, int wr, int wc, int fr, int fq) const {
        mfma_settle(acc[1][1][3][1]); mfma_settle(acc[1][1][3][0]);
        const bool isctx = u.pm >= 64; const float* g = isctx ? gctx : glat;
        float* hb = isctx ? hctx + (size_t)(wr * 64 + fr) * D : out + (size_t)(u.pm * 256 + wr * 64 + fr) * D;
        const int col0 = u.pn * 256 + wc * 32 + 4 * fq;
        f32x4 gv[2][2];
#pragma unroll
        for (int bj = 0; bj < 2; ++bj)
#pragma unroll
            for (int n = 0; n < 2; ++n) gv[bj][n] = *(const f32x4*)(g + col0 + bj * 128 + n * 16);
#pragma unroll
        for (int ai = 0; ai < 2; ++ai)
#pragma unroll
            for (int m = 0; m < 4; ++m) { float* rowp = hb + (size_t)(ai * 128 + m * 16) * D + col0;
#pragma unroll
                for (int bj = 0; bj < 2; ++bj)
#pragma unroll
                    for (int n = 0; n < 2; ++n) { float* p = rowp + bj * 128 + n * 16; const f32x4 h = *(const f32x4*)p; *(f32x4*)p = h * ALPHA + gv[bj][n] * acc[ai][bj][m][n]; } }
    }
};
struct EpiUp {
    static constexpr bool PERM = true, AFTER_DRAIN = false;
    bf16_t* G; bf16_t* V;
    __device__ __forceinline__ void operator()(const f32x4 (&acc)[2][2][4][2], const Unit& u, int wr, int wc, int fr, int fq) const {
        mfma_settle(acc[1][1][3][1]); mfma_settle(acc[1][1][3][0]);
        const int row0 = u.pm * 256 + wr * 64 + fr; int ct = u.pn * 256; bf16_t* base = G; if (ct >= DFF) { base = V; ct -= DFF; }
        const int col0 = ct + wc * 32 + 8 * fq;
#pragma unroll
        for (int ai = 0; ai < 2; ++ai)
#pragma unroll
            for (int m = 0; m < 4; ++m) { bf16_t* rowp = base + (size_t)(row0 + ai * 128 + m * 16) * DFF + col0;
#pragma unroll
                for (int bj = 0; bj < 2; ++bj) { const f32x4 v0 = acc[ai][bj][m][0], v1 = acc[ai][bj][m][1];
                    u32x4 w; w.x = cvt_pk_native(v0[0], v0[1]); w.y = cvt_pk_native(v0[2], v0[3]); w.z = cvt_pk_native(v1[0], v1[1]); w.w = cvt_pk_native(v1[2], v1[3]);
                    *(u32x4*)(rowp + bj * 128) = w; } }
    }
};

struct XItem { const float* W; bf16_t* WT; int K, N, d0, s0, k0; };
__device__ __forceinline__ void xpose_load(const XItem& x, float (&v)[32], int lane) {
#pragma unroll
    for (int i = 0; i < 32; ++i) { const int kk = 2 * i + (lane >> 5); v[i] = x.s0 >= 0 ? x.W[(size_t)(x.k0 + kk) * x.N + x.s0 + (lane & 31)] : 0.f; }
}
__device__ __forceinline__ void xpose_store(const XItem& x, const float (&v)[32], float* scr, int lane) {
#pragma unroll
    for (int i = 0; i < 32; ++i) { const int kk = 2 * i + (lane >> 5); scr[kk * 33 + (lane & 31)] = v[i]; }
    asm volatile("s_waitcnt lgkmcnt(0)" ::: "memory");
    const int c = lane & 7;
#pragma unroll
    for (int j = 0; j < 4; ++j) { const int n = (lane >> 3) + 8 * j; const float* sp = scr + (8 * c) * 33 + n;
        u32x4 o; o.x = cvt_pk_bf16(sp[0 * 33], sp[1 * 33]); o.y = cvt_pk_bf16(sp[2 * 33], sp[3 * 33]); o.z = cvt_pk_bf16(sp[4 * 33], sp[5 * 33]); o.w = cvt_pk_bf16(sp[6 * 33], sp[7 * 33]);
        *(u32x4*)(x.WT + (size_t)(x.d0 + n) * x.K + x.k0 + 8 * c) = o; }
    asm volatile("s_waitcnt lgkmcnt(0)" ::: "memory");
}
__device__ __forceinline__ XItem xpose_decode(const Args& a, int layer, int region, int r) {
    XItem x;
    if (region == 0) {
        bf16_t* WA = (bf16_t*)(a.ws + WS_WA);
        constexpr int I_IN = 32 * 328, I_GLU = 16 * 64, I_S5P = 16 * 64, I_SSDP = 32 * 64;
        if (r < I_IN) { const int kb = r / 328, d0 = (r % 328) * 32; int s0; if (d0 < 4096) s0 = d0; else if (d0 < 10240) s0 = d0 + 64; else if (d0 < 10304) s0 = d0 - 10240 + 4096; else s0 = -1;
            x.W = a.in[6] + (size_t)layer * 2048 * 10304; x.WT = WA + WA_IN / 2; x.K = 2048; x.N = 10304; x.d0 = d0; x.s0 = s0; x.k0 = kb * 64; return x; } r -= I_IN;
        if (r < I_GLU) { const int kb = r / 64, d0 = (r % 64) * 32, t = d0 >> 8, j = d0 & 255;
            x.W = a.in[15] + (size_t)layer * 1024 * 2048; x.WT = WA + WA_GLU / 2; x.K = 1024; x.N = 2048; x.d0 = d0; x.s0 = j < 128 ? t * 128 + j : 1024 + t * 128 + (j - 128); x.k0 = kb * 64; return x; } r -= I_GLU;
        if (r < I_S5P) { x.W = a.in[16] + (size_t)layer * 1024 * 2048; x.WT = WA + WA_S5P / 2; x.K = 1024; x.N = 2048; x.d0 = (r % 64) * 32; x.s0 = x.d0; x.k0 = (r / 64) * 64; return x; } r -= I_S5P;
        if (r < I_SSDP) { x.W = a.in[23] + (size_t)layer * 2048 * 2048; x.WT = WA + WA_SSDP / 2; x.K = 2048; x.N = 2048; x.d0 = (r % 64) * 32; x.s0 = x.d0; x.k0 = (r / 64) * 64; return x; } r -= I_SSDP;
        x.W = a.in[24] + (size_t)layer * 2048 * 2048; x.WT = WA + WA_WOUT / 2; x.K = 2048; x.N = 2048; x.d0 = (r % 64) * 32; x.s0 = x.d0; x.k0 = (r / 64) * 64; return x;
    }
    bf16_t* WB = (bf16_t*)(a.ws + WS_WB); constexpr int I_UP = 32 * 352;
    if (r < I_UP) { x.W = a.in[27] + (size_t)layer * 2048 * 11264; x.WT = WB + WB_UP / 2; x.K = 2048; x.N = 11264; x.d0 = (r % 352) * 32; x.s0 = x.d0; x.k0 = (r / 352) * 64; return x; } r -= I_UP;
    x.W = a.in[30] + (size_t)layer * 5632 * 2048; x.WT = WB + WB_DOWN / 2; x.K = 5632; x.N = 2048; x.d0 = (r % 64) * 32; x.s0 = x.d0; x.k0 = (r / 64) * 64; return x;
}
__device__ __forceinline__ void xpose_region(const Args& a, int layer, int region, float* scr, int gw, int NGW, int lane) {
    const int NI = region == 0 ? (32 * 328 + 16 * 64 + 16 * 64 + 32 * 64 + 32 * 64) : (32 * 352 + 88 * 64);
    for (int it = gw; it < NI; it += 2 * NGW) {
        const XItem x0 = xpose_decode(a, layer, region, it); float v0[32]; xpose_load(x0, v0, lane);
        const bool two = it + NGW < NI;
        if (two) { const XItem x1 = xpose_decode(a, layer, region, it + NGW); float v1[32]; xpose_load(x1, v1, lane);
            xpose_store(x0, v0, scr, lane); xpose_store(x1, v1, scr, lane); }
        else xpose_store(x0, v0, scr, lane);
    }
}

__device__ __forceinline__ void adaln_phase(const Args& a, float* lds, int tid) {
    float* sc = lds; float* scx = lds + 2048; float* red = lds + 4096;
    for (int i = tid; i < 2048; i += 512) { sc[i] = silu_(a.in[1][i]); scx[i] = silu_(a.in[3][i]); }
    __syncthreads();
    for (int unit = blockIdx.x; unit < 256; unit += gridDim.x) {
        const int layer = unit >> 7, col0 = (unit & 127) * 96;
        const float* W = a.in[4] + (size_t)layer * 2048 * 12288 + col0;
        if (tid < 504) { const int cq = tid % 24, ks = tid / 24; f32x4 al = {0.f, 0.f, 0.f, 0.f}, ac = {0.f, 0.f, 0.f, 0.f};
#pragma unroll 7
            for (int k = ks; k < 2048; k += 21) { const f32x4 w = *(const f32x4*)(W + (size_t)k * 12288 + cq * 4); al += w * sc[k]; ac += w * scx[k]; }
            *(f32x4*)(red + (ks * 2 + 0) * 96 + cq * 4) = al; *(f32x4*)(red + (ks * 2 + 1) * 96 + cq * 4) = ac; }
        __syncthreads();
        if (tid < 192) { const int v = tid / 96, c = tid % 96; float s = 0.f; for (int ks = 0; ks < 21; ++ks) s += red[(ks * 2 + v) * 96 + c];
            ((float*)(a.ws + WS_MVEC))[(size_t)(layer * 2 + v) * 12288 + col0 + c] = s + a.in[5][(size_t)layer * 12288 + col0 + c]; }
        __syncthreads();
    }
}

__device__ __forceinline__ float wave_sum(float v) {
#pragma unroll
    for (int o = 1; o < 64; o <<= 1) v += __shfl_xor(v, o);
    return v;
}
template <int MODE> __device__ __forceinline__ void row_phase(const Args& a, int nrows, const float* lng, const float* lnb, int mod_layer, int mod_off, int gw, int NGW, int lane) {
    bf16_t* XM = (bf16_t*)(a.ws + WS_XM);
    for (int row = gw; row < nrows; row += NGW) {
        const int isctx = row >= TL; float* h = hrow(a, row);
        const float* src = MODE == 0 ? (isctx ? a.in[2] + (size_t)(row - TL) * D : a.in[0] + (size_t)row * D) : h;
        f32x4 v[8];
#pragma unroll
        for (int j = 0; j < 8; ++j) v[j] = *(const f32x4*)(src + 4 * lane + 256 * j);
        if (MODE == 1) {
            float s = 0.f;
#pragma unroll
            for (int j = 0; j < 8; ++j) s += (v[j][0] + v[j][1]) + (v[j][2] + v[j][3]);
            const float mean = wave_sum(s) * (1.f / D); float q = 0.f;
#pragma unroll
            for (int j = 0; j < 8; ++j) { v[j] = v[j] - mean; q += (v[j][0] * v[j][0] + v[j][1] * v[j][1]) + (v[j][2] * v[j][2] + v[j][3] * v[j][3]); }
            const float rstd = __builtin_amdgcn_rsqf(wave_sum(q) * (1.f / D) + LN_EPS);
#pragma unroll
            for (int j = 0; j < 8; ++j) { const f32x4 g = *(const f32x4*)(lng + 4 * lane + 256 * j), b = *(const f32x4*)(lnb + 4 * lane + 256 * j); v[j] = v[j] * rstd * g + b; }
        }
#ifdef MK_SANITIZE
#pragma unroll
        for (int j = 0; j < 8; ++j)
#pragma unroll
            for (int e = 0; e < 4; ++e) if (!(fabsf(v[j][e]) < 1e30f)) v[j][e] = 0.f;
#endif
#pragma unroll
        for (int j = 0; j < 8; ++j) *(f32x4*)(h + 4 * lane + 256 * j) = v[j];
        if (mod_layer >= 0) { const float* m = mvec(a, mod_layer, isctx) + mod_off;
#pragma unroll
            for (int j = 0; j < 8; ++j) { const f32x4 sh = *(const f32x4*)(m + 4 * lane + 256 * j), scl = *(const f32x4*)(m + D + 4 * lane + 256 * j); const f32x4 o = v[j] * (scl + 1.f) + sh;
                u32x2 w; w.x = cvt_pk_bf16(o[0], o[1]); w.y = cvt_pk_bf16(o[2], o[3]); *(u32x2*)(XM + (size_t)row * D + 4 * lane + 256 * j) = w; } }
    }
}

__device__ __forceinline__ void ffnconv_ctx(const Args& a, int layer, int tid) {
    const bf16_t* G = (const bf16_t*)(a.ws + WS_BIG + B_G); bf16_t* V = (bf16_t*)(a.ws + WS_BIG + B_V);
    const float* cw = a.in[28] + (size_t)layer * 9 * DFF; const float* cb = a.in[29] + (size_t)layer * DFF;
    const int nunits = 260 * 11; const int oc = tid & 63, xs = tid >> 6;
    for (int unit = 256 * 11 + blockIdx.x; unit < nunits; unit += gridDim.x) {
        const int seg = unit / 11, ob = unit % 11, ch0 = ob * 512 + oc * 8; const bool cs = seg >= 256; const int t0 = seg * 64;
        float w[9][8], bias[8];
#pragma unroll
        for (int k = 0; k < 9; ++k) { const f32x4 w0 = *(const f32x4*)(cw + (size_t)k * DFF + ch0), w1 = *(const f32x4*)(cw + (size_t)k * DFF + ch0 + 4);
            w[k][0] = w0[0]; w[k][1] = w0[1]; w[k][2] = w0[2]; w[k][3] = w0[3]; w[k][4] = w1[0]; w[k][5] = w1[1]; w[k][6] = w1[2]; w[k][7] = w1[3]; }
        { const f32x4 b0 = *(const f32x4*)(cb + ch0), b1 = *(const f32x4*)(cb + ch0 + 4); bias[0] = b0[0]; bias[1] = b0[1]; bias[2] = b0[2]; bias[3] = b0[3]; bias[4] = b1[0]; bias[5] = b1[1]; bias[6] = b1[2]; bias[7] = b1[3]; }
#pragma unroll 4
        for (int xi = 0; xi < 8; ++xi) { const int x = xs * 8 + xi, t = t0 + x; float acc[8];
#pragma unroll
            for (int k = 0; k < 8; ++k) acc[k] = bias[k];
#pragma unroll
            for (int dy = -1; dy <= 1; ++dy) { bool rok = cs ? (dy == 0) : ((dy < 0 ? seg > 0 : true) && (dy > 0 ? seg < 255 : true));
#pragma unroll
                for (int dx = -1; dx <= 1; ++dx) { const bool ok = rok && (cs ? (t + dx >= TL && t + dx < MT) : (x + dx >= 0 && x + dx < 64));
                    if (ok) { const u32x4 g = *(const u32x4*)(G + (size_t)(t + dy * 64 + dx) * DFF + ch0); const int k = (dy + 1) * 3 + dx + 1;
                        acc[0] += w[k][0] * bflo(g.x); acc[1] += w[k][1] * bfhi(g.x); acc[2] += w[k][2] * bflo(g.y); acc[3] += w[k][3] * bfhi(g.y);
                        acc[4] += w[k][4] * bflo(g.z); acc[5] += w[k][5] * bfhi(g.z); acc[6] += w[k][6] * bflo(g.w); acc[7] += w[k][7] * bfhi(g.w); } } }
            bf16_t* vp = V + (size_t)t * DFF + ch0; const u32x4 vv = *(const u32x4*)vp;
            u32x4 o; o.x = cvt_pk_bf16(silu_(acc[0]) * bflo(vv.x), silu_(acc[1]) * bfhi(vv.x)); o.y = cvt_pk_bf16(silu_(acc[2]) * bflo(vv.y), silu_(acc[3]) * bfhi(vv.y));
            o.z = cvt_pk_bf16(silu_(acc[4]) * bflo(vv.z), silu_(acc[5]) * bfhi(vv.z)); o.w = cvt_pk_bf16(silu_(acc[6]) * bflo(vv.w), silu_(acc[7]) * bfhi(vv.w));
            *(u32x4*)vp = o; }
    }
}

__device__ __forceinline__ void ffnconv_phase(const Args& a, int layer, bool with_ctx, unsigned char* lds, int tid) {
    const bf16_t* G = (const bf16_t*)(a.ws + WS_BIG + B_G); bf16_t* V = (bf16_t*)(a.ws + WS_BIG + B_V);
    const float* cw = a.in[28] + (size_t)layer * 9 * DFF; const float* cb = a.in[29] + (size_t)layer * DFF;
    bf16_t* T = (bf16_t*)lds;
    const int oc = tid & 15, ts = tid >> 4;
    u32x4 gn[12];
#define FFC_PREFETCH(unit_) do { const int rg_ = (unit_) / 44, ch_ = ((unit_) % 44) * 128 + oc * 8, y0_ = rg_ * 4; \
        _Pragma("unroll") for (int i = 0; i < 12; ++i) { const int idx = tid + i * 512, r = idx >> 10, x = (idx >> 4) & 63, y = y0_ - 1 + r; const bool ok = y >= 0 && y < 256; \
            u32x4 v = *(const u32x4*)(G + (size_t)((ok ? y : y0_) * 64 + x) * DFF + ch_); if (!ok) v = (u32x4){0u, 0u, 0u, 0u}; gn[i] = v; } } while (0)
    int unit = blockIdx.x;
    if (unit < 64 * 44) FFC_PREFETCH(unit);
    for (; unit < 64 * 44; unit += gridDim.x) {
        const int rg = unit / 44, ch0 = (unit % 44) * 128 + oc * 8, y0 = rg * 4;
        __syncthreads();
#pragma unroll
        for (int i = 0; i < 12; ++i) { const int idx = tid + i * 512, r = idx >> 10, x = (idx >> 4) & 63; *(u32x4*)(T + ((r * 64 + x) * 128 + oc * 8)) = gn[i]; }
        u32x4 vv[8];
#pragma unroll
        for (int o = 0; o < 8; ++o) vv[o] = *(const u32x4*)(V + (size_t)((y0 + (o >> 1)) * 64 + ts * 2 + (o & 1)) * DFF + ch0);
        float w[9][8], bias[8];
#pragma unroll
        for (int k = 0; k < 9; ++k) { const f32x4 w0 = *(const f32x4*)(cw + (size_t)k * DFF + ch0), w1 = *(const f32x4*)(cw + (size_t)k * DFF + ch0 + 4);
            w[k][0] = w0[0]; w[k][1] = w0[1]; w[k][2] = w0[2]; w[k][3] = w0[3]; w[k][4] = w1[0]; w[k][5] = w1[1]; w[k][6] = w1[2]; w[k][7] = w1[3]; }
        { const f32x4 b0 = *(const f32x4*)(cb + ch0), b1 = *(const f32x4*)(cb + ch0 + 4); bias[0] = b0[0]; bias[1] = b0[1]; bias[2] = b0[2]; bias[3] = b0[3]; bias[4] = b1[0]; bias[5] = b1[1]; bias[6] = b1[2]; bias[7] = b1[3]; }
        __syncthreads();
        if (unit + (int)gridDim.x < 64 * 44) FFC_PREFETCH(unit + (int)gridDim.x);
#pragma unroll
        for (int o = 0; o < 8; ++o) { const int rr = o >> 1, x = ts * 2 + (o & 1); float acc[8];
#pragma unroll
            for (int k = 0; k < 8; ++k) acc[k] = bias[k];
#pragma unroll
            for (int dy = -1; dy <= 1; ++dy)
#pragma unroll
                for (int dx = -1; dx <= 1; ++dx) { const int xn = x + dx; const bool ok = xn >= 0 && xn < 64;
                    u32x4 g = *(const u32x4*)(T + (((rr + 1 + dy) * 64 + (ok ? xn : x)) * 128 + oc * 8)); if (!ok) g = (u32x4){0u, 0u, 0u, 0u}; const int k = (dy + 1) * 3 + dx + 1;
                    acc[0] += w[k][0] * bflo(g.x); acc[1] += w[k][1] * bfhi(g.x); acc[2] += w[k][2] * bflo(g.y); acc[3] += w[k][3] * bfhi(g.y);
                    acc[4] += w[k][4] * bflo(g.z); acc[5] += w[k][5] * bfhi(g.z); acc[6] += w[k][6] * bflo(g.w); acc[7] += w[k][7] * bfhi(g.w); }
            const u32x4 v = vv[o];
            u32x4 q; q.x = cvt_pk_bf16(silu_(acc[0]) * bflo(v.x), silu_(acc[1]) * bfhi(v.x)); q.y = cvt_pk_bf16(silu_(acc[2]) * bflo(v.y), silu_(acc[3]) * bfhi(v.y));
            q.z = cvt_pk_bf16(silu_(acc[4]) * bflo(v.z), silu_(acc[5]) * bfhi(v.z)); q.w = cvt_pk_bf16(silu_(acc[6]) * bflo(v.w), silu_(acc[7]) * bfhi(v.w));
            *(u32x4*)(V + (size_t)((y0 + rr) * 64 + x) * DFF + ch0) = q; }
    }
#undef FFC_PREFETCH
    __syncthreads();
    if (with_ctx) ffnconv_ctx(a, layer, tid);
}
__device__ __forceinline__ int s5_chunk_at(int dir, int q) { return dir ? 129 - q : (q + 128) % 130; }
__device__ __forceinline__ int s5_pos_of(int dir, int c) { return dir ? 129 - c : (c + 2) % 130; }
template <int PASS> __device__ __forceinline__ void s5_phase(const Args& a, int layer, unsigned char* lds, int tid, int nchunks) {
    constexpr int BUP = 132;
    const bf16_t* U5 = (const bf16_t*)(a.ws + WS_BIG + B_U5); bf16_t* Y5 = (bf16_t*)(a.ws + WS_BIG + B_Y5);
    float2* S5LOC = (float2*)(a.ws + WS_S5LOC);
    const int lane = tid & 63, w = tid >> 6, gl = w >> 1, dir = w & 1, p = lane, fr = lane & 15, fq = lane >> 4;
    float* BuW = (float*)lds + (size_t)w * (16 * BUP);
    bf16_t* STw = (bf16_t*)(lds + 67584) + (size_t)w * (16 * 136);
    float* YL = (float*)(lds + 102400);
    const int gq = blockIdx.x & 15, g = gq * 4 + gl;
    float ab_re, ab_im, a128r, a128i;
    const float step = expf(a.in[9][(size_t)(layer * 2 + dir) * 64 + g]);
    { const size_t pi = ((size_t)(layer * 2 + dir) * 64 + g) * 64 + p; const float lre = fminf(a.in[7][pi], -1e-4f), lim = a.in[8][pi];
      const float mag = expf(lre * step); float sn, cs; sincosf(lim * step, &sn, &cs); ab_re = mag * cs; ab_im = mag * sn; a128r = ab_re; a128i = ab_im;
#pragma unroll
      for (int k = 0; k < 7; ++k) { const float r = a128r * a128r - a128i * a128i, i = 2.f * a128r * a128i; a128r = r; a128i = i; } }
    bf16x8 bbf[8];
#pragma unroll
    for (int nt = 0; nt < 8; ++nt) { const int pp = nt * 8 + (fr >> 1), cc = fr & 1; const size_t pi = ((size_t)(layer * 2 + dir) * 64 + g) * 64 + pp;
        const float lre = fminf(a.in[7][pi], -1e-4f), lim = a.in[8][pi]; const float mag = expf(lre * step); float sn, cs; sincosf(lim * step, &sn, &cs);
        const float are = mag * cs, aim = mag * sn, den = lre * lre + lim * lim, q_re = ((are - 1.f) * lre + aim * lim) / den, q_im = (aim * lre - (are - 1.f) * lim) / den;
        const float* br = a.in[10] + (((size_t)layer * 64 + g) * 64 + pp) * 16 + (fq & 1) * 8; const float* bi = a.in[11] + (((size_t)layer * 64 + g) * 64 + pp) * 16 + (fq & 1) * 8;
        const f32x4 r0 = *(const f32x4*)br, r1 = *(const f32x4*)(br + 4), i0 = *(const f32x4*)bi, i1 = *(const f32x4*)(bi + 4); float v[8];
#pragma unroll
        for (int j = 0; j < 8; ++j) { const float r = j < 4 ? r0[j & 3] : r1[j & 3], i = j < 4 ? i0[j & 3] : i1[j & 3]; v[j] = fq < 2 ? (cc ? q_re * i + q_im * r : q_re * r - q_im * i) : 0.f; }
        bbf[nt] = mkfrag(cvt_pk_bf16(v[0], v[1]), cvt_pk_bf16(v[2], v[3]), cvt_pk_bf16(v[4], v[5]), cvt_pk_bf16(v[6], v[7])); }
    bf16x8 cm[4];
    if (PASS == 1) {
        const float* cre = a.in[12] + (((size_t)(layer * 2 + dir) * 64 + g) * 16 + fr) * 64; const float* cim = a.in[13] + (((size_t)(layer * 2 + dir) * 64 + g) * 16 + fr) * 64;
#pragma unroll
        for (int ks = 0; ks < 4; ++ks) { const f32x4 r = *(const f32x4*)(cre + ks * 16 + fq * 4), i = *(const f32x4*)(cim + ks * 16 + fq * 4);
            cm[ks] = mkfrag(cvt_pk_bf16(r[0], -i[0]), cvt_pk_bf16(r[1], -i[1]), cvt_pk_bf16(r[2], -i[2]), cvt_pk_bf16(r[3], -i[3])); }
    }
    const int cstep = gridDim.x >> 4;
    float2* S5IN = (float2*)(a.ws + WS_S5IN);
    if (PASS == 1) {
        float sr = 0.f, si = 0.f;
#pragma unroll 1
        for (int q0 = 0; q0 < NCH; q0 += 13) { float2 l[13];
#pragma unroll
            for (int i = 0; i < 13; ++i) l[i] = S5LOC[((size_t)(dir * NCH + s5_chunk_at(dir, q0 + i)) * 64 + g) * 64 + p];
#pragma unroll
            for (int i = 0; i < 13; ++i) { const int cc = s5_chunk_at(dir, q0 + i);
                if (cc < nchunks && (cc % cstep) == (int)(blockIdx.x >> 4)) S5IN[((size_t)(dir * NCH + cc) * 64 + g) * 64 + p] = make_float2(sr, si);
                const float nr = a128r * sr - a128i * si + l[i].x, ni = a128r * si + a128i * sr + l[i].y; sr = nr; si = ni; } }
    }
    for (int c = blockIdx.x >> 4; c < nchunks; c += cstep) {
        const int row0 = c * 128;
        bf16x8 uf[8];
#pragma unroll
        for (int k = 0; k < 8; ++k) { const int sl = dir ? 7 - k : k; const u32x4 v = *(const u32x4*)(U5 + (size_t)(row0 + sl * 16 + fr) * 1024 + g * 16 + (fq & 1) * 8);
            uf[k] = fq < 2 ? __builtin_bit_cast(bf16x8, v) : mkfrag(0u, 0u, 0u, 0u); }
        float sr = 0.f, si = 0.f;
        if (PASS == 1) { const float2 s0 = S5IN[((size_t)(dir * NCH + c) * 64 + g) * 64 + p]; sr = s0.x; si = s0.y; }
        f32x4 yacc[8];
#pragma unroll
        for (int k = 0; k < 8; ++k) {
#pragma unroll
            for (int nt = 0; nt < 8; ++nt) { f32x4 acc = {0.f, 0.f, 0.f, 0.f}; acc = __builtin_amdgcn_mfma_f32_16x16x32_bf16(uf[k], bbf[nt], acc, 0, 0, 0);
#pragma unroll
                for (int jj = 0; jj < 4; ++jj) BuW[(fq * 4 + jj) * BUP + nt * 16 + fr] = acc[jj]; }
            asm volatile("s_waitcnt lgkmcnt(0)" ::: "memory");
#pragma unroll
            for (int ii = 0; ii < 16; ++ii) { const int tl = dir ? 15 - ii : ii; const f32x2 b2 = *(const f32x2*)(BuW + tl * BUP + 2 * p);
                f32x2 ns = __builtin_elementwise_fma((f32x2){ab_re, ab_re}, (f32x2){sr, si}, b2); ns = __builtin_elementwise_fma((f32x2){-ab_im, ab_im}, (f32x2){si, sr}, ns); sr = ns[0]; si = ns[1];
                if (PASS == 1) *(unsigned*)(STw + tl * 136 + 2 * p) = cvt_pk_bf16(sr, si); }
            if (PASS == 1) {
                asm volatile("s_waitcnt lgkmcnt(0)" ::: "memory");
                f32x4 acc = {0.f, 0.f, 0.f, 0.f};
#pragma unroll
                for (int ks = 0; ks < 4; ++ks) acc = __builtin_amdgcn_mfma_f32_16x16x32_bf16(*(const bf16x8*)(STw + fr * 136 + ks * 32 + fq * 8), cm[ks], acc, 0, 0, 0);
                yacc[k] = acc;
            }
            asm volatile("s_waitcnt lgkmcnt(0)" ::: "memory");
        }
        if (PASS == 0) { S5LOC[((size_t)(dir * NCH + c) * 64 + g) * 64 + p] = make_float2(sr, si); }
        else {
            __syncthreads();
            if (dir == 0) {
#pragma unroll
                for (int k = 0; k < 8; ++k)
#pragma unroll
                    for (int jj = 0; jj < 4; ++jj) YL[gl * 2048 + (k * 16 + fq * 4 + jj) * 16 + fr] = yacc[k][jj]; }
            __syncthreads();
            if (dir == 1) {
#pragma unroll
                for (int k = 0; k < 8; ++k)
#pragma unroll
                    for (int jj = 0; jj < 4; ++jj) YL[gl * 2048 + ((7 - k) * 16 + fq * 4 + jj) * 16 + fr] += yacc[k][jj]; }
            __syncthreads();
            const int t = tid >> 2, q = tid & 3; const float* y = YL + q * 2048 + t * 16; const float* dd = a.in[14] + (size_t)layer * 1024 + gq * 64 + q * 16;
            const bf16_t* us = U5 + (size_t)(row0 + t) * 1024 + gq * 64 + q * 16; const u32x4 u0 = *(const u32x4*)us, u1 = *(const u32x4*)(us + 8);
            const float u[16] = {bflo(u0.x), bfhi(u0.x), bflo(u0.y), bfhi(u0.y), bflo(u0.z), bfhi(u0.z), bflo(u0.w), bfhi(u0.w), bflo(u1.x), bfhi(u1.x), bflo(u1.y), bfhi(u1.y), bflo(u1.z), bfhi(u1.z), bflo(u1.w), bfhi(u1.w)};
            unsigned o[8];
#pragma unroll
            for (int j = 0; j < 8; ++j) { const float y0 = y[2 * j] + u[2 * j] * dd[2 * j], y1 = y[2 * j + 1] + u[2 * j + 1] * dd[2 * j + 1]; o[j] = cvt_pk_bf16(gelu_tanh(y0), gelu_tanh(y1)); }
            bf16_t* dst = Y5 + (size_t)(row0 + t) * 1024 + gq * 64 + q * 16; u32x4 o0, o1; o0.x = o[0]; o0.y = o[1]; o0.z = o[2]; o0.w = o[3]; o1.x = o[4]; o1.y = o[5]; o1.z = o[6]; o1.w = o[7];
            *(u32x4*)dst = o0; *(u32x4*)(dst + 8) = o1;
        }
    }
    __syncthreads();
}

__device__ __forceinline__ int ssd_chunk_at(int dir, int q) { return s5_chunk_at(dir, q); }
__device__ __forceinline__ void conv8(const bf16_t* XBC, int rowbase, int l0, int ch, bool lo_ok, bool hi_ok, float w0, float w1, float w2, float b, float (&out)[8]) {
    float r[10];
#pragma unroll
    for (int i = 0; i < 10; ++i) { const int l = l0 - 1 + i; const bool ok = (l >= 0 || lo_ok) && (l < 128 || hi_ok); r[i] = ok ? bf2f((unsigned)XBC[(size_t)(rowbase + l) * 3072 + ch]) : 0.f; }
#pragma unroll
    for (int j = 0; j < 8; ++j) out[j] = silu_(w0 * r[j] + w1 * r[j + 1] + w2 * r[j + 2] + b);
}
__device__ __forceinline__ void stage_conv_tile(const bf16_t* XBC, const float* cw, const float* cb, int rowbase, int chbase, bool lo_ok, bool hi_ok, bf16_t* dst, int tid) {
    const int oc = tid & 15, ch = chbase + oc * 8; float w[3][8], b[8];
#pragma unroll
    for (int k = 0; k < 3; ++k) { const f32x4 a0 = *(const f32x4*)(cw + (size_t)k * 3072 + ch), a1 = *(const f32x4*)(cw + (size_t)k * 3072 + ch + 4);
        w[k][0] = a0[0]; w[k][1] = a0[1]; w[k][2] = a0[2]; w[k][3] = a0[3]; w[k][4] = a1[0]; w[k][5] = a1[1]; w[k][6] = a1[2]; w[k][7] = a1[3]; }
    { const f32x4 a0 = *(const f32x4*)(cb + ch), a1 = *(const f32x4*)(cb + ch + 4); b[0] = a0[0]; b[1] = a0[1]; b[2] = a0[2]; b[3] = a0[3]; b[4] = a1[0]; b[5] = a1[1]; b[6] = a1[2]; b[7] = a1[3]; }
#pragma unroll
    for (int i = 0; i < 4; ++i) { const int row = (tid >> 4) + i * 32; float acc[8];
#pragma unroll
        for (int k = 0; k < 8; ++k) acc[k] = b[k];
#pragma unroll
        for (int d = 0; d < 3; ++d) { const bool ok = d == 1 ? true : (d == 0 ? (row > 0 || lo_ok) : (row < 127 || hi_ok)); const int l = ok ? row + d - 1 : row;
            { u32x4 g = *(const u32x4*)(XBC + (size_t)(rowbase + l) * 3072 + ch); if (!ok) g = (u32x4){0u, 0u, 0u, 0u};
                acc[0] += w[d][0] * bflo(g.x); acc[1] += w[d][1] * bfhi(g.x); acc[2] += w[d][2] * bflo(g.y); acc[3] += w[d][3] * bfhi(g.y);
                acc[4] += w[d][4] * bflo(g.z); acc[5] += w[d][5] * bfhi(g.z); acc[6] += w[d][6] * bflo(g.w); acc[7] += w[d][7] * bfhi(g.w); } }
        u32x4 o; o.x = cvt_pk_bf16(silu_(acc[0]), silu_(acc[1])); o.y = cvt_pk_bf16(silu_(acc[2]), silu_(acc[3])); o.z = cvt_pk_bf16(silu_(acc[4]), silu_(acc[5])); o.w = cvt_pk_bf16(silu_(acc[6]), silu_(acc[7]));
        *(u32x4*)(dst + row * 136 + oc * 8) = o; }
}
constexpr int SL_CS = 0, SL_CB = 34816, SL_CUM = 69632, SL_DT = 77824, SL_PART = 86016, SL_BS = 94208, SL_XT = 94208;
template <int AUX> __device__ __forceinline__ void ssd_cum(const Args& a, int layer, int c, int h, int w, int lane, unsigned char* lds) {
    const float* DT = (const float*)(a.ws + WS_BIG + B_DT); float* cumL = (float*)(lds + SL_CUM); float* dtL = (float*)(lds + SL_DT); float* CHD = (float*)(a.ws + WS_CHD);
#pragma unroll
    for (int dir = 0; dir < 2; ++dir) {
        const float ah = -expf(a.in[20][(size_t)(layer * 2 + dir) * 32 + h]);
        const float d0 = DT[(size_t)(c * 128 + 2 * lane) * 64 + dir * 32 + h], d1 = DT[(size_t)(c * 128 + 2 * lane + 1) * 64 + dir * 32 + h];
        const float l0 = d0 * ah, l1 = d1 * ah, s = l0 + l1; float incl = s;
#pragma unroll
        for (int o = 1; o < 64; o <<= 1) { const float t = __shfl_up(incl, o); if (lane >= o) incl += t; }
        const float excl = incl - s, tot = __shfl(incl, 63);
        float c0, c1;
        if (dir == 0) { c0 = excl + l0; c1 = incl; } else { c0 = tot - excl; c1 = tot - (excl + l0); }
        float* cu = cumL + (dir * 8 + w) * 128 + 2 * lane; cu[0] = c0; cu[1] = c1;
        float* dd = dtL + (dir * 8 + w) * 128 + 2 * lane;
        if (AUX == 0) { dd[0] = d0; dd[1] = d1; } else { dd[0] = d0 * __expf(tot - c0); dd[1] = d1 * __expf(tot - c1); if (lane == 0) CHD[(size_t)(dir * NCH + c) * 32 + h] = tot; }
    }
}
__device__ __forceinline__ void stage_T(const bf16_t* XBC, const float* cw, const float* cb, int rowbase, int ch, int r0, bool lo_ok, bool hi_ok, bf16_t* dstT) {
    float w[3][8], b[8];
#pragma unroll
    for (int k = 0; k < 3; ++k) { const f32x4 a0 = *(const f32x4*)(cw + (size_t)k * 3072 + ch), a1 = *(const f32x4*)(cw + (size_t)k * 3072 + ch + 4);
        w[k][0] = a0[0]; w[k][1] = a0[1]; w[k][2] = a0[2]; w[k][3] = a0[3]; w[k][4] = a1[0]; w[k][5] = a1[1]; w[k][6] = a1[2]; w[k][7] = a1[3]; }
    { const f32x4 a0 = *(const f32x4*)(cb + ch), a1 = *(const f32x4*)(cb + ch + 4); b[0] = a0[0]; b[1] = a0[1]; b[2] = a0[2]; b[3] = a0[3]; b[4] = a1[0]; b[5] = a1[1]; b[6] = a1[2]; b[7] = a1[3]; }
    u32x4 raw[10];
    const bf16_t* base = XBC + (size_t)(rowbase + r0) * 3072 + ch;
    const bool ok0 = r0 > 0 || lo_ok, ok9 = r0 < 120 || hi_ok;
#pragma unroll
    for (int i = 1; i < 9; ++i) raw[i] = *(const u32x4*)(base + (i - 1) * 3072);
    { const u32x4 v = *(const u32x4*)(base + (ok0 ? -3072 : 0)); raw[0] = ok0 ? v : (u32x4){0u, 0u, 0u, 0u}; }
    { const u32x4 v = *(const u32x4*)(base + (ok9 ? 8 * 3072 : 7 * 3072)); raw[9] = ok9 ? v : (u32x4){0u, 0u, 0u, 0u}; }
    float sp[8]; unsigned o[8][4];
#pragma unroll
    for (int r = 0; r < 8; ++r) { float sv[8];
#pragma unroll
        for (int k = 0; k < 8; ++k) { float acc = b[k];
#pragma unroll
            for (int d = 0; d < 3; ++d) { const unsigned wd = k < 2 ? raw[r + d].x : (k < 4 ? raw[r + d].y : (k < 6 ? raw[r + d].z : raw[r + d].w)); acc += w[d][k] * ((k & 1) ? bfhi(wd) : bflo(wd)); }
            sv[k] = silu_(acc); }
        if (r & 1) {
#pragma unroll
            for (int k = 0; k < 8; ++k) o[k][r >> 1] = cvt_pk_bf16(sp[k], sv[k]); }
        else {
#pragma unroll
            for (int k = 0; k < 8; ++k) sp[k] = sv[k]; } }
#pragma unroll
    for (int k = 0; k < 8; ++k) { u32x4 v; v.x = o[k][0]; v.y = o[k][1]; v.z = o[k][2]; v.w = o[k][3]; *(u32x4*)(dstT + k * 136 + r0) = v; }
}
__device__ __forceinline__ void ssd_a_phase(const Args& a, int layer, unsigned char* lds, int tid) {
    const bf16_t* XBC = (const bf16_t*)(a.ws + WS_BIG + B_XBC); bf16_t* SST = (bf16_t*)(a.ws + WS_SST);
    const float* cw = a.in[17] + (size_t)layer * 3 * 3072; const float* cb = a.in[18] + (size_t)layer * 3072;
    bf16_t* BT = (bf16_t*)(lds + SL_CS); bf16_t* xT = (bf16_t*)(lds + SL_XT); const float* wL = (const float*)(lds + SL_DT);
    for (int unit = (blockIdx.x + (gridDim.x >> 1)) % gridDim.x; unit < NCH * 4; unit += gridDim.x) {
        int tl = tid; asm volatile("" : "+v"(tl));
        const int lane = tl & 63, w = __builtin_amdgcn_readfirstlane(tl >> 6), fr = lane & 15, fq = lane >> 4, og = lane & 7, rr = lane >> 3;
        const int c = unit >> 2, g = unit & 3, rowbase = c * 128; const bool lo_ok = !(c == 0 || c == 128), hi_ok = !(c == 127 || c == 129);
        __syncthreads();
        if (w < 4) { const int oct = (w & 1) * 8 + og; stage_T(XBC, cw, cb, rowbase, 2048 + g * 128 + oct * 8, ((w >> 1) * 8 + rr) * 8, lo_ok, hi_ok, BT + (oct * 8) * 136); }
        ssd_cum<1>(a, layer, c, g * 8 + w, w, lane, lds);
#pragma unroll 1
        for (int pass = 0; pass < 2; ++pass) {
            if (pass) __syncthreads();
            { const int hs = w & 3; stage_T(XBC, cw, cb, rowbase, (g * 8 + pass * 4 + hs) * 64 + og * 8, ((w >> 2) * 8 + rr) * 8, lo_ok, hi_ok, xT + ((hs * 64 + og * 8) * 136)); }
            __syncthreads();
            const int hl = w >> 1, dir = w & 1, hh = pass * 4 + hl, h = g * 8 + hh;
            bf16_t* sb = SST + (((size_t)(dir * NCH + c) * 32 + h) * 64) * 128;
#pragma unroll 1
            for (int nh = 0; nh < 2; ++nh) {
                f32x4 acc[4][4];
#pragma unroll
                for (int pt = 0; pt < 4; ++pt)
#pragma unroll
                    for (int nt = 0; nt < 4; ++nt) acc[pt][nt] = (f32x4){0.f, 0.f, 0.f, 0.f};
#pragma unroll
                for (int ks = 0; ks < 4; ++ks) {
                    const float* wp = wL + (dir * 8 + hh) * 128 + ks * 32 + fq * 8; const f32x4 wl0 = *(const f32x4*)wp, wl1 = *(const f32x4*)(wp + 4);
                    bf16x8 yf[4];
#pragma unroll
                    for (int pt = 0; pt < 4; ++pt) { const u32x4 xr = *(const u32x4*)(xT + ((hl * 64 + pt * 16 + fr) * 136 + ks * 32 + fq * 8));
                        yf[pt] = mkfrag(cvt_pk_bf16(bflo(xr.x) * wl0[0], bfhi(xr.x) * wl0[1]), cvt_pk_bf16(bflo(xr.y) * wl0[2], bfhi(xr.y) * wl0[3]), cvt_pk_bf16(bflo(xr.z) * wl1[0], bfhi(xr.z) * wl1[1]), cvt_pk_bf16(bflo(xr.w) * wl1[2], bfhi(xr.w) * wl1[3])); }
#pragma unroll
                    for (int nt = 0; nt < 4; ++nt) { const bf16x8 xf = *(const bf16x8*)(BT + ((nh * 4 + nt) * 16 + fr) * 136 + ks * 32 + fq * 8);
#pragma unroll
                        for (int pt = 0; pt < 4; ++pt) acc[pt][nt] = __builtin_amdgcn_mfma_f32_16x16x32_bf16(xf, yf[pt], acc[pt][nt], 0, 0, 0); }
                }
#pragma unroll
                for (int pt = 0; pt < 4; ++pt) mfma_settle(acc[pt][3]);
#pragma unroll
                for (int pt = 0; pt < 4; ++pt)
#pragma unroll
                    for (int nt = 0; nt < 4; ++nt) { u32x2 o; o.x = cvt_pk_native(acc[pt][nt][0], acc[pt][nt][1]); o.y = cvt_pk_native(acc[pt][nt][2], acc[pt][nt][3]);
                        *(u32x2*)(sb + (size_t)(pt * 16 + fr) * 128 + (nh * 4 + nt) * 16 + fq * 4) = o; }
            }
        }
    }
    __syncthreads();
}
__device__ __forceinline__ void ssd_b_phase(const Args& a, int tid) {
    bf16_t* SST = (bf16_t*)(a.ws + WS_SST); const float* CHD = (const float*)(a.ws + WS_CHD);
    for (int idx = blockIdx.x * 512 + tid; idx < 64 * 2048; idx += gridDim.x * 512) {
        const int e4 = idx & 2047, hd = idx >> 11, dir = hd >> 5, h = hd & 31; float s0 = 0.f, s1 = 0.f, s2 = 0.f, s3 = 0.f;
#pragma unroll 1
        for (int b = 0; b < 13; ++b) { u32x2 loc[10]; float dc[10];
#pragma unroll
            for (int i = 0; i < 10; ++i) { const int cq = ssd_chunk_at(dir, b * 10 + i); loc[i] = *(const u32x2*)(SST + ((size_t)(dir * NCH + cq) * 32 + h) * 8192 + e4 * 4); dc[i] = CHD[(size_t)(dir * NCH + cq) * 32 + h]; }
#pragma unroll
            for (int i = 0; i < 10; ++i) { const int cq = ssd_chunk_at(dir, b * 10 + i); u32x2 o; o.x = cvt_pk_bf16(s0, s1); o.y = cvt_pk_bf16(s2, s3);
                *(u32x2*)(SST + ((size_t)(dir * NCH + cq) * 32 + h) * 8192 + e4 * 4) = o; const float e = __expf(dc[i]);
                s0 = e * s0 + bflo(loc[i].x); s1 = e * s1 + bfhi(loc[i].x); s2 = e * s2 + bflo(loc[i].y); s3 = e * s3 + bfhi(loc[i].y); }
        }
    }
}
__device__ __forceinline__ void ssd_c_phase(const Args& a, int layer, unsigned char* lds, int tid, int nchunks) {
    const bf16_t* XBC = (const bf16_t*)(a.ws + WS_BIG + B_XBC); const bf16_t* SST = (const bf16_t*)(a.ws + WS_SST); const bf16_t* Z = (const bf16_t*)(a.ws + WS_BIG + B_Z); bf16_t* YD = (bf16_t*)(a.ws + WS_BIG + B_YD);
    const float* cw = a.in[17] + (size_t)layer * 3 * 3072; const float* cb = a.in[18] + (size_t)layer * 3072; const float* normw = a.in[22] + (size_t)layer * 2048;
    bf16_t* Cs = (bf16_t*)(lds + SL_CS); bf16_t* Bs = (bf16_t*)(lds + SL_BS); bf16_t* CBs = (bf16_t*)(lds + SL_CB); bf16_t* xT = (bf16_t*)(lds + SL_XT);
    const float* cumL = (const float*)(lds + SL_CUM); const float* dtL = (const float*)(lds + SL_DT); float* part = (float*)(lds + SL_PART);
    for (int unit = (blockIdx.x + (gridDim.x >> 1)) % gridDim.x; unit < nchunks * 4; unit += gridDim.x) {
        int tl = tid; asm volatile("" : "+v"(tl));
        const int lane = tl & 63, w = __builtin_amdgcn_readfirstlane(tl >> 6), fr = lane & 15, fq = lane >> 4, og = lane & 7, rr = lane >> 3;
        const int hl = w & 3, lh = w >> 2;
        const int c = unit >> 2, g = unit & 3, rowbase = c * 128; const bool lo_ok = !(c == 0 || c == 128), hi_ok = !(c == 127 || c == 129);
        __syncthreads();
        stage_conv_tile(XBC, cw, cb, rowbase, 2560 + g * 128, lo_ok, hi_ok, Cs, tl);
        stage_conv_tile(XBC, cw, cb, rowbase, 2048 + g * 128, lo_ok, hi_ok, Bs, tl);
        ssd_cum<0>(a, layer, c, g * 8 + w, w, lane, lds);
        __syncthreads();
#pragma unroll 1
        for (int st = 0; st < 8; ++st) { f32x4 acc = {0.f, 0.f, 0.f, 0.f};
#pragma unroll
            for (int ks = 0; ks < 4; ++ks) { const bf16x8 xf = *(const bf16x8*)(Bs + (st * 16 + fr) * 136 + ks * 32 + fq * 8), yf = *(const bf16x8*)(Cs + (w * 16 + fr) * 136 + ks * 32 + fq * 8);
                acc = __builtin_amdgcn_mfma_f32_16x16x32_bf16(xf, yf, acc, 0, 0, 0); }
            mfma_settle(acc);
            u32x2 o; o.x = cvt_pk_native(acc[0], acc[1]); o.y = cvt_pk_native(acc[2], acc[3]); *(u32x2*)(CBs + (w * 16 + fr) * 136 + st * 16 + fq * 4) = o; }
#pragma unroll 1
        for (int pass = 0; pass < 2; ++pass) {
            __syncthreads();
            stage_T(XBC, cw, cb, rowbase, (g * 8 + pass * 4 + hl) * 64 + og * 8, (lh * 8 + rr) * 8, lo_ok, hi_ok, xT + ((hl * 64 + og * 8) * 136));
            __syncthreads();
            const int hh = pass * 4 + hl, h = g * 8 + hh; const float Dh = a.in[21][(size_t)layer * 32 + h];
#pragma unroll 1
            for (int ih = 0; ih < 2; ++ih) {
            f32x4 acc[2][4];
#pragma unroll
            for (int i = 0; i < 2; ++i)
#pragma unroll
                for (int pt = 0; pt < 4; ++pt) acc[i][pt] = (f32x4){0.f, 0.f, 0.f, 0.f};
#pragma unroll
            for (int dir = 0; dir < 2; ++dir) {
                const bf16_t* sb = SST + (((size_t)(dir * NCH + c) * 32 + h) * 64) * 128;
                f32x4 tmp[2][4];
#pragma unroll
                for (int i = 0; i < 2; ++i)
#pragma unroll
                    for (int pt = 0; pt < 4; ++pt) tmp[i][pt] = (f32x4){0.f, 0.f, 0.f, 0.f};
#pragma unroll
                for (int ks = 0; ks < 4; ++ks) { const int lb = (lh * 4 + ih * 2) * 16 + fr;
                    const bf16x8 yf0 = *(const bf16x8*)(Cs + lb * 136 + ks * 32 + fq * 8), yf1 = *(const bf16x8*)(Cs + (lb + 16) * 136 + ks * 32 + fq * 8);
#pragma unroll
                    for (int pt = 0; pt < 4; ++pt) { const bf16x8 sfr = *(const bf16x8*)(sb + (size_t)(pt * 16 + fr) * 128 + ks * 32 + fq * 8);
                        tmp[0][pt] = __builtin_amdgcn_mfma_f32_16x16x32_bf16(sfr, yf0, tmp[0][pt], 0, 0, 0); tmp[1][pt] = __builtin_amdgcn_mfma_f32_16x16x32_bf16(sfr, yf1, tmp[1][pt], 0, 0, 0); } }
#pragma unroll
                for (int i = 0; i < 2; ++i) { int frv = fr; asm volatile("" : "+v"(frv));
                    const int lt = lh * 4 + ih * 2 + i, l = lt * 16 + frv;
                    const float cl = cumL[(dir * 8 + hh) * 128 + l], el = __expf(cl);
#pragma unroll
                    for (int pt = 0; pt < 4; ++pt) acc[i][pt] += tmp[i][pt] * el;
#pragma unroll
                    for (int ks = 0; ks < 4; ++ks) { const int s0 = ks * 32;
                        const bool skip = dir == 0 ? (s0 > lt * 16 + 15) : (s0 + 31 < lt * 16);
                        if (!skip) { const u32x4 cbv = *(const u32x4*)(CBs + l * 136 + s0 + fq * 8);
                            const float* cp = cumL + (dir * 8 + hh) * 128 + s0 + fq * 8; const float* dp = dtL + (dir * 8 + hh) * 128 + s0 + fq * 8;
                            const f32x4 c0 = *(const f32x4*)cp, c1 = *(const f32x4*)(cp + 4), d0 = *(const f32x4*)dp, d1 = *(const f32x4*)(dp + 4);
                            float cbf[8] = {bflo(cbv.x), bfhi(cbv.x), bflo(cbv.y), bfhi(cbv.y), bflo(cbv.z), bfhi(cbv.z), bflo(cbv.w), bfhi(cbv.w)}; float v[8];
#pragma unroll
                            for (int j = 0; j < 8; ++j) { const int sx = s0 + fq * 8 + j; const float cs = j < 4 ? c0[j & 3] : c1[j & 3], ds = j < 4 ? d0[j & 3] : d1[j & 3];
                                const bool valid = dir == 0 ? (sx <= l) : (sx >= l); float t = valid ? cbf[j] * __expf(fminf(cl - cs, 0.f)) * ds : 0.f; if (dir == 0 && sx == l) t += Dh; v[j] = t; }
                            const bf16x8 yf = mkfrag(cvt_pk_bf16(v[0], v[1]), cvt_pk_bf16(v[2], v[3]), cvt_pk_bf16(v[4], v[5]), cvt_pk_bf16(v[6], v[7]));
#pragma unroll
                            for (int pt = 0; pt < 4; ++pt) acc[i][pt] = __builtin_amdgcn_mfma_f32_16x16x32_bf16(*(const bf16x8*)(xT + ((hl * 64 + pt * 16 + fr) * 136 + s0 + fq * 8)), yf, acc[i][pt], 0, 0, 0); } }
                }
            }
#pragma unroll
            for (int i = 0; i < 2; ++i) { const int l = (lh * 4 + ih * 2 + i) * 16 + fr; const size_t row = (size_t)(rowbase + l); float ss = 0.f;
#pragma unroll
                for (int pt = 0; pt < 4; ++pt) { const int ch = h * 64 + pt * 16 + fq * 4; const u32x2 zz = *(const u32x2*)(Z + row * 2048 + ch);
                    const float h0 = acc[i][pt][0] * silu_(bflo(zz.x)), h1 = acc[i][pt][1] * silu_(bfhi(zz.x)), h2 = acc[i][pt][2] * silu_(bflo(zz.y)), h3 = acc[i][pt][3] * silu_(bfhi(zz.y));
                    ss += (h0 * h0 + h1 * h1) + (h2 * h2 + h3 * h3); u32x2 o; o.x = cvt_pk_bf16(h0, h1); o.y = cvt_pk_bf16(h2, h3); *(u32x2*)(YD + row * 2048 + ch) = o; }
                ss += __shfl_xor(ss, 16); ss += __shfl_xor(ss, 32);
                if (fq == 0) part[hh * 128 + l] = ss; }
            }
        }
        __syncthreads();
#pragma unroll 1
        for (int it = 0; it < 8; ++it) { const int pass = it >> 2, i = it & 3, l = (lh * 4 + i) * 16 + fr, h = g * 8 + pass * 4 + hl; float tot = 0.f;
#pragma unroll
            for (int hd = 0; hd < 8; ++hd) tot += part[hd * 128 + l];
            const float r = __builtin_amdgcn_rsqf(tot * (1.f / 512.f) + RMS_EPS); const size_t row = (size_t)(rowbase + l);
#pragma unroll
            for (int pt = 0; pt < 4; ++pt) { const int ch = h * 64 + pt * 16 + fq * 4; bf16_t* yp = YD + row * 2048 + ch; const u32x2 hv = *(const u32x2*)yp; const f32x4 nw = *(const f32x4*)(normw + ch);
                u32x2 o; o.x = cvt_pk_bf16(bflo(hv.x) * r * nw[0], bfhi(hv.x) * r * nw[1]); o.y = cvt_pk_bf16(bflo(hv.y) * r * nw[2], bfhi(hv.y) * r * nw[3]); *(u32x2*)yp = o; } }
    }
    __syncthreads();
}

#define LAS __attribute__((address_space(3)))
#define XB_TMO      128
#define XB_XCNT(j)  (256  + 64 * (j))
#define XB_XSUB(j)  (1280 + 64 * (j))
#define XB_XGEN(j)  (2304 + 64 * (j))
#define XB_TOP      3328
#define XB_TOPGEN   3392
#define XCD_BAR_WORDS 3456
#define XB_SPIN_CAP (1u << 18)

__device__ __forceinline__ unsigned xb_ld(unsigned* p)              { return __hip_atomic_load(p, __ATOMIC_RELAXED, __HIP_MEMORY_SCOPE_AGENT); }
__device__ __forceinline__ unsigned xb_add(unsigned* p, unsigned v) { return __hip_atomic_fetch_add(p, v, __ATOMIC_RELAXED, __HIP_MEMORY_SCOPE_AGENT); }
__device__ __forceinline__ unsigned xb_xcc_id() { return (unsigned)__builtin_amdgcn_s_getreg((3 << 11) | 20) & 0xFu; }
#define XB_SPIN(cond, bar) do { unsigned _sp = 0; while (cond) { __builtin_amdgcn_s_sleep(1); \
    if ((++_sp & 255u) == 0u) { if (xb_ld(&(bar)[XB_TMO])) break; if (_sp > XB_SPIN_CAP) { atomicAdd(&(bar)[XB_TMO], 1u); break; } } } } while (0)

struct XcdBarrier {
    unsigned* bar; unsigned x;
    volatile LAS unsigned* st;
};

__device__ __forceinline__ XcdBarrier xcd_barrier_post(unsigned* bar, volatile LAS unsigned* st) {
    XcdBarrier b; b.bar = bar; b.x = xb_xcc_id(); b.st = st;
    if (threadIdx.x == 0) (void)xb_add(&bar[XB_XCNT(b.x)], 1u);
    return b;
}
__device__ __forceinline__ void xcd_barrier_complete(unsigned* bar, unsigned x, unsigned& nloc, unsigned& nx) {
    const unsigned G = gridDim.x * gridDim.y * gridDim.z;
    unsigned sum, cnt, mine, sp = 0u;
    for (;;) {
        sum = 0u; cnt = 0u; mine = 0u;
#pragma unroll
        for (unsigned j = 0; j < 16; ++j) { const unsigned c = xb_ld(&bar[XB_XCNT(j)]); sum += c; cnt += (c > 0u) ? 1u : 0u; mine = (j == x) ? c : mine; }
        if (sum == G) break;
        __builtin_amdgcn_s_sleep(1);
        if ((++sp & 255u) == 0u) { if (xb_ld(&bar[XB_TMO])) break; if (sp > XB_SPIN_CAP) { atomicAdd(&bar[XB_TMO], 1u); break; } }
    }
    nloc = mine > 0u ? mine : 1u; nx = cnt > 0u ? cnt : 1u;
}

__device__ __forceinline__ void xcd_barrier(const XcdBarrier& b) {
    asm volatile("s_waitcnt vmcnt(0)" ::: "memory");
    __syncthreads();
    if (threadIdx.x == 0) {
        unsigned* bar = b.bar;
        __builtin_amdgcn_s_waitcnt(0);
        unsigned nloc = b.st[0], nx = b.st[1];
        if (nloc == 0u) { xcd_barrier_complete(bar, b.x, nloc, nx); b.st[0] = nloc; b.st[1] = nx; }
        const unsigned old = xb_add(&bar[XB_XSUB(b.x)], 1u);
        const unsigned gen = old / nloc;
        if (old + 1u == (gen + 1u) * nloc) {
            __builtin_amdgcn_fence(__ATOMIC_RELEASE, "agent");
            asm volatile("s_waitcnt vmcnt(0)" ::: "memory");
            const unsigned og = xb_add(&bar[XB_TOP], 1u);
            const unsigned tg = og / nx;
            if (og + 1u == (tg + 1u) * nx) xb_add(&bar[XB_TOPGEN], 1u);
            else XB_SPIN(xb_ld(&bar[XB_TOPGEN]) == tg, bar);
            __builtin_amdgcn_fence(__ATOMIC_ACQUIRE, "agent");
            xb_add(&bar[XB_XGEN(b.x)], 1u);
            asm volatile("s_waitcnt vmcnt(0)" ::: "memory");
        } else {
            XB_SPIN(xb_ld(&bar[XB_XGEN(b.x)]) == gen, bar);
            __builtin_amdgcn_fence(__ATOMIC_ACQUIRE, "agent");
            asm volatile("s_waitcnt vmcnt(0)" ::: "memory");
        }
    }
    __syncthreads();
}

#ifndef MK_REP_S5
#define MK_REP_S5 1
#endif
#ifndef MK_REP_SSD
#define MK_REP_SSD 1
#endif
#ifndef MK_REP_SYNC
#define MK_REP_SYNC 1
#endif
#ifndef MK_CG_SYNC_ALL
#define MK_CG_SYNC_ALL 0
#endif
#ifndef MK_REP_PRO
#define MK_REP_PRO 1
#endif
#ifndef MK_REP_GEMM
#define MK_REP_GEMM 1
#endif
constexpr int NPHASE = 2 + 11 * 2;
__global__ void __launch_bounds__(512, 2) fwd_megakernel(Args a) {
    extern __shared__ __attribute__((aligned(16))) unsigned char lds[];
    PG8_LAS unsigned char* lds3 = (PG8_LAS unsigned char*)lds;
    unsigned char* big = a.ws + WS_BIG;
    volatile LAS unsigned* bst = (volatile LAS unsigned*)(lds3 + (LDS_BYTES - 16));
    if (threadIdx.x < 4) bst[threadIdx.x] = 0u;
    __syncthreads();
    XcdBarrier xbar; xbar.bar = (unsigned*)(a.ws + WS_BAR); xbar.x = 0; xbar.st = bst;
    if (a.ph_hi - a.ph_lo > 1) xbar = xcd_barrier_post((unsigned*)(a.ws + WS_BAR), bst);
    for (int ph = a.ph_lo; ph < a.ph_hi; ++ph) {
        const int tid = pg8::pg8_tid(), lane = tid & 63, wave = tid >> 6, gw = blockIdx.x * 8 + wave, NGW = gridDim.x * 8;
        if (ph == 0) {
            for (int rep = 0; rep < MK_REP_PRO; ++rep) {
            adaln_phase(a, (float*)lds, tid);
            float* scr = (float*)lds + wave * (64 * 33);
            xpose_region(a, 0, 0, scr, gw, NGW, lane); xpose_region(a, 0, 1, scr, gw, NGW, lane); __syncthreads(); }
        } else if (ph == 1) {
            row_phase<0>(a, MT, nullptr, nullptr, 0, 0, gw, NGW, lane);
        } else {
            const int layer = (ph - 2) / 11, k = (ph - 2) % 11; const bool last = layer == 1; const int Mrows = last ? TL : MT;
            const bf16_t* WA = (const bf16_t*)(a.ws + WS_WA); const bf16_t* WB = (const bf16_t*)(a.ws + WS_WB);
#ifdef MK_SKIP_MASK
            if ((MK_SKIP_MASK >> k) & 1) { if (ph + 1 < a.ph_hi) xcd_barrier(xbar); continue; }
#endif
            if (k == 0) {
                pg8::Gemm g{(const bf16_t*)(a.ws + WS_XM), WA + WA_IN / 2, MT, NPROJ, D}; pg8::StaticOrder S; S.init(MT, NPROJ, gridDim.x, blockIdx.x);
                EpiInProj E{big, a.in[19] + (size_t)layer * 64}; for (int rep = 0; rep < MK_REP_GEMM; ++rep) { pg8::gemm_phase<EpiInProj, pg8::StaticOrder>(lds3, g, S, E, nullptr); __syncthreads(); }
            } else if (k == 1) {
                for (int rep = 0; rep < MK_REP_SSD; ++rep) ssd_a_phase(a, layer, lds, tid);
                for (int rep = 0; rep < MK_REP_S5; ++rep) s5_phase<0>(a, layer, lds, tid, NCH);
            } else if (k == 2) {
#if !defined(MK_NO_SSD) && !defined(MK_NO_SSDB)
                ssd_b_phase(a, tid);
#endif
                for (int rep = 0; rep < MK_REP_S5; ++rep) s5_phase<1>(a, layer, lds, tid, last ? 128 : NCH);
            } else if (k == 3) {
                for (int rep = 0; rep < MK_REP_SSD; ++rep) ssd_c_phase(a, layer, lds, tid, last ? 128 : NCH);
#ifndef MK_NO_S5
                pg8::Gemm g{(const bf16_t*)(big + B_Y5), WA + WA_GLU / 2, Mrows, 2048, 1024}; pg8::StaticOrder S; S.init(Mrows, 2048, gridDim.x, blockIdx.x);
                EpiGlu E{(bf16_t*)(big + B_U5)}; pg8::gemm_phase<EpiGlu, pg8::StaticOrder>(lds3, g, S, E, nullptr);
#endif
            } else if (k == 4) {
#ifndef MK_NO_S5
                { pg8::Gemm g{(const bf16_t*)(big + B_U5), WA + WA_S5P / 2, Mrows, 2048, 1024}; pg8::StaticOrder S; S.init(Mrows, 2048, gridDim.x, blockIdx.x);
                  EpiMerge<0> E{(bf16_t*)(big + B_XBC), (const bf16_t*)(big + B_GATE)}; pg8::gemm_phase<EpiMerge<0>, pg8::StaticOrder>(lds3, g, S, E, nullptr); }
                __syncthreads();
#endif
#ifndef MK_NO_SSD
#ifdef MK_NO_S5
                { pg8::Gemm g{(const bf16_t*)(big + B_YD), WA + WA_SSDP / 2, Mrows, 2048, 2048}; pg8::StaticOrder S; S.init(Mrows, 2048, gridDim.x, blockIdx.x);
                  EpiMerge<0, 1> E{(bf16_t*)(big + B_XBC), (const bf16_t*)(big + B_GATE)}; pg8::gemm_phase<EpiMerge<0, 1>, pg8::StaticOrder>(lds3, g, S, E, nullptr); }
#else
                { pg8::Gemm g{(const bf16_t*)(big + B_YD), WA + WA_SSDP / 2, Mrows, 2048, 2048}; pg8::StaticOrder S; S.init(Mrows, 2048, gridDim.x, blockIdx.x);
                  EpiMerge<1> E{(bf16_t*)(big + B_XBC), (const bf16_t*)(big + B_GATE)}; pg8::gemm_phase<EpiMerge<1>, pg8::StaticOrder>(lds3, g, S, E, nullptr); }
#endif
#endif
            } else if (k == 5) {
                pg8::Gemm g{(const bf16_t*)(big + B_XBC), WA + WA_WOUT / 2, Mrows, 2048, 2048}; pg8::StaticOrder S; S.init(Mrows, 2048, gridDim.x, blockIdx.x);
                EpiResid E{a.out, (float*)(a.ws + WS_HCTX), mvec(a, layer, 0) + 2 * D, mvec(a, layer, 1) + 2 * D}; pg8::gemm_phase<EpiResid, pg8::StaticOrder>(lds3, g, S, E, nullptr);
            } else if (k == 6) {
                row_phase<1>(a, Mrows, a.in[25] + (size_t)layer * D, a.in[26] + (size_t)layer * D, layer, 3 * D, gw, NGW, lane);
                if (!last) for (int rep = 0; rep < MK_REP_PRO; ++rep) { __syncthreads(); xpose_region(a, layer + 1, 0, (float*)lds + wave * (64 * 33), gw, NGW, lane); }
            } else if (k == 7) {
                pg8::Gemm g{(const bf16_t*)(a.ws + WS_XM), WB + WB_UP / 2, Mrows, 2 * DFF, D}; pg8::StaticOrder S; S.init(Mrows, 2 * DFF, gridDim.x, blockIdx.x);
                EpiUp E{(bf16_t*)(big + B_G), (bf16_t*)(big + B_V)}; for (int rep = 0; rep < MK_REP_GEMM; ++rep) { pg8::gemm_phase<EpiUp, pg8::StaticOrder>(lds3, g, S, E, nullptr); __syncthreads(); }
            } else if (k == 8) {
                ffnconv_phase(a, layer, !last, lds, tid);
            } else if (k == 9) {
                pg8::Gemm g{(const bf16_t*)(big + B_V), WB + WB_DOWN / 2, Mrows, D, DFF}; pg8::StaticOrder S; S.init(Mrows, D, gridDim.x, blockIdx.x);
                EpiResid E{a.out, (float*)(a.ws + WS_HCTX), mvec(a, layer, 0) + 5 * D, mvec(a, layer, 1) + 5 * D}; pg8::gemm_phase<EpiResid, pg8::StaticOrder>(lds3, g, S, E, nullptr);
            } else {
                row_phase<1>(a, Mrows, a.in[31] + (size_t)layer * D, a.in[32] + (size_t)layer * D, last ? -1 : layer + 1, 0, gw, NGW, lane);
                if (!last) for (int rep = 0; rep < MK_REP_PRO; ++rep) { __syncthreads(); xpose_region(a, layer + 1, 1, (float*)lds + wave * (64 * 33), gw, NGW, lane); }
            }
        }
        if (ph + 1 < a.ph_hi) { for (int rep = 0; rep < MK_REP_SYNC; ++rep) { if (MK_CG_SYNC_ALL || ph == a.ph_lo) cg::this_grid().sync(); else xcd_barrier(xbar); } }
#ifdef MK_TS_MASK
        if (blockIdx.x == 0 && threadIdx.x == 0) ((unsigned long long*)(a.ws + WS_BAR + 65536))[ph + 1] = __builtin_amdgcn_s_memrealtime();
#endif
    }
#ifdef MK_TS_MASK
    if (blockIdx.x == 0 && threadIdx.x == 0) {
        const unsigned long long* ts = (const unsigned long long*)(a.ws + WS_BAR + 65536); unsigned long long sum = 0;
        for (int ph = 1; ph < a.ph_hi - 1; ++ph) if ((MK_TS_MASK >> ph) & 1ull) sum += ts[ph + 1] - ts[ph];
        const unsigned long long t0 = __builtin_amdgcn_s_memrealtime();
        while (__builtin_amdgcn_s_memrealtime() - t0 < sum * MK_TS_AMP) __builtin_amdgcn_s_sleep(8);
    }
#endif
}
}

#ifndef MK_N_LAUNCH_MODE
#define MK_N_LAUNCH_MODE 0
#endif
extern "C" void kernel_launch(void* const* d_in, const int* in_sizes, int n_in, void* d_out, int out_size, void* d_ws, size_t ws_size, hipStream_t stream) {
    static int grid = 0;
    if (grid == 0) {
        if (n_in != 33 || ws_size < mk::WS_END) { fprintf(stderr, "kernel_launch: need 33 inputs and %zu bytes of workspace (got %d, %zu)\n", (size_t)mk::WS_END, n_in, ws_size); grid = -1; return; }
        int dev = 0, cus = 0, per_cu = 0;
        (void)hipGetDevice(&dev); (void)hipDeviceGetAttribute(&cus, hipDeviceAttributeMultiprocessorCount, dev);
        if (hipFuncSetAttribute((const void*)mk::fwd_megakernel, hipFuncAttributeMaxDynamicSharedMemorySize, mk::LDS_BYTES) != hipSuccess) { fprintf(stderr, "kernel_launch: hipFuncSetAttribute failed\n"); grid = -1; return; }
        if (hipOccupancyMaxActiveBlocksPerMultiprocessor(&per_cu, (const void*)mk::fwd_megakernel, 512, mk::LDS_BYTES) != hipSuccess || per_cu < 1) { fprintf(stderr, "kernel_launch: occupancy query says %d\n", per_cu); per_cu = 1; }
        (void)hipGetLastError();
        grid = cus * per_cu; if (grid > 256) grid = 256;
    }
    if (grid < 0) return;
    mk::Args a{};
    for (int i = 0; i < 33; ++i) a.in[i] = (const float*)d_in[i];
    a.out = (float*)d_out; a.ws = (unsigned char*)d_ws;
#if MK_N_LAUNCH_MODE == 1
    for (int ph = 0; ph < mk::NPHASE; ++ph) { a.ph_lo = ph; a.ph_hi = ph + 1; hipLaunchKernelGGL(mk::fwd_megakernel, dim3(grid), dim3(512), mk::LDS_BYTES, stream, a); }
#else
    a.ph_lo = 0; a.ph_hi = mk::NPHASE;
    (void)hipMemsetAsync((unsigned char*)d_ws + mk::WS_BAR, 0, XCD_BAR_WORDS * sizeof(unsigned), stream);
    void* args[] = {&a};
    hipError_t e = hipLaunchCooperativeKernel((const void*)mk::fwd_megakernel, dim3(grid), dim3(512), args, mk::LDS_BYTES, stream);
    if (e != hipSuccess) fprintf(stderr, "cooperative launch failed: %s (grid %d)\n", hipGetErrorString(e), grid);
#endif
}
```

```cpp
#include <hip/hip_runtime.h>
#include <hip/hip_cooperative_groups.h>
#include <cstdio>
namespace cg = cooperative_groups;
#define MK_N_LAUNCH_MODE 0
namespace pg8 {
#define PG8_LAS __attribute__((address_space(3)))
typedef unsigned short bf16_t;
typedef short bf16x8 __attribute__((ext_vector_type(8)));
typedef float f32x4 __attribute__((ext_vector_type(4)));
typedef unsigned u32x4 __attribute__((ext_vector_type(4)));
constexpr int BM = 256, BK = 64, HALF = 128, HTB = HALF * BK * 2  , STAGE_BYTES = 8 * HTB, NXCD = 8, WGM = 8;

__host__ __device__ __forceinline__ int lds_byte(int r, int c) { const int st = (r >> 4) * 2 + (c >> 5), rr = r & 15, cc = c & 31, ob = rr * 64 + cc * 2; return st * 1024 + (ob ^ (((ob >> 9) & 1) << 5)); }
__host__ __device__ __forceinline__ void stage_rc(int b, int& R, int& C) { const int st = b / 1024, sb = b % 1024, swz = sb ^ (((sb >> 9) & 1) << 5); R = (st >> 1) * 16 + swz / 64; C = (st & 1) * 32 + (swz % 64) / 2; }
__host__ __device__ __forceinline__ int perm32(int rho) { const int n = rho >> 4, i = rho & 15; return 8 * (i >> 2) + 4 * n + (i & 3); }

__device__ __forceinline__ int pg8_tid() { int t = threadIdx.x; asm volatile("" : "+v"(t)); return t; }
struct Unit { int pm, pn; };
struct Gemm { const bf16_t* A; const bf16_t* Bt; int M, N, K; };

struct StaticOrder {
    int nM, nN, nwg, G, c;
    __host__ __device__ void init(int M, int N, int G_, int c_) { nM = M / BM; nN = N / BM; nwg = nM * nN; G = G_; c = c_; }
    __host__ __device__ bool next(int i, Unit& u) const {
        const long L = (long)i * G + c; if (L >= nwg) return false;
        int wgid = (int)L; { const int q = nwg / NXCD, r = nwg % NXCD, xcd = wgid % NXCD, off = wgid / NXCD; wgid = (xcd < r ? xcd * (q + 1) : r * (q + 1) + (xcd - r) * q) + off; }
        const int nig = WGM * nN, gid = wgid / nig, fm = gid * WGM, gsz = (nM - fm) < WGM ? (nM - fm) : WGM;
        u.pm = fm + ((wgid % nig) % gsz); u.pn = (wgid % nig) / gsz; return true;
    }
    __device__ __forceinline__ void a_ready(const Unit&) const {}
    __device__ __forceinline__ void done(const Unit&) const {}
};
typedef float f32x2c __attribute__((ext_vector_type(2))); typedef __bf16 bf16x2c __attribute__((ext_vector_type(2)));
__device__ __forceinline__ unsigned cvt_pk_native(float lo, float hi) { const f32x2c v = {lo, hi}; const bf16x2c b = __builtin_convertvector(v, bf16x2c); return __builtin_bit_cast(unsigned, b); }
__device__ __forceinline__ unsigned cvt_pk_bf16(float lo, float hi) { unsigned r; asm volatile("v_cvt_pk_bf16_f32 %0, %1, %2" : "=v"(r) : "v"(lo), "v"(hi)); return r; }
__device__ __forceinline__ void mfma_settle(const float __attribute__((ext_vector_type(4)))& a) { asm volatile("s_nop 15\n\ts_nop 7" :: "v"(a)); }
typedef float f32x2 __attribute__((ext_vector_type(2)));
template <class Epi, class Sched, bool STAMP = false>
__device__ __forceinline__ void gemm_phase(PG8_LAS unsigned char* lds, const Gemm g, const Sched& S, const Epi& E, unsigned long long* stamps) {
    const int tid = pg8_tid(), wid = __builtin_amdgcn_readfirstlane(tid >> 6), lane = tid & 63, wr = wid >> 2, wc = wid & 3, fr = lane & 15, fq = lane >> 4;
    const int K = g.K, nt = K / BK;
    int ts_lo = 0, ts_hi = 0, nts = 0; const unsigned long long rt_entry = STAMP ? (unsigned long long)wall_clock64() : 0ull;
#define PG8_STAMP() do { if (STAMP && wid == 0 && nts < 64) { const unsigned long long _c = (unsigned long long)clock64(); \
        ts_lo = (lane == nts) ? (int)(unsigned)_c : ts_lo; ts_hi = (lane == nts) ? (int)(unsigned)(_c >> 32) : ts_hi; ++nts; } } while (0)
    PG8_STAMP();
    unsigned voffA[2], voffB[2];
#pragma unroll
    for (int i = 0; i < 2; ++i) { int R, C; stage_rc(tid * 16 + i * 8192, R, C); const int Rb = Epi::PERM ? ((R & ~31) + perm32(R & 31)) : R;
        voffA[i] = (unsigned)(R * K + C) * 2u; voffB[i] = (unsigned)(Rb * K + C) * 2u; }
    const size_t kstep = (size_t)(BK * 2);
    const size_t hstep = (size_t)HALF * K * 2;
    const size_t tstep = 2 * hstep;
    const unsigned ldsw = (unsigned)wid * 1024u;
    const int aoff = lds_byte(wr * 64 + fr, fq * 8), boff = lds_byte(wc * 32 + fr, fq * 8);
#define PG8_SA(b, h) (((b) * 2 + (h)) * HTB)
#define PG8_SB(b, h) ((4 + (b) * 2 + (h)) * HTB)
#define PG8_STAGE(bufoff, gbase, voff) do { _Pragma("unroll") for (int _i = 0; _i < 2; ++_i) \
        __builtin_amdgcn_global_load_lds((const unsigned*)((const char*)(gbase) + (voff)[_i]), (PG8_LAS unsigned*)(lds + (bufoff) + ldsw + _i * 8192), 16, 0, 0); } while (0)
#define PG8_LDA(dst, b, h) do { _Pragma("unroll") for (int m = 0; m < 4; ++m) _Pragma("unroll") for (int k = 0; k < 2; ++k) dst[m][k] = *(const PG8_LAS bf16x8*)(lds + PG8_SA(b, h) + aoff + m * 2048 + k * 1024); } while (0)
#define PG8_LDB(dst, b, h) do { _Pragma("unroll") for (int n = 0; n < 2; ++n) _Pragma("unroll") for (int k = 0; k < 2; ++k) dst[n][k] = *(const PG8_LAS bf16x8*)(lds + PG8_SB(b, h) + boff + n * 2048 + k * 1024); } while (0)
#define PG8_MMA(ai, bj, At, Bt) do { __builtin_amdgcn_s_setprio(1); _Pragma("unroll") for (int m = 0; m < 4; ++m) _Pragma("unroll") for (int n = 0; n < 2; ++n) _Pragma("unroll") for (int k = 0; k < 2; ++k) \
        acc[ai][bj][m][n] = __builtin_amdgcn_mfma_f32_16x16x32_bf16(Bt[n][k], At[m][k], acc[ai][bj][m][n], 0, 0, 0); __builtin_amdgcn_s_setprio(0); } while (0)
#define PG8_WAIT_V(n) asm volatile("s_waitcnt vmcnt(" #n ")" ::: "memory")
#define PG8_WAIT_L(n) asm volatile("s_waitcnt lgkmcnt(" #n ")" ::: "memory")
#define PG8_BAR __builtin_amdgcn_s_barrier()
#define PG8_SCHED __builtin_amdgcn_sched_barrier(0)
    Unit cur, nxt; int ui = 0;
    if (!S.next(0, cur)) return;
    f32x4 acc[2][2][4][2];
#pragma unroll
    for (int a = 0; a < 2; ++a)
#pragma unroll
        for (int b = 0; b < 2; ++b)
#pragma unroll
            for (int m = 0; m < 4; ++m)
#pragma unroll
                for (int n = 0; n < 2; ++n) acc[a][b][m][n] = (f32x4){0.f, 0.f, 0.f, 0.f};
    bf16x8 At[4][2], B0[2][2], B1[2][2];
    const char* cA = (const char*)g.A + (size_t)cur.pm * tstep; const char* cB = (const char*)g.Bt + (size_t)cur.pn * tstep;
    S.a_ready(cur);
    PG8_STAGE(PG8_SB(0, 0), cB, voffB); PG8_STAGE(PG8_SA(0, 0), cA, voffA); PG8_STAGE(PG8_SB(0, 1), cB + hstep, voffB); PG8_STAGE(PG8_SA(0, 1), cA + hstep, voffA);
    if (wr == 1) PG8_BAR;
    PG8_WAIT_V(4); PG8_BAR;
    PG8_STAGE(PG8_SB(1, 0), cB + kstep, voffB); PG8_STAGE(PG8_SA(1, 0), cA + kstep, voffA); PG8_STAGE(PG8_SB(1, 1), cB + hstep + kstep, voffB);
    PG8_WAIT_V(6); PG8_BAR;
    PG8_STAMP();
    for (;;) {
        const bool has_next = S.next(ui + 1, nxt);
        const char* nA = has_next ? (const char*)g.A + (size_t)nxt.pm * tstep : cA; const char* nB = has_next ? (const char*)g.Bt + (size_t)nxt.pn * tstep : cB;
        for (int t = 0; t < nt; t += 2) {
            const bool last = (t == nt - 2);
            const char* a1 = cA + (size_t)(t + 1) * kstep;
            const char* a2 = last ? nA : cA + (size_t)(t + 2) * kstep; const char* b2 = last ? nB : cB + (size_t)(t + 2) * kstep;
            const char* a3 = a2 + kstep; const char* b3 = b2 + kstep;
            if (last && has_next) S.a_ready(nxt);
            PG8_LDB(B0, 0, 0); PG8_SCHED; PG8_LDA(At, 0, 0); PG8_STAGE(PG8_SA(1, 1), a1 + hstep, voffA);
            PG8_WAIT_L(8); PG8_BAR; PG8_WAIT_L(0); PG8_MMA(0, 0, At, B0); PG8_BAR; PG8_SCHED;
            PG8_LDB(B1, 0, 1); PG8_STAGE(PG8_SB(0, 0), b2, voffB);
            PG8_BAR; PG8_WAIT_L(0); PG8_MMA(0, 1, At, B1); PG8_BAR;
            PG8_LDA(At, 0, 1); PG8_STAGE(PG8_SA(0, 0), a2, voffA);
            PG8_BAR; PG8_WAIT_L(0); PG8_MMA(1, 0, At, B0); PG8_BAR; PG8_SCHED;
            PG8_STAGE(PG8_SB(0, 1), b2 + hstep, voffB);
            PG8_WAIT_V(6); PG8_BAR; PG8_MMA(1, 1, At, B1); PG8_BAR;
            PG8_LDB(B0, 1, 0); PG8_SCHED; PG8_LDA(At, 1, 0); PG8_STAGE(PG8_SA(0, 1), a2 + hstep, voffA);
            PG8_WAIT_L(8); PG8_BAR; PG8_WAIT_L(0); PG8_MMA(0, 0, At, B0); PG8_BAR; PG8_SCHED;
            PG8_LDB(B1, 1, 1); PG8_STAGE(PG8_SB(1, 0), b3, voffB);
            PG8_BAR; PG8_WAIT_L(0); PG8_MMA(0, 1, At, B1); PG8_BAR;
            PG8_LDA(At, 1, 1); PG8_STAGE(PG8_SA(1, 0), a3, voffA);
            PG8_BAR; PG8_WAIT_L(0); PG8_MMA(1, 0, At, B0); PG8_BAR; PG8_SCHED;
            PG8_STAGE(PG8_SB(1, 1), b3 + hstep, voffB);
            PG8_WAIT_V(6); PG8_BAR; PG8_MMA(1, 1, At, B1); PG8_BAR;
        }
        PG8_STAMP();
        if constexpr (!Epi::AFTER_DRAIN) { E(acc, cur, wr, wc, fr, fq); S.done(cur); }
        PG8_STAMP();
        if (!has_next) break;
#pragma unroll
        for (int a = 0; a < 2; ++a)
#pragma unroll
            for (int b = 0; b < 2; ++b)
#pragma unroll
                for (int m = 0; m < 4; ++m)
#pragma unroll
                    for (int n = 0; n < 2; ++n) acc[a][b][m][n] = (f32x4){0.f, 0.f, 0.f, 0.f};
        cur = nxt; cA = nA; cB = nB; ++ui;
    }
    PG8_WAIT_V(0);
    if (wr == 0) PG8_BAR;
    PG8_BAR;
    if constexpr (Epi::AFTER_DRAIN) { E.fused(acc, cur, wr, wc, fr, fq, lds, wid, lane); S.done(cur); }
    PG8_STAMP();
    if (STAMP && wid == 0) { stamps[lane] = lane < nts ? (((unsigned long long)(unsigned)ts_hi << 32) | (unsigned)ts_lo) : 0ull;
        if (lane == 62) stamps[62] = rt_entry; if (lane == 63) stamps[63] = (unsigned long long)wall_clock64(); }
#undef PG8_STAMP
#undef PG8_SA
#undef PG8_SB
#undef PG8_STAGE
#undef PG8_LDA
#undef PG8_LDB
#undef PG8_MMA
#undef PG8_WAIT_V
#undef PG8_WAIT_L
#undef PG8_BAR
#undef PG8_SCHED
}
}

namespace mk {
using pg8::bf16_t; using pg8::bf16x8; using pg8::f32x4; using pg8::u32x4; using pg8::Unit; using pg8::cvt_pk_bf16; using pg8::cvt_pk_native; using pg8::mfma_settle;
typedef unsigned u32x2 __attribute__((ext_vector_type(2)));
typedef float f32x2 __attribute__((ext_vector_type(2)));
constexpr int D = 2048, TL = 16384, TC = 256, MT = TL + TC, NCH = MT / 128;
constexpr int NPROJ = 10496, DFF = 5632;
constexpr size_t MiB = 1u << 20;
constexpr size_t WS_MVEC = 0, WS_CHD = 256 * 1024, WS_BAR = 512 * 1024, WS_S5LOC = 1 * MiB, WS_WA = 10 * MiB, WS_WB = 75 * MiB, WS_HCTX = 141 * MiB, WS_XM = 143 * MiB, WS_SST = 208 * MiB, WS_BIG = 338 * MiB, WS_S5IN = 766 * MiB, WS_END = 775 * MiB;
constexpr size_t B_U5 = 0, B_XBC = B_U5 + (size_t)MT * 1024 * 2, B_Z = B_XBC + (size_t)MT * 3072 * 2, B_GATE = B_Z + (size_t)MT * 2048 * 2, B_DT = B_GATE + (size_t)MT * 4096 * 2,
                 B_Y5 = 330 * MiB, B_YD = B_Y5 + (size_t)MT * 1024 * 2;
static_assert(B_DT + (size_t)MT * 64 * 4 <= B_Y5 && B_YD + (size_t)MT * 2048 * 2 <= 428 * MiB, "big map");
constexpr size_t B_G = 0, B_V = (size_t)MT * DFF * 2;
constexpr size_t WA_IN = 0, WA_GLU = 41 * MiB, WA_S5P = 45 * MiB, WA_SSDP = 49 * MiB, WA_WOUT = 57 * MiB, WB_UP = 0, WB_DOWN = 44 * MiB;
constexpr int LDS_BYTES = 163840;
constexpr float ALPHA = 1.41421356237f, LN_EPS = 1e-5f, RMS_EPS = 1e-5f;

struct Args { const float* in[33]; float* out; unsigned char* ws; int ph_lo, ph_hi; };

__device__ __forceinline__ float bf2f(unsigned b) { return __uint_as_float(b << 16); }
__device__ __forceinline__ float bflo(unsigned w) { return __uint_as_float(w << 16); }
__device__ __forceinline__ float bfhi(unsigned w) { return __uint_as_float(w & 0xffff0000u); }
__device__ __forceinline__ float sigm(float x) { return __builtin_amdgcn_rcpf(1.f + __expf(-x)); }
__device__ __forceinline__ float silu_(float x) { return x * __builtin_amdgcn_rcpf(1.f + __expf(-x)); }
__device__ __forceinline__ float gelu_tanh(float x) { const float u = 0.7978845608028654f * (x + 0.044715f * x * x * x); const float th = 1.f - 2.f * __builtin_amdgcn_rcpf(__expf(2.f * u) + 1.f); return 0.5f * x * (1.f + th); }
__device__ __forceinline__ bf16x8 mkfrag(unsigned a, unsigned b, unsigned c, unsigned d) { u32x4 v; v.x = a; v.y = b; v.z = c; v.w = d; return __builtin_bit_cast(bf16x8, v); }
__device__ __forceinline__ float* hrow(const Args& a, int row) { return row < TL ? a.out + (size_t)row * D : (float*)(a.ws + WS_HCTX) + (size_t)(row - TL) * D; }
__device__ __forceinline__ const float* mvec(const Args& a, int layer, int isctx) { return (const float*)(a.ws + WS_MVEC) + (size_t)(layer * 2 + isctx) * 12288; }

struct EpiInProj {
    static constexpr bool PERM = true, AFTER_DRAIN = false;
    unsigned char* big; const float* dt_bias;
    __device__ __forceinline__ void operator()(const f32x4 (&acc)[2][2][4][2], const Unit& u, int wr, int wc, int fr, int fq) const {
        mfma_settle(acc[1][1][3][1]); mfma_settle(acc[1][1][3][0]);
        const int row0 = u.pm * 256 + wr * 64 + fr, ct = u.pn * 256;
        if (ct >= 10240) {
            if (wc < 2) { const int cc = wc * 32 + 8 * fq; float* DT = (float*)(big + B_DT);
                const f32x4 b0 = *(const f32x4*)(dt_bias + cc), b1 = *(const f32x4*)(dt_bias + cc + 4);
#pragma unroll
                for (int ai = 0; ai < 2; ++ai)
#pragma unroll
                    for (int m = 0; m < 4; ++m) { float* rp = DT + (size_t)(row0 + ai * 128 + m * 16) * 64 + cc; f32x4 v0 = acc[ai][0][m][0] + b0, v1 = acc[ai][0][m][1] + b1;
#pragma unroll
                        for (int j = 0; j < 4; ++j) { v0[j] = v0[j] > 20.f ? v0[j] : log1pf(expf(v0[j])); v1[j] = v1[j] > 20.f ? v1[j] : log1pf(expf(v1[j])); }
                        *(f32x4*)rp = v0; *(f32x4*)(rp + 4) = v1; } }
            return;
        }
        bf16_t* base; int ld, c0; bool sg = false;
        if (ct < 1024) { base = (bf16_t*)(big + B_U5); ld = 1024; c0 = ct; }
        else if (ct < 4096) { base = (bf16_t*)(big + B_XBC); ld = 3072; c0 = ct - 1024; }
        else if (ct < 6144) { base = (bf16_t*)(big + B_Z); ld = 2048; c0 = ct - 4096; }
        else { base = (bf16_t*)(big + B_GATE); ld = 4096; c0 = ct - 6144; sg = true; }
        const int col0 = c0 + wc * 32 + 8 * fq;
#pragma unroll
        for (int ai = 0; ai < 2; ++ai)
#pragma unroll
            for (int m = 0; m < 4; ++m) { bf16_t* rowp = base + (size_t)(row0 + ai * 128 + m * 16) * ld + col0;
#pragma unroll
                for (int bj = 0; bj < 2; ++bj) { f32x4 v0 = acc[ai][bj][m][0], v1 = acc[ai][bj][m][1];
                    if (sg) {
#pragma unroll
                        for (int j = 0; j < 4; ++j) { v0[j] = sigm(v0[j]); v1[j] = sigm(v1[j]); } }
                    u32x4 w; w.x = cvt_pk_native(v0[0], v0[1]); w.y = cvt_pk_native(v0[2], v0[3]); w.z = cvt_pk_native(v1[0], v1[1]); w.w = cvt_pk_native(v1[2], v1[3]);
                    *(u32x4*)(rowp + bj * 128) = w; } }
    }
};
struct EpiGlu {
    static constexpr bool PERM = true, AFTER_DRAIN = false;
    bf16_t* O;
    __device__ __forceinline__ void operator()(const f32x4 (&acc)[2][2][4][2], const Unit& u, int wr, int wc, int fr, int fq) const {
        mfma_settle(acc[1][1][3][1]); mfma_settle(acc[1][1][3][0]);
        const int row0 = u.pm * 256 + wr * 64 + fr, col0 = u.pn * 128 + wc * 32 + 8 * fq;
#pragma unroll
        for (int ai = 0; ai < 2; ++ai)
#pragma unroll
            for (int m = 0; m < 4; ++m) { f32x4 v0 = acc[ai][0][m][0], v1 = acc[ai][0][m][1]; const f32x4 g0 = acc[ai][1][m][0], g1 = acc[ai][1][m][1];
#pragma unroll
                for (int j = 0; j < 4; ++j) { v0[j] *= sigm(g0[j]); v1[j] *= sigm(g1[j]); }
                u32x4 w; w.x = cvt_pk_bf16(v0[0], v0[1]); w.y = cvt_pk_bf16(v0[2], v0[3]); w.z = cvt_pk_bf16(v1[0], v1[1]); w.w = cvt_pk_bf16(v1[2], v1[3]);
                *(u32x4*)(O + (size_t)(row0 + ai * 128 + m * 16) * 1024 + col0) = w; }
    }
};
template <int SECOND, int GSEL = SECOND> struct EpiMerge {
    static constexpr bool PERM = true, AFTER_DRAIN = false;
    bf16_t* MG; const bf16_t* GATE;
    __device__ __forceinline__ void operator()(const f32x4 (&acc)[2][2][4][2], const Unit& u, int wr, int wc, int fr, int fq) const {
        mfma_settle(acc[1][1][3][1]); mfma_settle(acc[1][1][3][0]);
        const int row0 = u.pm * 256 + wr * 64 + fr, col0 = u.pn * 256 + wc * 32 + 8 * fq;
#pragma unroll
        for (int ai = 0; ai < 2; ++ai)
#pragma unroll
            for (int m = 0; m < 4; ++m) { const size_t r = (size_t)(row0 + ai * 128 + m * 16); u32x4 gg[2], oo[2];
#pragma unroll
                for (int bj = 0; bj < 2; ++bj) { const int c = col0 + bj * 128; gg[bj] = *(const u32x4*)(GATE + r * 4096 + (GSEL ? 2048 : 0) + c); if (SECOND) oo[bj] = *(const u32x4*)(MG + r * 2048 + c); }
                __builtin_amdgcn_sched_barrier(0);
#pragma unroll
                for (int bj = 0; bj < 2; ++bj) { const int c = col0 + bj * 128; const u32x4 g = gg[bj];
                    f32x4 v0 = acc[ai][bj][m][0], v1 = acc[ai][bj][m][1];
                    v0[0] *= bflo(g.x); v0[1] *= bfhi(g.x); v0[2] *= bflo(g.y); v0[3] *= bfhi(g.y); v1[0] *= bflo(g.z); v1[1] *= bfhi(g.z); v1[2] *= bflo(g.w); v1[3] *= bfhi(g.w);
                    if (SECOND) { const u32x4 o = oo[bj];
                        v0[0] += bflo(o.x); v0[1] += bfhi(o.x); v0[2] += bflo(o.y); v0[3] += bfhi(o.y); v1[0] += bflo(o.z); v1[1] += bfhi(o.z); v1[2] += bflo(o.w); v1[3] += bfhi(o.w); }
                    u32x4 w; w.x = cvt_pk_bf16(v0[0], v0[1]); w.y = cvt_pk_bf16(v0[2], v0[3]); w.z = cvt_pk_bf16(v1[0], v1[1]); w.w = cvt_pk_bf16(v1[2], v1[3]);
                    *(u32x4*)(MG + r * 2048 + c) = w; }
                __builtin_amdgcn_sched_barrier(0); }
    }
};
struct EpiResid {
    static constexpr bool PERM = false, AFTER_DRAIN = false;
    float* out; float* hctx; const float* glat; const float* gctx;
    __device__ __forceinline__ void operator()(const f32x4 (&acc)[2][2][4][2], const Unit& u, int wr, int wc, int fr, int fq) const {
        mfma_settle(acc[1][1][3][1]); mfma_settle(acc[1][1][3][0]);
        const bool isctx = u.pm >= 64; const float* g = isctx ? gctx : glat;
        float* hb = isctx ? hctx + (size_t)(wr * 64 + fr) * D : out + (size_t)(u.pm * 256 + wr * 64 + fr) * D;
        const int col0 = u.pn * 256 + wc * 32 + 4 * fq;
        f32x4 gv[2][2];
#pragma unroll
        for (int bj = 0; bj < 2; ++bj)
#pragma unroll
            for (int n = 0; n < 2; ++n) gv[bj][n] = *(const f32x4*)(g + col0 + bj * 128 + n * 16);
#pragma unroll
        for (int ai = 0; ai < 2; ++ai)
#pragma unroll
            for (int m = 0; m < 4; ++m) { float* rowp = hb + (size_t)(ai * 128 + m * 16) * D + col0;
#pragma unroll
                for (int bj = 0; bj < 2; ++bj) { f32x4 h[2];
#pragma unroll
                    for (int n = 0; n < 2; ++n) h[n] = *(const f32x4*)(rowp + bj * 128 + n * 16);
                    __builtin_amdgcn_sched_barrier(0);
#pragma unroll
                    for (int n = 0; n < 2; ++n) *(f32x4*)(rowp + bj * 128 + n * 16) = h[n] * ALPHA + gv[bj][n] * acc[ai][bj][m][n];
                    __builtin_amdgcn_sched_barrier(0); } }
    }
};
struct EpiUp {
    static constexpr bool PERM = true, AFTER_DRAIN = false;
    bf16_t* G; bf16_t* V;
    __device__ __forceinline__ void operator()(const f32x4 (&acc)[2][2][4][2], const Unit& u, int wr, int wc, int fr, int fq) const {
        mfma_settle(acc[1][1][3][1]); mfma_settle(acc[1][1][3][0]);
        const int row0 = u.pm * 256 + wr * 64 + fr; int ct = u.pn * 256; bf16_t* base = G; if (ct >= DFF) { base = V; ct -= DFF; }
        const int col0 = ct + wc * 32 + 8 * fq;
#pragma unroll
        for (int ai = 0; ai < 2; ++ai)
#pragma unroll
            for (int m = 0; m < 4; ++m) { bf16_t* rowp = base + (size_t)(row0 + ai * 128 + m * 16) * DFF + col0;
#pragma unroll
                for (int bj = 0; bj < 2; ++bj) { const f32x4 v0 = acc[ai][bj][m][0], v1 = acc[ai][bj][m][1];
                    u32x4 w; w.x = cvt_pk_native(v0[0], v0[1]); w.y = cvt_pk_native(v0[2], v0[3]); w.z = cvt_pk_native(v1[0], v1[1]); w.w = cvt_pk_native(v1[2], v1[3]);
                    *(u32x4*)(rowp + bj * 128) = w; } }
    }
};

struct XItem { const float* W; bf16_t* WT; int K, N, d0, s0, k0; };
__device__ __forceinline__ void xpose_load(const XItem& x, float (&v)[32], int lane) {
#pragma unroll
    for (int i = 0; i < 32; ++i) { const int kk = 2 * i + (lane >> 5); v[i] = x.s0 >= 0 ? x.W[(size_t)(x.k0 + kk) * x.N + x.s0 + (lane & 31)] : 0.f; }
}
__device__ __forceinline__ void xpose_store(const XItem& x, const float (&v)[32], float* scr, int lane) {
#pragma unroll
    for (int i = 0; i < 32; ++i) { const int kk = 2 * i + (lane >> 5); scr[kk * 33 + (lane & 31)] = v[i]; }
    asm volatile("s_waitcnt lgkmcnt(0)" ::: "memory");
    const int c = lane & 7;
#pragma unroll
    for (int j = 0; j < 4; ++j) { const int n = (lane >> 3) + 8 * j; const float* sp = scr + (8 * c) * 33 + n;
        u32x4 o; o.x = cvt_pk_bf16(sp[0 * 33], sp[1 * 33]); o.y = cvt_pk_bf16(sp[2 * 33], sp[3 * 33]); o.z = cvt_pk_bf16(sp[4 * 33], sp[5 * 33]); o.w = cvt_pk_bf16(sp[6 * 33], sp[7 * 33]);
        *(u32x4*)(x.WT + (size_t)(x.d0 + n) * x.K + x.k0 + 8 * c) = o; }
    asm volatile("s_waitcnt lgkmcnt(0)" ::: "memory");
}
__device__ __forceinline__ XItem xpose_decode(const Args& a, int layer, int region, int r) {
    XItem x;
    if (region == 0) {
        bf16_t* WA = (bf16_t*)(a.ws + WS_WA);
        constexpr int I_IN = 32 * 328, I_GLU = 16 * 64, I_S5P = 16 * 64, I_SSDP = 32 * 64;
        if (r < I_IN) { const int kb = r / 328, d0 = (r % 328) * 32; int s0; if (d0 < 4096) s0 = d0; else if (d0 < 10240) s0 = d0 + 64; else if (d0 < 10304) s0 = d0 - 10240 + 4096; else s0 = -1;
            x.W = a.in[6] + (size_t)layer * 2048 * 10304; x.WT = WA + WA_IN / 2; x.K = 2048; x.N = 10304; x.d0 = d0; x.s0 = s0; x.k0 = kb * 64; return x; } r -= I_IN;
        if (r < I_GLU) { const int kb = r / 64, d0 = (r % 64) * 32, t = d0 >> 8, j = d0 & 255;
            x.W = a.in[15] + (size_t)layer * 1024 * 2048; x.WT = WA + WA_GLU / 2; x.K = 1024; x.N = 2048; x.d0 = d0; x.s0 = j < 128 ? t * 128 + j : 1024 + t * 128 + (j - 128); x.k0 = kb * 64; return x; } r -= I_GLU;
        if (r < I_S5P) { x.W = a.in[16] + (size_t)layer * 1024 * 2048; x.WT = WA + WA_S5P / 2; x.K = 1024; x.N = 2048; x.d0 = (r % 64) * 32; x.s0 = x.d0; x.k0 = (r / 64) * 64; return x; } r -= I_S5P;
        if (r < I_SSDP) { x.W = a.in[23] + (size_t)layer * 2048 * 2048; x.WT = WA + WA_SSDP / 2; x.K = 2048; x.N = 2048; x.d0 = (r % 64) * 32; x.s0 = x.d0; x.k0 = (r / 64) * 64; return x; } r -= I_SSDP;
        x.W = a.in[24] + (size_t)layer * 2048 * 2048; x.WT = WA + WA_WOUT / 2; x.K = 2048; x.N = 2048; x.d0 = (r % 64) * 32; x.s0 = x.d0; x.k0 = (r / 64) * 64; return x;
    }
    bf16_t* WB = (bf16_t*)(a.ws + WS_WB); constexpr int I_UP = 32 * 352;
    if (r < I_UP) { x.W = a.in[27] + (size_t)layer * 2048 * 11264; x.WT = WB + WB_UP / 2; x.K = 2048; x.N = 11264; x.d0 = (r % 352) * 32; x.s0 = x.d0; x.k0 = (r / 352) * 64; return x; } r -= I_UP;
    x.W = a.in[30] + (size_t)layer * 5632 * 2048; x.WT = WB + WB_DOWN / 2; x.K = 5632; x.N = 2048; x.d0 = (r % 64) * 32; x.s0 = x.d0; x.k0 = (r / 64) * 64; return x;
}
__device__ __forceinline__ void xpose_region(const Args& a, int layer, int region, float* scr, int gw, int NGW, int lane) {
    const int NI = region == 0 ? (32 * 328 + 16 * 64 + 16 * 64 + 32 * 64 + 32 * 64) : (32 * 352 + 88 * 64);
    int it = gw;
    for (; it + 3 * NGW < NI; it += 4 * NGW) {
        const XItem x0 = xpose_decode(a, layer, region, it), x1 = xpose_decode(a, layer, region, it + NGW), x2 = xpose_decode(a, layer, region, it + 2 * NGW), x3 = xpose_decode(a, layer, region, it + 3 * NGW);
        float v0[32], v1[32], v2[32], v3[32]; xpose_load(x0, v0, lane); xpose_load(x1, v1, lane); xpose_load(x2, v2, lane); xpose_load(x3, v3, lane);
        xpose_store(x0, v0, scr, lane); xpose_store(x1, v1, scr, lane); xpose_store(x2, v2, scr, lane); xpose_store(x3, v3, scr, lane);
    }
    for (; it < NI; it += NGW) { const XItem x0 = xpose_decode(a, layer, region, it); float v0[32]; xpose_load(x0, v0, lane); xpose_store(x0, v0, scr, lane); }
}

__device__ __forceinline__ void adaln_phase(const Args& a, float* lds, int tid) {
    float* sc = lds; float* scx = lds + 2048; float* red = lds + 4096;
    for (int i = tid; i < 2048; i += 512) { sc[i] = silu_(a.in[1][i]); scx[i] = silu_(a.in[3][i]); }
    __syncthreads();
    for (int unit = blockIdx.x; unit < 256; unit += gridDim.x) {
        const int layer = unit >> 7, col0 = (unit & 127) * 96;
        const float* W = a.in[4] + (size_t)layer * 2048 * 12288 + col0;
        if (tid < 504) { const int cq = tid % 24, ks = tid / 24; f32x4 al = {0.f, 0.f, 0.f, 0.f}, ac = {0.f, 0.f, 0.f, 0.f};
#pragma unroll 14
            for (int k = ks; k < 2048; k += 21) { const f32x4 w = *(const f32x4*)(W + (size_t)k * 12288 + cq * 4); al += w * sc[k]; ac += w * scx[k]; }
            *(f32x4*)(red + (ks * 2 + 0) * 96 + cq * 4) = al; *(f32x4*)(red + (ks * 2 + 1) * 96 + cq * 4) = ac; }
        __syncthreads();
        if (tid < 192) { const int v = tid / 96, c = tid % 96; float s = 0.f; for (int ks = 0; ks < 21; ++ks) s += red[(ks * 2 + v) * 96 + c];
            ((float*)(a.ws + WS_MVEC))[(size_t)(layer * 2 + v) * 12288 + col0 + c] = s + a.in[5][(size_t)layer * 12288 + col0 + c]; }
        __syncthreads();
    }
}

__device__ __forceinline__ float wave_sum(float v) {
#pragma unroll
    for (int o = 1; o < 64; o <<= 1) v += __shfl_xor(v, o);
    return v;
}
template <int MODE> __device__ __forceinline__ void row_phase(const Args& a, int nrows, const float* lng, const float* lnb, int mod_layer, int mod_off, int gw, int NGW, int lane) {
    bf16_t* XM = (bf16_t*)(a.ws + WS_XM);
    for (int row0 = gw; row0 < nrows; row0 += 2 * NGW) {
        const int row1 = row0 + NGW < nrows ? row0 + NGW : row0;
        const int rows[2] = {row0, row1}; f32x4 v[2][8];
#pragma unroll
        for (int u = 0; u < 2; ++u) { const int row = rows[u]; const int isctx = row >= TL;
            const float* src = MODE == 0 ? (isctx ? a.in[2] + (size_t)(row - TL) * D : a.in[0] + (size_t)row * D) : hrow(a, row);
#pragma unroll
            for (int j = 0; j < 8; ++j) v[u][j] = *(const f32x4*)(src + 4 * lane + 256 * j); }
        if (MODE == 1) {
            float s[2], q[2];
#pragma unroll
            for (int u = 0; u < 2; ++u) { s[u] = 0.f;
#pragma unroll
                for (int j = 0; j < 8; ++j) s[u] += (v[u][j][0] + v[u][j][1]) + (v[u][j][2] + v[u][j][3]); }
            s[0] = wave_sum(s[0]); s[1] = wave_sum(s[1]);
#pragma unroll
            for (int u = 0; u < 2; ++u) { const float mean = s[u] * (1.f / D); q[u] = 0.f;
#pragma unroll
                for (int j = 0; j < 8; ++j) { v[u][j] = v[u][j] - mean; q[u] += (v[u][j][0] * v[u][j][0] + v[u][j][1] * v[u][j][1]) + (v[u][j][2] * v[u][j][2] + v[u][j][3] * v[u][j][3]); } }
            q[0] = wave_sum(q[0]); q[1] = wave_sum(q[1]);
#pragma unroll
            for (int u = 0; u < 2; ++u) { const float rstd = __builtin_amdgcn_rsqf(q[u] * (1.f / D) + LN_EPS);
#pragma unroll
                for (int j = 0; j < 8; ++j) { const f32x4 g = *(const f32x4*)(lng + 4 * lane + 256 * j), b = *(const f32x4*)(lnb + 4 * lane + 256 * j); v[u][j] = v[u][j] * rstd * g + b; } }
        }
#pragma unroll
        for (int u = 0; u < 2; ++u) { const int row = rows[u]; const int isctx = row >= TL; float* h = hrow(a, row);
#pragma unroll
            for (int j = 0; j < 8; ++j) *(f32x4*)(h + 4 * lane + 256 * j) = v[u][j];
            if (mod_layer >= 0) { const float* m = mvec(a, mod_layer, isctx) + mod_off;
#pragma unroll
                for (int j = 0; j < 8; ++j) { const f32x4 sh = *(const f32x4*)(m + 4 * lane + 256 * j), scl = *(const f32x4*)(m + D + 4 * lane + 256 * j); const f32x4 o = v[u][j] * (scl + 1.f) + sh;
                    u32x2 w; w.x = cvt_pk_bf16(o[0], o[1]); w.y = cvt_pk_bf16(o[2], o[3]); *(u32x2*)(XM + (size_t)row * D + 4 * lane + 256 * j) = w; } } }
    }
}

__device__ __forceinline__ void ffnconv_ctx(const Args& a, int layer, int tid) {
    const bf16_t* G = (const bf16_t*)(a.ws + WS_BIG + B_G); bf16_t* V = (bf16_t*)(a.ws + WS_BIG + B_V);
    const float* cw = a.in[28] + (size_t)layer * 9 * DFF; const float* cb = a.in[29] + (size_t)layer * DFF;
    const int nunits = 260 * 11; const int oc = tid & 63, xs = tid >> 6;
    for (int unit = 256 * 11 + blockIdx.x; unit < nunits; unit += gridDim.x) {
        const int seg = unit / 11, ob = unit % 11, ch0 = ob * 512 + oc * 8; const bool cs = seg >= 256; const int t0 = seg * 64;
        float w[9][8], bias[8];
#pragma unroll
        for (int k = 0; k < 9; ++k) { const f32x4 w0 = *(const f32x4*)(cw + (size_t)k * DFF + ch0), w1 = *(const f32x4*)(cw + (size_t)k * DFF + ch0 + 4);
            w[k][0] = w0[0]; w[k][1] = w0[1]; w[k][2] = w0[2]; w[k][3] = w0[3]; w[k][4] = w1[0]; w[k][5] = w1[1]; w[k][6] = w1[2]; w[k][7] = w1[3]; }
        { const f32x4 b0 = *(const f32x4*)(cb + ch0), b1 = *(const f32x4*)(cb + ch0 + 4); bias[0] = b0[0]; bias[1] = b0[1]; bias[2] = b0[2]; bias[3] = b0[3]; bias[4] = b1[0]; bias[5] = b1[1]; bias[6] = b1[2]; bias[7] = b1[3]; }
#pragma unroll 4
        for (int xi = 0; xi < 8; ++xi) { const int x = xs * 8 + xi, t = t0 + x; float acc[8];
#pragma unroll
            for (int k = 0; k < 8; ++k) acc[k] = bias[k];
#pragma unroll
            for (int dy = -1; dy <= 1; ++dy) { bool rok = cs ? (dy == 0) : ((dy < 0 ? seg > 0 : true) && (dy > 0 ? seg < 255 : true));
#pragma unroll
                for (int dx = -1; dx <= 1; ++dx) { const bool ok = rok && (cs ? (t + dx >= TL && t + dx < MT) : (x + dx >= 0 && x + dx < 64));
                    if (ok) { const u32x4 g = *(const u32x4*)(G + (size_t)(t + dy * 64 + dx) * DFF + ch0); const int k = (dy + 1) * 3 + dx + 1;
                        acc[0] += w[k][0] * bflo(g.x); acc[1] += w[k][1] * bfhi(g.x); acc[2] += w[k][2] * bflo(g.y); acc[3] += w[k][3] * bfhi(g.y);
                        acc[4] += w[k][4] * bflo(g.z); acc[5] += w[k][5] * bfhi(g.z); acc[6] += w[k][6] * bflo(g.w); acc[7] += w[k][7] * bfhi(g.w); } } }
            bf16_t* vp = V + (size_t)t * DFF + ch0; const u32x4 vv = *(const u32x4*)vp;
            u32x4 o; o.x = cvt_pk_bf16(silu_(acc[0]) * bflo(vv.x), silu_(acc[1]) * bfhi(vv.x)); o.y = cvt_pk_bf16(silu_(acc[2]) * bflo(vv.y), silu_(acc[3]) * bfhi(vv.y));
            o.z = cvt_pk_bf16(silu_(acc[4]) * bflo(vv.z), silu_(acc[5]) * bfhi(vv.z)); o.w = cvt_pk_bf16(silu_(acc[6]) * bflo(vv.w), silu_(acc[7]) * bfhi(vv.w));
            *(u32x4*)vp = o; }
    }
}

__device__ __forceinline__ void ffnconv_phase(const Args& a, int layer, bool with_ctx, unsigned char* lds, int tid) {
    const bf16_t* G = (const bf16_t*)(a.ws + WS_BIG + B_G); bf16_t* V = (bf16_t*)(a.ws + WS_BIG + B_V);
    const float* cw = a.in[28] + (size_t)layer * 9 * DFF; const float* cb = a.in[29] + (size_t)layer * DFF;
    bf16_t* T = (bf16_t*)lds;
    const int oc = tid & 15, ts = tid >> 4;
    u32x4 gn[12];
#define FFC_PREFETCH(unit_) do { const int rg_ = (unit_) / 44, ch_ = ((unit_) % 44) * 128 + oc * 8, y0_ = rg_ * 4; \
        _Pragma("unroll") for (int i = 0; i < 12; ++i) { const int idx = tid + i * 512, r = idx >> 10, x = (idx >> 4) & 63, y = y0_ - 1 + r; const bool ok = y >= 0 && y < 256; \
            gn[i] = *(const u32x4*)(G + (size_t)((ok ? y : y0_) * 64 + x) * DFF + ch_); } } while (0)
    int unit = blockIdx.x;
    if (unit < 64 * 44) FFC_PREFETCH(unit);
    for (; unit < 64 * 44; unit += gridDim.x) {
        const int rg = unit / 44, ch0 = (unit % 44) * 128 + oc * 8, y0 = rg * 4;
        __syncthreads();
#pragma unroll
        for (int i = 0; i < 12; ++i) { const int idx = tid + i * 512, r = idx >> 10, x = (idx >> 4) & 63, y = y0 - 1 + r; const bool ok = y >= 0 && y < 256;
            *(u32x4*)(T + ((r * 64 + x) * 128 + oc * 8)) = ok ? gn[i] : (u32x4){0u, 0u, 0u, 0u}; }
        u32x4 vv[8];
#pragma unroll
        for (int o = 0; o < 8; ++o) vv[o] = *(const u32x4*)(V + (size_t)((y0 + (o >> 1)) * 64 + ts * 2 + (o & 1)) * DFF + ch0);
        float w[9][8], bias[8];
#pragma unroll
        for (int k = 0; k < 9; ++k) { const f32x4 w0 = *(const f32x4*)(cw + (size_t)k * DFF + ch0), w1 = *(const f32x4*)(cw + (size_t)k * DFF + ch0 + 4);
            w[k][0] = w0[0]; w[k][1] = w0[1]; w[k][2] = w0[2]; w[k][3] = w0[3]; w[k][4] = w1[0]; w[k][5] = w1[1]; w[k][6] = w1[2]; w[k][7] = w1[3]; }
        { const f32x4 b0 = *(const f32x4*)(cb + ch0), b1 = *(const f32x4*)(cb + ch0 + 4); bias[0] = b0[0]; bias[1] = b0[1]; bias[2] = b0[2]; bias[3] = b0[3]; bias[4] = b1[0]; bias[5] = b1[1]; bias[6] = b1[2]; bias[7] = b1[3]; }
        __syncthreads();
        __builtin_amdgcn_sched_barrier(0);
        if (unit + (int)gridDim.x < 64 * 44) FFC_PREFETCH(unit + (int)gridDim.x);
        __builtin_amdgcn_sched_barrier(0);
#pragma unroll
        for (int o = 0; o < 8; ++o) { const int rr = o >> 1, x = ts * 2 + (o & 1); float acc[8];
#pragma unroll
            for (int k = 0; k < 8; ++k) acc[k] = bias[k];
#pragma unroll
            for (int dy = -1; dy <= 1; ++dy)
#pragma unroll
                for (int dx = -1; dx <= 1; ++dx) { const int xn = x + dx; const bool ok = xn >= 0 && xn < 64;
                    u32x4 g = *(const u32x4*)(T + (((rr + 1 + dy) * 64 + (ok ? xn : x)) * 128 + oc * 8)); if (!ok) g = (u32x4){0u, 0u, 0u, 0u}; const int k = (dy + 1) * 3 + dx + 1;
                    acc[0] += w[k][0] * bflo(g.x); acc[1] += w[k][1] * bfhi(g.x); acc[2] += w[k][2] * bflo(g.y); acc[3] += w[k][3] * bfhi(g.y);
                    acc[4] += w[k][4] * bflo(g.z); acc[5] += w[k][5] * bfhi(g.z); acc[6] += w[k][6] * bflo(g.w); acc[7] += w[k][7] * bfhi(g.w); }
            const u32x4 v = vv[o];
            u32x4 q; q.x = cvt_pk_bf16(silu_(acc[0]) * bflo(v.x), silu_(acc[1]) * bfhi(v.x)); q.y = cvt_pk_bf16(silu_(acc[2]) * bflo(v.y), silu_(acc[3]) * bfhi(v.y));
            q.z = cvt_pk_bf16(silu_(acc[4]) * bflo(v.z), silu_(acc[5]) * bfhi(v.z)); q.w = cvt_pk_bf16(silu_(acc[6]) * bflo(v.w), silu_(acc[7]) * bfhi(v.w));
            *(u32x4*)(V + (size_t)((y0 + rr) * 64 + x) * DFF + ch0) = q; }
    }
#undef FFC_PREFETCH
    __syncthreads();
    if (with_ctx) ffnconv_ctx(a, layer, tid);
}
__device__ __forceinline__ int s5_chunk_at(int dir, int q) { return dir ? 129 - q : (q + 128) % 130; }
__device__ __forceinline__ int s5_pos_of(int dir, int c) { return dir ? 129 - c : (c + 2) % 130; }
template <int PASS> __device__ __forceinline__ void s5_phase(const Args& a, int layer, unsigned char* lds, int tid, int nchunks) {
    constexpr int BUP = 132;
    const bf16_t* U5 = (const bf16_t*)(a.ws + WS_BIG + B_U5); bf16_t* Y5 = (bf16_t*)(a.ws + WS_BIG + B_Y5);
    float2* S5LOC = (float2*)(a.ws + WS_S5LOC);
    const int lane = tid & 63, w = tid >> 6, gl = w >> 1, dir = w & 1, p = lane, fr = lane & 15, fq = lane >> 4;
    float* BuW = (float*)lds + (size_t)w * (16 * BUP);
    bf16_t* STw = (bf16_t*)(lds + 67584) + (size_t)w * (16 * 136);
    float* YL = (float*)(lds + 102400);
    const int gq = blockIdx.x & 15, g = gq * 4 + gl;
    float ab_re, ab_im, a128r, a128i;
    const float step = expf(a.in[9][(size_t)(layer * 2 + dir) * 64 + g]);
    { const size_t pi = ((size_t)(layer * 2 + dir) * 64 + g) * 64 + p; const float lre = fminf(a.in[7][pi], -1e-4f), lim = a.in[8][pi];
      const float mag = expf(lre * step); float sn, cs; sincosf(lim * step, &sn, &cs); ab_re = mag * cs; ab_im = mag * sn; a128r = ab_re; a128i = ab_im;
#pragma unroll
      for (int k = 0; k < 7; ++k) { const float r = a128r * a128r - a128i * a128i, i = 2.f * a128r * a128i; a128r = r; a128i = i; } }
    bf16x8 bbf[8];
#pragma unroll
    for (int nt = 0; nt < 8; ++nt) { const int pp = nt * 8 + (fr >> 1), cc = fr & 1; const size_t pi = ((size_t)(layer * 2 + dir) * 64 + g) * 64 + pp;
        const float lre = fminf(a.in[7][pi], -1e-4f), lim = a.in[8][pi]; const float mag = expf(lre * step); float sn, cs; sincosf(lim * step, &sn, &cs);
        const float are = mag * cs, aim = mag * sn, den = lre * lre + lim * lim, q_re = ((are - 1.f) * lre + aim * lim) / den, q_im = (aim * lre - (are - 1.f) * lim) / den;
        const float* br = a.in[10] + (((size_t)layer * 64 + g) * 64 + pp) * 16 + (fq & 1) * 8; const float* bi = a.in[11] + (((size_t)layer * 64 + g) * 64 + pp) * 16 + (fq & 1) * 8;
        const f32x4 r0 = *(const f32x4*)br, r1 = *(const f32x4*)(br + 4), i0 = *(const f32x4*)bi, i1 = *(const f32x4*)(bi + 4); float v[8];
#pragma unroll
        for (int j = 0; j < 8; ++j) { const float r = j < 4 ? r0[j & 3] : r1[j & 3], i = j < 4 ? i0[j & 3] : i1[j & 3]; v[j] = fq < 2 ? (cc ? q_re * i + q_im * r : q_re * r - q_im * i) : 0.f; }
        bbf[nt] = mkfrag(cvt_pk_bf16(v[0], v[1]), cvt_pk_bf16(v[2], v[3]), cvt_pk_bf16(v[4], v[5]), cvt_pk_bf16(v[6], v[7])); }
    bf16x8 cm[4];
    if (PASS == 1) {
        const float* cre = a.in[12] + (((size_t)(layer * 2 + dir) * 64 + g) * 16 + fr) * 64; const float* cim = a.in[13] + (((size_t)(layer * 2 + dir) * 64 + g) * 16 + fr) * 64;
#pragma unroll
        for (int ks = 0; ks < 4; ++ks) { const f32x4 r = *(const f32x4*)(cre + ks * 16 + fq * 4), i = *(const f32x4*)(cim + ks * 16 + fq * 4);
            cm[ks] = mkfrag(cvt_pk_bf16(r[0], -i[0]), cvt_pk_bf16(r[1], -i[1]), cvt_pk_bf16(r[2], -i[2]), cvt_pk_bf16(r[3], -i[3])); }
    }
    const int cstep = gridDim.x >> 4;
    float2* S5IN = (float2*)(a.ws + WS_S5IN);
    if (PASS == 1) {
        float sr = 0.f, si = 0.f;
#pragma unroll 1
        for (int q0 = 0; q0 < NCH; q0 += 13) { float2 l[13];
#pragma unroll
            for (int i = 0; i < 13; ++i) l[i] = S5LOC[((size_t)(dir * NCH + s5_chunk_at(dir, q0 + i)) * 64 + g) * 64 + p];
#pragma unroll
            for (int i = 0; i < 13; ++i) { const int cc = s5_chunk_at(dir, q0 + i);
                if (cc < nchunks && (cc % cstep) == (int)(blockIdx.x >> 4)) S5IN[((size_t)(dir * NCH + cc) * 64 + g) * 64 + p] = make_float2(sr, si);
                const float nr = a128r * sr - a128i * si + l[i].x, ni = a128r * si + a128i * sr + l[i].y; sr = nr; si = ni; } }
    }
    for (int c = blockIdx.x >> 4; c < nchunks; c += cstep) {
        const int row0 = c * 128;
        bf16x8 uf[8];
#pragma unroll
        for (int k = 0; k < 8; ++k) { const int sl = dir ? 7 - k : k; uf[k] = *(const bf16x8*)(U5 + (size_t)(row0 + sl * 16 + fr) * 1024 + g * 16 + (fq & 1) * 8); }
        __builtin_amdgcn_sched_barrier(0);
#pragma unroll
        for (int k = 0; k < 8; ++k) if (fq >= 2) uf[k] = mkfrag(0u, 0u, 0u, 0u);
        float sr = 0.f, si = 0.f;
        if (PASS == 1) { const float2 s0 = S5IN[((size_t)(dir * NCH + c) * 64 + g) * 64 + p]; sr = s0.x; si = s0.y; }
        f32x4 yacc[8];
#pragma unroll
        for (int k = 0; k < 8; ++k) {
#pragma unroll
            for (int nt = 0; nt < 8; ++nt) { f32x4 acc = {0.f, 0.f, 0.f, 0.f}; acc = __builtin_amdgcn_mfma_f32_16x16x32_bf16(uf[k], bbf[nt], acc, 0, 0, 0);
#pragma unroll
                for (int jj = 0; jj < 4; ++jj) BuW[(fq * 4 + jj) * BUP + nt * 16 + fr] = acc[jj]; }
            asm volatile("s_waitcnt lgkmcnt(0)" ::: "memory");
#pragma unroll
            for (int ii = 0; ii < 16; ++ii) { const int tl = dir ? 15 - ii : ii; const f32x2 b2 = *(const f32x2*)(BuW + tl * BUP + 2 * p);
                f32x2 ns = __builtin_elementwise_fma((f32x2){ab_re, ab_re}, (f32x2){sr, si}, b2); ns = __builtin_elementwise_fma((f32x2){-ab_im, ab_im}, (f32x2){si, sr}, ns); sr = ns[0]; si = ns[1];
                if (PASS == 1) *(unsigned*)(STw + tl * 136 + 2 * p) = cvt_pk_bf16(sr, si); }
            if (PASS == 1) {
                asm volatile("s_waitcnt lgkmcnt(0)" ::: "memory");
                f32x4 acc = {0.f, 0.f, 0.f, 0.f};
#pragma unroll
                for (int ks = 0; ks < 4; ++ks) acc = __builtin_amdgcn_mfma_f32_16x16x32_bf16(*(const bf16x8*)(STw + fr * 136 + ks * 32 + fq * 8), cm[ks], acc, 0, 0, 0);
                yacc[k] = acc;
            }
            asm volatile("s_waitcnt lgkmcnt(0)" ::: "memory");
        }
        if (PASS == 0) { S5LOC[((size_t)(dir * NCH + c) * 64 + g) * 64 + p] = make_float2(sr, si); }
        else {
            __syncthreads();
            if (dir == 0) {
#pragma unroll
                for (int k = 0; k < 8; ++k)
#pragma unroll
                    for (int jj = 0; jj < 4; ++jj) YL[gl * 2048 + (k * 16 + fq * 4 + jj) * 16 + fr] = yacc[k][jj]; }
            __syncthreads();
            if (dir == 1) {
#pragma unroll
                for (int k = 0; k < 8; ++k)
#pragma unroll
                    for (int jj = 0; jj < 4; ++jj) YL[gl * 2048 + ((7 - k) * 16 + fq * 4 + jj) * 16 + fr] += yacc[k][jj]; }
            __syncthreads();
            const int t = tid >> 2, q = tid & 3; const float* y = YL + q * 2048 + t * 16; const float* dd = a.in[14] + (size_t)layer * 1024 + gq * 64 + q * 16;
            const bf16_t* us = U5 + (size_t)(row0 + t) * 1024 + gq * 64 + q * 16; const u32x4 u0 = *(const u32x4*)us, u1 = *(const u32x4*)(us + 8);
            const float u[16] = {bflo(u0.x), bfhi(u0.x), bflo(u0.y), bfhi(u0.y), bflo(u0.z), bfhi(u0.z), bflo(u0.w), bfhi(u0.w), bflo(u1.x), bfhi(u1.x), bflo(u1.y), bfhi(u1.y), bflo(u1.z), bfhi(u1.z), bflo(u1.w), bfhi(u1.w)};
            unsigned o[8];
#pragma unroll
            for (int j = 0; j < 8; ++j) { const float y0 = y[2 * j] + u[2 * j] * dd[2 * j], y1 = y[2 * j + 1] + u[2 * j + 1] * dd[2 * j + 1]; o[j] = cvt_pk_bf16(gelu_tanh(y0), gelu_tanh(y1)); }
            bf16_t* dst = Y5 + (size_t)(row0 + t) * 1024 + gq * 64 + q * 16; u32x4 o0, o1; o0.x = o[0]; o0.y = o[1]; o0.z = o[2]; o0.w = o[3]; o1.x = o[4]; o1.y = o[5]; o1.z = o[6]; o1.w = o[7];
            *(u32x4*)dst = o0; *(u32x4*)(dst + 8) = o1;
        }
    }
    __syncthreads();
}

__device__ __forceinline__ int ssd_chunk_at(int dir, int q) { return s5_chunk_at(dir, q); }
__device__ __forceinline__ void conv8(const bf16_t* XBC, int rowbase, int l0, int ch, bool lo_ok, bool hi_ok, float w0, float w1, float w2, float b, float (&out)[8]) {
    float r[10];
#pragma unroll
    for (int i = 0; i < 10; ++i) { const int l = l0 - 1 + i; const bool ok = (l >= 0 || lo_ok) && (l < 128 || hi_ok); r[i] = ok ? bf2f((unsigned)XBC[(size_t)(rowbase + l) * 3072 + ch]) : 0.f; }
#pragma unroll
    for (int j = 0; j < 8; ++j) out[j] = silu_(w0 * r[j] + w1 * r[j + 1] + w2 * r[j + 2] + b);
}
__device__ __forceinline__ void stage_conv_tile(const bf16_t* XBC, const float* cw, const float* cb, int rowbase, int chbase, bool lo_ok, bool hi_ok, bf16_t* dst, int tid) {
    const int oc = tid & 15, ch = chbase + oc * 8; float w[3][8], b[8];
#pragma unroll
    for (int k = 0; k < 3; ++k) { const f32x4 a0 = *(const f32x4*)(cw + (size_t)k * 3072 + ch), a1 = *(const f32x4*)(cw + (size_t)k * 3072 + ch + 4);
        w[k][0] = a0[0]; w[k][1] = a0[1]; w[k][2] = a0[2]; w[k][3] = a0[3]; w[k][4] = a1[0]; w[k][5] = a1[1]; w[k][6] = a1[2]; w[k][7] = a1[3]; }
    { const f32x4 a0 = *(const f32x4*)(cb + ch), a1 = *(const f32x4*)(cb + ch + 4); b[0] = a0[0]; b[1] = a0[1]; b[2] = a0[2]; b[3] = a0[3]; b[4] = a1[0]; b[5] = a1[1]; b[6] = a1[2]; b[7] = a1[3]; }
    u32x4 gl[4][3];
#pragma unroll
    for (int i = 0; i < 4; ++i) { const int row = (tid >> 4) + i * 32;
#pragma unroll
        for (int d = 0; d < 3; ++d) { const bool ok = d == 1 ? true : (d == 0 ? (row > 0 || lo_ok) : (row < 127 || hi_ok)); const int l = ok ? row + d - 1 : row;
            gl[i][d] = *(const u32x4*)(XBC + (size_t)(rowbase + l) * 3072 + ch); } }
    __builtin_amdgcn_sched_barrier(0);
#pragma unroll
    for (int i = 0; i < 4; ++i) { const int row = (tid >> 4) + i * 32; float acc[8];
#pragma unroll
        for (int k = 0; k < 8; ++k) acc[k] = b[k];
#pragma unroll
        for (int d = 0; d < 3; ++d) { const bool ok = d == 1 ? true : (d == 0 ? (row > 0 || lo_ok) : (row < 127 || hi_ok));
            { u32x4 g = gl[i][d]; if (!ok) g = (u32x4){0u, 0u, 0u, 0u};
                acc[0] += w[d][0] * bflo(g.x); acc[1] += w[d][1] * bfhi(g.x); acc[2] += w[d][2] * bflo(g.y); acc[3] += w[d][3] * bfhi(g.y);
                acc[4] += w[d][4] * bflo(g.z); acc[5] += w[d][5] * bfhi(g.z); acc[6] += w[d][6] * bflo(g.w); acc[7] += w[d][7] * bfhi(g.w); } }
        u32x4 o; o.x = cvt_pk_bf16(silu_(acc[0]), silu_(acc[1])); o.y = cvt_pk_bf16(silu_(acc[2]), silu_(acc[3])); o.z = cvt_pk_bf16(silu_(acc[4]), silu_(acc[5])); o.w = cvt_pk_bf16(silu_(acc[6]), silu_(acc[7]));
        *(u32x4*)(dst + row * 136 + oc * 8) = o; }
}
constexpr int SL_CS = 0, SL_CB = 34816, SL_CUM = 69632, SL_DT = 77824, SL_PART = 86016, SL_BS = 94208, SL_XT = 94208;
template <int AUX> __device__ __forceinline__ void ssd_cum(const Args& a, int layer, int c, int h, int w, int lane, unsigned char* lds) {
    const float* DT = (const float*)(a.ws + WS_BIG + B_DT); float* cumL = (float*)(lds + SL_CUM); float* dtL = (float*)(lds + SL_DT); float* CHD = (float*)(a.ws + WS_CHD);
#pragma unroll
    for (int dir = 0; dir < 2; ++dir) {
        const float ah = -expf(a.in[20][(size_t)(layer * 2 + dir) * 32 + h]);
        const float d0 = DT[(size_t)(c * 128 + 2 * lane) * 64 + dir * 32 + h], d1 = DT[(size_t)(c * 128 + 2 * lane + 1) * 64 + dir * 32 + h];
        const float l0 = d0 * ah, l1 = d1 * ah, s = l0 + l1; float incl = s;
#pragma unroll
        for (int o = 1; o < 64; o <<= 1) { const float t = __shfl_up(incl, o); if (lane >= o) incl += t; }
        const float excl = incl - s, tot = __shfl(incl, 63);
        float c0, c1;
        if (dir == 0) { c0 = excl + l0; c1 = incl; } else { c0 = tot - excl; c1 = tot - (excl + l0); }
        float* cu = cumL + (dir * 8 + w) * 128 + 2 * lane; cu[0] = c0; cu[1] = c1;
        float* dd = dtL + (dir * 8 + w) * 128 + 2 * lane;
        if (AUX == 0) { dd[0] = d0; dd[1] = d1; } else { dd[0] = d0 * __expf(tot - c0); dd[1] = d1 * __expf(tot - c1); if (lane == 0) CHD[(size_t)(dir * NCH + c) * 32 + h] = tot; }
    }
}
__device__ __forceinline__ void stage_T(const bf16_t* XBC, const float* cw, const float* cb, int rowbase, int ch, int r0, bool lo_ok, bool hi_ok, bf16_t* dstT) {
    float w[3][8], b[8];
#pragma unroll
    for (int k = 0; k < 3; ++k) { const f32x4 a0 = *(const f32x4*)(cw + (size_t)k * 3072 + ch), a1 = *(const f32x4*)(cw + (size_t)k * 3072 + ch + 4);
        w[k][0] = a0[0]; w[k][1] = a0[1]; w[k][2] = a0[2]; w[k][3] = a0[3]; w[k][4] = a1[0]; w[k][5] = a1[1]; w[k][6] = a1[2]; w[k][7] = a1[3]; }
    { const f32x4 a0 = *(const f32x4*)(cb + ch), a1 = *(const f32x4*)(cb + ch + 4); b[0] = a0[0]; b[1] = a0[1]; b[2] = a0[2]; b[3] = a0[3]; b[4] = a1[0]; b[5] = a1[1]; b[6] = a1[2]; b[7] = a1[3]; }
    u32x4 raw[10];
    const bf16_t* base = XBC + (size_t)(rowbase + r0) * 3072 + ch;
    const bool ok0 = r0 > 0 || lo_ok, ok9 = r0 < 120 || hi_ok;
#pragma unroll
    for (int i = 1; i < 9; ++i) raw[i] = *(const u32x4*)(base + (i - 1) * 3072);
    raw[0] = *(const u32x4*)(base + (ok0 ? -3072 : 0)); raw[9] = *(const u32x4*)(base + (ok9 ? 8 * 3072 : 7 * 3072));
    __builtin_amdgcn_sched_barrier(0);
    if (!ok0) raw[0] = (u32x4){0u, 0u, 0u, 0u};
    if (!ok9) raw[9] = (u32x4){0u, 0u, 0u, 0u};
    float sp[8]; unsigned o[8][4];
#pragma unroll
    for (int r = 0; r < 8; ++r) { float sv[8];
#pragma unroll
        for (int k = 0; k < 8; ++k) { float acc = b[k];
#pragma unroll
            for (int d = 0; d < 3; ++d) { const unsigned wd = k < 2 ? raw[r + d].x : (k < 4 ? raw[r + d].y : (k < 6 ? raw[r + d].z : raw[r + d].w)); acc += w[d][k] * ((k & 1) ? bfhi(wd) : bflo(wd)); }
            sv[k] = silu_(acc); }
        if (r & 1) {
#pragma unroll
            for (int k = 0; k < 8; ++k) o[k][r >> 1] = cvt_pk_bf16(sp[k], sv[k]); }
        else {
#pragma unroll
            for (int k = 0; k < 8; ++k) sp[k] = sv[k]; } }
#pragma unroll
    for (int k = 0; k < 8; ++k) { u32x4 v; v.x = o[k][0]; v.y = o[k][1]; v.z = o[k][2]; v.w = o[k][3]; *(u32x4*)(dstT + k * 136 + r0) = v; }
}
__device__ __forceinline__ void ssd_a_phase(const Args& a, int layer, unsigned char* lds, int tid) {
    const bf16_t* XBC = (const bf16_t*)(a.ws + WS_BIG + B_XBC); bf16_t* SST = (bf16_t*)(a.ws + WS_SST);
    const float* cw = a.in[17] + (size_t)layer * 3 * 3072; const float* cb = a.in[18] + (size_t)layer * 3072;
    bf16_t* BT = (bf16_t*)(lds + SL_CS); bf16_t* xT = (bf16_t*)(lds + SL_XT); const float* wL = (const float*)(lds + SL_DT);
    for (int unit = (blockIdx.x + (gridDim.x >> 1)) % gridDim.x; unit < NCH * 4; unit += gridDim.x) {
        int tl = tid; asm volatile("" : "+v"(tl));
        const int lane = tl & 63, w = __builtin_amdgcn_readfirstlane(tl >> 6), fr = lane & 15, fq = lane >> 4, og = lane & 7, rr = lane >> 3;
        const int c = unit >> 2, g = unit & 3, rowbase = c * 128; const bool lo_ok = !(c == 0 || c == 128), hi_ok = !(c == 127 || c == 129);
        __syncthreads();
        if (w < 4) { const int oct = (w & 1) * 8 + og; stage_T(XBC, cw, cb, rowbase, 2048 + g * 128 + oct * 8, ((w >> 1) * 8 + rr) * 8, lo_ok, hi_ok, BT + (oct * 8) * 136); }
        ssd_cum<1>(a, layer, c, g * 8 + w, w, lane, lds);
#pragma unroll 1
        for (int pass = 0; pass < 2; ++pass) {
            if (pass) __syncthreads();
            { const int hs = w & 3; stage_T(XBC, cw, cb, rowbase, (g * 8 + pass * 4 + hs) * 64 + og * 8, ((w >> 2) * 8 + rr) * 8, lo_ok, hi_ok, xT + ((hs * 64 + og * 8) * 136)); }
            __syncthreads();
            const int hl = w >> 1, dir = w & 1, hh = pass * 4 + hl, h = g * 8 + hh;
            bf16_t* sb = SST + (((size_t)(dir * NCH + c) * 32 + h) * 64) * 128;
#pragma unroll 1
            for (int nh = 0; nh < 2; ++nh) {
                f32x4 acc[4][4];
#pragma unroll
                for (int pt = 0; pt < 4; ++pt)
#pragma unroll
                    for (int nt = 0; nt < 4; ++nt) acc[pt][nt] = (f32x4){0.f, 0.f, 0.f, 0.f};
#pragma unroll
                for (int ks = 0; ks < 4; ++ks) {
                    const float* wp = wL + (dir * 8 + hh) * 128 + ks * 32 + fq * 8; const f32x4 wl0 = *(const f32x4*)wp, wl1 = *(const f32x4*)(wp + 4);
                    bf16x8 yf[4];
#pragma unroll
                    for (int pt = 0; pt < 4; ++pt) { const u32x4 xr = *(const u32x4*)(xT + ((hl * 64 + pt * 16 + fr) * 136 + ks * 32 + fq * 8));
                        yf[pt] = mkfrag(cvt_pk_bf16(bflo(xr.x) * wl0[0], bfhi(xr.x) * wl0[1]), cvt_pk_bf16(bflo(xr.y) * wl0[2], bfhi(xr.y) * wl0[3]), cvt_pk_bf16(bflo(xr.z) * wl1[0], bfhi(xr.z) * wl1[1]), cvt_pk_bf16(bflo(xr.w) * wl1[2], bfhi(xr.w) * wl1[3])); }
#pragma unroll
                    for (int nt = 0; nt < 4; ++nt) { const bf16x8 xf = *(const bf16x8*)(BT + ((nh * 4 + nt) * 16 + fr) * 136 + ks * 32 + fq * 8);
#pragma unroll
                        for (int pt = 0; pt < 4; ++pt) acc[pt][nt] = __builtin_amdgcn_mfma_f32_16x16x32_bf16(xf, yf[pt], acc[pt][nt], 0, 0, 0); }
                }
#pragma unroll
                for (int pt = 0; pt < 4; ++pt) mfma_settle(acc[pt][3]);
#pragma unroll
                for (int pt = 0; pt < 4; ++pt)
#pragma unroll
                    for (int nt = 0; nt < 4; ++nt) { u32x2 o; o.x = cvt_pk_native(acc[pt][nt][0], acc[pt][nt][1]); o.y = cvt_pk_native(acc[pt][nt][2], acc[pt][nt][3]);
                        *(u32x2*)(sb + (size_t)(pt * 16 + fr) * 128 + (nh * 4 + nt) * 16 + fq * 4) = o; }
            }
        }
    }
    __syncthreads();
}
__device__ __forceinline__ void ssd_b_phase(const Args& a, int tid) {
    bf16_t* SST = (bf16_t*)(a.ws + WS_SST); const float* CHD = (const float*)(a.ws + WS_CHD);
    for (int idx = blockIdx.x * 512 + tid; idx < 64 * 2048; idx += gridDim.x * 512) {
        const int e4 = idx & 2047, hd = idx >> 11, dir = hd >> 5, h = hd & 31; float s0 = 0.f, s1 = 0.f, s2 = 0.f, s3 = 0.f;
#pragma unroll 1
        for (int b = 0; b < 13; ++b) { u32x2 loc[10]; float dc[10];
#pragma unroll
            for (int i = 0; i < 10; ++i) { const int cq = ssd_chunk_at(dir, b * 10 + i); loc[i] = *(const u32x2*)(SST + ((size_t)(dir * NCH + cq) * 32 + h) * 8192 + e4 * 4); dc[i] = CHD[(size_t)(dir * NCH + cq) * 32 + h]; }
#pragma unroll
            for (int i = 0; i < 10; ++i) { const int cq = ssd_chunk_at(dir, b * 10 + i); u32x2 o; o.x = cvt_pk_bf16(s0, s1); o.y = cvt_pk_bf16(s2, s3);
                *(u32x2*)(SST + ((size_t)(dir * NCH + cq) * 32 + h) * 8192 + e4 * 4) = o; const float e = __expf(dc[i]);
                s0 = e * s0 + bflo(loc[i].x); s1 = e * s1 + bfhi(loc[i].x); s2 = e * s2 + bflo(loc[i].y); s3 = e * s3 + bfhi(loc[i].y); }
        }
    }
}
__device__ __forceinline__ void ssd_c_phase(const Args& a, int layer, unsigned char* lds, int tid, int nchunks) {
    const bf16_t* XBC = (const bf16_t*)(a.ws + WS_BIG + B_XBC); const bf16_t* SST = (const bf16_t*)(a.ws + WS_SST); const bf16_t* Z = (const bf16_t*)(a.ws + WS_BIG + B_Z); bf16_t* YD = (bf16_t*)(a.ws + WS_BIG + B_YD);
    const float* cw = a.in[17] + (size_t)layer * 3 * 3072; const float* cb = a.in[18] + (size_t)layer * 3072; const float* normw = a.in[22] + (size_t)layer * 2048;
    bf16_t* Cs = (bf16_t*)(lds + SL_CS); bf16_t* Bs = (bf16_t*)(lds + SL_BS); bf16_t* CBs = (bf16_t*)(lds + SL_CB); bf16_t* xT = (bf16_t*)(lds + SL_XT);
    const float* cumL = (const float*)(lds + SL_CUM); const float* dtL = (const float*)(lds + SL_DT); float* part = (float*)(lds + SL_PART);
    for (int unit = (blockIdx.x + (gridDim.x >> 1)) % gridDim.x; unit < nchunks * 4; unit += gridDim.x) {
        int tl = tid; asm volatile("" : "+v"(tl));
        const int lane = tl & 63, w = __builtin_amdgcn_readfirstlane(tl >> 6), fr = lane & 15, fq = lane >> 4, og = lane & 7, rr = lane >> 3;
        const int hl = w & 3, lh = w >> 2;
        const int c = unit >> 2, g = unit & 3, rowbase = c * 128; const bool lo_ok = !(c == 0 || c == 128), hi_ok = !(c == 127 || c == 129);
        __syncthreads();
        stage_conv_tile(XBC, cw, cb, rowbase, 2560 + g * 128, lo_ok, hi_ok, Cs, tl);
        stage_conv_tile(XBC, cw, cb, rowbase, 2048 + g * 128, lo_ok, hi_ok, Bs, tl);
        ssd_cum<0>(a, layer, c, g * 8 + w, w, lane, lds);
        __syncthreads();
#pragma unroll 1
        for (int st = 0; st < 8; ++st) { f32x4 acc = {0.f, 0.f, 0.f, 0.f};
#pragma unroll
            for (int ks = 0; ks < 4; ++ks) { const bf16x8 xf = *(const bf16x8*)(Bs + (st * 16 + fr) * 136 + ks * 32 + fq * 8), yf = *(const bf16x8*)(Cs + (w * 16 + fr) * 136 + ks * 32 + fq * 8);
                acc = __builtin_amdgcn_mfma_f32_16x16x32_bf16(xf, yf, acc, 0, 0, 0); }
            mfma_settle(acc);
            u32x2 o; o.x = cvt_pk_native(acc[0], acc[1]); o.y = cvt_pk_native(acc[2], acc[3]); *(u32x2*)(CBs + (w * 16 + fr) * 136 + st * 16 + fq * 4) = o; }
#pragma unroll 1
        for (int pass = 0; pass < 2; ++pass) {
            __syncthreads();
            stage_T(XBC, cw, cb, rowbase, (g * 8 + pass * 4 + hl) * 64 + og * 8, (lh * 8 + rr) * 8, lo_ok, hi_ok, xT + ((hl * 64 + og * 8) * 136));
            __syncthreads();
            const int hh = pass * 4 + hl, h = g * 8 + hh; const float Dh = a.in[21][(size_t)layer * 32 + h];
#pragma unroll 1
            for (int ih = 0; ih < 2; ++ih) {
            f32x4 acc[2][4];
#pragma unroll
            for (int i = 0; i < 2; ++i)
#pragma unroll
                for (int pt = 0; pt < 4; ++pt) acc[i][pt] = (f32x4){0.f, 0.f, 0.f, 0.f};
#pragma unroll
            for (int dir = 0; dir < 2; ++dir) {
                const bf16_t* sb = SST + (((size_t)(dir * NCH + c) * 32 + h) * 64) * 128;
                f32x4 tmp[2][4];
#pragma unroll
                for (int i = 0; i < 2; ++i)
#pragma unroll
                    for (int pt = 0; pt < 4; ++pt) tmp[i][pt] = (f32x4){0.f, 0.f, 0.f, 0.f};
#pragma unroll
                for (int ks = 0; ks < 4; ++ks) { const int lb = (lh * 4 + ih * 2) * 16 + fr; bf16x8 sfr[4];
#pragma unroll
                    for (int pt = 0; pt < 4; ++pt) sfr[pt] = *(const bf16x8*)(sb + (size_t)(pt * 16 + fr) * 128 + ks * 32 + fq * 8);
                    const bf16x8 yf0 = *(const bf16x8*)(Cs + lb * 136 + ks * 32 + fq * 8), yf1 = *(const bf16x8*)(Cs + (lb + 16) * 136 + ks * 32 + fq * 8);
                    __builtin_amdgcn_sched_barrier(0);
#pragma unroll
                    for (int pt = 0; pt < 4; ++pt) {
                        tmp[0][pt] = __builtin_amdgcn_mfma_f32_16x16x32_bf16(sfr[pt], yf0, tmp[0][pt], 0, 0, 0); tmp[1][pt] = __builtin_amdgcn_mfma_f32_16x16x32_bf16(sfr[pt], yf1, tmp[1][pt], 0, 0, 0); } }
#pragma unroll
                for (int i = 0; i < 2; ++i) { int frv = fr; asm volatile("" : "+v"(frv));
                    const int lt = lh * 4 + ih * 2 + i, l = lt * 16 + frv;
                    const float cl = cumL[(dir * 8 + hh) * 128 + l], el = __expf(cl);
#pragma unroll
                    for (int pt = 0; pt < 4; ++pt) acc[i][pt] += tmp[i][pt] * el;
#pragma unroll
                    for (int ks = 0; ks < 4; ++ks) { const int s0 = ks * 32;
                        const bool skip = dir == 0 ? (s0 > lt * 16 + 15) : (s0 + 31 < lt * 16);
                        if (!skip) { const u32x4 cbv = *(const u32x4*)(CBs + l * 136 + s0 + fq * 8);
                            const float* cp = cumL + (dir * 8 + hh) * 128 + s0 + fq * 8; const float* dp = dtL + (dir * 8 + hh) * 128 + s0 + fq * 8;
                            const f32x4 c0 = *(const f32x4*)cp, c1 = *(const f32x4*)(cp + 4), d0 = *(const f32x4*)dp, d1 = *(const f32x4*)(dp + 4);
                            float cbf[8] = {bflo(cbv.x), bfhi(cbv.x), bflo(cbv.y), bfhi(cbv.y), bflo(cbv.z), bfhi(cbv.z), bflo(cbv.w), bfhi(cbv.w)}; float v[8];
#pragma unroll
                            for (int j = 0; j < 8; ++j) { const int sx = s0 + fq * 8 + j; const float cs = j < 4 ? c0[j & 3] : c1[j & 3], ds = j < 4 ? d0[j & 3] : d1[j & 3];
                                const bool valid = dir == 0 ? (sx <= l) : (sx >= l); float t = valid ? cbf[j] * __expf(fminf(cl - cs, 0.f)) * ds : 0.f; if (dir == 0 && sx == l) t += Dh; v[j] = t; }
                            const bf16x8 yf = mkfrag(cvt_pk_bf16(v[0], v[1]), cvt_pk_bf16(v[2], v[3]), cvt_pk_bf16(v[4], v[5]), cvt_pk_bf16(v[6], v[7]));
#pragma unroll
                            for (int pt = 0; pt < 4; ++pt) acc[i][pt] = __builtin_amdgcn_mfma_f32_16x16x32_bf16(*(const bf16x8*)(xT + ((hl * 64 + pt * 16 + fr) * 136 + s0 + fq * 8)), yf, acc[i][pt], 0, 0, 0); } }
                }
            }
#pragma unroll
            for (int i = 0; i < 2; ++i) { const int l = (lh * 4 + ih * 2 + i) * 16 + fr; const size_t row = (size_t)(rowbase + l); float ss = 0.f;
#pragma unroll
                for (int pt = 0; pt < 4; ++pt) { const int ch = h * 64 + pt * 16 + fq * 4; const u32x2 zz = *(const u32x2*)(Z + row * 2048 + ch);
                    const float h0 = acc[i][pt][0] * silu_(bflo(zz.x)), h1 = acc[i][pt][1] * silu_(bfhi(zz.x)), h2 = acc[i][pt][2] * silu_(bflo(zz.y)), h3 = acc[i][pt][3] * silu_(bfhi(zz.y));
                    ss += (h0 * h0 + h1 * h1) + (h2 * h2 + h3 * h3); u32x2 o; o.x = cvt_pk_bf16(h0, h1); o.y = cvt_pk_bf16(h2, h3); *(u32x2*)(YD + row * 2048 + ch) = o; }
                ss += __shfl_xor(ss, 16); ss += __shfl_xor(ss, 32);
                if (fq == 0) part[hh * 128 + l] = ss; }
            }
        }
        __syncthreads();
#pragma unroll 1
        for (int it = 0; it < 8; ++it) { const int pass = it >> 2, i = it & 3, l = (lh * 4 + i) * 16 + fr, h = g * 8 + pass * 4 + hl; float tot = 0.f;
#pragma unroll
            for (int hd = 0; hd < 8; ++hd) tot += part[hd * 128 + l];
            const float r = __builtin_amdgcn_rsqf(tot * (1.f / 512.f) + RMS_EPS); const size_t row = (size_t)(rowbase + l);
#pragma unroll
            for (int pt = 0; pt < 4; ++pt) { const int ch = h * 64 + pt * 16 + fq * 4; bf16_t* yp = YD + row * 2048 + ch; const u32x2 hv = *(const u32x2*)yp; const f32x4 nw = *(const f32x4*)(normw + ch);
                u32x2 o; o.x = cvt_pk_bf16(bflo(hv.x) * r * nw[0], bfhi(hv.x) * r * nw[1]); o.y = cvt_pk_bf16(bflo(hv.y) * r * nw[2], bfhi(hv.y) * r * nw[3]); *(u32x2*)yp = o; } }
    }
    __syncthreads();
}

#define LAS __attribute__((address_space(3)))
#define XB_TMO      128
#define XB_XCNT(j)  (256  + 64 * (j))
#define XB_XSUB(j)  (1280 + 64 * (j))
#define XB_XGEN(j)  (2304 + 64 * (j))
#define XB_TOP      3328
#define XB_TOPGEN   3392
#define XCD_BAR_WORDS 3456
#define XB_SPIN_CAP (1u << 18)

__device__ __forceinline__ unsigned xb_ld(unsigned* p)              { return __hip_atomic_load(p, __ATOMIC_RELAXED, __HIP_MEMORY_SCOPE_AGENT); }
__device__ __forceinline__ unsigned xb_add(unsigned* p, unsigned v) { return __hip_atomic_fetch_add(p, v, __ATOMIC_RELAXED, __HIP_MEMORY_SCOPE_AGENT); }
__device__ __forceinline__ unsigned xb_xcc_id() { return (unsigned)__builtin_amdgcn_s_getreg((3 << 11) | 20) & 0xFu; }
#define XB_SPIN(cond, bar) do { unsigned _sp = 0; while (cond) { __builtin_amdgcn_s_sleep(1); \
    if ((++_sp & 255u) == 0u) { if (xb_ld(&(bar)[XB_TMO])) break; if (_sp > XB_SPIN_CAP) { atomicAdd(&(bar)[XB_TMO], 1u); break; } } } } while (0)

struct XcdBarrier {
    unsigned* bar; unsigned x;
    volatile LAS unsigned* st;
};

__device__ __forceinline__ XcdBarrier xcd_barrier_post(unsigned* bar, volatile LAS unsigned* st) {
    XcdBarrier b; b.bar = bar; b.x = xb_xcc_id(); b.st = st;
    if (threadIdx.x == 0) (void)xb_add(&bar[XB_XCNT(b.x)], 1u);
    return b;
}
__device__ __forceinline__ void xcd_barrier_complete(unsigned* bar, unsigned x, unsigned& nloc, unsigned& nx) {
    const unsigned G = gridDim.x * gridDim.y * gridDim.z;
    unsigned sum, cnt, mine, sp = 0u;
    for (;;) {
        sum = 0u; cnt = 0u; mine = 0u;
#pragma unroll
        for (unsigned j = 0; j < 16; ++j) { const unsigned c = xb_ld(&bar[XB_XCNT(j)]); sum += c; cnt += (c > 0u) ? 1u : 0u; mine = (j == x) ? c : mine; }
        if (sum == G) break;
        __builtin_amdgcn_s_sleep(1);
        if ((++sp & 255u) == 0u) { if (xb_ld(&bar[XB_TMO])) break; if (sp > XB_SPIN_CAP) { atomicAdd(&bar[XB_TMO], 1u); break; } }
    }
    nloc = mine > 0u ? mine : 1u; nx = cnt > 0u ? cnt : 1u;
}

__device__ __forceinline__ void xcd_barrier(const XcdBarrier& b) {
    asm volatile("s_waitcnt vmcnt(0)" ::: "memory");
    __syncthreads();
    if (threadIdx.x == 0) {
        unsigned* bar = b.bar;
        __builtin_amdgcn_s_waitcnt(0);
        unsigned nloc = b.st[0], nx = b.st[1];
        if (nloc == 0u) { xcd_barrier_complete(bar, b.x, nloc, nx); b.st[0] = nloc; b.st[1] = nx; }
        const unsigned old = xb_add(&bar[XB_XSUB(b.x)], 1u);
        const unsigned gen = old / nloc;
        if (old + 1u == (gen + 1u) * nloc) {
            __builtin_amdgcn_fence(__ATOMIC_RELEASE, "agent");
            asm volatile("s_waitcnt vmcnt(0)" ::: "memory");
            const unsigned og = xb_add(&bar[XB_TOP], 1u);
            const unsigned tg = og / nx;
            if (og + 1u == (tg + 1u) * nx) xb_add(&bar[XB_TOPGEN], 1u);
            else XB_SPIN(xb_ld(&bar[XB_TOPGEN]) == tg, bar);
            __builtin_amdgcn_fence(__ATOMIC_ACQUIRE, "agent");
            xb_add(&bar[XB_XGEN(b.x)], 1u);
            asm volatile("s_waitcnt vmcnt(0)" ::: "memory");
        } else {
            XB_SPIN(xb_ld(&bar[XB_XGEN(b.x)]) == gen, bar);
            __builtin_amdgcn_fence(__ATOMIC_ACQUIRE, "agent");
            asm volatile("s_waitcnt vmcnt(0)" ::: "memory");
        }
    }
    __syncthreads();
}

#ifndef MK_REP_S5
#define MK_REP_S5 1
#endif
#ifndef MK_REP_SSD
#define MK_REP_SSD 1
#endif
#ifndef MK_REP_SYNC
#define MK_REP_SYNC 1
#endif
#ifndef MK_CG_SYNC_ALL
#define MK_CG_SYNC_ALL 0
#endif
#ifndef MK_REP_PRO
#define MK_REP_PRO 1
#endif
#ifndef MK_REP_GEMM
#define MK_REP_GEMM 1
#endif
constexpr int NPHASE = 2 + 11 * 2;
__global__ void __launch_bounds__(512, 2) fwd_megakernel(Args a) {
    extern __shared__ __attribute__((aligned(16))) unsigned char lds[];
    PG8_LAS unsigned char* lds3 = (PG8_LAS unsigned char*)lds;
    unsigned char* big = a.ws + WS_BIG;
    volatile LAS unsigned* bst = (volatile LAS unsigned*)(lds3 + (LDS_BYTES - 16));
    if (threadIdx.x < 4) bst[threadIdx.x] = 0u;
    __syncthreads();
    XcdBarrier xbar; xbar.bar = (unsigned*)(a.ws + WS_BAR); xbar.x = 0; xbar.st = bst;
    if (a.ph_hi - a.ph_lo > 1) xbar = xcd_barrier_post((unsigned*)(a.ws + WS_BAR), bst);
    for (int ph = a.ph_lo; ph < a.ph_hi; ++ph) {
        const int tid = pg8::pg8_tid(), lane = tid & 63, wave = tid >> 6, gw = blockIdx.x * 8 + wave, NGW = gridDim.x * 8;
        if (ph == 0) {
            for (int rep = 0; rep < MK_REP_PRO; ++rep) {
            adaln_phase(a, (float*)lds, tid);
            float* scr = (float*)lds + wave * (64 * 33);
            xpose_region(a, 0, 0, scr, gw, NGW, lane); xpose_region(a, 0, 1, scr, gw, NGW, lane); __syncthreads(); }
        } else if (ph == 1) {
            row_phase<0>(a, MT, nullptr, nullptr, 0, 0, gw, NGW, lane);
        } else {
            const int layer = (ph - 2) / 11, k = (ph - 2) % 11; const bool last = layer == 1; const int Mrows = last ? TL : MT;
            const bf16_t* WA = (const bf16_t*)(a.ws + WS_WA); const bf16_t* WB = (const bf16_t*)(a.ws + WS_WB);
#ifdef MK_SKIP_MASK
            if ((MK_SKIP_MASK >> k) & 1) { if (ph + 1 < a.ph_hi) xcd_barrier(xbar); continue; }
#endif
            if (k == 0) {
                pg8::Gemm g{(const bf16_t*)(a.ws + WS_XM), WA + WA_IN / 2, MT, NPROJ, D}; pg8::StaticOrder S; S.init(MT, NPROJ, gridDim.x, blockIdx.x);
                EpiInProj E{big, a.in[19] + (size_t)layer * 64}; for (int rep = 0; rep < MK_REP_GEMM; ++rep) { pg8::gemm_phase<EpiInProj, pg8::StaticOrder>(lds3, g, S, E, nullptr); __syncthreads(); }
            } else if (k == 1) {
                for (int rep = 0; rep < MK_REP_SSD; ++rep) ssd_a_phase(a, layer, lds, tid);
                for (int rep = 0; rep < MK_REP_S5; ++rep) s5_phase<0>(a, layer, lds, tid, NCH);
            } else if (k == 2) {
#if !defined(MK_NO_SSD) && !defined(MK_NO_SSDB)
                ssd_b_phase(a, tid);
#endif
                for (int rep = 0; rep < MK_REP_S5; ++rep) s5_phase<1>(a, layer, lds, tid, last ? 128 : NCH);
            } else if (k == 3) {
                for (int rep = 0; rep < MK_REP_SSD; ++rep) ssd_c_phase(a, layer, lds, tid, last ? 128 : NCH);
#ifndef MK_NO_S5
                pg8::Gemm g{(const bf16_t*)(big + B_Y5), WA + WA_GLU / 2, Mrows, 2048, 1024}; pg8::StaticOrder S; S.init(Mrows, 2048, gridDim.x, blockIdx.x);
                EpiGlu E{(bf16_t*)(big + B_U5)}; pg8::gemm_phase<EpiGlu, pg8::StaticOrder>(lds3, g, S, E, nullptr);
#endif
            } else if (k == 4) {
#ifndef MK_NO_S5
                { pg8::Gemm g{(const bf16_t*)(big + B_U5), WA + WA_S5P / 2, Mrows, 2048, 1024}; pg8::StaticOrder S; S.init(Mrows, 2048, gridDim.x, blockIdx.x);
                  EpiMerge<0> E{(bf16_t*)(big + B_XBC), (const bf16_t*)(big + B_GATE)}; pg8::gemm_phase<EpiMerge<0>, pg8::StaticOrder>(lds3, g, S, E, nullptr); }
                __syncthreads();
#endif
#ifndef MK_NO_SSD
#ifdef MK_NO_S5
                { pg8::Gemm g{(const bf16_t*)(big + B_YD), WA + WA_SSDP / 2, Mrows, 2048, 2048}; pg8::StaticOrder S; S.init(Mrows, 2048, gridDim.x, blockIdx.x);
                  EpiMerge<0, 1> E{(bf16_t*)(big + B_XBC), (const bf16_t*)(big + B_GATE)}; pg8::gemm_phase<EpiMerge<0, 1>, pg8::StaticOrder>(lds3, g, S, E, nullptr); }
#else
                { pg8::Gemm g{(const bf16_t*)(big + B_YD), WA + WA_SSDP / 2, Mrows, 2048, 2048}; pg8::StaticOrder S; S.init(Mrows, 2048, gridDim.x, blockIdx.x);
                  EpiMerge<1> E{(bf16_t*)(big + B_XBC), (const bf16_t*)(big + B_GATE)}; pg8::gemm_phase<EpiMerge<1>, pg8::StaticOrder>(lds3, g, S, E, nullptr); }
#endif
#endif
            } else if (k == 5) {
                pg8::Gemm g{(const bf16_t*)(big + B_XBC), WA + WA_WOUT / 2, Mrows, 2048, 2048}; pg8::StaticOrder S; S.init(Mrows, 2048, gridDim.x, blockIdx.x);
                EpiResid E{a.out, (float*)(a.ws + WS_HCTX), mvec(a, layer, 0) + 2 * D, mvec(a, layer, 1) + 2 * D}; pg8::gemm_phase<EpiResid, pg8::StaticOrder>(lds3, g, S, E, nullptr);
            } else if (k == 6) {
                row_phase<1>(a, Mrows, a.in[25] + (size_t)layer * D, a.in[26] + (size_t)layer * D, layer, 3 * D, gw, NGW, lane);
                if (!last) for (int rep = 0; rep < MK_REP_PRO; ++rep) { __syncthreads(); xpose_region(a, layer + 1, 0, (float*)lds + wave * (64 * 33), gw, NGW, lane); }
            } else if (k == 7) {
                pg8::Gemm g{(const bf16_t*)(a.ws + WS_XM), WB + WB_UP / 2, Mrows, 2 * DFF, D}; pg8::StaticOrder S; S.init(Mrows, 2 * DFF, gridDim.x, blockIdx.x);
                EpiUp E{(bf16_t*)(big + B_G), (bf16_t*)(big + B_V)}; for (int rep = 0; rep < MK_REP_GEMM; ++rep) { pg8::gemm_phase<EpiUp, pg8::StaticOrder>(lds3, g, S, E, nullptr); __syncthreads(); }
            } else if (k == 8) {
                ffnconv_phase(a, layer, !last, lds, tid);
            } else if (k == 9) {
                pg8::Gemm g{(const bf16_t*)(big + B_V), WB + WB_DOWN / 2, Mrows, D, DFF}; pg8::StaticOrder S; S.init(Mrows, D, gridDim.x, blockIdx.x);
                EpiResid E{a.out, (float*)(a.ws + WS_HCTX), mvec(a, layer, 0) + 5 * D, mvec(a, layer, 1) + 5 * D}; pg8::gemm_phase<EpiResid, pg8::StaticOrder>(lds3, g, S, E, nullptr);
            } else {
                row_phase<1>(a, Mrows, a.in[31] + (size_t)layer * D, a.in[32] + (size_t)layer * D, last ? -1 : layer + 1, 0, gw, NGW, lane);
                if (!last) for (int rep = 0; rep < MK_REP_PRO; ++rep) { __syncthreads(); xpose_region(a, layer + 1, 1, (float*)lds + wave * (64 * 33), gw, NGW, lane); }
            }
        }
        if (ph + 1 < a.ph_hi) { for (int rep = 0; rep < MK_REP_SYNC; ++rep) { if (MK_CG_SYNC_ALL || ph == a.ph_lo) cg::this_grid().sync(); else xcd_barrier(xbar); } }
#ifdef MK_TS_MASK
        if (blockIdx.x == 0 && threadIdx.x == 0) ((unsigned long long*)(a.ws + WS_BAR + 65536))[ph + 1] = __builtin_amdgcn_s_memrealtime();
#endif
    }
#ifdef MK_TS_MASK
    if (blockIdx.x == 0 && threadIdx.x == 0) {
        const unsigned long long* ts = (const unsigned long long*)(a.ws + WS_BAR + 65536); unsigned long long sum = 0;
        for (int ph = 1; ph < a.ph_hi - 1; ++ph) if ((MK_TS_MASK >> ph) & 1ull) sum += ts[ph + 1] - ts[ph];
        const unsigned long long t0 = __builtin_amdgcn_s_memrealtime();
        while (__builtin_amdgcn_s_memrealtime() - t0 < sum * MK_TS_AMP) __builtin_amdgcn_s_sleep(8);
    }
#endif
}
}

#ifndef MK_N_LAUNCH_MODE
#define MK_N_LAUNCH_MODE 0
#endif
extern "C" void kernel_launch(void* const* d_in, const int* in_sizes, int n_in, void* d_out, int out_size, void* d_ws, size_t ws_size, hipStream_t stream) {
    static int grid = 0;
    if (grid == 0) {
        if (n_in != 33 || ws_size < mk::WS_END) { fprintf(stderr, "kernel_launch: need 33 inputs and %zu bytes of workspace (got %d, %zu)\n", (size_t)mk::WS_END, n_in, ws_size); grid = -1; return; }
        int dev = 0, cus = 0, per_cu = 0;
        (void)hipGetDevice(&dev); (void)hipDeviceGetAttribute(&cus, hipDeviceAttributeMultiprocessorCount, dev);
        if (hipFuncSetAttribute((const void*)mk::fwd_megakernel, hipFuncAttributeMaxDynamicSharedMemorySize, mk::LDS_BYTES) != hipSuccess) { fprintf(stderr, "kernel_launch: hipFuncSetAttribute failed\n"); grid = -1; return; }
        if (hipOccupancyMaxActiveBlocksPerMultiprocessor(&per_cu, (const void*)mk::fwd_megakernel, 512, mk::LDS_BYTES) != hipSuccess || per_cu < 1) { fprintf(stderr, "kernel_launch: occupancy query says %d\n", per_cu); per_cu = 1; }
        (void)hipGetLastError();
        grid = cus * per_cu; if (grid > 256) grid = 256;
    }
    if (grid < 0) return;
    mk::Args a{};
    for (int i = 0; i < 33; ++i) a.in[i] = (const float*)d_in[i];
    a.out = (float*)d_out; a.ws = (unsigned char*)d_ws;
#if MK_N_LAUNCH_MODE == 1
    for (int ph = 0; ph < mk::NPHASE; ++ph) { a.ph_lo = ph; a.ph_hi = ph + 1; hipLaunchKernelGGL(mk::fwd_megakernel, dim3(grid), dim3(512), mk::LDS_BYTES, stream, a); }
#else
    a.ph_lo = 0; a.ph_hi = mk::NPHASE;
    (void)hipMemsetAsync((unsigned char*)d_ws + mk::WS_BAR, 0, XCD_BAR_WORDS * sizeof(unsigned), stream);
    void* args[] = {&a};
    hipError_t e = hipLaunchCooperativeKernel((const void*)mk::fwd_megakernel, dim3(grid), dim3(512), args, mk::LDS_BYTES, stream);
    if (e != hipSuccess) fprintf(stderr, "cooperative launch failed: %s (grid %d)\n", hipGetErrorString(e), grid);
#endif
}
```

```cpp
#include <hip/hip_runtime.h>
#include <hip/hip_cooperative_groups.h>
#include <cstdio>
namespace cg = cooperative_groups;
#define MK_N_LAUNCH_MODE 0
namespace pg8 {
#define PG8_LAS __attribute__((address_space(3)))
typedef unsigned short bf16_t;
typedef short bf16x8 __attribute__((ext_vector_type(8)));
typedef float f32x4 __attribute__((ext_vector_type(4)));
typedef unsigned u32x4 __attribute__((ext_vector_type(4)));
constexpr int BM = 256, BK = 64, HALF = 128, HTB = HALF * BK * 2  , STAGE_BYTES = 8 * HTB, NXCD = 8, WGM = 8;

__host__ __device__ __forceinline__ int lds_byte(int r, int c) { const int st = (r >> 4) * 2 + (c >> 5), rr = r & 15, cc = c & 31, ob = rr * 64 + cc * 2; return st * 1024 + (ob ^ (((ob >> 9) & 1) << 5)); }
__host__ __device__ __forceinline__ void stage_rc(int b, int& R, int& C) { const int st = b / 1024, sb = b % 1024, swz = sb ^ (((sb >> 9) & 1) << 5); R = (st >> 1) * 16 + swz / 64; C = (st & 1) * 32 + (swz % 64) / 2; }
__host__ __device__ __forceinline__ int perm32(int rho) { const int n = rho >> 4, i = rho & 15; return 8 * (i >> 2) + 4 * n + (i & 3); }

__device__ __forceinline__ int pg8_tid() { int t = threadIdx.x; asm volatile("" : "+v"(t)); return t; }
struct Unit { int pm, pn; };
struct Gemm { const bf16_t* A; const bf16_t* Bt; int M, N, K; };

struct StaticOrder {
    int nM, nN, nwg, G, c;
    __host__ __device__ void init(int M, int N, int G_, int c_) { nM = M / BM; nN = N / BM; nwg = nM * nN; G = G_; c = c_; }
    __host__ __device__ bool next(int i, Unit& u) const {
        const long L = (long)i * G + c; if (L >= nwg) return false;
        int wgid = (int)L; { const int q = nwg / NXCD, r = nwg % NXCD, xcd = wgid % NXCD, off = wgid / NXCD; wgid = (xcd < r ? xcd * (q + 1) : r * (q + 1) + (xcd - r) * q) + off; }
        const int nig = WGM * nN, gid = wgid / nig, fm = gid * WGM, gsz = (nM - fm) < WGM ? (nM - fm) : WGM;
        u.pm = fm + ((wgid % nig) % gsz); u.pn = (wgid % nig) / gsz; return true;
    }
    __device__ __forceinline__ void a_ready(const Unit&) const {}
    __device__ __forceinline__ void done(const Unit&) const {}
};
typedef float f32x2c __attribute__((ext_vector_type(2))); typedef __bf16 bf16x2c __attribute__((ext_vector_type(2)));
__device__ __forceinline__ unsigned cvt_pk_native(float lo, float hi) { const f32x2c v = {lo, hi}; const bf16x2c b = __builtin_convertvector(v, bf16x2c); return __builtin_bit_cast(unsigned, b); }
__device__ __forceinline__ unsigned cvt_pk_bf16(float lo, float hi) { unsigned r; asm volatile("v_cvt_pk_bf16_f32 %0, %1, %2" : "=v"(r) : "v"(lo), "v"(hi)); return r; }
__device__ __forceinline__ void mfma_settle(const float __attribute__((ext_vector_type(4)))& a) { asm volatile("s_nop 15\n\ts_nop 7" :: "v"(a)); }
typedef float f32x2 __attribute__((ext_vector_type(2)));
template <class Epi, class Sched, bool STAMP = false>
__device__ __forceinline__ void gemm_phase(PG8_LAS unsigned char* lds, const Gemm g, const Sched& S, const Epi& E, unsigned long long* stamps) {
    const int tid = pg8_tid(), wid = __builtin_amdgcn_readfirstlane(tid >> 6), lane = tid & 63, wr = wid >> 2, wc = wid & 3, fr = lane & 15, fq = lane >> 4;
    const int K = g.K, nt = K / BK;
    int ts_lo = 0, ts_hi = 0, nts = 0; const unsigned long long rt_entry = STAMP ? (unsigned long long)wall_clock64() : 0ull;
#define PG8_STAMP() do { if (STAMP && wid == 0 && nts < 64) { const unsigned long long _c = (unsigned long long)clock64(); \
        ts_lo = (lane == nts) ? (int)(unsigned)_c : ts_lo; ts_hi = (lane == nts) ? (int)(unsigned)(_c >> 32) : ts_hi; ++nts; } } while (0)
    PG8_STAMP();
    unsigned voffA[2], voffB[2];
#pragma unroll
    for (int i = 0; i < 2; ++i) { int R, C; stage_rc(tid * 16 + i * 8192, R, C); const int Rb = Epi::PERM ? ((R & ~31) + perm32(R & 31)) : R;
        voffA[i] = (unsigned)(R * K + C) * 2u; voffB[i] = (unsigned)(Rb * K + C) * 2u; }
    const size_t kstep = (size_t)(BK * 2);
    const size_t hstep = (size_t)HALF * K * 2;
    const size_t tstep = 2 * hstep;
    const unsigned ldsw = (unsigned)wid * 1024u;
    const int aoff = lds_byte(wr * 64 + fr, fq * 8), boff = lds_byte(wc * 32 + fr, fq * 8);
#define PG8_SA(b, h) (((b) * 2 + (h)) * HTB)
#define PG8_SB(b, h) ((4 + (b) * 2 + (h)) * HTB)
#define PG8_STAGE(bufoff, gbase, voff) do { _Pragma("unroll") for (int _i = 0; _i < 2; ++_i) \
        __builtin_amdgcn_global_load_lds((const unsigned*)((const char*)(gbase) + (voff)[_i]), (PG8_LAS unsigned*)(lds + (bufoff) + ldsw + _i * 8192), 16, 0, 0); } while (0)
#define PG8_LDA(dst, b, h) do { _Pragma("unroll") for (int m = 0; m < 4; ++m) _Pragma("unroll") for (int k = 0; k < 2; ++k) dst[m][k] = *(const PG8_LAS bf16x8*)(lds + PG8_SA(b, h) + aoff + m * 2048 + k * 1024); } while (0)
#define PG8_LDB(dst, b, h) do { _Pragma("unroll") for (int n = 0; n < 2; ++n) _Pragma("unroll") for (int k = 0; k < 2; ++k) dst[n][k] = *(const PG8_LAS bf16x8*)(lds + PG8_SB(b, h) + boff + n * 2048 + k * 1024); } while (0)
#define PG8_MMA(ai, bj, At, Bt) do { __builtin_amdgcn_s_setprio(1); _Pragma("unroll") for (int m = 0; m < 4; ++m) _Pragma("unroll") for (int n = 0; n < 2; ++n) _Pragma("unroll") for (int k = 0; k < 2; ++k) \
        acc[ai][bj][m][n] = __builtin_amdgcn_mfma_f32_16x16x32_bf16(Bt[n][k], At[m][k], acc[ai][bj][m][n], 0, 0, 0); __builtin_amdgcn_s_setprio(0); } while (0)
#define PG8_WAIT_V(n) asm volatile("s_waitcnt vmcnt(" #n ")" ::: "memory")
#define PG8_WAIT_L(n) asm volatile("s_waitcnt lgkmcnt(" #n ")" ::: "memory")
#define PG8_BAR __builtin_amdgcn_s_barrier()
#define PG8_SCHED __builtin_amdgcn_sched_barrier(0)
    Unit cur, nxt; int ui = 0;
    if (!S.next(0, cur)) return;
    f32x4 acc[2][2][4][2];
#pragma unroll
    for (int a = 0; a < 2; ++a)
#pragma unroll
        for (int b = 0; b < 2; ++b)
#pragma unroll
            for (int m = 0; m < 4; ++m)
#pragma unroll
                for (int n = 0; n < 2; ++n) acc[a][b][m][n] = (f32x4){0.f, 0.f, 0.f, 0.f};
    bf16x8 At[4][2], B0[2][2], B1[2][2];
    const char* cA = (const char*)g.A + (size_t)cur.pm * tstep; const char* cB = (const char*)g.Bt + (size_t)cur.pn * tstep;
    S.a_ready(cur);
    PG8_STAGE(PG8_SB(0, 0), cB, voffB); PG8_STAGE(PG8_SA(0, 0), cA, voffA); PG8_STAGE(PG8_SB(0, 1), cB + hstep, voffB); PG8_STAGE(PG8_SA(0, 1), cA + hstep, voffA);
    if (wr == 1) PG8_BAR;
    PG8_WAIT_V(4); PG8_BAR;
    PG8_STAGE(PG8_SB(1, 0), cB + kstep, voffB); PG8_STAGE(PG8_SA(1, 0), cA + kstep, voffA); PG8_STAGE(PG8_SB(1, 1), cB + hstep + kstep, voffB);
    PG8_WAIT_V(6); PG8_BAR;
    PG8_STAMP();
    for (;;) {
        const bool has_next = S.next(ui + 1, nxt);
        const char* nA = has_next ? (const char*)g.A + (size_t)nxt.pm * tstep : cA; const char* nB = has_next ? (const char*)g.Bt + (size_t)nxt.pn * tstep : cB;
        for (int t = 0; t < nt; t += 2) {
            const bool last = (t == nt - 2);
            const char* a1 = cA + (size_t)(t + 1) * kstep;
            const char* a2 = last ? nA : cA + (size_t)(t + 2) * kstep; const char* b2 = last ? nB : cB + (size_t)(t + 2) * kstep;
            const char* a3 = a2 + kstep; const char* b3 = b2 + kstep;
            if (last && has_next) S.a_ready(nxt);
            PG8_LDB(B0, 0, 0); PG8_SCHED; PG8_LDA(At, 0, 0); PG8_STAGE(PG8_SA(1, 1), a1 + hstep, voffA);
            PG8_WAIT_L(8); PG8_BAR; PG8_WAIT_L(0); PG8_MMA(0, 0, At, B0); PG8_BAR; PG8_SCHED;
            PG8_LDB(B1, 0, 1); PG8_STAGE(PG8_SB(0, 0), b2, voffB);
            PG8_BAR; PG8_WAIT_L(0); PG8_MMA(0, 1, At, B1); PG8_BAR;
            PG8_LDA(At, 0, 1); PG8_STAGE(PG8_SA(0, 0), a2, voffA);
            PG8_BAR; PG8_WAIT_L(0); PG8_MMA(1, 0, At, B0); PG8_BAR; PG8_SCHED;
            PG8_STAGE(PG8_SB(0, 1), b2 + hstep, voffB);
            PG8_WAIT_V(6); PG8_BAR; PG8_MMA(1, 1, At, B1); PG8_BAR;
            PG8_LDB(B0, 1, 0); PG8_SCHED; PG8_LDA(At, 1, 0); PG8_STAGE(PG8_SA(0, 1), a2 + hstep, voffA);
            PG8_WAIT_L(8); PG8_BAR; PG8_WAIT_L(0); PG8_MMA(0, 0, At, B0); PG8_BAR; PG8_SCHED;
            PG8_LDB(B1, 1, 1); PG8_STAGE(PG8_SB(1, 0), b3, voffB);
            PG8_BAR; PG8_WAIT_L(0); PG8_MMA(0, 1, At, B1); PG8_BAR;
            PG8_LDA(At, 1, 1); PG8_STAGE(PG8_SA(1, 0), a3, voffA);
            PG8_BAR; PG8_WAIT_L(0); PG8_MMA(1, 0, At, B0); PG8_BAR; PG8_SCHED;
            PG8_STAGE(PG8_SB(1, 1), b3 + hstep, voffB);
            PG8_WAIT_V(6); PG8_BAR; PG8_MMA(1, 1, At, B1); PG8_BAR;
        }
        PG8_STAMP();
        if constexpr (!Epi::AFTER_DRAIN) { E(acc, cur, wr, wc, fr, fq); S.done(cur); }
        PG8_STAMP();
        if (!has_next) break;
#pragma unroll
        for (int a = 0; a < 2; ++a)
#pragma unroll
            for (int b = 0; b < 2; ++b)
#pragma unroll
                for (int m = 0; m < 4; ++m)
#pragma unroll
                    for (int n = 0; n < 2; ++n) acc[a][b][m][n] = (f32x4){0.f, 0.f, 0.f, 0.f};
        cur = nxt; cA = nA; cB = nB; ++ui;
    }
    PG8_WAIT_V(0);
    if (wr == 0) PG8_BAR;
    PG8_BAR;
    if constexpr (Epi::AFTER_DRAIN) { E.fused(acc, cur, wr, wc, fr, fq, lds, wid, lane); S.done(cur); }
    PG8_STAMP();
    if (STAMP && wid == 0) { stamps[lane] = lane < nts ? (((unsigned long long)(unsigned)ts_hi << 32) | (unsigned)ts_lo) : 0ull;
        if (lane == 62) stamps[62] = rt_entry; if (lane == 63) stamps[63] = (unsigned long long)wall_clock64(); }
#undef PG8_STAMP
#undef PG8_SA
#undef PG8_SB
#undef PG8_STAGE
#undef PG8_LDA
#undef PG8_LDB
#undef PG8_MMA
#undef PG8_WAIT_V
#undef PG8_WAIT_L
#undef PG8_BAR
#undef PG8_SCHED
}
}

namespace mk {
using pg8::bf16_t; using pg8::bf16x8; using pg8::f32x4; using pg8::u32x4; using pg8::Unit; using pg8::cvt_pk_bf16; using pg8::cvt_pk_native; using pg8::mfma_settle;
typedef unsigned u32x2 __attribute__((ext_vector_type(2)));
typedef float f32x2 __attribute__((ext_vector_type(2)));
constexpr int D = 2048, TL = 16384, TC = 256, MT = TL + TC, NCH = MT / 128;
constexpr int NPROJ = 10496, DFF = 5632;
constexpr size_t MiB = 1u << 20;
constexpr size_t WS_MVEC = 0, WS_CHD = 256 * 1024, WS_BAR = 512 * 1024, WS_S5LOC = 1 * MiB, WS_WA = 10 * MiB, WS_WB = 75 * MiB, WS_HCTX = 141 * MiB, WS_XM = 143 * MiB, WS_SST = 208 * MiB, WS_BIG = 338 * MiB, WS_S5IN = 766 * MiB, WS_END = 775 * MiB;
constexpr size_t B_U5 = 0, B_XBC = B_U5 + (size_t)MT * 1024 * 2, B_Z = B_XBC + (size_t)MT * 3072 * 2, B_GATE = B_Z + (size_t)MT * 2048 * 2, B_DT = B_GATE + (size_t)MT * 4096 * 2,
                 B_Y5 = 330 * MiB, B_YD = B_Y5 + (size_t)MT * 1024 * 2;
static_assert(B_DT + (size_t)MT * 64 * 4 <= B_Y5 && B_YD + (size_t)MT * 2048 * 2 <= 428 * MiB, "big map");
constexpr size_t B_G = 0, B_V = (size_t)MT * DFF * 2;
constexpr size_t WA_IN = 0, WA_GLU = 41 * MiB, WA_S5P = 45 * MiB, WA_SSDP = 49 * MiB, WA_WOUT = 57 * MiB, WB_UP = 0, WB_DOWN = 44 * MiB;
constexpr int LDS_BYTES = 163840;
constexpr float ALPHA = 1.41421356237f, LN_EPS = 1e-5f, RMS_EPS = 1e-5f;

struct Args { const float* in[33]; float* out; unsigned char* ws; int ph_lo, ph_hi; };

__device__ __forceinline__ float bf2f(unsigned b) { return __uint_as_float(b << 16); }
__device__ __forceinline__ float bflo(unsigned w) { return __uint_as_float(w << 16); }
__device__ __forceinline__ float bfhi(unsigned w) { return __uint_as_float(w & 0xffff0000u); }
__device__ __forceinline__ float sigm(float x) { return __builtin_amdgcn_rcpf(1.f + __expf(-x)); }
__device__ __forceinline__ float silu_(float x) { return x * __builtin_amdgcn_rcpf(1.f + __expf(-x)); }
__device__ __forceinline__ float gelu_tanh(float x) { const float u = 0.7978845608028654f * (x + 0.044715f * x * x * x); const float th = 1.f - 2.f * __builtin_amdgcn_rcpf(__expf(2.f * u) + 1.f); return 0.5f * x * (1.f + th); }
__device__ __forceinline__ bf16x8 mkfrag(unsigned a, unsigned b, unsigned c, unsigned d) { u32x4 v; v.x = a; v.y = b; v.z = c; v.w = d; return __builtin_bit_cast(bf16x8, v); }
__device__ __forceinline__ float* hrow(const Args& a, int row) { return row < TL ? a.out + (size_t)row * D : (float*)(a.ws + WS_HCTX) + (size_t)(row - TL) * D; }
__device__ __forceinline__ const float* mvec(const Args& a, int layer, int isctx) { return (const float*)(a.ws + WS_MVEC) + (size_t)(layer * 2 + isctx) * 12288; }

struct EpiInProj {
    static constexpr bool PERM = true, AFTER_DRAIN = false;
    unsigned char* big; const float* dt_bias;
    __device__ __forceinline__ void operator()(const f32x4 (&acc)[2][2][4][2], const Unit& u, int wr, int wc, int fr, int fq) const {
        mfma_settle(acc[1][1][3][1]); mfma_settle(acc[1][1][3][0]);
        const int row0 = u.pm * 256 + wr * 64 + fr, ct = u.pn * 256;
        if (ct >= 10240) {
            if (wc < 2) { const int cc = wc * 32 + 8 * fq; float* DT = (float*)(big + B_DT);
                const f32x4 b0 = *(const f32x4*)(dt_bias + cc), b1 = *(const f32x4*)(dt_bias + cc + 4);
#pragma unroll
                for (int ai = 0; ai < 2; ++ai)
#pragma unroll
                    for (int m = 0; m < 4; ++m) { float* rp = DT + (size_t)(row0 + ai * 128 + m * 16) * 64 + cc; f32x4 v0 = acc[ai][0][m][0] + b0, v1 = acc[ai][0][m][1] + b1;
#pragma unroll
                        for (int j = 0; j < 4; ++j) { v0[j] = v0[j] > 20.f ? v0[j] : log1pf(expf(v0[j])); v1[j] = v1[j] > 20.f ? v1[j] : log1pf(expf(v1[j])); }
                        *(f32x4*)rp = v0; *(f32x4*)(rp + 4) = v1; } }
            return;
        }
        bf16_t* base; int ld, c0; bool sg = false;
        if (ct < 1024) { base = (bf16_t*)(big + B_U5); ld = 1024; c0 = ct; }
        else if (ct < 4096) { base = (bf16_t*)(big + B_XBC); ld = 3072; c0 = ct - 1024; }
        else if (ct < 6144) { base = (bf16_t*)(big + B_Z); ld = 2048; c0 = ct - 4096; }
        else { base = (bf16_t*)(big + B_GATE); ld = 4096; c0 = ct - 6144; sg = true; }
        const int col0 = c0 + wc * 32 + 8 * fq;
#pragma unroll
        for (int ai = 0; ai < 2; ++ai)
#pragma unroll
            for (int m = 0; m < 4; ++m) { bf16_t* rowp = base + (size_t)(row0 + ai * 128 + m * 16) * ld + col0;
#pragma unroll
                for (int bj = 0; bj < 2; ++bj) { f32x4 v0 = acc[ai][bj][m][0], v1 = acc[ai][bj][m][1];
                    if (sg) {
#pragma unroll
                        for (int j = 0; j < 4; ++j) { v0[j] = sigm(v0[j]); v1[j] = sigm(v1[j]); } }
                    u32x4 w; w.x = cvt_pk_native(v0[0], v0[1]); w.y = cvt_pk_native(v0[2], v0[3]); w.z = cvt_pk_native(v1[0], v1[1]); w.w = cvt_pk_native(v1[2], v1[3]);
                    *(u32x4*)(rowp + bj * 128) = w; } }
    }
};
struct EpiGlu {
    static constexpr bool PERM = true, AFTER_DRAIN = false;
    bf16_t* O;
    __device__ __forceinline__ void operator()(const f32x4 (&acc)[2][2][4][2], const Unit& u, int wr, int wc, int fr, int fq) const {
        mfma_settle(acc[1][1][3][1]); mfma_settle(acc[1][1][3][0]);
        const int row0 = u.pm * 256 + wr * 64 + fr, col0 = u.pn * 128 + wc * 32 + 8 * fq;
#pragma unroll
        for (int ai = 0; ai < 2; ++ai)
#pragma unroll
            for (int m = 0; m < 4; ++m) { f32x4 v0 = acc[ai][0][m][0], v1 = acc[ai][0][m][1]; const f32x4 g0 = acc[ai][1][m][0], g1 = acc[ai][1][m][1];
#pragma unroll
                for (int j = 0; j < 4; ++j) { v0[j] *= sigm(g0[j]); v1[j] *= sigm(g1[j]); }
                u32x4 w; w.x = cvt_pk_bf16(v0[0], v0[1]); w.y = cvt_pk_bf16(v0[2], v0[3]); w.z = cvt_pk_bf16(v1[0], v1[1]); w.w = cvt_pk_bf16(v1[2], v1[3]);
                *(u32x4*)(O + (size_t)(row0 + ai * 128 + m * 16) * 1024 + col0) = w; }
    }
};
template <int SECOND, int GSEL = SECOND> struct EpiMerge {
    static constexpr bool PERM = true, AFTER_DRAIN = false;
    bf16_t* MG; const bf16_t* GATE;
    __device__ __forceinline__ void operator()(const f32x4 (&acc)[2][2][4][2], const Unit& u, int wr, int wc, int fr, int fq) const {
        mfma_settle(acc[1][1][3][1]); mfma_settle(acc[1][1][3][0]);
        const int row0 = u.pm * 256 + wr * 64 + fr, col0 = u.pn * 256 + wc * 32 + 8 * fq;
#pragma unroll
        for (int ai = 0; ai < 2; ++ai)
#pragma unroll
            for (int m = 0; m < 4; ++m) { const size_t r = (size_t)(row0 + ai * 128 + m * 16); u32x4 gg[2], oo[2];
#pragma unroll
                for (int bj = 0; bj < 2; ++bj) { const int c = col0 + bj * 128; gg[bj] = *(const u32x4*)(GATE + r * 4096 + (GSEL ? 2048 : 0) + c); if (SECOND) oo[bj] = *(const u32x4*)(MG + r * 2048 + c); }
                __builtin_amdgcn_sched_barrier(0);
#pragma unroll
                for (int bj = 0; bj < 2; ++bj) { const int c = col0 + bj * 128; const u32x4 g = gg[bj];
                    f32x4 v0 = acc[ai][bj][m][0], v1 = acc[ai][bj][m][1];
                    v0[0] *= bflo(g.x); v0[1] *= bfhi(g.x); v0[2] *= bflo(g.y); v0[3] *= bfhi(g.y); v1[0] *= bflo(g.z); v1[1] *= bfhi(g.z); v1[2] *= bflo(g.w); v1[3] *= bfhi(g.w);
                    if (SECOND) { const u32x4 o = oo[bj];
                        v0[0] += bflo(o.x); v0[1] += bfhi(o.x); v0[2] += bflo(o.y); v0[3] += bfhi(o.y); v1[0] += bflo(o.z); v1[1] += bfhi(o.z); v1[2] += bflo(o.w); v1[3] += bfhi(o.w); }
                    u32x4 w; w.x = cvt_pk_bf16(v0[0], v0[1]); w.y = cvt_pk_bf16(v0[2], v0[3]); w.z = cvt_pk_bf16(v1[0], v1[1]); w.w = cvt_pk_bf16(v1[2], v1[3]);
                    *(u32x4*)(MG + r * 2048 + c) = w; }
                __builtin_amdgcn_sched_barrier(0); }
    }
};
struct EpiResid {
    static constexpr bool PERM = false, AFTER_DRAIN = false;
    float* out; float* hctx; const float* glat; const float* gctx;
    __device__ __forceinline__ void operator()(const f32x4 (&acc)[2][2][4][2], const Unit& u, int wr, int wc, int fr, int fq) const {
        mfma_settle(acc[1][1][3][1]); mfma_settle(acc[1][1][3][0]);
        const bool isctx = u.pm >= 64; const float* g = isctx ? gctx : glat;
        float* hb = isctx ? hctx + (size_t)(wr * 64 + fr) * D : out + (size_t)(u.pm * 256 + wr * 64 + fr) * D;
        const int col0 = u.pn * 256 + wc * 32 + 4 * fq;
        f32x4 gv[2][2];
#pragma unroll
        for (int bj = 0; bj < 2; ++bj)
#pragma unroll
            for (int n = 0; n < 2; ++n) gv[bj][n] = *(const f32x4*)(g + col0 + bj * 128 + n * 16);
#pragma unroll
        for (int ai = 0; ai < 2; ++ai)
#pragma unroll
            for (int m = 0; m < 4; ++m) { float* rowp = hb + (size_t)(ai * 128 + m * 16) * D + col0;
                { f32x4 h[2][2];
#pragma unroll
                for (int bj = 0; bj < 2; ++bj)
#pragma unroll
                    for (int n = 0; n < 2; ++n) h[bj][n] = *(const f32x4*)(rowp + bj * 128 + n * 16);
                __builtin_amdgcn_sched_barrier(0);
#pragma unroll
                for (int bj = 0; bj < 2; ++bj)
#pragma unroll
                    for (int n = 0; n < 2; ++n) *(f32x4*)(rowp + bj * 128 + n * 16) = h[bj][n] * ALPHA + gv[bj][n] * acc[ai][bj][m][n];
                __builtin_amdgcn_sched_barrier(0); } }
    }
};
struct EpiUp {
    static constexpr bool PERM = true, AFTER_DRAIN = false;
    bf16_t* G; bf16_t* V;
    __device__ __forceinline__ void operator()(const f32x4 (&acc)[2][2][4][2], const Unit& u, int wr, int wc, int fr, int fq) const {
        mfma_settle(acc[1][1][3][1]); mfma_settle(acc[1][1][3][0]);
        const int row0 = u.pm * 256 + wr * 64 + fr; int ct = u.pn * 256; bf16_t* base = G; if (ct >= DFF) { base = V; ct -= DFF; }
        const int col0 = ct + wc * 32 + 8 * fq;
#pragma unroll
        for (int ai = 0; ai < 2; ++ai)
#pragma unroll
            for (int m = 0; m < 4; ++m) { bf16_t* rowp = base + (size_t)(row0 + ai * 128 + m * 16) * DFF + col0;
#pragma unroll
                for (int bj = 0; bj < 2; ++bj) { const f32x4 v0 = acc[ai][bj][m][0], v1 = acc[ai][bj][m][1];
                    u32x4 w; w.x = cvt_pk_native(v0[0], v0[1]); w.y = cvt_pk_native(v0[2], v0[3]); w.z = cvt_pk_native(v1[0], v1[1]); w.w = cvt_pk_native(v1[2], v1[3]);
                    *(u32x4*)(rowp + bj * 128) = w; } }
    }
};

struct XItem { const float* W; bf16_t* WT; int K, N, d0, s0, k0; };
__device__ __forceinline__ void xpose_load(const XItem& x, float (&v)[32], int lane) {
#pragma unroll
    for (int i = 0; i < 32; ++i) { const int kk = 2 * i + (lane >> 5); v[i] = x.s0 >= 0 ? x.W[(size_t)(x.k0 + kk) * x.N + x.s0 + (lane & 31)] : 0.f; }
}
__device__ __forceinline__ void xpose_store(const XItem& x, const float (&v)[32], float* scr, int lane) {
#pragma unroll
    for (int i = 0; i < 32; ++i) { const int kk = 2 * i + (lane >> 5); scr[kk * 33 + (lane & 31)] = v[i]; }
    asm volatile("s_waitcnt lgkmcnt(0)" ::: "memory");
    const int c = lane & 7;
#pragma unroll
    for (int j = 0; j < 4; ++j) { const int n = (lane >> 3) + 8 * j; const float* sp = scr + (8 * c) * 33 + n;
        u32x4 o; o.x = cvt_pk_bf16(sp[0 * 33], sp[1 * 33]); o.y = cvt_pk_bf16(sp[2 * 33], sp[3 * 33]); o.z = cvt_pk_bf16(sp[4 * 33], sp[5 * 33]); o.w = cvt_pk_bf16(sp[6 * 33], sp[7 * 33]);
        *(u32x4*)(x.WT + (size_t)(x.d0 + n) * x.K + x.k0 + 8 * c) = o; }
    asm volatile("s_waitcnt lgkmcnt(0)" ::: "memory");
}
__device__ __forceinline__ XItem xpose_decode(const Args& a, int layer, int region, int r) {
    XItem x;
    if (region == 0) {
        bf16_t* WA = (bf16_t*)(a.ws + WS_WA);
        constexpr int I_IN = 32 * 328, I_GLU = 16 * 64, I_S5P = 16 * 64, I_SSDP = 32 * 64;
        if (r < I_IN) { const int kb = r / 328, d0 = (r % 328) * 32; int s0; if (d0 < 4096) s0 = d0; else if (d0 < 10240) s0 = d0 + 64; else if (d0 < 10304) s0 = d0 - 10240 + 4096; else s0 = -1;
            x.W = a.in[6] + (size_t)layer * 2048 * 10304; x.WT = WA + WA_IN / 2; x.K = 2048; x.N = 10304; x.d0 = d0; x.s0 = s0; x.k0 = kb * 64; return x; } r -= I_IN;
        if (r < I_GLU) { const int kb = r / 64, d0 = (r % 64) * 32, t = d0 >> 8, j = d0 & 255;
            x.W = a.in[15] + (size_t)layer * 1024 * 2048; x.WT = WA + WA_GLU / 2; x.K = 1024; x.N = 2048; x.d0 = d0; x.s0 = j < 128 ? t * 128 + j : 1024 + t * 128 + (j - 128); x.k0 = kb * 64; return x; } r -= I_GLU;
        if (r < I_S5P) { x.W = a.in[16] + (size_t)layer * 1024 * 2048; x.WT = WA + WA_S5P / 2; x.K = 1024; x.N = 2048; x.d0 = (r % 64) * 32; x.s0 = x.d0; x.k0 = (r / 64) * 64; return x; } r -= I_S5P;
        if (r < I_SSDP) { x.W = a.in[23] + (size_t)layer * 2048 * 2048; x.WT = WA + WA_SSDP / 2; x.K = 2048; x.N = 2048; x.d0 = (r % 64) * 32; x.s0 = x.d0; x.k0 = (r / 64) * 64; return x; } r -= I_SSDP;
        x.W = a.in[24] + (size_t)layer * 2048 * 2048; x.WT = WA + WA_WOUT / 2; x.K = 2048; x.N = 2048; x.d0 = (r % 64) * 32; x.s0 = x.d0; x.k0 = (r / 64) * 64; return x;
    }
    bf16_t* WB = (bf16_t*)(a.ws + WS_WB); constexpr int I_UP = 32 * 352;
    if (r < I_UP) { x.W = a.in[27] + (size_t)layer * 2048 * 11264; x.WT = WB + WB_UP / 2; x.K = 2048; x.N = 11264; x.d0 = (r % 352) * 32; x.s0 = x.d0; x.k0 = (r / 352) * 64; return x; } r -= I_UP;
    x.W = a.in[30] + (size_t)layer * 5632 * 2048; x.WT = WB + WB_DOWN / 2; x.K = 5632; x.N = 2048; x.d0 = (r % 64) * 32; x.s0 = x.d0; x.k0 = (r / 64) * 64; return x;
}
__device__ __forceinline__ void xpose_region(const Args& a, int layer, int region, float* scr, int gw, int NGW, int lane) {
    const int NI = region == 0 ? (32 * 328 + 16 * 64 + 16 * 64 + 32 * 64 + 32 * 64) : (32 * 352 + 88 * 64);
    int it = gw;
    for (; it + 3 * NGW < NI; it += 4 * NGW) {
        const XItem x0 = xpose_decode(a, layer, region, it), x1 = xpose_decode(a, layer, region, it + NGW), x2 = xpose_decode(a, layer, region, it + 2 * NGW), x3 = xpose_decode(a, layer, region, it + 3 * NGW);
        float v0[32], v1[32], v2[32], v3[32]; xpose_load(x0, v0, lane); xpose_load(x1, v1, lane); xpose_load(x2, v2, lane); xpose_load(x3, v3, lane);
        xpose_store(x0, v0, scr, lane); xpose_store(x1, v1, scr, lane); xpose_store(x2, v2, scr, lane); xpose_store(x3, v3, scr, lane);
    }
    for (; it < NI; it += NGW) { const XItem x0 = xpose_decode(a, layer, region, it); float v0[32]; xpose_load(x0, v0, lane); xpose_store(x0, v0, scr, lane); }
}

__device__ __forceinline__ void adaln_phase(const Args& a, float* lds, int tid) {
    float* sc = lds; float* scx = lds + 2048; float* red = lds + 4096;
    for (int i = tid; i < 2048; i += 512) { sc[i] = silu_(a.in[1][i]); scx[i] = silu_(a.in[3][i]); }
    __syncthreads();
    for (int unit = blockIdx.x; unit < 256; unit += gridDim.x) {
        const int layer = unit >> 7, col0 = (unit & 127) * 96;
        const float* W = a.in[4] + (size_t)layer * 2048 * 12288 + col0;
        if (tid < 504) { const int cq = tid % 24, ks = tid / 24; f32x4 al = {0.f, 0.f, 0.f, 0.f}, ac = {0.f, 0.f, 0.f, 0.f};
#pragma unroll 14
            for (int k = ks; k < 2048; k += 21) { const f32x4 w = *(const f32x4*)(W + (size_t)k * 12288 + cq * 4); al += w * sc[k]; ac += w * scx[k]; }
            *(f32x4*)(red + (ks * 2 + 0) * 96 + cq * 4) = al; *(f32x4*)(red + (ks * 2 + 1) * 96 + cq * 4) = ac; }
        __syncthreads();
        if (tid < 192) { const int v = tid / 96, c = tid % 96; float s = 0.f; for (int ks = 0; ks < 21; ++ks) s += red[(ks * 2 + v) * 96 + c];
            ((float*)(a.ws + WS_MVEC))[(size_t)(layer * 2 + v) * 12288 + col0 + c] = s + a.in[5][(size_t)layer * 12288 + col0 + c]; }
        __syncthreads();
    }
}

__device__ __forceinline__ float wave_sum(float v) {
#pragma unroll
    for (int o = 1; o < 64; o <<= 1) v += __shfl_xor(v, o);
    return v;
}
template <int MODE> __device__ __forceinline__ void row_phase(const Args& a, int nrows, const float* lng, const float* lnb, int mod_layer, int mod_off, int gw, int NGW, int lane) {
    bf16_t* XM = (bf16_t*)(a.ws + WS_XM);
    f32x4 lg[8], lb[8];
    if (MODE == 1) {
#pragma unroll
        for (int j = 0; j < 8; ++j) { lg[j] = *(const f32x4*)(lng + 4 * lane + 256 * j); lb[j] = *(const f32x4*)(lnb + 4 * lane + 256 * j); } }
    for (int row0 = gw; row0 < nrows; row0 += 2 * NGW) {
        const int row1 = row0 + NGW < nrows ? row0 + NGW : row0;
        const int rows[2] = {row0, row1}; f32x4 v[2][8];
#pragma unroll
        for (int u = 0; u < 2; ++u) { const int row = rows[u]; const int isctx = row >= TL;
            const float* src = MODE == 0 ? (isctx ? a.in[2] + (size_t)(row - TL) * D : a.in[0] + (size_t)row * D) : hrow(a, row);
#pragma unroll
            for (int j = 0; j < 8; ++j) v[u][j] = *(const f32x4*)(src + 4 * lane + 256 * j); }
        if (MODE == 1) {
            float s[2], q[2];
#pragma unroll
            for (int u = 0; u < 2; ++u) { s[u] = 0.f;
#pragma unroll
                for (int j = 0; j < 8; ++j) s[u] += (v[u][j][0] + v[u][j][1]) + (v[u][j][2] + v[u][j][3]); }
            s[0] = wave_sum(s[0]); s[1] = wave_sum(s[1]);
#pragma unroll
            for (int u = 0; u < 2; ++u) { const float mean = s[u] * (1.f / D); q[u] = 0.f;
#pragma unroll
                for (int j = 0; j < 8; ++j) { v[u][j] = v[u][j] - mean; q[u] += (v[u][j][0] * v[u][j][0] + v[u][j][1] * v[u][j][1]) + (v[u][j][2] * v[u][j][2] + v[u][j][3] * v[u][j][3]); } }
            q[0] = wave_sum(q[0]); q[1] = wave_sum(q[1]);
#pragma unroll
            for (int u = 0; u < 2; ++u) { const float rstd = __builtin_amdgcn_rsqf(q[u] * (1.f / D) + LN_EPS);
#pragma unroll
                for (int j = 0; j < 8; ++j) v[u][j] = v[u][j] * rstd * lg[j] + lb[j]; }
        }
#pragma unroll
        for (int u = 0; u < 2; ++u) { const int row = rows[u]; const int isctx = row >= TL; float* h = hrow(a, row);
#pragma unroll
            for (int j = 0; j < 8; ++j) *(f32x4*)(h + 4 * lane + 256 * j) = v[u][j];
            if (mod_layer >= 0) { const float* m = mvec(a, mod_layer, isctx) + mod_off; f32x4 shv[8], scv[8];
#pragma unroll
                for (int j = 0; j < 8; ++j) { shv[j] = *(const f32x4*)(m + 4 * lane + 256 * j); scv[j] = *(const f32x4*)(m + D + 4 * lane + 256 * j); }
                __builtin_amdgcn_sched_barrier(0);
#pragma unroll
                for (int j = 0; j < 8; ++j) { const f32x4 sh = shv[j], scl = scv[j]; const f32x4 o = v[u][j] * (scl + 1.f) + sh;
                    u32x2 w; w.x = cvt_pk_bf16(o[0], o[1]); w.y = cvt_pk_bf16(o[2], o[3]); *(u32x2*)(XM + (size_t)row * D + 4 * lane + 256 * j) = w; } } }
    }
}

__device__ __forceinline__ void ffnconv_ctx(const Args& a, int layer, int tid) {
    const bf16_t* G = (const bf16_t*)(a.ws + WS_BIG + B_G); bf16_t* V = (bf16_t*)(a.ws + WS_BIG + B_V);
    const float* cw = a.in[28] + (size_t)layer * 9 * DFF; const float* cb = a.in[29] + (size_t)layer * DFF;
    const int nunits = 260 * 11; const int oc = tid & 63, xs = tid >> 6;
    for (int unit = 256 * 11 + blockIdx.x; unit < nunits; unit += gridDim.x) {
        const int seg = unit / 11, ob = unit % 11, ch0 = ob * 512 + oc * 8; const bool cs = seg >= 256; const int t0 = seg * 64;
        float w[9][8], bias[8];
#pragma unroll
        for (int k = 0; k < 9; ++k) { const f32x4 w0 = *(const f32x4*)(cw + (size_t)k * DFF + ch0), w1 = *(const f32x4*)(cw + (size_t)k * DFF + ch0 + 4);
            w[k][0] = w0[0]; w[k][1] = w0[1]; w[k][2] = w0[2]; w[k][3] = w0[3]; w[k][4] = w1[0]; w[k][5] = w1[1]; w[k][6] = w1[2]; w[k][7] = w1[3]; }
        { const f32x4 b0 = *(const f32x4*)(cb + ch0), b1 = *(const f32x4*)(cb + ch0 + 4); bias[0] = b0[0]; bias[1] = b0[1]; bias[2] = b0[2]; bias[3] = b0[3]; bias[4] = b1[0]; bias[5] = b1[1]; bias[6] = b1[2]; bias[7] = b1[3]; }
#pragma unroll 4
        for (int xi = 0; xi < 8; ++xi) { const int x = xs * 8 + xi, t = t0 + x; float acc[8];
#pragma unroll
            for (int k = 0; k < 8; ++k) acc[k] = bias[k];
            u32x4 g3[3]; bf16_t* vp = V + (size_t)t * DFF + ch0;
#pragma unroll
            for (int dx = -1; dx <= 1; ++dx) { const bool ok = t + dx >= TL && t + dx < MT; g3[dx + 1] = *(const u32x4*)(G + (size_t)(ok ? t + dx : t) * DFF + ch0); }
            const u32x4 vv = *(const u32x4*)vp;
            __builtin_amdgcn_sched_barrier(0);
#pragma unroll
            for (int dx = -1; dx <= 1; ++dx) { const bool ok = t + dx >= TL && t + dx < MT; u32x4 g = g3[dx + 1]; if (!ok) g = (u32x4){0u, 0u, 0u, 0u}; const int k = 3 + dx + 1;
                acc[0] += w[k][0] * bflo(g.x); acc[1] += w[k][1] * bfhi(g.x); acc[2] += w[k][2] * bflo(g.y); acc[3] += w[k][3] * bfhi(g.y);
                acc[4] += w[k][4] * bflo(g.z); acc[5] += w[k][5] * bfhi(g.z); acc[6] += w[k][6] * bflo(g.w); acc[7] += w[k][7] * bfhi(g.w); }
            u32x4 o; o.x = cvt_pk_bf16(silu_(acc[0]) * bflo(vv.x), silu_(acc[1]) * bfhi(vv.x)); o.y = cvt_pk_bf16(silu_(acc[2]) * bflo(vv.y), silu_(acc[3]) * bfhi(vv.y));
            o.z = cvt_pk_bf16(silu_(acc[4]) * bflo(vv.z), silu_(acc[5]) * bfhi(vv.z)); o.w = cvt_pk_bf16(silu_(acc[6]) * bflo(vv.w), silu_(acc[7]) * bfhi(vv.w));
            *(u32x4*)vp = o; }
    }
}

__device__ __forceinline__ void ffnconv_phase(const Args& a, int layer, bool with_ctx, unsigned char* lds, int tid) {
    const bf16_t* G = (const bf16_t*)(a.ws + WS_BIG + B_G); bf16_t* V = (bf16_t*)(a.ws + WS_BIG + B_V);
    const float* cw = a.in[28] + (size_t)layer * 9 * DFF; const float* cb = a.in[29] + (size_t)layer * DFF;
    bf16_t* T = (bf16_t*)lds;
    const int oc = tid & 15, ts = tid >> 4;
    u32x4 gn[12];
#define FFC_PREFETCH(unit_) do { const int rg_ = (unit_) / 44, ch_ = ((unit_) % 44) * 128 + oc * 8, y0_ = rg_ * 4; \
        _Pragma("unroll") for (int i = 0; i < 12; ++i) { const int idx = tid + i * 512, r = idx >> 10, x = (idx >> 4) & 63, y = y0_ - 1 + r; const bool ok = y >= 0 && y < 256; \
            gn[i] = *(const u32x4*)(G + (size_t)((ok ? y : y0_) * 64 + x) * DFF + ch_); } } while (0)
    int unit = blockIdx.x;
    if (unit < 64 * 44) FFC_PREFETCH(unit);
    for (; unit < 64 * 44; unit += gridDim.x) {
        const int rg = unit / 44, ch0 = (unit % 44) * 128 + oc * 8, y0 = rg * 4;
        __syncthreads();
#pragma unroll
        for (int i = 0; i < 12; ++i) { const int idx = tid + i * 512, r = idx >> 10, x = (idx >> 4) & 63, y = y0 - 1 + r; const bool ok = y >= 0 && y < 256;
            *(u32x4*)(T + ((r * 64 + x) * 128 + oc * 8)) = ok ? gn[i] : (u32x4){0u, 0u, 0u, 0u}; }
        u32x4 vv[8];
#pragma unroll
        for (int o = 0; o < 8; ++o) vv[o] = *(const u32x4*)(V + (size_t)((y0 + (o >> 1)) * 64 + ts * 2 + (o & 1)) * DFF + ch0);
        float w[9][8], bias[8];
#pragma unroll
        for (int k = 0; k < 9; ++k) { const f32x4 w0 = *(const f32x4*)(cw + (size_t)k * DFF + ch0), w1 = *(const f32x4*)(cw + (size_t)k * DFF + ch0 + 4);
            w[k][0] = w0[0]; w[k][1] = w0[1]; w[k][2] = w0[2]; w[k][3] = w0[3]; w[k][4] = w1[0]; w[k][5] = w1[1]; w[k][6] = w1[2]; w[k][7] = w1[3]; }
        { const f32x4 b0 = *(const f32x4*)(cb + ch0), b1 = *(const f32x4*)(cb + ch0 + 4); bias[0] = b0[0]; bias[1] = b0[1]; bias[2] = b0[2]; bias[3] = b0[3]; bias[4] = b1[0]; bias[5] = b1[1]; bias[6] = b1[2]; bias[7] = b1[3]; }
        __syncthreads();
        __builtin_amdgcn_sched_barrier(0);
        if (unit + (int)gridDim.x < 64 * 44) FFC_PREFETCH(unit + (int)gridDim.x);
        __builtin_amdgcn_sched_barrier(0);
#pragma unroll
        for (int o = 0; o < 8; ++o) { const int rr = o >> 1, x = ts * 2 + (o & 1); float acc[8];
#pragma unroll
            for (int k = 0; k < 8; ++k) acc[k] = bias[k];
#pragma unroll
            for (int dy = -1; dy <= 1; ++dy)
#pragma unroll
                for (int dx = -1; dx <= 1; ++dx) { const int xn = x + dx; const bool ok = xn >= 0 && xn < 64;
                    u32x4 g = *(const u32x4*)(T + (((rr + 1 + dy) * 64 + (ok ? xn : x)) * 128 + oc * 8)); if (!ok) g = (u32x4){0u, 0u, 0u, 0u}; const int k = (dy + 1) * 3 + dx + 1;
                    acc[0] += w[k][0] * bflo(g.x); acc[1] += w[k][1] * bfhi(g.x); acc[2] += w[k][2] * bflo(g.y); acc[3] += w[k][3] * bfhi(g.y);
                    acc[4] += w[k][4] * bflo(g.z); acc[5] += w[k][5] * bfhi(g.z); acc[6] += w[k][6] * bflo(g.w); acc[7] += w[k][7] * bfhi(g.w); }
            const u32x4 v = vv[o];
            u32x4 q; q.x = cvt_pk_bf16(silu_(acc[0]) * bflo(v.x), silu_(acc[1]) * bfhi(v.x)); q.y = cvt_pk_bf16(silu_(acc[2]) * bflo(v.y), silu_(acc[3]) * bfhi(v.y));
            q.z = cvt_pk_bf16(silu_(acc[4]) * bflo(v.z), silu_(acc[5]) * bfhi(v.z)); q.w = cvt_pk_bf16(silu_(acc[6]) * bflo(v.w), silu_(acc[7]) * bfhi(v.w));
            *(u32x4*)(V + (size_t)((y0 + rr) * 64 + x) * DFF + ch0) = q; }
    }
#undef FFC_PREFETCH
    __syncthreads();
    if (with_ctx) ffnconv_ctx(a, layer, tid);
}
__device__ __forceinline__ int s5_chunk_at(int dir, int q) { return dir ? 129 - q : (q + 128) % 130; }
__device__ __forceinline__ int s5_pos_of(int dir, int c) { return dir ? 129 - c : (c + 2) % 130; }
template <int PASS> __device__ __forceinline__ void s5_phase(const Args& a, int layer, unsigned char* lds, int tid, int nchunks) {
    constexpr int BUP = 132;
    const bf16_t* U5 = (const bf16_t*)(a.ws + WS_BIG + B_U5); bf16_t* Y5 = (bf16_t*)(a.ws + WS_BIG + B_Y5);
    float2* S5LOC = (float2*)(a.ws + WS_S5LOC);
    const int lane = tid & 63, w = tid >> 6, gl = w >> 1, dir = w & 1, p = lane, fr = lane & 15, fq = lane >> 4;
    float* BuW = (float*)lds + (size_t)w * (16 * BUP);
    bf16_t* STw = (bf16_t*)(lds + 67584) + (size_t)w * (16 * 136);
    float* YL = (float*)(lds + 102400);
    const int gq = blockIdx.x & 15, g = gq * 4 + gl;
    float ab_re, ab_im, a128r, a128i;
    const float step = expf(a.in[9][(size_t)(layer * 2 + dir) * 64 + g]);
    { const size_t pi = ((size_t)(layer * 2 + dir) * 64 + g) * 64 + p; const float lre = fminf(a.in[7][pi], -1e-4f), lim = a.in[8][pi];
      const float mag = expf(lre * step); float sn, cs; sincosf(lim * step, &sn, &cs); ab_re = mag * cs; ab_im = mag * sn; a128r = ab_re; a128i = ab_im;
#pragma unroll
      for (int k = 0; k < 7; ++k) { const float r = a128r * a128r - a128i * a128i, i = 2.f * a128r * a128i; a128r = r; a128i = i; } }
    bf16x8 bbf[8];
#pragma unroll
    for (int nt = 0; nt < 8; ++nt) { const int pp = nt * 8 + (fr >> 1), cc = fr & 1; const size_t pi = ((size_t)(layer * 2 + dir) * 64 + g) * 64 + pp;
        const float lre = fminf(a.in[7][pi], -1e-4f), lim = a.in[8][pi]; const float mag = expf(lre * step); float sn, cs; sincosf(lim * step, &sn, &cs);
        const float are = mag * cs, aim = mag * sn, den = lre * lre + lim * lim, q_re = ((are - 1.f) * lre + aim * lim) / den, q_im = (aim * lre - (are - 1.f) * lim) / den;
        const float* br = a.in[10] + (((size_t)layer * 64 + g) * 64 + pp) * 16 + (fq & 1) * 8; const float* bi = a.in[11] + (((size_t)layer * 64 + g) * 64 + pp) * 16 + (fq & 1) * 8;
        const f32x4 r0 = *(const f32x4*)br, r1 = *(const f32x4*)(br + 4), i0 = *(const f32x4*)bi, i1 = *(const f32x4*)(bi + 4); float v[8];
#pragma unroll
        for (int j = 0; j < 8; ++j) { const float r = j < 4 ? r0[j & 3] : r1[j & 3], i = j < 4 ? i0[j & 3] : i1[j & 3]; v[j] = fq < 2 ? (cc ? q_re * i + q_im * r : q_re * r - q_im * i) : 0.f; }
        bbf[nt] = mkfrag(cvt_pk_bf16(v[0], v[1]), cvt_pk_bf16(v[2], v[3]), cvt_pk_bf16(v[4], v[5]), cvt_pk_bf16(v[6], v[7])); }
    bf16x8 cm[4];
    if (PASS == 1) {
        const float* cre = a.in[12] + (((size_t)(layer * 2 + dir) * 64 + g) * 16 + fr) * 64; const float* cim = a.in[13] + (((size_t)(layer * 2 + dir) * 64 + g) * 16 + fr) * 64;
#pragma unroll
        for (int ks = 0; ks < 4; ++ks) { const f32x4 r = *(const f32x4*)(cre + ks * 16 + fq * 4), i = *(const f32x4*)(cim + ks * 16 + fq * 4);
            cm[ks] = mkfrag(cvt_pk_bf16(r[0], -i[0]), cvt_pk_bf16(r[1], -i[1]), cvt_pk_bf16(r[2], -i[2]), cvt_pk_bf16(r[3], -i[3])); }
    }
    const int cstep = gridDim.x >> 4;
    float2* S5IN = (float2*)(a.ws + WS_S5IN);
    if (PASS == 1) {
        float sr = 0.f, si = 0.f;
#pragma unroll 1
        for (int q0 = 0; q0 < NCH; q0 += 13) { float2 l[13];
#pragma unroll
            for (int i = 0; i < 13; ++i) l[i] = S5LOC[((size_t)(dir * NCH + s5_chunk_at(dir, q0 + i)) * 64 + g) * 64 + p];
#pragma unroll
            for (int i = 0; i < 13; ++i) { const int cc = s5_chunk_at(dir, q0 + i);
                if (cc < nchunks && (cc % cstep) == (int)(blockIdx.x >> 4)) S5IN[((size_t)(dir * NCH + cc) * 64 + g) * 64 + p] = make_float2(sr, si);
                const float nr = a128r * sr - a128i * si + l[i].x, ni = a128r * si + a128i * sr + l[i].y; sr = nr; si = ni; } }
    }
    for (int c = blockIdx.x >> 4; c < nchunks; c += cstep) {
        const int row0 = c * 128;
        bf16x8 uf[8];
#pragma unroll
        for (int k = 0; k < 8; ++k) { const int sl = dir ? 7 - k : k; uf[k] = *(const bf16x8*)(U5 + (size_t)(row0 + sl * 16 + fr) * 1024 + g * 16 + (fq & 1) * 8); }
        __builtin_amdgcn_sched_barrier(0);
#pragma unroll
        for (int k = 0; k < 8; ++k) if (fq >= 2) uf[k] = mkfrag(0u, 0u, 0u, 0u);
        float sr = 0.f, si = 0.f;
        if (PASS == 1) { const float2 s0 = S5IN[((size_t)(dir * NCH + c) * 64 + g) * 64 + p]; sr = s0.x; si = s0.y; }
        f32x4 yacc[8];
#pragma unroll
        for (int k = 0; k < 8; ++k) {
#pragma unroll
            for (int nt = 0; nt < 8; ++nt) { f32x4 acc = {0.f, 0.f, 0.f, 0.f}; acc = __builtin_amdgcn_mfma_f32_16x16x32_bf16(uf[k], bbf[nt], acc, 0, 0, 0);
#pragma unroll
                for (int jj = 0; jj < 4; ++jj) BuW[(fq * 4 + jj) * BUP + nt * 16 + fr] = acc[jj]; }
            asm volatile("s_waitcnt lgkmcnt(0)" ::: "memory");
#pragma unroll
            for (int ii = 0; ii < 16; ++ii) { const int tl = dir ? 15 - ii : ii; const f32x2 b2 = *(const f32x2*)(BuW + tl * BUP + 2 * p);
                f32x2 ns = __builtin_elementwise_fma((f32x2){ab_re, ab_re}, (f32x2){sr, si}, b2); ns = __builtin_elementwise_fma((f32x2){-ab_im, ab_im}, (f32x2){si, sr}, ns); sr = ns[0]; si = ns[1];
                if (PASS == 1) *(unsigned*)(STw + tl * 136 + 2 * p) = cvt_pk_bf16(sr, si); }
            if (PASS == 1) {
                asm volatile("s_waitcnt lgkmcnt(0)" ::: "memory");
                f32x4 acc = {0.f, 0.f, 0.f, 0.f};
#pragma unroll
                for (int ks = 0; ks < 4; ++ks) acc = __builtin_amdgcn_mfma_f32_16x16x32_bf16(*(const bf16x8*)(STw + fr * 136 + ks * 32 + fq * 8), cm[ks], acc, 0, 0, 0);
                yacc[k] = acc;
            }
            asm volatile("s_waitcnt lgkmcnt(0)" ::: "memory");
        }
        if (PASS == 0) { S5LOC[((size_t)(dir * NCH + c) * 64 + g) * 64 + p] = make_float2(sr, si); }
        else {
            __syncthreads();
            if (dir == 0) {
#pragma unroll
                for (int k = 0; k < 8; ++k)
#pragma unroll
                    for (int jj = 0; jj < 4; ++jj) YL[gl * 2048 + (k * 16 + fq * 4 + jj) * 16 + fr] = yacc[k][jj]; }
            __syncthreads();
            if (dir == 1) {
#pragma unroll
                for (int k = 0; k < 8; ++k)
#pragma unroll
                    for (int jj = 0; jj < 4; ++jj) YL[gl * 2048 + ((7 - k) * 16 + fq * 4 + jj) * 16 + fr] += yacc[k][jj]; }
            __syncthreads();
            const int t = tid >> 2, q = tid & 3; const float* y = YL + q * 2048 + t * 16; const float* dd = a.in[14] + (size_t)layer * 1024 + gq * 64 + q * 16;
            const bf16_t* us = U5 + (size_t)(row0 + t) * 1024 + gq * 64 + q * 16; const u32x4 u0 = *(const u32x4*)us, u1 = *(const u32x4*)(us + 8);
            const float u[16] = {bflo(u0.x), bfhi(u0.x), bflo(u0.y), bfhi(u0.y), bflo(u0.z), bfhi(u0.z), bflo(u0.w), bfhi(u0.w), bflo(u1.x), bfhi(u1.x), bflo(u1.y), bfhi(u1.y), bflo(u1.z), bfhi(u1.z), bflo(u1.w), bfhi(u1.w)};
            unsigned o[8];
#pragma unroll
            for (int j = 0; j < 8; ++j) { const float y0 = y[2 * j] + u[2 * j] * dd[2 * j], y1 = y[2 * j + 1] + u[2 * j + 1] * dd[2 * j + 1]; o[j] = cvt_pk_bf16(gelu_tanh(y0), gelu_tanh(y1)); }
            bf16_t* dst = Y5 + (size_t)(row0 + t) * 1024 + gq * 64 + q * 16; u32x4 o0, o1; o0.x = o[0]; o0.y = o[1]; o0.z = o[2]; o0.w = o[3]; o1.x = o[4]; o1.y = o[5]; o1.z = o[6]; o1.w = o[7];
            *(u32x4*)dst = o0; *(u32x4*)(dst + 8) = o1;
        }
    }
    __syncthreads();
}

__device__ __forceinline__ int ssd_chunk_at(int dir, int q) { return s5_chunk_at(dir, q); }
__device__ __forceinline__ void conv8(const bf16_t* XBC, int rowbase, int l0, int ch, bool lo_ok, bool hi_ok, float w0, float w1, float w2, float b, float (&out)[8]) {
    float r[10];
#pragma unroll
    for (int i = 0; i < 10; ++i) { const int l = l0 - 1 + i; const bool ok = (l >= 0 || lo_ok) && (l < 128 || hi_ok); r[i] = ok ? bf2f((unsigned)XBC[(size_t)(rowbase + l) * 3072 + ch]) : 0.f; }
#pragma unroll
    for (int j = 0; j < 8; ++j) out[j] = silu_(w0 * r[j] + w1 * r[j + 1] + w2 * r[j + 2] + b);
}
__device__ __forceinline__ void stage_conv_tile(const bf16_t* XBC, const float* cw, const float* cb, int rowbase, int chbase, bool lo_ok, bool hi_ok, bf16_t* dst, int tid) {
    const int oc = tid & 15, ch = chbase + oc * 8; float w[3][8], b[8];
#pragma unroll
    for (int k = 0; k < 3; ++k) { const f32x4 a0 = *(const f32x4*)(cw + (size_t)k * 3072 + ch), a1 = *(const f32x4*)(cw + (size_t)k * 3072 + ch + 4);
        w[k][0] = a0[0]; w[k][1] = a0[1]; w[k][2] = a0[2]; w[k][3] = a0[3]; w[k][4] = a1[0]; w[k][5] = a1[1]; w[k][6] = a1[2]; w[k][7] = a1[3]; }
    { const f32x4 a0 = *(const f32x4*)(cb + ch), a1 = *(const f32x4*)(cb + ch + 4); b[0] = a0[0]; b[1] = a0[1]; b[2] = a0[2]; b[3] = a0[3]; b[4] = a1[0]; b[5] = a1[1]; b[6] = a1[2]; b[7] = a1[3]; }
    u32x4 gl[4][3];
#pragma unroll
    for (int i = 0; i < 4; ++i) { const int row = (tid >> 4) + i * 32;
#pragma unroll
        for (int d = 0; d < 3; ++d) { const bool ok = d == 1 ? true : (d == 0 ? (row > 0 || lo_ok) : (row < 127 || hi_ok)); const int l = ok ? row + d - 1 : row;
            gl[i][d] = *(const u32x4*)(XBC + (size_t)(rowbase + l) * 3072 + ch); } }
    __builtin_amdgcn_sched_barrier(0);
#pragma unroll
    for (int i = 0; i < 4; ++i) { const int row = (tid >> 4) + i * 32; float acc[8];
#pragma unroll
        for (int k = 0; k < 8; ++k) acc[k] = b[k];
#pragma unroll
        for (int d = 0; d < 3; ++d) { const bool ok = d == 1 ? true : (d == 0 ? (row > 0 || lo_ok) : (row < 127 || hi_ok));
            { u32x4 g = gl[i][d]; if (!ok) g = (u32x4){0u, 0u, 0u, 0u};
                acc[0] += w[d][0] * bflo(g.x); acc[1] += w[d][1] * bfhi(g.x); acc[2] += w[d][2] * bflo(g.y); acc[3] += w[d][3] * bfhi(g.y);
                acc[4] += w[d][4] * bflo(g.z); acc[5] += w[d][5] * bfhi(g.z); acc[6] += w[d][6] * bflo(g.w); acc[7] += w[d][7] * bfhi(g.w); } }
        u32x4 o; o.x = cvt_pk_bf16(silu_(acc[0]), silu_(acc[1])); o.y = cvt_pk_bf16(silu_(acc[2]), silu_(acc[3])); o.z = cvt_pk_bf16(silu_(acc[4]), silu_(acc[5])); o.w = cvt_pk_bf16(silu_(acc[6]), silu_(acc[7]));
        *(u32x4*)(dst + row * 136 + oc * 8) = o; }
}
constexpr int SL_CS = 0, SL_CB = 34816, SL_CUM = 69632, SL_DT = 77824, SL_PART = 86016, SL_BS = 94208, SL_XT = 94208;
template <int AUX> __device__ __forceinline__ void ssd_cum(const Args& a, int layer, int c, int h, int w, int lane, unsigned char* lds) {
    const float* DT = (const float*)(a.ws + WS_BIG + B_DT); float* cumL = (float*)(lds + SL_CUM); float* dtL = (float*)(lds + SL_DT); float* CHD = (float*)(a.ws + WS_CHD);
#pragma unroll
    for (int dir = 0; dir < 2; ++dir) {
        const float ah = -expf(a.in[20][(size_t)(layer * 2 + dir) * 32 + h]);
        const float d0 = DT[(size_t)(c * 128 + 2 * lane) * 64 + dir * 32 + h], d1 = DT[(size_t)(c * 128 + 2 * lane + 1) * 64 + dir * 32 + h];
        const float l0 = d0 * ah, l1 = d1 * ah, s = l0 + l1; float incl = s;
#pragma unroll
        for (int o = 1; o < 64; o <<= 1) { const float t = __shfl_up(incl, o); if (lane >= o) incl += t; }
        const float excl = incl - s, tot = __shfl(incl, 63);
        float c0, c1;
        if (dir == 0) { c0 = excl + l0; c1 = incl; } else { c0 = tot - excl; c1 = tot - (excl + l0); }
        float* cu = cumL + (dir * 8 + w) * 128 + 2 * lane; cu[0] = c0; cu[1] = c1;
        float* dd = dtL + (dir * 8 + w) * 128 + 2 * lane;
        if (AUX == 0) { dd[0] = d0; dd[1] = d1; } else { dd[0] = d0 * __expf(tot - c0); dd[1] = d1 * __expf(tot - c1); if (lane == 0) CHD[(size_t)(dir * NCH + c) * 32 + h] = tot; }
    }
}
__device__ __forceinline__ void stage_T(const bf16_t* XBC, const float* cw, const float* cb, int rowbase, int ch, int r0, bool lo_ok, bool hi_ok, bf16_t* dstT) {
    float w[3][8], b[8];
#pragma unroll
    for (int k = 0; k < 3; ++k) { const f32x4 a0 = *(const f32x4*)(cw + (size_t)k * 3072 + ch), a1 = *(const f32x4*)(cw + (size_t)k * 3072 + ch + 4);
        w[k][0] = a0[0]; w[k][1] = a0[1]; w[k][2] = a0[2]; w[k][3] = a0[3]; w[k][4] = a1[0]; w[k][5] = a1[1]; w[k][6] = a1[2]; w[k][7] = a1[3]; }
    { const f32x4 a0 = *(const f32x4*)(cb + ch), a1 = *(const f32x4*)(cb + ch + 4); b[0] = a0[0]; b[1] = a0[1]; b[2] = a0[2]; b[3] = a0[3]; b[4] = a1[0]; b[5] = a1[1]; b[6] = a1[2]; b[7] = a1[3]; }
    u32x4 raw[10];
    const bf16_t* base = XBC + (size_t)(rowbase + r0) * 3072 + ch;
    const bool ok0 = r0 > 0 || lo_ok, ok9 = r0 < 120 || hi_ok;
#pragma unroll
    for (int i = 1; i < 9; ++i) raw[i] = *(const u32x4*)(base + (i - 1) * 3072);
    raw[0] = *(const u32x4*)(base + (ok0 ? -3072 : 0)); raw[9] = *(const u32x4*)(base + (ok9 ? 8 * 3072 : 7 * 3072));
    __builtin_amdgcn_sched_barrier(0);
    if (!ok0) raw[0] = (u32x4){0u, 0u, 0u, 0u};
    if (!ok9) raw[9] = (u32x4){0u, 0u, 0u, 0u};
    float sp[8]; unsigned o[8][4];
#pragma unroll
    for (int r = 0; r < 8; ++r) { float sv[8];
#pragma unroll
        for (int k = 0; k < 8; ++k) { float acc = b[k];
#pragma unroll
            for (int d = 0; d < 3; ++d) { const unsigned wd = k < 2 ? raw[r + d].x : (k < 4 ? raw[r + d].y : (k < 6 ? raw[r + d].z : raw[r + d].w)); acc += w[d][k] * ((k & 1) ? bfhi(wd) : bflo(wd)); }
            sv[k] = silu_(acc); }
        if (r & 1) {
#pragma unroll
            for (int k = 0; k < 8; ++k) o[k][r >> 1] = cvt_pk_bf16(sp[k], sv[k]); }
        else {
#pragma unroll
            for (int k = 0; k < 8; ++k) sp[k] = sv[k]; } }
#pragma unroll
    for (int k = 0; k < 8; ++k) { u32x4 v; v.x = o[k][0]; v.y = o[k][1]; v.z = o[k][2]; v.w = o[k][3]; *(u32x4*)(dstT + k * 136 + r0) = v; }
}
__device__ __forceinline__ void ssd_a_phase(const Args& a, int layer, unsigned char* lds, int tid) {
    const bf16_t* XBC = (const bf16_t*)(a.ws + WS_BIG + B_XBC); bf16_t* SST = (bf16_t*)(a.ws + WS_SST);
    const float* cw = a.in[17] + (size_t)layer * 3 * 3072; const float* cb = a.in[18] + (size_t)layer * 3072;
    bf16_t* BT = (bf16_t*)(lds + SL_CS); bf16_t* xT = (bf16_t*)(lds + SL_XT); const float* wL = (const float*)(lds + SL_DT);
    for (int unit = (blockIdx.x + (gridDim.x >> 1)) % gridDim.x; unit < NCH * 4; unit += gridDim.x) {
        int tl = tid; asm volatile("" : "+v"(tl));
        const int lane = tl & 63, w = __builtin_amdgcn_readfirstlane(tl >> 6), fr = lane & 15, fq = lane >> 4, og = lane & 7, rr = lane >> 3;
        const int c = unit >> 2, g = unit & 3, rowbase = c * 128; const bool lo_ok = !(c == 0 || c == 128), hi_ok = !(c == 127 || c == 129);
        __syncthreads();
        if (w < 4) { const int oct = (w & 1) * 8 + og; stage_T(XBC, cw, cb, rowbase, 2048 + g * 128 + oct * 8, ((w >> 1) * 8 + rr) * 8, lo_ok, hi_ok, BT + (oct * 8) * 136); }
        ssd_cum<1>(a, layer, c, g * 8 + w, w, lane, lds);
#pragma unroll 1
        for (int pass = 0; pass < 2; ++pass) {
            if (pass) __syncthreads();
            { const int hs = w & 3; stage_T(XBC, cw, cb, rowbase, (g * 8 + pass * 4 + hs) * 64 + og * 8, ((w >> 2) * 8 + rr) * 8, lo_ok, hi_ok, xT + ((hs * 64 + og * 8) * 136)); }
            __syncthreads();
            const int hl = w >> 1, dir = w & 1, hh = pass * 4 + hl, h = g * 8 + hh;
            bf16_t* sb = SST + (((size_t)(dir * NCH + c) * 32 + h) * 64) * 128;
#pragma unroll 1
            for (int nh = 0; nh < 2; ++nh) {
                f32x4 acc[4][4];
#pragma unroll
                for (int pt = 0; pt < 4; ++pt)
#pragma unroll
                    for (int nt = 0; nt < 4; ++nt) acc[pt][nt] = (f32x4){0.f, 0.f, 0.f, 0.f};
#pragma unroll
                for (int ks = 0; ks < 4; ++ks) {
                    const float* wp = wL + (dir * 8 + hh) * 128 + ks * 32 + fq * 8; const f32x4 wl0 = *(const f32x4*)wp, wl1 = *(const f32x4*)(wp + 4);
                    bf16x8 yf[4];
#pragma unroll
                    for (int pt = 0; pt < 4; ++pt) { const u32x4 xr = *(const u32x4*)(xT + ((hl * 64 + pt * 16 + fr) * 136 + ks * 32 + fq * 8));
                        yf[pt] = mkfrag(cvt_pk_bf16(bflo(xr.x) * wl0[0], bfhi(xr.x) * wl0[1]), cvt_pk_bf16(bflo(xr.y) * wl0[2], bfhi(xr.y) * wl0[3]), cvt_pk_bf16(bflo(xr.z) * wl1[0], bfhi(xr.z) * wl1[1]), cvt_pk_bf16(bflo(xr.w) * wl1[2], bfhi(xr.w) * wl1[3])); }
#pragma unroll
                    for (int nt = 0; nt < 4; ++nt) { const bf16x8 xf = *(const bf16x8*)(BT + ((nh * 4 + nt) * 16 + fr) * 136 + ks * 32 + fq * 8);
#pragma unroll
                        for (int pt = 0; pt < 4; ++pt) acc[pt][nt] = __builtin_amdgcn_mfma_f32_16x16x32_bf16(xf, yf[pt], acc[pt][nt], 0, 0, 0); }
                }
#pragma unroll
                for (int pt = 0; pt < 4; ++pt) mfma_settle(acc[pt][3]);
#pragma unroll
                for (int pt = 0; pt < 4; ++pt)
#pragma unroll
                    for (int nt = 0; nt < 4; ++nt) { u32x2 o; o.x = cvt_pk_native(acc[pt][nt][0], acc[pt][nt][1]); o.y = cvt_pk_native(acc[pt][nt][2], acc[pt][nt][3]);
                        *(u32x2*)(sb + (size_t)(pt * 16 + fr) * 128 + (nh * 4 + nt) * 16 + fq * 4) = o; }
            }
        }
    }
    __syncthreads();
}
__device__ __forceinline__ void ssd_b_phase(const Args& a, int tid) {
    bf16_t* SST = (bf16_t*)(a.ws + WS_SST); const float* CHD = (const float*)(a.ws + WS_CHD);
    for (int idx = blockIdx.x * 512 + tid; idx < 64 * 2048; idx += gridDim.x * 512) {
        const int e4 = idx & 2047, hd = idx >> 11, dir = hd >> 5, h = hd & 31; float s0 = 0.f, s1 = 0.f, s2 = 0.f, s3 = 0.f;
#pragma unroll 1
        for (int b = 0; b < 13; ++b) { u32x2 loc[10]; float dc[10];
#pragma unroll
            for (int i = 0; i < 10; ++i) { const int cq = ssd_chunk_at(dir, b * 10 + i); loc[i] = *(const u32x2*)(SST + ((size_t)(dir * NCH + cq) * 32 + h) * 8192 + e4 * 4); dc[i] = CHD[(size_t)(dir * NCH + cq) * 32 + h]; }
#pragma unroll
            for (int i = 0; i < 10; ++i) { const int cq = ssd_chunk_at(dir, b * 10 + i); u32x2 o; o.x = cvt_pk_bf16(s0, s1); o.y = cvt_pk_bf16(s2, s3);
                *(u32x2*)(SST + ((size_t)(dir * NCH + cq) * 32 + h) * 8192 + e4 * 4) = o; const float e = __expf(dc[i]);
                s0 = e * s0 + bflo(loc[i].x); s1 = e * s1 + bfhi(loc[i].x); s2 = e * s2 + bflo(loc[i].y); s3 = e * s3 + bfhi(loc[i].y); }
        }
    }
}
__device__ __forceinline__ void ssd_c_phase(const Args& a, int layer, unsigned char* lds, int tid, int nchunks) {
    const bf16_t* XBC = (const bf16_t*)(a.ws + WS_BIG + B_XBC); const bf16_t* SST = (const bf16_t*)(a.ws + WS_SST); const bf16_t* Z = (const bf16_t*)(a.ws + WS_BIG + B_Z); bf16_t* YD = (bf16_t*)(a.ws + WS_BIG + B_YD);
    const float* cw = a.in[17] + (size_t)layer * 3 * 3072; const float* cb = a.in[18] + (size_t)layer * 3072; const float* normw = a.in[22] + (size_t)layer * 2048;
    bf16_t* Cs = (bf16_t*)(lds + SL_CS); bf16_t* Bs = (bf16_t*)(lds + SL_BS); bf16_t* CBs = (bf16_t*)(lds + SL_CB); bf16_t* xT = (bf16_t*)(lds + SL_XT);
    const float* cumL = (const float*)(lds + SL_CUM); const float* dtL = (const float*)(lds + SL_DT); float* part = (float*)(lds + SL_PART);
    for (int unit = (blockIdx.x + (gridDim.x >> 1)) % gridDim.x; unit < nchunks * 4; unit += gridDim.x) {
        int tl = tid; asm volatile("" : "+v"(tl));
        const int lane = tl & 63, w = __builtin_amdgcn_readfirstlane(tl >> 6), fr = lane & 15, fq = lane >> 4, og = lane & 7, rr = lane >> 3;
        const int hl = w & 3, lh = w >> 2;
        const int c = unit >> 2, g = unit & 3, rowbase = c * 128; const bool lo_ok = !(c == 0 || c == 128), hi_ok = !(c == 127 || c == 129);
        __syncthreads();
        stage_conv_tile(XBC, cw, cb, rowbase, 2560 + g * 128, lo_ok, hi_ok, Cs, tl);
        stage_conv_tile(XBC, cw, cb, rowbase, 2048 + g * 128, lo_ok, hi_ok, Bs, tl);
        ssd_cum<0>(a, layer, c, g * 8 + w, w, lane, lds);
        __syncthreads();
#pragma unroll 1
        for (int st = 0; st < 8; ++st) { f32x4 acc = {0.f, 0.f, 0.f, 0.f};
#pragma unroll
            for (int ks = 0; ks < 4; ++ks) { const bf16x8 xf = *(const bf16x8*)(Bs + (st * 16 + fr) * 136 + ks * 32 + fq * 8), yf = *(const bf16x8*)(Cs + (w * 16 + fr) * 136 + ks * 32 + fq * 8);
                acc = __builtin_amdgcn_mfma_f32_16x16x32_bf16(xf, yf, acc, 0, 0, 0); }
            mfma_settle(acc);
            u32x2 o; o.x = cvt_pk_native(acc[0], acc[1]); o.y = cvt_pk_native(acc[2], acc[3]); *(u32x2*)(CBs + (w * 16 + fr) * 136 + st * 16 + fq * 4) = o; }
#pragma unroll 1
        for (int pass = 0; pass < 2; ++pass) {
            __syncthreads();
            stage_T(XBC, cw, cb, rowbase, (g * 8 + pass * 4 + hl) * 64 + og * 8, (lh * 8 + rr) * 8, lo_ok, hi_ok, xT + ((hl * 64 + og * 8) * 136));
            __syncthreads();
            const int hh = pass * 4 + hl, h = g * 8 + hh; const float Dh = a.in[21][(size_t)layer * 32 + h];
#pragma unroll 1
            for (int ih = 0; ih < 2; ++ih) {
            f32x4 acc[2][4]; u32x2 zq[2][4];
#pragma unroll
            for (int i = 0; i < 2; ++i)
#pragma unroll
                for (int pt = 0; pt < 4; ++pt) { acc[i][pt] = (f32x4){0.f, 0.f, 0.f, 0.f};
                    zq[i][pt] = *(const u32x2*)(Z + (size_t)(rowbase + (lh * 4 + ih * 2 + i) * 16 + fr) * 2048 + h * 64 + pt * 16 + fq * 4); }
#pragma unroll
            for (int dir = 0; dir < 2; ++dir) {
                const bf16_t* sb = SST + (((size_t)(dir * NCH + c) * 32 + h) * 64) * 128;
                f32x4 tmp[2][4];
#pragma unroll
                for (int i = 0; i < 2; ++i)
#pragma unroll
                    for (int pt = 0; pt < 4; ++pt) tmp[i][pt] = (f32x4){0.f, 0.f, 0.f, 0.f};
#pragma unroll
                for (int ks = 0; ks < 4; ++ks) { const int lb = (lh * 4 + ih * 2) * 16 + fr; bf16x8 sfr[4];
#pragma unroll
                    for (int pt = 0; pt < 4; ++pt) sfr[pt] = *(const bf16x8*)(sb + (size_t)(pt * 16 + fr) * 128 + ks * 32 + fq * 8);
                    const bf16x8 yf0 = *(const bf16x8*)(Cs + lb * 136 + ks * 32 + fq * 8), yf1 = *(const bf16x8*)(Cs + (lb + 16) * 136 + ks * 32 + fq * 8);
                    __builtin_amdgcn_sched_barrier(0);
#pragma unroll
                    for (int pt = 0; pt < 4; ++pt) {
                        tmp[0][pt] = __builtin_amdgcn_mfma_f32_16x16x32_bf16(sfr[pt], yf0, tmp[0][pt], 0, 0, 0); tmp[1][pt] = __builtin_amdgcn_mfma_f32_16x16x32_bf16(sfr[pt], yf1, tmp[1][pt], 0, 0, 0); } }
#pragma unroll
                for (int i = 0; i < 2; ++i) { int frv = fr; asm volatile("" : "+v"(frv));
                    const int lt = lh * 4 + ih * 2 + i, l = lt * 16 + frv;
                    const float cl = cumL[(dir * 8 + hh) * 128 + l], el = __expf(cl);
#pragma unroll
                    for (int pt = 0; pt < 4; ++pt) acc[i][pt] += tmp[i][pt] * el;
#pragma unroll
                    for (int ks = 0; ks < 4; ++ks) { const int s0 = ks * 32;
                        const bool skip = dir == 0 ? (s0 > lt * 16 + 15) : (s0 + 31 < lt * 16);
                        if (!skip) { const u32x4 cbv = *(const u32x4*)(CBs + l * 136 + s0 + fq * 8);
                            const float* cp = cumL + (dir * 8 + hh) * 128 + s0 + fq * 8; const float* dp = dtL + (dir * 8 + hh) * 128 + s0 + fq * 8;
                            const f32x4 c0 = *(const f32x4*)cp, c1 = *(const f32x4*)(cp + 4), d0 = *(const f32x4*)dp, d1 = *(const f32x4*)(dp + 4);
                            float cbf[8] = {bflo(cbv.x), bfhi(cbv.x), bflo(cbv.y), bfhi(cbv.y), bflo(cbv.z), bfhi(cbv.z), bflo(cbv.w), bfhi(cbv.w)}; float v[8];
#pragma unroll
                            for (int j = 0; j < 8; ++j) { const int sx = s0 + fq * 8 + j; const float cs = j < 4 ? c0[j & 3] : c1[j & 3], ds = j < 4 ? d0[j & 3] : d1[j & 3];
                                const bool valid = dir == 0 ? (sx <= l) : (sx >= l); float t = valid ? cbf[j] * __expf(fminf(cl - cs, 0.f)) * ds : 0.f; if (dir == 0 && sx == l) t += Dh; v[j] = t; }
                            const bf16x8 yf = mkfrag(cvt_pk_bf16(v[0], v[1]), cvt_pk_bf16(v[2], v[3]), cvt_pk_bf16(v[4], v[5]), cvt_pk_bf16(v[6], v[7]));
#pragma unroll
                            for (int pt = 0; pt < 4; ++pt) acc[i][pt] = __builtin_amdgcn_mfma_f32_16x16x32_bf16(*(const bf16x8*)(xT + ((hl * 64 + pt * 16 + fr) * 136 + s0 + fq * 8)), yf, acc[i][pt], 0, 0, 0); } }
                }
            }
#pragma unroll
            for (int i = 0; i < 2; ++i) { const int l = (lh * 4 + ih * 2 + i) * 16 + fr; const size_t row = (size_t)(rowbase + l); float ss = 0.f;
#pragma unroll
                for (int pt = 0; pt < 4; ++pt) { const int ch = h * 64 + pt * 16 + fq * 4; const u32x2 zz = zq[i][pt];
                    const float h0 = acc[i][pt][0] * silu_(bflo(zz.x)), h1 = acc[i][pt][1] * silu_(bfhi(zz.x)), h2 = acc[i][pt][2] * silu_(bflo(zz.y)), h3 = acc[i][pt][3] * silu_(bfhi(zz.y));
                    ss += (h0 * h0 + h1 * h1) + (h2 * h2 + h3 * h3); u32x2 o; o.x = cvt_pk_bf16(h0, h1); o.y = cvt_pk_bf16(h2, h3); *(u32x2*)(YD + row * 2048 + ch) = o; }
                ss += __shfl_xor(ss, 16); ss += __shfl_xor(ss, 32);
                if (fq == 0) part[hh * 128 + l] = ss; }
            }
        }
        __syncthreads();
#pragma unroll 1
        for (int it = 0; it < 8; ++it) { const int pass = it >> 2, i = it & 3, l = (lh * 4 + i) * 16 + fr, h = g * 8 + pass * 4 + hl; float tot = 0.f;
#pragma unroll
            for (int hd = 0; hd < 8; ++hd) tot += part[hd * 128 + l];
            const float r = __builtin_amdgcn_rsqf(tot * (1.f / 512.f) + RMS_EPS); const size_t row = (size_t)(rowbase + l);
            u32x2 hq[4]; f32x4 nq[4];
#pragma unroll
            for (int pt = 0; pt < 4; ++pt) { const int ch = h * 64 + pt * 16 + fq * 4; hq[pt] = *(const u32x2*)(YD + row * 2048 + ch); nq[pt] = *(const f32x4*)(normw + ch); }
            __builtin_amdgcn_sched_barrier(0);
#pragma unroll
            for (int pt = 0; pt < 4; ++pt) { const int ch = h * 64 + pt * 16 + fq * 4; bf16_t* yp = YD + row * 2048 + ch; const u32x2 hv = hq[pt]; const f32x4 nw = nq[pt];
                u32x2 o; o.x = cvt_pk_bf16(bflo(hv.x) * r * nw[0], bfhi(hv.x) * r * nw[1]); o.y = cvt_pk_bf16(bflo(hv.y) * r * nw[2], bfhi(hv.y) * r * nw[3]); *(u32x2*)yp = o; }
            __builtin_amdgcn_sched_barrier(0); }
    }
    __syncthreads();
}

#define LAS __attribute__((address_space(3)))
#define XB_TMO      128
#define XB_XCNT(j)  (256  + 64 * (j))
#define XB_XSUB(j)  (1280 + 64 * (j))
#define XB_XGEN(j)  (2304 + 64 * (j))
#define XB_TOP      3328
#define XB_TOPGEN   3392
#define XCD_BAR_WORDS 3456
#define XB_SPIN_CAP (1u << 18)

__device__ __forceinline__ unsigned xb_ld(unsigned* p)              { return __hip_atomic_load(p, __ATOMIC_RELAXED, __HIP_MEMORY_SCOPE_AGENT); }
__device__ __forceinline__ unsigned xb_add(unsigned* p, unsigned v) { return __hip_atomic_fetch_add(p, v, __ATOMIC_RELAXED, __HIP_MEMORY_SCOPE_AGENT); }
__device__ __forceinline__ unsigned xb_xcc_id() { return (unsigned)__builtin_amdgcn_s_getreg((3 << 11) | 20) & 0xFu; }
#define XB_SPIN(cond, bar) do { unsigned _sp = 0; while (cond) { __builtin_amdgcn_s_sleep(1); \
    if ((++_sp & 255u) == 0u) { if (xb_ld(&(bar)[XB_TMO])) break; if (_sp > XB_SPIN_CAP) { atomicAdd(&(bar)[XB_TMO], 1u); break; } } } } while (0)

struct XcdBarrier {
    unsigned* bar; unsigned x;
    volatile LAS unsigned* st;
};

__device__ __forceinline__ XcdBarrier xcd_barrier_post(unsigned* bar, volatile LAS unsigned* st) {
    XcdBarrier b; b.bar = bar; b.x = xb_xcc_id(); b.st = st;
    if (threadIdx.x == 0) (void)xb_add(&bar[XB_XCNT(b.x)], 1u);
    return b;
}
__device__ __forceinline__ void xcd_barrier_complete(unsigned* bar, unsigned x, unsigned& nloc, unsigned& nx) {
    const unsigned G = gridDim.x * gridDim.y * gridDim.z;
    unsigned sum, cnt, mine, sp = 0u;
    for (;;) {
        sum = 0u; cnt = 0u; mine = 0u;
#pragma unroll
        for (unsigned j = 0; j < 16; ++j) { const unsigned c = xb_ld(&bar[XB_XCNT(j)]); sum += c; cnt += (c > 0u) ? 1u : 0u; mine = (j == x) ? c : mine; }
        if (sum == G) break;
        __builtin_amdgcn_s_sleep(1);
        if ((++sp & 255u) == 0u) { if (xb_ld(&bar[XB_TMO])) break; if (sp > XB_SPIN_CAP) { atomicAdd(&bar[XB_TMO], 1u); break; } }
    }
    nloc = mine > 0u ? mine : 1u; nx = cnt > 0u ? cnt : 1u;
}

__device__ __forceinline__ void xcd_barrier(const XcdBarrier& b) {
    asm volatile("s_waitcnt vmcnt(0)" ::: "memory");
    __syncthreads();
    if (threadIdx.x == 0) {
        unsigned* bar = b.bar;
        __builtin_amdgcn_s_waitcnt(0);
        unsigned nloc = b.st[0], nx = b.st[1];
        if (nloc == 0u) { xcd_barrier_complete(bar, b.x, nloc, nx); b.st[0] = nloc; b.st[1] = nx; }
        const unsigned old = xb_add(&bar[XB_XSUB(b.x)], 1u);
        const unsigned gen = old / nloc;
        if (old + 1u == (gen + 1u) * nloc) {
            __builtin_amdgcn_fence(__ATOMIC_RELEASE, "agent");
            asm volatile("s_waitcnt vmcnt(0)" ::: "memory");
            const unsigned og = xb_add(&bar[XB_TOP], 1u);
            const unsigned tg = og / nx;
            if (og + 1u == (tg + 1u) * nx) xb_add(&bar[XB_TOPGEN], 1u);
            else XB_SPIN(xb_ld(&bar[XB_TOPGEN]) == tg, bar);
            __builtin_amdgcn_fence(__ATOMIC_ACQUIRE, "agent");
            xb_add(&bar[XB_XGEN(b.x)], 1u);
            asm volatile("s_waitcnt vmcnt(0)" ::: "memory");
        } else {
            XB_SPIN(xb_ld(&bar[XB_XGEN(b.x)]) == gen, bar);
            __builtin_amdgcn_fence(__ATOMIC_ACQUIRE, "agent");
            asm volatile("s_waitcnt vmcnt(0)" ::: "memory");
        }
    }
    __syncthreads();
}

#ifndef MK_REP_S5
#define MK_REP_S5 1
#endif
#ifndef MK_REP_SSD
#define MK_REP_SSD 1
#endif
#ifndef MK_REP_SYNC
#define MK_REP_SYNC 1
#endif
#ifndef MK_CG_SYNC_ALL
#define MK_CG_SYNC_ALL 0
#endif
#ifndef MK_REP_PRO
#define MK_REP_PRO 1
#endif
#ifndef MK_REP_GEMM
#define MK_REP_GEMM 1
#endif
constexpr int NPHASE = 2 + 11 * 2;
__global__ void __launch_bounds__(512, 2) fwd_megakernel(Args a) {
    extern __shared__ __attribute__((aligned(16))) unsigned char lds[];
    PG8_LAS unsigned char* lds3 = (PG8_LAS unsigned char*)lds;
    unsigned char* big = a.ws + WS_BIG;
    volatile LAS unsigned* bst = (volatile LAS unsigned*)(lds3 + (LDS_BYTES - 16));
    if (threadIdx.x < 4) bst[threadIdx.x] = 0u;
    __syncthreads();
    XcdBarrier xbar; xbar.bar = (unsigned*)(a.ws + WS_BAR); xbar.x = 0; xbar.st = bst;
    if (a.ph_hi - a.ph_lo > 1) xbar = xcd_barrier_post((unsigned*)(a.ws + WS_BAR), bst);
    for (int ph = a.ph_lo; ph < a.ph_hi; ++ph) {
        const int tid = pg8::pg8_tid(), lane = tid & 63, wave = tid >> 6, gw = blockIdx.x * 8 + wave, NGW = gridDim.x * 8;
        if (ph == 0) {
            for (int rep = 0; rep < MK_REP_PRO; ++rep) {
            adaln_phase(a, (float*)lds, tid);
            float* scr = (float*)lds + wave * (64 * 33);
            xpose_region(a, 0, 0, scr, gw, NGW, lane); xpose_region(a, 0, 1, scr, gw, NGW, lane); __syncthreads(); }
        } else if (ph == 1) {
            row_phase<0>(a, MT, nullptr, nullptr, 0, 0, gw, NGW, lane);
        } else {
            const int layer = (ph - 2) / 11, k = (ph - 2) % 11; const bool last = layer == 1; const int Mrows = last ? TL : MT;
            const bf16_t* WA = (const bf16_t*)(a.ws + WS_WA); const bf16_t* WB = (const bf16_t*)(a.ws + WS_WB);
#ifdef MK_SKIP_MASK
            if ((MK_SKIP_MASK >> k) & 1) { if (ph + 1 < a.ph_hi) xcd_barrier(xbar); continue; }
#endif
            if (k == 0) {
                pg8::Gemm g{(const bf16_t*)(a.ws + WS_XM), WA + WA_IN / 2, MT, NPROJ, D}; pg8::StaticOrder S; S.init(MT, NPROJ, gridDim.x, blockIdx.x);
                EpiInProj E{big, a.in[19] + (size_t)layer * 64}; for (int rep = 0; rep < MK_REP_GEMM; ++rep) { pg8::gemm_phase<EpiInProj, pg8::StaticOrder>(lds3, g, S, E, nullptr); __syncthreads(); }
            } else if (k == 1) {
                for (int rep = 0; rep < MK_REP_SSD; ++rep) ssd_a_phase(a, layer, lds, tid);
                for (int rep = 0; rep < MK_REP_S5; ++rep) s5_phase<0>(a, layer, lds, tid, NCH);
            } else if (k == 2) {
#if !defined(MK_NO_SSD) && !defined(MK_NO_SSDB)
                ssd_b_phase(a, tid);
#endif
                for (int rep = 0; rep < MK_REP_S5; ++rep) s5_phase<1>(a, layer, lds, tid, last ? 128 : NCH);
            } else if (k == 3) {
                for (int rep = 0; rep < MK_REP_SSD; ++rep) ssd_c_phase(a, layer, lds, tid, last ? 128 : NCH);
#ifndef MK_NO_S5
                pg8::Gemm g{(const bf16_t*)(big + B_Y5), WA + WA_GLU / 2, Mrows, 2048, 1024}; pg8::StaticOrder S; S.init(Mrows, 2048, gridDim.x, blockIdx.x);
                EpiGlu E{(bf16_t*)(big + B_U5)}; pg8::gemm_phase<EpiGlu, pg8::StaticOrder>(lds3, g, S, E, nullptr);
#endif
            } else if (k == 4) {
#ifndef MK_NO_S5
                { pg8::Gemm g{(const bf16_t*)(big + B_U5), WA + WA_S5P / 2, Mrows, 2048, 1024}; pg8::StaticOrder S; S.init(Mrows, 2048, gridDim.x, blockIdx.x);
                  EpiMerge<0> E{(bf16_t*)(big + B_XBC), (const bf16_t*)(big + B_GATE)}; pg8::gemm_phase<EpiMerge<0>, pg8::StaticOrder>(lds3, g, S, E, nullptr); }
                __syncthreads();
#endif
#ifndef MK_NO_SSD
#ifdef MK_NO_S5
                { pg8::Gemm g{(const bf16_t*)(big + B_YD), WA + WA_SSDP / 2, Mrows, 2048, 2048}; pg8::StaticOrder S; S.init(Mrows, 2048, gridDim.x, blockIdx.x);
                  EpiMerge<0, 1> E{(bf16_t*)(big + B_XBC), (const bf16_t*)(big + B_GATE)}; pg8::gemm_phase<EpiMerge<0, 1>, pg8::StaticOrder>(lds3, g, S, E, nullptr); }
#else
                { pg8::Gemm g{(const bf16_t*)(big + B_YD), WA + WA_SSDP / 2, Mrows, 2048, 2048}; pg8::StaticOrder S; S.init(Mrows, 2048, gridDim.x, blockIdx.x);
                  EpiMerge<1> E{(bf16_t*)(big + B_XBC), (const bf16_t*)(big + B_GATE)}; pg8::gemm_phase<EpiMerge<1>, pg8::StaticOrder>(lds3, g, S, E, nullptr); }
#endif
#endif
            } else if (k == 5) {
                pg8::Gemm g{(const bf16_t*)(big + B_XBC), WA + WA_WOUT / 2, Mrows, 2048, 2048}; pg8::StaticOrder S; S.init(Mrows, 2048, gridDim.x, blockIdx.x);
                EpiResid E{a.out, (float*)(a.ws + WS_HCTX), mvec(a, layer, 0) + 2 * D, mvec(a, layer, 1) + 2 * D}; pg8::gemm_phase<EpiResid, pg8::StaticOrder>(lds3, g, S, E, nullptr);
            } else if (k == 6) {
                row_phase<1>(a, Mrows, a.in[25] + (size_t)layer * D, a.in[26] + (size_t)layer * D, layer, 3 * D, gw, NGW, lane);
                if (!last) for (int rep = 0; rep < MK_REP_PRO; ++rep) { __syncthreads(); xpose_region(a, layer + 1, 0, (float*)lds + wave * (64 * 33), gw, NGW, lane); }
            } else if (k == 7) {
                pg8::Gemm g{(const bf16_t*)(a.ws + WS_XM), WB + WB_UP / 2, Mrows, 2 * DFF, D}; pg8::StaticOrder S; S.init(Mrows, 2 * DFF, gridDim.x, blockIdx.x);
                EpiUp E{(bf16_t*)(big + B_G), (bf16_t*)(big + B_V)}; for (int rep = 0; rep < MK_REP_GEMM; ++rep) { pg8::gemm_phase<EpiUp, pg8::StaticOrder>(lds3, g, S, E, nullptr); __syncthreads(); }
            } else if (k == 8) {
                ffnconv_phase(a, layer, !last, lds, tid);
            } else if (k == 9) {
                pg8::Gemm g{(const bf16_t*)(big + B_V), WB + WB_DOWN / 2, Mrows, D, DFF}; pg8::StaticOrder S; S.init(Mrows, D, gridDim.x, blockIdx.x);
                EpiResid E{a.out, (float*)(a.ws + WS_HCTX), mvec(a, layer, 0) + 5 * D, mvec(a, layer, 1) + 5 * D}; pg8::gemm_phase<EpiResid, pg8::StaticOrder>(lds3, g, S, E, nullptr);
            } else {
                row_phase<1>(a, Mrows, a.in[31] + (size_t)layer * D, a.in[32] + (size_t)layer * D, last ? -1 : layer + 1, 0, gw, NGW, lane);
                if (!last) for (int rep = 0; rep < MK_REP_PRO; ++rep) { __syncthreads(); xpose_region(a, layer + 1, 1, (float*)lds + wave * (64 * 33), gw, NGW, lane); }
            }
        }
        if (ph + 1 < a.ph_hi) { for (int rep = 0; rep < MK_REP_SYNC; ++rep) { if (MK_CG_SYNC_ALL || ph == a.ph_lo) cg::this_grid().sync(); else xcd_barrier(xbar); } }
#ifdef MK_TS_MASK
        if (blockIdx.x == 0 && threadIdx.x == 0) ((unsigned long long*)(a.ws + WS_BAR + 65536))[ph + 1] = __builtin_amdgcn_s_memrealtime();
#endif
    }
#ifdef MK_TS_MASK
    if (blockIdx.x == 0 && threadIdx.x == 0) {
        const unsigned long long* ts = (const unsigned long long*)(a.ws + WS_BAR + 65536); unsigned long long sum = 0;
        for (int ph = 1; ph < a.ph_hi - 1; ++ph) if ((MK_TS_MASK >> ph) & 1ull) sum += ts[ph + 1] - ts[ph];
        const unsigned long long t0 = __builtin_amdgcn_s_memrealtime();
        while (__builtin_amdgcn_s_memrealtime() - t0 < sum * MK_TS_AMP) __builtin_amdgcn_s_sleep(8);
    }
#endif
}
}

#ifndef MK_N_LAUNCH_MODE
#define MK_N_LAUNCH_MODE 0
#endif
extern "C" void kernel_launch(void* const* d_in, const int* in_sizes, int n_in, void* d_out, int out_size, void* d_ws, size_t ws_size, hipStream_t stream) {
    static int grid = 0;
    if (grid == 0) {
        if (n_in != 33 || ws_size < mk::WS_END) { fprintf(stderr, "kernel_launch: need 33 inputs and %zu bytes of workspace (got %d, %zu)\n", (size_t)mk::WS_END, n_in, ws_size); grid = -1; return; }
        int dev = 0, cus = 0, per_cu = 0;
        (void)hipGetDevice(&dev); (void)hipDeviceGetAttribute(&cus, hipDeviceAttributeMultiprocessorCount, dev);
        if (hipFuncSetAttribute((const void*)mk::fwd_megakernel, hipFuncAttributeMaxDynamicSharedMemorySize, mk::LDS_BYTES) != hipSuccess) { fprintf(stderr, "kernel_launch: hipFuncSetAttribute failed\n"); grid = -1; return; }
        if (hipOccupancyMaxActiveBlocksPerMultiprocessor(&per_cu, (const void*)mk::fwd_megakernel, 512, mk::LDS_BYTES) != hipSuccess || per_cu < 1) { fprintf(stderr, "kernel_launch: occupancy query says %d\n", per_cu); per_cu = 1; }
        (void)hipGetLastError();
        grid = cus * per_cu; if (grid > 256) grid = 256;
    }
    if (grid < 0) return;
    mk::Args a{};
    for (int i = 0; i < 33; ++i) a.in[i] = (const float*)d_in[i];
    a.out = (float*)d_out; a.ws = (unsigned char*)d_ws;
#if MK_N_LAUNCH_MODE == 1
    for (int ph = 0; ph < mk::NPHASE; ++ph) { a.ph_lo = ph; a.ph_hi = ph + 1; hipLaunchKernelGGL(mk::fwd_megakernel, dim3(grid), dim3(512), mk::LDS_BYTES, stream, a); }
#else
    a.ph_lo = 0; a.ph_hi = mk::NPHASE;
    (void)hipMemsetAsync((unsigned char*)d_ws + mk::WS_BAR, 0, XCD_BAR_WORDS * sizeof(unsigned), stream);
    void* args[] = {&a};
    hipError_t e = hipLaunchCooperativeKernel((const void*)mk::fwd_megakernel, dim3(grid), dim3(512), args, mk::LDS_BYTES, stream);
    if (e != hipSuccess) fprintf(stderr, "cooperative launch failed: %s (grid %d)\n", hipGetErrorString(e), grid);
#endif
}
```

```cpp
#include <hip/hip_runtime.h>
#include <hip/hip_cooperative_groups.h>
#include <cstdio>
namespace cg = cooperative_groups;
#define MK_N_LAUNCH_MODE 0
namespace pg8 {
#define PG8_LAS __attribute__((address_space(3)))
typedef unsigned short bf16_t;
typedef short bf16x8 __attribute__((ext_vector_type(8)));
typedef float f32x4 __attribute__((ext_vector_type(4)));
typedef unsigned u32x4 __attribute__((ext_vector_type(4)));
constexpr int BM = 256, BK = 64, HALF = 128, HTB = HALF * BK * 2  , STAGE_BYTES = 8 * HTB, NXCD = 8, WGM = 8;

__host__ __device__ __forceinline__ int lds_byte(int r, int c) { const int st = (r >> 4) * 2 + (c >> 5), rr = r & 15, cc = c & 31, ob = rr * 64 + cc * 2; return st * 1024 + (ob ^ (((ob >> 9) & 1) << 5)); }
__host__ __device__ __forceinline__ void stage_rc(int b, int& R, int& C) { const int st = b / 1024, sb = b % 1024, swz = sb ^ (((sb >> 9) & 1) << 5); R = (st >> 1) * 16 + swz / 64; C = (st & 1) * 32 + (swz % 64) / 2; }
__host__ __device__ __forceinline__ int perm32(int rho) { const int n = rho >> 4, i = rho & 15; return 8 * (i >> 2) + 4 * n + (i & 3); }

__device__ __forceinline__ int pg8_tid() { int t = threadIdx.x; asm volatile("" : "+v"(t)); return t; }
struct Unit { int pm, pn; };
struct Gemm { const bf16_t* A; const bf16_t* Bt; int M, N, K; };

struct StaticOrder {
    int nM, nN, nwg, G, c;
    __host__ __device__ void init(int M, int N, int G_, int c_) { nM = M / BM; nN = N / BM; nwg = nM * nN; G = G_; c = c_; }
    __host__ __device__ bool next(int i, Unit& u) const {
        const long L = (long)i * G + c; if (L >= nwg) return false;
        int wgid = (int)L; { const int q = nwg / NXCD, r = nwg % NXCD, xcd = wgid % NXCD, off = wgid / NXCD; wgid = (xcd < r ? xcd * (q + 1) : r * (q + 1) + (xcd - r) * q) + off; }
        const int nig = WGM * nN, gid = wgid / nig, fm = gid * WGM, gsz = (nM - fm) < WGM ? (nM - fm) : WGM;
        u.pm = fm + ((wgid % nig) % gsz); u.pn = (wgid % nig) / gsz; return true;
    }
    __device__ __forceinline__ void a_ready(const Unit&) const {}
    __device__ __forceinline__ void done(const Unit&) const {}
};
typedef float f32x2c __attribute__((ext_vector_type(2))); typedef __bf16 bf16x2c __attribute__((ext_vector_type(2)));
__device__ __forceinline__ unsigned cvt_pk_native(float lo, float hi) { const f32x2c v = {lo, hi}; const bf16x2c b = __builtin_convertvector(v, bf16x2c); return __builtin_bit_cast(unsigned, b); }
__device__ __forceinline__ unsigned cvt_pk_bf16(float lo, float hi) { unsigned r; asm volatile("v_cvt_pk_bf16_f32 %0, %1, %2" : "=v"(r) : "v"(lo), "v"(hi)); return r; }
__device__ __forceinline__ void mfma_settle(const float __attribute__((ext_vector_type(4)))& a) { asm volatile("s_nop 15\n\ts_nop 7" :: "v"(a)); }
typedef float f32x2 __attribute__((ext_vector_type(2)));
template <class Epi, class Sched, bool STAMP = false>
__device__ __forceinline__ void gemm_phase(PG8_LAS unsigned char* lds, const Gemm g, const Sched& S, const Epi& E, unsigned long long* stamps) {
    const int tid = pg8_tid(), wid = __builtin_amdgcn_readfirstlane(tid >> 6), lane = tid & 63, wr = wid >> 2, wc = wid & 3, fr = lane & 15, fq = lane >> 4;
    const int K = g.K, nt = K / BK;
    int ts_lo = 0, ts_hi = 0, nts = 0; const unsigned long long rt_entry = STAMP ? (unsigned long long)wall_clock64() : 0ull;
#define PG8_STAMP() do { if (STAMP && wid == 0 && nts < 64) { const unsigned long long _c = (unsigned long long)clock64(); \
        ts_lo = (lane == nts) ? (int)(unsigned)_c : ts_lo; ts_hi = (lane == nts) ? (int)(unsigned)(_c >> 32) : ts_hi; ++nts; } } while (0)
    PG8_STAMP();
    unsigned voffA[2], voffB[2];
#pragma unroll
    for (int i = 0; i < 2; ++i) { int R, C; stage_rc(tid * 16 + i * 8192, R, C); const int Rb = Epi::PERM ? ((R & ~31) + perm32(R & 31)) : R;
        voffA[i] = (unsigned)(R * K + C) * 2u; voffB[i] = (unsigned)(Rb * K + C) * 2u; }
    const size_t kstep = (size_t)(BK * 2);
    const size_t hstep = (size_t)HALF * K * 2;
    const size_t tstep = 2 * hstep;
    const unsigned ldsw = (unsigned)wid * 1024u;
    const int aoff = lds_byte(wr * 64 + fr, fq * 8), boff = lds_byte(wc * 32 + fr, fq * 8);
#define PG8_SA(b, h) (((b) * 2 + (h)) * HTB)
#define PG8_SB(b, h) ((4 + (b) * 2 + (h)) * HTB)
#define PG8_STAGE(bufoff, gbase, voff) do { _Pragma("unroll") for (int _i = 0; _i < 2; ++_i) \
        __builtin_amdgcn_global_load_lds((const unsigned*)((const char*)(gbase) + (voff)[_i]), (PG8_LAS unsigned*)(lds + (bufoff) + ldsw + _i * 8192), 16, 0, 0); } while (0)
#define PG8_LDA(dst, b, h) do { _Pragma("unroll") for (int m = 0; m < 4; ++m) _Pragma("unroll") for (int k = 0; k < 2; ++k) dst[m][k] = *(const PG8_LAS bf16x8*)(lds + PG8_SA(b, h) + aoff + m * 2048 + k * 1024); } while (0)
#define PG8_LDB(dst, b, h) do { _Pragma("unroll") for (int n = 0; n < 2; ++n) _Pragma("unroll") for (int k = 0; k < 2; ++k) dst[n][k] = *(const PG8_LAS bf16x8*)(lds + PG8_SB(b, h) + boff + n * 2048 + k * 1024); } while (0)
#define PG8_MMA(ai, bj, At, Bt) do { __builtin_amdgcn_s_setprio(1); _Pragma("unroll") for (int m = 0; m < 4; ++m) _Pragma("unroll") for (int n = 0; n < 2; ++n) _Pragma("unroll") for (int k = 0; k < 2; ++k) \
        acc[ai][bj][m][n] = __builtin_amdgcn_mfma_f32_16x16x32_bf16(Bt[n][k], At[m][k], acc[ai][bj][m][n], 0, 0, 0); __builtin_amdgcn_s_setprio(0); } while (0)
#define PG8_WAIT_V(n) asm volatile("s_waitcnt vmcnt(" #n ")" ::: "memory")
#define PG8_WAIT_L(n) asm volatile("s_waitcnt lgkmcnt(" #n ")" ::: "memory")
#define PG8_BAR __builtin_amdgcn_s_barrier()
#define PG8_SCHED __builtin_amdgcn_sched_barrier(0)
    Unit cur, nxt; int ui = 0;
    if (!S.next(0, cur)) return;
    f32x4 acc[2][2][4][2];
#pragma unroll
    for (int a = 0; a < 2; ++a)
#pragma unroll
        for (int b = 0; b < 2; ++b)
#pragma unroll
            for (int m = 0; m < 4; ++m)
#pragma unroll
                for (int n = 0; n < 2; ++n) acc[a][b][m][n] = (f32x4){0.f, 0.f, 0.f, 0.f};
    bf16x8 At[4][2], B0[2][2], B1[2][2];
    const char* cA = (const char*)g.A + (size_t)cur.pm * tstep; const char* cB = (const char*)g.Bt + (size_t)cur.pn * tstep;
    S.a_ready(cur);
    PG8_STAGE(PG8_SB(0, 0), cB, voffB); PG8_STAGE(PG8_SA(0, 0), cA, voffA); PG8_STAGE(PG8_SB(0, 1), cB + hstep, voffB); PG8_STAGE(PG8_SA(0, 1), cA + hstep, voffA);
    if (wr == 1) PG8_BAR;
    PG8_WAIT_V(4); PG8_BAR;
    PG8_STAGE(PG8_SB(1, 0), cB + kstep, voffB); PG8_STAGE(PG8_SA(1, 0), cA + kstep, voffA); PG8_STAGE(PG8_SB(1, 1), cB + hstep + kstep, voffB);
    PG8_WAIT_V(6); PG8_BAR;
    PG8_STAMP();
    for (;;) {
        const bool has_next = S.next(ui + 1, nxt);
        const char* nA = has_next ? (const char*)g.A + (size_t)nxt.pm * tstep : cA; const char* nB = has_next ? (const char*)g.Bt + (size_t)nxt.pn * tstep : cB;
        for (int t = 0; t < nt; t += 2) {
            const bool last = (t == nt - 2);
            const char* a1 = cA + (size_t)(t + 1) * kstep;
            const char* a2 = last ? nA : cA + (size_t)(t + 2) * kstep; const char* b2 = last ? nB : cB + (size_t)(t + 2) * kstep;
            const char* a3 = a2 + kstep; const char* b3 = b2 + kstep;
            if (last && has_next) S.a_ready(nxt);
            PG8_LDB(B0, 0, 0); PG8_SCHED; PG8_LDA(At, 0, 0); PG8_STAGE(PG8_SA(1, 1), a1 + hstep, voffA);
            PG8_WAIT_L(8); PG8_BAR; PG8_WAIT_L(0); PG8_MMA(0, 0, At, B0); PG8_BAR; PG8_SCHED;
            PG8_LDB(B1, 0, 1); PG8_STAGE(PG8_SB(0, 0), b2, voffB);
            PG8_BAR; PG8_WAIT_L(0); PG8_MMA(0, 1, At, B1); PG8_BAR;
            PG8_LDA(At, 0, 1); PG8_STAGE(PG8_SA(0, 0), a2, voffA);
            PG8_BAR; PG8_WAIT_L(0); PG8_MMA(1, 0, At, B0); PG8_BAR; PG8_SCHED;
            PG8_STAGE(PG8_SB(0, 1), b2 + hstep, voffB);
            PG8_WAIT_V(6); PG8_BAR; PG8_MMA(1, 1, At, B1); PG8_BAR;
            PG8_LDB(B0, 1, 0); PG8_SCHED; PG8_LDA(At, 1, 0); PG8_STAGE(PG8_SA(0, 1), a2 + hstep, voffA);
            PG8_WAIT_L(8); PG8_BAR; PG8_WAIT_L(0); PG8_MMA(0, 0, At, B0); PG8_BAR; PG8_SCHED;
            PG8_LDB(B1, 1, 1); PG8_STAGE(PG8_SB(1, 0), b3, voffB);
            PG8_BAR; PG8_WAIT_L(0); PG8_MMA(0, 1, At, B1); PG8_BAR;
            PG8_LDA(At, 1, 1); PG8_STAGE(PG8_SA(1, 0), a3, voffA);
            PG8_BAR; PG8_WAIT_L(0); PG8_MMA(1, 0, At, B0); PG8_BAR; PG8_SCHED;
            PG8_STAGE(PG8_SB(1, 1), b3 + hstep, voffB);
            PG8_WAIT_V(6); PG8_BAR; PG8_MMA(1, 1, At, B1); PG8_BAR;
        }
        PG8_STAMP();
        if constexpr (!Epi::AFTER_DRAIN) { E(acc, cur, wr, wc, fr, fq); S.done(cur); }
        PG8_STAMP();
        if (!has_next) break;
#pragma unroll
        for (int a = 0; a < 2; ++a)
#pragma unroll
            for (int b = 0; b < 2; ++b)
#pragma unroll
                for (int m = 0; m < 4; ++m)
#pragma unroll
                    for (int n = 0; n < 2; ++n) acc[a][b][m][n] = (f32x4){0.f, 0.f, 0.f, 0.f};
        cur = nxt; cA = nA; cB = nB; ++ui;
    }
    PG8_WAIT_V(0);
    if (wr == 0) PG8_BAR;
    PG8_BAR;
    if constexpr (Epi::AFTER_DRAIN) { E.fused(acc, cur, wr, wc, fr, fq, lds, wid, lane); S.done(cur); }
    PG8_STAMP();
    if (STAMP && wid == 0) { stamps[lane] = lane < nts ? (((unsigned long long)(unsigned)ts_hi << 32) | (unsigned)ts_lo) : 0ull;
        if (lane == 62) stamps[62] = rt_entry; if (lane == 63) stamps[63] = (unsigned long long)wall_clock64(); }
#undef PG8_STAMP
#undef PG8_SA
#undef PG8_SB
#undef PG8_STAGE
#undef PG8_LDA
#undef PG8_LDB
#undef PG8_MMA
#undef PG8_WAIT_V
#undef PG8_WAIT_L
#undef PG8_BAR
#undef PG8_SCHED
}
}

namespace mk {
using pg8::bf16_t; using pg8::bf16x8; using pg8::f32x4; using pg8::u32x4; using pg8::Unit; using pg8::cvt_pk_bf16; using pg8::cvt_pk_native; using pg8::mfma_settle;
typedef unsigned u32x2 __attribute__((ext_vector_type(2)));
typedef float f32x2 __attribute__((ext_vector_type(2)));
constexpr int D = 2048, TL = 16384, TC = 256, MT = TL + TC, NCH = MT / 128;
constexpr int NPROJ = 10496, DFF = 5632;
constexpr size_t MiB = 1u << 20;
constexpr size_t WS_MVEC = 0, WS_CHD = 256 * 1024, WS_BAR = 512 * 1024, WS_S5LOC = 1 * MiB, WS_WA = 10 * MiB, WS_WB = 75 * MiB, WS_HCTX = 141 * MiB, WS_XM = 143 * MiB, WS_SST = 208 * MiB, WS_BIG = 338 * MiB, WS_S5IN = 766 * MiB, WS_END = 775 * MiB;
constexpr size_t B_U5 = 0, B_XBC = B_U5 + (size_t)MT * 1024 * 2, B_Z = B_XBC + (size_t)MT * 3072 * 2, B_GATE = B_Z + (size_t)MT * 2048 * 2, B_DT = B_GATE + (size_t)MT * 4096 * 2,
                 B_Y5 = 330 * MiB, B_YD = B_Y5 + (size_t)MT * 1024 * 2;
static_assert(B_DT + (size_t)MT * 64 * 4 <= B_Y5 && B_YD + (size_t)MT * 2048 * 2 <= 428 * MiB, "big map");
constexpr size_t B_G = 0, B_V = (size_t)MT * DFF * 2;
constexpr size_t WA_IN = 0, WA_GLU = 41 * MiB, WA_S5P = 45 * MiB, WA_SSDP = 49 * MiB, WA_WOUT = 57 * MiB, WB_UP = 0, WB_DOWN = 44 * MiB;
constexpr int LDS_BYTES = 163840;
constexpr float ALPHA = 1.41421356237f, LN_EPS = 1e-5f, RMS_EPS = 1e-5f;

struct Args { const float* in[33]; float* out; unsigned char* ws; int ph_lo, ph_hi; };

__device__ __forceinline__ float bf2f(unsigned b) { return __uint_as_float(b << 16); }
__device__ __forceinline__ float bflo(unsigned w) { return __uint_as_float(w << 16); }
__device__ __forceinline__ float bfhi(unsigned w) { return __uint_as_float(w & 0xffff0000u); }
__device__ __forceinline__ float sigm(float x) { return __builtin_amdgcn_rcpf(1.f + __expf(-x)); }
__device__ __forceinline__ float silu_(float x) { return x * __builtin_amdgcn_rcpf(1.f + __expf(-x)); }
__device__ __forceinline__ float gelu_tanh(float x) { const float u = 0.7978845608028654f * (x + 0.044715f * x * x * x); const float th = 1.f - 2.f * __builtin_amdgcn_rcpf(__expf(2.f * u) + 1.f); return 0.5f * x * (1.f + th); }
__device__ __forceinline__ bf16x8 mkfrag(unsigned a, unsigned b, unsigned c, unsigned d) { u32x4 v; v.x = a; v.y = b; v.z = c; v.w = d; return __builtin_bit_cast(bf16x8, v); }
__device__ __forceinline__ float* hrow(const Args& a, int row) { return row < TL ? a.out + (size_t)row * D : (float*)(a.ws + WS_HCTX) + (size_t)(row - TL) * D; }
__device__ __forceinline__ const float* mvec(const Args& a, int layer, int isctx) { return (const float*)(a.ws + WS_MVEC) + (size_t)(layer * 2 + isctx) * 12288; }

struct EpiInProj {
    static constexpr bool PERM = true, AFTER_DRAIN = false;
    unsigned char* big; const float* dt_bias;
    __device__ __forceinline__ void operator()(const f32x4 (&acc)[2][2][4][2], const Unit& u, int wr, int wc, int fr, int fq) const {
        mfma_settle(acc[1][1][3][1]); mfma_settle(acc[1][1][3][0]);
        const int row0 = u.pm * 256 + wr * 64 + fr, ct = u.pn * 256;
        if (ct >= 10240) {
            if (wc < 2) { const int cc = wc * 32 + 8 * fq; float* DT = (float*)(big + B_DT);
                const f32x4 b0 = *(const f32x4*)(dt_bias + cc), b1 = *(const f32x4*)(dt_bias + cc + 4);
#pragma unroll
                for (int ai = 0; ai < 2; ++ai)
#pragma unroll
                    for (int m = 0; m < 4; ++m) { float* rp = DT + (size_t)(row0 + ai * 128 + m * 16) * 64 + cc; f32x4 v0 = acc[ai][0][m][0] + b0, v1 = acc[ai][0][m][1] + b1;
#pragma unroll
                        for (int j = 0; j < 4; ++j) { v0[j] = v0[j] > 20.f ? v0[j] : log1pf(expf(v0[j])); v1[j] = v1[j] > 20.f ? v1[j] : log1pf(expf(v1[j])); }
                        *(f32x4*)rp = v0; *(f32x4*)(rp + 4) = v1; } }
            return;
        }
        bf16_t* base; int ld, c0; bool sg = false;
        if (ct < 1024) { base = (bf16_t*)(big + B_U5); ld = 1024; c0 = ct; }
        else if (ct < 4096) { base = (bf16_t*)(big + B_XBC); ld = 3072; c0 = ct - 1024; }
        else if (ct < 6144) { base = (bf16_t*)(big + B_Z); ld = 2048; c0 = ct - 4096; }
        else { base = (bf16_t*)(big + B_GATE); ld = 4096; c0 = ct - 6144; sg = true; }
        const int col0 = c0 + wc * 32 + 8 * fq;
#pragma unroll
        for (int ai = 0; ai < 2; ++ai)
#pragma unroll
            for (int m = 0; m < 4; ++m) { bf16_t* rowp = base + (size_t)(row0 + ai * 128 + m * 16) * ld + col0;
#pragma unroll
                for (int bj = 0; bj < 2; ++bj) { f32x4 v0 = acc[ai][bj][m][0], v1 = acc[ai][bj][m][1];
                    if (sg) {
#pragma unroll
                        for (int j = 0; j < 4; ++j) { v0[j] = sigm(v0[j]); v1[j] = sigm(v1[j]); } }
                    u32x4 w; w.x = cvt_pk_native(v0[0], v0[1]); w.y = cvt_pk_native(v0[2], v0[3]); w.z = cvt_pk_native(v1[0], v1[1]); w.w = cvt_pk_native(v1[2], v1[3]);
                    *(u32x4*)(rowp + bj * 128) = w; } }
    }
};
struct EpiGlu {
    static constexpr bool PERM = true, AFTER_DRAIN = false;
    bf16_t* O;
    __device__ __forceinline__ void operator()(const f32x4 (&acc)[2][2][4][2], const Unit& u, int wr, int wc, int fr, int fq) const {
        mfma_settle(acc[1][1][3][1]); mfma_settle(acc[1][1][3][0]);
        const int row0 = u.pm * 256 + wr * 64 + fr, col0 = u.pn * 128 + wc * 32 + 8 * fq;
#pragma unroll
        for (int ai = 0; ai < 2; ++ai)
#pragma unroll
            for (int m = 0; m < 4; ++m) { f32x4 v0 = acc[ai][0][m][0], v1 = acc[ai][0][m][1]; const f32x4 g0 = acc[ai][1][m][0], g1 = acc[ai][1][m][1];
#pragma unroll
                for (int j = 0; j < 4; ++j) { v0[j] *= sigm(g0[j]); v1[j] *= sigm(g1[j]); }
                u32x4 w; w.x = cvt_pk_bf16(v0[0], v0[1]); w.y = cvt_pk_bf16(v0[2], v0[3]); w.z = cvt_pk_bf16(v1[0], v1[1]); w.w = cvt_pk_bf16(v1[2], v1[3]);
                *(u32x4*)(O + (size_t)(row0 + ai * 128 + m * 16) * 1024 + col0) = w; }
    }
};
template <int SECOND, int GSEL = SECOND> struct EpiMerge {
    static constexpr bool PERM = true, AFTER_DRAIN = false;
    bf16_t* MG; const bf16_t* GATE;
    __device__ __forceinline__ void operator()(const f32x4 (&acc)[2][2][4][2], const Unit& u, int wr, int wc, int fr, int fq) const {
        mfma_settle(acc[1][1][3][1]); mfma_settle(acc[1][1][3][0]);
        const int row0 = u.pm * 256 + wr * 64 + fr, col0 = u.pn * 256 + wc * 32 + 8 * fq;
#pragma unroll
        for (int ai = 0; ai < 2; ++ai)
#pragma unroll
            for (int m = 0; m < 4; ++m) { const size_t r = (size_t)(row0 + ai * 128 + m * 16); u32x4 gg[2], oo[2];
#pragma unroll
                for (int bj = 0; bj < 2; ++bj) { const int c = col0 + bj * 128; gg[bj] = *(const u32x4*)(GATE + r * 4096 + (GSEL ? 2048 : 0) + c); if (SECOND) oo[bj] = *(const u32x4*)(MG + r * 2048 + c); }
                __builtin_amdgcn_sched_barrier(0);
#pragma unroll
                for (int bj = 0; bj < 2; ++bj) { const int c = col0 + bj * 128; const u32x4 g = gg[bj];
                    f32x4 v0 = acc[ai][bj][m][0], v1 = acc[ai][bj][m][1];
                    v0[0] *= bflo(g.x); v0[1] *= bfhi(g.x); v0[2] *= bflo(g.y); v0[3] *= bfhi(g.y); v1[0] *= bflo(g.z); v1[1] *= bfhi(g.z); v1[2] *= bflo(g.w); v1[3] *= bfhi(g.w);
                    if (SECOND) { const u32x4 o = oo[bj];
                        v0[0] += bflo(o.x); v0[1] += bfhi(o.x); v0[2] += bflo(o.y); v0[3] += bfhi(o.y); v1[0] += bflo(o.z); v1[1] += bfhi(o.z); v1[2] += bflo(o.w); v1[3] += bfhi(o.w); }
                    u32x4 w; w.x = cvt_pk_bf16(v0[0], v0[1]); w.y = cvt_pk_bf16(v0[2], v0[3]); w.z = cvt_pk_bf16(v1[0], v1[1]); w.w = cvt_pk_bf16(v1[2], v1[3]);
                    *(u32x4*)(MG + r * 2048 + c) = w; }
                __builtin_amdgcn_sched_barrier(0); }
    }
};
struct EpiResid {
    static constexpr bool PERM = false, AFTER_DRAIN = false;
    float* out; float* hctx; const float* glat; const float* gctx;
    __device__ __forceinline__ void operator()(const f32x4 (&acc)[2][2][4][2], const Unit& u, int wr, int wc, int fr, int fq) const {
        mfma_settle(acc[1][1][3][1]); mfma_settle(acc[1][1][3][0]);
        const bool isctx = u.pm >= 64; const float* g = isctx ? gctx : glat;
        float* hb = isctx ? hctx + (size_t)(wr * 64 + fr) * D : out + (size_t)(u.pm * 256 + wr * 64 + fr) * D;
        const int col0 = u.pn * 256 + wc * 32 + 4 * fq;
        f32x4 gv[2][2];
#pragma unroll
        for (int bj = 0; bj < 2; ++bj)
#pragma unroll
            for (int n = 0; n < 2; ++n) gv[bj][n] = *(const f32x4*)(g + col0 + bj * 128 + n * 16);
#pragma unroll
        for (int ai = 0; ai < 2; ++ai)
#pragma unroll
            for (int m = 0; m < 4; ++m) { float* rowp = hb + (size_t)(ai * 128 + m * 16) * D + col0;
                { f32x4 h[2][2];
#pragma unroll
                for (int bj = 0; bj < 2; ++bj)
#pragma unroll
                    for (int n = 0; n < 2; ++n) h[bj][n] = *(const f32x4*)(rowp + bj * 128 + n * 16);
                __builtin_amdgcn_sched_barrier(0);
#pragma unroll
                for (int bj = 0; bj < 2; ++bj)
#pragma unroll
                    for (int n = 0; n < 2; ++n) *(f32x4*)(rowp + bj * 128 + n * 16) = h[bj][n] * ALPHA + gv[bj][n] * acc[ai][bj][m][n];
                __builtin_amdgcn_sched_barrier(0); } }
    }
};
struct EpiUp {
    static constexpr bool PERM = true, AFTER_DRAIN = false;
    bf16_t* G; bf16_t* V;
    __device__ __forceinline__ void operator()(const f32x4 (&acc)[2][2][4][2], const Unit& u, int wr, int wc, int fr, int fq) const {
        mfma_settle(acc[1][1][3][1]); mfma_settle(acc[1][1][3][0]);
        const int row0 = u.pm * 256 + wr * 64 + fr; int ct = u.pn * 256; bf16_t* base = G; if (ct >= DFF) { base = V; ct -= DFF; }
        const int col0 = ct + wc * 32 + 8 * fq;
#pragma unroll
        for (int ai = 0; ai < 2; ++ai)
#pragma unroll
            for (int m = 0; m < 4; ++m) { bf16_t* rowp = base + (size_t)(row0 + ai * 128 + m * 16) * DFF + col0;
#pragma unroll
                for (int bj = 0; bj < 2; ++bj) { const f32x4 v0 = acc[ai][bj][m][0], v1 = acc[ai][bj][m][1];
                    u32x4 w; w.x = cvt_pk_native(v0[0], v0[1]); w.y = cvt_pk_native(v0[2], v0[3]); w.z = cvt_pk_native(v1[0], v1[1]); w.w = cvt_pk_native(v1[2], v1[3]);
                    *(u32x4*)(rowp + bj * 128) = w; } }
    }
};

struct XItem { const float* W; bf16_t* WT; int K, N, d0, s0, k0; };
__device__ __forceinline__ void xpose_load(const XItem& x, float (&v)[32], int lane) {
#pragma unroll
    for (int i = 0; i < 32; ++i) { const int kk = 2 * i + (lane >> 5); v[i] = x.s0 >= 0 ? x.W[(size_t)(x.k0 + kk) * x.N + x.s0 + (lane & 31)] : 0.f; }
}
__device__ __forceinline__ void xpose_store(const XItem& x, const float (&v)[32], float* scr, int lane) {
#pragma unroll
    for (int i = 0; i < 32; ++i) { const int kk = 2 * i + (lane >> 5); scr[kk * 33 + (lane & 31)] = v[i]; }
    asm volatile("s_waitcnt lgkmcnt(0)" ::: "memory");
    const int c = lane & 7;
#pragma unroll
    for (int j = 0; j < 4; ++j) { const int n = (lane >> 3) + 8 * j; const float* sp = scr + (8 * c) * 33 + n;
        u32x4 o; o.x = cvt_pk_bf16(sp[0 * 33], sp[1 * 33]); o.y = cvt_pk_bf16(sp[2 * 33], sp[3 * 33]); o.z = cvt_pk_bf16(sp[4 * 33], sp[5 * 33]); o.w = cvt_pk_bf16(sp[6 * 33], sp[7 * 33]);
        *(u32x4*)(x.WT + (size_t)(x.d0 + n) * x.K + x.k0 + 8 * c) = o; }
    asm volatile("s_waitcnt lgkmcnt(0)" ::: "memory");
}
__device__ __forceinline__ XItem xpose_decode(const Args& a, int layer, int region, int r) {
    XItem x;
    if (region == 0) {
        bf16_t* WA = (bf16_t*)(a.ws + WS_WA);
        constexpr int I_IN = 32 * 328, I_GLU = 16 * 64, I_S5P = 16 * 64, I_SSDP = 32 * 64;
        if (r < I_IN) { const int kb = r / 328, d0 = (r % 328) * 32; int s0; if (d0 < 4096) s0 = d0; else if (d0 < 10240) s0 = d0 + 64; else if (d0 < 10304) s0 = d0 - 10240 + 4096; else s0 = -1;
            x.W = a.in[6] + (size_t)layer * 2048 * 10304; x.WT = WA + WA_IN / 2; x.K = 2048; x.N = 10304; x.d0 = d0; x.s0 = s0; x.k0 = kb * 64; return x; } r -= I_IN;
        if (r < I_GLU) { const int kb = r / 64, d0 = (r % 64) * 32, t = d0 >> 8, j = d0 & 255;
            x.W = a.in[15] + (size_t)layer * 1024 * 2048; x.WT = WA + WA_GLU / 2; x.K = 1024; x.N = 2048; x.d0 = d0; x.s0 = j < 128 ? t * 128 + j : 1024 + t * 128 + (j - 128); x.k0 = kb * 64; return x; } r -= I_GLU;
        if (r < I_S5P) { x.W = a.in[16] + (size_t)layer * 1024 * 2048; x.WT = WA + WA_S5P / 2; x.K = 1024; x.N = 2048; x.d0 = (r % 64) * 32; x.s0 = x.d0; x.k0 = (r / 64) * 64; return x; } r -= I_S5P;
        if (r < I_SSDP) { x.W = a.in[23] + (size_t)layer * 2048 * 2048; x.WT = WA + WA_SSDP / 2; x.K = 2048; x.N = 2048; x.d0 = (r % 64) * 32; x.s0 = x.d0; x.k0 = (r / 64) * 64; return x; } r -= I_SSDP;
        x.W = a.in[24] + (size_t)layer * 2048 * 2048; x.WT = WA + WA_WOUT / 2; x.K = 2048; x.N = 2048; x.d0 = (r % 64) * 32; x.s0 = x.d0; x.k0 = (r / 64) * 64; return x;
    }
    bf16_t* WB = (bf16_t*)(a.ws + WS_WB); constexpr int I_UP = 32 * 352;
    if (r < I_UP) { x.W = a.in[27] + (size_t)layer * 2048 * 11264; x.WT = WB + WB_UP / 2; x.K = 2048; x.N = 11264; x.d0 = (r % 352) * 32; x.s0 = x.d0; x.k0 = (r / 352) * 64; return x; } r -= I_UP;
    x.W = a.in[30] + (size_t)layer * 5632 * 2048; x.WT = WB + WB_DOWN / 2; x.K = 5632; x.N = 2048; x.d0 = (r % 64) * 32; x.s0 = x.d0; x.k0 = (r / 64) * 64; return x;
}
__device__ __forceinline__ void xpose_region(const Args& a, int layer, int region, float* scr, int gw, int NGW, int lane) {
    const int NI = region == 0 ? (32 * 328 + 16 * 64 + 16 * 64 + 32 * 64 + 32 * 64) : (32 * 352 + 88 * 64);
    int it = gw;
    for (; it + 3 * NGW < NI; it += 4 * NGW) {
        const XItem x0 = xpose_decode(a, layer, region, it), x1 = xpose_decode(a, layer, region, it + NGW), x2 = xpose_decode(a, layer, region, it + 2 * NGW), x3 = xpose_decode(a, layer, region, it + 3 * NGW);
        float v0[32], v1[32], v2[32], v3[32]; xpose_load(x0, v0, lane); xpose_load(x1, v1, lane); xpose_load(x2, v2, lane); xpose_load(x3, v3, lane);
        xpose_store(x0, v0, scr, lane); xpose_store(x1, v1, scr, lane); xpose_store(x2, v2, scr, lane); xpose_store(x3, v3, scr, lane);
    }
    for (; it < NI; it += NGW) { const XItem x0 = xpose_decode(a, layer, region, it); float v0[32]; xpose_load(x0, v0, lane); xpose_store(x0, v0, scr, lane); }
}

__device__ __forceinline__ void adaln_phase(const Args& a, float* lds, int tid) {
    float* sc = lds; float* scx = lds + 2048; float* red = lds + 4096;
    for (int i = tid; i < 2048; i += 512) { sc[i] = silu_(a.in[1][i]); scx[i] = silu_(a.in[3][i]); }
    __syncthreads();
    for (int unit = blockIdx.x; unit < 256; unit += gridDim.x) {
        const int layer = unit >> 7, col0 = (unit & 127) * 96;
        const float* W = a.in[4] + (size_t)layer * 2048 * 12288 + col0;
        if (tid < 504) { const int cq = tid % 24, ks = tid / 24; f32x4 al = {0.f, 0.f, 0.f, 0.f}, ac = {0.f, 0.f, 0.f, 0.f};
#pragma unroll 14
            for (int k = ks; k < 2048; k += 21) { const f32x4 w = *(const f32x4*)(W + (size_t)k * 12288 + cq * 4); al += w * sc[k]; ac += w * scx[k]; }
            *(f32x4*)(red + (ks * 2 + 0) * 96 + cq * 4) = al; *(f32x4*)(red + (ks * 2 + 1) * 96 + cq * 4) = ac; }
        __syncthreads();
        if (tid < 192) { const int v = tid / 96, c = tid % 96; float s = 0.f; for (int ks = 0; ks < 21; ++ks) s += red[(ks * 2 + v) * 96 + c];
            ((float*)(a.ws + WS_MVEC))[(size_t)(layer * 2 + v) * 12288 + col0 + c] = s + a.in[5][(size_t)layer * 12288 + col0 + c]; }
        __syncthreads();
    }
}

__device__ __forceinline__ float wave_sum(float v) {
#pragma unroll
    for (int o = 1; o < 64; o <<= 1) v += __shfl_xor(v, o);
    return v;
}
template <int MODE> __device__ __forceinline__ void row_phase(const Args& a, int nrows, const float* lng, const float* lnb, int mod_layer, int mod_off, int gw, int NGW, int lane) {
    bf16_t* XM = (bf16_t*)(a.ws + WS_XM);
    f32x4 lg[8], lb[8];
    if (MODE == 1) {
#pragma unroll
        for (int j = 0; j < 8; ++j) { lg[j] = *(const f32x4*)(lng + 4 * lane + 256 * j); lb[j] = *(const f32x4*)(lnb + 4 * lane + 256 * j); } }
    for (int row0 = gw; row0 < nrows; row0 += 2 * NGW) {
        const int row1 = row0 + NGW < nrows ? row0 + NGW : row0;
        const int rows[2] = {row0, row1}; f32x4 v[2][8];
#pragma unroll
        for (int u = 0; u < 2; ++u) { const int row = rows[u]; const int isctx = row >= TL;
            const float* src = MODE == 0 ? (isctx ? a.in[2] + (size_t)(row - TL) * D : a.in[0] + (size_t)row * D) : hrow(a, row);
#pragma unroll
            for (int j = 0; j < 8; ++j) v[u][j] = *(const f32x4*)(src + 4 * lane + 256 * j); }
        if (MODE == 1) {
            float s[2], q[2];
#pragma unroll
            for (int u = 0; u < 2; ++u) { s[u] = 0.f;
#pragma unroll
                for (int j = 0; j < 8; ++j) s[u] += (v[u][j][0] + v[u][j][1]) + (v[u][j][2] + v[u][j][3]); }
            s[0] = wave_sum(s[0]); s[1] = wave_sum(s[1]);
#pragma unroll
            for (int u = 0; u < 2; ++u) { const float mean = s[u] * (1.f / D); q[u] = 0.f;
#pragma unroll
                for (int j = 0; j < 8; ++j) { v[u][j] = v[u][j] - mean; q[u] += (v[u][j][0] * v[u][j][0] + v[u][j][1] * v[u][j][1]) + (v[u][j][2] * v[u][j][2] + v[u][j][3] * v[u][j][3]); } }
            q[0] = wave_sum(q[0]); q[1] = wave_sum(q[1]);
#pragma unroll
            for (int u = 0; u < 2; ++u) { const float rstd = __builtin_amdgcn_rsqf(q[u] * (1.f / D) + LN_EPS);
#pragma unroll
                for (int j = 0; j < 8; ++j) v[u][j] = v[u][j] * rstd * lg[j] + lb[j]; }
        }
#pragma unroll
        for (int u = 0; u < 2; ++u) { const int row = rows[u]; const int isctx = row >= TL; float* h = hrow(a, row);
#pragma unroll
            for (int j = 0; j < 8; ++j) *(f32x4*)(h + 4 * lane + 256 * j) = v[u][j];
            if (mod_layer >= 0) { const float* m = mvec(a, mod_layer, isctx) + mod_off; f32x4 shv[8], scv[8];
#pragma unroll
                for (int j = 0; j < 8; ++j) { shv[j] = *(const f32x4*)(m + 4 * lane + 256 * j); scv[j] = *(const f32x4*)(m + D + 4 * lane + 256 * j); }
                __builtin_amdgcn_sched_barrier(0);
#pragma unroll
                for (int j = 0; j < 8; ++j) { const f32x4 sh = shv[j], scl = scv[j]; const f32x4 o = v[u][j] * (scl + 1.f) + sh;
                    u32x2 w; w.x = cvt_pk_bf16(o[0], o[1]); w.y = cvt_pk_bf16(o[2], o[3]); *(u32x2*)(XM + (size_t)row * D + 4 * lane + 256 * j) = w; } } }
    }
}

__device__ __forceinline__ void ffnconv_ctx(const Args& a, int layer, int tid) {
    const bf16_t* G = (const bf16_t*)(a.ws + WS_BIG + B_G); bf16_t* V = (bf16_t*)(a.ws + WS_BIG + B_V);
    const float* cw = a.in[28] + (size_t)layer * 9 * DFF; const float* cb = a.in[29] + (size_t)layer * DFF;
    const int nunits = 260 * 11; const int oc = tid & 63, xs = tid >> 6;
    for (int unit = 256 * 11 + blockIdx.x; unit < nunits; unit += gridDim.x) {
        const int seg = unit / 11, ob = unit % 11, ch0 = ob * 512 + oc * 8; const bool cs = seg >= 256; const int t0 = seg * 64;
        float w[9][8], bias[8];
#pragma unroll
        for (int k = 0; k < 9; ++k) { const f32x4 w0 = *(const f32x4*)(cw + (size_t)k * DFF + ch0), w1 = *(const f32x4*)(cw + (size_t)k * DFF + ch0 + 4);
            w[k][0] = w0[0]; w[k][1] = w0[1]; w[k][2] = w0[2]; w[k][3] = w0[3]; w[k][4] = w1[0]; w[k][5] = w1[1]; w[k][6] = w1[2]; w[k][7] = w1[3]; }
        { const f32x4 b0 = *(const f32x4*)(cb + ch0), b1 = *(const f32x4*)(cb + ch0 + 4); bias[0] = b0[0]; bias[1] = b0[1]; bias[2] = b0[2]; bias[3] = b0[3]; bias[4] = b1[0]; bias[5] = b1[1]; bias[6] = b1[2]; bias[7] = b1[3]; }
#pragma unroll 4
        for (int xi = 0; xi < 8; ++xi) { const int x = xs * 8 + xi, t = t0 + x; float acc[8];
#pragma unroll
            for (int k = 0; k < 8; ++k) acc[k] = bias[k];
            u32x4 g3[3]; bf16_t* vp = V + (size_t)t * DFF + ch0;
#pragma unroll
            for (int dx = -1; dx <= 1; ++dx) { const bool ok = t + dx >= TL && t + dx < MT; g3[dx + 1] = *(const u32x4*)(G + (size_t)(ok ? t + dx : t) * DFF + ch0); }
            const u32x4 vv = *(const u32x4*)vp;
            __builtin_amdgcn_sched_barrier(0);
#pragma unroll
            for (int dx = -1; dx <= 1; ++dx) { const bool ok = t + dx >= TL && t + dx < MT; u32x4 g = g3[dx + 1]; if (!ok) g = (u32x4){0u, 0u, 0u, 0u}; const int k = 3 + dx + 1;
                acc[0] += w[k][0] * bflo(g.x); acc[1] += w[k][1] * bfhi(g.x); acc[2] += w[k][2] * bflo(g.y); acc[3] += w[k][3] * bfhi(g.y);
                acc[4] += w[k][4] * bflo(g.z); acc[5] += w[k][5] * bfhi(g.z); acc[6] += w[k][6] * bflo(g.w); acc[7] += w[k][7] * bfhi(g.w); }
            u32x4 o; o.x = cvt_pk_bf16(silu_(acc[0]) * bflo(vv.x), silu_(acc[1]) * bfhi(vv.x)); o.y = cvt_pk_bf16(silu_(acc[2]) * bflo(vv.y), silu_(acc[3]) * bfhi(vv.y));
            o.z = cvt_pk_bf16(silu_(acc[4]) * bflo(vv.z), silu_(acc[5]) * bfhi(vv.z)); o.w = cvt_pk_bf16(silu_(acc[6]) * bflo(vv.w), silu_(acc[7]) * bfhi(vv.w));
            *(u32x4*)vp = o; }
    }
}

__device__ __forceinline__ void ffnconv_phase(const Args& a, int layer, bool with_ctx, unsigned char* lds, int tid) {
    const bf16_t* G = (const bf16_t*)(a.ws + WS_BIG + B_G); bf16_t* V = (bf16_t*)(a.ws + WS_BIG + B_V);
    const float* cw = a.in[28] + (size_t)layer * 9 * DFF; const float* cb = a.in[29] + (size_t)layer * DFF;
    bf16_t* T = (bf16_t*)lds;
    const int oc = tid & 15, ts = tid >> 4;
    u32x4 gn[12];
#define FFC_PREFETCH(unit_) do { const int rg_ = (unit_) / 44, ch_ = ((unit_) % 44) * 128 + oc * 8, y0_ = rg_ * 4; \
        _Pragma("unroll") for (int i = 0; i < 12; ++i) { const int idx = tid + i * 512, r = idx >> 10, x = (idx >> 4) & 63, y = y0_ - 1 + r; const bool ok = y >= 0 && y < 256; \
            gn[i] = *(const u32x4*)(G + (size_t)((ok ? y : y0_) * 64 + x) * DFF + ch_); } } while (0)
    int unit = blockIdx.x;
    if (unit < 64 * 44) FFC_PREFETCH(unit);
    for (; unit < 64 * 44; unit += gridDim.x) {
        const int rg = unit / 44, ch0 = (unit % 44) * 128 + oc * 8, y0 = rg * 4;
        __syncthreads();
#pragma unroll
        for (int i = 0; i < 12; ++i) { const int idx = tid + i * 512, r = idx >> 10, x = (idx >> 4) & 63, y = y0 - 1 + r; const bool ok = y >= 0 && y < 256;
            *(u32x4*)(T + ((r * 64 + x) * 128 + oc * 8)) = ok ? gn[i] : (u32x4){0u, 0u, 0u, 0u}; }
        u32x4 vv[8];
#pragma unroll
        for (int o = 0; o < 8; ++o) vv[o] = *(const u32x4*)(V + (size_t)((y0 + (o >> 1)) * 64 + ts * 2 + (o & 1)) * DFF + ch0);
        float w[9][8], bias[8];
#pragma unroll
        for (int k = 0; k < 9; ++k) { const f32x4 w0 = *(const f32x4*)(cw + (size_t)k * DFF + ch0), w1 = *(const f32x4*)(cw + (size_t)k * DFF + ch0 + 4);
            w[k][0] = w0[0]; w[k][1] = w0[1]; w[k][2] = w0[2]; w[k][3] = w0[3]; w[k][4] = w1[0]; w[k][5] = w1[1]; w[k][6] = w1[2]; w[k][7] = w1[3]; }
        { const f32x4 b0 = *(const f32x4*)(cb + ch0), b1 = *(const f32x4*)(cb + ch0 + 4); bias[0] = b0[0]; bias[1] = b0[1]; bias[2] = b0[2]; bias[3] = b0[3]; bias[4] = b1[0]; bias[5] = b1[1]; bias[6] = b1[2]; bias[7] = b1[3]; }
        __syncthreads();
        __builtin_amdgcn_sched_barrier(0);
        if (unit + (int)gridDim.x < 64 * 44) FFC_PREFETCH(unit + (int)gridDim.x);
        __builtin_amdgcn_sched_barrier(0);
#pragma unroll
        for (int o = 0; o < 8; ++o) { const int rr = o >> 1, x = ts * 2 + (o & 1); float acc[8];
#pragma unroll
            for (int k = 0; k < 8; ++k) acc[k] = bias[k];
#pragma unroll
            for (int dy = -1; dy <= 1; ++dy)
#pragma unroll
                for (int dx = -1; dx <= 1; ++dx) { const int xn = x + dx; const bool ok = xn >= 0 && xn < 64;
                    u32x4 g = *(const u32x4*)(T + (((rr + 1 + dy) * 64 + (ok ? xn : x)) * 128 + oc * 8)); if (!ok) g = (u32x4){0u, 0u, 0u, 0u}; const int k = (dy + 1) * 3 + dx + 1;
                    acc[0] += w[k][0] * bflo(g.x); acc[1] += w[k][1] * bfhi(g.x); acc[2] += w[k][2] * bflo(g.y); acc[3] += w[k][3] * bfhi(g.y);
                    acc[4] += w[k][4] * bflo(g.z); acc[5] += w[k][5] * bfhi(g.z); acc[6] += w[k][6] * bflo(g.w); acc[7] += w[k][7] * bfhi(g.w); }
            const u32x4 v = vv[o];
            u32x4 q; q.x = cvt_pk_bf16(silu_(acc[0]) * bflo(v.x), silu_(acc[1]) * bfhi(v.x)); q.y = cvt_pk_bf16(silu_(acc[2]) * bflo(v.y), silu_(acc[3]) * bfhi(v.y));
            q.z = cvt_pk_bf16(silu_(acc[4]) * bflo(v.z), silu_(acc[5]) * bfhi(v.z)); q.w = cvt_pk_bf16(silu_(acc[6]) * bflo(v.w), silu_(acc[7]) * bfhi(v.w));
            *(u32x4*)(V + (size_t)((y0 + rr) * 64 + x) * DFF + ch0) = q; }
    }
#undef FFC_PREFETCH
    __syncthreads();
    if (with_ctx) ffnconv_ctx(a, layer, tid);
}
__device__ __forceinline__ int s5_chunk_at(int dir, int q) { return dir ? 129 - q : (q + 128) % 130; }
__device__ __forceinline__ int s5_pos_of(int dir, int c) { return dir ? 129 - c : (c + 2) % 130; }
template <int PASS> __device__ __forceinline__ void s5_phase(const Args& a, int layer, unsigned char* lds, int tid, int nchunks) {
    constexpr int BUP = 132;
    const bf16_t* U5 = (const bf16_t*)(a.ws + WS_BIG + B_U5); bf16_t* Y5 = (bf16_t*)(a.ws + WS_BIG + B_Y5);
    float2* S5LOC = (float2*)(a.ws + WS_S5LOC);
    const int lane = tid & 63, w = tid >> 6, gl = w >> 1, dir = w & 1, p = lane, fr = lane & 15, fq = lane >> 4;
    float* BuW = (float*)lds + (size_t)w * (16 * BUP);
    bf16_t* STw = (bf16_t*)(lds + 67584) + (size_t)w * (16 * 136);
    float* YL = (float*)(lds + 102400);
    const int gq = blockIdx.x & 15, g = gq * 4 + gl;
    float ab_re, ab_im, a128r, a128i;
    const float step = expf(a.in[9][(size_t)(layer * 2 + dir) * 64 + g]);
    { const size_t pi = ((size_t)(layer * 2 + dir) * 64 + g) * 64 + p; const float lre = fminf(a.in[7][pi], -1e-4f), lim = a.in[8][pi];
      const float mag = expf(lre * step); float sn, cs; sincosf(lim * step, &sn, &cs); ab_re = mag * cs; ab_im = mag * sn; a128r = ab_re; a128i = ab_im;
#pragma unroll
      for (int k = 0; k < 7; ++k) { const float r = a128r * a128r - a128i * a128i, i = 2.f * a128r * a128i; a128r = r; a128i = i; } }
    bf16x8 bbf[8];
#pragma unroll
    for (int nt = 0; nt < 8; ++nt) { const int pp = nt * 8 + (fr >> 1), cc = fr & 1; const size_t pi = ((size_t)(layer * 2 + dir) * 64 + g) * 64 + pp;
        const float lre = fminf(a.in[7][pi], -1e-4f), lim = a.in[8][pi]; const float mag = expf(lre * step); float sn, cs; sincosf(lim * step, &sn, &cs);
        const float are = mag * cs, aim = mag * sn, den = lre * lre + lim * lim, q_re = ((are - 1.f) * lre + aim * lim) / den, q_im = (aim * lre - (are - 1.f) * lim) / den;
        const float* br = a.in[10] + (((size_t)layer * 64 + g) * 64 + pp) * 16 + (fq & 1) * 8; const float* bi = a.in[11] + (((size_t)layer * 64 + g) * 64 + pp) * 16 + (fq & 1) * 8;
        const f32x4 r0 = *(const f32x4*)br, r1 = *(const f32x4*)(br + 4), i0 = *(const f32x4*)bi, i1 = *(const f32x4*)(bi + 4); float v[8];
#pragma unroll
        for (int j = 0; j < 8; ++j) { const float r = j < 4 ? r0[j & 3] : r1[j & 3], i = j < 4 ? i0[j & 3] : i1[j & 3]; v[j] = fq < 2 ? (cc ? q_re * i + q_im * r : q_re * r - q_im * i) : 0.f; }
        bbf[nt] = mkfrag(cvt_pk_bf16(v[0], v[1]), cvt_pk_bf16(v[2], v[3]), cvt_pk_bf16(v[4], v[5]), cvt_pk_bf16(v[6], v[7])); }
    bf16x8 cm[4];
    if (PASS == 1) {
        const float* cre = a.in[12] + (((size_t)(layer * 2 + dir) * 64 + g) * 16 + fr) * 64; const float* cim = a.in[13] + (((size_t)(layer * 2 + dir) * 64 + g) * 16 + fr) * 64;
#pragma unroll
        for (int ks = 0; ks < 4; ++ks) { const f32x4 r = *(const f32x4*)(cre + ks * 16 + fq * 4), i = *(const f32x4*)(cim + ks * 16 + fq * 4);
            cm[ks] = mkfrag(cvt_pk_bf16(r[0], -i[0]), cvt_pk_bf16(r[1], -i[1]), cvt_pk_bf16(r[2], -i[2]), cvt_pk_bf16(r[3], -i[3])); }
    }
    const int cstep = gridDim.x >> 4;
    float2* S5IN = (float2*)(a.ws + WS_S5IN);
    if (PASS == 1) {
        float sr = 0.f, si = 0.f;
#pragma unroll 1
        for (int q0 = 0; q0 < NCH; q0 += 13) { float2 l[13];
#pragma unroll
            for (int i = 0; i < 13; ++i) l[i] = S5LOC[((size_t)(dir * NCH + s5_chunk_at(dir, q0 + i)) * 64 + g) * 64 + p];
#pragma unroll
            for (int i = 0; i < 13; ++i) { const int cc = s5_chunk_at(dir, q0 + i);
                if (cc < nchunks && (cc % cstep) == (int)(blockIdx.x >> 4)) S5IN[((size_t)(dir * NCH + cc) * 64 + g) * 64 + p] = make_float2(sr, si);
                const float nr = a128r * sr - a128i * si + l[i].x, ni = a128r * si + a128i * sr + l[i].y; sr = nr; si = ni; } }
    }
    for (int c = blockIdx.x >> 4; c < nchunks; c += cstep) {
        const int row0 = c * 128;
        bf16x8 uf[8];
#pragma unroll
        for (int k = 0; k < 8; ++k) { const int sl = dir ? 7 - k : k; uf[k] = *(const bf16x8*)(U5 + (size_t)(row0 + sl * 16 + fr) * 1024 + g * 16 + (fq & 1) * 8); }
        __builtin_amdgcn_sched_barrier(0);
#pragma unroll
        for (int k = 0; k < 8; ++k) if (fq >= 2) uf[k] = mkfrag(0u, 0u, 0u, 0u);
        float sr = 0.f, si = 0.f;
        if (PASS == 1) { const float2 s0 = S5IN[((size_t)(dir * NCH + c) * 64 + g) * 64 + p]; sr = s0.x; si = s0.y; }
        f32x4 yacc[8];
#pragma unroll
        for (int k = 0; k < 8; ++k) {
#pragma unroll
            for (int nt = 0; nt < 8; ++nt) { f32x4 acc = {0.f, 0.f, 0.f, 0.f}; acc = __builtin_amdgcn_mfma_f32_16x16x32_bf16(uf[k], bbf[nt], acc, 0, 0, 0);
#pragma unroll
                for (int jj = 0; jj < 4; ++jj) BuW[(fq * 4 + jj) * BUP + nt * 16 + fr] = acc[jj]; }
            asm volatile("s_waitcnt lgkmcnt(0)" ::: "memory");
#pragma unroll
            for (int ii = 0; ii < 16; ++ii) { const int tl = dir ? 15 - ii : ii; const f32x2 b2 = *(const f32x2*)(BuW + tl * BUP + 2 * p);
                f32x2 ns = __builtin_elementwise_fma((f32x2){ab_re, ab_re}, (f32x2){sr, si}, b2); ns = __builtin_elementwise_fma((f32x2){-ab_im, ab_im}, (f32x2){si, sr}, ns); sr = ns[0]; si = ns[1];
                if (PASS == 1) *(unsigned*)(STw + tl * 136 + 2 * p) = cvt_pk_bf16(sr, si); }
            if (PASS == 1) {
                asm volatile("s_waitcnt lgkmcnt(0)" ::: "memory");
                f32x4 acc = {0.f, 0.f, 0.f, 0.f};
#pragma unroll
                for (int ks = 0; ks < 4; ++ks) acc = __builtin_amdgcn_mfma_f32_16x16x32_bf16(*(const bf16x8*)(STw + fr * 136 + ks * 32 + fq * 8), cm[ks], acc, 0, 0, 0);
                yacc[k] = acc;
            }
            asm volatile("s_waitcnt lgkmcnt(0)" ::: "memory");
        }
        if (PASS == 0) { S5LOC[((size_t)(dir * NCH + c) * 64 + g) * 64 + p] = make_float2(sr, si); }
        else {
            __syncthreads();
            if (dir == 0) {
#pragma unroll
                for (int k = 0; k < 8; ++k)
#pragma unroll
                    for (int jj = 0; jj < 4; ++jj) YL[gl * 2048 + (k * 16 + fq * 4 + jj) * 16 + fr] = yacc[k][jj]; }
            __syncthreads();
            if (dir == 1) {
#pragma unroll
                for (int k = 0; k < 8; ++k)
#pragma unroll
                    for (int jj = 0; jj < 4; ++jj) YL[gl * 2048 + ((7 - k) * 16 + fq * 4 + jj) * 16 + fr] += yacc[k][jj]; }
            __syncthreads();
            const int t = tid >> 2, q = tid & 3; const float* y = YL + q * 2048 + t * 16; const float* dd = a.in[14] + (size_t)layer * 1024 + gq * 64 + q * 16;
            const bf16_t* us = U5 + (size_t)(row0 + t) * 1024 + gq * 64 + q * 16; const u32x4 u0 = *(const u32x4*)us, u1 = *(const u32x4*)(us + 8);
            const float u[16] = {bflo(u0.x), bfhi(u0.x), bflo(u0.y), bfhi(u0.y), bflo(u0.z), bfhi(u0.z), bflo(u0.w), bfhi(u0.w), bflo(u1.x), bfhi(u1.x), bflo(u1.y), bfhi(u1.y), bflo(u1.z), bfhi(u1.z), bflo(u1.w), bfhi(u1.w)};
            f32x4 dq[4], yq[4];
#pragma unroll
            for (int j = 0; j < 4; ++j) { dq[j] = *(const f32x4*)(dd + 4 * j); yq[j] = *(const f32x4*)(y + 4 * j); }
            __builtin_amdgcn_sched_barrier(0);
            unsigned o[8];
#pragma unroll
            for (int j = 0; j < 8; ++j) { const int e0 = 2 * j, e1 = 2 * j + 1; const float y0 = yq[e0 >> 2][e0 & 3] + u[e0] * dq[e0 >> 2][e0 & 3], y1 = yq[e1 >> 2][e1 & 3] + u[e1] * dq[e1 >> 2][e1 & 3]; o[j] = cvt_pk_bf16(gelu_tanh(y0), gelu_tanh(y1)); }
            bf16_t* dst = Y5 + (size_t)(row0 + t) * 1024 + gq * 64 + q * 16; u32x4 o0, o1; o0.x = o[0]; o0.y = o[1]; o0.z = o[2]; o0.w = o[3]; o1.x = o[4]; o1.y = o[5]; o1.z = o[6]; o1.w = o[7];
            *(u32x4*)dst = o0; *(u32x4*)(dst + 8) = o1;
        }
    }
    __syncthreads();
}

__device__ __forceinline__ int ssd_chunk_at(int dir, int q) { return s5_chunk_at(dir, q); }
__device__ __forceinline__ void conv8(const bf16_t* XBC, int rowbase, int l0, int ch, bool lo_ok, bool hi_ok, float w0, float w1, float w2, float b, float (&out)[8]) {
    float r[10];
#pragma unroll
    for (int i = 0; i < 10; ++i) { const int l = l0 - 1 + i; const bool ok = (l >= 0 || lo_ok) && (l < 128 || hi_ok); r[i] = ok ? bf2f((unsigned)XBC[(size_t)(rowbase + l) * 3072 + ch]) : 0.f; }
#pragma unroll
    for (int j = 0; j < 8; ++j) out[j] = silu_(w0 * r[j] + w1 * r[j + 1] + w2 * r[j + 2] + b);
}
__device__ __forceinline__ void stage_conv_tile(const bf16_t* XBC, const float* cw, const float* cb, int rowbase, int chbase, bool lo_ok, bool hi_ok, bf16_t* dst, int tid) {
    const int oc = tid & 15, ch = chbase + oc * 8; float w[3][8], b[8];
#pragma unroll
    for (int k = 0; k < 3; ++k) { const f32x4 a0 = *(const f32x4*)(cw + (size_t)k * 3072 + ch), a1 = *(const f32x4*)(cw + (size_t)k * 3072 + ch + 4);
        w[k][0] = a0[0]; w[k][1] = a0[1]; w[k][2] = a0[2]; w[k][3] = a0[3]; w[k][4] = a1[0]; w[k][5] = a1[1]; w[k][6] = a1[2]; w[k][7] = a1[3]; }
    { const f32x4 a0 = *(const f32x4*)(cb + ch), a1 = *(const f32x4*)(cb + ch + 4); b[0] = a0[0]; b[1] = a0[1]; b[2] = a0[2]; b[3] = a0[3]; b[4] = a1[0]; b[5] = a1[1]; b[6] = a1[2]; b[7] = a1[3]; }
    u32x4 gl[4][3];
#pragma unroll
    for (int i = 0; i < 4; ++i) { const int row = (tid >> 4) + i * 32;
#pragma unroll
        for (int d = 0; d < 3; ++d) { const bool ok = d == 1 ? true : (d == 0 ? (row > 0 || lo_ok) : (row < 127 || hi_ok)); const int l = ok ? row + d - 1 : row;
            gl[i][d] = *(const u32x4*)(XBC + (size_t)(rowbase + l) * 3072 + ch); } }
    __builtin_amdgcn_sched_barrier(0);
#pragma unroll
    for (int i = 0; i < 4; ++i) { const int row = (tid >> 4) + i * 32; float acc[8];
#pragma unroll
        for (int k = 0; k < 8; ++k) acc[k] = b[k];
#pragma unroll
        for (int d = 0; d < 3; ++d) { const bool ok = d == 1 ? true : (d == 0 ? (row > 0 || lo_ok) : (row < 127 || hi_ok));
            { u32x4 g = gl[i][d]; if (!ok) g = (u32x4){0u, 0u, 0u, 0u};
                acc[0] += w[d][0] * bflo(g.x); acc[1] += w[d][1] * bfhi(g.x); acc[2] += w[d][2] * bflo(g.y); acc[3] += w[d][3] * bfhi(g.y);
                acc[4] += w[d][4] * bflo(g.z); acc[5] += w[d][5] * bfhi(g.z); acc[6] += w[d][6] * bflo(g.w); acc[7] += w[d][7] * bfhi(g.w); } }
        u32x4 o; o.x = cvt_pk_bf16(silu_(acc[0]), silu_(acc[1])); o.y = cvt_pk_bf16(silu_(acc[2]), silu_(acc[3])); o.z = cvt_pk_bf16(silu_(acc[4]), silu_(acc[5])); o.w = cvt_pk_bf16(silu_(acc[6]), silu_(acc[7]));
        *(u32x4*)(dst + row * 136 + oc * 8) = o; }
}
constexpr int SL_CS = 0, SL_CB = 34816, SL_CUM = 69632, SL_DT = 77824, SL_PART = 86016, SL_BS = 94208, SL_XT = 94208;
template <int AUX> __device__ __forceinline__ void ssd_cum(const Args& a, int layer, int c, int h, int w, int lane, unsigned char* lds) {
    const float* DT = (const float*)(a.ws + WS_BIG + B_DT); float* cumL = (float*)(lds + SL_CUM); float* dtL = (float*)(lds + SL_DT); float* CHD = (float*)(a.ws + WS_CHD);
#pragma unroll
    for (int dir = 0; dir < 2; ++dir) {
        const float ah = -expf(a.in[20][(size_t)(layer * 2 + dir) * 32 + h]);
        const float d0 = DT[(size_t)(c * 128 + 2 * lane) * 64 + dir * 32 + h], d1 = DT[(size_t)(c * 128 + 2 * lane + 1) * 64 + dir * 32 + h];
        const float l0 = d0 * ah, l1 = d1 * ah, s = l0 + l1; float incl = s;
#pragma unroll
        for (int o = 1; o < 64; o <<= 1) { const float t = __shfl_up(incl, o); if (lane >= o) incl += t; }
        const float excl = incl - s, tot = __shfl(incl, 63);
        float c0, c1;
        if (dir == 0) { c0 = excl + l0; c1 = incl; } else { c0 = tot - excl; c1 = tot - (excl + l0); }
        float* cu = cumL + (dir * 8 + w) * 128 + 2 * lane; cu[0] = c0; cu[1] = c1;
        float* dd = dtL + (dir * 8 + w) * 128 + 2 * lane;
        if (AUX == 0) { dd[0] = d0; dd[1] = d1; } else { dd[0] = d0 * __expf(tot - c0); dd[1] = d1 * __expf(tot - c1); if (lane == 0) CHD[(size_t)(dir * NCH + c) * 32 + h] = tot; }
    }
}
__device__ __forceinline__ void stage_T(const bf16_t* XBC, const float* cw, const float* cb, int rowbase, int ch, int r0, bool lo_ok, bool hi_ok, bf16_t* dstT) {
    float w[3][8], b[8];
#pragma unroll
    for (int k = 0; k < 3; ++k) { const f32x4 a0 = *(const f32x4*)(cw + (size_t)k * 3072 + ch), a1 = *(const f32x4*)(cw + (size_t)k * 3072 + ch + 4);
        w[k][0] = a0[0]; w[k][1] = a0[1]; w[k][2] = a0[2]; w[k][3] = a0[3]; w[k][4] = a1[0]; w[k][5] = a1[1]; w[k][6] = a1[2]; w[k][7] = a1[3]; }
    { const f32x4 a0 = *(const f32x4*)(cb + ch), a1 = *(const f32x4*)(cb + ch + 4); b[0] = a0[0]; b[1] = a0[1]; b[2] = a0[2]; b[3] = a0[3]; b[4] = a1[0]; b[5] = a1[1]; b[6] = a1[2]; b[7] = a1[3]; }
    u32x4 raw[10];
    const bf16_t* base = XBC + (size_t)(rowbase + r0) * 3072 + ch;
    const bool ok0 = r0 > 0 || lo_ok, ok9 = r0 < 120 || hi_ok;
#pragma unroll
    for (int i = 1; i < 9; ++i) raw[i] = *(const u32x4*)(base + (i - 1) * 3072);
    raw[0] = *(const u32x4*)(base + (ok0 ? -3072 : 0)); raw[9] = *(const u32x4*)(base + (ok9 ? 8 * 3072 : 7 * 3072));
    __builtin_amdgcn_sched_barrier(0);
    if (!ok0) raw[0] = (u32x4){0u, 0u, 0u, 0u};
    if (!ok9) raw[9] = (u32x4){0u, 0u, 0u, 0u};
    float sp[8]; unsigned o[8][4];
#pragma unroll
    for (int r = 0; r < 8; ++r) { float sv[8];
#pragma unroll
        for (int k = 0; k < 8; ++k) { float acc = b[k];
#pragma unroll
            for (int d = 0; d < 3; ++d) { const unsigned wd = k < 2 ? raw[r + d].x : (k < 4 ? raw[r + d].y : (k < 6 ? raw[r + d].z : raw[r + d].w)); acc += w[d][k] * ((k & 1) ? bfhi(wd) : bflo(wd)); }
            sv[k] = silu_(acc); }
        if (r & 1) {
#pragma unroll
            for (int k = 0; k < 8; ++k) o[k][r >> 1] = cvt_pk_bf16(sp[k], sv[k]); }
        else {
#pragma unroll
            for (int k = 0; k < 8; ++k) sp[k] = sv[k]; } }
#pragma unroll
    for (int k = 0; k < 8; ++k) { u32x4 v; v.x = o[k][0]; v.y = o[k][1]; v.z = o[k][2]; v.w = o[k][3]; *(u32x4*)(dstT + k * 136 + r0) = v; }
}
__device__ __forceinline__ void ssd_a_phase(const Args& a, int layer, unsigned char* lds, int tid) {
    const bf16_t* XBC = (const bf16_t*)(a.ws + WS_BIG + B_XBC); bf16_t* SST = (bf16_t*)(a.ws + WS_SST);
    const float* cw = a.in[17] + (size_t)layer * 3 * 3072; const float* cb = a.in[18] + (size_t)layer * 3072;
    bf16_t* BT = (bf16_t*)(lds + SL_CS); bf16_t* xT = (bf16_t*)(lds + SL_XT); const float* wL = (const float*)(lds + SL_DT);
    for (int unit = (blockIdx.x + (gridDim.x >> 1)) % gridDim.x; unit < NCH * 4; unit += gridDim.x) {
        int tl = tid; asm volatile("" : "+v"(tl));
        const int lane = tl & 63, w = __builtin_amdgcn_readfirstlane(tl >> 6), fr = lane & 15, fq = lane >> 4, og = lane & 7, rr = lane >> 3;
        const int c = unit >> 2, g = unit & 3, rowbase = c * 128; const bool lo_ok = !(c == 0 || c == 128), hi_ok = !(c == 127 || c == 129);
        __syncthreads();
        if (w < 4) { const int oct = (w & 1) * 8 + og; stage_T(XBC, cw, cb, rowbase, 2048 + g * 128 + oct * 8, ((w >> 1) * 8 + rr) * 8, lo_ok, hi_ok, BT + (oct * 8) * 136); }
        ssd_cum<1>(a, layer, c, g * 8 + w, w, lane, lds);
#pragma unroll 1
        for (int pass = 0; pass < 2; ++pass) {
            if (pass) __syncthreads();
            { const int hs = w & 3; stage_T(XBC, cw, cb, rowbase, (g * 8 + pass * 4 + hs) * 64 + og * 8, ((w >> 2) * 8 + rr) * 8, lo_ok, hi_ok, xT + ((hs * 64 + og * 8) * 136)); }
            __syncthreads();
            const int hl = w >> 1, dir = w & 1, hh = pass * 4 + hl, h = g * 8 + hh;
            bf16_t* sb = SST + (((size_t)(dir * NCH + c) * 32 + h) * 64) * 128;
#pragma unroll 1
            for (int nh = 0; nh < 2; ++nh) {
                f32x4 acc[4][4];
#pragma unroll
                for (int pt = 0; pt < 4; ++pt)
#pragma unroll
                    for (int nt = 0; nt < 4; ++nt) acc[pt][nt] = (f32x4){0.f, 0.f, 0.f, 0.f};
#pragma unroll
                for (int ks = 0; ks < 4; ++ks) {
                    const float* wp = wL + (dir * 8 + hh) * 128 + ks * 32 + fq * 8; const f32x4 wl0 = *(const f32x4*)wp, wl1 = *(const f32x4*)(wp + 4);
                    bf16x8 yf[4];
#pragma unroll
                    for (int pt = 0; pt < 4; ++pt) { const u32x4 xr = *(const u32x4*)(xT + ((hl * 64 + pt * 16 + fr) * 136 + ks * 32 + fq * 8));
                        yf[pt] = mkfrag(cvt_pk_bf16(bflo(xr.x) * wl0[0], bfhi(xr.x) * wl0[1]), cvt_pk_bf16(bflo(xr.y) * wl0[2], bfhi(xr.y) * wl0[3]), cvt_pk_bf16(bflo(xr.z) * wl1[0], bfhi(xr.z) * wl1[1]), cvt_pk_bf16(bflo(xr.w) * wl1[2], bfhi(xr.w) * wl1[3])); }
#pragma unroll
                    for (int nt = 0; nt < 4; ++nt) { const bf16x8 xf = *(const bf16x8*)(BT + ((nh * 4 + nt) * 16 + fr) * 136 + ks * 32 + fq * 8);
#pragma unroll
                        for (int pt = 0; pt < 4; ++pt) acc[pt][nt] = __builtin_amdgcn_mfma_f32_16x16x32_bf16(xf, yf[pt], acc[pt][nt], 0, 0, 0); }
                }
#pragma unroll
                for (int pt = 0; pt < 4; ++pt) mfma_settle(acc[pt][3]);
#pragma unroll
                for (int pt = 0; pt < 4; ++pt)
#pragma unroll
                    for (int nt = 0; nt < 4; ++nt) { u32x2 o; o.x = cvt_pk_native(acc[pt][nt][0], acc[pt][nt][1]); o.y = cvt_pk_native(acc[pt][nt][2], acc[pt][nt][3]);
                        *(u32x2*)(sb + (size_t)(pt * 16 + fr) * 128 + (nh * 4 + nt) * 16 + fq * 4) = o; }
            }
        }
    }
    __syncthreads();
}
__device__ __forceinline__ void ssd_b_phase(const Args& a, int tid) {
    bf16_t* SST = (bf16_t*)(a.ws + WS_SST); const float* CHD = (const float*)(a.ws + WS_CHD);
    for (int idx = blockIdx.x * 512 + tid; idx < 64 * 2048; idx += gridDim.x * 512) {
        const int e4 = idx & 2047, hd = idx >> 11, dir = hd >> 5, h = hd & 31; float s0 = 0.f, s1 = 0.f, s2 = 0.f, s3 = 0.f;
#pragma unroll 1
        for (int b = 0; b < 13; ++b) { u32x2 loc[10]; float dc[10];
#pragma unroll
            for (int i = 0; i < 10; ++i) { const int cq = ssd_chunk_at(dir, b * 10 + i); loc[i] = *(const u32x2*)(SST + ((size_t)(dir * NCH + cq) * 32 + h) * 8192 + e4 * 4); dc[i] = CHD[(size_t)(dir * NCH + cq) * 32 + h]; }
#pragma unroll
            for (int i = 0; i < 10; ++i) { const int cq = ssd_chunk_at(dir, b * 10 + i); u32x2 o; o.x = cvt_pk_bf16(s0, s1); o.y = cvt_pk_bf16(s2, s3);
                *(u32x2*)(SST + ((size_t)(dir * NCH + cq) * 32 + h) * 8192 + e4 * 4) = o; const float e = __expf(dc[i]);
                s0 = e * s0 + bflo(loc[i].x); s1 = e * s1 + bfhi(loc[i].x); s2 = e * s2 + bflo(loc[i].y); s3 = e * s3 + bfhi(loc[i].y); }
        }
    }
}
__device__ __forceinline__ void ssd_c_phase(const Args& a, int layer, unsigned char* lds, int tid, int nchunks) {
    const bf16_t* XBC = (const bf16_t*)(a.ws + WS_BIG + B_XBC); const bf16_t* SST = (const bf16_t*)(a.ws + WS_SST); const bf16_t* Z = (const bf16_t*)(a.ws + WS_BIG + B_Z); bf16_t* YD = (bf16_t*)(a.ws + WS_BIG + B_YD);
    const float* cw = a.in[17] + (size_t)layer * 3 * 3072; const float* cb = a.in[18] + (size_t)layer * 3072; const float* normw = a.in[22] + (size_t)layer * 2048;
    bf16_t* Cs = (bf16_t*)(lds + SL_CS); bf16_t* Bs = (bf16_t*)(lds + SL_BS); bf16_t* CBs = (bf16_t*)(lds + SL_CB); bf16_t* xT = (bf16_t*)(lds + SL_XT);
    const float* cumL = (const float*)(lds + SL_CUM); const float* dtL = (const float*)(lds + SL_DT); float* part = (float*)(lds + SL_PART);
    for (int unit = (blockIdx.x + (gridDim.x >> 1)) % gridDim.x; unit < nchunks * 4; unit += gridDim.x) {
        int tl = tid; asm volatile("" : "+v"(tl));
        const int lane = tl & 63, w = __builtin_amdgcn_readfirstlane(tl >> 6), fr = lane & 15, fq = lane >> 4, og = lane & 7, rr = lane >> 3;
        const int hl = w & 3, lh = w >> 2;
        const int c = unit >> 2, g = unit & 3, rowbase = c * 128; const bool lo_ok = !(c == 0 || c == 128), hi_ok = !(c == 127 || c == 129);
        __syncthreads();
        stage_conv_tile(XBC, cw, cb, rowbase, 2560 + g * 128, lo_ok, hi_ok, Cs, tl);
        stage_conv_tile(XBC, cw, cb, rowbase, 2048 + g * 128, lo_ok, hi_ok, Bs, tl);
        ssd_cum<0>(a, layer, c, g * 8 + w, w, lane, lds);
        __syncthreads();
#pragma unroll 1
        for (int st = 0; st < 8; ++st) { f32x4 acc = {0.f, 0.f, 0.f, 0.f};
#pragma unroll
            for (int ks = 0; ks < 4; ++ks) { const bf16x8 xf = *(const bf16x8*)(Bs + (st * 16 + fr) * 136 + ks * 32 + fq * 8), yf = *(const bf16x8*)(Cs + (w * 16 + fr) * 136 + ks * 32 + fq * 8);
                acc = __builtin_amdgcn_mfma_f32_16x16x32_bf16(xf, yf, acc, 0, 0, 0); }
            mfma_settle(acc);
            u32x2 o; o.x = cvt_pk_native(acc[0], acc[1]); o.y = cvt_pk_native(acc[2], acc[3]); *(u32x2*)(CBs + (w * 16 + fr) * 136 + st * 16 + fq * 4) = o; }
#pragma unroll 1
        for (int pass = 0; pass < 2; ++pass) {
            __syncthreads();
            stage_T(XBC, cw, cb, rowbase, (g * 8 + pass * 4 + hl) * 64 + og * 8, (lh * 8 + rr) * 8, lo_ok, hi_ok, xT + ((hl * 64 + og * 8) * 136));
            __syncthreads();
            const int hh = pass * 4 + hl, h = g * 8 + hh; const float Dh = a.in[21][(size_t)layer * 32 + h];
#pragma unroll 1
            for (int ih = 0; ih < 2; ++ih) {
            f32x4 acc[2][4]; u32x2 zq[2][4];
#pragma unroll
            for (int i = 0; i < 2; ++i)
#pragma unroll
                for (int pt = 0; pt < 4; ++pt) { acc[i][pt] = (f32x4){0.f, 0.f, 0.f, 0.f};
                    zq[i][pt] = *(const u32x2*)(Z + (size_t)(rowbase + (lh * 4 + ih * 2 + i) * 16 + fr) * 2048 + h * 64 + pt * 16 + fq * 4); }
#pragma unroll
            for (int dir = 0; dir < 2; ++dir) {
                const bf16_t* sb = SST + (((size_t)(dir * NCH + c) * 32 + h) * 64) * 128;
                f32x4 tmp[2][4];
#pragma unroll
                for (int i = 0; i < 2; ++i)
#pragma unroll
                    for (int pt = 0; pt < 4; ++pt) tmp[i][pt] = (f32x4){0.f, 0.f, 0.f, 0.f};
#pragma unroll
                for (int ks = 0; ks < 4; ++ks) { const int lb = (lh * 4 + ih * 2) * 16 + fr; bf16x8 sfr[4];
#pragma unroll
                    for (int pt = 0; pt < 4; ++pt) sfr[pt] = *(const bf16x8*)(sb + (size_t)(pt * 16 + fr) * 128 + ks * 32 + fq * 8);
                    const bf16x8 yf0 = *(const bf16x8*)(Cs + lb * 136 + ks * 32 + fq * 8), yf1 = *(const bf16x8*)(Cs + (lb + 16) * 136 + ks * 32 + fq * 8);
                    __builtin_amdgcn_sched_barrier(0);
#pragma unroll
                    for (int pt = 0; pt < 4; ++pt) {
                        tmp[0][pt] = __builtin_amdgcn_mfma_f32_16x16x32_bf16(sfr[pt], yf0, tmp[0][pt], 0, 0, 0); tmp[1][pt] = __builtin_amdgcn_mfma_f32_16x16x32_bf16(sfr[pt], yf1, tmp[1][pt], 0, 0, 0); } }
#pragma unroll
                for (int i = 0; i < 2; ++i) { int frv = fr; asm volatile("" : "+v"(frv));
                    const int lt = lh * 4 + ih * 2 + i, l = lt * 16 + frv;
                    const float cl = cumL[(dir * 8 + hh) * 128 + l], el = __expf(cl);
#pragma unroll
                    for (int pt = 0; pt < 4; ++pt) acc[i][pt] += tmp[i][pt] * el;
#pragma unroll
                    for (int ks = 0; ks < 4; ++ks) { const int s0 = ks * 32;
                        const bool skip = dir == 0 ? (s0 > lt * 16 + 15) : (s0 + 31 < lt * 16);
                        if (!skip) { const u32x4 cbv = *(const u32x4*)(CBs + l * 136 + s0 + fq * 8);
                            const float* cp = cumL + (dir * 8 + hh) * 128 + s0 + fq * 8; const float* dp = dtL + (dir * 8 + hh) * 128 + s0 + fq * 8;
                            const f32x4 c0 = *(const f32x4*)cp, c1 = *(const f32x4*)(cp + 4), d0 = *(const f32x4*)dp, d1 = *(const f32x4*)(dp + 4);
                            float cbf[8] = {bflo(cbv.x), bfhi(cbv.x), bflo(cbv.y), bfhi(cbv.y), bflo(cbv.z), bfhi(cbv.z), bflo(cbv.w), bfhi(cbv.w)}; float v[8];
#pragma unroll
                            for (int j = 0; j < 8; ++j) { const int sx = s0 + fq * 8 + j; const float cs = j < 4 ? c0[j & 3] : c1[j & 3], ds = j < 4 ? d0[j & 3] : d1[j & 3];
                                const bool valid = dir == 0 ? (sx <= l) : (sx >= l); float t = valid ? cbf[j] * __expf(fminf(cl - cs, 0.f)) * ds : 0.f; if (dir == 0 && sx == l) t += Dh; v[j] = t; }
                            const bf16x8 yf = mkfrag(cvt_pk_bf16(v[0], v[1]), cvt_pk_bf16(v[2], v[3]), cvt_pk_bf16(v[4], v[5]), cvt_pk_bf16(v[6], v[7]));
#pragma unroll
                            for (int pt = 0; pt < 4; ++pt) acc[i][pt] = __builtin_amdgcn_mfma_f32_16x16x32_bf16(*(const bf16x8*)(xT + ((hl * 64 + pt * 16 + fr) * 136 + s0 + fq * 8)), yf, acc[i][pt], 0, 0, 0); } }
                }
            }
#pragma unroll
            for (int i = 0; i < 2; ++i) { const int l = (lh * 4 + ih * 2 + i) * 16 + fr; const size_t row = (size_t)(rowbase + l); float ss = 0.f;
#pragma unroll
                for (int pt = 0; pt < 4; ++pt) { const int ch = h * 64 + pt * 16 + fq * 4; const u32x2 zz = zq[i][pt];
                    const float h0 = acc[i][pt][0] * silu_(bflo(zz.x)), h1 = acc[i][pt][1] * silu_(bfhi(zz.x)), h2 = acc[i][pt][2] * silu_(bflo(zz.y)), h3 = acc[i][pt][3] * silu_(bfhi(zz.y));
                    ss += (h0 * h0 + h1 * h1) + (h2 * h2 + h3 * h3); u32x2 o; o.x = cvt_pk_bf16(h0, h1); o.y = cvt_pk_bf16(h2, h3); *(u32x2*)(YD + row * 2048 + ch) = o; }
                ss += __shfl_xor(ss, 16); ss += __shfl_xor(ss, 32);
                if (fq == 0) part[hh * 128 + l] = ss; }
            }
        }
        __syncthreads();
#pragma unroll 1
        for (int it = 0; it < 8; ++it) { const int pass = it >> 2, i = it & 3, l = (lh * 4 + i) * 16 + fr, h = g * 8 + pass * 4 + hl; float tot = 0.f;
#pragma unroll
            for (int hd = 0; hd < 8; ++hd) tot += part[hd * 128 + l];
            const float r = __builtin_amdgcn_rsqf(tot * (1.f / 512.f) + RMS_EPS); const size_t row = (size_t)(rowbase + l);
            u32x2 hq[4]; f32x4 nq[4];
#pragma unroll
            for (int pt = 0; pt < 4; ++pt) { const int ch = h * 64 + pt * 16 + fq * 4; hq[pt] = *(const u32x2*)(YD + row * 2048 + ch); nq[pt] = *(const f32x4*)(normw + ch); }
            __builtin_amdgcn_sched_barrier(0);
#pragma unroll
            for (int pt = 0; pt < 4; ++pt) { const int ch = h * 64 + pt * 16 + fq * 4; bf16_t* yp = YD + row * 2048 + ch; const u32x2 hv = hq[pt]; const f32x4 nw = nq[pt];
                u32x2 o; o.x = cvt_pk_bf16(bflo(hv.x) * r * nw[0], bfhi(hv.x) * r * nw[1]); o.y = cvt_pk_bf16(bflo(hv.y) * r * nw[2], bfhi(hv.y) * r * nw[3]); *(u32x2*)yp = o; }
            __builtin_amdgcn_sched_barrier(0); }
    }
    __syncthreads();
}

#define LAS __attribute__((address_space(3)))
#define XB_TMO      128
#define XB_XCNT(j)  (256  + 64 * (j))
#define XB_XSUB(j)  (1280 + 64 * (j))
#define XB_XGEN(j)  (2304 + 64 * (j))
#define XB_TOP      3328
#define XB_TOPGEN   3392
#define XCD_BAR_WORDS 3456
#define XB_SPIN_CAP (1u << 18)

__device__ __forceinline__ unsigned xb_ld(unsigned* p)              { return __hip_atomic_load(p, __ATOMIC_RELAXED, __HIP_MEMORY_SCOPE_AGENT); }
__device__ __forceinline__ unsigned xb_add(unsigned* p, unsigned v) { return __hip_atomic_fetch_add(p, v, __ATOMIC_RELAXED, __HIP_MEMORY_SCOPE_AGENT); }
__device__ __forceinline__ unsigned xb_xcc_id() { return (unsigned)__builtin_amdgcn_s_getreg((3 << 11) | 20) & 0xFu; }
#define XB_SPIN(cond, bar) do { unsigned _sp = 0; while (cond) { __builtin_amdgcn_s_sleep(1); \
    if ((++_sp & 255u) == 0u) { if (xb_ld(&(bar)[XB_TMO])) break; if (_sp > XB_SPIN_CAP) { atomicAdd(&(bar)[XB_TMO], 1u); break; } } } } while (0)

struct XcdBarrier {
    unsigned* bar; unsigned x;
    volatile LAS unsigned* st;
};

__device__ __forceinline__ XcdBarrier xcd_barrier_post(unsigned* bar, volatile LAS unsigned* st) {
    XcdBarrier b; b.bar = bar; b.x = xb_xcc_id(); b.st = st;
    if (threadIdx.x == 0) (void)xb_add(&bar[XB_XCNT(b.x)], 1u);
    return b;
}
__device__ __forceinline__ void xcd_barrier_complete(unsigned* bar, unsigned x, unsigned& nloc, unsigned& nx) {
    const unsigned G = gridDim.x * gridDim.y * gridDim.z;
    unsigned sum, cnt, mine, sp = 0u;
    for (;;) {
        sum = 0u; cnt = 0u; mine = 0u;
#pragma unroll
        for (unsigned j = 0; j < 16; ++j) { const unsigned c = xb_ld(&bar[XB_XCNT(j)]); sum += c; cnt += (c > 0u) ? 1u : 0u; mine = (j == x) ? c : mine; }
        if (sum == G) break;
        __builtin_amdgcn_s_sleep(1);
        if ((++sp & 255u) == 0u) { if (xb_ld(&bar[XB_TMO])) break; if (sp > XB_SPIN_CAP) { atomicAdd(&bar[XB_TMO], 1u); break; } }
    }
    nloc = mine > 0u ? mine : 1u; nx = cnt > 0u ? cnt : 1u;
}

__device__ __forceinline__ void xcd_barrier(const XcdBarrier& b) {
    asm volatile("s_waitcnt vmcnt(0)" ::: "memory");
    __syncthreads();
    if (threadIdx.x == 0) {
        unsigned* bar = b.bar;
        __builtin_amdgcn_s_waitcnt(0);
        unsigned nloc = b.st[0], nx = b.st[1];
        if (nloc == 0u) { xcd_barrier_complete(bar, b.x, nloc, nx); b.st[0] = nloc; b.st[1] = nx; }
        const unsigned old = xb_add(&bar[XB_XSUB(b.x)], 1u);
        const unsigned gen = old / nloc;
        if (old + 1u == (gen + 1u) * nloc) {
            __builtin_amdgcn_fence(__ATOMIC_RELEASE, "agent");
            asm volatile("s_waitcnt vmcnt(0)" ::: "memory");
            const unsigned og = xb_add(&bar[XB_TOP], 1u);
            const unsigned tg = og / nx;
            if (og + 1u == (tg + 1u) * nx) xb_add(&bar[XB_TOPGEN], 1u);
            else XB_SPIN(xb_ld(&bar[XB_TOPGEN]) == tg, bar);
            __builtin_amdgcn_fence(__ATOMIC_ACQUIRE, "agent");
            xb_add(&bar[XB_XGEN(b.x)], 1u);
            asm volatile("s_waitcnt vmcnt(0)" ::: "memory");
        } else {
            XB_SPIN(xb_ld(&bar[XB_XGEN(b.x)]) == gen, bar);
            __builtin_amdgcn_fence(__ATOMIC_ACQUIRE, "agent");
            asm volatile("s_waitcnt vmcnt(0)" ::: "memory");
        }
    }
    __syncthreads();
}

#ifndef MK_REP_S5
#define MK_REP_S5 1
#endif
#ifndef MK_REP_SSD
#define MK_REP_SSD 1
#endif
#ifndef MK_REP_SYNC
#define MK_REP_SYNC 1
#endif
#ifndef MK_CG_SYNC_ALL
#define MK_CG_SYNC_ALL 0
#endif
#ifndef MK_REP_PRO
#define MK_REP_PRO 1
#endif
#ifndef MK_REP_GEMM
#define MK_REP_GEMM 1
#endif
constexpr int NPHASE = 2 + 11 * 2;
__global__ void __launch_bounds__(512, 2) fwd_megakernel(Args a) {
    extern __shared__ __attribute__((aligned(16))) unsigned char lds[];
    PG8_LAS unsigned char* lds3 = (PG8_LAS unsigned char*)lds;
    unsigned char* big = a.ws + WS_BIG;
    volatile LAS unsigned* bst = (volatile LAS unsigned*)(lds3 + (LDS_BYTES - 16));
    if (threadIdx.x < 4) bst[threadIdx.x] = 0u;
    __syncthreads();
    XcdBarrier xbar; xbar.bar = (unsigned*)(a.ws + WS_BAR); xbar.x = 0; xbar.st = bst;
    if (a.ph_hi - a.ph_lo > 1) xbar = xcd_barrier_post((unsigned*)(a.ws + WS_BAR), bst);
    for (int ph = a.ph_lo; ph < a.ph_hi; ++ph) {
        const int tid = pg8::pg8_tid(), lane = tid & 63, wave = tid >> 6, gw = blockIdx.x * 8 + wave, NGW = gridDim.x * 8;
        if (ph == 0) {
            for (int rep = 0; rep < MK_REP_PRO; ++rep) {
            adaln_phase(a, (float*)lds, tid);
            float* scr = (float*)lds + wave * (64 * 33);
            xpose_region(a, 0, 0, scr, gw, NGW, lane); xpose_region(a, 0, 1, scr, gw, NGW, lane); __syncthreads(); }
        } else if (ph == 1) {
            row_phase<0>(a, MT, nullptr, nullptr, 0, 0, gw, NGW, lane);
        } else {
            const int layer = (ph - 2) / 11, k = (ph - 2) % 11; const bool last = layer == 1; const int Mrows = last ? TL : MT;
            const bf16_t* WA = (const bf16_t*)(a.ws + WS_WA); const bf16_t* WB = (const bf16_t*)(a.ws + WS_WB);
#ifdef MK_SKIP_MASK
            if ((MK_SKIP_MASK >> k) & 1) { if (ph + 1 < a.ph_hi) xcd_barrier(xbar); continue; }
#endif
            if (k == 0) {
                pg8::Gemm g{(const bf16_t*)(a.ws + WS_XM), WA + WA_IN / 2, MT, NPROJ, D}; pg8::StaticOrder S; S.init(MT, NPROJ, gridDim.x, blockIdx.x);
                EpiInProj E{big, a.in[19] + (size_t)layer * 64}; for (int rep = 0; rep < MK_REP_GEMM; ++rep) { pg8::gemm_phase<EpiInProj, pg8::StaticOrder>(lds3, g, S, E, nullptr); __syncthreads(); }
            } else if (k == 1) {
                for (int rep = 0; rep < MK_REP_SSD; ++rep) ssd_a_phase(a, layer, lds, tid);
                for (int rep = 0; rep < MK_REP_S5; ++rep) s5_phase<0>(a, layer, lds, tid, NCH);
            } else if (k == 2) {
#if !defined(MK_NO_SSD) && !defined(MK_NO_SSDB)
                ssd_b_phase(a, tid);
#endif
                for (int rep = 0; rep < MK_REP_S5; ++rep) s5_phase<1>(a, layer, lds, tid, last ? 128 : NCH);
            } else if (k == 3) {
                for (int rep = 0; rep < MK_REP_SSD; ++rep) ssd_c_phase(a, layer, lds, tid, last ? 128 : NCH);
#ifndef MK_NO_S5
                pg8::Gemm g{(const bf16_t*)(big + B_Y5), WA + WA_GLU / 2, Mrows, 2048, 1024}; pg8::StaticOrder S; S.init(Mrows, 2048, gridDim.x, blockIdx.x);
                EpiGlu E{(bf16_t*)(big + B_U5)}; pg8::gemm_phase<EpiGlu, pg8::StaticOrder>(lds3, g, S, E, nullptr);
#endif
            } else if (k == 4) {
#ifndef MK_NO_S5
                { pg8::Gemm g{(const bf16_t*)(big + B_U5), WA + WA_S5P / 2, Mrows, 2048, 1024}; pg8::StaticOrder S; S.init(Mrows, 2048, gridDim.x, blockIdx.x);
                  EpiMerge<0> E{(bf16_t*)(big + B_XBC), (const bf16_t*)(big + B_GATE)}; pg8::gemm_phase<EpiMerge<0>, pg8::StaticOrder>(lds3, g, S, E, nullptr); }
                __syncthreads();
#endif
#ifndef MK_NO_SSD
#ifdef MK_NO_S5
                { pg8::Gemm g{(const bf16_t*)(big + B_YD), WA + WA_SSDP / 2, Mrows, 2048, 2048}; pg8::StaticOrder S; S.init(Mrows, 2048, gridDim.x, blockIdx.x);
                  EpiMerge<0, 1> E{(bf16_t*)(big + B_XBC), (const bf16_t*)(big + B_GATE)}; pg8::gemm_phase<EpiMerge<0, 1>, pg8::StaticOrder>(lds3, g, S, E, nullptr); }
#else
                { pg8::Gemm g{(const bf16_t*)(big + B_YD), WA + WA_SSDP / 2, Mrows, 2048, 2048}; pg8::StaticOrder S; S.init(Mrows, 2048, gridDim.x, blockIdx.x);
                  EpiMerge<1> E{(bf16_t*)(big + B_XBC), (const bf16_t*)(big + B_GATE)}; pg8::gemm_phase<EpiMerge<1>, pg8::StaticOrder>(lds3, g, S, E, nullptr); }
#endif
#endif
            } else if (k == 5) {
                pg8::Gemm g{(const bf16_t*)(big + B_XBC), WA + WA_WOUT / 2, Mrows, 2048, 2048}; pg8::StaticOrder S; S.init(Mrows, 2048, gridDim.x, blockIdx.x);
                EpiResid E{a.out, (float*)(a.ws + WS_HCTX), mvec(a, layer, 0) + 2 * D, mvec(a, layer, 1) + 2 * D}; pg8::gemm_phase<EpiResid, pg8::StaticOrder>(lds3, g, S, E, nullptr);
            } else if (k == 6) {
                row_phase<1>(a, Mrows, a.in[25] + (size_t)layer * D, a.in[26] + (size_t)layer * D, layer, 3 * D, gw, NGW, lane);
                if (!last) for (int rep = 0; rep < MK_REP_PRO; ++rep) { __syncthreads(); xpose_region(a, layer + 1, 0, (float*)lds + wave * (64 * 33), gw, NGW, lane); }
            } else if (k == 7) {
                pg8::Gemm g{(const bf16_t*)(a.ws + WS_XM), WB + WB_UP / 2, Mrows, 2 * DFF, D}; pg8::StaticOrder S; S.init(Mrows, 2 * DFF, gridDim.x, blockIdx.x);
                EpiUp E{(bf16_t*)(big + B_G), (bf16_t*)(big + B_V)}; for (int rep = 0; rep < MK_REP_GEMM; ++rep) { pg8::gemm_phase<EpiUp, pg8::StaticOrder>(lds3, g, S, E, nullptr); __syncthreads(); }
            } else if (k == 8) {
                ffnconv_phase(a, layer, !last, lds, tid);
            } else if (k == 9) {
                pg8::Gemm g{(const bf16_t*)(big + B_V), WB + WB_DOWN / 2, Mrows, D, DFF}; pg8::StaticOrder S; S.init(Mrows, D, gridDim.x, blockIdx.x);
                EpiResid E{a.out, (float*)(a.ws + WS_HCTX), mvec(a, layer, 0) + 5 * D, mvec(a, layer, 1) + 5 * D}; pg8::gemm_phase<EpiResid, pg8::StaticOrder>(lds3, g, S, E, nullptr);
            } else {
                row_phase<1>(a, Mrows, a.in[31] + (size_t)layer * D, a.in[32] + (size_t)layer * D, last ? -1 : layer + 1, 0, gw, NGW, lane);
                if (!last) for (int rep = 0; rep < MK_REP_PRO; ++rep) { __syncthreads(); xpose_region(a, layer + 1, 1, (float*)lds + wave * (64 * 33), gw, NGW, lane); }
            }
        }
        if (ph + 1 < a.ph_hi) { for (int rep = 0; rep < MK_REP_SYNC; ++rep) { if (MK_CG_SYNC_ALL || a.ph_hi > 1000) cg::this_grid().sync(); else xcd_barrier(xbar);     } }
#ifdef MK_TS_MASK
        if (blockIdx.x == 0 && threadIdx.x == 0) ((unsigned long long*)(a.ws + WS_BAR + 65536))[ph + 1] = __builtin_amdgcn_s_memrealtime();
#endif
    }
#ifdef MK_TS_MASK
    if (blockIdx.x == 0 && threadIdx.x == 0) {
        const unsigned long long* ts = (const unsigned long long*)(a.ws + WS_BAR + 65536); unsigned long long sum = 0;
        for (int ph = 1; ph < a.ph_hi - 1; ++ph) if ((MK_TS_MASK >> ph) & 1ull) sum += ts[ph + 1] - ts[ph];
        const unsigned long long t0 = __builtin_amdgcn_s_memrealtime();
        while (__builtin_amdgcn_s_memrealtime() - t0 < sum * MK_TS_AMP) __builtin_amdgcn_s_sleep(8);
    }
#endif
}
}

#ifndef MK_N_LAUNCH_MODE
#define MK_N_LAUNCH_MODE 0
#endif
extern "C" void kernel_launch(void* const* d_in, const int* in_sizes, int n_in, void* d_out, int out_size, void* d_ws, size_t ws_size, hipStream_t stream) {
    static int grid = 0;
    if (grid == 0) {
        if (n_in != 33 || ws_size < mk::WS_END) { fprintf(stderr, "kernel_launch: need 33 inputs and %zu bytes of workspace (got %d, %zu)\n", (size_t)mk::WS_END, n_in, ws_size); grid = -1; return; }
        int dev = 0, cus = 0, per_cu = 0;
        (void)hipGetDevice(&dev); (void)hipDeviceGetAttribute(&cus, hipDeviceAttributeMultiprocessorCount, dev);
        if (hipFuncSetAttribute((const void*)mk::fwd_megakernel, hipFuncAttributeMaxDynamicSharedMemorySize, mk::LDS_BYTES) != hipSuccess) { fprintf(stderr, "kernel_launch: hipFuncSetAttribute failed\n"); grid = -1; return; }
        if (hipOccupancyMaxActiveBlocksPerMultiprocessor(&per_cu, (const void*)mk::fwd_megakernel, 512, mk::LDS_BYTES) != hipSuccess || per_cu < 1) { fprintf(stderr, "kernel_launch: occupancy query says %d\n", per_cu); per_cu = 1; }
        (void)hipGetLastError();
        grid = cus * per_cu; if (grid > 256) grid = 256;
    }
    if (grid < 0) return;
    mk::Args a{};
    for (int i = 0; i < 33; ++i) a.in[i] = (const float*)d_in[i];
    a.out = (float*)d_out; a.ws = (unsigned char*)d_ws;
#if MK_N_LAUNCH_MODE == 1
    for (int ph = 0; ph < mk::NPHASE; ++ph) { a.ph_lo = ph; a.ph_hi = ph + 1; hipLaunchKernelGGL(mk::fwd_megakernel, dim3(grid), dim3(512), mk::LDS_BYTES, stream, a); }
#else
    a.ph_lo = 0; a.ph_hi = mk::NPHASE;
    (void)hipMemsetAsync((unsigned char*)d_ws + mk::WS_BAR, 0, XCD_BAR_WORDS * sizeof(unsigned), stream);
    void* args[] = {&a};
    hipError_t e = hipLaunchCooperativeKernel((const void*)mk::fwd_megakernel, dim3(grid), dim3(512), args, mk::LDS_BYTES, stream);
    if (e != hipSuccess) fprintf(stderr, "cooperative launch failed: %s (grid %d)\n", hipGetErrorString(e), grid);
#endif
}
```

```cpp
#include <hip/hip_runtime.h>
#include <hip/hip_cooperative_groups.h>
#include <cstdio>
namespace cg = cooperative_groups;
#define MK_N_LAUNCH_MODE 0
namespace pg8 {
#define PG8_LAS __attribute__((address_space(3)))
typedef unsigned short bf16_t;
typedef short bf16x8 __attribute__((ext_vector_type(8)));
typedef float f32x4 __attribute__((ext_vector_type(4)));
typedef unsigned u32x4 __attribute__((ext_vector_type(4)));
constexpr int BM = 256, BK = 64, HALF = 128, HTB = HALF * BK * 2  , STAGE_BYTES = 8 * HTB, NXCD = 8, WGM = 8;

__host__ __device__ __forceinline__ int lds_byte(int r, int c) { const int st = (r >> 4) * 2 + (c >> 5), rr = r & 15, cc = c & 31, ob = rr * 64 + cc * 2; return st * 1024 + (ob ^ (((ob >> 9) & 1) << 5)); }
__host__ __device__ __forceinline__ void stage_rc(int b, int& R, int& C) { const int st = b / 1024, sb = b % 1024, swz = sb ^ (((sb >> 9) & 1) << 5); R = (st >> 1) * 16 + swz / 64; C = (st & 1) * 32 + (swz % 64) / 2; }
__host__ __device__ __forceinline__ int perm32(int rho) { const int n = rho >> 4, i = rho & 15; return 8 * (i >> 2) + 4 * n + (i & 3); }

__device__ __forceinline__ int pg8_tid() { int t = threadIdx.x; asm volatile("" : "+v"(t)); return t; }
struct Unit { int pm, pn; };
struct Gemm { const bf16_t* A; const bf16_t* Bt; int M, N, K; };

struct StaticOrder {
    int nM, nN, nwg, G, c;
    __host__ __device__ void init(int M, int N, int G_, int c_) { nM = M / BM; nN = N / BM; nwg = nM * nN; G = G_; c = c_; }
    __host__ __device__ bool next(int i, Unit& u) const {
        const long L = (long)i * G + c; if (L >= nwg) return false;
        int wgid = (int)L; { const int q = nwg / NXCD, r = nwg % NXCD, xcd = wgid % NXCD, off = wgid / NXCD; wgid = (xcd < r ? xcd * (q + 1) : r * (q + 1) + (xcd - r) * q) + off; }
        const int nig = WGM * nN, gid = wgid / nig, fm = gid * WGM, gsz = (nM - fm) < WGM ? (nM - fm) : WGM;
        u.pm = fm + ((wgid % nig) % gsz); u.pn = (wgid % nig) / gsz; return true;
    }
    __device__ __forceinline__ void a_ready(const Unit&) const {}
    __device__ __forceinline__ void done(const Unit&) const {}
};
typedef float f32x2c __attribute__((ext_vector_type(2))); typedef __bf16 bf16x2c __attribute__((ext_vector_type(2)));
__device__ __forceinline__ unsigned cvt_pk_native(float lo, float hi) { const f32x2c v = {lo, hi}; const bf16x2c b = __builtin_convertvector(v, bf16x2c); return __builtin_bit_cast(unsigned, b); }
__device__ __forceinline__ unsigned cvt_pk_bf16(float lo, float hi) { unsigned r; asm volatile("v_cvt_pk_bf16_f32 %0, %1, %2" : "=v"(r) : "v"(lo), "v"(hi)); return r; }
__device__ __forceinline__ void mfma_settle(const float __attribute__((ext_vector_type(4)))& a) { asm volatile("s_nop 15\n\ts_nop 7" :: "v"(a)); }
typedef float f32x2 __attribute__((ext_vector_type(2)));
template <class Epi, class Sched, bool STAMP = false>
__device__ __forceinline__ void gemm_phase(PG8_LAS unsigned char* lds, const Gemm g, const Sched& S, const Epi& E, unsigned long long* stamps) {
    const int tid = pg8_tid(), wid = __builtin_amdgcn_readfirstlane(tid >> 6), lane = tid & 63, wr = wid >> 2, wc = wid & 3, fr = lane & 15, fq = lane >> 4;
    const int K = g.K, nt = K / BK;
    int ts_lo = 0, ts_hi = 0, nts = 0; const unsigned long long rt_entry = STAMP ? (unsigned long long)wall_clock64() : 0ull;
#define PG8_STAMP() do { if (STAMP && wid == 0 && nts < 64) { const unsigned long long _c = (unsigned long long)clock64(); \
        ts_lo = (lane == nts) ? (int)(unsigned)_c : ts_lo; ts_hi = (lane == nts) ? (int)(unsigned)(_c >> 32) : ts_hi; ++nts; } } while (0)
    PG8_STAMP();
    unsigned voffA[2], voffB[2];
#pragma unroll
    for (int i = 0; i < 2; ++i) { int R, C; stage_rc(tid * 16 + i * 8192, R, C); const int Rb = Epi::PERM ? ((R & ~31) + perm32(R & 31)) : R;
        voffA[i] = (unsigned)(R * K + C) * 2u; voffB[i] = (unsigned)(Rb * K + C) * 2u; }
    const size_t kstep = (size_t)(BK * 2);
    const size_t hstep = (size_t)HALF * K * 2;
    const size_t tstep = 2 * hstep;
    const unsigned ldsw = (unsigned)wid * 1024u;
    const int aoff = lds_byte(wr * 64 + fr, fq * 8), boff = lds_byte(wc * 32 + fr, fq * 8);
#define PG8_SA(b, h) (((b) * 2 + (h)) * HTB)
#define PG8_SB(b, h) ((4 + (b) * 2 + (h)) * HTB)
#define PG8_STAGE(bufoff, gbase, voff) do { _Pragma("unroll") for (int _i = 0; _i < 2; ++_i) \
        __builtin_amdgcn_global_load_lds((const unsigned*)((const char*)(gbase) + (voff)[_i]), (PG8_LAS unsigned*)(lds + (bufoff) + ldsw + _i * 8192), 16, 0, 0); } while (0)
#define PG8_LDA(dst, b, h) do { _Pragma("unroll") for (int m = 0; m < 4; ++m) _Pragma("unroll") for (int k = 0; k < 2; ++k) dst[m][k] = *(const PG8_LAS bf16x8*)(lds + PG8_SA(b, h) + aoff + m * 2048 + k * 1024); } while (0)
#define PG8_LDB(dst, b, h) do { _Pragma("unroll") for (int n = 0; n < 2; ++n) _Pragma("unroll") for (int k = 0; k < 2; ++k) dst[n][k] = *(const PG8_LAS bf16x8*)(lds + PG8_SB(b, h) + boff + n * 2048 + k * 1024); } while (0)
#define PG8_MMA(ai, bj, At, Bt) do { __builtin_amdgcn_s_setprio(1); _Pragma("unroll") for (int m = 0; m < 4; ++m) _Pragma("unroll") for (int n = 0; n < 2; ++n) _Pragma("unroll") for (int k = 0; k < 2; ++k) \
        acc[ai][bj][m][n] = __builtin_amdgcn_mfma_f32_16x16x32_bf16(Bt[n][k], At[m][k], acc[ai][bj][m][n], 0, 0, 0); __builtin_amdgcn_s_setprio(0); } while (0)
#define PG8_WAIT_V(n) asm volatile("s_waitcnt vmcnt(" #n ")" ::: "memory")
#define PG8_WAIT_L(n) asm volatile("s_waitcnt lgkmcnt(" #n ")" ::: "memory")
#define PG8_BAR __builtin_amdgcn_s_barrier()
#define PG8_SCHED __builtin_amdgcn_sched_barrier(0)
    Unit cur, nxt; int ui = 0;
    if (!S.next(0, cur)) return;
    f32x4 acc[2][2][4][2];
#pragma unroll
    for (int a = 0; a < 2; ++a)
#pragma unroll
        for (int b = 0; b < 2; ++b)
#pragma unroll
            for (int m = 0; m < 4; ++m)
#pragma unroll
                for (int n = 0; n < 2; ++n) acc[a][b][m][n] = (f32x4){0.f, 0.f, 0.f, 0.f};
    bf16x8 At[4][2], B0[2][2], B1[2][2];
    const char* cA = (const char*)g.A + (size_t)cur.pm * tstep; const char* cB = (const char*)g.Bt + (size_t)cur.pn * tstep;
    S.a_ready(cur);
    PG8_STAGE(PG8_SB(0, 0), cB, voffB); PG8_STAGE(PG8_SA(0, 0), cA, voffA); PG8_STAGE(PG8_SB(0, 1), cB + hstep, voffB); PG8_STAGE(PG8_SA(0, 1), cA + hstep, voffA);
    if (wr == 1) PG8_BAR;
    PG8_WAIT_V(4); PG8_BAR;
    PG8_STAGE(PG8_SB(1, 0), cB + kstep, voffB); PG8_STAGE(PG8_SA(1, 0), cA + kstep, voffA); PG8_STAGE(PG8_SB(1, 1), cB + hstep + kstep, voffB);
    PG8_WAIT_V(6); PG8_BAR;
    PG8_STAMP();
    for (;;) {
        const bool has_next = S.next(ui + 1, nxt);
        const char* nA = has_next ? (const char*)g.A + (size_t)nxt.pm * tstep : cA; const char* nB = has_next ? (const char*)g.Bt + (size_t)nxt.pn * tstep : cB;
        for (int t = 0; t < nt; t += 2) {
            const bool last = (t == nt - 2);
            const char* a1 = cA + (size_t)(t + 1) * kstep;
            const char* a2 = last ? nA : cA + (size_t)(t + 2) * kstep; const char* b2 = last ? nB : cB + (size_t)(t + 2) * kstep;
            const char* a3 = a2 + kstep; const char* b3 = b2 + kstep;
            if (last && has_next) S.a_ready(nxt);
            PG8_LDB(B0, 0, 0); PG8_SCHED; PG8_LDA(At, 0, 0); PG8_STAGE(PG8_SA(1, 1), a1 + hstep, voffA);
            PG8_WAIT_L(8); PG8_BAR; PG8_WAIT_L(0); PG8_MMA(0, 0, At, B0); PG8_BAR; PG8_SCHED;
            PG8_LDB(B1, 0, 1); PG8_STAGE(PG8_SB(0, 0), b2, voffB);
            PG8_BAR; PG8_WAIT_L(0); PG8_MMA(0, 1, At, B1); PG8_BAR;
            PG8_LDA(At, 0, 1); PG8_STAGE(PG8_SA(0, 0), a2, voffA);
            PG8_BAR; PG8_WAIT_L(0); PG8_MMA(1, 0, At, B0); PG8_BAR; PG8_SCHED;
            PG8_STAGE(PG8_SB(0, 1), b2 + hstep, voffB);
            PG8_WAIT_V(6); PG8_BAR; PG8_MMA(1, 1, At, B1); PG8_BAR;
            PG8_LDB(B0, 1, 0); PG8_SCHED; PG8_LDA(At, 1, 0); PG8_STAGE(PG8_SA(0, 1), a2 + hstep, voffA);
            PG8_WAIT_L(8); PG8_BAR; PG8_WAIT_L(0); PG8_MMA(0, 0, At, B0); PG8_BAR; PG8_SCHED;
            PG8_LDB(B1, 1, 1); PG8_STAGE(PG8_SB(1, 0), b3, voffB);
            PG8_BAR; PG8_WAIT_L(0); PG8_MMA(0, 1, At, B1); PG8_BAR;
            PG8_LDA(At, 1, 1); PG8_STAGE(PG8_SA(1, 0), a3, voffA);
            PG8_BAR; PG8_WAIT_L(0); PG8_MMA(1, 0, At, B0); PG8_BAR; PG8_SCHED;
            PG8_STAGE(PG8_SB(1, 1), b3 + hstep, voffB);
            PG8_WAIT_V(6); PG8_BAR; PG8_MMA(1, 1, At, B1); PG8_BAR;
        }
        PG8_STAMP();
        if constexpr (!Epi::AFTER_DRAIN) { E(acc, cur, wr, wc, fr, fq); S.done(cur); }
        PG8_STAMP();
        if (!has_next) break;
#pragma unroll
        for (int a = 0; a < 2; ++a)
#pragma unroll
            for (int b = 0; b < 2; ++b)
#pragma unroll
                for (int m = 0; m < 4; ++m)
#pragma unroll
                    for (int n = 0; n < 2; ++n) acc[a][b][m][n] = (f32x4){0.f, 0.f, 0.f, 0.f};
        cur = nxt; cA = nA; cB = nB; ++ui;
    }
    PG8_WAIT_V(0);
    if (wr == 0) PG8_BAR;
    PG8_BAR;
    if constexpr (Epi::AFTER_DRAIN) { E.fused(acc, cur, wr, wc, fr, fq, lds, wid, lane); S.done(cur); }
    PG8_STAMP();
    if (STAMP && wid == 0) { stamps[lane] = lane < nts ? (((unsigned long long)(unsigned)ts_hi << 32) | (unsigned)ts_lo) : 0ull;
        if (lane == 62) stamps[62] = rt_entry; if (lane == 63) stamps[63] = (unsigned long long)wall_clock64(); }
#undef PG8_STAMP
#undef PG8_SA
#undef PG8_SB
#undef PG8_STAGE
#undef PG8_LDA
#undef PG8_LDB
#undef PG8_MMA
#undef PG8_WAIT_V
#undef PG8_WAIT_L
#undef PG8_BAR
#undef PG8_SCHED
}
}

namespace mk {
using pg8::bf16_t; using pg8::bf16x8; using pg8::f32x4; using pg8::u32x4; using pg8::Unit; using pg8::cvt_pk_bf16; using pg8::cvt_pk_native; using pg8::mfma_settle;
typedef unsigned u32x2 __attribute__((ext_vector_type(2)));
typedef float f32x2 __attribute__((ext_vector_type(2)));
constexpr int D = 2048, TL = 16384, TC = 256, MT = TL + TC, NCH = MT / 128;
constexpr int NPROJ = 10496, DFF = 5632;
constexpr size_t MiB = 1u << 20;
constexpr size_t WS_MVEC = 0, WS_CHD = 256 * 1024, WS_BAR = 512 * 1024, WS_S5LOC = 1 * MiB, WS_WA = 10 * MiB, WS_WB = 75 * MiB, WS_HCTX = 141 * MiB, WS_XM = 143 * MiB, WS_SST = 208 * MiB, WS_BIG = 338 * MiB, WS_S5IN = 766 * MiB, WS_END = 775 * MiB;
constexpr size_t B_U5 = 0, B_XBC = B_U5 + (size_t)MT * 1024 * 2, B_Z = B_XBC + (size_t)MT * 3072 * 2, B_GATE = B_Z + (size_t)MT * 2048 * 2, B_DT = B_GATE + (size_t)MT * 4096 * 2,
                 B_Y5 = 330 * MiB, B_YD = B_Y5 + (size_t)MT * 1024 * 2;
static_assert(B_DT + (size_t)MT * 64 * 4 <= B_Y5 && B_YD + (size_t)MT * 2048 * 2 <= 428 * MiB, "big map");
constexpr size_t B_G = 0, B_V = (size_t)MT * DFF * 2;
constexpr size_t WA_IN = 0, WA_GLU = 41 * MiB, WA_S5P = 45 * MiB, WA_SSDP = 49 * MiB, WA_WOUT = 57 * MiB, WB_UP = 0, WB_DOWN = 44 * MiB;
constexpr int LDS_BYTES = 163840;
constexpr float ALPHA = 1.41421356237f, LN_EPS = 1e-5f, RMS_EPS = 1e-5f;

struct Args { const float* in[33]; float* out; unsigned char* ws; int ph_lo, ph_hi; };

__device__ __forceinline__ float bf2f(unsigned b) { return __uint_as_float(b << 16); }
__device__ __forceinline__ float bflo(unsigned w) { return __uint_as_float(w << 16); }
__device__ __forceinline__ float bfhi(unsigned w) { return __uint_as_float(w & 0xffff0000u); }
__device__ __forceinline__ float sigm(float x) { return __builtin_amdgcn_rcpf(1.f + __expf(-x)); }
__device__ __forceinline__ float silu_(float x) { return x * __builtin_amdgcn_rcpf(1.f + __expf(-x)); }
__device__ __forceinline__ float gelu_tanh(float x) { const float u = 0.7978845608028654f * (x + 0.044715f * x * x * x); const float th = 1.f - 2.f * __builtin_amdgcn_rcpf(__expf(2.f * u) + 1.f); return 0.5f * x * (1.f + th); }
__device__ __forceinline__ bf16x8 mkfrag(unsigned a, unsigned b, unsigned c, unsigned d) { u32x4 v; v.x = a; v.y = b; v.z = c; v.w = d; return __builtin_bit_cast(bf16x8, v); }
__device__ __forceinline__ float* hrow(const Args& a, int row) { return row < TL ? a.out + (size_t)row * D : (float*)(a.ws + WS_HCTX) + (size_t)(row - TL) * D; }
__device__ __forceinline__ const float* mvec(const Args& a, int layer, int isctx) { return (const float*)(a.ws + WS_MVEC) + (size_t)(layer * 2 + isctx) * 12288; }

struct EpiInProj {
    static constexpr bool PERM = true, AFTER_DRAIN = false;
    unsigned char* big; const float* dt_bias;
    __device__ __forceinline__ void operator()(const f32x4 (&acc)[2][2][4][2], const Unit& u, int wr, int wc, int fr, int fq) const {
        mfma_settle(acc[1][1][3][1]); mfma_settle(acc[1][1][3][0]);
        const int row0 = u.pm * 256 + wr * 64 + fr, ct = u.pn * 256;
        if (ct >= 10240) {
            if (wc < 2) { const int cc = wc * 32 + 8 * fq; float* DT = (float*)(big + B_DT);
                const f32x4 b0 = *(const f32x4*)(dt_bias + cc), b1 = *(const f32x4*)(dt_bias + cc + 4);
#pragma unroll
                for (int ai = 0; ai < 2; ++ai)
#pragma unroll
                    for (int m = 0; m < 4; ++m) { float* rp = DT + (size_t)(row0 + ai * 128 + m * 16) * 64 + cc; f32x4 v0 = acc[ai][0][m][0] + b0, v1 = acc[ai][0][m][1] + b1;
#pragma unroll
                        for (int j = 0; j < 4; ++j) { v0[j] = v0[j] > 20.f ? v0[j] : log1pf(expf(v0[j])); v1[j] = v1[j] > 20.f ? v1[j] : log1pf(expf(v1[j])); }
                        *(f32x4*)rp = v0; *(f32x4*)(rp + 4) = v1; } }
            return;
        }
        bf16_t* base; int ld, c0; bool sg = false;
        if (ct < 1024) { base = (bf16_t*)(big + B_U5); ld = 1024; c0 = ct; }
        else if (ct < 4096) { base = (bf16_t*)(big + B_XBC); ld = 3072; c0 = ct - 1024; }
        else if (ct < 6144) { base = (bf16_t*)(big + B_Z); ld = 2048; c0 = ct - 4096; }
        else { base = (bf16_t*)(big + B_GATE); ld = 4096; c0 = ct - 6144; sg = true; }
        const int col0 = c0 + wc * 32 + 8 * fq;
#pragma unroll
        for (int ai = 0; ai < 2; ++ai)
#pragma unroll
            for (int m = 0; m < 4; ++m) { bf16_t* rowp = base + (size_t)(row0 + ai * 128 + m * 16) * ld + col0;
#pragma unroll
                for (int bj = 0; bj < 2; ++bj) { f32x4 v0 = acc[ai][bj][m][0], v1 = acc[ai][bj][m][1];
                    if (sg) {
#pragma unroll
                        for (int j = 0; j < 4; ++j) { v0[j] = sigm(v0[j]); v1[j] = sigm(v1[j]); } }
                    u32x4 w; w.x = cvt_pk_native(v0[0], v0[1]); w.y = cvt_pk_native(v0[2], v0[3]); w.z = cvt_pk_native(v1[0], v1[1]); w.w = cvt_pk_native(v1[2], v1[3]);
                    *(u32x4*)(rowp + bj * 128) = w; } }
    }
};
struct EpiGlu {
    static constexpr bool PERM = true, AFTER_DRAIN = false;
    bf16_t* O;
    __device__ __forceinline__ void operator()(const f32x4 (&acc)[2][2][4][2], const Unit& u, int wr, int wc, int fr, int fq) const {
        mfma_settle(acc[1][1][3][1]); mfma_settle(acc[1][1][3][0]);
        const int row0 = u.pm * 256 + wr * 64 + fr, col0 = u.pn * 128 + wc * 32 + 8 * fq;
#pragma unroll
        for (int ai = 0; ai < 2; ++ai)
#pragma unroll
            for (int m = 0; m < 4; ++m) { f32x4 v0 = acc[ai][0][m][0], v1 = acc[ai][0][m][1]; const f32x4 g0 = acc[ai][1][m][0], g1 = acc[ai][1][m][1];
#pragma unroll
                for (int j = 0; j < 4; ++j) { v0[j] *= sigm(g0[j]); v1[j] *= sigm(g1[j]); }
                u32x4 w; w.x = cvt_pk_bf16(v0[0], v0[1]); w.y = cvt_pk_bf16(v0[2], v0[3]); w.z = cvt_pk_bf16(v1[0], v1[1]); w.w = cvt_pk_bf16(v1[2], v1[3]);
                *(u32x4*)(O + (size_t)(row0 + ai * 128 + m * 16) * 1024 + col0) = w; }
    }
};
template <int SECOND, int GSEL = SECOND> struct EpiMerge {
    static constexpr bool PERM = true, AFTER_DRAIN = false;
    bf16_t* MG; const bf16_t* GATE;
    __device__ __forceinline__ void operator()(const f32x4 (&acc)[2][2][4][2], const Unit& u, int wr, int wc, int fr, int fq) const {
        mfma_settle(acc[1][1][3][1]); mfma_settle(acc[1][1][3][0]);
        const int row0 = u.pm * 256 + wr * 64 + fr, col0 = u.pn * 256 + wc * 32 + 8 * fq;
#pragma unroll
        for (int ai = 0; ai < 2; ++ai)
#pragma unroll
            for (int m = 0; m < 4; ++m) { const size_t r = (size_t)(row0 + ai * 128 + m * 16); u32x4 gg[2], oo[2];
#pragma unroll
                for (int bj = 0; bj < 2; ++bj) { const int c = col0 + bj * 128; gg[bj] = *(const u32x4*)(GATE + r * 4096 + (GSEL ? 2048 : 0) + c); if (SECOND) oo[bj] = *(const u32x4*)(MG + r * 2048 + c); }
                __builtin_amdgcn_sched_barrier(0);
#pragma unroll
                for (int bj = 0; bj < 2; ++bj) { const int c = col0 + bj * 128; const u32x4 g = gg[bj];
                    f32x4 v0 = acc[ai][bj][m][0], v1 = acc[ai][bj][m][1];
                    v0[0] *= bflo(g.x); v0[1] *= bfhi(g.x); v0[2] *= bflo(g.y); v0[3] *= bfhi(g.y); v1[0] *= bflo(g.z); v1[1] *= bfhi(g.z); v1[2] *= bflo(g.w); v1[3] *= bfhi(g.w);
                    if (SECOND) { const u32x4 o = oo[bj];
                        v0[0] += bflo(o.x); v0[1] += bfhi(o.x); v0[2] += bflo(o.y); v0[3] += bfhi(o.y); v1[0] += bflo(o.z); v1[1] += bfhi(o.z); v1[2] += bflo(o.w); v1[3] += bfhi(o.w); }
                    u32x4 w; w.x = cvt_pk_bf16(v0[0], v0[1]); w.y = cvt_pk_bf16(v0[2], v0[3]); w.z = cvt_pk_bf16(v1[0], v1[1]); w.w = cvt_pk_bf16(v1[2], v1[3]);
                    *(u32x4*)(MG + r * 2048 + c) = w; }
                __builtin_amdgcn_sched_barrier(0); }
    }
};
struct EpiResid {
    static constexpr bool PERM = false, AFTER_DRAIN = false;
    float* out; float* hctx; const float* glat; const float* gctx;
    __device__ __forceinline__ void operator()(const f32x4 (&acc)[2][2][4][2], const Unit& u, int wr, int wc, int fr, int fq) const {
        mfma_settle(acc[1][1][3][1]); mfma_settle(acc[1][1][3][0]);
        const bool isctx = u.pm >= 64; const float* g = isctx ? gctx : glat;
        float* hb = isctx ? hctx + (size_t)(wr * 64 + fr) * D : out + (size_t)(u.pm * 256 + wr * 64 + fr) * D;
        const int col0 = u.pn * 256 + wc * 32 + 4 * fq;
        f32x4 gv[2][2];
#pragma unroll
        for (int bj = 0; bj < 2; ++bj)
#pragma unroll
            for (int n = 0; n < 2; ++n) gv[bj][n] = *(const f32x4*)(g + col0 + bj * 128 + n * 16);
#pragma unroll
        for (int ai = 0; ai < 2; ++ai)
#pragma unroll
            for (int m = 0; m < 4; ++m) { float* rowp = hb + (size_t)(ai * 128 + m * 16) * D + col0;
                { f32x4 h[2][2];
#pragma unroll
                for (int bj = 0; bj < 2; ++bj)
#pragma unroll
                    for (int n = 0; n < 2; ++n) h[bj][n] = *(const f32x4*)(rowp + bj * 128 + n * 16);
                __builtin_amdgcn_sched_barrier(0);
#pragma unroll
                for (int bj = 0; bj < 2; ++bj)
#pragma unroll
                    for (int n = 0; n < 2; ++n) *(f32x4*)(rowp + bj * 128 + n * 16) = h[bj][n] * ALPHA + gv[bj][n] * acc[ai][bj][m][n];
                __builtin_amdgcn_sched_barrier(0); } }
    }
};
struct EpiUp {
    static constexpr bool PERM = true, AFTER_DRAIN = false;
    bf16_t* G; bf16_t* V;
    __device__ __forceinline__ void operator()(const f32x4 (&acc)[2][2][4][2], const Unit& u, int wr, int wc, int fr, int fq) const {
        mfma_settle(acc[1][1][3][1]); mfma_settle(acc[1][1][3][0]);
        const int row0 = u.pm * 256 + wr * 64 + fr; int ct = u.pn * 256; bf16_t* base = G; if (ct >= DFF) { base = V; ct -= DFF; }
        const int col0 = ct + wc * 32 + 8 * fq;
#pragma unroll
        for (int ai = 0; ai < 2; ++ai)
#pragma unroll
            for (int m = 0; m < 4; ++m) { bf16_t* rowp = base + (size_t)(row0 + ai * 128 + m * 16) * DFF + col0;
#pragma unroll
                for (int bj = 0; bj < 2; ++bj) { const f32x4 v0 = acc[ai][bj][m][0], v1 = acc[ai][bj][m][1];
                    u32x4 w; w.x = cvt_pk_native(v0[0], v0[1]); w.y = cvt_pk_native(v0[2], v0[3]); w.z = cvt_pk_native(v1[0], v1[1]); w.w = cvt_pk_native(v1[2], v1[3]);
                    *(u32x4*)(rowp + bj * 128) = w; } }
    }
};

struct XItem { const float* W; bf16_t* WT; int K, N, d0, s0, k0; };
__device__ __forceinline__ void xpose_load(const XItem& x, float (&v)[32], int lane) {
#pragma unroll
    for (int i = 0; i < 32; ++i) { const int kk = 2 * i + (lane >> 5); v[i] = x.s0 >= 0 ? x.W[(size_t)(x.k0 + kk) * x.N + x.s0 + (lane & 31)] : 0.f; }
}
__device__ __forceinline__ void xpose_store(const XItem& x, const float (&v)[32], float* scr, int lane) {
#pragma unroll
    for (int i = 0; i < 32; ++i) { const int kk = 2 * i + (lane >> 5); scr[kk * 33 + (lane & 31)] = v[i]; }
    asm volatile("s_waitcnt lgkmcnt(0)" ::: "memory");
    const int c = lane & 7;
#pragma unroll
    for (int j = 0; j < 4; ++j) { const int n = (lane >> 3) + 8 * j; const float* sp = scr + (8 * c) * 33 + n;
        u32x4 o; o.x = cvt_pk_bf16(sp[0 * 33], sp[1 * 33]); o.y = cvt_pk_bf16(sp[2 * 33], sp[3 * 33]); o.z = cvt_pk_bf16(sp[4 * 33], sp[5 * 33]); o.w = cvt_pk_bf16(sp[6 * 33], sp[7 * 33]);
        *(u32x4*)(x.WT + (size_t)(x.d0 + n) * x.K + x.k0 + 8 * c) = o; }
    asm volatile("s_waitcnt lgkmcnt(0)" ::: "memory");
}
__device__ __forceinline__ XItem xpose_decode(const Args& a, int layer, int region, int r) {
    XItem x;
    if (region == 0) {
        bf16_t* WA = (bf16_t*)(a.ws + WS_WA);
        constexpr int I_IN = 32 * 328, I_GLU = 16 * 64, I_S5P = 16 * 64, I_SSDP = 32 * 64;
        if (r < I_IN) { const int kb = r / 328, d0 = (r % 328) * 32; int s0; if (d0 < 4096) s0 = d0; else if (d0 < 10240) s0 = d0 + 64; else if (d0 < 10304) s0 = d0 - 10240 + 4096; else s0 = -1;
            x.W = a.in[6] + (size_t)layer * 2048 * 10304; x.WT = WA + WA_IN / 2; x.K = 2048; x.N = 10304; x.d0 = d0; x.s0 = s0; x.k0 = kb * 64; return x; } r -= I_IN;
        if (r < I_GLU) { const int kb = r / 64, d0 = (r % 64) * 32, t = d0 >> 8, j = d0 & 255;
            x.W = a.in[15] + (size_t)layer * 1024 * 2048; x.WT = WA + WA_GLU / 2; x.K = 1024; x.N = 2048; x.d0 = d0; x.s0 = j < 128 ? t * 128 + j : 1024 + t * 128 + (j - 128); x.k0 = kb * 64; return x; } r -= I_GLU;
        if (r < I_S5P) { x.W = a.in[16] + (size_t)layer * 1024 * 2048; x.WT = WA + WA_S5P / 2; x.K = 1024; x.N = 2048; x.d0 = (r % 64) * 32; x.s0 = x.d0; x.k0 = (r / 64) * 64; return x; } r -= I_S5P;
        if (r < I_SSDP) { x.W = a.in[23] + (size_t)layer * 2048 * 2048; x.WT = WA + WA_SSDP / 2; x.K = 2048; x.N = 2048; x.d0 = (r % 64) * 32; x.s0 = x.d0; x.k0 = (r / 64) * 64; return x; } r -= I_SSDP;
        x.W = a.in[24] + (size_t)layer * 2048 * 2048; x.WT = WA + WA_WOUT / 2; x.K = 2048; x.N = 2048; x.d0 = (r % 64) * 32; x.s0 = x.d0; x.k0 = (r / 64) * 64; return x;
    }
    bf16_t* WB = (bf16_t*)(a.ws + WS_WB); constexpr int I_UP = 32 * 352;
    if (r < I_UP) { x.W = a.in[27] + (size_t)layer * 2048 * 11264; x.WT = WB + WB_UP / 2; x.K = 2048; x.N = 11264; x.d0 = (r % 352) * 32; x.s0 = x.d0; x.k0 = (r / 352) * 64; return x; } r -= I_UP;
    x.W = a.in[30] + (size_t)layer * 5632 * 2048; x.WT = WB + WB_DOWN / 2; x.K = 5632; x.N = 2048; x.d0 = (r % 64) * 32; x.s0 = x.d0; x.k0 = (r / 64) * 64; return x;
}
__device__ __forceinline__ void xpose_region(const Args& a, int layer, int region, float* scr, int gw, int NGW, int lane) {
    const int NI = region == 0 ? (32 * 328 + 16 * 64 + 16 * 64 + 32 * 64 + 32 * 64) : (32 * 352 + 88 * 64);
    int it = gw;
    for (; it + 3 * NGW < NI; it += 4 * NGW) {
        const XItem x0 = xpose_decode(a, layer, region, it), x1 = xpose_decode(a, layer, region, it + NGW), x2 = xpose_decode(a, layer, region, it + 2 * NGW), x3 = xpose_decode(a, layer, region, it + 3 * NGW);
        float v0[32], v1[32], v2[32], v3[32]; xpose_load(x0, v0, lane); xpose_load(x1, v1, lane); xpose_load(x2, v2, lane); xpose_load(x3, v3, lane);
        xpose_store(x0, v0, scr, lane); xpose_store(x1, v1, scr, lane); xpose_store(x2, v2, scr, lane); xpose_store(x3, v3, scr, lane);
    }
    for (; it < NI; it += NGW) { const XItem x0 = xpose_decode(a, layer, region, it); float v0[32]; xpose_load(x0, v0, lane); xpose_store(x0, v0, scr, lane); }
}

__device__ __forceinline__ void adaln_phase(const Args& a, float* lds, int tid) {
    float* sc = lds; float* scx = lds + 2048; float* red = lds + 4096;
    for (int i = tid; i < 2048; i += 512) { sc[i] = silu_(a.in[1][i]); scx[i] = silu_(a.in[3][i]); }
    __syncthreads();
    for (int unit = blockIdx.x; unit < 256; unit += gridDim.x) {
        const int layer = unit >> 7, col0 = (unit & 127) * 96;
        const float* W = a.in[4] + (size_t)layer * 2048 * 12288 + col0;
        if (tid < 504) { const int cq = tid % 24, ks = tid / 24; f32x4 al = {0.f, 0.f, 0.f, 0.f}, ac = {0.f, 0.f, 0.f, 0.f};
#pragma unroll 14
            for (int k = ks; k < 2048; k += 21) { const f32x4 w = *(const f32x4*)(W + (size_t)k * 12288 + cq * 4); al += w * sc[k]; ac += w * scx[k]; }
            *(f32x4*)(red + (ks * 2 + 0) * 96 + cq * 4) = al; *(f32x4*)(red + (ks * 2 + 1) * 96 + cq * 4) = ac; }
        __syncthreads();
        if (tid < 192) { const int v = tid / 96, c = tid % 96; float s = 0.f; for (int ks = 0; ks < 21; ++ks) s += red[(ks * 2 + v) * 96 + c];
            ((float*)(a.ws + WS_MVEC))[(size_t)(layer * 2 + v) * 12288 + col0 + c] = s + a.in[5][(size_t)layer * 12288 + col0 + c]; }
        __syncthreads();
    }
}

__device__ __forceinline__ float wave_sum(float v) {
#pragma unroll
    for (int o = 1; o < 64; o <<= 1) v += __shfl_xor(v, o);
    return v;
}
template <int MODE> __device__ __forceinline__ void row_phase(const Args& a, int nrows, const float* lng, const float* lnb, int mod_layer, int mod_off, int gw, int NGW, int lane) {
    bf16_t* XM = (bf16_t*)(a.ws + WS_XM);
    f32x4 lg[8], lb[8];
    if (MODE == 1) {
#pragma unroll
        for (int j = 0; j < 8; ++j) { lg[j] = *(const f32x4*)(lng + 4 * lane + 256 * j); lb[j] = *(const f32x4*)(lnb + 4 * lane + 256 * j); } }
    for (int row0 = gw; row0 < nrows; row0 += 2 * NGW) {
        const int row1 = row0 + NGW < nrows ? row0 + NGW : row0;
        const int rows[2] = {row0, row1}; f32x4 v[2][8];
#pragma unroll
        for (int u = 0; u < 2; ++u) { const int row = rows[u]; const int isctx = row >= TL;
            const float* src = MODE == 0 ? (isctx ? a.in[2] + (size_t)(row - TL) * D : a.in[0] + (size_t)row * D) : hrow(a, row);
#pragma unroll
            for (int j = 0; j < 8; ++j) v[u][j] = *(const f32x4*)(src + 4 * lane + 256 * j); }
        if (MODE == 1) {
            float s[2], q[2];
#pragma unroll
            for (int u = 0; u < 2; ++u) { s[u] = 0.f;
#pragma unroll
                for (int j = 0; j < 8; ++j) s[u] += (v[u][j][0] + v[u][j][1]) + (v[u][j][2] + v[u][j][3]); }
            s[0] = wave_sum(s[0]); s[1] = wave_sum(s[1]);
#pragma unroll
            for (int u = 0; u < 2; ++u) { const float mean = s[u] * (1.f / D); q[u] = 0.f;
#pragma unroll
                for (int j = 0; j < 8; ++j) { v[u][j] = v[u][j] - mean; q[u] += (v[u][j][0] * v[u][j][0] + v[u][j][1] * v[u][j][1]) + (v[u][j][2] * v[u][j][2] + v[u][j][3] * v[u][j][3]); } }
            q[0] = wave_sum(q[0]); q[1] = wave_sum(q[1]);
#pragma unroll
            for (int u = 0; u < 2; ++u) { const float rstd = __builtin_amdgcn_rsqf(q[u] * (1.f / D) + LN_EPS);
#pragma unroll
                for (int j = 0; j < 8; ++j) v[u][j] = v[u][j] * rstd * lg[j] + lb[j]; }
        }
#pragma unroll
        for (int u = 0; u < 2; ++u) { const int row = rows[u]; const int isctx = row >= TL; float* h = hrow(a, row);
#pragma unroll
            for (int j = 0; j < 8; ++j) *(f32x4*)(h + 4 * lane + 256 * j) = v[u][j];
            if (mod_layer >= 0) { const float* m = mvec(a, mod_layer, isctx) + mod_off; f32x4 shv[8], scv[8];
#pragma unroll
                for (int j = 0; j < 8; ++j) { shv[j] = *(const f32x4*)(m + 4 * lane + 256 * j); scv[j] = *(const f32x4*)(m + D + 4 * lane + 256 * j); }
                __builtin_amdgcn_sched_barrier(0);
#pragma unroll
                for (int j = 0; j < 8; ++j) { const f32x4 sh = shv[j], scl = scv[j]; const f32x4 o = v[u][j] * (scl + 1.f) + sh;
                    u32x2 w; w.x = cvt_pk_bf16(o[0], o[1]); w.y = cvt_pk_bf16(o[2], o[3]); *(u32x2*)(XM + (size_t)row * D + 4 * lane + 256 * j) = w; } } }
    }
}

__device__ __forceinline__ void ffnconv_ctx(const Args& a, int layer, int tid) {
    const bf16_t* G = (const bf16_t*)(a.ws + WS_BIG + B_G); bf16_t* V = (bf16_t*)(a.ws + WS_BIG + B_V);
    const float* cw = a.in[28] + (size_t)layer * 9 * DFF; const float* cb = a.in[29] + (size_t)layer * DFF;
    const int nunits = 260 * 11; const int oc = tid & 63, xs = tid >> 6;
    for (int unit = 256 * 11 + blockIdx.x; unit < nunits; unit += gridDim.x) {
        const int seg = unit / 11, ob = unit % 11, ch0 = ob * 512 + oc * 8; const bool cs = seg >= 256; const int t0 = seg * 64;
        float w[9][8], bias[8];
#pragma unroll
        for (int k = 0; k < 9; ++k) { const f32x4 w0 = *(const f32x4*)(cw + (size_t)k * DFF + ch0), w1 = *(const f32x4*)(cw + (size_t)k * DFF + ch0 + 4);
            w[k][0] = w0[0]; w[k][1] = w0[1]; w[k][2] = w0[2]; w[k][3] = w0[3]; w[k][4] = w1[0]; w[k][5] = w1[1]; w[k][6] = w1[2]; w[k][7] = w1[3]; }
        { const f32x4 b0 = *(const f32x4*)(cb + ch0), b1 = *(const f32x4*)(cb + ch0 + 4); bias[0] = b0[0]; bias[1] = b0[1]; bias[2] = b0[2]; bias[3] = b0[3]; bias[4] = b1[0]; bias[5] = b1[1]; bias[6] = b1[2]; bias[7] = b1[3]; }
#pragma unroll 4
        for (int xi = 0; xi < 8; ++xi) { const int x = xs * 8 + xi, t = t0 + x; float acc[8];
#pragma unroll
            for (int k = 0; k < 8; ++k) acc[k] = bias[k];
            u32x4 g3[3]; bf16_t* vp = V + (size_t)t * DFF + ch0;
#pragma unroll
            for (int dx = -1; dx <= 1; ++dx) { const bool ok = t + dx >= TL && t + dx < MT; g3[dx + 1] = *(const u32x4*)(G + (size_t)(ok ? t + dx : t) * DFF + ch0); }
            const u32x4 vv = *(const u32x4*)vp;
            __builtin_amdgcn_sched_barrier(0);
#pragma unroll
            for (int dx = -1; dx <= 1; ++dx) { const bool ok = t + dx >= TL && t + dx < MT; u32x4 g = g3[dx + 1]; if (!ok) g = (u32x4){0u, 0u, 0u, 0u}; const int k = 3 + dx + 1;
                acc[0] += w[k][0] * bflo(g.x); acc[1] += w[k][1] * bfhi(g.x); acc[2] += w[k][2] * bflo(g.y); acc[3] += w[k][3] * bfhi(g.y);
                acc[4] += w[k][4] * bflo(g.z); acc[5] += w[k][5] * bfhi(g.z); acc[6] += w[k][6] * bflo(g.w); acc[7] += w[k][7] * bfhi(g.w); }
            u32x4 o; o.x = cvt_pk_bf16(silu_(acc[0]) * bflo(vv.x), silu_(acc[1]) * bfhi(vv.x)); o.y = cvt_pk_bf16(silu_(acc[2]) * bflo(vv.y), silu_(acc[3]) * bfhi(vv.y));
            o.z = cvt_pk_bf16(silu_(acc[4]) * bflo(vv.z), silu_(acc[5]) * bfhi(vv.z)); o.w = cvt_pk_bf16(silu_(acc[6]) * bflo(vv.w), silu_(acc[7]) * bfhi(vv.w));
            *(u32x4*)vp = o; }
    }
}

__device__ __forceinline__ void ffnconv_phase(const Args& a, int layer, bool with_ctx, unsigned char* lds, int tid) {
    const bf16_t* G = (const bf16_t*)(a.ws + WS_BIG + B_G); bf16_t* V = (bf16_t*)(a.ws + WS_BIG + B_V);
    const float* cw = a.in[28] + (size_t)layer * 9 * DFF; const float* cb = a.in[29] + (size_t)layer * DFF;
    bf16_t* T = (bf16_t*)lds;
    const int oc = tid & 15, ts = tid >> 4;
    u32x4 gn[12];
#define FFC_PREFETCH(unit_) do { const int rg_ = (unit_) / 44, ch_ = ((unit_) % 44) * 128 + oc * 8, y0_ = rg_ * 4; \
        _Pragma("unroll") for (int i = 0; i < 12; ++i) { const int idx = tid + i * 512, r = idx >> 10, x = (idx >> 4) & 63, y = y0_ - 1 + r; const bool ok = y >= 0 && y < 256; \
            gn[i] = *(const u32x4*)(G + (size_t)((ok ? y : y0_) * 64 + x) * DFF + ch_); } } while (0)
    for (int unit = blockIdx.x; unit < 64 * 44; unit += gridDim.x) {
        const int rg = unit / 44, ch0 = (unit % 44) * 128 + oc * 8, y0 = rg * 4;
        FFC_PREFETCH(unit);
        __syncthreads();
#pragma unroll
        for (int i = 0; i < 12; ++i) { const int idx = tid + i * 512, r = idx >> 10, x = (idx >> 4) & 63, y = y0 - 1 + r; const bool ok = y >= 0 && y < 256;
            *(u32x4*)(T + ((r * 64 + x) * 128 + oc * 8)) = ok ? gn[i] : (u32x4){0u, 0u, 0u, 0u}; }
        u32x4 vv[8];
#pragma unroll
        for (int o = 0; o < 8; ++o) vv[o] = *(const u32x4*)(V + (size_t)((y0 + (o >> 1)) * 64 + ts * 2 + (o & 1)) * DFF + ch0);
        float w[9][8], bias[8];
#pragma unroll
        for (int k = 0; k < 9; ++k) { const f32x4 w0 = *(const f32x4*)(cw + (size_t)k * DFF + ch0), w1 = *(const f32x4*)(cw + (size_t)k * DFF + ch0 + 4);
            w[k][0] = w0[0]; w[k][1] = w0[1]; w[k][2] = w0[2]; w[k][3] = w0[3]; w[k][4] = w1[0]; w[k][5] = w1[1]; w[k][6] = w1[2]; w[k][7] = w1[3]; }
        { const f32x4 b0 = *(const f32x4*)(cb + ch0), b1 = *(const f32x4*)(cb + ch0 + 4); bias[0] = b0[0]; bias[1] = b0[1]; bias[2] = b0[2]; bias[3] = b0[3]; bias[4] = b1[0]; bias[5] = b1[1]; bias[6] = b1[2]; bias[7] = b1[3]; }
        __syncthreads();
#pragma unroll
        for (int o = 0; o < 8; ++o) { const int rr = o >> 1, x = ts * 2 + (o & 1); float acc[8];
#pragma unroll
            for (int k = 0; k < 8; ++k) acc[k] = bias[k];
            u32x4 g9[9];
#pragma unroll
            for (int dy = -1; dy <= 1; ++dy)
#pragma unroll
                for (int dx = -1; dx <= 1; ++dx) { const int xn = x + dx; const bool ok = xn >= 0 && xn < 64; g9[(dy + 1) * 3 + dx + 1] = *(const u32x4*)(T + (((rr + 1 + dy) * 64 + (ok ? xn : x)) * 128 + oc * 8)); }
            __builtin_amdgcn_sched_barrier(0);
#pragma unroll
            for (int dy = -1; dy <= 1; ++dy)
#pragma unroll
                for (int dx = -1; dx <= 1; ++dx) { const int xn = x + dx; const bool ok = xn >= 0 && xn < 64; const int k = (dy + 1) * 3 + dx + 1;
                    u32x4 g = g9[k]; if (!ok) g = (u32x4){0u, 0u, 0u, 0u};
                    acc[0] += w[k][0] * bflo(g.x); acc[1] += w[k][1] * bfhi(g.x); acc[2] += w[k][2] * bflo(g.y); acc[3] += w[k][3] * bfhi(g.y);
                    acc[4] += w[k][4] * bflo(g.z); acc[5] += w[k][5] * bfhi(g.z); acc[6] += w[k][6] * bflo(g.w); acc[7] += w[k][7] * bfhi(g.w); }
            const u32x4 v = vv[o];
            u32x4 q; q.x = cvt_pk_bf16(silu_(acc[0]) * bflo(v.x), silu_(acc[1]) * bfhi(v.x)); q.y = cvt_pk_bf16(silu_(acc[2]) * bflo(v.y), silu_(acc[3]) * bfhi(v.y));
            q.z = cvt_pk_bf16(silu_(acc[4]) * bflo(v.z), silu_(acc[5]) * bfhi(v.z)); q.w = cvt_pk_bf16(silu_(acc[6]) * bflo(v.w), silu_(acc[7]) * bfhi(v.w));
            *(u32x4*)(V + (size_t)((y0 + rr) * 64 + x) * DFF + ch0) = q; }
    }
#undef FFC_PREFETCH
    __syncthreads();
    if (with_ctx) ffnconv_ctx(a, layer, tid);
}
__device__ __forceinline__ int s5_chunk_at(int dir, int q) { return dir ? 129 - q : (q + 128) % 130; }
__device__ __forceinline__ int s5_pos_of(int dir, int c) { return dir ? 129 - c : (c + 2) % 130; }
template <int PASS> __device__ __forceinline__ void s5_phase(const Args& a, int layer, unsigned char* lds, int tid, int nchunks) {
    constexpr int BUP = 132;
    const bf16_t* U5 = (const bf16_t*)(a.ws + WS_BIG + B_U5); bf16_t* Y5 = (bf16_t*)(a.ws + WS_BIG + B_Y5);
    float2* S5LOC = (float2*)(a.ws + WS_S5LOC);
    const int lane = tid & 63, w = tid >> 6, gl = w >> 1, dir = w & 1, p = lane, fr = lane & 15, fq = lane >> 4;
    float* BuW = (float*)lds + (size_t)w * (16 * BUP);
    bf16_t* STw = (bf16_t*)(lds + 67584) + (size_t)w * (16 * 136);
    float* YL = (float*)(lds + 102400);
    const int gq = blockIdx.x & 15, g = gq * 4 + gl;
    float ab_re, ab_im, a128r, a128i;
    const float step = expf(a.in[9][(size_t)(layer * 2 + dir) * 64 + g]);
    { const size_t pi = ((size_t)(layer * 2 + dir) * 64 + g) * 64 + p; const float lre = fminf(a.in[7][pi], -1e-4f), lim = a.in[8][pi];
      const float mag = expf(lre * step); float sn, cs; sincosf(lim * step, &sn, &cs); ab_re = mag * cs; ab_im = mag * sn; a128r = ab_re; a128i = ab_im;
#pragma unroll
      for (int k = 0; k < 7; ++k) { const float r = a128r * a128r - a128i * a128i, i = 2.f * a128r * a128i; a128r = r; a128i = i; } }
    bf16x8 bbf[8];
#pragma unroll
    for (int nt = 0; nt < 8; ++nt) { const int pp = nt * 8 + (fr >> 1), cc = fr & 1; const size_t pi = ((size_t)(layer * 2 + dir) * 64 + g) * 64 + pp;
        const float lre = fminf(a.in[7][pi], -1e-4f), lim = a.in[8][pi]; const float mag = expf(lre * step); float sn, cs; sincosf(lim * step, &sn, &cs);
        const float are = mag * cs, aim = mag * sn, den = lre * lre + lim * lim, q_re = ((are - 1.f) * lre + aim * lim) / den, q_im = (aim * lre - (are - 1.f) * lim) / den;
        const float* br = a.in[10] + (((size_t)layer * 64 + g) * 64 + pp) * 16 + (fq & 1) * 8; const float* bi = a.in[11] + (((size_t)layer * 64 + g) * 64 + pp) * 16 + (fq & 1) * 8;
        const f32x4 r0 = *(const f32x4*)br, r1 = *(const f32x4*)(br + 4), i0 = *(const f32x4*)bi, i1 = *(const f32x4*)(bi + 4); float v[8];
#pragma unroll
        for (int j = 0; j < 8; ++j) { const float r = j < 4 ? r0[j & 3] : r1[j & 3], i = j < 4 ? i0[j & 3] : i1[j & 3]; v[j] = fq < 2 ? (cc ? q_re * i + q_im * r : q_re * r - q_im * i) : 0.f; }
        bbf[nt] = mkfrag(cvt_pk_bf16(v[0], v[1]), cvt_pk_bf16(v[2], v[3]), cvt_pk_bf16(v[4], v[5]), cvt_pk_bf16(v[6], v[7])); }
    bf16x8 cm[4];
    if (PASS == 1) {
        const float* cre = a.in[12] + (((size_t)(layer * 2 + dir) * 64 + g) * 16 + fr) * 64; const float* cim = a.in[13] + (((size_t)(layer * 2 + dir) * 64 + g) * 16 + fr) * 64;
#pragma unroll
        for (int ks = 0; ks < 4; ++ks) { const f32x4 r = *(const f32x4*)(cre + ks * 16 + fq * 4), i = *(const f32x4*)(cim + ks * 16 + fq * 4);
            cm[ks] = mkfrag(cvt_pk_bf16(r[0], -i[0]), cvt_pk_bf16(r[1], -i[1]), cvt_pk_bf16(r[2], -i[2]), cvt_pk_bf16(r[3], -i[3])); }
    }
    const int cstep = gridDim.x >> 4;
    float2* S5IN = (float2*)(a.ws + WS_S5IN);
    if (PASS == 1) {
        float sr = 0.f, si = 0.f;
#pragma unroll 1
        for (int q0 = 0; q0 < NCH; q0 += 13) { float2 l[13];
#pragma unroll
            for (int i = 0; i < 13; ++i) l[i] = S5LOC[((size_t)(dir * NCH + s5_chunk_at(dir, q0 + i)) * 64 + g) * 64 + p];
#pragma unroll
            for (int i = 0; i < 13; ++i) { const int cc = s5_chunk_at(dir, q0 + i);
                if (cc < nchunks && (cc % cstep) == (int)(blockIdx.x >> 4)) S5IN[((size_t)(dir * NCH + cc) * 64 + g) * 64 + p] = make_float2(sr, si);
                const float nr = a128r * sr - a128i * si + l[i].x, ni = a128r * si + a128i * sr + l[i].y; sr = nr; si = ni; } }
    }
    for (int c = blockIdx.x >> 4; c < nchunks; c += cstep) {
        const int row0 = c * 128;
        bf16x8 uf[8];
#pragma unroll
        for (int k = 0; k < 8; ++k) { const int sl = dir ? 7 - k : k; uf[k] = *(const bf16x8*)(U5 + (size_t)(row0 + sl * 16 + fr) * 1024 + g * 16 + (fq & 1) * 8); }
        __builtin_amdgcn_sched_barrier(0);
#pragma unroll
        for (int k = 0; k < 8; ++k) if (fq >= 2) uf[k] = mkfrag(0u, 0u, 0u, 0u);
        float sr = 0.f, si = 0.f;
        if (PASS == 1) { const float2 s0 = S5IN[((size_t)(dir * NCH + c) * 64 + g) * 64 + p]; sr = s0.x; si = s0.y; }
        f32x4 yacc[8];
#pragma unroll
        for (int k = 0; k < 8; ++k) {
#pragma unroll
            for (int nt = 0; nt < 8; ++nt) { f32x4 acc = {0.f, 0.f, 0.f, 0.f}; acc = __builtin_amdgcn_mfma_f32_16x16x32_bf16(uf[k], bbf[nt], acc, 0, 0, 0);
#pragma unroll
                for (int jj = 0; jj < 4; ++jj) BuW[(fq * 4 + jj) * BUP + nt * 16 + fr] = acc[jj]; }
            asm volatile("s_waitcnt lgkmcnt(0)" ::: "memory");
#pragma unroll
            for (int ii = 0; ii < 16; ++ii) { const int tl = dir ? 15 - ii : ii; const f32x2 b2 = *(const f32x2*)(BuW + tl * BUP + 2 * p);
                f32x2 ns = __builtin_elementwise_fma((f32x2){ab_re, ab_re}, (f32x2){sr, si}, b2); ns = __builtin_elementwise_fma((f32x2){-ab_im, ab_im}, (f32x2){si, sr}, ns); sr = ns[0]; si = ns[1];
                if (PASS == 1) *(unsigned*)(STw + tl * 136 + 2 * p) = cvt_pk_bf16(sr, si); }
            if (PASS == 1) {
                asm volatile("s_waitcnt lgkmcnt(0)" ::: "memory");
                f32x4 acc = {0.f, 0.f, 0.f, 0.f};
#pragma unroll
                for (int ks = 0; ks < 4; ++ks) acc = __builtin_amdgcn_mfma_f32_16x16x32_bf16(*(const bf16x8*)(STw + fr * 136 + ks * 32 + fq * 8), cm[ks], acc, 0, 0, 0);
                yacc[k] = acc;
            }
            asm volatile("s_waitcnt lgkmcnt(0)" ::: "memory");
        }
        if (PASS == 0) { S5LOC[((size_t)(dir * NCH + c) * 64 + g) * 64 + p] = make_float2(sr, si); }
        else {
            __syncthreads();
            if (dir == 0) {
#pragma unroll
                for (int k = 0; k < 8; ++k)
#pragma unroll
                    for (int jj = 0; jj < 4; ++jj) YL[gl * 2048 + (k * 16 + fq * 4 + jj) * 16 + fr] = yacc[k][jj]; }
            __syncthreads();
            if (dir == 1) {
#pragma unroll
                for (int k = 0; k < 8; ++k)
#pragma unroll
                    for (int jj = 0; jj < 4; ++jj) YL[gl * 2048 + ((7 - k) * 16 + fq * 4 + jj) * 16 + fr] += yacc[k][jj]; }
            __syncthreads();
            const int t = tid >> 2, q = tid & 3; const float* y = YL + q * 2048 + t * 16; const float* dd = a.in[14] + (size_t)layer * 1024 + gq * 64 + q * 16;
            const bf16_t* us = U5 + (size_t)(row0 + t) * 1024 + gq * 64 + q * 16; const u32x4 u0 = *(const u32x4*)us, u1 = *(const u32x4*)(us + 8);
            const float u[16] = {bflo(u0.x), bfhi(u0.x), bflo(u0.y), bfhi(u0.y), bflo(u0.z), bfhi(u0.z), bflo(u0.w), bfhi(u0.w), bflo(u1.x), bfhi(u1.x), bflo(u1.y), bfhi(u1.y), bflo(u1.z), bfhi(u1.z), bflo(u1.w), bfhi(u1.w)};
            f32x4 dq[4], yq[4];
#pragma unroll
            for (int j = 0; j < 4; ++j) { dq[j] = *(const f32x4*)(dd + 4 * j); yq[j] = *(const f32x4*)(y + 4 * j); }
            __builtin_amdgcn_sched_barrier(0);
            unsigned o[8];
#pragma unroll
            for (int j = 0; j < 8; ++j) { const int e0 = 2 * j, e1 = 2 * j + 1; const float y0 = yq[e0 >> 2][e0 & 3] + u[e0] * dq[e0 >> 2][e0 & 3], y1 = yq[e1 >> 2][e1 & 3] + u[e1] * dq[e1 >> 2][e1 & 3]; o[j] = cvt_pk_bf16(gelu_tanh(y0), gelu_tanh(y1)); }
            bf16_t* dst = Y5 + (size_t)(row0 + t) * 1024 + gq * 64 + q * 16; u32x4 o0, o1; o0.x = o[0]; o0.y = o[1]; o0.z = o[2]; o0.w = o[3]; o1.x = o[4]; o1.y = o[5]; o1.z = o[6]; o1.w = o[7];
            *(u32x4*)dst = o0; *(u32x4*)(dst + 8) = o1;
        }
    }
    __syncthreads();
}

__device__ __forceinline__ int ssd_chunk_at(int dir, int q) { return s5_chunk_at(dir, q); }
__device__ __forceinline__ void conv8(const bf16_t* XBC, int rowbase, int l0, int ch, bool lo_ok, bool hi_ok, float w0, float w1, float w2, float b, float (&out)[8]) {
    float r[10];
#pragma unroll
    for (int i = 0; i < 10; ++i) { const int l = l0 - 1 + i; const bool ok = (l >= 0 || lo_ok) && (l < 128 || hi_ok); r[i] = ok ? bf2f((unsigned)XBC[(size_t)(rowbase + l) * 3072 + ch]) : 0.f; }
#pragma unroll
    for (int j = 0; j < 8; ++j) out[j] = silu_(w0 * r[j] + w1 * r[j + 1] + w2 * r[j + 2] + b);
}
__device__ __forceinline__ void stage_conv_tile(const bf16_t* XBC, const float* cw, const float* cb, int rowbase, int chbase, bool lo_ok, bool hi_ok, bf16_t* dst, int tid) {
    const int oc = tid & 15, ch = chbase + oc * 8; float w[3][8], b[8];
#pragma unroll
    for (int k = 0; k < 3; ++k) { const f32x4 a0 = *(const f32x4*)(cw + (size_t)k * 3072 + ch), a1 = *(const f32x4*)(cw + (size_t)k * 3072 + ch + 4);
        w[k][0] = a0[0]; w[k][1] = a0[1]; w[k][2] = a0[2]; w[k][3] = a0[3]; w[k][4] = a1[0]; w[k][5] = a1[1]; w[k][6] = a1[2]; w[k][7] = a1[3]; }
    { const f32x4 a0 = *(const f32x4*)(cb + ch), a1 = *(const f32x4*)(cb + ch + 4); b[0] = a0[0]; b[1] = a0[1]; b[2] = a0[2]; b[3] = a0[3]; b[4] = a1[0]; b[5] = a1[1]; b[6] = a1[2]; b[7] = a1[3]; }
    u32x4 gl[4][3];
#pragma unroll
    for (int i = 0; i < 4; ++i) { const int row = (tid >> 4) + i * 32;
#pragma unroll
        for (int d = 0; d < 3; ++d) { const bool ok = d == 1 ? true : (d == 0 ? (row > 0 || lo_ok) : (row < 127 || hi_ok)); const int l = ok ? row + d - 1 : row;
            gl[i][d] = *(const u32x4*)(XBC + (size_t)(rowbase + l) * 3072 + ch); } }
    __builtin_amdgcn_sched_barrier(0);
#pragma unroll
    for (int i = 0; i < 4; ++i) { const int row = (tid >> 4) + i * 32; float acc[8];
#pragma unroll
        for (int k = 0; k < 8; ++k) acc[k] = b[k];
#pragma unroll
        for (int d = 0; d < 3; ++d) { const bool ok = d == 1 ? true : (d == 0 ? (row > 0 || lo_ok) : (row < 127 || hi_ok));
            { u32x4 g = gl[i][d]; if (!ok) g = (u32x4){0u, 0u, 0u, 0u};
                acc[0] += w[d][0] * bflo(g.x); acc[1] += w[d][1] * bfhi(g.x); acc[2] += w[d][2] * bflo(g.y); acc[3] += w[d][3] * bfhi(g.y);
                acc[4] += w[d][4] * bflo(g.z); acc[5] += w[d][5] * bfhi(g.z); acc[6] += w[d][6] * bflo(g.w); acc[7] += w[d][7] * bfhi(g.w); } }
        u32x4 o; o.x = cvt_pk_bf16(silu_(acc[0]), silu_(acc[1])); o.y = cvt_pk_bf16(silu_(acc[2]), silu_(acc[3])); o.z = cvt_pk_bf16(silu_(acc[4]), silu_(acc[5])); o.w = cvt_pk_bf16(silu_(acc[6]), silu_(acc[7]));
        *(u32x4*)(dst + row * 136 + oc * 8) = o; }
}
constexpr int SL_CS = 0, SL_CB = 34816, SL_CUM = 69632, SL_DT = 77824, SL_PART = 86016, SL_BS = 94208, SL_XT = 94208;
template <int AUX> __device__ __forceinline__ void ssd_cum(const Args& a, int layer, int c, int h, int w, int lane, unsigned char* lds) {
    const float* DT = (const float*)(a.ws + WS_BIG + B_DT); float* cumL = (float*)(lds + SL_CUM); float* dtL = (float*)(lds + SL_DT); float* CHD = (float*)(a.ws + WS_CHD);
#pragma unroll
    for (int dir = 0; dir < 2; ++dir) {
        const float ah = -expf(a.in[20][(size_t)(layer * 2 + dir) * 32 + h]);
        const float d0 = DT[(size_t)(c * 128 + 2 * lane) * 64 + dir * 32 + h], d1 = DT[(size_t)(c * 128 + 2 * lane + 1) * 64 + dir * 32 + h];
        const float l0 = d0 * ah, l1 = d1 * ah, s = l0 + l1; float incl = s;
#pragma unroll
        for (int o = 1; o < 64; o <<= 1) { const float t = __shfl_up(incl, o); if (lane >= o) incl += t; }
        const float excl = incl - s, tot = __shfl(incl, 63);
        float c0, c1;
        if (dir == 0) { c0 = excl + l0; c1 = incl; } else { c0 = tot - excl; c1 = tot - (excl + l0); }
        float* cu = cumL + (dir * 8 + w) * 128 + 2 * lane; cu[0] = c0; cu[1] = c1;
        float* dd = dtL + (dir * 8 + w) * 128 + 2 * lane;
        if (AUX == 0) { dd[0] = d0; dd[1] = d1; } else { dd[0] = d0 * __expf(tot - c0); dd[1] = d1 * __expf(tot - c1); if (lane == 0) CHD[(size_t)(dir * NCH + c) * 32 + h] = tot; }
    }
}
__device__ __forceinline__ void stage_T(const bf16_t* XBC, const float* cw, const float* cb, int rowbase, int ch, int r0, bool lo_ok, bool hi_ok, bf16_t* dstT) {
    float w[3][8], b[8];
#pragma unroll
    for (int k = 0; k < 3; ++k) { const f32x4 a0 = *(const f32x4*)(cw + (size_t)k * 3072 + ch), a1 = *(const f32x4*)(cw + (size_t)k * 3072 + ch + 4);
        w[k][0] = a0[0]; w[k][1] = a0[1]; w[k][2] = a0[2]; w[k][3] = a0[3]; w[k][4] = a1[0]; w[k][5] = a1[1]; w[k][6] = a1[2]; w[k][7] = a1[3]; }
    { const f32x4 a0 = *(const f32x4*)(cb + ch), a1 = *(const f32x4*)(cb + ch + 4); b[0] = a0[0]; b[1] = a0[1]; b[2] = a0[2]; b[3] = a0[3]; b[4] = a1[0]; b[5] = a1[1]; b[6] = a1[2]; b[7] = a1[3]; }
    u32x4 raw[10];
    const bf16_t* base = XBC + (size_t)(rowbase + r0) * 3072 + ch;
    const bool ok0 = r0 > 0 || lo_ok, ok9 = r0 < 120 || hi_ok;
#pragma unroll
    for (int i = 1; i < 9; ++i) raw[i] = *(const u32x4*)(base + (i - 1) * 3072);
    raw[0] = *(const u32x4*)(base + (ok0 ? -3072 : 0)); raw[9] = *(const u32x4*)(base + (ok9 ? 8 * 3072 : 7 * 3072));
    __builtin_amdgcn_sched_barrier(0);
    if (!ok0) raw[0] = (u32x4){0u, 0u, 0u, 0u};
    if (!ok9) raw[9] = (u32x4){0u, 0u, 0u, 0u};
    float sp[8]; unsigned o[8][4];
#pragma unroll
    for (int r = 0; r < 8; ++r) { float sv[8];
#pragma unroll
        for (int k = 0; k < 8; ++k) { float acc = b[k];
#pragma unroll
            for (int d = 0; d < 3; ++d) { const unsigned wd = k < 2 ? raw[r + d].x : (k < 4 ? raw[r + d].y : (k < 6 ? raw[r + d].z : raw[r + d].w)); acc += w[d][k] * ((k & 1) ? bfhi(wd) : bflo(wd)); }
            sv[k] = silu_(acc); }
        if (r & 1) {
#pragma unroll
            for (int k = 0; k < 8; ++k) o[k][r >> 1] = cvt_pk_bf16(sp[k], sv[k]); }
        else {
#pragma unroll
            for (int k = 0; k < 8; ++k) sp[k] = sv[k]; } }
#pragma unroll
    for (int k = 0; k < 8; ++k) { u32x4 v; v.x = o[k][0]; v.y = o[k][1]; v.z = o[k][2]; v.w = o[k][3]; *(u32x4*)(dstT + k * 136 + r0) = v; }
}
__device__ __forceinline__ void ssd_a_phase(const Args& a, int layer, unsigned char* lds, int tid) {
    const bf16_t* XBC = (const bf16_t*)(a.ws + WS_BIG + B_XBC); bf16_t* SST = (bf16_t*)(a.ws + WS_SST);
    const float* cw = a.in[17] + (size_t)layer * 3 * 3072; const float* cb = a.in[18] + (size_t)layer * 3072;
    bf16_t* BT = (bf16_t*)(lds + SL_CS); bf16_t* xT = (bf16_t*)(lds + SL_XT); const float* wL = (const float*)(lds + SL_DT);
    for (int unit = (blockIdx.x + (gridDim.x >> 1)) % gridDim.x; unit < NCH * 4; unit += gridDim.x) {
        int tl = tid; asm volatile("" : "+v"(tl));
        const int lane = tl & 63, w = __builtin_amdgcn_readfirstlane(tl >> 6), fr = lane & 15, fq = lane >> 4, og = lane & 7, rr = lane >> 3;
        const int c = unit >> 2, g = unit & 3, rowbase = c * 128; const bool lo_ok = !(c == 0 || c == 128), hi_ok = !(c == 127 || c == 129);
        __syncthreads();
        if (w < 4) { const int oct = (w & 1) * 8 + og; stage_T(XBC, cw, cb, rowbase, 2048 + g * 128 + oct * 8, ((w >> 1) * 8 + rr) * 8, lo_ok, hi_ok, BT + (oct * 8) * 136); }
        ssd_cum<1>(a, layer, c, g * 8 + w, w, lane, lds);
#pragma unroll 1
        for (int pass = 0; pass < 2; ++pass) {
            if (pass) __syncthreads();
            { const int hs = w & 3; stage_T(XBC, cw, cb, rowbase, (g * 8 + pass * 4 + hs) * 64 + og * 8, ((w >> 2) * 8 + rr) * 8, lo_ok, hi_ok, xT + ((hs * 64 + og * 8) * 136)); }
            __syncthreads();
            const int hl = w >> 1, dir = w & 1, hh = pass * 4 + hl, h = g * 8 + hh;
            bf16_t* sb = SST + (((size_t)(dir * NCH + c) * 32 + h) * 64) * 128;
#pragma unroll 1
            for (int nh = 0; nh < 2; ++nh) {
                f32x4 acc[4][4];
#pragma unroll
                for (int pt = 0; pt < 4; ++pt)
#pragma unroll
                    for (int nt = 0; nt < 4; ++nt) acc[pt][nt] = (f32x4){0.f, 0.f, 0.f, 0.f};
#pragma unroll
                for (int ks = 0; ks < 4; ++ks) {
                    const float* wp = wL + (dir * 8 + hh) * 128 + ks * 32 + fq * 8; const f32x4 wl0 = *(const f32x4*)wp, wl1 = *(const f32x4*)(wp + 4);
                    bf16x8 yf[4];
#pragma unroll
                    for (int pt = 0; pt < 4; ++pt) { const u32x4 xr = *(const u32x4*)(xT + ((hl * 64 + pt * 16 + fr) * 136 + ks * 32 + fq * 8));
                        yf[pt] = mkfrag(cvt_pk_bf16(bflo(xr.x) * wl0[0], bfhi(xr.x) * wl0[1]), cvt_pk_bf16(bflo(xr.y) * wl0[2], bfhi(xr.y) * wl0[3]), cvt_pk_bf16(bflo(xr.z) * wl1[0], bfhi(xr.z) * wl1[1]), cvt_pk_bf16(bflo(xr.w) * wl1[2], bfhi(xr.w) * wl1[3])); }
#pragma unroll
                    for (int nt = 0; nt < 4; ++nt) { const bf16x8 xf = *(const bf16x8*)(BT + ((nh * 4 + nt) * 16 + fr) * 136 + ks * 32 + fq * 8);
#pragma unroll
                        for (int pt = 0; pt < 4; ++pt) acc[pt][nt] = __builtin_amdgcn_mfma_f32_16x16x32_bf16(xf, yf[pt], acc[pt][nt], 0, 0, 0); }
                }
#pragma unroll
                for (int pt = 0; pt < 4; ++pt) mfma_settle(acc[pt][3]);
#pragma unroll
                for (int pt = 0; pt < 4; ++pt)
#pragma unroll
                    for (int nt = 0; nt < 4; ++nt) { u32x2 o; o.x = cvt_pk_native(acc[pt][nt][0], acc[pt][nt][1]); o.y = cvt_pk_native(acc[pt][nt][2], acc[pt][nt][3]);
                        *(u32x2*)(sb + (size_t)(pt * 16 + fr) * 128 + (nh * 4 + nt) * 16 + fq * 4) = o; }
            }
        }
    }
    __syncthreads();
}
__device__ __forceinline__ void ssd_b_phase(const Args& a, int tid) {
    bf16_t* SST = (bf16_t*)(a.ws + WS_SST); const float* CHD = (const float*)(a.ws + WS_CHD);
    for (int idx = blockIdx.x * 512 + tid; idx < 64 * 2048; idx += gridDim.x * 512) {
        const int e4 = idx & 2047, hd = idx >> 11, dir = hd >> 5, h = hd & 31; float s0 = 0.f, s1 = 0.f, s2 = 0.f, s3 = 0.f;
#pragma unroll 1
        for (int b = 0; b < 13; ++b) { u32x2 loc[10]; float dc[10];
#pragma unroll
            for (int i = 0; i < 10; ++i) { const int cq = ssd_chunk_at(dir, b * 10 + i); loc[i] = *(const u32x2*)(SST + ((size_t)(dir * NCH + cq) * 32 + h) * 8192 + e4 * 4); dc[i] = CHD[(size_t)(dir * NCH + cq) * 32 + h]; }
#pragma unroll
            for (int i = 0; i < 10; ++i) { const int cq = ssd_chunk_at(dir, b * 10 + i); u32x2 o; o.x = cvt_pk_bf16(s0, s1); o.y = cvt_pk_bf16(s2, s3);
                *(u32x2*)(SST + ((size_t)(dir * NCH + cq) * 32 + h) * 8192 + e4 * 4) = o; const float e = __expf(dc[i]);
                s0 = e * s0 + bflo(loc[i].x); s1 = e * s1 + bfhi(loc[i].x); s2 = e * s2 + bflo(loc[i].y); s3 = e * s3 + bfhi(loc[i].y); }
        }
    }
}
__device__ __forceinline__ void ssd_c_phase(const Args& a, int layer, unsigned char* lds, int tid, int nchunks) {
    const bf16_t* XBC = (const bf16_t*)(a.ws + WS_BIG + B_XBC); const bf16_t* SST = (const bf16_t*)(a.ws + WS_SST); const bf16_t* Z = (const bf16_t*)(a.ws + WS_BIG + B_Z); bf16_t* YD = (bf16_t*)(a.ws + WS_BIG + B_YD);
    const float* cw = a.in[17] + (size_t)layer * 3 * 3072; const float* cb = a.in[18] + (size_t)layer * 3072; const float* normw = a.in[22] + (size_t)layer * 2048;
    bf16_t* Cs = (bf16_t*)(lds + SL_CS); bf16_t* Bs = (bf16_t*)(lds + SL_BS); bf16_t* CBs = (bf16_t*)(lds + SL_CB); bf16_t* xT = (bf16_t*)(lds + SL_XT);
    const float* cumL = (const float*)(lds + SL_CUM); const float* dtL = (const float*)(lds + SL_DT); float* part = (float*)(lds + SL_PART);
    for (int unit = (blockIdx.x + (gridDim.x >> 1)) % gridDim.x; unit < nchunks * 4; unit += gridDim.x) {
        int tl = tid; asm volatile("" : "+v"(tl));
        const int lane = tl & 63, w = __builtin_amdgcn_readfirstlane(tl >> 6), fr = lane & 15, fq = lane >> 4, og = lane & 7, rr = lane >> 3;
        const int hl = w & 3, lh = w >> 2;
        const int c = unit >> 2, g = unit & 3, rowbase = c * 128; const bool lo_ok = !(c == 0 || c == 128), hi_ok = !(c == 127 || c == 129);
        __syncthreads();
        stage_conv_tile(XBC, cw, cb, rowbase, 2560 + g * 128, lo_ok, hi_ok, Cs, tl);
        stage_conv_tile(XBC, cw, cb, rowbase, 2048 + g * 128, lo_ok, hi_ok, Bs, tl);
        ssd_cum<0>(a, layer, c, g * 8 + w, w, lane, lds);
        __syncthreads();
#pragma unroll 1
        for (int st = 0; st < 8; ++st) { f32x4 acc = {0.f, 0.f, 0.f, 0.f};
#pragma unroll
            for (int ks = 0; ks < 4; ++ks) { const bf16x8 xf = *(const bf16x8*)(Bs + (st * 16 + fr) * 136 + ks * 32 + fq * 8), yf = *(const bf16x8*)(Cs + (w * 16 + fr) * 136 + ks * 32 + fq * 8);
                acc = __builtin_amdgcn_mfma_f32_16x16x32_bf16(xf, yf, acc, 0, 0, 0); }
            mfma_settle(acc);
            u32x2 o; o.x = cvt_pk_native(acc[0], acc[1]); o.y = cvt_pk_native(acc[2], acc[3]); *(u32x2*)(CBs + (w * 16 + fr) * 136 + st * 16 + fq * 4) = o; }
#pragma unroll 1
        for (int pass = 0; pass < 2; ++pass) {
            __syncthreads();
            stage_T(XBC, cw, cb, rowbase, (g * 8 + pass * 4 + hl) * 64 + og * 8, (lh * 8 + rr) * 8, lo_ok, hi_ok, xT + ((hl * 64 + og * 8) * 136));
            __syncthreads();
            const int hh = pass * 4 + hl, h = g * 8 + hh; const float Dh = a.in[21][(size_t)layer * 32 + h];
#pragma unroll 1
            for (int ih = 0; ih < 2; ++ih) {
            f32x4 acc[2][4]; u32x2 zq[2][4];
#pragma unroll
            for (int i = 0; i < 2; ++i)
#pragma unroll
                for (int pt = 0; pt < 4; ++pt) { acc[i][pt] = (f32x4){0.f, 0.f, 0.f, 0.f};
                    zq[i][pt] = *(const u32x2*)(Z + (size_t)(rowbase + (lh * 4 + ih * 2 + i) * 16 + fr) * 2048 + h * 64 + pt * 16 + fq * 4); }
#pragma unroll
            for (int dir = 0; dir < 2; ++dir) {
                const bf16_t* sb = SST + (((size_t)(dir * NCH + c) * 32 + h) * 64) * 128;
                f32x4 tmp[2][4];
#pragma unroll
                for (int i = 0; i < 2; ++i)
#pragma unroll
                    for (int pt = 0; pt < 4; ++pt) tmp[i][pt] = (f32x4){0.f, 0.f, 0.f, 0.f};
#pragma unroll
                for (int ks = 0; ks < 4; ++ks) { const int lb = (lh * 4 + ih * 2) * 16 + fr; bf16x8 sfr[4];
#pragma unroll
                    for (int pt = 0; pt < 4; ++pt) sfr[pt] = *(const bf16x8*)(sb + (size_t)(pt * 16 + fr) * 128 + ks * 32 + fq * 8);
                    const bf16x8 yf0 = *(const bf16x8*)(Cs + lb * 136 + ks * 32 + fq * 8), yf1 = *(const bf16x8*)(Cs + (lb + 16) * 136 + ks * 32 + fq * 8);
                    __builtin_amdgcn_sched_barrier(0);
#pragma unroll
                    for (int pt = 0; pt < 4; ++pt) {
                        tmp[0][pt] = __builtin_amdgcn_mfma_f32_16x16x32_bf16(sfr[pt], yf0, tmp[0][pt], 0, 0, 0); tmp[1][pt] = __builtin_amdgcn_mfma_f32_16x16x32_bf16(sfr[pt], yf1, tmp[1][pt], 0, 0, 0); } }
#pragma unroll
                for (int i = 0; i < 2; ++i) { int frv = fr; asm volatile("" : "+v"(frv));
                    const int lt = lh * 4 + ih * 2 + i, l = lt * 16 + frv;
                    const float cl = cumL[(dir * 8 + hh) * 128 + l], el = __expf(cl);
#pragma unroll
                    for (int pt = 0; pt < 4; ++pt) acc[i][pt] += tmp[i][pt] * el;
#pragma unroll
                    for (int ks = 0; ks < 4; ++ks) { const int s0 = ks * 32;
                        const bool skip = dir == 0 ? (s0 > lt * 16 + 15) : (s0 + 31 < lt * 16);
                        if (!skip) { const u32x4 cbv = *(const u32x4*)(CBs + l * 136 + s0 + fq * 8);
                            const float* cp = cumL + (dir * 8 + hh) * 128 + s0 + fq * 8; const float* dp = dtL + (dir * 8 + hh) * 128 + s0 + fq * 8;
                            const f32x4 c0 = *(const f32x4*)cp, c1 = *(const f32x4*)(cp + 4), d0 = *(const f32x4*)dp, d1 = *(const f32x4*)(dp + 4);
                            float cbf[8] = {bflo(cbv.x), bfhi(cbv.x), bflo(cbv.y), bfhi(cbv.y), bflo(cbv.z), bfhi(cbv.z), bflo(cbv.w), bfhi(cbv.w)}; float v[8];
#pragma unroll
                            for (int j = 0; j < 8; ++j) { const int sx = s0 + fq * 8 + j; const float cs = j < 4 ? c0[j & 3] : c1[j & 3], ds = j < 4 ? d0[j & 3] : d1[j & 3];
                                const bool valid = dir == 0 ? (sx <= l) : (sx >= l); float t = valid ? cbf[j] * __expf(fminf(cl - cs, 0.f)) * ds : 0.f; if (dir == 0 && sx == l) t += Dh; v[j] = t; }
                            const bf16x8 yf = mkfrag(cvt_pk_bf16(v[0], v[1]), cvt_pk_bf16(v[2], v[3]), cvt_pk_bf16(v[4], v[5]), cvt_pk_bf16(v[6], v[7]));
#pragma unroll
                            for (int pt = 0; pt < 4; ++pt) acc[i][pt] = __builtin_amdgcn_mfma_f32_16x16x32_bf16(*(const bf16x8*)(xT + ((hl * 64 + pt * 16 + fr) * 136 + s0 + fq * 8)), yf, acc[i][pt], 0, 0, 0); } }
                }
            }
#pragma unroll
            for (int i = 0; i < 2; ++i) { const int l = (lh * 4 + ih * 2 + i) * 16 + fr; const size_t row = (size_t)(rowbase + l); float ss = 0.f;
#pragma unroll
                for (int pt = 0; pt < 4; ++pt) { const int ch = h * 64 + pt * 16 + fq * 4; const u32x2 zz = zq[i][pt];
                    const float h0 = acc[i][pt][0] * silu_(bflo(zz.x)), h1 = acc[i][pt][1] * silu_(bfhi(zz.x)), h2 = acc[i][pt][2] * silu_(bflo(zz.y)), h3 = acc[i][pt][3] * silu_(bfhi(zz.y));
                    ss += (h0 * h0 + h1 * h1) + (h2 * h2 + h3 * h3); u32x2 o; o.x = cvt_pk_bf16(h0, h1); o.y = cvt_pk_bf16(h2, h3); *(u32x2*)(YD + row * 2048 + ch) = o; }
                ss += __shfl_xor(ss, 16); ss += __shfl_xor(ss, 32);
                if (fq == 0) part[hh * 128 + l] = ss; }
            }
        }
        __syncthreads();
#pragma unroll 1
        for (int it = 0; it < 8; ++it) { const int pass = it >> 2, i = it & 3, l = (lh * 4 + i) * 16 + fr, h = g * 8 + pass * 4 + hl; float tot = 0.f;
#pragma unroll
            for (int hd = 0; hd < 8; ++hd) tot += part[hd * 128 + l];
            const float r = __builtin_amdgcn_rsqf(tot * (1.f / 512.f) + RMS_EPS); const size_t row = (size_t)(rowbase + l);
            u32x2 hq[4]; f32x4 nq[4];
#pragma unroll
            for (int pt = 0; pt < 4; ++pt) { const int ch = h * 64 + pt * 16 + fq * 4; hq[pt] = *(const u32x2*)(YD + row * 2048 + ch); nq[pt] = *(const f32x4*)(normw + ch); }
            __builtin_amdgcn_sched_barrier(0);
#pragma unroll
            for (int pt = 0; pt < 4; ++pt) { const int ch = h * 64 + pt * 16 + fq * 4; bf16_t* yp = YD + row * 2048 + ch; const u32x2 hv = hq[pt]; const f32x4 nw = nq[pt];
                u32x2 o; o.x = cvt_pk_bf16(bflo(hv.x) * r * nw[0], bfhi(hv.x) * r * nw[1]); o.y = cvt_pk_bf16(bflo(hv.y) * r * nw[2], bfhi(hv.y) * r * nw[3]); *(u32x2*)yp = o; }
            __builtin_amdgcn_sched_barrier(0); }
    }
    __syncthreads();
}

#define LAS __attribute__((address_space(3)))
#define XB_TMO      128
#define XB_XCNT(j)  (256  + 64 * (j))
#define XB_XSUB(j)  (1280 + 64 * (j))
#define XB_XGEN(j)  (2304 + 64 * (j))
#define XB_TOP      3328
#define XB_TOPGEN   3392
#define XCD_BAR_WORDS 3456
#define XB_SPIN_CAP (1u << 18)

__device__ __forceinline__ unsigned xb_ld(unsigned* p)              { return __hip_atomic_load(p, __ATOMIC_RELAXED, __HIP_MEMORY_SCOPE_AGENT); }
__device__ __forceinline__ unsigned xb_add(unsigned* p, unsigned v) { return __hip_atomic_fetch_add(p, v, __ATOMIC_RELAXED, __HIP_MEMORY_SCOPE_AGENT); }
__device__ __forceinline__ unsigned xb_xcc_id() { return (unsigned)__builtin_amdgcn_s_getreg((3 << 11) | 20) & 0xFu; }
#define XB_SPIN(cond, bar) do { unsigned _sp = 0; while (cond) { __builtin_amdgcn_s_sleep(1); \
    if ((++_sp & 255u) == 0u) { if (xb_ld(&(bar)[XB_TMO])) break; if (_sp > XB_SPIN_CAP) { atomicAdd(&(bar)[XB_TMO], 1u); break; } } } } while (0)

struct XcdBarrier {
    unsigned* bar; unsigned x;
    volatile LAS unsigned* st;
};

__device__ __forceinline__ XcdBarrier xcd_barrier_post(unsigned* bar, volatile LAS unsigned* st) {
    XcdBarrier b; b.bar = bar; b.x = xb_xcc_id(); b.st = st;
    if (threadIdx.x == 0) (void)xb_add(&bar[XB_XCNT(b.x)], 1u);
    return b;
}
__device__ __forceinline__ void xcd_barrier_complete(unsigned* bar, unsigned x, unsigned& nloc, unsigned& nx) {
    const unsigned G = gridDim.x * gridDim.y * gridDim.z;
    unsigned sum, cnt, mine, sp = 0u;
    for (;;) {
        sum = 0u; cnt = 0u; mine = 0u;
#pragma unroll
        for (unsigned j = 0; j < 16; ++j) { const unsigned c = xb_ld(&bar[XB_XCNT(j)]); sum += c; cnt += (c > 0u) ? 1u : 0u; mine = (j == x) ? c : mine; }
        if (sum == G) break;
        __builtin_amdgcn_s_sleep(1);
        if ((++sp & 255u) == 0u) { if (xb_ld(&bar[XB_TMO])) break; if (sp > XB_SPIN_CAP) { atomicAdd(&bar[XB_TMO], 1u); break; } }
    }
    nloc = mine > 0u ? mine : 1u; nx = cnt > 0u ? cnt : 1u;
}

__device__ __forceinline__ void xcd_barrier(const XcdBarrier& b) {
    asm volatile("s_waitcnt vmcnt(0)" ::: "memory");
    __syncthreads();
    if (threadIdx.x == 0) {
        unsigned* bar = b.bar;
        __builtin_amdgcn_s_waitcnt(0);
        unsigned nloc = b.st[0], nx = b.st[1];
        if (nloc == 0u) { xcd_barrier_complete(bar, b.x, nloc, nx); b.st[0] = nloc; b.st[1] = nx; }
        const unsigned old = xb_add(&bar[XB_XSUB(b.x)], 1u);
        const unsigned gen = old / nloc;
        if (old + 1u == (gen + 1u) * nloc) {
            __builtin_amdgcn_fence(__ATOMIC_RELEASE, "agent");
            asm volatile("s_waitcnt vmcnt(0)" ::: "memory");
            const unsigned og = xb_add(&bar[XB_TOP], 1u);
            const unsigned tg = og / nx;
            if (og + 1u == (tg + 1u) * nx) xb_add(&bar[XB_TOPGEN], 1u);
            else XB_SPIN(xb_ld(&bar[XB_TOPGEN]) == tg, bar);
            __builtin_amdgcn_fence(__ATOMIC_ACQUIRE, "agent");
            xb_add(&bar[XB_XGEN(b.x)], 1u);
            asm volatile("s_waitcnt vmcnt(0)" ::: "memory");
        } else {
            XB_SPIN(xb_ld(&bar[XB_XGEN(b.x)]) == gen, bar);
            __builtin_amdgcn_fence(__ATOMIC_ACQUIRE, "agent");
            asm volatile("s_waitcnt vmcnt(0)" ::: "memory");
        }
    }
    __syncthreads();
}

#ifndef MK_REP_S5
#define MK_REP_S5 1
#endif
#ifndef MK_REP_SSD
#define MK_REP_SSD 1
#endif
#ifndef MK_REP_SYNC
#define MK_REP_SYNC 1
#endif
#ifndef MK_CG_SYNC_ALL
#define MK_CG_SYNC_ALL 0
#endif
#ifndef MK_REP_PRO
#define MK_REP_PRO 1
#endif
#ifndef MK_REP_GEMM
#define MK_REP_GEMM 1
#endif
constexpr int NPHASE = 2 + 11 * 2;
__global__ void __launch_bounds__(512, 2) fwd_megakernel(Args a) {
    extern __shared__ __attribute__((aligned(16))) unsigned char lds[];
    PG8_LAS unsigned char* lds3 = (PG8_LAS unsigned char*)lds;
    unsigned char* big = a.ws + WS_BIG;
    volatile LAS unsigned* bst = (volatile LAS unsigned*)(lds3 + (LDS_BYTES - 16));
    if (threadIdx.x < 4) bst[threadIdx.x] = 0u;
    __syncthreads();
    XcdBarrier xbar; xbar.bar = (unsigned*)(a.ws + WS_BAR); xbar.x = 0; xbar.st = bst;
    if (a.ph_hi - a.ph_lo > 1) xbar = xcd_barrier_post((unsigned*)(a.ws + WS_BAR), bst);
    for (int ph = a.ph_lo; ph < a.ph_hi; ++ph) {
        const int tid = pg8::pg8_tid(), lane = tid & 63, wave = tid >> 6, gw = blockIdx.x * 8 + wave, NGW = gridDim.x * 8;
        if (ph == 0) {
            for (int rep = 0; rep < MK_REP_PRO; ++rep) {
            adaln_phase(a, (float*)lds, tid);
            float* scr = (float*)lds + wave * (64 * 33);
            xpose_region(a, 0, 0, scr, gw, NGW, lane); xpose_region(a, 0, 1, scr, gw, NGW, lane); __syncthreads(); }
        } else if (ph == 1) {
            row_phase<0>(a, MT, nullptr, nullptr, 0, 0, gw, NGW, lane);
        } else {
            const int layer = (ph - 2) / 11, k = (ph - 2) % 11; const bool last = layer == 1; const int Mrows = last ? TL : MT;
            const bf16_t* WA = (const bf16_t*)(a.ws + WS_WA); const bf16_t* WB = (const bf16_t*)(a.ws + WS_WB);
#ifdef MK_SKIP_MASK
            if ((MK_SKIP_MASK >> k) & 1) { if (ph + 1 < a.ph_hi) xcd_barrier(xbar); continue; }
#endif
            if (k == 0) {
                pg8::Gemm g{(const bf16_t*)(a.ws + WS_XM), WA + WA_IN / 2, MT, NPROJ, D}; pg8::StaticOrder S; S.init(MT, NPROJ, gridDim.x, blockIdx.x);
                EpiInProj E{big, a.in[19] + (size_t)layer * 64}; for (int rep = 0; rep < MK_REP_GEMM; ++rep) { pg8::gemm_phase<EpiInProj, pg8::StaticOrder>(lds3, g, S, E, nullptr); __syncthreads(); }
            } else if (k == 1) {
                for (int rep = 0; rep < MK_REP_SSD; ++rep) ssd_a_phase(a, layer, lds, tid);
                for (int rep = 0; rep < MK_REP_S5; ++rep) s5_phase<0>(a, layer, lds, tid, NCH);
            } else if (k == 2) {
#if !defined(MK_NO_SSD) && !defined(MK_NO_SSDB)
                ssd_b_phase(a, tid);
#endif
                for (int rep = 0; rep < MK_REP_S5; ++rep) s5_phase<1>(a, layer, lds, tid, last ? 128 : NCH);
            } else if (k == 3) {
                for (int rep = 0; rep < MK_REP_SSD; ++rep) ssd_c_phase(a, layer, lds, tid, last ? 128 : NCH);
#ifndef MK_NO_S5
                pg8::Gemm g{(const bf16_t*)(big + B_Y5), WA + WA_GLU / 2, Mrows, 2048, 1024}; pg8::StaticOrder S; S.init(Mrows, 2048, gridDim.x, blockIdx.x);
                EpiGlu E{(bf16_t*)(big + B_U5)}; pg8::gemm_phase<EpiGlu, pg8::StaticOrder>(lds3, g, S, E, nullptr);
#endif
            } else if (k == 4) {
#ifndef MK_NO_S5
                { pg8::Gemm g{(const bf16_t*)(big + B_U5), WA + WA_S5P / 2, Mrows, 2048, 1024}; pg8::StaticOrder S; S.init(Mrows, 2048, gridDim.x, blockIdx.x);
                  EpiMerge<0> E{(bf16_t*)(big + B_XBC), (const bf16_t*)(big + B_GATE)}; pg8::gemm_phase<EpiMerge<0>, pg8::StaticOrder>(lds3, g, S, E, nullptr); }
                __syncthreads();
#endif
#ifndef MK_NO_SSD
#ifdef MK_NO_S5
                { pg8::Gemm g{(const bf16_t*)(big + B_YD), WA + WA_SSDP / 2, Mrows, 2048, 2048}; pg8::StaticOrder S; S.init(Mrows, 2048, gridDim.x, blockIdx.x);
                  EpiMerge<0, 1> E{(bf16_t*)(big + B_XBC), (const bf16_t*)(big + B_GATE)}; pg8::gemm_phase<EpiMerge<0, 1>, pg8::StaticOrder>(lds3, g, S, E, nullptr); }
#else
                { pg8::Gemm g{(const bf16_t*)(big + B_YD), WA + WA_SSDP / 2, Mrows, 2048, 2048}; pg8::StaticOrder S; S.init(Mrows, 2048, gridDim.x, blockIdx.x);
                  EpiMerge<1> E{(bf16_t*)(big + B_XBC), (const bf16_t*)(big + B_GATE)}; pg8::gemm_phase<EpiMerge<1>, pg8::StaticOrder>(lds3, g, S, E, nullptr); }
#endif
#endif
            } else if (k == 5) {
                pg8::Gemm g{(const bf16_t*)(big + B_XBC), WA + WA_WOUT / 2, Mrows, 2048, 2048}; pg8::StaticOrder S; S.init(Mrows, 2048, gridDim.x, blockIdx.x);
                EpiResid E{a.out, (float*)(a.ws + WS_HCTX), mvec(a, layer, 0) + 2 * D, mvec(a, layer, 1) + 2 * D}; pg8::gemm_phase<EpiResid, pg8::StaticOrder>(lds3, g, S, E, nullptr);
            } else if (k == 6) {
                row_phase<1>(a, Mrows, a.in[25] + (size_t)layer * D, a.in[26] + (size_t)layer * D, layer, 3 * D, gw, NGW, lane);
                if (!last) for (int rep = 0; rep < MK_REP_PRO; ++rep) { __syncthreads(); xpose_region(a, layer + 1, 0, (float*)lds + wave * (64 * 33), gw, NGW, lane); }
            } else if (k == 7) {
                pg8::Gemm g{(const bf16_t*)(a.ws + WS_XM), WB + WB_UP / 2, Mrows, 2 * DFF, D}; pg8::StaticOrder S; S.init(Mrows, 2 * DFF, gridDim.x, blockIdx.x);
                EpiUp E{(bf16_t*)(big + B_G), (bf16_t*)(big + B_V)}; for (int rep = 0; rep < MK_REP_GEMM; ++rep) { pg8::gemm_phase<EpiUp, pg8::StaticOrder>(lds3, g, S, E, nullptr); __syncthreads(); }
            } else if (k == 8) {
                ffnconv_phase(a, layer, !last, lds, tid);
            } else if (k == 9) {
                pg8::Gemm g{(const bf16_t*)(big + B_V), WB + WB_DOWN / 2, Mrows, D, DFF}; pg8::StaticOrder S; S.init(Mrows, D, gridDim.x, blockIdx.x);
                EpiResid E{a.out, (float*)(a.ws + WS_HCTX), mvec(a, layer, 0) + 5 * D, mvec(a, layer, 1) + 5 * D}; pg8::gemm_phase<EpiResid, pg8::StaticOrder>(lds3, g, S, E, nullptr);
            } else {
                row_phase<1>(a, Mrows, a.in[31] + (size_t)layer * D, a.in[32] + (size_t)layer * D, last ? -1 : layer + 1, 0, gw, NGW, lane);
                if (!last) for (int rep = 0; rep < MK_REP_PRO; ++rep) { __syncthreads(); xpose_region(a, layer + 1, 1, (float*)lds + wave * (64 * 33), gw, NGW, lane); }
            }
        }
        if (ph + 1 < a.ph_hi) { for (int rep = 0; rep < MK_REP_SYNC; ++rep) { if (MK_CG_SYNC_ALL || a.ph_hi > 1000) cg::this_grid().sync(); else xcd_barrier(xbar);     } }
#ifdef MK_TS_MASK
        if (blockIdx.x == 0 && threadIdx.x == 0) ((unsigned long long*)(a.ws + WS_BAR + 65536))[ph + 1] = __builtin_amdgcn_s_memrealtime();
#endif
    }
#ifdef MK_TS_MASK
    if (blockIdx.x == 0 && threadIdx.x == 0) {
        const unsigned long long* ts = (const unsigned long long*)(a.ws + WS_BAR + 65536); unsigned long long sum = 0;
        for (int ph = 1; ph < a.ph_hi - 1; ++ph) if ((MK_TS_MASK >> ph) & 1ull) sum += ts[ph + 1] - ts[ph];
        const unsigned long long t0 = __builtin_amdgcn_s_memrealtime();
        while (__builtin_amdgcn_s_memrealtime() - t0 < sum * MK_TS_AMP) __builtin_amdgcn_s_sleep(8);
    }
#endif
}
}

#ifndef MK_N_LAUNCH_MODE
#define MK_N_LAUNCH_MODE 0
#endif
extern "C" void kernel_launch(void* const* d_in, const int* in_sizes, int n_in, void* d_out, int out_size, void* d_ws, size_t ws_size, hipStream_t stream) {
    static int grid = 0;
    if (grid == 0) {
        if (n_in != 33 || ws_size < mk::WS_END) { fprintf(stderr, "kernel_launch: need 33 inputs and %zu bytes of workspace (got %d, %zu)\n", (size_t)mk::WS_END, n_in, ws_size); grid = -1; return; }
        int dev = 0, cus = 0, per_cu = 0;
        (void)hipGetDevice(&dev); (void)hipDeviceGetAttribute(&cus, hipDeviceAttributeMultiprocessorCount, dev);
        if (hipFuncSetAttribute((const void*)mk::fwd_megakernel, hipFuncAttributeMaxDynamicSharedMemorySize, mk::LDS_BYTES) != hipSuccess) { fprintf(stderr, "kernel_launch: hipFuncSetAttribute failed\n"); grid = -1; return; }
        if (hipOccupancyMaxActiveBlocksPerMultiprocessor(&per_cu, (const void*)mk::fwd_megakernel, 512, mk::LDS_BYTES) != hipSuccess || per_cu < 1) { fprintf(stderr, "kernel_launch: occupancy query says %d\n", per_cu); per_cu = 1; }
        (void)hipGetLastError();
        grid = cus * per_cu; if (grid > 256) grid = 256;
    }
    if (grid < 0) return;
    mk::Args a{};
    for (int i = 0; i < 33; ++i) a.in[i] = (const float*)d_in[i];
    a.out = (float*)d_out; a.ws = (unsigned char*)d_ws;
#if MK_N_LAUNCH_MODE == 1
    for (int ph = 0; ph < mk::NPHASE; ++ph) { a.ph_lo = ph; a.ph_hi = ph + 1; hipLaunchKernelGGL(mk::fwd_megakernel, dim3(grid), dim3(512), mk::LDS_BYTES, stream, a); }
#else
    a.ph_lo = 0; a.ph_hi = mk::NPHASE;
    (void)hipMemsetAsync((unsigned char*)d_ws + mk::WS_BAR, 0, XCD_BAR_WORDS * sizeof(unsigned), stream);
    void* args[] = {&a};
    hipError_t e = hipLaunchCooperativeKernel((const void*)mk::fwd_megakernel, dim3(grid), dim3(512), args, mk::LDS_BYTES, stream);
    if (e != hipSuccess) fprintf(stderr, "cooperative launch failed: %s (grid %d)\n", hipGetErrorString(e), grid);
#endif
}
```

```cpp
#include <hip/hip_runtime.h>
#include <hip/hip_cooperative_groups.h>
#include <cstdio>
namespace cg = cooperative_groups;
#define MK_N_LAUNCH_MODE 0
namespace pg8 {
#define PG8_LAS __attribute__((address_space(3)))
typedef unsigned short bf16_t;
typedef short bf16x8 __attribute__((ext_vector_type(8)));
typedef float f32x4 __attribute__((ext_vector_type(4)));
typedef unsigned u32x4 __attribute__((ext_vector_type(4)));
constexpr int BM = 256, BK = 64, HALF = 128, HTB = HALF * BK * 2  , STAGE_BYTES = 8 * HTB, NXCD = 8, WGM = 8;

__host__ __device__ __forceinline__ int lds_byte(int r, int c) { const int st = (r >> 4) * 2 + (c >> 5), rr = r & 15, cc = c & 31, ob = rr * 64 + cc * 2; return st * 1024 + (ob ^ (((ob >> 9) & 1) << 5)); }
__host__ __device__ __forceinline__ void stage_rc(int b, int& R, int& C) { const int st = b / 1024, sb = b % 1024, swz = sb ^ (((sb >> 9) & 1) << 5); R = (st >> 1) * 16 + swz / 64; C = (st & 1) * 32 + (swz % 64) / 2; }
__host__ __device__ __forceinline__ int perm32(int rho) { const int n = rho >> 4, i = rho & 15; return 8 * (i >> 2) + 4 * n + (i & 3); }

__device__ __forceinline__ int pg8_tid() { int t = threadIdx.x; asm volatile("" : "+v"(t)); return t; }
struct Unit { int pm, pn; };
struct Gemm { const bf16_t* A; const bf16_t* Bt; int M, N, K; };

struct StaticOrder {
    int nM, nN, nwg, G, c;
    __host__ __device__ void init(int M, int N, int G_, int c_) { nM = M / BM; nN = N / BM; nwg = nM * nN; G = G_; c = c_; }
    __host__ __device__ bool next(int i, Unit& u) const {
        const long L = (long)i * G + c; if (L >= nwg) return false;
        int wgid = (int)L; { const int q = nwg / NXCD, r = nwg % NXCD, xcd = wgid % NXCD, off = wgid / NXCD; wgid = (xcd < r ? xcd * (q + 1) : r * (q + 1) + (xcd - r) * q) + off; }
        const int nig = WGM * nN, gid = wgid / nig, fm = gid * WGM, gsz = (nM - fm) < WGM ? (nM - fm) : WGM;
        u.pm = fm + ((wgid % nig) % gsz); u.pn = (wgid % nig) / gsz; return true;
    }
    __device__ __forceinline__ void a_ready(const Unit&) const {}
    __device__ __forceinline__ void done(const Unit&) const {}
};
typedef float f32x2c __attribute__((ext_vector_type(2))); typedef __bf16 bf16x2c __attribute__((ext_vector_type(2)));
__device__ __forceinline__ unsigned cvt_pk_native(float lo, float hi) { const f32x2c v = {lo, hi}; const bf16x2c b = __builtin_convertvector(v, bf16x2c); return __builtin_bit_cast(unsigned, b); }
__device__ __forceinline__ unsigned cvt_pk_bf16(float lo, float hi) { return cvt_pk_native(lo, hi); }
__device__ __forceinline__ void mfma_settle(const float __attribute__((ext_vector_type(4)))& a) { asm volatile("s_nop 15\n\ts_nop 7" :: "v"(a)); }
typedef float f32x2 __attribute__((ext_vector_type(2)));
template <class Epi, class Sched, bool STAMP = false>
__device__ __forceinline__ void gemm_phase(PG8_LAS unsigned char* lds, const Gemm g, const Sched& S, const Epi& E, unsigned long long* stamps) {
    const int tid = pg8_tid(), wid = __builtin_amdgcn_readfirstlane(tid >> 6), lane = tid & 63, wr = wid >> 2, wc = wid & 3, fr = lane & 15, fq = lane >> 4;
    const int K = g.K, nt = K / BK;
    int ts_lo = 0, ts_hi = 0, nts = 0; const unsigned long long rt_entry = STAMP ? (unsigned long long)wall_clock64() : 0ull;
#define PG8_STAMP() do { if (STAMP && wid == 0 && nts < 64) { const unsigned long long _c = (unsigned long long)clock64(); \
        ts_lo = (lane == nts) ? (int)(unsigned)_c : ts_lo; ts_hi = (lane == nts) ? (int)(unsigned)(_c >> 32) : ts_hi; ++nts; } } while (0)
    PG8_STAMP();
    unsigned voffA[2], voffB[2];
#pragma unroll
    for (int i = 0; i < 2; ++i) { int R, C; stage_rc(tid * 16 + i * 8192, R, C); const int Rb = Epi::PERM ? ((R & ~31) + perm32(R & 31)) : R;
        voffA[i] = (unsigned)(R * K + C) * 2u; voffB[i] = (unsigned)(Rb * K + C) * 2u; }
    const size_t kstep = (size_t)(BK * 2);
    const size_t hstep = (size_t)HALF * K * 2;
    const size_t tstep = 2 * hstep;
    const unsigned ldsw = (unsigned)wid * 1024u;
    const int aoff = lds_byte(wr * 64 + fr, fq * 8), boff = lds_byte(wc * 32 + fr, fq * 8);
#define PG8_SA(b, h) (((b) * 2 + (h)) * HTB)
#define PG8_SB(b, h) ((4 + (b) * 2 + (h)) * HTB)
#define PG8_STAGE(bufoff, gbase, voff) do { _Pragma("unroll") for (int _i = 0; _i < 2; ++_i) \
        __builtin_amdgcn_global_load_lds((const unsigned*)((const char*)(gbase) + (voff)[_i]), (PG8_LAS unsigned*)(lds + (bufoff) + ldsw + _i * 8192), 16, 0, 0); } while (0)
#define PG8_LDA(dst, b, h) do { _Pragma("unroll") for (int m = 0; m < 4; ++m) _Pragma("unroll") for (int k = 0; k < 2; ++k) dst[m][k] = *(const PG8_LAS bf16x8*)(lds + PG8_SA(b, h) + aoff + m * 2048 + k * 1024); } while (0)
#define PG8_LDB(dst, b, h) do { _Pragma("unroll") for (int n = 0; n < 2; ++n) _Pragma("unroll") for (int k = 0; k < 2; ++k) dst[n][k] = *(const PG8_LAS bf16x8*)(lds + PG8_SB(b, h) + boff + n * 2048 + k * 1024); } while (0)
#define PG8_MMA(ai, bj, At, Bt) do { __builtin_amdgcn_s_setprio(1); _Pragma("unroll") for (int m = 0; m < 4; ++m) _Pragma("unroll") for (int n = 0; n < 2; ++n) _Pragma("unroll") for (int k = 0; k < 2; ++k) \
        acc[ai][bj][m][n] = __builtin_amdgcn_mfma_f32_16x16x32_bf16(Bt[n][k], At[m][k], acc[ai][bj][m][n], 0, 0, 0); __builtin_amdgcn_s_setprio(0); } while (0)
#define PG8_WAIT_V(n) asm volatile("s_waitcnt vmcnt(" #n ")" ::: "memory")
#define PG8_WAIT_L(n) asm volatile("s_waitcnt lgkmcnt(" #n ")" ::: "memory")
#define PG8_BAR __builtin_amdgcn_s_barrier()
#define PG8_SCHED __builtin_amdgcn_sched_barrier(0)
    Unit cur, nxt; int ui = 0;
    if (!S.next(0, cur)) return;
    f32x4 acc[2][2][4][2];
#pragma unroll
    for (int a = 0; a < 2; ++a)
#pragma unroll
        for (int b = 0; b < 2; ++b)
#pragma unroll
            for (int m = 0; m < 4; ++m)
#pragma unroll
                for (int n = 0; n < 2; ++n) acc[a][b][m][n] = (f32x4){0.f, 0.f, 0.f, 0.f};
    bf16x8 At[4][2], B0[2][2], B1[2][2];
    const char* cA = (const char*)g.A + (size_t)cur.pm * tstep; const char* cB = (const char*)g.Bt + (size_t)cur.pn * tstep;
    S.a_ready(cur);
    PG8_STAGE(PG8_SB(0, 0), cB, voffB); PG8_STAGE(PG8_SA(0, 0), cA, voffA); PG8_STAGE(PG8_SB(0, 1), cB + hstep, voffB); PG8_STAGE(PG8_SA(0, 1), cA + hstep, voffA);
    if (wr == 1) PG8_BAR;
    PG8_WAIT_V(4); PG8_BAR;
    PG8_STAGE(PG8_SB(1, 0), cB + kstep, voffB); PG8_STAGE(PG8_SA(1, 0), cA + kstep, voffA); PG8_STAGE(PG8_SB(1, 1), cB + hstep + kstep, voffB);
    PG8_WAIT_V(6); PG8_BAR;
    PG8_STAMP();
    for (;;) {
        const bool has_next = S.next(ui + 1, nxt);
        const char* nA = has_next ? (const char*)g.A + (size_t)nxt.pm * tstep : cA; const char* nB = has_next ? (const char*)g.Bt + (size_t)nxt.pn * tstep : cB;
        for (int t = 0; t < nt; t += 2) {
            const bool last = (t == nt - 2);
            const char* a1 = cA + (size_t)(t + 1) * kstep;
            const char* a2 = last ? nA : cA + (size_t)(t + 2) * kstep; const char* b2 = last ? nB : cB + (size_t)(t + 2) * kstep;
            const char* a3 = a2 + kstep; const char* b3 = b2 + kstep;
            if (last && has_next) S.a_ready(nxt);
            PG8_LDB(B0, 0, 0); PG8_SCHED; PG8_LDA(At, 0, 0); PG8_STAGE(PG8_SA(1, 1), a1 + hstep, voffA);
            PG8_WAIT_L(8); PG8_BAR; PG8_WAIT_L(0); PG8_MMA(0, 0, At, B0); PG8_BAR; PG8_SCHED;
            PG8_LDB(B1, 0, 1); PG8_STAGE(PG8_SB(0, 0), b2, voffB);
            PG8_BAR; PG8_WAIT_L(0); PG8_MMA(0, 1, At, B1); PG8_BAR;
            PG8_LDA(At, 0, 1); PG8_STAGE(PG8_SA(0, 0), a2, voffA);
            PG8_BAR; PG8_WAIT_L(0); PG8_MMA(1, 0, At, B0); PG8_BAR; PG8_SCHED;
            PG8_STAGE(PG8_SB(0, 1), b2 + hstep, voffB);
            PG8_WAIT_V(6); PG8_BAR; PG8_MMA(1, 1, At, B1); PG8_BAR;
            PG8_LDB(B0, 1, 0); PG8_SCHED; PG8_LDA(At, 1, 0); PG8_STAGE(PG8_SA(0, 1), a2 + hstep, voffA);
            PG8_WAIT_L(8); PG8_BAR; PG8_WAIT_L(0); PG8_MMA(0, 0, At, B0); PG8_BAR; PG8_SCHED;
            PG8_LDB(B1, 1, 1); PG8_STAGE(PG8_SB(1, 0), b3, voffB);
            PG8_BAR; PG8_WAIT_L(0); PG8_MMA(0, 1, At, B1); PG8_BAR;
            PG8_LDA(At, 1, 1); PG8_STAGE(PG8_SA(1, 0), a3, voffA);
            PG8_BAR; PG8_WAIT_L(0); PG8_MMA(1, 0, At, B0); PG8_BAR; PG8_SCHED;
            PG8_STAGE(PG8_SB(1, 1), b3 + hstep, voffB);
            PG8_WAIT_V(6); PG8_BAR; PG8_MMA(1, 1, At, B1); PG8_BAR;
        }
        PG8_STAMP();
        if constexpr (!Epi::AFTER_DRAIN) { E(acc, cur, wr, wc, fr, fq); S.done(cur); }
        PG8_STAMP();
        if (!has_next) break;
#pragma unroll
        for (int a = 0; a < 2; ++a)
#pragma unroll
            for (int b = 0; b < 2; ++b)
#pragma unroll
                for (int m = 0; m < 4; ++m)
#pragma unroll
                    for (int n = 0; n < 2; ++n) acc[a][b][m][n] = (f32x4){0.f, 0.f, 0.f, 0.f};
        cur = nxt; cA = nA; cB = nB; ++ui;
    }
    PG8_WAIT_V(0);
    if (wr == 0) PG8_BAR;
    PG8_BAR;
    if constexpr (Epi::AFTER_DRAIN) { E.fused(acc, cur, wr, wc, fr, fq, lds, wid, lane); S.done(cur); }
    PG8_STAMP();
    if (STAMP && wid == 0) { stamps[lane] = lane < nts ? (((unsigned long long)(unsigned)ts_hi << 32) | (unsigned)ts_lo) : 0ull;
        if (lane == 62) stamps[62] = rt_entry; if (lane == 63) stamps[63] = (unsigned long long)wall_clock64(); }
#undef PG8_STAMP
#undef PG8_SA
#undef PG8_SB
#undef PG8_STAGE
#undef PG8_LDA
#undef PG8_LDB
#undef PG8_MMA
#undef PG8_WAIT_V
#undef PG8_WAIT_L
#undef PG8_BAR
#undef PG8_SCHED
}
}

namespace mk {
using pg8::bf16_t; using pg8::bf16x8; using pg8::f32x4; using pg8::u32x4; using pg8::Unit; using pg8::cvt_pk_bf16; using pg8::cvt_pk_native; using pg8::mfma_settle;
typedef unsigned u32x2 __attribute__((ext_vector_type(2)));
typedef float f32x2 __attribute__((ext_vector_type(2)));
constexpr int D = 2048, TL = 16384, TC = 256, MT = TL + TC, NCH = MT / 128;
constexpr int NPROJ = 10496, DFF = 5632;
constexpr size_t MiB = 1u << 20;
constexpr size_t WS_MVEC = 0, WS_CHD = 256 * 1024, WS_BAR = 512 * 1024, WS_S5LOC = 1 * MiB, WS_WA = 10 * MiB, WS_WB = 75 * MiB, WS_HCTX = 141 * MiB, WS_XM = 143 * MiB, WS_SST = 208 * MiB, WS_BIG = 338 * MiB, WS_S5IN = 766 * MiB, WS_END = 775 * MiB;
constexpr size_t B_U5 = 0, B_XBC = B_U5 + (size_t)MT * 1024 * 2, B_Z = B_XBC + (size_t)MT * 3072 * 2, B_GATE = B_Z + (size_t)MT * 2048 * 2, B_DT = B_GATE + (size_t)MT * 4096 * 2,
                 B_Y5 = 330 * MiB, B_YD = B_Y5 + (size_t)MT * 1024 * 2;
static_assert(B_DT + (size_t)MT * 64 * 4 <= B_Y5 && B_YD + (size_t)MT * 2048 * 2 <= 428 * MiB, "big map");
constexpr size_t B_G = 0, B_V = (size_t)MT * DFF * 2;
constexpr size_t WA_IN = 0, WA_GLU = 41 * MiB, WA_S5P = 45 * MiB, WA_SSDP = 49 * MiB, WA_WOUT = 57 * MiB, WB_UP = 0, WB_DOWN = 44 * MiB;
constexpr int LDS_BYTES = 163840;
constexpr float ALPHA = 1.41421356237f, LN_EPS = 1e-5f, RMS_EPS = 1e-5f;

struct Args { const float* in[33]; float* out; unsigned char* ws; int ph_lo, ph_hi; };

__device__ __forceinline__ float bf2f(unsigned b) { return __uint_as_float(b << 16); }
__device__ __forceinline__ float bflo(unsigned w) { return __uint_as_float(w << 16); }
__device__ __forceinline__ float bfhi(unsigned w) { return __uint_as_float(w & 0xffff0000u); }
__device__ __forceinline__ float sigm(float x) { return __builtin_amdgcn_rcpf(1.f + __expf(-x)); }
__device__ __forceinline__ float silu_(float x) { return x * __builtin_amdgcn_rcpf(1.f + __expf(-x)); }
__device__ __forceinline__ float gelu_tanh(float x) { const float u = 0.7978845608028654f * (x + 0.044715f * x * x * x); const float th = 1.f - 2.f * __builtin_amdgcn_rcpf(__expf(2.f * u) + 1.f); return 0.5f * x * (1.f + th); }
__device__ __forceinline__ bf16x8 mkfrag(unsigned a, unsigned b, unsigned c, unsigned d) { u32x4 v; v.x = a; v.y = b; v.z = c; v.w = d; return __builtin_bit_cast(bf16x8, v); }
__device__ __forceinline__ float* hrow(const Args& a, int row) { return row < TL ? a.out + (size_t)row * D : (float*)(a.ws + WS_HCTX) + (size_t)(row - TL) * D; }
__device__ __forceinline__ const float* mvec(const Args& a, int layer, int isctx) { return (const float*)(a.ws + WS_MVEC) + (size_t)(layer * 2 + isctx) * 12288; }

struct EpiInProj {
    static constexpr bool PERM = true, AFTER_DRAIN = false;
    unsigned char* big; const float* dt_bias;
    __device__ __forceinline__ void operator()(const f32x4 (&acc)[2][2][4][2], const Unit& u, int wr, int wc, int fr, int fq) const {
        mfma_settle(acc[1][1][3][1]); mfma_settle(acc[1][1][3][0]);
        const int row0 = u.pm * 256 + wr * 64 + fr, ct = u.pn * 256;
        if (ct >= 10240) {
            if (wc < 2) { const int cc = wc * 32 + 8 * fq; float* DT = (float*)(big + B_DT);
                const f32x4 b0 = *(const f32x4*)(dt_bias + cc), b1 = *(const f32x4*)(dt_bias + cc + 4);
#pragma unroll
                for (int ai = 0; ai < 2; ++ai)
#pragma unroll
                    for (int m = 0; m < 4; ++m) { float* rp = DT + (size_t)(row0 + ai * 128 + m * 16) * 64 + cc; f32x4 v0 = acc[ai][0][m][0] + b0, v1 = acc[ai][0][m][1] + b1;
#pragma unroll
                        for (int j = 0; j < 4; ++j) { v0[j] = v0[j] > 20.f ? v0[j] : log1pf(expf(v0[j])); v1[j] = v1[j] > 20.f ? v1[j] : log1pf(expf(v1[j])); }
                        *(f32x4*)rp = v0; *(f32x4*)(rp + 4) = v1; } }
            return;
        }
        bf16_t* base; int ld, c0; bool sg = false;
        if (ct < 1024) { base = (bf16_t*)(big + B_U5); ld = 1024; c0 = ct; }
        else if (ct < 4096) { base = (bf16_t*)(big + B_XBC); ld = 3072; c0 = ct - 1024; }
        else if (ct < 6144) { base = (bf16_t*)(big + B_Z); ld = 2048; c0 = ct - 4096; }
        else { base = (bf16_t*)(big + B_GATE); ld = 4096; c0 = ct - 6144; sg = true; }
        const int col0 = c0 + wc * 32 + 8 * fq;
#pragma unroll
        for (int ai = 0; ai < 2; ++ai)
#pragma unroll
            for (int m = 0; m < 4; ++m) { bf16_t* rowp = base + (size_t)(row0 + ai * 128 + m * 16) * ld + col0;
#pragma unroll
                for (int bj = 0; bj < 2; ++bj) { f32x4 v0 = acc[ai][bj][m][0], v1 = acc[ai][bj][m][1];
                    if (sg) {
#pragma unroll
                        for (int j = 0; j < 4; ++j) { v0[j] = sigm(v0[j]); v1[j] = sigm(v1[j]); } }
                    u32x4 w; w.x = cvt_pk_native(v0[0], v0[1]); w.y = cvt_pk_native(v0[2], v0[3]); w.z = cvt_pk_native(v1[0], v1[1]); w.w = cvt_pk_native(v1[2], v1[3]);
                    *(u32x4*)(rowp + bj * 128) = w; } }
    }
};
struct EpiGlu {
    static constexpr bool PERM = true, AFTER_DRAIN = false;
    bf16_t* O;
    __device__ __forceinline__ void operator()(const f32x4 (&acc)[2][2][4][2], const Unit& u, int wr, int wc, int fr, int fq) const {
        mfma_settle(acc[1][1][3][1]); mfma_settle(acc[1][1][3][0]);
        const int row0 = u.pm * 256 + wr * 64 + fr, col0 = u.pn * 128 + wc * 32 + 8 * fq;
#pragma unroll
        for (int ai = 0; ai < 2; ++ai)
#pragma unroll
            for (int m = 0; m < 4; ++m) { f32x4 v0 = acc[ai][0][m][0], v1 = acc[ai][0][m][1]; const f32x4 g0 = acc[ai][1][m][0], g1 = acc[ai][1][m][1];
#pragma unroll
                for (int j = 0; j < 4; ++j) { v0[j] *= sigm(g0[j]); v1[j] *= sigm(g1[j]); }
                u32x4 w; w.x = cvt_pk_bf16(v0[0], v0[1]); w.y = cvt_pk_bf16(v0[2], v0[3]); w.z = cvt_pk_bf16(v1[0], v1[1]); w.w = cvt_pk_bf16(v1[2], v1[3]);
                *(u32x4*)(O + (size_t)(row0 + ai * 128 + m * 16) * 1024 + col0) = w; }
    }
};
template <int SECOND, int GSEL = SECOND> struct EpiMerge {
    static constexpr bool PERM = true, AFTER_DRAIN = false;
    bf16_t* MG; const bf16_t* GATE;
    __device__ __forceinline__ void operator()(const f32x4 (&acc)[2][2][4][2], const Unit& u, int wr, int wc, int fr, int fq) const {
        mfma_settle(acc[1][1][3][1]); mfma_settle(acc[1][1][3][0]);
        const int row0 = u.pm * 256 + wr * 64 + fr, col0 = u.pn * 256 + wc * 32 + 8 * fq;
#pragma unroll
        for (int ai = 0; ai < 2; ++ai)
#pragma unroll
            for (int m = 0; m < 4; ++m) { const size_t r = (size_t)(row0 + ai * 128 + m * 16); u32x4 gg[2], oo[2];
#pragma unroll
                for (int bj = 0; bj < 2; ++bj) { const int c = col0 + bj * 128; gg[bj] = *(const u32x4*)(GATE + r * 4096 + (GSEL ? 2048 : 0) + c); if (SECOND) oo[bj] = *(const u32x4*)(MG + r * 2048 + c); }
                __builtin_amdgcn_sched_barrier(0);
#pragma unroll
                for (int bj = 0; bj < 2; ++bj) { const int c = col0 + bj * 128; const u32x4 g = gg[bj];
                    f32x4 v0 = acc[ai][bj][m][0], v1 = acc[ai][bj][m][1];
                    v0[0] *= bflo(g.x); v0[1] *= bfhi(g.x); v0[2] *= bflo(g.y); v0[3] *= bfhi(g.y); v1[0] *= bflo(g.z); v1[1] *= bfhi(g.z); v1[2] *= bflo(g.w); v1[3] *= bfhi(g.w);
                    if (SECOND) { const u32x4 o = oo[bj];
                        v0[0] += bflo(o.x); v0[1] += bfhi(o.x); v0[2] += bflo(o.y); v0[3] += bfhi(o.y); v1[0] += bflo(o.z); v1[1] += bfhi(o.z); v1[2] += bflo(o.w); v1[3] += bfhi(o.w); }
                    u32x4 w; w.x = cvt_pk_bf16(v0[0], v0[1]); w.y = cvt_pk_bf16(v0[2], v0[3]); w.z = cvt_pk_bf16(v1[0], v1[1]); w.w = cvt_pk_bf16(v1[2], v1[3]);
                    *(u32x4*)(MG + r * 2048 + c) = w; }
                __builtin_amdgcn_sched_barrier(0); }
    }
};
struct EpiResid {
    static constexpr bool PERM = false, AFTER_DRAIN = false;
    float* out; float* hctx; const float* glat; const float* gctx;
    __device__ __forceinline__ void operator()(const f32x4 (&acc)[2][2][4][2], const Unit& u, int wr, int wc, int fr, int fq) const {
        mfma_settle(acc[1][1][3][1]); mfma_settle(acc[1][1][3][0]);
        const bool isctx = u.pm >= 64; const float* g = isctx ? gctx : glat;
        float* hb = isctx ? hctx + (size_t)(wr * 64 + fr) * D : out + (size_t)(u.pm * 256 + wr * 64 + fr) * D;
        const int col0 = u.pn * 256 + wc * 32 + 4 * fq;
        f32x4 gv[2][2];
#pragma unroll
        for (int bj = 0; bj < 2; ++bj)
#pragma unroll
            for (int n = 0; n < 2; ++n) gv[bj][n] = *(const f32x4*)(g + col0 + bj * 128 + n * 16);
#pragma unroll
        for (int ai = 0; ai < 2; ++ai)
#pragma unroll
            for (int m = 0; m < 4; ++m) { float* rowp = hb + (size_t)(ai * 128 + m * 16) * D + col0;
                { f32x4 h[2][2];
#pragma unroll
                for (int bj = 0; bj < 2; ++bj)
#pragma unroll
                    for (int n = 0; n < 2; ++n) h[bj][n] = *(const f32x4*)(rowp + bj * 128 + n * 16);
                __builtin_amdgcn_sched_barrier(0);
#pragma unroll
                for (int bj = 0; bj < 2; ++bj)
#pragma unroll
                    for (int n = 0; n < 2; ++n) *(f32x4*)(rowp + bj * 128 + n * 16) = h[bj][n] * ALPHA + gv[bj][n] * acc[ai][bj][m][n];
                __builtin_amdgcn_sched_barrier(0); } }
    }
};
struct EpiUp {
    static constexpr bool PERM = true, AFTER_DRAIN = false;
    bf16_t* G; bf16_t* V;
    __device__ __forceinline__ void operator()(const f32x4 (&acc)[2][2][4][2], const Unit& u, int wr, int wc, int fr, int fq) const {
        mfma_settle(acc[1][1][3][1]); mfma_settle(acc[1][1][3][0]);
        const int row0 = u.pm * 256 + wr * 64 + fr; int ct = u.pn * 256; bf16_t* base = G; if (ct >= DFF) { base = V; ct -= DFF; }
        const int col0 = ct + wc * 32 + 8 * fq;
#pragma unroll
        for (int ai = 0; ai < 2; ++ai)
#pragma unroll
            for (int m = 0; m < 4; ++m) { bf16_t* rowp = base + (size_t)(row0 + ai * 128 + m * 16) * DFF + col0;
#pragma unroll
                for (int bj = 0; bj < 2; ++bj) { const f32x4 v0 = acc[ai][bj][m][0], v1 = acc[ai][bj][m][1];
                    u32x4 w; w.x = cvt_pk_native(v0[0], v0[1]); w.y = cvt_pk_native(v0[2], v0[3]); w.z = cvt_pk_native(v1[0], v1[1]); w.w = cvt_pk_native(v1[2], v1[3]);
                    *(u32x4*)(rowp + bj * 128) = w; } }
    }
};

struct XItem { const float* W; bf16_t* WT; int K, N, d0, s0, k0; };
__device__ __forceinline__ void xpose_load(const XItem& x, float (&v)[32], int lane) {
#pragma unroll
    for (int i = 0; i < 32; ++i) { const int kk = 2 * i + (lane >> 5); v[i] = x.s0 >= 0 ? x.W[(size_t)(x.k0 + kk) * x.N + x.s0 + (lane & 31)] : 0.f; }
}
__device__ __forceinline__ void xpose_store(const XItem& x, const float (&v)[32], float* scr, int lane) {
#pragma unroll
    for (int i = 0; i < 32; ++i) { const int kk = 2 * i + (lane >> 5); scr[kk * 33 + (lane & 31)] = v[i]; }
    asm volatile("s_waitcnt lgkmcnt(0)" ::: "memory");
    const int c = lane & 7;
#pragma unroll
    for (int j = 0; j < 4; ++j) { const int n = (lane >> 3) + 8 * j; const float* sp = scr + (8 * c) * 33 + n;
        u32x4 o; o.x = cvt_pk_bf16(sp[0 * 33], sp[1 * 33]); o.y = cvt_pk_bf16(sp[2 * 33], sp[3 * 33]); o.z = cvt_pk_bf16(sp[4 * 33], sp[5 * 33]); o.w = cvt_pk_bf16(sp[6 * 33], sp[7 * 33]);
        *(u32x4*)(x.WT + (size_t)(x.d0 + n) * x.K + x.k0 + 8 * c) = o; }
    asm volatile("s_waitcnt lgkmcnt(0)" ::: "memory");
}
__device__ __forceinline__ XItem xpose_decode(const Args& a, int layer, int region, int r) {
    XItem x;
    if (region == 0) {
        bf16_t* WA = (bf16_t*)(a.ws + WS_WA);
        constexpr int I_IN = 32 * 328, I_GLU = 16 * 64, I_S5P = 16 * 64, I_SSDP = 32 * 64;
        if (r < I_IN) { const int kb = r / 328, d0 = (r % 328) * 32; int s0; if (d0 < 4096) s0 = d0; else if (d0 < 10240) s0 = d0 + 64; else if (d0 < 10304) s0 = d0 - 10240 + 4096; else s0 = -1;
            x.W = a.in[6] + (size_t)layer * 2048 * 10304; x.WT = WA + WA_IN / 2; x.K = 2048; x.N = 10304; x.d0 = d0; x.s0 = s0; x.k0 = kb * 64; return x; } r -= I_IN;
        if (r < I_GLU) { const int kb = r / 64, d0 = (r % 64) * 32, t = d0 >> 8, j = d0 & 255;
            x.W = a.in[15] + (size_t)layer * 1024 * 2048; x.WT = WA + WA_GLU / 2; x.K = 1024; x.N = 2048; x.d0 = d0; x.s0 = j < 128 ? t * 128 + j : 1024 + t * 128 + (j - 128); x.k0 = kb * 64; return x; } r -= I_GLU;
        if (r < I_S5P) { x.W = a.in[16] + (size_t)layer * 1024 * 2048; x.WT = WA + WA_S5P / 2; x.K = 1024; x.N = 2048; x.d0 = (r % 64) * 32; x.s0 = x.d0; x.k0 = (r / 64) * 64; return x; } r -= I_S5P;
        if (r < I_SSDP) { x.W = a.in[23] + (size_t)layer * 2048 * 2048; x.WT = WA + WA_SSDP / 2; x.K = 2048; x.N = 2048; x.d0 = (r % 64) * 32; x.s0 = x.d0; x.k0 = (r / 64) * 64; return x; } r -= I_SSDP;
        x.W = a.in[24] + (size_t)layer * 2048 * 2048; x.WT = WA + WA_WOUT / 2; x.K = 2048; x.N = 2048; x.d0 = (r % 64) * 32; x.s0 = x.d0; x.k0 = (r / 64) * 64; return x;
    }
    bf16_t* WB = (bf16_t*)(a.ws + WS_WB); constexpr int I_UP = 32 * 352;
    if (r < I_UP) { x.W = a.in[27] + (size_t)layer * 2048 * 11264; x.WT = WB + WB_UP / 2; x.K = 2048; x.N = 11264; x.d0 = (r % 352) * 32; x.s0 = x.d0; x.k0 = (r / 352) * 64; return x; } r -= I_UP;
    x.W = a.in[30] + (size_t)layer * 5632 * 2048; x.WT = WB + WB_DOWN / 2; x.K = 5632; x.N = 2048; x.d0 = (r % 64) * 32; x.s0 = x.d0; x.k0 = (r / 64) * 64; return x;
}
__device__ __forceinline__ void xpose_region(const Args& a, int layer, int region, float* scr, int gw, int NGW, int lane) {
    const int NI = region == 0 ? (32 * 328 + 16 * 64 + 16 * 64 + 32 * 64 + 32 * 64) : (32 * 352 + 88 * 64);
    int it = gw;
    for (; it + 3 * NGW < NI; it += 4 * NGW) {
        const XItem x0 = xpose_decode(a, layer, region, it), x1 = xpose_decode(a, layer, region, it + NGW), x2 = xpose_decode(a, layer, region, it + 2 * NGW), x3 = xpose_decode(a, layer, region, it + 3 * NGW);
        float v0[32], v1[32], v2[32], v3[32]; xpose_load(x0, v0, lane); xpose_load(x1, v1, lane); xpose_load(x2, v2, lane); xpose_load(x3, v3, lane);
        xpose_store(x0, v0, scr, lane); xpose_store(x1, v1, scr, lane); xpose_store(x2, v2, scr, lane); xpose_store(x3, v3, scr, lane);
    }
    for (; it < NI; it += NGW) { const XItem x0 = xpose_decode(a, layer, region, it); float v0[32]; xpose_load(x0, v0, lane); xpose_store(x0, v0, scr, lane); }
}

__device__ __forceinline__ void adaln_phase(const Args& a, float* lds, int tid) {
    float* sc = lds; float* scx = lds + 2048; float* red = lds + 4096;
    for (int i = tid; i < 2048; i += 512) { sc[i] = silu_(a.in[1][i]); scx[i] = silu_(a.in[3][i]); }
    __syncthreads();
    for (int unit = blockIdx.x; unit < 256; unit += gridDim.x) {
        const int layer = unit >> 7, col0 = (unit & 127) * 96;
        const float* W = a.in[4] + (size_t)layer * 2048 * 12288 + col0;
        if (tid < 504) { const int cq = tid % 24, ks = tid / 24; f32x4 al = {0.f, 0.f, 0.f, 0.f}, ac = {0.f, 0.f, 0.f, 0.f};
#pragma unroll 14
            for (int k = ks; k < 2048; k += 21) { const f32x4 w = *(const f32x4*)(W + (size_t)k * 12288 + cq * 4); al += w * sc[k]; ac += w * scx[k]; }
            *(f32x4*)(red + (ks * 2 + 0) * 96 + cq * 4) = al; *(f32x4*)(red + (ks * 2 + 1) * 96 + cq * 4) = ac; }
        __syncthreads();
        if (tid < 192) { const int v = tid / 96, c = tid % 96; float s = 0.f; for (int ks = 0; ks < 21; ++ks) s += red[(ks * 2 + v) * 96 + c];
            ((float*)(a.ws + WS_MVEC))[(size_t)(layer * 2 + v) * 12288 + col0 + c] = s + a.in[5][(size_t)layer * 12288 + col0 + c]; }
        __syncthreads();
    }
}

__device__ __forceinline__ float wave_sum(float v) {
#pragma unroll
    for (int o = 1; o < 64; o <<= 1) v += __shfl_xor(v, o);
    return v;
}
template <int MODE> __device__ __forceinline__ void row_phase(const Args& a, int nrows, const float* lng, const float* lnb, int mod_layer, int mod_off, int gw, int NGW, int lane) {
    bf16_t* XM = (bf16_t*)(a.ws + WS_XM);
    f32x4 lg[8], lb[8];
    if (MODE == 1) {
#pragma unroll
        for (int j = 0; j < 8; ++j) { lg[j] = *(const f32x4*)(lng + 4 * lane + 256 * j); lb[j] = *(const f32x4*)(lnb + 4 * lane + 256 * j); } }
    for (int row0 = gw; row0 < nrows; row0 += 2 * NGW) {
        const int row1 = row0 + NGW < nrows ? row0 + NGW : row0;
        const int rows[2] = {row0, row1}; f32x4 v[2][8];
#pragma unroll
        for (int u = 0; u < 2; ++u) { const int row = rows[u]; const int isctx = row >= TL;
            const float* src = MODE == 0 ? (isctx ? a.in[2] + (size_t)(row - TL) * D : a.in[0] + (size_t)row * D) : hrow(a, row);
#pragma unroll
            for (int j = 0; j < 8; ++j) v[u][j] = *(const f32x4*)(src + 4 * lane + 256 * j); }
        if (MODE == 1) {
            float s[2], q[2];
#pragma unroll
            for (int u = 0; u < 2; ++u) { s[u] = 0.f;
#pragma unroll
                for (int j = 0; j < 8; ++j) s[u] += (v[u][j][0] + v[u][j][1]) + (v[u][j][2] + v[u][j][3]); }
            s[0] = wave_sum(s[0]); s[1] = wave_sum(s[1]);
#pragma unroll
            for (int u = 0; u < 2; ++u) { const float mean = s[u] * (1.f / D); q[u] = 0.f;
#pragma unroll
                for (int j = 0; j < 8; ++j) { v[u][j] = v[u][j] - mean; q[u] += (v[u][j][0] * v[u][j][0] + v[u][j][1] * v[u][j][1]) + (v[u][j][2] * v[u][j][2] + v[u][j][3] * v[u][j][3]); } }
            q[0] = wave_sum(q[0]); q[1] = wave_sum(q[1]);
#pragma unroll
            for (int u = 0; u < 2; ++u) { const float rstd = __builtin_amdgcn_rsqf(q[u] * (1.f / D) + LN_EPS);
#pragma unroll
                for (int j = 0; j < 8; ++j) v[u][j] = v[u][j] * rstd * lg[j] + lb[j]; }
        }
#pragma unroll
        for (int u = 0; u < 2; ++u) { const int row = rows[u]; const int isctx = row >= TL; float* h = hrow(a, row);
#pragma unroll
            for (int j = 0; j < 8; ++j) *(f32x4*)(h + 4 * lane + 256 * j) = v[u][j];
            if (mod_layer >= 0) { const float* m = mvec(a, mod_layer, isctx) + mod_off; f32x4 shv[8], scv[8];
#pragma unroll
                for (int j = 0; j < 8; ++j) { shv[j] = *(const f32x4*)(m + 4 * lane + 256 * j); scv[j] = *(const f32x4*)(m + D + 4 * lane + 256 * j); }
                __builtin_amdgcn_sched_barrier(0);
#pragma unroll
                for (int j = 0; j < 8; ++j) { const f32x4 sh = shv[j], scl = scv[j]; const f32x4 o = v[u][j] * (scl + 1.f) + sh;
                    u32x2 w; w.x = cvt_pk_bf16(o[0], o[1]); w.y = cvt_pk_bf16(o[2], o[3]); *(u32x2*)(XM + (size_t)row * D + 4 * lane + 256 * j) = w; } } }
    }
}

__device__ __forceinline__ void ffnconv_ctx(const Args& a, int layer, int tid) {
    const bf16_t* G = (const bf16_t*)(a.ws + WS_BIG + B_G); bf16_t* V = (bf16_t*)(a.ws + WS_BIG + B_V);
    const float* cw = a.in[28] + (size_t)layer * 9 * DFF; const float* cb = a.in[29] + (size_t)layer * DFF;
    const int nunits = 260 * 11; const int oc = tid & 63, xs = tid >> 6;
    for (int unit = 256 * 11 + blockIdx.x; unit < nunits; unit += gridDim.x) {
        const int seg = unit / 11, ob = unit % 11, ch0 = ob * 512 + oc * 8; const bool cs = seg >= 256; const int t0 = seg * 64;
        float w[9][8], bias[8];
#pragma unroll
        for (int k = 0; k < 9; ++k) { const f32x4 w0 = *(const f32x4*)(cw + (size_t)k * DFF + ch0), w1 = *(const f32x4*)(cw + (size_t)k * DFF + ch0 + 4);
            w[k][0] = w0[0]; w[k][1] = w0[1]; w[k][2] = w0[2]; w[k][3] = w0[3]; w[k][4] = w1[0]; w[k][5] = w1[1]; w[k][6] = w1[2]; w[k][7] = w1[3]; }
        { const f32x4 b0 = *(const f32x4*)(cb + ch0), b1 = *(const f32x4*)(cb + ch0 + 4); bias[0] = b0[0]; bias[1] = b0[1]; bias[2] = b0[2]; bias[3] = b0[3]; bias[4] = b1[0]; bias[5] = b1[1]; bias[6] = b1[2]; bias[7] = b1[3]; }
#pragma unroll 4
        for (int xi = 0; xi < 8; ++xi) { const int x = xs * 8 + xi, t = t0 + x; float acc[8];
#pragma unroll
            for (int k = 0; k < 8; ++k) acc[k] = bias[k];
            u32x4 g3[3]; bf16_t* vp = V + (size_t)t * DFF + ch0;
#pragma unroll
            for (int dx = -1; dx <= 1; ++dx) { const bool ok = t + dx >= TL && t + dx < MT; g3[dx + 1] = *(const u32x4*)(G + (size_t)(ok ? t + dx : t) * DFF + ch0); }
            const u32x4 vv = *(const u32x4*)vp;
            __builtin_amdgcn_sched_barrier(0);
#pragma unroll
            for (int dx = -1; dx <= 1; ++dx) { const bool ok = t + dx >= TL && t + dx < MT; u32x4 g = g3[dx + 1]; if (!ok) g = (u32x4){0u, 0u, 0u, 0u}; const int k = 3 + dx + 1;
                acc[0] += w[k][0] * bflo(g.x); acc[1] += w[k][1] * bfhi(g.x); acc[2] += w[k][2] * bflo(g.y); acc[3] += w[k][3] * bfhi(g.y);
                acc[4] += w[k][4] * bflo(g.z); acc[5] += w[k][5] * bfhi(g.z); acc[6] += w[k][6] * bflo(g.w); acc[7] += w[k][7] * bfhi(g.w); }
            u32x4 o; o.x = cvt_pk_bf16(silu_(acc[0]) * bflo(vv.x), silu_(acc[1]) * bfhi(vv.x)); o.y = cvt_pk_bf16(silu_(acc[2]) * bflo(vv.y), silu_(acc[3]) * bfhi(vv.y));
            o.z = cvt_pk_bf16(silu_(acc[4]) * bflo(vv.z), silu_(acc[5]) * bfhi(vv.z)); o.w = cvt_pk_bf16(silu_(acc[6]) * bflo(vv.w), silu_(acc[7]) * bfhi(vv.w));
            *(u32x4*)vp = o; }
    }
}

__device__ __forceinline__ void ffnconv_phase(const Args& a, int layer, bool with_ctx, unsigned char* lds, int tid) {
    const bf16_t* G = (const bf16_t*)(a.ws + WS_BIG + B_G); bf16_t* V = (bf16_t*)(a.ws + WS_BIG + B_V);
    const float* cw = a.in[28] + (size_t)layer * 9 * DFF; const float* cb = a.in[29] + (size_t)layer * DFF;
    bf16_t* T = (bf16_t*)lds;
    const int oc = tid & 15, ts = tid >> 4;
    u32x4 gn[12];
#define FFC_PREFETCH(unit_) do { const int rg_ = (unit_) / 44, ch_ = ((unit_) % 44) * 128 + oc * 8, y0_ = rg_ * 4; \
        _Pragma("unroll") for (int i = 0; i < 12; ++i) { const int idx = tid + i * 512, r = idx >> 10, x = (idx >> 4) & 63, y = y0_ - 1 + r; const bool ok = y >= 0 && y < 256; \
            gn[i] = *(const u32x4*)(G + (size_t)((ok ? y : y0_) * 64 + x) * DFF + ch_); } } while (0)
    for (int unit = blockIdx.x; unit < 64 * 44; unit += gridDim.x) {
        const int rg = unit / 44, ch0 = (unit % 44) * 128 + oc * 8, y0 = rg * 4;
        FFC_PREFETCH(unit);
        __syncthreads();
#pragma unroll
        for (int i = 0; i < 12; ++i) { const int idx = tid + i * 512, r = idx >> 10, x = (idx >> 4) & 63, y = y0 - 1 + r; const bool ok = y >= 0 && y < 256;
            *(u32x4*)(T + ((r * 64 + x) * 128 + oc * 8)) = ok ? gn[i] : (u32x4){0u, 0u, 0u, 0u}; }
        u32x4 vv[8];
#pragma unroll
        for (int o = 0; o < 8; ++o) vv[o] = *(const u32x4*)(V + (size_t)((y0 + (o >> 1)) * 64 + ts * 2 + (o & 1)) * DFF + ch0);
        float w[9][8], bias[8];
#pragma unroll
        for (int k = 0; k < 9; ++k) { const f32x4 w0 = *(const f32x4*)(cw + (size_t)k * DFF + ch0), w1 = *(const f32x4*)(cw + (size_t)k * DFF + ch0 + 4);
            w[k][0] = w0[0]; w[k][1] = w0[1]; w[k][2] = w0[2]; w[k][3] = w0[3]; w[k][4] = w1[0]; w[k][5] = w1[1]; w[k][6] = w1[2]; w[k][7] = w1[3]; }
        { const f32x4 b0 = *(const f32x4*)(cb + ch0), b1 = *(const f32x4*)(cb + ch0 + 4); bias[0] = b0[0]; bias[1] = b0[1]; bias[2] = b0[2]; bias[3] = b0[3]; bias[4] = b1[0]; bias[5] = b1[1]; bias[6] = b1[2]; bias[7] = b1[3]; }
        __syncthreads();
#pragma unroll
        for (int o = 0; o < 8; ++o) { const int rr = o >> 1, x = ts * 2 + (o & 1); float acc[8];
#pragma unroll
            for (int k = 0; k < 8; ++k) acc[k] = bias[k];
            u32x4 g9[9];
#pragma unroll
            for (int dy = -1; dy <= 1; ++dy)
#pragma unroll
                for (int dx = -1; dx <= 1; ++dx) { const int xn = x + dx; const bool ok = xn >= 0 && xn < 64; g9[(dy + 1) * 3 + dx + 1] = *(const u32x4*)(T + (((rr + 1 + dy) * 64 + (ok ? xn : x)) * 128 + oc * 8)); }
            __builtin_amdgcn_sched_barrier(0);
#pragma unroll
            for (int dy = -1; dy <= 1; ++dy)
#pragma unroll
                for (int dx = -1; dx <= 1; ++dx) { const int xn = x + dx; const bool ok = xn >= 0 && xn < 64; const int k = (dy + 1) * 3 + dx + 1;
                    u32x4 g = g9[k]; if (!ok) g = (u32x4){0u, 0u, 0u, 0u};
                    acc[0] += w[k][0] * bflo(g.x); acc[1] += w[k][1] * bfhi(g.x); acc[2] += w[k][2] * bflo(g.y); acc[3] += w[k][3] * bfhi(g.y);
                    acc[4] += w[k][4] * bflo(g.z); acc[5] += w[k][5] * bfhi(g.z); acc[6] += w[k][6] * bflo(g.w); acc[7] += w[k][7] * bfhi(g.w); }
            const u32x4 v = vv[o];
            u32x4 q; q.x = cvt_pk_bf16(silu_(acc[0]) * bflo(v.x), silu_(acc[1]) * bfhi(v.x)); q.y = cvt_pk_bf16(silu_(acc[2]) * bflo(v.y), silu_(acc[3]) * bfhi(v.y));
            q.z = cvt_pk_bf16(silu_(acc[4]) * bflo(v.z), silu_(acc[5]) * bfhi(v.z)); q.w = cvt_pk_bf16(silu_(acc[6]) * bflo(v.w), silu_(acc[7]) * bfhi(v.w));
            *(u32x4*)(V + (size_t)((y0 + rr) * 64 + x) * DFF + ch0) = q; }
    }
#undef FFC_PREFETCH
    __syncthreads();
    if (with_ctx) ffnconv_ctx(a, layer, tid);
}
__device__ __forceinline__ int s5_chunk_at(int dir, int q) { return dir ? 129 - q : (q + 128) % 130; }
__device__ __forceinline__ int s5_pos_of(int dir, int c) { return dir ? 129 - c : (c + 2) % 130; }
template <int PASS> __device__ __forceinline__ void s5_phase(const Args& a, int layer, unsigned char* lds, int tid, int nchunks) {
    constexpr int BUP = 132;
    const bf16_t* U5 = (const bf16_t*)(a.ws + WS_BIG + B_U5); bf16_t* Y5 = (bf16_t*)(a.ws + WS_BIG + B_Y5);
    float2* S5LOC = (float2*)(a.ws + WS_S5LOC);
    const int lane = tid & 63, w = tid >> 6, gl = w >> 1, dir = w & 1, p = lane, fr = lane & 15, fq = lane >> 4;
    float* BuW = (float*)lds + (size_t)w * (16 * BUP);
    bf16_t* STw = (bf16_t*)(lds + 67584) + (size_t)w * (16 * 136);
    float* YL = (float*)(lds + 102400);
    const int gq = blockIdx.x & 15, g = gq * 4 + gl;
    float ab_re, ab_im, a128r, a128i;
    const float step = expf(a.in[9][(size_t)(layer * 2 + dir) * 64 + g]);
    { const size_t pi = ((size_t)(layer * 2 + dir) * 64 + g) * 64 + p; const float lre = fminf(a.in[7][pi], -1e-4f), lim = a.in[8][pi];
      const float mag = expf(lre * step); float sn, cs; sincosf(lim * step, &sn, &cs); ab_re = mag * cs; ab_im = mag * sn; a128r = ab_re; a128i = ab_im;
#pragma unroll
      for (int k = 0; k < 7; ++k) { const float r = a128r * a128r - a128i * a128i, i = 2.f * a128r * a128i; a128r = r; a128i = i; } }
    bf16x8 bbf[8];
#pragma unroll
    for (int nt = 0; nt < 8; ++nt) { const int pp = nt * 8 + (fr >> 1), cc = fr & 1; const size_t pi = ((size_t)(layer * 2 + dir) * 64 + g) * 64 + pp;
        const float lre = fminf(a.in[7][pi], -1e-4f), lim = a.in[8][pi]; const float mag = expf(lre * step); float sn, cs; sincosf(lim * step, &sn, &cs);
        const float are = mag * cs, aim = mag * sn, den = lre * lre + lim * lim, q_re = ((are - 1.f) * lre + aim * lim) / den, q_im = (aim * lre - (are - 1.f) * lim) / den;
        const float* br = a.in[10] + (((size_t)layer * 64 + g) * 64 + pp) * 16 + (fq & 1) * 8; const float* bi = a.in[11] + (((size_t)layer * 64 + g) * 64 + pp) * 16 + (fq & 1) * 8;
        const f32x4 r0 = *(const f32x4*)br, r1 = *(const f32x4*)(br + 4), i0 = *(const f32x4*)bi, i1 = *(const f32x4*)(bi + 4); float v[8];
#pragma unroll
        for (int j = 0; j < 8; ++j) { const float r = j < 4 ? r0[j & 3] : r1[j & 3], i = j < 4 ? i0[j & 3] : i1[j & 3]; v[j] = fq < 2 ? (cc ? q_re * i + q_im * r : q_re * r - q_im * i) : 0.f; }
        bbf[nt] = mkfrag(cvt_pk_bf16(v[0], v[1]), cvt_pk_bf16(v[2], v[3]), cvt_pk_bf16(v[4], v[5]), cvt_pk_bf16(v[6], v[7])); }
    bf16x8 cm[4];
    if (PASS == 1) {
        const float* cre = a.in[12] + (((size_t)(layer * 2 + dir) * 64 + g) * 16 + fr) * 64; const float* cim = a.in[13] + (((size_t)(layer * 2 + dir) * 64 + g) * 16 + fr) * 64;
#pragma unroll
        for (int ks = 0; ks < 4; ++ks) { const f32x4 r = *(const f32x4*)(cre + ks * 16 + fq * 4), i = *(const f32x4*)(cim + ks * 16 + fq * 4);
            cm[ks] = mkfrag(cvt_pk_bf16(r[0], -i[0]), cvt_pk_bf16(r[1], -i[1]), cvt_pk_bf16(r[2], -i[2]), cvt_pk_bf16(r[3], -i[3])); }
    }
    const int cstep = gridDim.x >> 4;
    float2* S5IN = (float2*)(a.ws + WS_S5IN);
    if (PASS == 1) {
        float sr = 0.f, si = 0.f;
#pragma unroll 1
        for (int q0 = 0; q0 < NCH; q0 += 13) { float2 l[13];
#pragma unroll
            for (int i = 0; i < 13; ++i) l[i] = S5LOC[((size_t)(dir * NCH + s5_chunk_at(dir, q0 + i)) * 64 + g) * 64 + p];
#pragma unroll
            for (int i = 0; i < 13; ++i) { const int cc = s5_chunk_at(dir, q0 + i);
                if (cc < nchunks && (cc % cstep) == (int)(blockIdx.x >> 4)) S5IN[((size_t)(dir * NCH + cc) * 64 + g) * 64 + p] = make_float2(sr, si);
                const float nr = a128r * sr - a128i * si + l[i].x, ni = a128r * si + a128i * sr + l[i].y; sr = nr; si = ni; } }
    }
    for (int c = blockIdx.x >> 4; c < nchunks; c += cstep) {
        const int row0 = c * 128;
        bf16x8 uf[8];
#pragma unroll
        for (int k = 0; k < 8; ++k) { const int sl = dir ? 7 - k : k; uf[k] = *(const bf16x8*)(U5 + (size_t)(row0 + sl * 16 + fr) * 1024 + g * 16 + (fq & 1) * 8); }
        __builtin_amdgcn_sched_barrier(0);
#pragma unroll
        for (int k = 0; k < 8; ++k) if (fq >= 2) uf[k] = mkfrag(0u, 0u, 0u, 0u);
        float sr = 0.f, si = 0.f;
        if (PASS == 1) { const float2 s0 = S5IN[((size_t)(dir * NCH + c) * 64 + g) * 64 + p]; sr = s0.x; si = s0.y; }
        f32x4 yacc[8];
#pragma unroll
        for (int k = 0; k < 8; ++k) {
#pragma unroll
            for (int nt = 0; nt < 8; ++nt) { f32x4 acc = {0.f, 0.f, 0.f, 0.f}; acc = __builtin_amdgcn_mfma_f32_16x16x32_bf16(uf[k], bbf[nt], acc, 0, 0, 0);
#pragma unroll
                for (int jj = 0; jj < 4; ++jj) BuW[(fq * 4 + jj) * BUP + nt * 16 + fr] = acc[jj]; }
            asm volatile("s_waitcnt lgkmcnt(0)" ::: "memory");
#pragma unroll
            for (int ii = 0; ii < 16; ++ii) { const int tl = dir ? 15 - ii : ii; const f32x2 b2 = *(const f32x2*)(BuW + tl * BUP + 2 * p);
                f32x2 ns = __builtin_elementwise_fma((f32x2){ab_re, ab_re}, (f32x2){sr, si}, b2); ns = __builtin_elementwise_fma((f32x2){-ab_im, ab_im}, (f32x2){si, sr}, ns); sr = ns[0]; si = ns[1];
                if (PASS == 1) *(unsigned*)(STw + tl * 136 + 2 * p) = cvt_pk_bf16(sr, si); }
            if (PASS == 1) {
                asm volatile("s_waitcnt lgkmcnt(0)" ::: "memory");
                f32x4 acc = {0.f, 0.f, 0.f, 0.f};
#pragma unroll
                for (int ks = 0; ks < 4; ++ks) acc = __builtin_amdgcn_mfma_f32_16x16x32_bf16(*(const bf16x8*)(STw + fr * 136 + ks * 32 + fq * 8), cm[ks], acc, 0, 0, 0);
                yacc[k] = acc;
            }
            asm volatile("s_waitcnt lgkmcnt(0)" ::: "memory");
        }
        if (PASS == 0) { S5LOC[((size_t)(dir * NCH + c) * 64 + g) * 64 + p] = make_float2(sr, si); }
        else {
            __syncthreads();
            if (dir == 0) {
#pragma unroll
                for (int k = 0; k < 8; ++k)
#pragma unroll
                    for (int jj = 0; jj < 4; ++jj) YL[gl * 2048 + (k * 16 + fq * 4 + jj) * 16 + fr] = yacc[k][jj]; }
            __syncthreads();
            if (dir == 1) {
#pragma unroll
                for (int k = 0; k < 8; ++k)
#pragma unroll
                    for (int jj = 0; jj < 4; ++jj) YL[gl * 2048 + ((7 - k) * 16 + fq * 4 + jj) * 16 + fr] += yacc[k][jj]; }
            __syncthreads();
            const int t = tid >> 2, q = tid & 3; const float* y = YL + q * 2048 + t * 16; const float* dd = a.in[14] + (size_t)layer * 1024 + gq * 64 + q * 16;
            const bf16_t* us = U5 + (size_t)(row0 + t) * 1024 + gq * 64 + q * 16; const u32x4 u0 = *(const u32x4*)us, u1 = *(const u32x4*)(us + 8);
            const float u[16] = {bflo(u0.x), bfhi(u0.x), bflo(u0.y), bfhi(u0.y), bflo(u0.z), bfhi(u0.z), bflo(u0.w), bfhi(u0.w), bflo(u1.x), bfhi(u1.x), bflo(u1.y), bfhi(u1.y), bflo(u1.z), bfhi(u1.z), bflo(u1.w), bfhi(u1.w)};
            f32x4 dq[4], yq[4];
#pragma unroll
            for (int j = 0; j < 4; ++j) { dq[j] = *(const f32x4*)(dd + 4 * j); yq[j] = *(const f32x4*)(y + 4 * j); }
            __builtin_amdgcn_sched_barrier(0);
            unsigned o[8];
#pragma unroll
            for (int j = 0; j < 8; ++j) { const int e0 = 2 * j, e1 = 2 * j + 1; const float y0 = yq[e0 >> 2][e0 & 3] + u[e0] * dq[e0 >> 2][e0 & 3], y1 = yq[e1 >> 2][e1 & 3] + u[e1] * dq[e1 >> 2][e1 & 3]; o[j] = cvt_pk_bf16(gelu_tanh(y0), gelu_tanh(y1)); }
            bf16_t* dst = Y5 + (size_t)(row0 + t) * 1024 + gq * 64 + q * 16; u32x4 o0, o1; o0.x = o[0]; o0.y = o[1]; o0.z = o[2]; o0.w = o[3]; o1.x = o[4]; o1.y = o[5]; o1.z = o[6]; o1.w = o[7];
            *(u32x4*)dst = o0; *(u32x4*)(dst + 8) = o1;
        }
    }
    __syncthreads();
}

__device__ __forceinline__ int ssd_chunk_at(int dir, int q) { return s5_chunk_at(dir, q); }
__device__ __forceinline__ void conv8(const bf16_t* XBC, int rowbase, int l0, int ch, bool lo_ok, bool hi_ok, float w0, float w1, float w2, float b, float (&out)[8]) {
    float r[10];
#pragma unroll
    for (int i = 0; i < 10; ++i) { const int l = l0 - 1 + i; const bool ok = (l >= 0 || lo_ok) && (l < 128 || hi_ok); r[i] = ok ? bf2f((unsigned)XBC[(size_t)(rowbase + l) * 3072 + ch]) : 0.f; }
#pragma unroll
    for (int j = 0; j < 8; ++j) out[j] = silu_(w0 * r[j] + w1 * r[j + 1] + w2 * r[j + 2] + b);
}
__device__ __forceinline__ void stage_conv_tile(const bf16_t* XBC, const float* cw, const float* cb, int rowbase, int chbase, bool lo_ok, bool hi_ok, bf16_t* dst, int tid) {
    const int oc = tid & 15, ch = chbase + oc * 8; float w[3][8], b[8];
#pragma unroll
    for (int k = 0; k < 3; ++k) { const f32x4 a0 = *(const f32x4*)(cw + (size_t)k * 3072 + ch), a1 = *(const f32x4*)(cw + (size_t)k * 3072 + ch + 4);
        w[k][0] = a0[0]; w[k][1] = a0[1]; w[k][2] = a0[2]; w[k][3] = a0[3]; w[k][4] = a1[0]; w[k][5] = a1[1]; w[k][6] = a1[2]; w[k][7] = a1[3]; }
    { const f32x4 a0 = *(const f32x4*)(cb + ch), a1 = *(const f32x4*)(cb + ch + 4); b[0] = a0[0]; b[1] = a0[1]; b[2] = a0[2]; b[3] = a0[3]; b[4] = a1[0]; b[5] = a1[1]; b[6] = a1[2]; b[7] = a1[3]; }
    u32x4 gl[4][3];
#pragma unroll
    for (int i = 0; i < 4; ++i) { const int row = (tid >> 4) + i * 32;
#pragma unroll
        for (int d = 0; d < 3; ++d) { const bool ok = d == 1 ? true : (d == 0 ? (row > 0 || lo_ok) : (row < 127 || hi_ok)); const int l = ok ? row + d - 1 : row;
            gl[i][d] = *(const u32x4*)(XBC + (size_t)(rowbase + l) * 3072 + ch); } }
    __builtin_amdgcn_sched_barrier(0);
#pragma unroll
    for (int i = 0; i < 4; ++i) { const int row = (tid >> 4) + i * 32; float acc[8];
#pragma unroll
        for (int k = 0; k < 8; ++k) acc[k] = b[k];
#pragma unroll
        for (int d = 0; d < 3; ++d) { const bool ok = d == 1 ? true : (d == 0 ? (row > 0 || lo_ok) : (row < 127 || hi_ok));
            { u32x4 g = gl[i][d]; if (!ok) g = (u32x4){0u, 0u, 0u, 0u};
                acc[0] += w[d][0] * bflo(g.x); acc[1] += w[d][1] * bfhi(g.x); acc[2] += w[d][2] * bflo(g.y); acc[3] += w[d][3] * bfhi(g.y);
                acc[4] += w[d][4] * bflo(g.z); acc[5] += w[d][5] * bfhi(g.z); acc[6] += w[d][6] * bflo(g.w); acc[7] += w[d][7] * bfhi(g.w); } }
        u32x4 o; o.x = cvt_pk_bf16(silu_(acc[0]), silu_(acc[1])); o.y = cvt_pk_bf16(silu_(acc[2]), silu_(acc[3])); o.z = cvt_pk_bf16(silu_(acc[4]), silu_(acc[5])); o.w = cvt_pk_bf16(silu_(acc[6]), silu_(acc[7]));
        *(u32x4*)(dst + row * 136 + oc * 8) = o; }
}
constexpr int SL_CS = 0, SL_CB = 34816, SL_CUM = 69632, SL_DT = 77824, SL_PART = 86016, SL_BS = 94208, SL_XT = 94208;
template <int AUX> __device__ __forceinline__ void ssd_cum(const Args& a, int layer, int c, int h, int w, int lane, unsigned char* lds) {
    const float* DT = (const float*)(a.ws + WS_BIG + B_DT); float* cumL = (float*)(lds + SL_CUM); float* dtL = (float*)(lds + SL_DT); float* CHD = (float*)(a.ws + WS_CHD);
#pragma unroll
    for (int dir = 0; dir < 2; ++dir) {
        const float ah = -expf(a.in[20][(size_t)(layer * 2 + dir) * 32 + h]);
        const float d0 = DT[(size_t)(c * 128 + 2 * lane) * 64 + dir * 32 + h], d1 = DT[(size_t)(c * 128 + 2 * lane + 1) * 64 + dir * 32 + h];
        const float l0 = d0 * ah, l1 = d1 * ah, s = l0 + l1; float incl = s;
#pragma unroll
        for (int o = 1; o < 64; o <<= 1) { const float t = __shfl_up(incl, o); if (lane >= o) incl += t; }
        const float excl = incl - s, tot = __shfl(incl, 63);
        float c0, c1;
        if (dir == 0) { c0 = excl + l0; c1 = incl; } else { c0 = tot - excl; c1 = tot - (excl + l0); }
        float* cu = cumL + (dir * 8 + w) * 128 + 2 * lane; cu[0] = c0; cu[1] = c1;
        float* dd = dtL + (dir * 8 + w) * 128 + 2 * lane;
        if (AUX == 0) { dd[0] = d0; dd[1] = d1; } else { dd[0] = d0 * __expf(tot - c0); dd[1] = d1 * __expf(tot - c1); if (lane == 0) CHD[(size_t)(dir * NCH + c) * 32 + h] = tot; }
    }
}
__device__ __forceinline__ void stage_T(const bf16_t* XBC, const float* cw, const float* cb, int rowbase, int ch, int r0, bool lo_ok, bool hi_ok, bf16_t* dstT) {
    float w[3][8], b[8];
#pragma unroll
    for (int k = 0; k < 3; ++k) { const f32x4 a0 = *(const f32x4*)(cw + (size_t)k * 3072 + ch), a1 = *(const f32x4*)(cw + (size_t)k * 3072 + ch + 4);
        w[k][0] = a0[0]; w[k][1] = a0[1]; w[k][2] = a0[2]; w[k][3] = a0[3]; w[k][4] = a1[0]; w[k][5] = a1[1]; w[k][6] = a1[2]; w[k][7] = a1[3]; }
    { const f32x4 a0 = *(const f32x4*)(cb + ch), a1 = *(const f32x4*)(cb + ch + 4); b[0] = a0[0]; b[1] = a0[1]; b[2] = a0[2]; b[3] = a0[3]; b[4] = a1[0]; b[5] = a1[1]; b[6] = a1[2]; b[7] = a1[3]; }
    u32x4 raw[10];
    const bf16_t* base = XBC + (size_t)(rowbase + r0) * 3072 + ch;
    const bool ok0 = r0 > 0 || lo_ok, ok9 = r0 < 120 || hi_ok;
#pragma unroll
    for (int i = 1; i < 9; ++i) raw[i] = *(const u32x4*)(base + (i - 1) * 3072);
    raw[0] = *(const u32x4*)(base + (ok0 ? -3072 : 0)); raw[9] = *(const u32x4*)(base + (ok9 ? 8 * 3072 : 7 * 3072));
    __builtin_amdgcn_sched_barrier(0);
    if (!ok0) raw[0] = (u32x4){0u, 0u, 0u, 0u};
    if (!ok9) raw[9] = (u32x4){0u, 0u, 0u, 0u};
    float sp[8]; unsigned o[8][4];
#pragma unroll
    for (int r = 0; r < 8; ++r) { float sv[8];
#pragma unroll
        for (int k = 0; k < 8; ++k) { float acc = b[k];
#pragma unroll
            for (int d = 0; d < 3; ++d) { const unsigned wd = k < 2 ? raw[r + d].x : (k < 4 ? raw[r + d].y : (k < 6 ? raw[r + d].z : raw[r + d].w)); acc += w[d][k] * ((k & 1) ? bfhi(wd) : bflo(wd)); }
            sv[k] = silu_(acc); }
        if (r & 1) {
#pragma unroll
            for (int k = 0; k < 8; ++k) o[k][r >> 1] = cvt_pk_bf16(sp[k], sv[k]); }
        else {
#pragma unroll
            for (int k = 0; k < 8; ++k) sp[k] = sv[k]; } }
#pragma unroll
    for (int k = 0; k < 8; ++k) { u32x4 v; v.x = o[k][0]; v.y = o[k][1]; v.z = o[k][2]; v.w = o[k][3]; *(u32x4*)(dstT + k * 136 + r0) = v; }
}
__device__ __forceinline__ void ssd_a_phase(const Args& a, int layer, unsigned char* lds, int tid) {
    const bf16_t* XBC = (const bf16_t*)(a.ws + WS_BIG + B_XBC); bf16_t* SST = (bf16_t*)(a.ws + WS_SST);
    const float* cw = a.in[17] + (size_t)layer * 3 * 3072; const float* cb = a.in[18] + (size_t)layer * 3072;
    bf16_t* BT = (bf16_t*)(lds + SL_CS); bf16_t* xT = (bf16_t*)(lds + SL_XT); const float* wL = (const float*)(lds + SL_DT);
    for (int unit = (blockIdx.x + (gridDim.x >> 1)) % gridDim.x; unit < NCH * 4; unit += gridDim.x) {
        int tl = tid; asm volatile("" : "+v"(tl));
        const int lane = tl & 63, w = __builtin_amdgcn_readfirstlane(tl >> 6), fr = lane & 15, fq = lane >> 4, og = lane & 7, rr = lane >> 3;
        const int c = unit >> 2, g = unit & 3, rowbase = c * 128; const bool lo_ok = !(c == 0 || c == 128), hi_ok = !(c == 127 || c == 129);
        __syncthreads();
        if (w < 4) { const int oct = (w & 1) * 8 + og; stage_T(XBC, cw, cb, rowbase, 2048 + g * 128 + oct * 8, ((w >> 1) * 8 + rr) * 8, lo_ok, hi_ok, BT + (oct * 8) * 136); }
        ssd_cum<1>(a, layer, c, g * 8 + w, w, lane, lds);
#pragma unroll 1
        for (int pass = 0; pass < 2; ++pass) {
            if (pass) __syncthreads();
            { const int hs = w & 3; stage_T(XBC, cw, cb, rowbase, (g * 8 + pass * 4 + hs) * 64 + og * 8, ((w >> 2) * 8 + rr) * 8, lo_ok, hi_ok, xT + ((hs * 64 + og * 8) * 136)); }
            __syncthreads();
            const int hl = w >> 1, dir = w & 1, hh = pass * 4 + hl, h = g * 8 + hh;
            bf16_t* sb = SST + (((size_t)(dir * NCH + c) * 32 + h) * 64) * 128;
#pragma unroll 1
            for (int nh = 0; nh < 2; ++nh) {
                f32x4 acc[4][4];
#pragma unroll
                for (int pt = 0; pt < 4; ++pt)
#pragma unroll
                    for (int nt = 0; nt < 4; ++nt) acc[pt][nt] = (f32x4){0.f, 0.f, 0.f, 0.f};
#pragma unroll
                for (int ks = 0; ks < 4; ++ks) {
                    const float* wp = wL + (dir * 8 + hh) * 128 + ks * 32 + fq * 8; const f32x4 wl0 = *(const f32x4*)wp, wl1 = *(const f32x4*)(wp + 4);
                    bf16x8 yf[4];
#pragma unroll
                    for (int pt = 0; pt < 4; ++pt) { const u32x4 xr = *(const u32x4*)(xT + ((hl * 64 + pt * 16 + fr) * 136 + ks * 32 + fq * 8));
                        yf[pt] = mkfrag(cvt_pk_bf16(bflo(xr.x) * wl0[0], bfhi(xr.x) * wl0[1]), cvt_pk_bf16(bflo(xr.y) * wl0[2], bfhi(xr.y) * wl0[3]), cvt_pk_bf16(bflo(xr.z) * wl1[0], bfhi(xr.z) * wl1[1]), cvt_pk_bf16(bflo(xr.w) * wl1[2], bfhi(xr.w) * wl1[3])); }
#pragma unroll
                    for (int nt = 0; nt < 4; ++nt) { const bf16x8 xf = *(const bf16x8*)(BT + ((nh * 4 + nt) * 16 + fr) * 136 + ks * 32 + fq * 8);
#pragma unroll
                        for (int pt = 0; pt < 4; ++pt) acc[pt][nt] = __builtin_amdgcn_mfma_f32_16x16x32_bf16(xf, yf[pt], acc[pt][nt], 0, 0, 0); }
                }
#pragma unroll
                for (int pt = 0; pt < 4; ++pt) mfma_settle(acc[pt][3]);
#pragma unroll
                for (int pt = 0; pt < 4; ++pt)
#pragma unroll
                    for (int nt = 0; nt < 4; ++nt) { u32x2 o; o.x = cvt_pk_native(acc[pt][nt][0], acc[pt][nt][1]); o.y = cvt_pk_native(acc[pt][nt][2], acc[pt][nt][3]);
                        *(u32x2*)(sb + (size_t)(pt * 16 + fr) * 128 + (nh * 4 + nt) * 16 + fq * 4) = o; }
            }
        }
    }
    __syncthreads();
}
__device__ __forceinline__ void ssd_b_phase(const Args& a, int tid) {
    bf16_t* SST = (bf16_t*)(a.ws + WS_SST); const float* CHD = (const float*)(a.ws + WS_CHD);
    for (int idx = blockIdx.x * 512 + tid; idx < 64 * 2048; idx += gridDim.x * 512) {
        const int e4 = idx & 2047, hd = idx >> 11, dir = hd >> 5, h = hd & 31; float s0 = 0.f, s1 = 0.f, s2 = 0.f, s3 = 0.f;
#pragma unroll 1
        for (int b = 0; b < 13; ++b) { u32x2 loc[10]; float dc[10];
#pragma unroll
            for (int i = 0; i < 10; ++i) { const int cq = ssd_chunk_at(dir, b * 10 + i); loc[i] = *(const u32x2*)(SST + ((size_t)(dir * NCH + cq) * 32 + h) * 8192 + e4 * 4); dc[i] = CHD[(size_t)(dir * NCH + cq) * 32 + h]; }
#pragma unroll
            for (int i = 0; i < 10; ++i) { const int cq = ssd_chunk_at(dir, b * 10 + i); u32x2 o; o.x = cvt_pk_bf16(s0, s1); o.y = cvt_pk_bf16(s2, s3);
                *(u32x2*)(SST + ((size_t)(dir * NCH + cq) * 32 + h) * 8192 + e4 * 4) = o; const float e = __expf(dc[i]);
                s0 = e * s0 + bflo(loc[i].x); s1 = e * s1 + bfhi(loc[i].x); s2 = e * s2 + bflo(loc[i].y); s3 = e * s3 + bfhi(loc[i].y); }
        }
    }
}
__device__ __forceinline__ void ssd_c_phase(const Args& a, int layer, unsigned char* lds, int tid, int nchunks) {
    const bf16_t* XBC = (const bf16_t*)(a.ws + WS_BIG + B_XBC); const bf16_t* SST = (const bf16_t*)(a.ws + WS_SST); const bf16_t* Z = (const bf16_t*)(a.ws + WS_BIG + B_Z); bf16_t* YD = (bf16_t*)(a.ws + WS_BIG + B_YD);
    const float* cw = a.in[17] + (size_t)layer * 3 * 3072; const float* cb = a.in[18] + (size_t)layer * 3072; const float* normw = a.in[22] + (size_t)layer * 2048;
    bf16_t* Cs = (bf16_t*)(lds + SL_CS); bf16_t* Bs = (bf16_t*)(lds + SL_BS); bf16_t* CBs = (bf16_t*)(lds + SL_CB); bf16_t* xT = (bf16_t*)(lds + SL_XT);
    const float* cumL = (const float*)(lds + SL_CUM); const float* dtL = (const float*)(lds + SL_DT); float* part = (float*)(lds + SL_PART);
    for (int unit = (blockIdx.x + (gridDim.x >> 1)) % gridDim.x; unit < nchunks * 4; unit += gridDim.x) {
        int tl = tid; asm volatile("" : "+v"(tl));
        const int lane = tl & 63, w = __builtin_amdgcn_readfirstlane(tl >> 6), fr = lane & 15, fq = lane >> 4, og = lane & 7, rr = lane >> 3;
        const int hl = w & 3, lh = w >> 2;
        const int c = unit >> 2, g = unit & 3, rowbase = c * 128; const bool lo_ok = !(c == 0 || c == 128), hi_ok = !(c == 127 || c == 129);
        __syncthreads();
        stage_conv_tile(XBC, cw, cb, rowbase, 2560 + g * 128, lo_ok, hi_ok, Cs, tl);
        stage_conv_tile(XBC, cw, cb, rowbase, 2048 + g * 128, lo_ok, hi_ok, Bs, tl);
        ssd_cum<0>(a, layer, c, g * 8 + w, w, lane, lds);
        __syncthreads();
#pragma unroll 1
        for (int st = 0; st < 8; ++st) { f32x4 acc = {0.f, 0.f, 0.f, 0.f};
#pragma unroll
            for (int ks = 0; ks < 4; ++ks) { const bf16x8 xf = *(const bf16x8*)(Bs + (st * 16 + fr) * 136 + ks * 32 + fq * 8), yf = *(const bf16x8*)(Cs + (w * 16 + fr) * 136 + ks * 32 + fq * 8);
                acc = __builtin_amdgcn_mfma_f32_16x16x32_bf16(xf, yf, acc, 0, 0, 0); }
            mfma_settle(acc);
            u32x2 o; o.x = cvt_pk_native(acc[0], acc[1]); o.y = cvt_pk_native(acc[2], acc[3]); *(u32x2*)(CBs + (w * 16 + fr) * 136 + st * 16 + fq * 4) = o; }
#pragma unroll 1
        for (int pass = 0; pass < 2; ++pass) {
            __syncthreads();
            stage_T(XBC, cw, cb, rowbase, (g * 8 + pass * 4 + hl) * 64 + og * 8, (lh * 8 + rr) * 8, lo_ok, hi_ok, xT + ((hl * 64 + og * 8) * 136));
            __syncthreads();
            const int hh = pass * 4 + hl, h = g * 8 + hh; const float Dh = a.in[21][(size_t)layer * 32 + h];
#pragma unroll 1
            for (int ih = 0; ih < 2; ++ih) {
            f32x4 acc[2][4]; u32x2 zq[2][4];
#pragma unroll
            for (int i = 0; i < 2; ++i)
#pragma unroll
                for (int pt = 0; pt < 4; ++pt) { acc[i][pt] = (f32x4){0.f, 0.f, 0.f, 0.f};
                    zq[i][pt] = *(const u32x2*)(Z + (size_t)(rowbase + (lh * 4 + ih * 2 + i) * 16 + fr) * 2048 + h * 64 + pt * 16 + fq * 4); }
#pragma unroll
            for (int dir = 0; dir < 2; ++dir) {
                const bf16_t* sb = SST + (((size_t)(dir * NCH + c) * 32 + h) * 64) * 128;
                f32x4 tmp[2][4];
#pragma unroll
                for (int i = 0; i < 2; ++i)
#pragma unroll
                    for (int pt = 0; pt < 4; ++pt) tmp[i][pt] = (f32x4){0.f, 0.f, 0.f, 0.f};
#pragma unroll
                for (int ks = 0; ks < 4; ++ks) { const int lb = (lh * 4 + ih * 2) * 16 + fr; bf16x8 sfr[4];
#pragma unroll
                    for (int pt = 0; pt < 4; ++pt) sfr[pt] = *(const bf16x8*)(sb + (size_t)(pt * 16 + fr) * 128 + ks * 32 + fq * 8);
                    const bf16x8 yf0 = *(const bf16x8*)(Cs + lb * 136 + ks * 32 + fq * 8), yf1 = *(const bf16x8*)(Cs + (lb + 16) * 136 + ks * 32 + fq * 8);
                    __builtin_amdgcn_sched_barrier(0);
#pragma unroll
                    for (int pt = 0; pt < 4; ++pt) {
                        tmp[0][pt] = __builtin_amdgcn_mfma_f32_16x16x32_bf16(sfr[pt], yf0, tmp[0][pt], 0, 0, 0); tmp[1][pt] = __builtin_amdgcn_mfma_f32_16x16x32_bf16(sfr[pt], yf1, tmp[1][pt], 0, 0, 0); } }
#pragma unroll
                for (int i = 0; i < 2; ++i) { int frv = fr; asm volatile("" : "+v"(frv));
                    const int lt = lh * 4 + ih * 2 + i, l = lt * 16 + frv;
                    const float cl = cumL[(dir * 8 + hh) * 128 + l], el = __expf(cl);
#pragma unroll
                    for (int pt = 0; pt < 4; ++pt) acc[i][pt] += tmp[i][pt] * el;
#pragma unroll
                    for (int ks = 0; ks < 4; ++ks) { const int s0 = ks * 32;
                        const bool skip = dir == 0 ? (s0 > lt * 16 + 15) : (s0 + 31 < lt * 16);
                        if (!skip) { const u32x4 cbv = *(const u32x4*)(CBs + l * 136 + s0 + fq * 8);
                            const float* cp = cumL + (dir * 8 + hh) * 128 + s0 + fq * 8; const float* dp = dtL + (dir * 8 + hh) * 128 + s0 + fq * 8;
                            const f32x4 c0 = *(const f32x4*)cp, c1 = *(const f32x4*)(cp + 4), d0 = *(const f32x4*)dp, d1 = *(const f32x4*)(dp + 4);
                            float cbf[8] = {bflo(cbv.x), bfhi(cbv.x), bflo(cbv.y), bfhi(cbv.y), bflo(cbv.z), bfhi(cbv.z), bflo(cbv.w), bfhi(cbv.w)}; float v[8];
#pragma unroll
                            for (int j = 0; j < 8; ++j) { const int sx = s0 + fq * 8 + j; const float cs = j < 4 ? c0[j & 3] : c1[j & 3], ds = j < 4 ? d0[j & 3] : d1[j & 3];
                                const bool valid = dir == 0 ? (sx <= l) : (sx >= l); float t = valid ? cbf[j] * __expf(fminf(cl - cs, 0.f)) * ds : 0.f; if (dir == 0 && sx == l) t += Dh; v[j] = t; }
                            const bf16x8 yf = mkfrag(cvt_pk_bf16(v[0], v[1]), cvt_pk_bf16(v[2], v[3]), cvt_pk_bf16(v[4], v[5]), cvt_pk_bf16(v[6], v[7]));
#pragma unroll
                            for (int pt = 0; pt < 4; ++pt) acc[i][pt] = __builtin_amdgcn_mfma_f32_16x16x32_bf16(*(const bf16x8*)(xT + ((hl * 64 + pt * 16 + fr) * 136 + s0 + fq * 8)), yf, acc[i][pt], 0, 0, 0); } }
                }
            }
#pragma unroll
            for (int i = 0; i < 2; ++i) { const int l = (lh * 4 + ih * 2 + i) * 16 + fr; const size_t row = (size_t)(rowbase + l); float ss = 0.f;
#pragma unroll
                for (int pt = 0; pt < 4; ++pt) { const int ch = h * 64 + pt * 16 + fq * 4; const u32x2 zz = zq[i][pt];
                    const float h0 = acc[i][pt][0] * silu_(bflo(zz.x)), h1 = acc[i][pt][1] * silu_(bfhi(zz.x)), h2 = acc[i][pt][2] * silu_(bflo(zz.y)), h3 = acc[i][pt][3] * silu_(bfhi(zz.y));
                    ss += (h0 * h0 + h1 * h1) + (h2 * h2 + h3 * h3); u32x2 o; o.x = cvt_pk_bf16(h0, h1); o.y = cvt_pk_bf16(h2, h3); *(u32x2*)(YD + row * 2048 + ch) = o; }
                ss += __shfl_xor(ss, 16); ss += __shfl_xor(ss, 32);
                if (fq == 0) part[hh * 128 + l] = ss; }
            }
        }
        __syncthreads();
#pragma unroll 1
        for (int it = 0; it < 8; ++it) { const int pass = it >> 2, i = it & 3, l = (lh * 4 + i) * 16 + fr, h = g * 8 + pass * 4 + hl; float tot = 0.f;
#pragma unroll
            for (int hd = 0; hd < 8; ++hd) tot += part[hd * 128 + l];
            const float r = __builtin_amdgcn_rsqf(tot * (1.f / 512.f) + RMS_EPS); const size_t row = (size_t)(rowbase + l);
            u32x2 hq[4]; f32x4 nq[4];
#pragma unroll
            for (int pt = 0; pt < 4; ++pt) { const int ch = h * 64 + pt * 16 + fq * 4; hq[pt] = *(const u32x2*)(YD + row * 2048 + ch); nq[pt] = *(const f32x4*)(normw + ch); }
            __builtin_amdgcn_sched_barrier(0);
#pragma unroll
            for (int pt = 0; pt < 4; ++pt) { const int ch = h * 64 + pt * 16 + fq * 4; bf16_t* yp = YD + row * 2048 + ch; const u32x2 hv = hq[pt]; const f32x4 nw = nq[pt];
                u32x2 o; o.x = cvt_pk_bf16(bflo(hv.x) * r * nw[0], bfhi(hv.x) * r * nw[1]); o.y = cvt_pk_bf16(bflo(hv.y) * r * nw[2], bfhi(hv.y) * r * nw[3]); *(u32x2*)yp = o; }
            __builtin_amdgcn_sched_barrier(0); }
    }
    __syncthreads();
}

#define LAS __attribute__((address_space(3)))
#define XB_TMO      128
#define XB_XCNT(j)  (256  + 64 * (j))
#define XB_XSUB(j)  (1280 + 64 * (j))
#define XB_XGEN(j)  (2304 + 64 * (j))
#define XB_TOP      3328
#define XB_TOPGEN   3392
#define XCD_BAR_WORDS 3456
#define XB_SPIN_CAP (1u << 18)

__device__ __forceinline__ unsigned xb_ld(unsigned* p)              { return __hip_atomic_load(p, __ATOMIC_RELAXED, __HIP_MEMORY_SCOPE_AGENT); }
__device__ __forceinline__ unsigned xb_add(unsigned* p, unsigned v) { return __hip_atomic_fetch_add(p, v, __ATOMIC_RELAXED, __HIP_MEMORY_SCOPE_AGENT); }
__device__ __forceinline__ unsigned xb_xcc_id() { return (unsigned)__builtin_amdgcn_s_getreg((3 << 11) | 20) & 0xFu; }
#define XB_SPIN(cond, bar) do { unsigned _sp = 0; while (cond) { __builtin_amdgcn_s_sleep(1); \
    if ((++_sp & 255u) == 0u) { if (xb_ld(&(bar)[XB_TMO])) break; if (_sp > XB_SPIN_CAP) { atomicAdd(&(bar)[XB_TMO], 1u); break; } } } } while (0)

struct XcdBarrier {
    unsigned* bar; unsigned x;
    volatile LAS unsigned* st;
};

__device__ __forceinline__ XcdBarrier xcd_barrier_post(unsigned* bar, volatile LAS unsigned* st) {
    XcdBarrier b; b.bar = bar; b.x = xb_xcc_id(); b.st = st;
    if (threadIdx.x == 0) (void)xb_add(&bar[XB_XCNT(b.x)], 1u);
    return b;
}
__device__ __forceinline__ void xcd_barrier_complete(unsigned* bar, unsigned x, unsigned& nloc, unsigned& nx) {
    const unsigned G = gridDim.x * gridDim.y * gridDim.z;
    unsigned sum, cnt, mine, sp = 0u;
    for (;;) {
        sum = 0u; cnt = 0u; mine = 0u;
#pragma unroll
        for (unsigned j = 0; j < 16; ++j) { const unsigned c = xb_ld(&bar[XB_XCNT(j)]); sum += c; cnt += (c > 0u) ? 1u : 0u; mine = (j == x) ? c : mine; }
        if (sum == G) break;
        __builtin_amdgcn_s_sleep(1);
        if ((++sp & 255u) == 0u) { if (xb_ld(&bar[XB_TMO])) break; if (sp > XB_SPIN_CAP) { atomicAdd(&bar[XB_TMO], 1u); break; } }
    }
    nloc = mine > 0u ? mine : 1u; nx = cnt > 0u ? cnt : 1u;
}

__device__ __forceinline__ void xcd_barrier(const XcdBarrier& b) {
    asm volatile("s_waitcnt vmcnt(0)" ::: "memory");
    __syncthreads();
    if (threadIdx.x == 0) {
        unsigned* bar = b.bar;
        __builtin_amdgcn_s_waitcnt(0);
        unsigned nloc = b.st[0], nx = b.st[1];
        if (nloc == 0u) { xcd_barrier_complete(bar, b.x, nloc, nx); b.st[0] = nloc; b.st[1] = nx; }
        const unsigned old = xb_add(&bar[XB_XSUB(b.x)], 1u);
        const unsigned gen = old / nloc;
        if (old + 1u == (gen + 1u) * nloc) {
            __builtin_amdgcn_fence(__ATOMIC_RELEASE, "agent");
            asm volatile("s_waitcnt vmcnt(0)" ::: "memory");
            const unsigned og = xb_add(&bar[XB_TOP], 1u);
            const unsigned tg = og / nx;
            if (og + 1u == (tg + 1u) * nx) xb_add(&bar[XB_TOPGEN], 1u);
            else XB_SPIN(xb_ld(&bar[XB_TOPGEN]) == tg, bar);
            __builtin_amdgcn_fence(__ATOMIC_ACQUIRE, "agent");
            xb_add(&bar[XB_XGEN(b.x)], 1u);
            asm volatile("s_waitcnt vmcnt(0)" ::: "memory");
        } else {
            XB_SPIN(xb_ld(&bar[XB_XGEN(b.x)]) == gen, bar);
            __builtin_amdgcn_fence(__ATOMIC_ACQUIRE, "agent");
            asm volatile("s_waitcnt vmcnt(0)" ::: "memory");
        }
    }
    __syncthreads();
}

#ifndef MK_REP_S5
#define MK_REP_S5 1
#endif
#ifndef MK_REP_SSD
#define MK_REP_SSD 1
#endif
#ifndef MK_REP_SYNC
#define MK_REP_SYNC 1
#endif
#ifndef MK_CG_SYNC_ALL
#define MK_CG_SYNC_ALL 0
#endif
#ifndef MK_REP_PRO
#define MK_REP_PRO 1
#endif
#ifndef MK_REP_GEMM
#define MK_REP_GEMM 1
#endif
constexpr int NPHASE = 2 + 11 * 2;
__global__ void __launch_bounds__(512, 2) fwd_megakernel(Args a) {
    extern __shared__ __attribute__((aligned(16))) unsigned char lds[];
    PG8_LAS unsigned char* lds3 = (PG8_LAS unsigned char*)lds;
    unsigned char* big = a.ws + WS_BIG;
    volatile LAS unsigned* bst = (volatile LAS unsigned*)(lds3 + (LDS_BYTES - 16));
    if (threadIdx.x < 4) bst[threadIdx.x] = 0u;
    __syncthreads();
    XcdBarrier xbar; xbar.bar = (unsigned*)(a.ws + WS_BAR); xbar.x = 0; xbar.st = bst;
    if (a.ph_hi - a.ph_lo > 1) xbar = xcd_barrier_post((unsigned*)(a.ws + WS_BAR), bst);
    for (int ph = a.ph_lo; ph < a.ph_hi; ++ph) {
        const int tid = pg8::pg8_tid(), lane = tid & 63, wave = tid >> 6, gw = blockIdx.x * 8 + wave, NGW = gridDim.x * 8;
        if (ph == 0) {
            for (int rep = 0; rep < MK_REP_PRO; ++rep) {
            adaln_phase(a, (float*)lds, tid);
            float* scr = (float*)lds + wave * (64 * 33);
            xpose_region(a, 0, 0, scr, gw, NGW, lane); xpose_region(a, 0, 1, scr, gw, NGW, lane); __syncthreads(); }
        } else if (ph == 1) {
            row_phase<0>(a, MT, nullptr, nullptr, 0, 0, gw, NGW, lane);
        } else {
            const int layer = (ph - 2) / 11, k = (ph - 2) % 11; const bool last = layer == 1; const int Mrows = last ? TL : MT;
            const bf16_t* WA = (const bf16_t*)(a.ws + WS_WA); const bf16_t* WB = (const bf16_t*)(a.ws + WS_WB);
#ifdef MK_SKIP_MASK
            if ((MK_SKIP_MASK >> k) & 1) { if (ph + 1 < a.ph_hi) xcd_barrier(xbar); continue; }
#endif
            if (k == 0) {
                pg8::Gemm g{(const bf16_t*)(a.ws + WS_XM), WA + WA_IN / 2, MT, NPROJ, D}; pg8::StaticOrder S; S.init(MT, NPROJ, gridDim.x, blockIdx.x);
                EpiInProj E{big, a.in[19] + (size_t)layer * 64}; for (int rep = 0; rep < MK_REP_GEMM; ++rep) { pg8::gemm_phase<EpiInProj, pg8::StaticOrder>(lds3, g, S, E, nullptr); __syncthreads(); }
            } else if (k == 1) {
                for (int rep = 0; rep < MK_REP_SSD; ++rep) ssd_a_phase(a, layer, lds, tid);
                for (int rep = 0; rep < MK_REP_S5; ++rep) s5_phase<0>(a, layer, lds, tid, NCH);
            } else if (k == 2) {
#if !defined(MK_NO_SSD) && !defined(MK_NO_SSDB)
                ssd_b_phase(a, tid);
#endif
                for (int rep = 0; rep < MK_REP_S5; ++rep) s5_phase<1>(a, layer, lds, tid, last ? 128 : NCH);
            } else if (k == 3) {
                for (int rep = 0; rep < MK_REP_SSD; ++rep) ssd_c_phase(a, layer, lds, tid, last ? 128 : NCH);
#ifndef MK_NO_S5
                pg8::Gemm g{(const bf16_t*)(big + B_Y5), WA + WA_GLU / 2, Mrows, 2048, 1024}; pg8::StaticOrder S; S.init(Mrows, 2048, gridDim.x, blockIdx.x);
                EpiGlu E{(bf16_t*)(big + B_U5)}; pg8::gemm_phase<EpiGlu, pg8::StaticOrder>(lds3, g, S, E, nullptr);
#endif
            } else if (k == 4) {
#ifndef MK_NO_S5
                { pg8::Gemm g{(const bf16_t*)(big + B_U5), WA + WA_S5P / 2, Mrows, 2048, 1024}; pg8::StaticOrder S; S.init(Mrows, 2048, gridDim.x, blockIdx.x);
                  EpiMerge<0> E{(bf16_t*)(big + B_XBC), (const bf16_t*)(big + B_GATE)}; pg8::gemm_phase<EpiMerge<0>, pg8::StaticOrder>(lds3, g, S, E, nullptr); }
                __syncthreads();
#endif
#ifndef MK_NO_SSD
#ifdef MK_NO_S5
                { pg8::Gemm g{(const bf16_t*)(big + B_YD), WA + WA_SSDP / 2, Mrows, 2048, 2048}; pg8::StaticOrder S; S.init(Mrows, 2048, gridDim.x, blockIdx.x);
                  EpiMerge<0, 1> E{(bf16_t*)(big + B_XBC), (const bf16_t*)(big + B_GATE)}; pg8::gemm_phase<EpiMerge<0, 1>, pg8::StaticOrder>(lds3, g, S, E, nullptr); }
#else
                { pg8::Gemm g{(const bf16_t*)(big + B_YD), WA + WA_SSDP / 2, Mrows, 2048, 2048}; pg8::StaticOrder S; S.init(Mrows, 2048, gridDim.x, blockIdx.x);
                  EpiMerge<1> E{(bf16_t*)(big + B_XBC), (const bf16_t*)(big + B_GATE)}; pg8::gemm_phase<EpiMerge<1>, pg8::StaticOrder>(lds3, g, S, E, nullptr); }
#endif
#endif
            } else if (k == 5) {
                pg8::Gemm g{(const bf16_t*)(big + B_XBC), WA + WA_WOUT / 2, Mrows, 2048, 2048}; pg8::StaticOrder S; S.init(Mrows, 2048, gridDim.x, blockIdx.x);
                EpiResid E{a.out, (float*)(a.ws + WS_HCTX), mvec(a, layer, 0) + 2 * D, mvec(a, layer, 1) + 2 * D}; pg8::gemm_phase<EpiResid, pg8::StaticOrder>(lds3, g, S, E, nullptr);
            } else if (k == 6) {
                row_phase<1>(a, Mrows, a.in[25] + (size_t)layer * D, a.in[26] + (size_t)layer * D, layer, 3 * D, gw, NGW, lane);
                if (!last) for (int rep = 0; rep < MK_REP_PRO; ++rep) { __syncthreads(); xpose_region(a, layer + 1, 0, (float*)lds + wave * (64 * 33), gw, NGW, lane); }
            } else if (k == 7) {
                pg8::Gemm g{(const bf16_t*)(a.ws + WS_XM), WB + WB_UP / 2, Mrows, 2 * DFF, D}; pg8::StaticOrder S; S.init(Mrows, 2 * DFF, gridDim.x, blockIdx.x);
                EpiUp E{(bf16_t*)(big + B_G), (bf16_t*)(big + B_V)}; for (int rep = 0; rep < MK_REP_GEMM; ++rep) { pg8::gemm_phase<EpiUp, pg8::StaticOrder>(lds3, g, S, E, nullptr); __syncthreads(); }
            } else if (k == 8) {
                ffnconv_phase(a, layer, !last, lds, tid);
            } else if (k == 9) {
                pg8::Gemm g{(const bf16_t*)(big + B_V), WB + WB_DOWN / 2, Mrows, D, DFF}; pg8::StaticOrder S; S.init(Mrows, D, gridDim.x, blockIdx.x);
                EpiResid E{a.out, (float*)(a.ws + WS_HCTX), mvec(a, layer, 0) + 5 * D, mvec(a, layer, 1) + 5 * D}; pg8::gemm_phase<EpiResid, pg8::StaticOrder>(lds3, g, S, E, nullptr);
            } else {
                row_phase<1>(a, Mrows, a.in[31] + (size_t)layer * D, a.in[32] + (size_t)layer * D, last ? -1 : layer + 1, 0, gw, NGW, lane);
                if (!last) for (int rep = 0; rep < MK_REP_PRO; ++rep) { __syncthreads(); xpose_region(a, layer + 1, 1, (float*)lds + wave * (64 * 33), gw, NGW, lane); }
            }
        }
        if (ph + 1 < a.ph_hi) { for (int rep = 0; rep < MK_REP_SYNC; ++rep) { if (MK_CG_SYNC_ALL || a.ph_hi > 1000) cg::this_grid().sync(); else xcd_barrier(xbar);     } }
#ifdef MK_TS_MASK
        if (blockIdx.x == 0 && threadIdx.x == 0) ((unsigned long long*)(a.ws + WS_BAR + 65536))[ph + 1] = __builtin_amdgcn_s_memrealtime();
#endif
    }
#ifdef MK_TS_MASK
    if (blockIdx.x == 0 && threadIdx.x == 0) {
        const unsigned long long* ts = (const unsigned long long*)(a.ws + WS_BAR + 65536); unsigned long long sum = 0;
        for (int ph = 1; ph < a.ph_hi - 1; ++ph) if ((MK_TS_MASK >> ph) & 1ull) sum += ts[ph + 1] - ts[ph];
        const unsigned long long t0 = __builtin_amdgcn_s_memrealtime();
        while (__builtin_amdgcn_s_memrealtime() - t0 < sum * MK_TS_AMP) __builtin_amdgcn_s_sleep(8);
    }
#endif
}
}

#ifndef MK_N_LAUNCH_MODE
#define MK_N_LAUNCH_MODE 0
#endif
extern "C" void kernel_launch(void* const* d_in, const int* in_sizes, int n_in, void* d_out, int out_size, void* d_ws, size_t ws_size, hipStream_t stream) {
    static int grid = 0;
    if (grid == 0) {
        if (n_in != 33 || ws_size < mk::WS_END) { fprintf(stderr, "kernel_launch: need 33 inputs and %zu bytes of workspace (got %d, %zu)\n", (size_t)mk::WS_END, n_in, ws_size); grid = -1; return; }
        int dev = 0, cus = 0, per_cu = 0;
        (void)hipGetDevice(&dev); (void)hipDeviceGetAttribute(&cus, hipDeviceAttributeMultiprocessorCount, dev);
        if (hipFuncSetAttribute((const void*)mk::fwd_megakernel, hipFuncAttributeMaxDynamicSharedMemorySize, mk::LDS_BYTES) != hipSuccess) { fprintf(stderr, "kernel_launch: hipFuncSetAttribute failed\n"); grid = -1; return; }
        if (hipOccupancyMaxActiveBlocksPerMultiprocessor(&per_cu, (const void*)mk::fwd_megakernel, 512, mk::LDS_BYTES) != hipSuccess || per_cu < 1) { fprintf(stderr, "kernel_launch: occupancy query says %d\n", per_cu); per_cu = 1; }
        (void)hipGetLastError();
        grid = cus * per_cu; if (grid > 256) grid = 256;
    }
    if (grid < 0) return;
    mk::Args a{};
    for (int i = 0; i < 33; ++i) a.in[i] = (const float*)d_in[i];
    a.out = (float*)d_out; a.ws = (unsigned char*)d_ws;
#if MK_N_LAUNCH_MODE == 1
    for (int ph = 0; ph < mk::NPHASE; ++ph) { a.ph_lo = ph; a.ph_hi = ph + 1; hipLaunchKernelGGL(mk::fwd_megakernel, dim3(grid), dim3(512), mk::LDS_BYTES, stream, a); }
#else
    a.ph_lo = 0; a.ph_hi = mk::NPHASE;
    (void)hipMemsetAsync((unsigned char*)d_ws + mk::WS_BAR, 0, XCD_BAR_WORDS * sizeof(unsigned), stream);
    void* args[] = {&a};
    hipError_t e = hipLaunchCooperativeKernel((const void*)mk::fwd_megakernel, dim3(grid), dim3(512), args, mk::LDS_BYTES, stream);
    if (e != hipSuccess) fprintf(stderr, "cooperative launch failed: %s (grid %d)\n", hipGetErrorString(e), grid);
#endif
}
```
